# Optimizing an MI355X kernel written in HIP

```python
import jax, jax.numpy as jnp
from jax import lax
import numpy as np

D_MODEL = 2048
BATCH = 2
SEQ = 4096
DEPTH = 1

MLA_HEADS = 8
MLA_Q_RANK = 512
MLA_KV_RANK = 512
MLA_NOPE = 128
MLA_ROPE = 64
MLA_V = 128
ROPE_THETA = 10000.0
FOX_HEADS = 8
FOX_HEAD_DIM = 128
MIX_WIDTH = MLA_HEADS * MLA_V + FOX_HEADS * FOX_HEAD_DIM
Q_BLOCK = 128
OFF_CQ = 0
OFF_CKV = OFF_CQ + MLA_Q_RANK
OFF_KR = OFF_CKV + MLA_KV_RANK
OFF_FQ = OFF_KR + MLA_ROPE
OFF_FK = OFF_FQ + FOX_HEADS * FOX_HEAD_DIM
OFF_FV = OFF_FK + FOX_HEADS * FOX_HEAD_DIM
OFF_FF = OFF_FV + FOX_HEADS * FOX_HEAD_DIM
IN_WIDTH = OFF_FF + FOX_HEADS
PEER_HEADS = 8
PEER_NKEYS = 128
PEER_EXPERTS = PEER_NKEYS * PEER_NKEYS
PEER_KEY_DIM = 128
PEER_TOPK = 16
PEER_TOKEN_BLOCK = 128
PLE_DIM = 256
ALPHA = (2 * DEPTH) ** 0.25
BETA = (8 * DEPTH) ** -0.25
NORM_EPS = 1e-6
NEG_INF = -1e30

kernel_name = "hybrid_mla_fox_peer_deepnorm"


def layer_norm(x, g, b):
    xf = x.astype(jnp.float32)
    mu = jnp.mean(xf, axis=-1, keepdims=True)
    var = jnp.mean(jnp.square(xf - mu), axis=-1, keepdims=True)
    y = (xf - mu) * lax.rsqrt(var + NORM_EPS)
    return (y * g.astype(jnp.float32) + b.astype(jnp.float32)).astype(x.dtype)


def rms_norm(x, g):
    xf = x.astype(jnp.float32)
    y = xf * lax.rsqrt(jnp.mean(jnp.square(xf), axis=-1, keepdims=True) + NORM_EPS)
    return (y * g.astype(jnp.float32)).astype(x.dtype)


def rope(x, cos, sin):
    half = x.shape[-1] // 2
    x1, x2 = x[..., :half], x[..., half:]
    cos = cos.astype(x.dtype)
    sin = sin.astype(x.dtype)
    return jnp.concatenate([x1 * cos - x2 * sin, x1 * sin + x2 * cos], axis=-1)


def to_blocks(t):
    b, s = t.shape[0], t.shape[1]
    return jnp.swapaxes(t.reshape((b, s // Q_BLOCK, Q_BLOCK) + t.shape[2:]), 0, 1)


def from_blocks(t):
    t = jnp.swapaxes(t, 0, 1)
    return t.reshape((t.shape[0], t.shape[1] * t.shape[2]) + t.shape[3:])


def causal_mask(start, seq):
    q_idx = start + jnp.arange(Q_BLOCK)
    k_idx = jnp.arange(seq)
    return k_idx[None, :] <= q_idx[:, None]


def mla_attention(q_nope, q_rope, k_nope, k_rope, v):
    seq = q_nope.shape[1]
    scale = (MLA_NOPE + MLA_ROPE) ** -0.5
    starts = jnp.arange(seq // Q_BLOCK) * Q_BLOCK

    def one_block(args):
        qn, qr, start = args
        s = (jnp.einsum('bqhd,bkhd->bhqk', qn, k_nope, preferred_element_type=jnp.float32)
             + jnp.einsum('bqhr,bkr->bhqk', qr, k_rope, preferred_element_type=jnp.float32)) * scale
        s = jnp.where(causal_mask(start, seq), s, NEG_INF)
        pr = jax.nn.softmax(s, axis=-1).astype(v.dtype)
        return jnp.einsum('bhqk,bkhd->bqhd', pr, v)

    out = lax.map(one_block, (to_blocks(q_nope), to_blocks(q_rope), starts))
    return from_blocks(out)


def fox_attention(q, k, v, cum_log_f):
    seq = q.shape[1]
    scale = FOX_HEAD_DIM ** -0.5
    starts = jnp.arange(seq // Q_BLOCK) * Q_BLOCK
    f_k = jnp.transpose(cum_log_f, (0, 2, 1))

    def one_block(args):
        qb, fq, start = args
        s = jnp.einsum('bqhd,bkhd->bhqk', qb, k, preferred_element_type=jnp.float32) * scale
        s = s + jnp.transpose(fq, (0, 2, 1))[..., :, None] - f_k[:, :, None, :]
        s = jnp.where(causal_mask(start, seq), s, NEG_INF)
        pr = jax.nn.softmax(s, axis=-1).astype(v.dtype)
        return jnp.einsum('bhqk,bkhd->bqhd', pr, v)

    out = lax.map(one_block, (to_blocks(q), to_blocks(cum_log_f), starts))
    return from_blocks(out)


def peer(h, w_q, keys1, keys2, u_tab, v_tab):
    b, s, d = h.shape
    half = PEER_KEY_DIM // 2
    q = (h @ w_q).reshape(b, s, PEER_HEADS, PEER_KEY_DIM)
    s1 = jnp.einsum('bshd,hnd->bshn', q[..., :half], keys1, preferred_element_type=jnp.float32)
    s2 = jnp.einsum('bshd,hnd->bshn', q[..., half:], keys2, preferred_element_type=jnp.float32)
    v1, i1 = lax.top_k(s1, PEER_TOPK)
    v2, i2 = lax.top_k(s2, PEER_TOPK)
    n_cand = PEER_TOPK * PEER_TOPK
    cand = (v1[..., :, None] + v2[..., None, :]).reshape(b, s, PEER_HEADS, n_cand)
    cidx = (i1[..., :, None] * PEER_NKEYS + i2[..., None, :]).reshape(b, s, PEER_HEADS, n_cand)
    sc, pos = lax.top_k(cand, PEER_TOPK)
    eidx = jnp.take_along_axis(cidx, pos, axis=-1)
    gate = jax.nn.softmax(sc, axis=-1).astype(h.dtype)

    t = PEER_TOKEN_BLOCK
    n = (b * s) // t
    hb = h.reshape(n, t, d)
    eb = eidx.reshape(n, t, PEER_HEADS, PEER_TOPK)
    gb = gate.reshape(n, t, PEER_HEADS, PEER_TOPK)

    def one_block(args):
        hx, e, g = args
        u = u_tab[e]
        a = jnp.einsum('thkd,td->thk', u, hx)
        act = jax.nn.gelu(a, approximate=False) * g
        return jnp.einsum('thk,thkd->td', act, v_tab[e])

    return lax.map(one_block, (hb, eb, gb)).reshape(b, s, d)


def setup_inputs(seed: int = 0) -> dict:
    key = jax.random.key(seed)
    ks = jax.random.split(key, 24)
    f32 = jnp.float32

    def nrm(k, shape, scale):
        return jax.random.normal(k, shape, f32) * scale

    L = DEPTH
    return {
        "x": nrm(ks[0], (BATCH, SEQ, D_MODEL), 1.0),
        "p": nrm(ks[1], (DEPTH, BATCH, SEQ, PLE_DIM), 1.0),
        "positions": jnp.broadcast_to(jnp.arange(SEQ, dtype=jnp.int32)[None, :], (BATCH, SEQ)),
        "w_in": nrm(ks[2], (L, D_MODEL, IN_WIDTH), D_MODEL ** -0.5),
        "b_forget": 1.0 + nrm(ks[3], (L, FOX_HEADS), 0.5),
        "g_q_norm": 1.0 + nrm(ks[4], (L, MLA_Q_RANK), 0.02),
        "w_uq": nrm(ks[5], (L, MLA_Q_RANK, MLA_HEADS * (MLA_NOPE + MLA_ROPE)), MLA_Q_RANK ** -0.5),
        "g_kv_norm": 1.0 + nrm(ks[6], (L, MLA_KV_RANK), 0.02),
        "w_ukv": nrm(ks[7], (L, MLA_KV_RANK, MLA_HEADS * (MLA_NOPE + MLA_V)), MLA_KV_RANK ** -0.5),
        "w_out": nrm(ks[8], (L, MIX_WIDTH, D_MODEL), BETA * MIX_WIDTH ** -0.5),
        "ln1_g": 1.0 + nrm(ks[9], (L, D_MODEL), 0.02),
        "ln1_b": nrm(ks[10], (L, D_MODEL), 0.02),
        "peer_wq": nrm(ks[11], (L, D_MODEL, PEER_HEADS * PEER_KEY_DIM), D_MODEL ** -0.5),
        "peer_keys1": nrm(ks[12], (L, PEER_HEADS, PEER_NKEYS, PEER_KEY_DIM // 2), (PEER_KEY_DIM // 2) ** -0.5),
        "peer_keys2": nrm(ks[13], (L, PEER_HEADS, PEER_NKEYS, PEER_KEY_DIM // 2), (PEER_KEY_DIM // 2) ** -0.5),
        "peer_u": nrm(ks[14], (L, PEER_EXPERTS, D_MODEL), D_MODEL ** -0.5),
        "peer_v": nrm(ks[15], (L, PEER_EXPERTS, D_MODEL), BETA * PEER_HEADS ** -0.5),
        "ple_wgate": nrm(ks[16], (L, D_MODEL, D_MODEL), D_MODEL ** -0.5),
        "ple_wproj": nrm(ks[17], (L, PLE_DIM, D_MODEL), BETA * PLE_DIM ** -0.5),
        "ln2_g": 1.0 + nrm(ks[18], (L, D_MODEL), 0.02),
        "ln2_b": nrm(ks[19], (L, D_MODEL), 0.02),
    }


def reference(x, p, positions, w_in, b_forget, g_q_norm, w_uq, g_kv_norm, w_ukv, w_out,
              ln1_g, ln1_b, peer_wq, peer_keys1, peer_keys2, peer_u, peer_v,
              ple_wgate, ple_wproj, ln2_g, ln2_b):
    b, s, _ = x.shape
    inv_freq = 1.0 / (ROPE_THETA ** (jnp.arange(0, MLA_ROPE, 2, dtype=jnp.float32) / MLA_ROPE))
    ang = positions.astype(jnp.float32)[..., None] * inv_freq
    cos, sin = jnp.cos(ang), jnp.sin(ang)

    h = x
    for i in range(DEPTH):
        z = h @ w_in[i]

        cq = rms_norm(z[..., OFF_CQ:OFF_CKV], g_q_norm[i])
        q = (cq @ w_uq[i]).reshape(b, s, MLA_HEADS, MLA_NOPE + MLA_ROPE)
        q_nope = q[..., :MLA_NOPE]
        q_rope = rope(q[..., MLA_NOPE:], cos[:, :, None, :], sin[:, :, None, :])
        ckv = rms_norm(z[..., OFF_CKV:OFF_KR], g_kv_norm[i])
        kv = (ckv @ w_ukv[i]).reshape(b, s, MLA_HEADS, MLA_NOPE + MLA_V)
        k_nope, v_mla = kv[..., :MLA_NOPE], kv[..., MLA_NOPE:]
        k_rope = rope(z[..., OFF_KR:OFF_FQ], cos, sin)
        o_mla = mla_attention(q_nope, q_rope, k_nope, k_rope, v_mla).reshape(b, s, MLA_HEADS * MLA_V)

        fq = z[..., OFF_FQ:OFF_FK].reshape(b, s, FOX_HEADS, FOX_HEAD_DIM)
        fk = z[..., OFF_FK:OFF_FV].reshape(b, s, FOX_HEADS, FOX_HEAD_DIM)
        fv = z[..., OFF_FV:OFF_FF].reshape(b, s, FOX_HEADS, FOX_HEAD_DIM)
        log_f = jax.nn.log_sigmoid(z[..., OFF_FF:IN_WIDTH].astype(jnp.float32) + b_forget[i].astype(jnp.float32))
        cum_log_f = lax.cumsum(log_f, axis=1)
        o_fox = fox_attention(fq, fk, fv, cum_log_f).reshape(b, s, FOX_HEADS * FOX_HEAD_DIM)

        mix = jnp.concatenate([o_mla, o_fox], axis=-1) @ w_out[i]
        h = layer_norm(ALPHA * h + mix, ln1_g[i], ln1_b[i])

        ffn = peer(h, peer_wq[i], peer_keys1[i], peer_keys2[i], peer_u[i], peer_v[i])
        ple = (p[i] @ ple_wproj[i]) * jax.nn.sigmoid(h @ ple_wgate[i])
        h = layer_norm(ALPHA * h + ffn + ple, ln2_g[i], ln2_b[i])
    return h
```

```cpp
#include <hip/hip_runtime.h>
#include <hip/hip_bf16.h>
#include <hip/hip_cooperative_groups.h>
#include <stdint.h>
#include <cstdio>
namespace cg = cooperative_groups;

typedef unsigned short u16;
typedef short bf16x8 __attribute__((ext_vector_type(8)));
typedef float f32x4 __attribute__((ext_vector_type(4)));
typedef unsigned u32x4 __attribute__((ext_vector_type(4)));
typedef unsigned u32x2 __attribute__((ext_vector_type(2)));

#ifndef SINGLE_LAUNCH
#define SINGLE_LAUNCH 1
#endif

constexpr int T_ = 8192, D_ = 2048, S_ = 4096, NB_ = 2;
constexpr int INW = 4168;
constexpr int NPH = 8;
constexpr float ALPHA = 1.189207115002721f;
constexpr float EPS = 1e-6f;
constexpr int SMEM_BYTES = 65536;

constexpr size_t al256(size_t x) { return (x + 255) & ~(size_t)255; }
constexpr size_t O_CTR = 0;
constexpr size_t O_WINT = O_CTR + 256;
constexpr size_t O_WUQT = O_WINT + al256((size_t)4224 * 2048 * 2);
constexpr size_t O_WUKVT = O_WUQT + al256((size_t)1536 * 512 * 2);
constexpr size_t O_WOUTT = O_WUKVT + al256((size_t)2048 * 512 * 2);
constexpr size_t O_WPQT = O_WOUTT + al256((size_t)2048 * 2048 * 2);
constexpr size_t O_WGT = O_WPQT + al256((size_t)1024 * 2048 * 2);
constexpr size_t O_WPT = O_WGT + al256((size_t)2048 * 2048 * 2);
constexpr size_t O_PB = O_WPT + al256((size_t)2048 * 256 * 2);
constexpr size_t O_UB = O_PB + al256((size_t)8192 * 256 * 2);
constexpr size_t O_VB = O_UB + al256((size_t)16384 * 2048 * 2);
constexpr size_t O_OMIX = O_VB + al256((size_t)16384 * 2048 * 2);
constexpr size_t O_CS = O_OMIX + al256((size_t)8192 * 2048 * 2);
constexpr size_t O_REGB = O_CS + al256((size_t)8192 * 32 * 8);
constexpr size_t O_XB = O_REGB;
constexpr size_t O_CQB = O_XB + al256((size_t)8192 * 2048 * 2);
constexpr size_t O_CKVB = O_CQB + al256((size_t)8192 * 512 * 2);
constexpr size_t O_QM = O_CKVB + al256((size_t)8192 * 512 * 2);
constexpr size_t O_KM = O_QM + al256((size_t)8192 * 8 * 192 * 2);
constexpr size_t O_VMT = O_KM + al256((size_t)8192 * 8 * 192 * 2);
constexpr size_t O_QF = O_VMT + al256((size_t)8192 * 8 * 128 * 2);
constexpr size_t O_KF = O_QF + al256((size_t)8192 * 8 * 128 * 2);
constexpr size_t O_VFT = O_KF + al256((size_t)8192 * 8 * 128 * 2);
constexpr size_t O_LOGF = O_VFT + al256((size_t)8192 * 8 * 128 * 2);
constexpr size_t O_FK = O_LOGF + al256((size_t)16 * 4096 * 4);
constexpr size_t O_ENDB = O_FK + al256((size_t)16 * 4096 * 4);
constexpr size_t O_Y1 = O_REGB;
constexpr size_t O_H1B = O_Y1 + al256((size_t)8192 * 2048 * 4);
constexpr size_t O_PQ = O_H1B + al256((size_t)8192 * 2048 * 2);
constexpr size_t O_ENDB2 = O_PQ + al256((size_t)8192 * 1024 * 4);
static_assert(O_ENDB2 <= O_ENDB, "region B reuse overflow");
static_assert(O_ENDB <= (size_t)500 * 1024 * 1024, "workspace too large");

struct Params {
  const float *x, *p; const int* positions;
  const float *w_in, *b_forget, *g_q, *w_uq, *g_kv, *w_ukv, *w_out, *ln1_g, *ln1_b;
  const float *peer_wq, *keys1, *keys2, *peer_u, *peer_v, *wgate, *wproj, *ln2_g, *ln2_b;
  float* out;
  char* ws;
#define WSP(type, name, off) __device__ __forceinline__ type* name() const { return (type*)(ws + (off)); }
  WSP(unsigned, ctr, O_CTR) WSP(u16, WinT, O_WINT) WSP(u16, WuqT, O_WUQT) WSP(u16, WukvT, O_WUKVT) WSP(u16, WoutT, O_WOUTT)
  WSP(u16, WpqT, O_WPQT) WSP(u16, WgT, O_WGT) WSP(u16, WpT, O_WPT) WSP(u16, pb, O_PB) WSP(u16, Ub, O_UB) WSP(u16, Vb, O_VB)
  WSP(u16, omix, O_OMIX) WSP(float2, cs, O_CS)
  WSP(u16, xb, O_XB) WSP(u16, cqb, O_CQB) WSP(u16, ckvb, O_CKVB) WSP(u16, Qm, O_QM) WSP(u16, Km, O_KM) WSP(u16, VmT, O_VMT)
  WSP(u16, Qf, O_QF) WSP(u16, Kf, O_KF) WSP(u16, VfT, O_VFT) WSP(float, logf, O_LOGF) WSP(float, Fk, O_FK)
  WSP(float, y1, O_Y1) WSP(u16, h1b, O_H1B) WSP(float, pq, O_PQ)
#undef WSP
};

__device__ __forceinline__ unsigned pk2(float lo, float hi) {
  unsigned r; asm volatile("v_cvt_pk_bf16_f32 %0, %1, %2" : "=v"(r) : "v"(lo), "v"(hi)); return r;
}
__device__ __forceinline__ u16 f2bf(float f) { return (u16)(pk2(f, 0.f) & 0xffffu); }
__device__ __forceinline__ float bf2f(u16 v) { return __uint_as_float(((unsigned)v) << 16); }
__device__ __forceinline__ float bflo(unsigned v) { return __uint_as_float(v << 16); }
__device__ __forceinline__ float bfhi(unsigned v) { return __uint_as_float(v & 0xffff0000u); }

template <int CTRL> __device__ __forceinline__ int dppi(int v) { return __builtin_amdgcn_update_dpp(0, v, CTRL, 0xF, 0xF, false); }
template <int CTRL> __device__ __forceinline__ float dppf(float v) { return __int_as_float(dppi<CTRL>(__float_as_int(v))); }
__device__ __forceinline__ float rdlane(float v, int l) { return __int_as_float(__builtin_amdgcn_readlane(__float_as_int(v), l)); }

__device__ __forceinline__ float row_sum(float v) {
  v += dppf<0xB1>(v); v += dppf<0x4E>(v); v += dppf<0x141>(v); v += dppf<0x140>(v); return v;
}
__device__ __forceinline__ float row_max(float v) {
  v = fmaxf(v, dppf<0xB1>(v)); v = fmaxf(v, dppf<0x4E>(v)); v = fmaxf(v, dppf<0x141>(v)); v = fmaxf(v, dppf<0x140>(v)); return v;
}
__device__ __forceinline__ float wave_sum(float v) {
  v = row_sum(v);
  return (rdlane(v, 0) + rdlane(v, 16)) + (rdlane(v, 32) + rdlane(v, 48));
}
__device__ __forceinline__ float wave_max(float v) {
  v = row_max(v);
  return fmaxf(fmaxf(rdlane(v, 0), rdlane(v, 16)), fmaxf(rdlane(v, 32), rdlane(v, 48)));
}
__device__ __forceinline__ unsigned wave_umax(unsigned v) {
  unsigned t;
  t = (unsigned)dppi<0xB1>((int)v); v = v > t ? v : t;
  t = (unsigned)dppi<0x4E>((int)v); v = v > t ? v : t;
  t = (unsigned)dppi<0x141>((int)v); v = v > t ? v : t;
  t = (unsigned)dppi<0x140>((int)v); v = v > t ? v : t;
  unsigned a = (unsigned)__builtin_amdgcn_readlane((int)v, 0), b = (unsigned)__builtin_amdgcn_readlane((int)v, 16);
  unsigned c = (unsigned)__builtin_amdgcn_readlane((int)v, 32), d = (unsigned)__builtin_amdgcn_readlane((int)v, 48);
  a = a > b ? a : b; c = c > d ? c : d; return a > c ? a : c;
}
__device__ __forceinline__ unsigned ordkey(float f) {
  unsigned u = __float_as_uint(f);
  return (u & 0x80000000u) ? ~u : (u | 0x80000000u);
}

__device__ void transpose_cvt(const float* __restrict__ W, int ldw, int K, int src_col0, int ncols,
                              u16* __restrict__ WT, int dst_row0, const float* __restrict__ kscale,
                              float* tile, int bid, int nb) {
  const int tiles_k = K / 64, tiles_n = ncols / 64, tid = threadIdx.x;
#pragma unroll 1
  for (int t = bid; t < tiles_k * tiles_n; t += nb) {
    const int tk = t % tiles_k, tn = t / tiles_k, k0 = tk * 64, n0 = tn * 64;
#pragma unroll
    for (int i = 0; i < 4; ++i) {
      const int r = (tid >> 4) + 16 * i, c = (tid & 15) * 4;
      const float4 v = *(const float4*)(W + (size_t)(k0 + r) * ldw + src_col0 + n0 + c);
      const float sc = kscale ? kscale[k0 + r] : 1.f;
      tile[r * 65 + c + 0] = v.x * sc; tile[r * 65 + c + 1] = v.y * sc;
      tile[r * 65 + c + 2] = v.z * sc; tile[r * 65 + c + 3] = v.w * sc;
    }
    __syncthreads();
    {
      const int n = tid >> 2, kk = (tid & 3) * 16;
      unsigned w[8];
#pragma unroll
      for (int e = 0; e < 8; ++e) w[e] = pk2(tile[(kk + 2 * e) * 65 + n], tile[(kk + 2 * e + 1) * 65 + n]);
      u32x4* dst = (u32x4*)(WT + (size_t)(dst_row0 + n0 + n) * K + k0 + kk);
      dst[0] = u32x4{w[0], w[1], w[2], w[3]};
      dst[1] = u32x4{w[4], w[5], w[6], w[7]};
    }
    __syncthreads();
  }
}

__device__ void cvt_bf16(const float* __restrict__ src, u16* __restrict__ dst, size_t n8, size_t gtid, size_t gthreads) {
  for (size_t i = gtid; i < n8; i += gthreads) {
    const float4 a = ((const float4*)src)[2 * i], b = ((const float4*)src)[2 * i + 1];
    ((u32x4*)dst)[i] = u32x4{pk2(a.x, a.y), pk2(a.z, a.w), pk2(b.x, b.y), pk2(b.z, b.w)};
  }
}

__device__ void phase_prep(const Params& p, char* smem, int bid, int nb) {
  const int tid = threadIdx.x, lane = tid & 63, wid = tid >> 6;
  float* tile = (float*)smem;
  if (bid == 0 && tid == 0) p.ctr()[0] = 0;
  transpose_cvt(p.w_in, INW, D_, 0, 1024, p.WinT(), 0, nullptr, tile, bid, nb);
  transpose_cvt(p.w_in, INW, D_, 1088, 3072, p.WinT(), 1024, nullptr, tile, bid, nb);
  transpose_cvt(p.w_in, INW, D_, 1024, 64, p.WinT(), 4096, nullptr, tile, bid, nb);
  transpose_cvt(p.w_uq, 1536, 512, 0, 1536, p.WuqT(), 0, p.g_q, tile, bid, nb);
  transpose_cvt(p.w_ukv, 2048, 512, 0, 2048, p.WukvT(), 0, p.g_kv, tile, bid, nb);
  transpose_cvt(p.w_out, 2048, 2048, 0, 2048, p.WoutT(), 0, nullptr, tile, bid, nb);
  transpose_cvt(p.peer_wq, 1024, 2048, 0, 1024, p.WpqT(), 0, nullptr, tile, bid, nb);
  transpose_cvt(p.wgate, 2048, 2048, 0, 2048, p.WgT(), 0, nullptr, tile, bid, nb);
  transpose_cvt(p.wproj, 2048, 256, 0, 2048, p.WpT(), 0, nullptr, tile, bid, nb);
  const size_t gtid = (size_t)bid * 256 + tid, gth = (size_t)nb * 256;
  for (size_t i = gtid; i < (size_t)64 * 2048 / 8; i += gth) ((u32x4*)(p.WinT() + (size_t)4160 * 2048))[i] = u32x4{0, 0, 0, 0};
  cvt_bf16(p.x, p.xb(), (size_t)T_ * D_ / 8, gtid, gth);
  cvt_bf16(p.p, p.pb(), (size_t)T_ * 256 / 8, gtid, gth);
  cvt_bf16(p.peer_u, p.Ub(), (size_t)16384 * 2048 / 8, gtid, gth);
  cvt_bf16(p.peer_v, p.Vb(), (size_t)16384 * 2048 / 8, gtid, gth);
  for (size_t i = gtid; i < (size_t)T_ * 32; i += gth) {
    const int t = (int)(i >> 5), fi = (int)(i & 31);
    const float invf = 1.0f / powf(10000.0f, (float)(2 * fi) / 64.0f);
    const float ang = (float)p.positions[t] * invf;
    const double rev = (double)ang * 0.15915494309189535;
    const float fr = (float)(rev - rint(rev));
    p.cs()[i] = make_float2(__builtin_amdgcn_cosf(fr), __builtin_amdgcn_sinf(fr));
  }
  __syncthreads();
  float* wff = (float*)smem;
  for (int i = tid; i < 2048 * 2; i += 256) {
    const int k = i >> 1, hf = i & 1;
    *(float4*)(wff + k * 8 + hf * 4) = *(const float4*)(p.w_in + (size_t)k * INW + 4160 + hf * 4);
  }
  __syncthreads();
  for (int t = bid * 4 + wid; t < T_; t += nb * 4) {
    float a[8];
#pragma unroll
    for (int e = 0; e < 8; ++e) a[e] = 0.f;
#pragma unroll 4
    for (int i = 0; i < 32; ++i) {
      const int k = i * 64 + lane;
      const float xv = p.x[(size_t)t * D_ + k];
      const float4 w0 = *(const float4*)(wff + k * 8), w1 = *(const float4*)(wff + k * 8 + 4);
      a[0] += xv * w0.x; a[1] += xv * w0.y; a[2] += xv * w0.z; a[3] += xv * w0.w;
      a[4] += xv * w1.x; a[5] += xv * w1.y; a[6] += xv * w1.z; a[7] += xv * w1.w;
    }
    float mine = 0.f;
#pragma unroll
    for (int e = 0; e < 8; ++e) { const float s = wave_sum(a[e]); if (lane == e) mine = s; }
    if (lane < 8) {
      const float z = mine + p.b_forget[lane];
      const float ls = fminf(z, 0.f) - log1pf(expf(-fabsf(z)));
      const int b = t >> 12, s = t & 4095;
      p.logf()[((size_t)(b * 8 + lane)) * S_ + s] = ls;
    }
  }
}

__device__ __forceinline__ void gemm_core(const u16* __restrict__ A, int lda, const u16* __restrict__ Bt, int ldb,
                                          int K, int brow, int bcol, char* smem, f32x4 (&acc)[4][4]) {
  u16* SA = (u16*)smem; u16* SB = (u16*)(smem + 8192);
  const int tid = threadIdx.x, wid = tid >> 6, lane = tid & 63, wr = wid >> 1, wc = wid & 1, fr = lane & 15, fq = lane >> 4;
#pragma unroll
  for (int m = 0; m < 4; ++m)
#pragma unroll
    for (int n = 0; n < 4; ++n) acc[m][n] = f32x4{0.f, 0.f, 0.f, 0.f};
  const int nk = K / 32;
  for (int kt = 0; kt < nk; ++kt) {
#pragma unroll
    for (int i = 0; i < 2; ++i) {
      const int b = tid * 16 + i * 4096, r = b / 64, c = (b % 64) / 2;
      __builtin_amdgcn_global_load_lds((const unsigned*)(A + (size_t)(brow + r) * lda + kt * 32 + c), (unsigned*)((char*)SA + b), 16, 0, 0);
      __builtin_amdgcn_global_load_lds((const unsigned*)(Bt + (size_t)(bcol + r) * ldb + kt * 32 + c), (unsigned*)((char*)SB + b), 16, 0, 0);
    }
    asm volatile("s_waitcnt vmcnt(0)" ::: "memory");
    __syncthreads();
    bf16x8 At[4], Bl[4];
#pragma unroll
    for (int m = 0; m < 4; ++m) At[m] = *reinterpret_cast<const bf16x8*>((char*)SA + (wr * 64 + m * 16 + fr) * 64 + fq * 16);
#pragma unroll
    for (int n = 0; n < 4; ++n) Bl[n] = *reinterpret_cast<const bf16x8*>((char*)SB + (wc * 64 + n * 16 + fr) * 64 + fq * 16);
#pragma unroll
    for (int m = 0; m < 4; ++m)
#pragma unroll
      for (int n = 0; n < 4; ++n) acc[m][n] = __builtin_amdgcn_mfma_f32_16x16x32_bf16(At[m], Bl[n], acc[m][n], 0, 0, 0);
    __syncthreads();
  }
}

template <class Epi>
__device__ __forceinline__ void gemm128(const u16* __restrict__ A, int lda, const u16* __restrict__ Bt, int ldb,
                                        int K, int brow, int bcol, char* smem, Epi epi) {
  const int tid = threadIdx.x, wid = tid >> 6, lane = tid & 63, wr = wid >> 1, wc = wid & 1, fr = lane & 15, fq = lane >> 4;
  f32x4 acc[4][4];
  gemm_core(A, lda, Bt, ldb, K, brow, bcol, smem, acc);
  epi(acc, brow + wr * 64, bcol + wc * 64, fr, fq);
}

__device__ void phase_inproj(const Params& p, char* smem, int bid, int nb) {
  const int ntn = 33, ntiles = 64 * ntn;
  for (int t = bid; t < ntiles; t += nb) {
    const int tm = t / ntn, tn = t % ntn;
    gemm128(p.xb(), D_, p.WinT(), D_, D_, tm * 128, tn * 128, smem,
      [&](f32x4 (&acc)[4][4], int row0, int col0, int fr, int fq) {
        if (col0 < 1024) {
          u16* dst = col0 < 512 ? p.cqb() : p.ckvb(); const int cb = col0 & 511;
#pragma unroll
          for (int m = 0; m < 4; ++m)
#pragma unroll
            for (int n = 0; n < 4; ++n)
#pragma unroll
              for (int j = 0; j < 4; ++j) {
                const int row = row0 + m * 16 + fq * 4 + j;
                dst[(size_t)row * 512 + cb + n * 16 + fr] = f2bf(acc[m][n][j]);
              }
        } else if (col0 < 3072) {
          int c = col0 - 1024; u16* dst = c < 1024 ? p.Qf() : p.Kf(); c &= 1023;
          const int hh = c >> 7, d0 = c & 127;
#pragma unroll
          for (int m = 0; m < 4; ++m)
#pragma unroll
            for (int n = 0; n < 4; ++n)
#pragma unroll
              for (int j = 0; j < 4; ++j) {
                const int row = row0 + m * 16 + fq * 4 + j, b = row >> 12, s = row & 4095;
                dst[((size_t)(b * 8 + hh) * S_ + s) * 128 + d0 + n * 16 + fr] = f2bf(acc[m][n][j]);
              }
        } else if (col0 < 4096) {
          const int c = col0 - 3072, hh = c >> 7, d0 = c & 127;
#pragma unroll
          for (int m = 0; m < 4; ++m)
#pragma unroll
            for (int n = 0; n < 4; ++n) {
              const int row = row0 + m * 16 + fq * 4, b = row >> 12, s = row & 4095, dv = d0 + n * 16 + fr;
              *(u32x2*)(p.VfT() + ((size_t)(b * 8 + hh) * 128 + dv) * S_ + s) =
                  u32x2{pk2(acc[m][n][0], acc[m][n][1]), pk2(acc[m][n][2], acc[m][n][3])};
            }
        } else if (col0 == 4096) {
#pragma unroll
          for (int m = 0; m < 4; ++m)
#pragma unroll
            for (int j = 0; j < 4; ++j) {
              const int row = row0 + m * 16 + fq * 4 + j, b = row >> 12, s = row & 4095;
#pragma unroll
              for (int n = 0; n < 2; ++n) {
                const int i = n * 16 + fr;
                const float2 cs = p.cs()[(size_t)row * 32 + i];
                const float x1 = acc[m][n][j], x2 = acc[m][n + 2][j];
                const u16 o1 = f2bf(x1 * cs.x - x2 * cs.y), o2 = f2bf(x1 * cs.y + x2 * cs.x);
                for (int hh = 0; hh < 8; ++hh) {
                  u16* kd = p.Km() + ((size_t)(b * 8 + hh) * S_ + s) * 192 + 128;
                  kd[i] = o1; kd[32 + i] = o2;
                }
              }
            }
        }
      });
  }
}

__device__ __forceinline__ void compute_rs(const u16* __restrict__ src, int brow, float* rsv) {
  const int tid = threadIdx.x, row = tid >> 1, hf = tid & 1;
  const u16* r = src + (size_t)(brow + row) * 512 + hf * 256;
  float ss = 0.f;
#pragma unroll 4
  for (int i = 0; i < 32; ++i) {
    const u32x4 v = *(const u32x4*)(r + i * 8);
#pragma unroll
    for (int w = 0; w < 4; ++w) { const float a = bflo(v[w]), b = bfhi(v[w]); ss += a * a + b * b; }
  }
  ss += dppf<0xB1>(ss);
  if (hf == 0) rsv[row] = rsqrtf(ss * (1.f / 512.f) + EPS);
}

__device__ void phase_up(const Params& p, char* smem, int bid, int nb) {
  float* rsv = (float*)(smem + 16384);
  const int nq = 64 * 12, nkv = 64 * 16, njobs = nq + nkv + 16;
  for (int t = bid; t < njobs; t += nb) {
    if (t < nq) {
      const int tm = t / 12, tn = t % 12;
      compute_rs(p.cqb(), tm * 128, rsv);
      gemm128(p.cqb(), 512, p.WuqT(), 512, 512, tm * 128, tn * 128, smem,
        [&](f32x4 (&acc)[4][4], int row0, int col0, int fr, int fq) {
          const int hh = col0 / 192, off = col0 % 192;
          const int lr0 = row0 & 127;
          if (off < 128) {
#pragma unroll
            for (int m = 0; m < 4; ++m)
#pragma unroll
              for (int j = 0; j < 4; ++j) {
                const int lr = lr0 + m * 16 + fq * 4 + j, row = (row0 - lr0) + lr, b = row >> 12, s = row & 4095;
                const float rs = rsv[lr];
                u16* qd = p.Qm() + ((size_t)(b * 8 + hh) * S_ + s) * 192 + off;
#pragma unroll
                for (int n = 0; n < 4; ++n) qd[n * 16 + fr] = f2bf(acc[m][n][j] * rs);
              }
          } else {
#pragma unroll
            for (int m = 0; m < 4; ++m)
#pragma unroll
              for (int j = 0; j < 4; ++j) {
                const int lr = lr0 + m * 16 + fq * 4 + j, row = (row0 - lr0) + lr, b = row >> 12, s = row & 4095;
                const float rs = rsv[lr];
                u16* qd = p.Qm() + ((size_t)(b * 8 + hh) * S_ + s) * 192 + 128;
#pragma unroll
                for (int n = 0; n < 2; ++n) {
                  const int i = n * 16 + fr;
                  const float2 cs = p.cs()[(size_t)row * 32 + i];
                  const float x1 = acc[m][n][j] * rs, x2 = acc[m][n + 2][j] * rs;
                  qd[i] = f2bf(x1 * cs.x - x2 * cs.y); qd[32 + i] = f2bf(x1 * cs.y + x2 * cs.x);
                }
              }
          }
        });
      __syncthreads();
    } else if (t < nq + nkv) {
      const int tt = t - nq, tm = tt / 16, tn = tt % 16;
      compute_rs(p.ckvb(), tm * 128, rsv);
      gemm128(p.ckvb(), 512, p.WukvT(), 512, 512, tm * 128, tn * 128, smem,
        [&](f32x4 (&acc)[4][4], int row0, int col0, int fr, int fq) {
          const int hh = col0 >> 8, off = col0 & 255;
          const int lr0 = row0 & 127;
          if (off < 128) {
#pragma unroll
            for (int m = 0; m < 4; ++m)
#pragma unroll
              for (int j = 0; j < 4; ++j) {
                const int lr = lr0 + m * 16 + fq * 4 + j, row = (row0 - lr0) + lr, b = row >> 12, s = row & 4095;
                const float rs = rsv[lr];
                u16* kd = p.Km() + ((size_t)(b * 8 + hh) * S_ + s) * 192 + off;
#pragma unroll
                for (int n = 0; n < 4; ++n) kd[n * 16 + fr] = f2bf(acc[m][n][j] * rs);
              }
          } else {
#pragma unroll
            for (int m = 0; m < 4; ++m) {
              const int lr = lr0 + m * 16 + fq * 4, row = (row0 - lr0) + lr, b = row >> 12, s = row & 4095;
              const float r0 = rsv[lr], r1 = rsv[lr + 1], r2 = rsv[lr + 2], r3 = rsv[lr + 3];
#pragma unroll
              for (int n = 0; n < 4; ++n) {
                const int dv = off - 128 + n * 16 + fr;
                *(u32x2*)(p.VmT() + ((size_t)(b * 8 + hh) * 128 + dv) * S_ + s) =
                    u32x2{pk2(acc[m][n][0] * r0, acc[m][n][1] * r1), pk2(acc[m][n][2] * r2, acc[m][n][3] * r3)};
              }
            }
          }
        });
      __syncthreads();
    } else {
      const int seq = t - nq - nkv;
      if ((threadIdx.x >> 6) == 0) {
        const int lane = threadIdx.x & 63;
        const float* src = p.logf() + (size_t)seq * S_ + lane * 64;
        float* dst = p.Fk() + (size_t)seq * S_ + lane * 64;
        float sum = 0.f;
        for (int i = 0; i < 16; ++i) { const float4 v = *(const float4*)(src + i * 4); sum += v.x; sum += v.y; sum += v.z; sum += v.w; }
        float inc = sum;
#pragma unroll
        for (int d = 1; d < 64; d <<= 1) { const float o = __shfl_up(inc, d, 64); if (lane >= d) inc += o; }
        float run = inc - sum;
        for (int i = 0; i < 16; ++i) {
          const float4 v = *(const float4*)(src + i * 4); float4 o;
          run += v.x; o.x = run; run += v.y; o.y = run; run += v.z; o.z = run; run += v.w; o.w = run;
          *(float4*)(dst + i * 4) = o;
        }
      }
    }
  }
}

#ifdef ATTN_NAIVE
__device__ void phase_attn_naive(const Params& p, char* smem, int bid, int nb) {
  const int tid = threadIdx.x, lane = tid & 63, wid = tid >> 6;
  const int per = NB_ * 8 * S_, nrows = 2 * per;
  for (int r = bid * 4 + wid; r < nrows; r += nb * 4) {
    const int type = r / per, rr = r % per, bh = rr / S_, s = rr % S_;
    const int DQ = type ? 128 : 192;
    const u16* Q = type ? p.Qf() + ((size_t)bh * S_ + s) * 128 : p.Qm() + ((size_t)bh * S_ + s) * 192;
    const u16* Kb = type ? p.Kf() + (size_t)bh * S_ * 128 : p.Km() + (size_t)bh * S_ * 192;
    const u16* VT = (type ? p.VfT() : p.VmT()) + (size_t)bh * 128 * S_;
    const float* F = p.Fk() + (size_t)bh * S_;
    const float scale = type ? 0.08838834764831845f : 0.07216878364870322f;
    float m = -1e30f, l = 0.f;
    float acc[128];
#pragma unroll
    for (int d = 0; d < 128; ++d) acc[d] = 0.f;
    const float fqv = type ? F[s] : 0.f;
    for (int k0 = 0; k0 <= s; k0 += 64) {
      const int key = k0 + lane; const bool valid = key <= s; const int keyc = valid ? key : s;
      const u16* kr = Kb + (size_t)keyc * DQ;
      float sc = 0.f;
      for (int d = 0; d < DQ; d += 8) {
        const u32x4 kv = *(const u32x4*)(kr + d), qv = *(const u32x4*)(Q + d);
#pragma unroll
        for (int w = 0; w < 4; ++w) sc += bflo(kv[w]) * bflo(qv[w]) + bfhi(kv[w]) * bfhi(qv[w]);
      }
      sc *= scale;
      if (type) sc += fqv - F[keyc];
      if (!valid) sc = -1e30f;
      const float mx = wave_max(sc), mn = fmaxf(m, mx), alpha = __expf(m - mn);
      const float pr = valid ? __expf(sc - mn) : 0.f;
      m = mn; l = l * alpha + pr;
#pragma unroll
      for (int d = 0; d < 128; ++d) acc[d] = acc[d] * alpha + pr * bf2f(VT[(size_t)d * S_ + keyc]);
    }
    const float inv = 1.f / wave_sum(l);
    float o0 = 0.f, o1 = 0.f;
#pragma unroll
    for (int d = 0; d < 128; ++d) {
      const float o = wave_sum(acc[d]) * inv;
      if (lane == (d & 63)) { if (d < 64) o0 = o; else o1 = o; }
    }
    const int b = bh >> 3, hh = bh & 7;
    u16* od = p.omix() + ((size_t)(b * S_ + s)) * 2048 + type * 1024 + hh * 128;
    od[lane] = f2bf(o0); od[64 + lane] = f2bf(o1);
  }
}

#endif
typedef float f32x16 __attribute__((ext_vector_type(16)));
template <int TYPE>
__device__ __forceinline__ void attn_item(const Params& p, char* smem, int bh, int qb) {
  constexpr int DQK = TYPE ? 128 : 192, NKS = DQK / 16, KSTR = DQK * 2 + 16, VSTR = 128;
  constexpr int KCH = DQK / 8, NKL = 64 * KCH / 256;
  constexpr float C2 = (TYPE ? 0.08838834764831845f : 0.07216878364870322f) * 1.4426950408889634f;
  char* sK = smem; char* sV = smem + 25600; float* sF = (float*)(smem + 25600 + 32768);
  const int tid = threadIdx.x, lane = tid & 63, wid = tid >> 6, c = lane & 31, hi = lane >> 5;
  const u16* Qb = (TYPE ? p.Qf() : p.Qm()) + (size_t)bh * S_ * DQK;
  const u16* Kb = (TYPE ? p.Kf() : p.Km()) + (size_t)bh * S_ * DQK;
  const u16* Vb = (TYPE ? p.VfT() : p.VmT()) + (size_t)bh * 128 * S_;
  const float* Fb = p.Fk() + (size_t)bh * S_;
  const int qrow = qb * 128 + wid * 32;
  bf16x8 qf[NKS];
#pragma unroll
  for (int ks = 0; ks < NKS; ++ks) qf[ks] = *(const bf16x8*)(Qb + (size_t)(qrow + c) * DQK + ks * 16 + hi * 8);
  f32x16 o[4];
#pragma unroll
  for (int db = 0; db < 4; ++db)
#pragma unroll
    for (int r = 0; r < 16; ++r) o[db][r] = 0.f;
  float m = -1e30f, l = 0.f;
  const int ntiles = 2 * qb + 2;
  u32x4 kreg[NKL];
  float4 freg = make_float4(0.f, 0.f, 0.f, 0.f);
  const unsigned koff = (unsigned)tid * 16u;
  auto load_k = [&](int kt) {
    const char* kb = (const char*)(Kb + (size_t)kt * 64 * DQK);
#pragma unroll
    for (int i = 0; i < NKL; ++i) kreg[i] = *(const u32x4*)(kb + i * 4096 + koff);
    if (TYPE) { if (tid < 16) freg = *(const float4*)(Fb + kt * 64 + tid * 4); }
  };
  const unsigned voff = (unsigned)((((tid >> 3) * S_) + (((tid & 7) ^ ((tid >> 4) & 7)) * 8)) * 2);
  auto load_v = [&](int kt) {
    const char* vb = (const char*)(Vb + kt * 64);
    char* dst = sV + (kt & 1) * 16384 + tid * 16;
#pragma unroll
    for (int i = 0; i < 4; ++i)
      __builtin_amdgcn_global_load_lds((const unsigned*)(vb + (size_t)i * 32 * S_ * 2 + voff), (unsigned*)(dst + i * 4096), 16, 0, 0);
  };
  auto store_tile = [&]() {
#pragma unroll
    for (int i = 0; i < NKL; ++i) { const int ch = tid + 256 * i, key = ch / KCH, dc = ch % KCH; *(u32x4*)(sK + key * KSTR + dc * 16) = kreg[i]; }
    if (TYPE) { if (tid < 16) { const float L2E = 1.4426950408889634f; *(float4*)(sF + tid * 4) = make_float4(freg.x * L2E, freg.y * L2E, freg.z * L2E, freg.w * L2E); } }
  };
  const int krow = (c & 19) | ((c & 4) << 1) | ((c & 8) >> 1);
  const char* ka0 = sK + krow * KSTR + hi * 16;
  const char* ka1 = ka0 + 32 * KSTR;
  const int vx = (c >> 1) & 7;
  int vo[2][2];
#pragma unroll
  for (int kb = 0; kb < 2; ++kb)
#pragma unroll
    for (int s2 = 0; s2 < 2; ++s2) vo[kb][s2] = c * VSTR + (((4 * kb + 2 * s2 + hi) ^ vx) * 16);
  load_k(0); load_v(0);
#pragma unroll 1
  for (int kt = 0; kt < ntiles; ++kt) {
    asm volatile("s_waitcnt vmcnt(0)" ::: "memory");
    __syncthreads();
    store_tile();
    __syncthreads();
    if (kt + 1 < ntiles) { load_k(kt + 1); load_v(kt + 1); }
    const int k0 = kt * 64;
    const char* sVc = sV + (kt & 1) * 16384;
    if (k0 <= qrow + 31) {
      f32x16 p0, p1;
#pragma unroll
      for (int r = 0; r < 16; ++r) { p0[r] = 0.f; p1[r] = 0.f; }
#pragma unroll
      for (int ks = 0; ks < NKS; ++ks) {
        const bf16x8 a0 = *(const bf16x8*)(ka0 + ks * 32), a1 = *(const bf16x8*)(ka1 + ks * 32);
        p0 = __builtin_amdgcn_mfma_f32_32x32x16_bf16(a0, qf[ks], p0, 0, 0, 0);
        p1 = __builtin_amdgcn_mfma_f32_32x32x16_bf16(a1, qf[ks], p1, 0, 0, 0);
      }
      if (TYPE) {
#pragma unroll
        for (int s = 0; s < 2; ++s) {
          const float4 f0 = *(const float4*)(sF + 16 * s + 8 * hi), f1 = *(const float4*)(sF + 16 * s + 8 * hi + 4);
          const float4 g0 = *(const float4*)(sF + 32 + 16 * s + 8 * hi), g1 = *(const float4*)(sF + 32 + 16 * s + 8 * hi + 4);
          p0[8 * s + 0] = p0[8 * s + 0] * C2 - f0.x; p0[8 * s + 1] = p0[8 * s + 1] * C2 - f0.y; p0[8 * s + 2] = p0[8 * s + 2] * C2 - f0.z; p0[8 * s + 3] = p0[8 * s + 3] * C2 - f0.w;
          p0[8 * s + 4] = p0[8 * s + 4] * C2 - f1.x; p0[8 * s + 5] = p0[8 * s + 5] * C2 - f1.y; p0[8 * s + 6] = p0[8 * s + 6] * C2 - f1.z; p0[8 * s + 7] = p0[8 * s + 7] * C2 - f1.w;
          p1[8 * s + 0] = p1[8 * s + 0] * C2 - g0.x; p1[8 * s + 1] = p1[8 * s + 1] * C2 - g0.y; p1[8 * s + 2] = p1[8 * s + 2] * C2 - g0.z; p1[8 * s + 3] = p1[8 * s + 3] * C2 - g0.w;
          p1[8 * s + 4] = p1[8 * s + 4] * C2 - g1.x; p1[8 * s + 5] = p1[8 * s + 5] * C2 - g1.y; p1[8 * s + 6] = p1[8 * s + 6] * C2 - g1.z; p1[8 * s + 7] = p1[8 * s + 7] * C2 - g1.w;
        }
      } else {
#pragma unroll
        for (int r = 0; r < 16; ++r) { p0[r] *= C2; p1[r] *= C2; }
      }
      if (k0 + 63 > qrow) {
        const int lim = qrow + c - k0 - 8 * hi;
        const float NEG = -__builtin_inff();
#pragma unroll
        for (int r = 0; r < 16; ++r) {
          const int kb = 16 * (r >> 3) + (r & 7);
          if (kb > lim) p0[r] = NEG;
          if (kb + 32 > lim) p1[r] = NEG;
        }
      }
      float mx = p0[0];
#pragma unroll
      for (int r = 1; r < 16; ++r) mx = fmaxf(mx, p0[r]);
#pragma unroll
      for (int r = 0; r < 16; ++r) mx = fmaxf(mx, p1[r]);
      {
        auto rr = __builtin_amdgcn_permlane32_swap(__float_as_uint(mx), __float_as_uint(mx), false, false);
        mx = fmaxf(__uint_as_float(rr[0]), __uint_as_float(rr[1]));
      }
      const float mn = fmaxf(m, mx);
      const float alpha = __builtin_amdgcn_exp2f(m - mn);
      m = mn;
      if (!__all(alpha == 1.f)) {
#pragma unroll
        for (int db = 0; db < 4; ++db)
#pragma unroll
          for (int r = 0; r < 16; ++r) o[db][r] *= alpha;
      }
      float ps = 0.f;
#pragma unroll
      for (int r = 0; r < 16; ++r) { p0[r] = __builtin_amdgcn_exp2f(p0[r] - mn); p1[r] = __builtin_amdgcn_exp2f(p1[r] - mn); ps += p0[r] + p1[r]; }
      l = l * alpha + ps;
      bf16x8 pa[2][2];
#pragma unroll
      for (int s = 0; s < 2; ++s) {
        u32x4 w0 = {pk2(p0[8 * s + 0], p0[8 * s + 1]), pk2(p0[8 * s + 2], p0[8 * s + 3]), pk2(p0[8 * s + 4], p0[8 * s + 5]), pk2(p0[8 * s + 6], p0[8 * s + 7])};
        u32x4 w1 = {pk2(p1[8 * s + 0], p1[8 * s + 1]), pk2(p1[8 * s + 2], p1[8 * s + 3]), pk2(p1[8 * s + 4], p1[8 * s + 5]), pk2(p1[8 * s + 6], p1[8 * s + 7])};
        pa[0][s] = *reinterpret_cast<bf16x8*>(&w0); pa[1][s] = *reinterpret_cast<bf16x8*>(&w1);
      }
#pragma unroll
      for (int db = 0; db < 4; ++db)
#pragma unroll
        for (int kb = 0; kb < 2; ++kb)
#pragma unroll
          for (int s = 0; s < 2; ++s) {
            const bf16x8 av = *(const bf16x8*)(sVc + db * 32 * VSTR + vo[kb][s]);
            o[db] = __builtin_amdgcn_mfma_f32_32x32x16_bf16(av, pa[kb][s], o[db], 0, 0, 0);
          }
    }
  }
  {
    auto rr = __builtin_amdgcn_permlane32_swap(__float_as_uint(l), __float_as_uint(l), false, false);
    const float inv = 1.f / (__uint_as_float(rr[0]) + __uint_as_float(rr[1]));
    const int b = bh >> 3, hh = bh & 7;
    u16* od = p.omix() + ((size_t)(b * S_ + qrow + c)) * 2048 + TYPE * 1024 + hh * 128 + 4 * hi;
#pragma unroll
    for (int db = 0; db < 4; ++db)
#pragma unroll
      for (int g = 0; g < 4; ++g)
        *(u32x2*)(od + 32 * db + 8 * g) = u32x2{pk2(o[db][4 * g] * inv, o[db][4 * g + 1] * inv), pk2(o[db][4 * g + 2] * inv, o[db][4 * g + 3] * inv)};
  }
}

__device__ void phase_attn(const Params& p, char* smem, int bid, int nb) {
  int* sItem = (int*)(smem + 60000);
  for (;;) {
    __syncthreads();
    if (threadIdx.x == 0) *sItem = (int)atomicAdd(p.ctr(), 1u);
    __syncthreads();
    const int item = *sItem;
    if (item >= 1024) break;
    const int qb = 31 - (item >> 5), r = item & 31, type = r >> 4, bh = r & 15;
    if (type == 0) attn_item<0>(p, smem, bh, qb); else attn_item<1>(p, smem, bh, qb);
  }
}

__device__ void phase_outproj(const Params& p, char* smem, int bid, int nb) {
  const int ntiles = 64 * 16;
  for (int t = bid; t < ntiles; t += nb) {
    const int tm = t / 16, tn = t % 16;
    gemm128(p.omix(), D_, p.WoutT(), D_, D_, tm * 128, tn * 128, smem,
      [&](f32x4 (&acc)[4][4], int row0, int col0, int fr, int fq) {
#pragma unroll
        for (int m = 0; m < 4; ++m)
#pragma unroll
          for (int n = 0; n < 4; ++n)
#pragma unroll
            for (int j = 0; j < 4; ++j) {
              const size_t idx = (size_t)(row0 + m * 16 + fq * 4 + j) * D_ + col0 + n * 16 + fr;
              p.y1()[idx] = ALPHA * p.x[idx] + acc[m][n][j];
            }
      });
  }
}

__device__ void phase_ln1(const Params& p, int bid, int nb) {
  const int lane = threadIdx.x & 63, wid = threadIdx.x >> 6;
  for (int t = bid * 4 + wid; t < T_; t += nb * 4) {
    float* row = p.y1() + (size_t)t * D_;
    float4 v[8];
    float sum = 0.f;
#pragma unroll
    for (int i = 0; i < 8; ++i) { v[i] = *(const float4*)(row + (i * 64 + lane) * 4); sum += (v[i].x + v[i].y) + (v[i].z + v[i].w); }
    const float mu = wave_sum(sum) * (1.f / D_);
    float sq = 0.f;
#pragma unroll
    for (int i = 0; i < 8; ++i) {
      v[i].x -= mu; v[i].y -= mu; v[i].z -= mu; v[i].w -= mu;
      sq += (v[i].x * v[i].x + v[i].y * v[i].y) + (v[i].z * v[i].z + v[i].w * v[i].w);
    }
    const float rstd = rsqrtf(wave_sum(sq) * (1.f / D_) + EPS);
#pragma unroll
    for (int i = 0; i < 8; ++i) {
      const int c = (i * 64 + lane) * 4;
      const float4 g = *(const float4*)(p.ln1_g + c), bb = *(const float4*)(p.ln1_b + c);
      float4 o; o.x = v[i].x * rstd * g.x + bb.x; o.y = v[i].y * rstd * g.y + bb.y; o.z = v[i].z * rstd * g.z + bb.z; o.w = v[i].w * rstd * g.w + bb.w;
      *(float4*)(row + c) = o;
      *(u32x2*)(p.h1b() + (size_t)t * D_ + c) = u32x2{pk2(o.x, o.y), pk2(o.z, o.w)};
    }
  }
}

__device__ void phase_mid(const Params& p, char* smem, int bid, int nb) {
  const int ng = 64 * 16, nq = 64 * 8;
  for (int t = bid; t < ng + nq; t += nb) {
    if (t < ng) {
      const int tm = t / 16, tn = t % 16;
      f32x4 pacc[4][4], acc[4][4];
      gemm_core(p.pb(), 256, p.WpT(), 256, 256, tm * 128, tn * 128, smem, pacc);
      gemm_core(p.h1b(), D_, p.WgT(), D_, D_, tm * 128, tn * 128, smem, acc);
      {
        const int tid = threadIdx.x, wid = tid >> 6, lane = tid & 63, wr = wid >> 1, wc = wid & 1, fr = lane & 15, fq = lane >> 4;
        const size_t base = (size_t)(tm * 128 + wr * 64 + fq * 4) * D_ + tn * 128 + wc * 64 + fr;
        const float* yb = p.y1() + base;
        float* ob = p.out + base;
#pragma unroll
        for (int m = 0; m < 4; ++m) {
#pragma unroll
          for (int n = 0; n < 4; ++n)
#pragma unroll
            for (int j = 0; j < 4; ++j) {
              const int o = (m * 16 + j) * D_ + n * 16;
              const float sg = 1.f / (1.f + __expf(-acc[m][n][j]));
              ob[o] = ALPHA * yb[o] + pacc[m][n][j] * sg;
            }
        }
      }
    } else {
      const int tt = t - ng, tm = tt / 8, tn = tt % 8;
      gemm128(p.h1b(), D_, p.WpqT(), D_, D_, tm * 128, tn * 128, smem,
        [&](f32x4 (&acc)[4][4], int row0, int col0, int fr, int fq) {
#pragma unroll
          for (int m = 0; m < 4; ++m)
#pragma unroll
            for (int n = 0; n < 4; ++n)
#pragma unroll
              for (int j = 0; j < 4; ++j)
                p.pq()[(size_t)(row0 + m * 16 + fq * 4 + j) * 1024 + col0 + n * 16 + fr] = acc[m][n][j];
        });
    }
  }
}

template <int NPER, int IDXMASK>
__device__ __forceinline__ int top16(unsigned (&k)[NPER], int lane) {
  int mine = 0;
#pragma unroll 1
  for (int r = 0; r < 16; ++r) {
    unsigned loc = k[0];
#pragma unroll
    for (int i = 1; i < NPER; ++i) loc = loc > k[i] ? loc : k[i];
    const unsigned best = wave_umax(loc);
#pragma unroll
    for (int i = 0; i < NPER; ++i) if (k[i] == best) k[i] = 0u;
    if (lane == r) mine = IDXMASK - (int)(best & (unsigned)IDXMASK);
  }
  return mine;
}

__device__ void phase_peer(const Params& p, char* smem, int bid, int nb) {
  const int tid = threadIdx.x, lane = tid & 63, wid = tid >> 6;
  float* qs = (float*)smem;
  float* sc = (float*)(smem + 8192);
  int* eidx = (int*)(smem + 24576);
  float* gts = (float*)(smem + 32768);
  for (int it = bid; it < T_ / 16; it += nb) {
    const int t0 = it * 16;
    for (int h = 0; h < 8; ++h) {
#pragma unroll
      for (int i = 0; i < 8; ++i) {
        const int idx = tid + 256 * i, tok = idx >> 7, d = idx & 127;
        qs[idx] = p.pq()[(size_t)(t0 + tok) * 1024 + h * 128 + d];
      }
      const int half = tid >> 7, n = tid & 127;
      const float* kp = (half ? p.keys2 : p.keys1) + ((size_t)(h * 128 + n)) * 64;
      float4 kv[16];
#pragma unroll
      for (int i = 0; i < 16; ++i) kv[i] = *(const float4*)(kp + i * 4);
      __syncthreads();
      for (int tok = 0; tok < 16; ++tok) {
        const float* q = qs + tok * 128 + half * 64;
        float d = 0.f;
#pragma unroll
        for (int i = 0; i < 16; ++i) {
          const float4 qv = *(const float4*)(q + i * 4);
          d += kv[i].x * qv.x; d += kv[i].y * qv.y; d += kv[i].z * qv.z; d += kv[i].w * qv.w;
        }
        sc[tok * 256 + tid] = d;
      }
      __syncthreads();
      for (int ti = 0; ti < 4; ++ti) {
        const int tok = wid * 4 + ti;
        const float* s = sc + tok * 256;
        unsigned k1[2], k2[2];
        k1[0] = (ordkey(s[lane]) & ~127u) | (unsigned)(127 - lane);
        k1[1] = (ordkey(s[64 + lane]) & ~127u) | (unsigned)(127 - (64 + lane));
        k2[0] = (ordkey(s[128 + lane]) & ~127u) | (unsigned)(127 - lane);
        k2[1] = (ordkey(s[192 + lane]) & ~127u) | (unsigned)(127 - (64 + lane));
        const int i1 = top16<2, 127>(k1, lane);
        const int i2 = top16<2, 127>(k2, lane);
        const float v1 = s[i1 & 127], v2 = s[128 + (i2 & 127)];
        unsigned kc[4];
        const float v2b = __shfl(v2, lane & 15, 64);
#pragma unroll
        for (int m = 0; m < 4; ++m) {
          const float v1a = __shfl(v1, (lane >> 4) + 4 * m, 64);
          const int c = lane + 64 * m;
          kc[m] = (ordkey(v1a + v2b) & ~255u) | (unsigned)(255 - c);
        }
        const int cw = top16<4, 255>(kc, lane) & 255;
        const int a = cw >> 4, b = cw & 15;
        const int i1a = __shfl(i1, a, 64), i2b = __shfl(i2, b, 64);
        const float val = __shfl(v1, a, 64) + __shfl(v2, b, 64);
        const float mx = rdlane(row_max(lane < 16 ? val : -3e38f), 0);
        const float ex = lane < 16 ? __expf(val - mx) : 0.f;
        const float sm = rdlane(row_sum(ex), 0);
        if (lane < 16) {
          eidx[tok * 128 + h * 16 + lane] = i1a * 128 + i2b;
          gts[tok * 128 + h * 16 + lane] = ex / sm;
        }
      }
      __syncthreads();
    }
    for (int ti = 0; ti < 4; ++ti) {
      const int tok = wid * 4 + ti, t = t0 + tok;
      float hreg[32], o[32];
#pragma unroll
      for (int c = 0; c < 4; ++c) {
        const u32x4 hv = *(const u32x4*)(p.h1b() + (size_t)t * D_ + (c * 64 + lane) * 8);
#pragma unroll
        for (int w = 0; w < 4; ++w) { hreg[c * 8 + 2 * w] = bflo(hv[w]); hreg[c * 8 + 2 * w + 1] = bfhi(hv[w]); }
      }
#pragma unroll
      for (int i = 0; i < 32; ++i) o[i] = 0.f;
#pragma unroll 1
      for (int j0 = 0; j0 < 128; j0 += 2) {
        u32x4 ur[2][4], vr[2][4];
        float g[2];
#pragma unroll
        for (int jj = 0; jj < 2; ++jj) {
          const int e = __builtin_amdgcn_readfirstlane(eidx[tok * 128 + j0 + jj]);
          g[jj] = gts[tok * 128 + j0 + jj];
          const u16* up = p.Ub() + (size_t)e * D_ + lane * 8;
          const u16* vp = p.Vb() + (size_t)e * D_ + lane * 8;
#pragma unroll
          for (int c = 0; c < 4; ++c) { ur[jj][c] = *(const u32x4*)(up + c * 512); vr[jj][c] = *(const u32x4*)(vp + c * 512); }
        }
#pragma unroll
        for (int jj = 0; jj < 2; ++jj) {
          float d = 0.f;
#pragma unroll
          for (int c = 0; c < 4; ++c)
#pragma unroll
            for (int w = 0; w < 4; ++w) {
              d += bflo(ur[jj][c][w]) * hreg[c * 8 + 2 * w];
              d += bfhi(ur[jj][c][w]) * hreg[c * 8 + 2 * w + 1];
            }
          const float av = wave_sum(d);
          const float act = 0.5f * av * (1.f + erff(av * 0.7071067811865476f)) * g[jj];
#pragma unroll
          for (int c = 0; c < 4; ++c)
#pragma unroll
            for (int w = 0; w < 4; ++w) {
              o[c * 8 + 2 * w] += act * bflo(vr[jj][c][w]);
              o[c * 8 + 2 * w + 1] += act * bfhi(vr[jj][c][w]);
            }
        }
      }
      float* orow = p.out + (size_t)t * D_;
      float sum = 0.f;
#pragma unroll
      for (int c = 0; c < 4; ++c) {
        const float4 r0 = *(const float4*)(orow + (c * 64 + lane) * 8), r1 = *(const float4*)(orow + (c * 64 + lane) * 8 + 4);
        o[c * 8 + 0] += r0.x; o[c * 8 + 1] += r0.y; o[c * 8 + 2] += r0.z; o[c * 8 + 3] += r0.w;
        o[c * 8 + 4] += r1.x; o[c * 8 + 5] += r1.y; o[c * 8 + 6] += r1.z; o[c * 8 + 7] += r1.w;
      }
#pragma unroll
      for (int i = 0; i < 32; ++i) sum += o[i];
      const float mu = wave_sum(sum) * (1.f / D_);
      float sq = 0.f;
#pragma unroll
      for (int i = 0; i < 32; ++i) { o[i] -= mu; sq += o[i] * o[i]; }
      const float rstd = rsqrtf(wave_sum(sq) * (1.f / D_) + EPS);
#pragma unroll
      for (int c = 0; c < 4; ++c) {
        const int col = (c * 64 + lane) * 8;
        const float4 g0 = *(const float4*)(p.ln2_g + col), g1 = *(const float4*)(p.ln2_g + col + 4);
        const float4 b0 = *(const float4*)(p.ln2_b + col), b1 = *(const float4*)(p.ln2_b + col + 4);
        float4 w0, w1;
        w0.x = o[c * 8 + 0] * rstd * g0.x + b0.x; w0.y = o[c * 8 + 1] * rstd * g0.y + b0.y;
        w0.z = o[c * 8 + 2] * rstd * g0.z + b0.z; w0.w = o[c * 8 + 3] * rstd * g0.w + b0.w;
        w1.x = o[c * 8 + 4] * rstd * g1.x + b1.x; w1.y = o[c * 8 + 5] * rstd * g1.y + b1.y;
        w1.z = o[c * 8 + 6] * rstd * g1.z + b1.z; w1.w = o[c * 8 + 7] * rstd * g1.w + b1.w;
        *(float4*)(orow + col) = w0; *(float4*)(orow + col + 4) = w1;
      }
    }
    __syncthreads();
  }
}

template <int PH>
__device__ __forceinline__ void run_phase(const Params& p, char* smem, int bid, int nb) {
  if constexpr (PH == 0) phase_prep(p, smem, bid, nb);
  if constexpr (PH == 1) phase_inproj(p, smem, bid, nb);
  if constexpr (PH == 2) phase_up(p, smem, bid, nb);
#ifdef ATTN_NAIVE
  if constexpr (PH == 3) phase_attn_naive(p, smem, bid, nb);
#else
  if constexpr (PH == 3) phase_attn(p, smem, bid, nb);
#endif
  if constexpr (PH == 4) phase_outproj(p, smem, bid, nb);
  if constexpr (PH == 5) phase_ln1(p, bid, nb);
  if constexpr (PH == 6) phase_mid(p, smem, bid, nb);
  if constexpr (PH == 7) phase_peer(p, smem, bid, nb);
}

template <int PH>
__global__ void __launch_bounds__(256, 2) phase_kernel(Params p) {
  __shared__ __attribute__((aligned(16))) char smem[SMEM_BYTES];
  run_phase<PH>(p, smem, blockIdx.x, gridDim.x);
}

#if SINGLE_LAUNCH
typedef const __attribute__((address_space(4))) unsigned long long* kargp_t;
static_assert(sizeof(Params) % 8 == 0, "Params must be a pack of 8-byte fields");
#define RUN_PHASE(N)                                                                        \
  {                                                                                         \
    kargp_t q = (kargp_t)__builtin_amdgcn_kernarg_segment_ptr();                            \
    asm volatile("" : "+s"(q));                                                             \
    Params lp;                                                                              \
    unsigned long long* d = (unsigned long long*)&lp;                                       \
    _Pragma("unroll") for (int i = 0; i < (int)(sizeof(Params) / 8); ++i) d[i] = q[i];      \
    run_phase<N>(lp, smem, bid, nb);                                                        \
  }
__global__ void __launch_bounds__(256, 2) fwd_kernel(Params p_) {
  __shared__ __attribute__((aligned(16))) char smem[SMEM_BYTES];
  const int bid = blockIdx.x, nb = gridDim.x;
  cg::grid_group grid = cg::this_grid();
  RUN_PHASE(0) grid.sync();
  RUN_PHASE(1) grid.sync();
  RUN_PHASE(2) grid.sync();
  RUN_PHASE(3) grid.sync();
  RUN_PHASE(4) grid.sync();
  RUN_PHASE(5) grid.sync();
  RUN_PHASE(6) grid.sync();
  RUN_PHASE(7)
}
#endif

extern "C" void kernel_launch(void* const* d_in, const int* in_sizes, int n_in, void* d_out, int out_size,
                              void* d_ws, size_t ws_size, hipStream_t stream) {
  (void)in_sizes; (void)n_in; (void)out_size; (void)ws_size;
  Params p{};
  p.x = (const float*)d_in[0]; p.p = (const float*)d_in[1]; p.positions = (const int*)d_in[2];
  p.w_in = (const float*)d_in[3]; p.b_forget = (const float*)d_in[4]; p.g_q = (const float*)d_in[5];
  p.w_uq = (const float*)d_in[6]; p.g_kv = (const float*)d_in[7]; p.w_ukv = (const float*)d_in[8];
  p.w_out = (const float*)d_in[9]; p.ln1_g = (const float*)d_in[10]; p.ln1_b = (const float*)d_in[11];
  p.peer_wq = (const float*)d_in[12]; p.keys1 = (const float*)d_in[13]; p.keys2 = (const float*)d_in[14];
  p.peer_u = (const float*)d_in[15]; p.peer_v = (const float*)d_in[16]; p.wgate = (const float*)d_in[17];
  p.wproj = (const float*)d_in[18]; p.ln2_g = (const float*)d_in[19]; p.ln2_b = (const float*)d_in[20];
  p.out = (float*)d_out;
  p.ws = (char*)d_ws;

  static int grid_blocks = 0;
  if (!grid_blocks) {
    int dev = 0, cus = 0, per_cu = 0;
    (void)hipGetDevice(&dev);
    (void)hipDeviceGetAttribute(&cus, hipDeviceAttributeMultiprocessorCount, dev);
#if SINGLE_LAUNCH
    (void)hipOccupancyMaxActiveBlocksPerMultiprocessor(&per_cu, fwd_kernel, 256, 0);
#else
    per_cu = 2;
#endif
    if (per_cu > 2) per_cu = 2;
    if (per_cu < 1) per_cu = 1;
    grid_blocks = cus * per_cu;
  }
#if SINGLE_LAUNCH
  void* args[] = {&p};
  hipError_t e = hipLaunchCooperativeKernel((void*)fwd_kernel, dim3(grid_blocks), dim3(256), args, 0, stream);
  if (e != hipSuccess) fprintf(stderr, "cooperative launch failed: %s (grid %d)\n", hipGetErrorString(e), grid_blocks);
#else
  phase_kernel<0><<<grid_blocks, 256, 0, stream>>>(p);
  phase_kernel<1><<<grid_blocks, 256, 0, stream>>>(p);
  phase_kernel<2><<<grid_blocks, 256, 0, stream>>>(p);
  phase_kernel<3><<<grid_blocks, 256, 0, stream>>>(p);
  phase_kernel<4><<<grid_blocks, 256, 0, stream>>>(p);
  phase_kernel<5><<<grid_blocks, 256, 0, stream>>>(p);
  phase_kernel<6><<<grid_blocks, 256, 0, stream>>>(p);
  phase_kernel<7><<<grid_blocks, 256, 0, stream>>>(p);
#endif
}
```

```cpp
#include <hip/hip_runtime.h>
#include <hip/hip_bf16.h>
#include <hip/hip_cooperative_groups.h>
#include <stdint.h>
#include <cstdio>
namespace cg = cooperative_groups;

typedef unsigned short u16;
typedef short bf16x8 __attribute__((ext_vector_type(8)));
typedef float f32x4 __attribute__((ext_vector_type(4)));
typedef unsigned u32x4 __attribute__((ext_vector_type(4)));
typedef unsigned u32x2 __attribute__((ext_vector_type(2)));

#ifndef SINGLE_LAUNCH
#define SINGLE_LAUNCH 1
#endif

constexpr int T_ = 8192, D_ = 2048, S_ = 4096, NB_ = 2;
constexpr int INW = 4168;
constexpr int NPH = 8;
constexpr float ALPHA = 1.189207115002721f;
constexpr float EPS = 1e-6f;
constexpr int SMEM_BYTES = 65536;

constexpr size_t al256(size_t x) { return (x + 255) & ~(size_t)255; }
constexpr size_t O_CTR = 0;
constexpr size_t O_WINT = O_CTR + 256;
constexpr size_t O_WUQT = O_WINT + al256((size_t)4224 * 2048 * 2);
constexpr size_t O_WUKVT = O_WUQT + al256((size_t)1536 * 512 * 2);
constexpr size_t O_WOUTT = O_WUKVT + al256((size_t)2048 * 512 * 2);
constexpr size_t O_WPQT = O_WOUTT + al256((size_t)2048 * 2048 * 2);
constexpr size_t O_WGT = O_WPQT + al256((size_t)1024 * 2048 * 2);
constexpr size_t O_WPT = O_WGT + al256((size_t)2048 * 2048 * 2);
constexpr size_t O_PB = O_WPT + al256((size_t)2048 * 256 * 2);
constexpr size_t O_UB = O_PB + al256((size_t)8192 * 256 * 2);
constexpr size_t O_VB = O_UB + al256((size_t)16384 * 2048);
constexpr size_t O_OMIX = O_VB + al256((size_t)16384 * 2048);
constexpr size_t O_CS = O_OMIX + al256((size_t)8192 * 2048 * 2);
constexpr size_t O_US = O_CS + al256((size_t)8192 * 32 * 8);
constexpr size_t O_VS = O_US + al256((size_t)16384 * 4);
constexpr size_t O_REGB = O_VS + al256((size_t)16384 * 4);
constexpr size_t O_XB = O_REGB;
constexpr size_t O_CQB = O_XB + al256((size_t)8192 * 2048 * 2);
constexpr size_t O_CKVB = O_CQB + al256((size_t)8192 * 512 * 2);
constexpr size_t O_QM = O_CKVB + al256((size_t)8192 * 512 * 2);
constexpr size_t O_KM = O_QM + al256((size_t)8192 * 8 * 192 * 2);
constexpr size_t O_VMT = O_KM + al256((size_t)8192 * 8 * 192 * 2);
constexpr size_t O_QF = O_VMT + al256((size_t)8192 * 8 * 128 * 2);
constexpr size_t O_KF = O_QF + al256((size_t)8192 * 8 * 128 * 2);
constexpr size_t O_VFT = O_KF + al256((size_t)8192 * 8 * 128 * 2);
constexpr size_t O_LOGF = O_VFT + al256((size_t)8192 * 8 * 128 * 2);
constexpr size_t O_FK = O_LOGF + al256((size_t)16 * 4096 * 4);
constexpr size_t O_ENDB = O_FK + al256((size_t)16 * 4096 * 4);
constexpr size_t O_Y1 = O_REGB;
constexpr size_t O_H1B = O_Y1 + al256((size_t)8192 * 2048 * 4);
constexpr size_t O_PQ = O_H1B + al256((size_t)8192 * 2048 * 2);
constexpr size_t O_ENDB2 = O_PQ + al256((size_t)8192 * 1024 * 4);
static_assert(O_ENDB2 <= O_ENDB, "region B reuse overflow");
static_assert(O_ENDB <= (size_t)500 * 1024 * 1024, "workspace too large");

struct Params {
  const float *x, *p; const int* positions;
  const float *w_in, *b_forget, *g_q, *w_uq, *g_kv, *w_ukv, *w_out, *ln1_g, *ln1_b;
  const float *peer_wq, *keys1, *keys2, *peer_u, *peer_v, *wgate, *wproj, *ln2_g, *ln2_b;
  float* out;
  char* ws;
#define WSP(type, name, off) __device__ __forceinline__ type* name() const { return (type*)(ws + (off)); }
  WSP(unsigned, ctr, O_CTR) WSP(u16, WinT, O_WINT) WSP(u16, WuqT, O_WUQT) WSP(u16, WukvT, O_WUKVT) WSP(u16, WoutT, O_WOUTT)
  WSP(u16, WpqT, O_WPQT) WSP(u16, WgT, O_WGT) WSP(u16, WpT, O_WPT) WSP(u16, pb, O_PB) WSP(unsigned char, Uq, O_UB) WSP(unsigned char, Vq, O_VB) WSP(float, Us, O_US) WSP(float, Vs, O_VS)
  WSP(u16, omix, O_OMIX) WSP(float2, cs, O_CS)
  WSP(u16, xb, O_XB) WSP(u16, cqb, O_CQB) WSP(u16, ckvb, O_CKVB) WSP(u16, Qm, O_QM) WSP(u16, Km, O_KM) WSP(u16, VmT, O_VMT)
  WSP(u16, Qf, O_QF) WSP(u16, Kf, O_KF) WSP(u16, VfT, O_VFT) WSP(float, logf, O_LOGF) WSP(float, Fk, O_FK)
  WSP(float, y1, O_Y1) WSP(u16, h1b, O_H1B) WSP(float, pq, O_PQ)
#undef WSP
};

__device__ __forceinline__ int TID() { int t = threadIdx.x; asm volatile("" : "+v"(t)); return t; }
__device__ __forceinline__ unsigned pk2(float lo, float hi) {
  unsigned r; asm volatile("v_cvt_pk_bf16_f32 %0, %1, %2" : "=v"(r) : "v"(lo), "v"(hi)); return r;
}
__device__ __forceinline__ u16 f2bf(float f) { return (u16)(pk2(f, 0.f) & 0xffffu); }
__device__ __forceinline__ float bf2f(u16 v) { return __uint_as_float(((unsigned)v) << 16); }
__device__ __forceinline__ float bflo(unsigned v) { return __uint_as_float(v << 16); }
__device__ __forceinline__ float bfhi(unsigned v) { return __uint_as_float(v & 0xffff0000u); }

template <int CTRL> __device__ __forceinline__ int dppi(int v) { return __builtin_amdgcn_update_dpp(0, v, CTRL, 0xF, 0xF, false); }
template <int CTRL> __device__ __forceinline__ float dppf(float v) { return __int_as_float(dppi<CTRL>(__float_as_int(v))); }
__device__ __forceinline__ float rdlane(float v, int l) { return __int_as_float(__builtin_amdgcn_readlane(__float_as_int(v), l)); }

__device__ __forceinline__ float row_sum(float v) {
  v += dppf<0xB1>(v); v += dppf<0x4E>(v); v += dppf<0x141>(v); v += dppf<0x140>(v); return v;
}
__device__ __forceinline__ float row_max(float v) {
  v = fmaxf(v, dppf<0xB1>(v)); v = fmaxf(v, dppf<0x4E>(v)); v = fmaxf(v, dppf<0x141>(v)); v = fmaxf(v, dppf<0x140>(v)); return v;
}
__device__ __forceinline__ float wave_sum(float v) {
  v = row_sum(v);
  return (rdlane(v, 0) + rdlane(v, 16)) + (rdlane(v, 32) + rdlane(v, 48));
}
__device__ __forceinline__ float wave_max(float v) {
  v = row_max(v);
  return fmaxf(fmaxf(rdlane(v, 0), rdlane(v, 16)), fmaxf(rdlane(v, 32), rdlane(v, 48)));
}
__device__ __forceinline__ unsigned wave_umax(unsigned v) {
  unsigned t;
  t = (unsigned)dppi<0xB1>((int)v); v = v > t ? v : t;
  t = (unsigned)dppi<0x4E>((int)v); v = v > t ? v : t;
  t = (unsigned)dppi<0x141>((int)v); v = v > t ? v : t;
  t = (unsigned)dppi<0x140>((int)v); v = v > t ? v : t;
  unsigned a = (unsigned)__builtin_amdgcn_readlane((int)v, 0), b = (unsigned)__builtin_amdgcn_readlane((int)v, 16);
  unsigned c = (unsigned)__builtin_amdgcn_readlane((int)v, 32), d = (unsigned)__builtin_amdgcn_readlane((int)v, 48);
  a = a > b ? a : b; c = c > d ? c : d; return a > c ? a : c;
}
__device__ __forceinline__ unsigned ordkey(float f) {
  unsigned u = __float_as_uint(f);
  return (u & 0x80000000u) ? ~u : (u | 0x80000000u);
}

__device__ void transpose_cvt(const float* __restrict__ W, int ldw, int K, int src_col0, int ncols,
                              u16* __restrict__ WT, int dst_row0, const float* __restrict__ kscale,
                              float* tile, int bid, int nb) {
  const int tiles_k = K / 64, tiles_n = ncols / 64, tid = TID();
#pragma unroll 1
  for (int t = bid; t < tiles_k * tiles_n; t += nb) {
    const int tk = t % tiles_k, tn = t / tiles_k, k0 = tk * 64, n0 = tn * 64;
#pragma unroll
    for (int i = 0; i < 4; ++i) {
      const int r = (tid >> 4) + 16 * i, c = (tid & 15) * 4;
      const float4 v = *(const float4*)(W + (size_t)(k0 + r) * ldw + src_col0 + n0 + c);
      const float sc = kscale ? kscale[k0 + r] : 1.f;
      tile[r * 65 + c + 0] = v.x * sc; tile[r * 65 + c + 1] = v.y * sc;
      tile[r * 65 + c + 2] = v.z * sc; tile[r * 65 + c + 3] = v.w * sc;
    }
    __syncthreads();
    {
      const int n = tid >> 2, kk = (tid & 3) * 16;
      unsigned w[8];
#pragma unroll
      for (int e = 0; e < 8; ++e) w[e] = pk2(tile[(kk + 2 * e) * 65 + n], tile[(kk + 2 * e + 1) * 65 + n]);
      u32x4* dst = (u32x4*)(WT + (size_t)(dst_row0 + n0 + n) * K + k0 + kk);
      dst[0] = u32x4{w[0], w[1], w[2], w[3]};
      dst[1] = u32x4{w[4], w[5], w[6], w[7]};
    }
    __syncthreads();
  }
}

__device__ void cvt_bf16(const float* __restrict__ src, u16* __restrict__ dst, size_t n8, size_t gtid, size_t gthreads) {
  for (size_t i = gtid; i < n8; i += gthreads) {
    const float4 a = ((const float4*)src)[2 * i], b = ((const float4*)src)[2 * i + 1];
    ((u32x4*)dst)[i] = u32x4{pk2(a.x, a.y), pk2(a.z, a.w), pk2(b.x, b.y), pk2(b.z, b.w)};
  }
}

__device__ void phase_prep(const Params& p, char* smem, int bid, int nb) {
  const int tid = TID(), lane = tid & 63, wid = tid >> 6;
  float* tile = (float*)smem;
  if (bid == 0 && tid == 0) p.ctr()[0] = 0;
  transpose_cvt(p.w_in, INW, D_, 0, 1024, p.WinT(), 0, nullptr, tile, bid, nb);
  transpose_cvt(p.w_in, INW, D_, 1088, 3072, p.WinT(), 1024, nullptr, tile, bid, nb);
  transpose_cvt(p.w_in, INW, D_, 1024, 64, p.WinT(), 4096, nullptr, tile, bid, nb);
  transpose_cvt(p.w_uq, 1536, 512, 0, 1536, p.WuqT(), 0, p.g_q, tile, bid, nb);
  transpose_cvt(p.w_ukv, 2048, 512, 0, 2048, p.WukvT(), 0, p.g_kv, tile, bid, nb);
  transpose_cvt(p.w_out, 2048, 2048, 0, 2048, p.WoutT(), 0, nullptr, tile, bid, nb);
  transpose_cvt(p.peer_wq, 1024, 2048, 0, 1024, p.WpqT(), 0, nullptr, tile, bid, nb);
  transpose_cvt(p.wgate, 2048, 2048, 0, 2048, p.WgT(), 0, nullptr, tile, bid, nb);
  transpose_cvt(p.wproj, 2048, 256, 0, 2048, p.WpT(), 0, nullptr, tile, bid, nb);
  const size_t gtid = (size_t)bid * 256 + tid, gth = (size_t)nb * 256;
  for (size_t i = gtid; i < (size_t)64 * 2048 / 8; i += gth) ((u32x4*)(p.WinT() + (size_t)4160 * 2048))[i] = u32x4{0, 0, 0, 0};
  cvt_bf16(p.x, p.xb(), (size_t)T_ * D_ / 8, gtid, gth);
  cvt_bf16(p.p, p.pb(), (size_t)T_ * 256 / 8, gtid, gth);
  for (int r = bid * 4 + wid; r < 2 * 16384; r += nb * 4) {
    const int tab = r >> 14, row = r & 16383;
    const float* src = (tab ? p.peer_v : p.peer_u) + (size_t)row * D_;
    unsigned* dst = (unsigned*)((tab ? p.Vq() : p.Uq()) + (size_t)row * D_);
    float4 v[8];
    float am = 0.f;
#pragma unroll
    for (int i = 0; i < 8; ++i) {
      v[i] = *(const float4*)(src + (i * 64 + lane) * 4);
      am = fmaxf(am, fmaxf(fmaxf(fabsf(v[i].x), fabsf(v[i].y)), fmaxf(fabsf(v[i].z), fabsf(v[i].w))));
    }
    am = wave_max(am);
    const float qs = am > 0.f ? 224.f / am : 1.f;
#pragma unroll
    for (int i = 0; i < 8; ++i) {
      unsigned w = __builtin_amdgcn_cvt_pk_fp8_f32(v[i].x * qs, v[i].y * qs, 0, false);
      w = __builtin_amdgcn_cvt_pk_fp8_f32(v[i].z * qs, v[i].w * qs, w, true);
      dst[i * 64 + lane] = w;
    }
    if (lane == 0) (tab ? p.Vs() : p.Us())[row] = am > 0.f ? am / 224.f : 1.f;
  }
  for (size_t i = gtid; i < (size_t)T_ * 32; i += gth) {
    const int t = (int)(i >> 5), fi = (int)(i & 31);
    const float invf = 1.0f / powf(10000.0f, (float)(2 * fi) / 64.0f);
    const float ang = (float)p.positions[t] * invf;
    const double rev = (double)ang * 0.15915494309189535;
    const float fr = (float)(rev - rint(rev));
    p.cs()[i] = make_float2(__builtin_amdgcn_cosf(fr), __builtin_amdgcn_sinf(fr));
  }
  __syncthreads();
  float* wff = (float*)smem;
  for (int i = tid; i < 2048 * 2; i += 256) {
    const int k = i >> 1, hf = i & 1;
    *(float4*)(wff + k * 8 + hf * 4) = *(const float4*)(p.w_in + (size_t)k * INW + 4160 + hf * 4);
  }
  __syncthreads();
  for (int t = bid * 4 + wid; t < T_; t += nb * 4) {
    float a[8];
#pragma unroll
    for (int e = 0; e < 8; ++e) a[e] = 0.f;
#pragma unroll 4
    for (int i = 0; i < 32; ++i) {
      const int k = i * 64 + lane;
      const float xv = p.x[(size_t)t * D_ + k];
      const float4 w0 = *(const float4*)(wff + k * 8), w1 = *(const float4*)(wff + k * 8 + 4);
      a[0] += xv * w0.x; a[1] += xv * w0.y; a[2] += xv * w0.z; a[3] += xv * w0.w;
      a[4] += xv * w1.x; a[5] += xv * w1.y; a[6] += xv * w1.z; a[7] += xv * w1.w;
    }
    float mine = 0.f;
#pragma unroll
    for (int e = 0; e < 8; ++e) { const float s = wave_sum(a[e]); if (lane == e) mine = s; }
    if (lane < 8) {
      const float z = mine + p.b_forget[lane];
      const float ls = fminf(z, 0.f) - log1pf(expf(-fabsf(z)));
      const int b = t >> 12, s = t & 4095;
      p.logf()[((size_t)(b * 8 + lane)) * S_ + s] = ls;
    }
  }
}

__device__ __forceinline__ void gemm_core(const u16* __restrict__ A, int lda, const u16* __restrict__ Bt, int ldb,
                                          int K, int brow, int bcol, char* smem, f32x4 (&acc)[4][4]) {
  u16* SA = (u16*)smem; u16* SB = (u16*)(smem + 8192);
  const int tid = TID(), wid = tid >> 6, lane = tid & 63, wr = wid >> 1, wc = wid & 1, fr = lane & 15, fq = lane >> 4;
#pragma unroll
  for (int m = 0; m < 4; ++m)
#pragma unroll
    for (int n = 0; n < 4; ++n) acc[m][n] = f32x4{0.f, 0.f, 0.f, 0.f};
  const int nk = K / 32;
  for (int kt = 0; kt < nk; ++kt) {
#pragma unroll
    for (int i = 0; i < 2; ++i) {
      const int b = tid * 16 + i * 4096, r = b / 64, c = (b % 64) / 2;
      __builtin_amdgcn_global_load_lds((const unsigned*)(A + (size_t)(brow + r) * lda + kt * 32 + c), (unsigned*)((char*)SA + b), 16, 0, 0);
      __builtin_amdgcn_global_load_lds((const unsigned*)(Bt + (size_t)(bcol + r) * ldb + kt * 32 + c), (unsigned*)((char*)SB + b), 16, 0, 0);
    }
    asm volatile("s_waitcnt vmcnt(0)" ::: "memory");
    __syncthreads();
    bf16x8 At[4], Bl[4];
#pragma unroll
    for (int m = 0; m < 4; ++m) At[m] = *reinterpret_cast<const bf16x8*>((char*)SA + (wr * 64 + m * 16 + fr) * 64 + fq * 16);
#pragma unroll
    for (int n = 0; n < 4; ++n) Bl[n] = *reinterpret_cast<const bf16x8*>((char*)SB + (wc * 64 + n * 16 + fr) * 64 + fq * 16);
#pragma unroll
    for (int m = 0; m < 4; ++m)
#pragma unroll
      for (int n = 0; n < 4; ++n) acc[m][n] = __builtin_amdgcn_mfma_f32_16x16x32_bf16(At[m], Bl[n], acc[m][n], 0, 0, 0);
    __syncthreads();
  }
}

template <class Epi>
__device__ __forceinline__ void gemm128(const u16* __restrict__ A, int lda, const u16* __restrict__ Bt, int ldb,
                                        int K, int brow, int bcol, char* smem, Epi epi) {
  const int tid = TID(), wid = tid >> 6, lane = tid & 63, wr = wid >> 1, wc = wid & 1, fr = lane & 15, fq = lane >> 4;
  f32x4 acc[4][4];
  gemm_core(A, lda, Bt, ldb, K, brow, bcol, smem, acc);
  epi(acc, brow + wr * 64, bcol + wc * 64, fr, fq);
}

__device__ void phase_inproj(const Params& p, char* smem, int bid, int nb) {
  const int ntn = 33, ntiles = 64 * ntn;
  for (int t = bid; t < ntiles; t += nb) {
    const int tm = t / ntn, tn = t % ntn;
    gemm128(p.xb(), D_, p.WinT(), D_, D_, tm * 128, tn * 128, smem,
      [&](f32x4 (&acc)[4][4], int row0, int col0, int fr, int fq) {
        if (col0 < 1024) {
          u16* dst = col0 < 512 ? p.cqb() : p.ckvb(); const int cb = col0 & 511;
#pragma unroll
          for (int m = 0; m < 4; ++m)
#pragma unroll
            for (int n = 0; n < 4; ++n)
#pragma unroll
              for (int j = 0; j < 4; ++j) {
                const int row = row0 + m * 16 + fq * 4 + j;
                dst[(size_t)row * 512 + cb + n * 16 + fr] = f2bf(acc[m][n][j]);
              }
        } else if (col0 < 3072) {
          int c = col0 - 1024; u16* dst = c < 1024 ? p.Qf() : p.Kf(); c &= 1023;
          const int hh = c >> 7, d0 = c & 127;
#pragma unroll
          for (int m = 0; m < 4; ++m)
#pragma unroll
            for (int n = 0; n < 4; ++n)
#pragma unroll
              for (int j = 0; j < 4; ++j) {
                const int row = row0 + m * 16 + fq * 4 + j, b = row >> 12, s = row & 4095;
                dst[((size_t)(b * 8 + hh) * S_ + s) * 128 + d0 + n * 16 + fr] = f2bf(acc[m][n][j]);
              }
        } else if (col0 < 4096) {
          const int c = col0 - 3072, hh = c >> 7, d0 = c & 127;
#pragma unroll
          for (int m = 0; m < 4; ++m)
#pragma unroll
            for (int n = 0; n < 4; ++n) {
              const int row = row0 + m * 16 + fq * 4, b = row >> 12, s = row & 4095, dv = d0 + n * 16 + fr;
              *(u32x2*)(p.VfT() + ((size_t)(b * 8 + hh) * 128 + dv) * S_ + s) =
                  u32x2{pk2(acc[m][n][0], acc[m][n][1]), pk2(acc[m][n][2], acc[m][n][3])};
            }
        } else if (col0 == 4096) {
#pragma unroll
          for (int m = 0; m < 4; ++m)
#pragma unroll
            for (int j = 0; j < 4; ++j) {
              const int row = row0 + m * 16 + fq * 4 + j, b = row >> 12, s = row & 4095;
#pragma unroll
              for (int n = 0; n < 2; ++n) {
                const int i = n * 16 + fr;
                const float2 cs = p.cs()[(size_t)row * 32 + i];
                const float x1 = acc[m][n][j], x2 = acc[m][n + 2][j];
                const u16 o1 = f2bf(x1 * cs.x - x2 * cs.y), o2 = f2bf(x1 * cs.y + x2 * cs.x);
                for (int hh = 0; hh < 8; ++hh) {
                  u16* kd = p.Km() + ((size_t)(b * 8 + hh) * S_ + s) * 192 + 128;
                  kd[i] = o1; kd[32 + i] = o2;
                }
              }
            }
        }
      });
  }
}

__device__ __forceinline__ void compute_rs(const u16* __restrict__ src, int brow, float* rsv) {
  const int tid = TID(), row = tid >> 1, hf = tid & 1;
  const u16* r = src + (size_t)(brow + row) * 512 + hf * 256;
  float ss = 0.f;
#pragma unroll 4
  for (int i = 0; i < 32; ++i) {
    const u32x4 v = *(const u32x4*)(r + i * 8);
#pragma unroll
    for (int w = 0; w < 4; ++w) { const float a = bflo(v[w]), b = bfhi(v[w]); ss += a * a + b * b; }
  }
  ss += dppf<0xB1>(ss);
  if (hf == 0) rsv[row] = rsqrtf(ss * (1.f / 512.f) + EPS);
}

__device__ void phase_up(const Params& p, char* smem, int bid, int nb) {
  float* rsv = (float*)(smem + 16384);
  const int nq = 64 * 12, nkv = 64 * 16, njobs = nq + nkv + 16;
  for (int t = bid; t < njobs; t += nb) {
    if (t < nq) {
      const int tm = t / 12, tn = t % 12;
      compute_rs(p.cqb(), tm * 128, rsv);
      gemm128(p.cqb(), 512, p.WuqT(), 512, 512, tm * 128, tn * 128, smem,
        [&](f32x4 (&acc)[4][4], int row0, int col0, int fr, int fq) {
          const int hh = col0 / 192, off = col0 % 192;
          const int lr0 = row0 & 127;
          if (off < 128) {
#pragma unroll
            for (int m = 0; m < 4; ++m)
#pragma unroll
              for (int j = 0; j < 4; ++j) {
                const int lr = lr0 + m * 16 + fq * 4 + j, row = (row0 - lr0) + lr, b = row >> 12, s = row & 4095;
                const float rs = rsv[lr];
                u16* qd = p.Qm() + ((size_t)(b * 8 + hh) * S_ + s) * 192 + off;
#pragma unroll
                for (int n = 0; n < 4; ++n) qd[n * 16 + fr] = f2bf(acc[m][n][j] * rs);
              }
          } else {
#pragma unroll
            for (int m = 0; m < 4; ++m)
#pragma unroll
              for (int j = 0; j < 4; ++j) {
                const int lr = lr0 + m * 16 + fq * 4 + j, row = (row0 - lr0) + lr, b = row >> 12, s = row & 4095;
                const float rs = rsv[lr];
                u16* qd = p.Qm() + ((size_t)(b * 8 + hh) * S_ + s) * 192 + 128;
#pragma unroll
                for (int n = 0; n < 2; ++n) {
                  const int i = n * 16 + fr;
                  const float2 cs = p.cs()[(size_t)row * 32 + i];
                  const float x1 = acc[m][n][j] * rs, x2 = acc[m][n + 2][j] * rs;
                  qd[i] = f2bf(x1 * cs.x - x2 * cs.y); qd[32 + i] = f2bf(x1 * cs.y + x2 * cs.x);
                }
              }
          }
        });
      __syncthreads();
    } else if (t < nq + nkv) {
      const int tt = t - nq, tm = tt / 16, tn = tt % 16;
      compute_rs(p.ckvb(), tm * 128, rsv);
      gemm128(p.ckvb(), 512, p.WukvT(), 512, 512, tm * 128, tn * 128, smem,
        [&](f32x4 (&acc)[4][4], int row0, int col0, int fr, int fq) {
          const int hh = col0 >> 8, off = col0 & 255;
          const int lr0 = row0 & 127;
          if (off < 128) {
#pragma unroll
            for (int m = 0; m < 4; ++m)
#pragma unroll
              for (int j = 0; j < 4; ++j) {
                const int lr = lr0 + m * 16 + fq * 4 + j, row = (row0 - lr0) + lr, b = row >> 12, s = row & 4095;
                const float rs = rsv[lr];
                u16* kd = p.Km() + ((size_t)(b * 8 + hh) * S_ + s) * 192 + off;
#pragma unroll
                for (int n = 0; n < 4; ++n) kd[n * 16 + fr] = f2bf(acc[m][n][j] * rs);
              }
          } else {
#pragma unroll
            for (int m = 0; m < 4; ++m) {
              const int lr = lr0 + m * 16 + fq * 4, row = (row0 - lr0) + lr, b = row >> 12, s = row & 4095;
              const float r0 = rsv[lr], r1 = rsv[lr + 1], r2 = rsv[lr + 2], r3 = rsv[lr + 3];
#pragma unroll
              for (int n = 0; n < 4; ++n) {
                const int dv = off - 128 + n * 16 + fr;
                *(u32x2*)(p.VmT() + ((size_t)(b * 8 + hh) * 128 + dv) * S_ + s) =
                    u32x2{pk2(acc[m][n][0] * r0, acc[m][n][1] * r1), pk2(acc[m][n][2] * r2, acc[m][n][3] * r3)};
              }
            }
          }
        });
      __syncthreads();
    } else {
      const int seq = t - nq - nkv;
      if ((TID() >> 6) == 0) {
        const int lane = TID() & 63;
        const float* src = p.logf() + (size_t)seq * S_ + lane * 64;
        float* dst = p.Fk() + (size_t)seq * S_ + lane * 64;
        float sum = 0.f;
        for (int i = 0; i < 16; ++i) { const float4 v = *(const float4*)(src + i * 4); sum += v.x; sum += v.y; sum += v.z; sum += v.w; }
        float inc = sum;
#pragma unroll
        for (int d = 1; d < 64; d <<= 1) { const float o = __shfl_up(inc, d, 64); if (lane >= d) inc += o; }
        float run = inc - sum;
        for (int i = 0; i < 16; ++i) {
          const float4 v = *(const float4*)(src + i * 4); float4 o;
          run += v.x; o.x = run; run += v.y; o.y = run; run += v.z; o.z = run; run += v.w; o.w = run;
          *(float4*)(dst + i * 4) = o;
        }
      }
    }
  }
}

#ifdef ATTN_NAIVE
__device__ void phase_attn_naive(const Params& p, char* smem, int bid, int nb) {
  const int tid = TID(), lane = tid & 63, wid = tid >> 6;
  const int per = NB_ * 8 * S_, nrows = 2 * per;
  for (int r = bid * 4 + wid; r < nrows; r += nb * 4) {
    const int type = r / per, rr = r % per, bh = rr / S_, s = rr % S_;
    const int DQ = type ? 128 : 192;
    const u16* Q = type ? p.Qf() + ((size_t)bh * S_ + s) * 128 : p.Qm() + ((size_t)bh * S_ + s) * 192;
    const u16* Kb = type ? p.Kf() + (size_t)bh * S_ * 128 : p.Km() + (size_t)bh * S_ * 192;
    const u16* VT = (type ? p.VfT() : p.VmT()) + (size_t)bh * 128 * S_;
    const float* F = p.Fk() + (size_t)bh * S_;
    const float scale = type ? 0.08838834764831845f : 0.07216878364870322f;
    float m = -1e30f, l = 0.f;
    float acc[128];
#pragma unroll
    for (int d = 0; d < 128; ++d) acc[d] = 0.f;
    const float fqv = type ? F[s] : 0.f;
    for (int k0 = 0; k0 <= s; k0 += 64) {
      const int key = k0 + lane; const bool valid = key <= s; const int keyc = valid ? key : s;
      const u16* kr = Kb + (size_t)keyc * DQ;
      float sc = 0.f;
      for (int d = 0; d < DQ; d += 8) {
        const u32x4 kv = *(const u32x4*)(kr + d), qv = *(const u32x4*)(Q + d);
#pragma unroll
        for (int w = 0; w < 4; ++w) sc += bflo(kv[w]) * bflo(qv[w]) + bfhi(kv[w]) * bfhi(qv[w]);
      }
      sc *= scale;
      if (type) sc += fqv - F[keyc];
      if (!valid) sc = -1e30f;
      const float mx = wave_max(sc), mn = fmaxf(m, mx), alpha = __expf(m - mn);
      const float pr = valid ? __expf(sc - mn) : 0.f;
      m = mn; l = l * alpha + pr;
#pragma unroll
      for (int d = 0; d < 128; ++d) acc[d] = acc[d] * alpha + pr * bf2f(VT[(size_t)d * S_ + keyc]);
    }
    const float inv = 1.f / wave_sum(l);
    float o0 = 0.f, o1 = 0.f;
#pragma unroll
    for (int d = 0; d < 128; ++d) {
      const float o = wave_sum(acc[d]) * inv;
      if (lane == (d & 63)) { if (d < 64) o0 = o; else o1 = o; }
    }
    const int b = bh >> 3, hh = bh & 7;
    u16* od = p.omix() + ((size_t)(b * S_ + s)) * 2048 + type * 1024 + hh * 128;
    od[lane] = f2bf(o0); od[64 + lane] = f2bf(o1);
  }
}

#endif
typedef float f32x16 __attribute__((ext_vector_type(16)));
template <int TYPE>
__device__ __forceinline__ void attn_item(const Params& p, char* smem, int bh, int qb) {
  constexpr int DQK = TYPE ? 128 : 192, NKS = DQK / 16, KSTR = DQK * 2 + 16, VSTR = 128;
  constexpr int KCH = DQK / 8, NKL = 64 * KCH / 256;
  constexpr float C2 = (TYPE ? 0.08838834764831845f : 0.07216878364870322f) * 1.4426950408889634f;
  char* sK = smem; char* sV = smem + 25600; float* sF = (float*)(smem + 25600 + 32768);
  const int tid = TID(), lane = tid & 63, wid = tid >> 6, c = lane & 31, hi = lane >> 5;
  const u16* Qb = (TYPE ? p.Qf() : p.Qm()) + (size_t)bh * S_ * DQK;
  const u16* Kb = (TYPE ? p.Kf() : p.Km()) + (size_t)bh * S_ * DQK;
  const u16* Vb = (TYPE ? p.VfT() : p.VmT()) + (size_t)bh * 128 * S_;
  const float* Fb = p.Fk() + (size_t)bh * S_;
  const int qrow = qb * 128 + wid * 32;
  bf16x8 qf[NKS];
#pragma unroll
  for (int ks = 0; ks < NKS; ++ks) qf[ks] = *(const bf16x8*)(Qb + (size_t)(qrow + c) * DQK + ks * 16 + hi * 8);
  f32x16 o[4];
#pragma unroll
  for (int db = 0; db < 4; ++db)
#pragma unroll
    for (int r = 0; r < 16; ++r) o[db][r] = 0.f;
  float m = -1e30f, l = 0.f;
  const int ntiles = 2 * qb + 2;
  u32x4 kreg[NKL];
  float4 freg = make_float4(0.f, 0.f, 0.f, 0.f);
  const unsigned koff = (unsigned)tid * 16u;
  auto load_k = [&](int kt) {
    const char* kb = (const char*)(Kb + (size_t)kt * 64 * DQK);
#pragma unroll
    for (int i = 0; i < NKL; ++i) kreg[i] = *(const u32x4*)(kb + i * 4096 + koff);
    if (TYPE) { if (tid < 16) freg = *(const float4*)(Fb + kt * 64 + tid * 4); }
  };
  const unsigned voff = (unsigned)((((tid >> 3) * S_) + (((tid & 7) ^ ((tid >> 4) & 7)) * 8)) * 2);
  auto load_v = [&](int kt) {
    const char* vb = (const char*)(Vb + kt * 64);
    char* dst = sV + (kt & 1) * 16384 + tid * 16;
#pragma unroll
    for (int i = 0; i < 4; ++i)
      __builtin_amdgcn_global_load_lds((const unsigned*)(vb + (size_t)i * 32 * S_ * 2 + voff), (unsigned*)(dst + i * 4096), 16, 0, 0);
  };
  auto store_tile = [&]() {
#pragma unroll
    for (int i = 0; i < NKL; ++i) { const int ch = tid + 256 * i, key = ch / KCH, dc = ch % KCH; *(u32x4*)(sK + key * KSTR + dc * 16) = kreg[i]; }
    if (TYPE) { if (tid < 16) { const float L2E = 1.4426950408889634f; *(float4*)(sF + tid * 4) = make_float4(freg.x * L2E, freg.y * L2E, freg.z * L2E, freg.w * L2E); } }
  };
  const int krow = (c & 19) | ((c & 4) << 1) | ((c & 8) >> 1);
  const char* ka0 = sK + krow * KSTR + hi * 16;
  const char* ka1 = ka0 + 32 * KSTR;
  const int vx = (c >> 1) & 7;
  int vo[2][2];
#pragma unroll
  for (int kb = 0; kb < 2; ++kb)
#pragma unroll
    for (int s2 = 0; s2 < 2; ++s2) vo[kb][s2] = c * VSTR + (((4 * kb + 2 * s2 + hi) ^ vx) * 16);
  load_k(0); load_v(0);
#pragma unroll 1
  for (int kt = 0; kt < ntiles; ++kt) {
    asm volatile("s_waitcnt vmcnt(0)" ::: "memory");
    __syncthreads();
    store_tile();
    __syncthreads();
    if (kt + 1 < ntiles) { load_k(kt + 1); load_v(kt + 1); }
    const int k0 = kt * 64;
    const char* sVc = sV + (kt & 1) * 16384;
    if (k0 <= qrow + 31) {
      f32x16 p0, p1;
#pragma unroll
      for (int r = 0; r < 16; ++r) { p0[r] = 0.f; p1[r] = 0.f; }
#pragma unroll
      for (int ks = 0; ks < NKS; ++ks) {
        const bf16x8 a0 = *(const bf16x8*)(ka0 + ks * 32), a1 = *(const bf16x8*)(ka1 + ks * 32);
        p0 = __builtin_amdgcn_mfma_f32_32x32x16_bf16(a0, qf[ks], p0, 0, 0, 0);
        p1 = __builtin_amdgcn_mfma_f32_32x32x16_bf16(a1, qf[ks], p1, 0, 0, 0);
      }
      if (TYPE) {
#pragma unroll
        for (int s = 0; s < 2; ++s) {
          const float4 f0 = *(const float4*)(sF + 16 * s + 8 * hi), f1 = *(const float4*)(sF + 16 * s + 8 * hi + 4);
          const float4 g0 = *(const float4*)(sF + 32 + 16 * s + 8 * hi), g1 = *(const float4*)(sF + 32 + 16 * s + 8 * hi + 4);
          p0[8 * s + 0] = p0[8 * s + 0] * C2 - f0.x; p0[8 * s + 1] = p0[8 * s + 1] * C2 - f0.y; p0[8 * s + 2] = p0[8 * s + 2] * C2 - f0.z; p0[8 * s + 3] = p0[8 * s + 3] * C2 - f0.w;
          p0[8 * s + 4] = p0[8 * s + 4] * C2 - f1.x; p0[8 * s + 5] = p0[8 * s + 5] * C2 - f1.y; p0[8 * s + 6] = p0[8 * s + 6] * C2 - f1.z; p0[8 * s + 7] = p0[8 * s + 7] * C2 - f1.w;
          p1[8 * s + 0] = p1[8 * s + 0] * C2 - g0.x; p1[8 * s + 1] = p1[8 * s + 1] * C2 - g0.y; p1[8 * s + 2] = p1[8 * s + 2] * C2 - g0.z; p1[8 * s + 3] = p1[8 * s + 3] * C2 - g0.w;
          p1[8 * s + 4] = p1[8 * s + 4] * C2 - g1.x; p1[8 * s + 5] = p1[8 * s + 5] * C2 - g1.y; p1[8 * s + 6] = p1[8 * s + 6] * C2 - g1.z; p1[8 * s + 7] = p1[8 * s + 7] * C2 - g1.w;
        }
      } else {
#pragma unroll
        for (int r = 0; r < 16; ++r) { p0[r] *= C2; p1[r] *= C2; }
      }
      if (k0 + 63 > qrow) {
        const int lim = qrow + c - k0 - 8 * hi;
        const float NEG = -__builtin_inff();
#pragma unroll
        for (int r = 0; r < 16; ++r) {
          const int kb = 16 * (r >> 3) + (r & 7);
          if (kb > lim) p0[r] = NEG;
          if (kb + 32 > lim) p1[r] = NEG;
        }
      }
      float mx = p0[0];
#pragma unroll
      for (int r = 1; r < 16; ++r) mx = fmaxf(mx, p0[r]);
#pragma unroll
      for (int r = 0; r < 16; ++r) mx = fmaxf(mx, p1[r]);
      {
        auto rr = __builtin_amdgcn_permlane32_swap(__float_as_uint(mx), __float_as_uint(mx), false, false);
        mx = fmaxf(__uint_as_float(rr[0]), __uint_as_float(rr[1]));
      }
      const float mn = fmaxf(m, mx);
      const float alpha = __builtin_amdgcn_exp2f(m - mn);
      m = mn;
      if (!__all(alpha == 1.f)) {
#pragma unroll
        for (int db = 0; db < 4; ++db)
#pragma unroll
          for (int r = 0; r < 16; ++r) o[db][r] *= alpha;
      }
      float ps = 0.f;
#pragma unroll
      for (int r = 0; r < 16; ++r) { p0[r] = __builtin_amdgcn_exp2f(p0[r] - mn); p1[r] = __builtin_amdgcn_exp2f(p1[r] - mn); ps += p0[r] + p1[r]; }
      l = l * alpha + ps;
      bf16x8 pa[2][2];
#pragma unroll
      for (int s = 0; s < 2; ++s) {
        u32x4 w0 = {pk2(p0[8 * s + 0], p0[8 * s + 1]), pk2(p0[8 * s + 2], p0[8 * s + 3]), pk2(p0[8 * s + 4], p0[8 * s + 5]), pk2(p0[8 * s + 6], p0[8 * s + 7])};
        u32x4 w1 = {pk2(p1[8 * s + 0], p1[8 * s + 1]), pk2(p1[8 * s + 2], p1[8 * s + 3]), pk2(p1[8 * s + 4], p1[8 * s + 5]), pk2(p1[8 * s + 6], p1[8 * s + 7])};
        pa[0][s] = *reinterpret_cast<bf16x8*>(&w0); pa[1][s] = *reinterpret_cast<bf16x8*>(&w1);
      }
#pragma unroll
      for (int db = 0; db < 4; ++db)
#pragma unroll
        for (int kb = 0; kb < 2; ++kb)
#pragma unroll
          for (int s = 0; s < 2; ++s) {
            const bf16x8 av = *(const bf16x8*)(sVc + db * 32 * VSTR + vo[kb][s]);
            o[db] = __builtin_amdgcn_mfma_f32_32x32x16_bf16(av, pa[kb][s], o[db], 0, 0, 0);
          }
    }
  }
  {
    auto rr = __builtin_amdgcn_permlane32_swap(__float_as_uint(l), __float_as_uint(l), false, false);
    const float inv = 1.f / (__uint_as_float(rr[0]) + __uint_as_float(rr[1]));
    const int b = bh >> 3, hh = bh & 7;
    u16* od = p.omix() + ((size_t)(b * S_ + qrow + c)) * 2048 + TYPE * 1024 + hh * 128 + 4 * hi;
#pragma unroll
    for (int db = 0; db < 4; ++db)
#pragma unroll
      for (int g = 0; g < 4; ++g)
        *(u32x2*)(od + 32 * db + 8 * g) = u32x2{pk2(o[db][4 * g] * inv, o[db][4 * g + 1] * inv), pk2(o[db][4 * g + 2] * inv, o[db][4 * g + 3] * inv)};
  }
}

__device__ void phase_attn(const Params& p, char* smem, int bid, int nb) {
  int* sItem = (int*)(smem + 60000);
  for (;;) {
    __syncthreads();
    if (TID() == 0) *sItem = (int)atomicAdd(p.ctr(), 1u);
    __syncthreads();
    const int item = *sItem;
    if (item >= 1024) break;
    const int qb = 31 - (item >> 5), r = item & 31, type = r >> 4, bh = r & 15;
    if (type == 0) attn_item<0>(p, smem, bh, qb); else attn_item<1>(p, smem, bh, qb);
  }
}

__device__ void phase_outproj(const Params& p, char* smem, int bid, int nb) {
  const int ntiles = 64 * 16;
  for (int t = bid; t < ntiles; t += nb) {
    const int tm = t / 16, tn = t % 16;
    gemm128(p.omix(), D_, p.WoutT(), D_, D_, tm * 128, tn * 128, smem,
      [&](f32x4 (&acc)[4][4], int row0, int col0, int fr, int fq) {
#pragma unroll
        for (int m = 0; m < 4; ++m)
#pragma unroll
          for (int n = 0; n < 4; ++n)
#pragma unroll
            for (int j = 0; j < 4; ++j) {
              const size_t idx = (size_t)(row0 + m * 16 + fq * 4 + j) * D_ + col0 + n * 16 + fr;
              p.y1()[idx] = ALPHA * p.x[idx] + acc[m][n][j];
            }
      });
  }
}

__device__ void phase_ln1(const Params& p, int bid, int nb) {
  const int lane = TID() & 63, wid = TID() >> 6;
  for (int t = bid * 4 + wid; t < T_; t += nb * 4) {
    float* row = p.y1() + (size_t)t * D_;
    float4 v[8];
    float sum = 0.f;
#pragma unroll
    for (int i = 0; i < 8; ++i) { v[i] = *(const float4*)(row + (i * 64 + lane) * 4); sum += (v[i].x + v[i].y) + (v[i].z + v[i].w); }
    const float mu = wave_sum(sum) * (1.f / D_);
    float sq = 0.f;
#pragma unroll
    for (int i = 0; i < 8; ++i) {
      v[i].x -= mu; v[i].y -= mu; v[i].z -= mu; v[i].w -= mu;
      sq += (v[i].x * v[i].x + v[i].y * v[i].y) + (v[i].z * v[i].z + v[i].w * v[i].w);
    }
    const float rstd = rsqrtf(wave_sum(sq) * (1.f / D_) + EPS);
#pragma unroll
    for (int i = 0; i < 8; ++i) {
      const int c = (i * 64 + lane) * 4;
      const float4 g = *(const float4*)(p.ln1_g + c), bb = *(const float4*)(p.ln1_b + c);
      float4 o; o.x = v[i].x * rstd * g.x + bb.x; o.y = v[i].y * rstd * g.y + bb.y; o.z = v[i].z * rstd * g.z + bb.z; o.w = v[i].w * rstd * g.w + bb.w;
      *(float4*)(row + c) = o;
      *(u32x2*)(p.h1b() + (size_t)t * D_ + c) = u32x2{pk2(o.x, o.y), pk2(o.z, o.w)};
    }
  }
}

__device__ void phase_mid(const Params& p, char* smem, int bid, int nb) {
  const int ng = 64 * 16, nq = 64 * 8;
  for (int t = bid; t < ng + nq; t += nb) {
    if (t < ng) {
      const int tm = t / 16, tn = t % 16;
      f32x4 pacc[4][4], acc[4][4];
      gemm_core(p.pb(), 256, p.WpT(), 256, 256, tm * 128, tn * 128, smem, pacc);
      gemm_core(p.h1b(), D_, p.WgT(), D_, D_, tm * 128, tn * 128, smem, acc);
      {
        const int tid = TID(), wid = tid >> 6, lane = tid & 63, wr = wid >> 1, wc = wid & 1, fr = lane & 15, fq = lane >> 4;
        const size_t base = (size_t)(tm * 128 + wr * 64 + fq * 4) * D_ + tn * 128 + wc * 64 + fr;
        const float* yb = p.y1() + base;
        float* ob = p.out + base;
#pragma unroll
        for (int m = 0; m < 4; ++m) {
#pragma unroll
          for (int n = 0; n < 4; ++n)
#pragma unroll
            for (int j = 0; j < 4; ++j) {
              const int o = (m * 16 + j) * D_ + n * 16;
              const float sg = 1.f / (1.f + __expf(-acc[m][n][j]));
              ob[o] = ALPHA * yb[o] + pacc[m][n][j] * sg;
            }
        }
      }
    } else {
      const int tt = t - ng, tm = tt / 8, tn = tt % 8;
      gemm128(p.h1b(), D_, p.WpqT(), D_, D_, tm * 128, tn * 128, smem,
        [&](f32x4 (&acc)[4][4], int row0, int col0, int fr, int fq) {
#pragma unroll
          for (int m = 0; m < 4; ++m)
#pragma unroll
            for (int n = 0; n < 4; ++n)
#pragma unroll
              for (int j = 0; j < 4; ++j)
                p.pq()[(size_t)(row0 + m * 16 + fq * 4 + j) * 1024 + col0 + n * 16 + fr] = acc[m][n][j];
        });
    }
  }
}

template <int NPER, int IDXMASK>
__device__ __forceinline__ int top16(unsigned (&k)[NPER], int lane) {
  int mine = 0;
#pragma unroll 1
  for (int r = 0; r < 16; ++r) {
    unsigned loc = k[0];
#pragma unroll
    for (int i = 1; i < NPER; ++i) loc = loc > k[i] ? loc : k[i];
    const unsigned best = wave_umax(loc);
#pragma unroll
    for (int i = 0; i < NPER; ++i) if (k[i] == best) k[i] = 0u;
    if (lane == r) mine = IDXMASK - (int)(best & (unsigned)IDXMASK);
  }
  return mine;
}

__device__ void phase_peer(const Params& p, char* smem, int bid, int nb) {
  const int tid = TID(), lane = tid & 63, wid = tid >> 6;
  float* qs = (float*)smem;
  float* sc = (float*)(smem + 8192);
  int* eidx = (int*)(smem + 24576);
  float* gts = (float*)(smem + 32768);
  for (int it = bid; it < T_ / 16; it += nb) {
    const int t0 = it * 16;
    for (int h = 0; h < 8; ++h) {
#pragma unroll
      for (int i = 0; i < 8; ++i) {
        const int idx = tid + 256 * i, tok = idx >> 7, d = idx & 127;
        qs[idx] = p.pq()[(size_t)(t0 + tok) * 1024 + h * 128 + d];
      }
      const int half = tid >> 7, n = tid & 127;
      const float* kp = (half ? p.keys2 : p.keys1) + ((size_t)(h * 128 + n)) * 64;
      float4 kv[16];
#pragma unroll
      for (int i = 0; i < 16; ++i) kv[i] = *(const float4*)(kp + i * 4);
      __syncthreads();
      for (int tok = 0; tok < 16; ++tok) {
        const float* q = qs + tok * 128 + half * 64;
        float d = 0.f;
#pragma unroll
        for (int i = 0; i < 16; ++i) {
          const float4 qv = *(const float4*)(q + i * 4);
          d += kv[i].x * qv.x; d += kv[i].y * qv.y; d += kv[i].z * qv.z; d += kv[i].w * qv.w;
        }
        sc[tok * 256 + tid] = d;
      }
      __syncthreads();
      for (int ti = 0; ti < 4; ++ti) {
        const int tok = wid * 4 + ti;
        const float* s = sc + tok * 256;
        unsigned k1[2], k2[2];
        k1[0] = (ordkey(s[lane]) & ~127u) | (unsigned)(127 - lane);
        k1[1] = (ordkey(s[64 + lane]) & ~127u) | (unsigned)(127 - (64 + lane));
        k2[0] = (ordkey(s[128 + lane]) & ~127u) | (unsigned)(127 - lane);
        k2[1] = (ordkey(s[192 + lane]) & ~127u) | (unsigned)(127 - (64 + lane));
        const int i1 = top16<2, 127>(k1, lane);
        const int i2 = top16<2, 127>(k2, lane);
        const float v1 = s[i1 & 127], v2 = s[128 + (i2 & 127)];
        unsigned kc[4];
        const float v2b = __shfl(v2, lane & 15, 64);
#pragma unroll
        for (int m = 0; m < 4; ++m) {
          const float v1a = __shfl(v1, (lane >> 4) + 4 * m, 64);
          const int c = lane + 64 * m;
          kc[m] = (ordkey(v1a + v2b) & ~255u) | (unsigned)(255 - c);
        }
        const int cw = top16<4, 255>(kc, lane) & 255;
        const int a = cw >> 4, b = cw & 15;
        const int i1a = __shfl(i1, a, 64), i2b = __shfl(i2, b, 64);
        const float val = __shfl(v1, a, 64) + __shfl(v2, b, 64);
        const float mx = rdlane(row_max(lane < 16 ? val : -3e38f), 0);
        const float ex = lane < 16 ? __expf(val - mx) : 0.f;
        const float sm = rdlane(row_sum(ex), 0);
        if (lane < 16) {
          eidx[tok * 128 + h * 16 + lane] = i1a * 128 + i2b;
          gts[tok * 128 + h * 16 + lane] = ex / sm;
        }
      }
      __syncthreads();
    }
    for (int ti = 0; ti < 4; ++ti) {
      const int tok = wid * 4 + ti, t = t0 + tok;
      typedef float f32x2 __attribute__((ext_vector_type(2)));
      float hreg[32], o[32];
#pragma unroll
      for (int c = 0; c < 2; ++c)
#pragma unroll
        for (int q = 0; q < 2; ++q) {
          const u32x4 hv = *(const u32x4*)(p.h1b() + (size_t)t * D_ + (c * 64 + lane) * 16 + q * 8);
#pragma unroll
          for (int w = 0; w < 4; ++w) { hreg[c * 16 + q * 8 + 2 * w] = bflo(hv[w]); hreg[c * 16 + q * 8 + 2 * w + 1] = bfhi(hv[w]); }
        }
#pragma unroll
      for (int i = 0; i < 32; ++i) o[i] = 0.f;
      const float* Us = p.Us(); const float* Vs = p.Vs();
      const unsigned char* Uq = p.Uq(); const unsigned char* Vq = p.Vq();
#pragma unroll 1
      for (int j0 = 0; j0 < 128; j0 += 4) {
        u32x4 ur[4][2], vr[4][2];
        float g[4], su[4], sv[4];
#pragma unroll
        for (int jj = 0; jj < 4; ++jj) {
          const int e = __builtin_amdgcn_readfirstlane(eidx[tok * 128 + j0 + jj]);
          g[jj] = gts[tok * 128 + j0 + jj];
          su[jj] = Us[e]; sv[jj] = Vs[e];
          const unsigned char* up = Uq + (size_t)e * D_ + lane * 16;
          const unsigned char* vp = Vq + (size_t)e * D_ + lane * 16;
#pragma unroll
          for (int c = 0; c < 2; ++c) { ur[jj][c] = *(const u32x4*)(up + c * 1024); vr[jj][c] = *(const u32x4*)(vp + c * 1024); }
        }
#pragma unroll
        for (int jj = 0; jj < 4; ++jj) {
          float d = 0.f;
#pragma unroll
          for (int c = 0; c < 2; ++c)
#pragma unroll
            for (int w = 0; w < 4; ++w) {
              const f32x2 lo = __builtin_amdgcn_cvt_pk_f32_fp8(ur[jj][c][w], false), hi2 = __builtin_amdgcn_cvt_pk_f32_fp8(ur[jj][c][w], true);
              d += lo[0] * hreg[c * 16 + 4 * w]; d += lo[1] * hreg[c * 16 + 4 * w + 1];
              d += hi2[0] * hreg[c * 16 + 4 * w + 2]; d += hi2[1] * hreg[c * 16 + 4 * w + 3];
            }
          const float av = wave_sum(d) * su[jj];
          const float act = 0.5f * av * (1.f + erff(av * 0.7071067811865476f)) * g[jj] * sv[jj];
#pragma unroll
          for (int c = 0; c < 2; ++c)
#pragma unroll
            for (int w = 0; w < 4; ++w) {
              const f32x2 lo = __builtin_amdgcn_cvt_pk_f32_fp8(vr[jj][c][w], false), hi2 = __builtin_amdgcn_cvt_pk_f32_fp8(vr[jj][c][w], true);
              o[c * 16 + 4 * w] += act * lo[0]; o[c * 16 + 4 * w + 1] += act * lo[1];
              o[c * 16 + 4 * w + 2] += act * hi2[0]; o[c * 16 + 4 * w + 3] += act * hi2[1];
            }
        }
      }
      float* orow = p.out + (size_t)t * D_;
      float sum = 0.f;
#pragma unroll
      for (int c = 0; c < 2; ++c)
#pragma unroll
        for (int q = 0; q < 4; ++q) {
          const float4 r0 = *(const float4*)(orow + (c * 64 + lane) * 16 + q * 4);
          o[c * 16 + q * 4 + 0] += r0.x; o[c * 16 + q * 4 + 1] += r0.y; o[c * 16 + q * 4 + 2] += r0.z; o[c * 16 + q * 4 + 3] += r0.w;
        }
#pragma unroll
      for (int i = 0; i < 32; ++i) sum += o[i];
      const float mu = wave_sum(sum) * (1.f / D_);
      float sq = 0.f;
#pragma unroll
      for (int i = 0; i < 32; ++i) { o[i] -= mu; sq += o[i] * o[i]; }
      const float rstd = rsqrtf(wave_sum(sq) * (1.f / D_) + EPS);
#pragma unroll
      for (int c = 0; c < 2; ++c)
#pragma unroll
        for (int q = 0; q < 4; ++q) {
          const int col = (c * 64 + lane) * 16 + q * 4;
          const float4 g0 = *(const float4*)(p.ln2_g + col), b0 = *(const float4*)(p.ln2_b + col);
          float4 w0;
          w0.x = o[c * 16 + q * 4 + 0] * rstd * g0.x + b0.x; w0.y = o[c * 16 + q * 4 + 1] * rstd * g0.y + b0.y;
          w0.z = o[c * 16 + q * 4 + 2] * rstd * g0.z + b0.z; w0.w = o[c * 16 + q * 4 + 3] * rstd * g0.w + b0.w;
          *(float4*)(orow + col) = w0;
        }
    }
    __syncthreads();
  }
}

template <int PH>
__device__ __forceinline__ void run_phase(const Params& p, char* smem, int bid, int nb) {
  if constexpr (PH == 0) phase_prep(p, smem, bid, nb);
  if constexpr (PH == 1) phase_inproj(p, smem, bid, nb);
  if constexpr (PH == 2) phase_up(p, smem, bid, nb);
#ifdef ATTN_NAIVE
  if constexpr (PH == 3) phase_attn_naive(p, smem, bid, nb);
#else
  if constexpr (PH == 3) phase_attn(p, smem, bid, nb);
#endif
  if constexpr (PH == 4) phase_outproj(p, smem, bid, nb);
  if constexpr (PH == 5) phase_ln1(p, bid, nb);
  if constexpr (PH == 6) phase_mid(p, smem, bid, nb);
  if constexpr (PH == 7) phase_peer(p, smem, bid, nb);
}

template <int PH>
__global__ void __launch_bounds__(256, 2) phase_kernel(Params p) {
  __shared__ __attribute__((aligned(16))) char smem[SMEM_BYTES];
  run_phase<PH>(p, smem, blockIdx.x, gridDim.x);
}

__device__ __forceinline__ void grid_barrier(unsigned* ctr, unsigned target) {
  asm volatile("s_waitcnt vmcnt(0)" ::: "memory");
  __syncthreads();
  if (threadIdx.x == 0) {
    __builtin_amdgcn_fence(__ATOMIC_RELEASE, "agent");
    asm volatile("s_waitcnt vmcnt(0)" ::: "memory");
    __hip_atomic_fetch_add(ctr, 1u, __ATOMIC_RELAXED, __HIP_MEMORY_SCOPE_AGENT);
    while (__hip_atomic_load(ctr, __ATOMIC_RELAXED, __HIP_MEMORY_SCOPE_AGENT) < target) __builtin_amdgcn_s_sleep(2);
    __builtin_amdgcn_fence(__ATOMIC_ACQUIRE, "agent");
    asm volatile("s_waitcnt vmcnt(0)" ::: "memory");
  }
  __syncthreads();
}

#if SINGLE_LAUNCH
typedef const __attribute__((address_space(4))) unsigned long long* kargp_t;
static_assert(sizeof(Params) % 8 == 0, "Params must be a pack of 8-byte fields");
#define RUN_PHASE(N)                                                                        \
  {                                                                                         \
    kargp_t q = (kargp_t)__builtin_amdgcn_kernarg_segment_ptr();                            \
    asm volatile("" : "+s"(q));                                                             \
    Params lp;                                                                              \
    unsigned long long* d = (unsigned long long*)&lp;                                       \
    _Pragma("unroll") for (int i = 0; i < (int)(sizeof(Params) / 8); ++i) d[i] = q[i];      \
    run_phase<N>(lp, smem, bid, nb);                                                        \
  }
__global__ void __launch_bounds__(256, 2) fwd_kernel(Params p_) {
  __shared__ __attribute__((aligned(16))) char smem[SMEM_BYTES];
  const int bid = blockIdx.x, nb = gridDim.x;
  unsigned* bar = (unsigned*)(p_.ws + O_CTR) + 16;
  if (p_.out == nullptr) cg::this_grid().sync();
  const unsigned nbu = (unsigned)nb;
  RUN_PHASE(0) grid_barrier(bar, 1u * nbu);
  RUN_PHASE(1) grid_barrier(bar, 2u * nbu);
  RUN_PHASE(2) grid_barrier(bar, 3u * nbu);
  RUN_PHASE(3) grid_barrier(bar, 4u * nbu);
  RUN_PHASE(4) grid_barrier(bar, 5u * nbu);
  RUN_PHASE(5) grid_barrier(bar, 6u * nbu);
  RUN_PHASE(6) grid_barrier(bar, 7u * nbu);
  RUN_PHASE(7)
}
#endif

extern "C" void kernel_launch(void* const* d_in, const int* in_sizes, int n_in, void* d_out, int out_size,
                              void* d_ws, size_t ws_size, hipStream_t stream) {
  (void)in_sizes; (void)n_in; (void)out_size; (void)ws_size;
  Params p{};
  p.x = (const float*)d_in[0]; p.p = (const float*)d_in[1]; p.positions = (const int*)d_in[2];
  p.w_in = (const float*)d_in[3]; p.b_forget = (const float*)d_in[4]; p.g_q = (const float*)d_in[5];
  p.w_uq = (const float*)d_in[6]; p.g_kv = (const float*)d_in[7]; p.w_ukv = (const float*)d_in[8];
  p.w_out = (const float*)d_in[9]; p.ln1_g = (const float*)d_in[10]; p.ln1_b = (const float*)d_in[11];
  p.peer_wq = (const float*)d_in[12]; p.keys1 = (const float*)d_in[13]; p.keys2 = (const float*)d_in[14];
  p.peer_u = (const float*)d_in[15]; p.peer_v = (const float*)d_in[16]; p.wgate = (const float*)d_in[17];
  p.wproj = (const float*)d_in[18]; p.ln2_g = (const float*)d_in[19]; p.ln2_b = (const float*)d_in[20];
  p.out = (float*)d_out;
  p.ws = (char*)d_ws;

  static int grid_blocks = 0;
  if (!grid_blocks) {
    int dev = 0, cus = 0, per_cu = 0;
    (void)hipGetDevice(&dev);
    (void)hipDeviceGetAttribute(&cus, hipDeviceAttributeMultiprocessorCount, dev);
#if SINGLE_LAUNCH
    (void)hipOccupancyMaxActiveBlocksPerMultiprocessor(&per_cu, fwd_kernel, 256, 0);
#else
    per_cu = 2;
#endif
    if (per_cu > 2) per_cu = 2;
    if (per_cu < 1) per_cu = 1;
    grid_blocks = cus * per_cu;
  }
#if SINGLE_LAUNCH
  (void)hipMemsetAsync(d_ws, 0, 256, stream);
  void* args[] = {&p};
  hipError_t e = hipLaunchCooperativeKernel((void*)fwd_kernel, dim3(grid_blocks), dim3(256), args, 0, stream);
  if (e != hipSuccess) fprintf(stderr, "cooperative launch failed: %s (grid %d)\n", hipGetErrorString(e), grid_blocks);
#else
  phase_kernel<0><<<grid_blocks, 256, 0, stream>>>(p);
  phase_kernel<1><<<grid_blocks, 256, 0, stream>>>(p);
  phase_kernel<2><<<grid_blocks, 256, 0, stream>>>(p);
  phase_kernel<3><<<grid_blocks, 256, 0, stream>>>(p);
  phase_kernel<4><<<grid_blocks, 256, 0, stream>>>(p);
  phase_kernel<5><<<grid_blocks, 256, 0, stream>>>(p);
  phase_kernel<6><<<grid_blocks, 256, 0, stream>>>(p);
  phase_kernel<7><<<grid_blocks, 256, 0, stream>>>(p);
#endif
}
```

```cpp
#include <hip/hip_runtime.h>
#include <hip/hip_bf16.h>
#include <hip/hip_cooperative_groups.h>
#include <stdint.h>
#include <cstdio>
namespace cg = cooperative_groups;

typedef unsigned short u16;
typedef short bf16x8 __attribute__((ext_vector_type(8)));
typedef float f32x4 __attribute__((ext_vector_type(4)));
typedef unsigned u32x4 __attribute__((ext_vector_type(4)));
typedef unsigned u32x2 __attribute__((ext_vector_type(2)));

#ifndef SINGLE_LAUNCH
#define SINGLE_LAUNCH 1
#endif

constexpr int T_ = 8192, D_ = 2048, S_ = 4096, NB_ = 2;
constexpr int INW = 4168;
constexpr int NPH = 8;
constexpr float ALPHA = 1.189207115002721f;
constexpr float EPS = 1e-6f;
constexpr int SMEM_BYTES = 65536 + 1024;

constexpr size_t al256(size_t x) { return (x + 255) & ~(size_t)255; }
constexpr size_t O_CTR = 0;
constexpr size_t O_WINT = O_CTR + 256;
constexpr size_t O_WUQT = O_WINT + al256((size_t)4224 * 2048 * 2);
constexpr size_t O_WUKVT = O_WUQT + al256((size_t)1536 * 512 * 2);
constexpr size_t O_WOUTT = O_WUKVT + al256((size_t)2048 * 512 * 2);
constexpr size_t O_WPQT = O_WOUTT + al256((size_t)2048 * 2048 * 2);
constexpr size_t O_WGT = O_WPQT + al256((size_t)1024 * 2048 * 2);
constexpr size_t O_WPT = O_WGT + al256((size_t)2048 * 2048 * 2);
constexpr size_t O_PB = O_WPT + al256((size_t)2048 * 256 * 2);
constexpr size_t O_UB = O_PB + al256((size_t)8192 * 256 * 2);
constexpr size_t O_VB = O_UB + al256((size_t)16384 * 2048);
constexpr size_t O_OMIX = O_VB + al256((size_t)16384 * 2048);
constexpr size_t O_CS = O_OMIX + al256((size_t)8192 * 2048 * 2);
constexpr size_t O_US = O_CS + al256((size_t)8192 * 32 * 8);
constexpr size_t O_VS = O_US + al256((size_t)16384 * 4);
constexpr size_t O_REGB = O_VS + al256((size_t)16384 * 4);
constexpr size_t O_XB = O_REGB;
constexpr size_t O_CQB = O_XB + al256((size_t)8192 * 2048 * 2);
constexpr size_t O_CKVB = O_CQB + al256((size_t)8192 * 512 * 2);
constexpr size_t O_QM = O_CKVB + al256((size_t)8192 * 512 * 2);
constexpr size_t O_KM = O_QM + al256((size_t)8192 * 8 * 192 * 2);
constexpr size_t O_VMT = O_KM + al256((size_t)8192 * 8 * 192 * 2);
constexpr size_t O_QF = O_VMT + al256((size_t)8192 * 8 * 128 * 2);
constexpr size_t O_KF = O_QF + al256((size_t)8192 * 8 * 128 * 2);
constexpr size_t O_VFT = O_KF + al256((size_t)8192 * 8 * 128 * 2);
constexpr size_t O_LOGF = O_VFT + al256((size_t)8192 * 8 * 128 * 2);
constexpr size_t O_FK = O_LOGF + al256((size_t)16 * 4096 * 4);
constexpr size_t O_ENDB = O_FK + al256((size_t)16 * 4096 * 4);
constexpr size_t O_Y1 = O_REGB;
constexpr size_t O_H1B = O_Y1 + al256((size_t)8192 * 2048 * 4);
constexpr size_t O_PQ = O_H1B + al256((size_t)8192 * 2048 * 2);
constexpr size_t O_GATE = O_PQ + al256((size_t)8192 * 128 * 4);
constexpr size_t O_ENDB2 = O_GATE + al256((size_t)8192 * 128 * 4);
static_assert(O_ENDB2 <= O_ENDB, "region B reuse overflow");
static_assert(O_ENDB <= (size_t)500 * 1024 * 1024, "workspace too large");

struct Params {
  const float *x, *p; const int* positions;
  const float *w_in, *b_forget, *g_q, *w_uq, *g_kv, *w_ukv, *w_out, *ln1_g, *ln1_b;
  const float *peer_wq, *keys1, *keys2, *peer_u, *peer_v, *wgate, *wproj, *ln2_g, *ln2_b;
  float* out;
  char* ws;
#define WSP(type, name, off) __device__ __forceinline__ type* name() const { return (type*)(ws + (off)); }
  WSP(unsigned, ctr, O_CTR) WSP(u16, WinT, O_WINT) WSP(u16, WuqT, O_WUQT) WSP(u16, WukvT, O_WUKVT) WSP(u16, WoutT, O_WOUTT)
  WSP(u16, WpqT, O_WPQT) WSP(u16, WgT, O_WGT) WSP(u16, WpT, O_WPT) WSP(u16, pb, O_PB) WSP(unsigned char, Uq, O_UB) WSP(unsigned char, Vq, O_VB) WSP(float, Us, O_US) WSP(float, Vs, O_VS)
  WSP(u16, omix, O_OMIX) WSP(float2, cs, O_CS)
  WSP(u16, xb, O_XB) WSP(u16, cqb, O_CQB) WSP(u16, ckvb, O_CKVB) WSP(u16, Qm, O_QM) WSP(u16, Km, O_KM) WSP(u16, VmT, O_VMT)
  WSP(u16, Qf, O_QF) WSP(u16, Kf, O_KF) WSP(u16, VfT, O_VFT) WSP(float, logf, O_LOGF) WSP(float, Fk, O_FK)
  WSP(float, y1, O_Y1) WSP(u16, h1b, O_H1B) WSP(int, eidxG, O_PQ) WSP(float, gateG, O_GATE)
#undef WSP
};

__device__ __forceinline__ int TID() { int t = threadIdx.x; asm volatile("" : "+v"(t)); return t; }
__device__ __forceinline__ unsigned pk2(float lo, float hi) {
  unsigned r; asm volatile("v_cvt_pk_bf16_f32 %0, %1, %2" : "=v"(r) : "v"(lo), "v"(hi)); return r;
}
__device__ __forceinline__ u16 f2bf(float f) { return (u16)(pk2(f, 0.f) & 0xffffu); }
__device__ __forceinline__ float bf2f(u16 v) { return __uint_as_float(((unsigned)v) << 16); }
__device__ __forceinline__ float bflo(unsigned v) { return __uint_as_float(v << 16); }
__device__ __forceinline__ float bfhi(unsigned v) { return __uint_as_float(v & 0xffff0000u); }

template <int CTRL> __device__ __forceinline__ int dppi(int v) { return __builtin_amdgcn_update_dpp(0, v, CTRL, 0xF, 0xF, false); }
template <int CTRL> __device__ __forceinline__ float dppf(float v) { return __int_as_float(dppi<CTRL>(__float_as_int(v))); }
__device__ __forceinline__ float rdlane(float v, int l) { return __int_as_float(__builtin_amdgcn_readlane(__float_as_int(v), l)); }

__device__ __forceinline__ float row_sum(float v) {
  v += dppf<0xB1>(v); v += dppf<0x4E>(v); v += dppf<0x141>(v); v += dppf<0x140>(v); return v;
}
__device__ __forceinline__ float row_max(float v) {
  v = fmaxf(v, dppf<0xB1>(v)); v = fmaxf(v, dppf<0x4E>(v)); v = fmaxf(v, dppf<0x141>(v)); v = fmaxf(v, dppf<0x140>(v)); return v;
}
__device__ __forceinline__ float wave_sum(float v) {
  v = row_sum(v);
  return (rdlane(v, 0) + rdlane(v, 16)) + (rdlane(v, 32) + rdlane(v, 48));
}
__device__ __forceinline__ float wave_max(float v) {
  v = row_max(v);
  return fmaxf(fmaxf(rdlane(v, 0), rdlane(v, 16)), fmaxf(rdlane(v, 32), rdlane(v, 48)));
}
__device__ __forceinline__ unsigned wave_umax(unsigned v) {
  unsigned t;
  t = (unsigned)dppi<0xB1>((int)v); v = v > t ? v : t;
  t = (unsigned)dppi<0x4E>((int)v); v = v > t ? v : t;
  t = (unsigned)dppi<0x141>((int)v); v = v > t ? v : t;
  t = (unsigned)dppi<0x140>((int)v); v = v > t ? v : t;
  unsigned a = (unsigned)__builtin_amdgcn_readlane((int)v, 0), b = (unsigned)__builtin_amdgcn_readlane((int)v, 16);
  unsigned c = (unsigned)__builtin_amdgcn_readlane((int)v, 32), d = (unsigned)__builtin_amdgcn_readlane((int)v, 48);
  a = a > b ? a : b; c = c > d ? c : d; return a > c ? a : c;
}
__device__ __forceinline__ unsigned ordkey(float f) {
  unsigned u = __float_as_uint(f);
  return (u & 0x80000000u) ? ~u : (u | 0x80000000u);
}

__device__ void transpose_cvt(const float* __restrict__ W, int ldw, int K, int src_col0, int ncols,
                              u16* __restrict__ WT, int dst_row0, const float* __restrict__ kscale,
                              float* tile, int bid, int nb) {
  const int tiles_k = K / 64, tiles_n = ncols / 64, tid = TID();
#pragma unroll 1
  for (int t = bid; t < tiles_k * tiles_n; t += nb) {
    const int tk = t % tiles_k, tn = t / tiles_k, k0 = tk * 64, n0 = tn * 64;
#pragma unroll
    for (int i = 0; i < 4; ++i) {
      const int r = (tid >> 4) + 16 * i, c = (tid & 15) * 4;
      const float4 v = *(const float4*)(W + (size_t)(k0 + r) * ldw + src_col0 + n0 + c);
      const float sc = kscale ? kscale[k0 + r] : 1.f;
      tile[r * 65 + c + 0] = v.x * sc; tile[r * 65 + c + 1] = v.y * sc;
      tile[r * 65 + c + 2] = v.z * sc; tile[r * 65 + c + 3] = v.w * sc;
    }
    __syncthreads();
    {
      const int n = tid >> 2, kk = (tid & 3) * 16;
      unsigned w[8];
#pragma unroll
      for (int e = 0; e < 8; ++e) w[e] = pk2(tile[(kk + 2 * e) * 65 + n], tile[(kk + 2 * e + 1) * 65 + n]);
      u32x4* dst = (u32x4*)(WT + (size_t)(dst_row0 + n0 + n) * K + k0 + kk);
      dst[0] = u32x4{w[0], w[1], w[2], w[3]};
      dst[1] = u32x4{w[4], w[5], w[6], w[7]};
    }
    __syncthreads();
  }
}

__device__ void cvt_bf16(const float* __restrict__ src, u16* __restrict__ dst, size_t n8, size_t gtid, size_t gthreads) {
  for (size_t i = gtid; i < n8; i += gthreads) {
    const float4 a = ((const float4*)src)[2 * i], b = ((const float4*)src)[2 * i + 1];
    ((u32x4*)dst)[i] = u32x4{pk2(a.x, a.y), pk2(a.z, a.w), pk2(b.x, b.y), pk2(b.z, b.w)};
  }
}

__device__ void phase_prep(const Params& p, char* smem, int bid, int nb) {
  const int tid = TID(), lane = tid & 63, wid = tid >> 6;
  float* tile = (float*)smem;
  if (bid == 0 && tid == 0) p.ctr()[0] = 0;
  transpose_cvt(p.w_in, INW, D_, 0, 1024, p.WinT(), 0, nullptr, tile, bid, nb);
  transpose_cvt(p.w_in, INW, D_, 1088, 3072, p.WinT(), 1024, nullptr, tile, bid, nb);
  transpose_cvt(p.w_in, INW, D_, 1024, 64, p.WinT(), 4096, nullptr, tile, bid, nb);
  transpose_cvt(p.w_uq, 1536, 512, 0, 1536, p.WuqT(), 0, p.g_q, tile, bid, nb);
  transpose_cvt(p.w_ukv, 2048, 512, 0, 2048, p.WukvT(), 0, p.g_kv, tile, bid, nb);
  transpose_cvt(p.w_out, 2048, 2048, 0, 2048, p.WoutT(), 0, nullptr, tile, bid, nb);
  transpose_cvt(p.peer_wq, 1024, 2048, 0, 1024, p.WpqT(), 0, nullptr, tile, bid, nb);
  transpose_cvt(p.wgate, 2048, 2048, 0, 2048, p.WgT(), 0, nullptr, tile, bid, nb);
  transpose_cvt(p.wproj, 2048, 256, 0, 2048, p.WpT(), 0, nullptr, tile, bid, nb);
  const size_t gtid = (size_t)bid * 256 + tid, gth = (size_t)nb * 256;
  for (size_t i = gtid; i < (size_t)64 * 2048 / 8; i += gth) ((u32x4*)(p.WinT() + (size_t)4160 * 2048))[i] = u32x4{0, 0, 0, 0};
  cvt_bf16(p.x, p.xb(), (size_t)T_ * D_ / 8, gtid, gth);
  cvt_bf16(p.p, p.pb(), (size_t)T_ * 256 / 8, gtid, gth);
  for (int r = bid * 4 + wid; r < 2 * 16384; r += nb * 4) {
    const int tab = r >> 14, row = r & 16383;
    const float* src = (tab ? p.peer_v : p.peer_u) + (size_t)row * D_;
    unsigned* dst = (unsigned*)((tab ? p.Vq() : p.Uq()) + (size_t)row * D_);
    float4 v[8];
    float am = 0.f;
#pragma unroll
    for (int i = 0; i < 8; ++i) {
      v[i] = *(const float4*)(src + (i * 64 + lane) * 4);
      am = fmaxf(am, fmaxf(fmaxf(fabsf(v[i].x), fabsf(v[i].y)), fmaxf(fabsf(v[i].z), fabsf(v[i].w))));
    }
    am = wave_max(am);
    const float qs = am > 0.f ? 224.f / am : 1.f;
#pragma unroll
    for (int i = 0; i < 8; ++i) {
      unsigned w = __builtin_amdgcn_cvt_pk_fp8_f32(v[i].x * qs, v[i].y * qs, 0, false);
      w = __builtin_amdgcn_cvt_pk_fp8_f32(v[i].z * qs, v[i].w * qs, w, true);
      dst[i * 64 + lane] = w;
    }
    if (lane == 0) (tab ? p.Vs() : p.Us())[row] = am > 0.f ? am / 224.f : 1.f;
  }
  for (size_t i = gtid; i < (size_t)T_ * 32; i += gth) {
    const int t = (int)(i >> 5), fi = (int)(i & 31);
    const float invf = 1.0f / powf(10000.0f, (float)(2 * fi) / 64.0f);
    const float ang = (float)p.positions[t] * invf;
    const double rev = (double)ang * 0.15915494309189535;
    const float fr = (float)(rev - rint(rev));
    p.cs()[i] = make_float2(__builtin_amdgcn_cosf(fr), __builtin_amdgcn_sinf(fr));
  }
  __syncthreads();
  float* wff = (float*)smem;
  for (int i = tid; i < 2048 * 2; i += 256) {
    const int k = i >> 1, hf = i & 1;
    *(float4*)(wff + k * 8 + hf * 4) = *(const float4*)(p.w_in + (size_t)k * INW + 4160 + hf * 4);
  }
  __syncthreads();
  for (int t = bid * 4 + wid; t < T_; t += nb * 4) {
    float a[8];
#pragma unroll
    for (int e = 0; e < 8; ++e) a[e] = 0.f;
#pragma unroll 4
    for (int i = 0; i < 32; ++i) {
      const int k = i * 64 + lane;
      const float xv = p.x[(size_t)t * D_ + k];
      const float4 w0 = *(const float4*)(wff + k * 8), w1 = *(const float4*)(wff + k * 8 + 4);
      a[0] += xv * w0.x; a[1] += xv * w0.y; a[2] += xv * w0.z; a[3] += xv * w0.w;
      a[4] += xv * w1.x; a[5] += xv * w1.y; a[6] += xv * w1.z; a[7] += xv * w1.w;
    }
    float mine = 0.f;
#pragma unroll
    for (int e = 0; e < 8; ++e) { const float s = wave_sum(a[e]); if (lane == e) mine = s; }
    if (lane < 8) {
      const float z = mine + p.b_forget[lane];
      const float ls = fminf(z, 0.f) - log1pf(expf(-fabsf(z)));
      const int b = t >> 12, s = t & 4095;
      p.logf()[((size_t)(b * 8 + lane)) * S_ + s] = ls;
    }
  }
}

__device__ __forceinline__ void gemm_core(const u16* __restrict__ A, int lda, const u16* __restrict__ Bt, int ldb,
                                          int K, int brow, int bcol, char* smem, f32x4 (&acc)[4][4]) {
  const int tid = TID(), wid = tid >> 6, lane = tid & 63, wr = wid >> 1, wc = wid & 1, fr = lane & 15, fq = lane >> 4;
#pragma unroll
  for (int m = 0; m < 4; ++m)
#pragma unroll
    for (int n = 0; n < 4; ++n) acc[m][n] = f32x4{0.f, 0.f, 0.f, 0.f};
  const int nk = K / 32;
  const int srow = tid >> 2, sch = (tid & 3) ^ ((0x78 >> (((tid >> 4) & 3) * 2)) & 3);
  const u16* ga = A + (size_t)(brow + srow) * lda + sch * 8;
  const u16* gb = Bt + (size_t)(bcol + srow) * ldb + sch * 8;
  char* sdst = smem + tid * 16;
  auto issue = [&](int kt, int st) {
    char* sa = sdst + st * 16384;
#pragma unroll
    for (int i = 0; i < 2; ++i) {
      __builtin_amdgcn_global_load_lds((const unsigned*)(ga + (size_t)i * 64 * lda + kt * 32), (unsigned*)(sa + i * 4096), 16, 0, 0);
      __builtin_amdgcn_global_load_lds((const unsigned*)(gb + (size_t)i * 64 * ldb + kt * 32), (unsigned*)(sa + 8192 + i * 4096), 16, 0, 0);
    }
  };
  const int rsw = ((fq ^ ((0x78 >> (((fr >> 2) & 3) * 2)) & 3)) * 16);
  const int aoff = (wr * 64 + fr) * 64 + rsw, boff = 8192 + (wc * 64 + fr) * 64 + rsw;
  asm volatile("s_waitcnt vmcnt(0)" ::: "memory");
  __syncthreads();
  issue(0, 0);
  issue(nk > 1 ? 1 : nk - 1, 1);
  issue(nk > 2 ? 2 : nk - 1, 2);
#pragma unroll 1
  for (int kt = 0; kt < nk; ++kt) {
    asm volatile("s_waitcnt vmcnt(8)" ::: "memory");
    __builtin_amdgcn_s_barrier();
    asm volatile("" ::: "memory");
    issue(kt + 3 < nk ? kt + 3 : nk - 1, (kt + 3) & 3);
    const char* sb = smem + (kt & 3) * 16384;
    bf16x8 At[4], Bl[4];
#pragma unroll
    for (int m = 0; m < 4; ++m) At[m] = *reinterpret_cast<const bf16x8*>(sb + aoff + m * 1024);
#pragma unroll
    for (int n = 0; n < 4; ++n) Bl[n] = *reinterpret_cast<const bf16x8*>(sb + boff + n * 1024);
#pragma unroll
    for (int m = 0; m < 4; ++m)
#pragma unroll
      for (int n = 0; n < 4; ++n) acc[m][n] = __builtin_amdgcn_mfma_f32_16x16x32_bf16(At[m], Bl[n], acc[m][n], 0, 0, 0);
  }
  asm volatile("s_waitcnt vmcnt(0)" ::: "memory");
}

template <class Epi>
__device__ __forceinline__ void gemm128(const u16* __restrict__ A, int lda, const u16* __restrict__ Bt, int ldb,
                                        int K, int brow, int bcol, char* smem, Epi epi) {
  const int tid = TID(), wid = tid >> 6, lane = tid & 63, wr = wid >> 1, wc = wid & 1, fr = lane & 15, fq = lane >> 4;
  f32x4 acc[4][4];
  gemm_core(A, lda, Bt, ldb, K, brow, bcol, smem, acc);
  epi(acc, brow + wr * 64, bcol + wc * 64, fr, fq);
}

__device__ __forceinline__ int vblock(int bid, int nb) { return (nb & 7) ? bid : (bid & 7) * (nb >> 3) + (bid >> 3); }
__device__ __forceinline__ void tile_rc(int t, int Nt, int& tm, int& tn) {
  const int g = t / (8 * Nt), q = t % (8 * Nt);
  tn = q >> 3; tm = g * 8 + (q & 7);
}

__device__ void phase_inproj(const Params& p, char* smem, int bid, int nb) {
  const int ntn = 33, ntiles = 64 * ntn;
  for (int t = vblock(bid, nb); t < ntiles; t += nb) {
    int tm, tn; tile_rc(t, ntn, tm, tn);
    gemm128(p.xb(), D_, p.WinT(), D_, D_, tm * 128, tn * 128, smem,
      [&](f32x4 (&acc)[4][4], int row0, int col0, int fr, int fq) {
        if (col0 < 1024) {
          u16* dst = col0 < 512 ? p.cqb() : p.ckvb(); const int cb = col0 & 511;
#pragma unroll
          for (int m = 0; m < 4; ++m)
#pragma unroll
            for (int n = 0; n < 4; ++n)
#pragma unroll
              for (int j = 0; j < 4; ++j) {
                const int row = row0 + m * 16 + fq * 4 + j;
                dst[(size_t)row * 512 + cb + n * 16 + fr] = f2bf(acc[m][n][j]);
              }
        } else if (col0 < 3072) {
          int c = col0 - 1024; u16* dst = c < 1024 ? p.Qf() : p.Kf(); c &= 1023;
          const int hh = c >> 7, d0 = c & 127;
#pragma unroll
          for (int m = 0; m < 4; ++m)
#pragma unroll
            for (int n = 0; n < 4; ++n)
#pragma unroll
              for (int j = 0; j < 4; ++j) {
                const int row = row0 + m * 16 + fq * 4 + j, b = row >> 12, s = row & 4095;
                dst[((size_t)(b * 8 + hh) * S_ + s) * 128 + d0 + n * 16 + fr] = f2bf(acc[m][n][j]);
              }
        } else if (col0 < 4096) {
          const int c = col0 - 3072, hh = c >> 7, d0 = c & 127;
#pragma unroll
          for (int m = 0; m < 4; ++m)
#pragma unroll
            for (int n = 0; n < 4; ++n) {
              const int row = row0 + m * 16 + fq * 4, b = row >> 12, s = row & 4095, dv = d0 + n * 16 + fr;
              *(u32x2*)(p.VfT() + ((size_t)(b * 8 + hh) * 128 + dv) * S_ + s) =
                  u32x2{pk2(acc[m][n][0], acc[m][n][1]), pk2(acc[m][n][2], acc[m][n][3])};
            }
        } else if (col0 == 4096) {
#pragma unroll
          for (int m = 0; m < 4; ++m)
#pragma unroll
            for (int j = 0; j < 4; ++j) {
              const int row = row0 + m * 16 + fq * 4 + j, b = row >> 12, s = row & 4095;
#pragma unroll
              for (int n = 0; n < 2; ++n) {
                const int i = n * 16 + fr;
                const float2 cs = p.cs()[(size_t)row * 32 + i];
                const float x1 = acc[m][n][j], x2 = acc[m][n + 2][j];
                const u16 o1 = f2bf(x1 * cs.x - x2 * cs.y), o2 = f2bf(x1 * cs.y + x2 * cs.x);
                for (int hh = 0; hh < 8; ++hh) {
                  u16* kd = p.Km() + ((size_t)(b * 8 + hh) * S_ + s) * 192 + 128;
                  kd[i] = o1; kd[32 + i] = o2;
                }
              }
            }
        }
      });
  }
}

__device__ __forceinline__ void compute_rs(const u16* __restrict__ src, int brow, float* rsv) {
  const int tid = TID(), row = tid >> 1, hf = tid & 1;
  const u16* r = src + (size_t)(brow + row) * 512 + hf * 256;
  float ss = 0.f;
#pragma unroll 4
  for (int i = 0; i < 32; ++i) {
    const u32x4 v = *(const u32x4*)(r + i * 8);
#pragma unroll
    for (int w = 0; w < 4; ++w) { const float a = bflo(v[w]), b = bfhi(v[w]); ss += a * a + b * b; }
  }
  ss += dppf<0xB1>(ss);
  if (hf == 0) rsv[row] = rsqrtf(ss * (1.f / 512.f) + EPS);
}

__device__ void phase_up(const Params& p, char* smem, int bid, int nb) {
  float* rsv = (float*)(smem + 65536);
  const int nq = 64 * 12, nkv = 64 * 16, njobs = nq + nkv + 16;
  for (int t = vblock(bid, nb); t < njobs; t += nb) {
    if (t < nq) {
      int tm, tn; tile_rc(t, 12, tm, tn);
      compute_rs(p.cqb(), tm * 128, rsv);
      gemm128(p.cqb(), 512, p.WuqT(), 512, 512, tm * 128, tn * 128, smem,
        [&](f32x4 (&acc)[4][4], int row0, int col0, int fr, int fq) {
          const int hh = col0 / 192, off = col0 % 192;
          const int lr0 = row0 & 127;
          if (off < 128) {
#pragma unroll
            for (int m = 0; m < 4; ++m)
#pragma unroll
              for (int j = 0; j < 4; ++j) {
                const int lr = lr0 + m * 16 + fq * 4 + j, row = (row0 - lr0) + lr, b = row >> 12, s = row & 4095;
                const float rs = rsv[lr];
                u16* qd = p.Qm() + ((size_t)(b * 8 + hh) * S_ + s) * 192 + off;
#pragma unroll
                for (int n = 0; n < 4; ++n) qd[n * 16 + fr] = f2bf(acc[m][n][j] * rs);
              }
          } else {
#pragma unroll
            for (int m = 0; m < 4; ++m)
#pragma unroll
              for (int j = 0; j < 4; ++j) {
                const int lr = lr0 + m * 16 + fq * 4 + j, row = (row0 - lr0) + lr, b = row >> 12, s = row & 4095;
                const float rs = rsv[lr];
                u16* qd = p.Qm() + ((size_t)(b * 8 + hh) * S_ + s) * 192 + 128;
#pragma unroll
                for (int n = 0; n < 2; ++n) {
                  const int i = n * 16 + fr;
                  const float2 cs = p.cs()[(size_t)row * 32 + i];
                  const float x1 = acc[m][n][j] * rs, x2 = acc[m][n + 2][j] * rs;
                  qd[i] = f2bf(x1 * cs.x - x2 * cs.y); qd[32 + i] = f2bf(x1 * cs.y + x2 * cs.x);
                }
              }
          }
        });
      __syncthreads();
    } else if (t < nq + nkv) {
      int tm, tn; tile_rc(t - nq, 16, tm, tn);
      compute_rs(p.ckvb(), tm * 128, rsv);
      gemm128(p.ckvb(), 512, p.WukvT(), 512, 512, tm * 128, tn * 128, smem,
        [&](f32x4 (&acc)[4][4], int row0, int col0, int fr, int fq) {
          const int hh = col0 >> 8, off = col0 & 255;
          const int lr0 = row0 & 127;
          if (off < 128) {
#pragma unroll
            for (int m = 0; m < 4; ++m)
#pragma unroll
              for (int j = 0; j < 4; ++j) {
                const int lr = lr0 + m * 16 + fq * 4 + j, row = (row0 - lr0) + lr, b = row >> 12, s = row & 4095;
                const float rs = rsv[lr];
                u16* kd = p.Km() + ((size_t)(b * 8 + hh) * S_ + s) * 192 + off;
#pragma unroll
                for (int n = 0; n < 4; ++n) kd[n * 16 + fr] = f2bf(acc[m][n][j] * rs);
              }
          } else {
#pragma unroll
            for (int m = 0; m < 4; ++m) {
              const int lr = lr0 + m * 16 + fq * 4, row = (row0 - lr0) + lr, b = row >> 12, s = row & 4095;
              const float r0 = rsv[lr], r1 = rsv[lr + 1], r2 = rsv[lr + 2], r3 = rsv[lr + 3];
#pragma unroll
              for (int n = 0; n < 4; ++n) {
                const int dv = off - 128 + n * 16 + fr;
                *(u32x2*)(p.VmT() + ((size_t)(b * 8 + hh) * 128 + dv) * S_ + s) =
                    u32x2{pk2(acc[m][n][0] * r0, acc[m][n][1] * r1), pk2(acc[m][n][2] * r2, acc[m][n][3] * r3)};
              }
            }
          }
        });
      __syncthreads();
    } else {
      const int seq = t - nq - nkv;
      if ((TID() >> 6) == 0) {
        const int lane = TID() & 63;
        const float* src = p.logf() + (size_t)seq * S_ + lane * 64;
        float* dst = p.Fk() + (size_t)seq * S_ + lane * 64;
        float sum = 0.f;
        for (int i = 0; i < 16; ++i) { const float4 v = *(const float4*)(src + i * 4); sum += v.x; sum += v.y; sum += v.z; sum += v.w; }
        float inc = sum;
#pragma unroll
        for (int d = 1; d < 64; d <<= 1) { const float o = __shfl_up(inc, d, 64); if (lane >= d) inc += o; }
        float run = inc - sum;
        for (int i = 0; i < 16; ++i) {
          const float4 v = *(const float4*)(src + i * 4); float4 o;
          run += v.x; o.x = run; run += v.y; o.y = run; run += v.z; o.z = run; run += v.w; o.w = run;
          *(float4*)(dst + i * 4) = o;
        }
      }
    }
  }
}

#ifdef ATTN_NAIVE
__device__ void phase_attn_naive(const Params& p, char* smem, int bid, int nb) {
  const int tid = TID(), lane = tid & 63, wid = tid >> 6;
  const int per = NB_ * 8 * S_, nrows = 2 * per;
  for (int r = bid * 4 + wid; r < nrows; r += nb * 4) {
    const int type = r / per, rr = r % per, bh = rr / S_, s = rr % S_;
    const int DQ = type ? 128 : 192;
    const u16* Q = type ? p.Qf() + ((size_t)bh * S_ + s) * 128 : p.Qm() + ((size_t)bh * S_ + s) * 192;
    const u16* Kb = type ? p.Kf() + (size_t)bh * S_ * 128 : p.Km() + (size_t)bh * S_ * 192;
    const u16* VT = (type ? p.VfT() : p.VmT()) + (size_t)bh * 128 * S_;
    const float* F = p.Fk() + (size_t)bh * S_;
    const float scale = type ? 0.08838834764831845f : 0.07216878364870322f;
    float m = -1e30f, l = 0.f;
    float acc[128];
#pragma unroll
    for (int d = 0; d < 128; ++d) acc[d] = 0.f;
    const float fqv = type ? F[s] : 0.f;
    for (int k0 = 0; k0 <= s; k0 += 64) {
      const int key = k0 + lane; const bool valid = key <= s; const int keyc = valid ? key : s;
      const u16* kr = Kb + (size_t)keyc * DQ;
      float sc = 0.f;
      for (int d = 0; d < DQ; d += 8) {
        const u32x4 kv = *(const u32x4*)(kr + d), qv = *(const u32x4*)(Q + d);
#pragma unroll
        for (int w = 0; w < 4; ++w) sc += bflo(kv[w]) * bflo(qv[w]) + bfhi(kv[w]) * bfhi(qv[w]);
      }
      sc *= scale;
      if (type) sc += fqv - F[keyc];
      if (!valid) sc = -1e30f;
      const float mx = wave_max(sc), mn = fmaxf(m, mx), alpha = __expf(m - mn);
      const float pr = valid ? __expf(sc - mn) : 0.f;
      m = mn; l = l * alpha + pr;
#pragma unroll
      for (int d = 0; d < 128; ++d) acc[d] = acc[d] * alpha + pr * bf2f(VT[(size_t)d * S_ + keyc]);
    }
    const float inv = 1.f / wave_sum(l);
    float o0 = 0.f, o1 = 0.f;
#pragma unroll
    for (int d = 0; d < 128; ++d) {
      const float o = wave_sum(acc[d]) * inv;
      if (lane == (d & 63)) { if (d < 64) o0 = o; else o1 = o; }
    }
    const int b = bh >> 3, hh = bh & 7;
    u16* od = p.omix() + ((size_t)(b * S_ + s)) * 2048 + type * 1024 + hh * 128;
    od[lane] = f2bf(o0); od[64 + lane] = f2bf(o1);
  }
}

#endif
typedef float f32x16 __attribute__((ext_vector_type(16)));
template <int TYPE>
__device__ __forceinline__ void attn_item(const Params& p, char* smem, int bh, int qb) {
  constexpr int DQK = TYPE ? 128 : 192, NKS = DQK / 16, KSTR = DQK * 2 + 16, VSTR = 128;
  constexpr int KCH = DQK / 8, NKL = 64 * KCH / 256;
  constexpr float C2 = (TYPE ? 0.08838834764831845f : 0.07216878364870322f) * 1.4426950408889634f;
  char* sK = smem; char* sV = smem + 25600; float* sF = (float*)(smem + 25600 + 32768);
  const int tid = TID(), lane = tid & 63, wid = tid >> 6, c = lane & 31, hi = lane >> 5;
  const u16* Qb = (TYPE ? p.Qf() : p.Qm()) + (size_t)bh * S_ * DQK;
  const u16* Kb = (TYPE ? p.Kf() : p.Km()) + (size_t)bh * S_ * DQK;
  const u16* Vb = (TYPE ? p.VfT() : p.VmT()) + (size_t)bh * 128 * S_;
  const float* Fb = p.Fk() + (size_t)bh * S_;
  const int qrow = qb * 128 + wid * 32;
  bf16x8 qf[NKS];
#pragma unroll
  for (int ks = 0; ks < NKS; ++ks) qf[ks] = *(const bf16x8*)(Qb + (size_t)(qrow + c) * DQK + ks * 16 + hi * 8);
  f32x16 o[4];
#pragma unroll
  for (int db = 0; db < 4; ++db)
#pragma unroll
    for (int r = 0; r < 16; ++r) o[db][r] = 0.f;
  float m = -1e30f, l = 0.f;
  const int ntiles = 2 * qb + 2;
  u32x4 kreg[NKL];
  float4 freg = make_float4(0.f, 0.f, 0.f, 0.f);
  const unsigned koff = (unsigned)tid * 16u;
  auto load_k = [&](int kt) {
    const char* kb = (const char*)(Kb + (size_t)kt * 64 * DQK);
#pragma unroll
    for (int i = 0; i < NKL; ++i) kreg[i] = *(const u32x4*)(kb + i * 4096 + koff);
    if (TYPE) { if (tid < 16) freg = *(const float4*)(Fb + kt * 64 + tid * 4); }
  };
  const unsigned voff = (unsigned)((((tid >> 3) * S_) + (((tid & 7) ^ ((tid >> 4) & 7)) * 8)) * 2);
  auto load_v = [&](int kt) {
    const char* vb = (const char*)(Vb + kt * 64);
    char* dst = sV + (kt & 1) * 16384 + tid * 16;
#pragma unroll
    for (int i = 0; i < 4; ++i)
      __builtin_amdgcn_global_load_lds((const unsigned*)(vb + (size_t)i * 32 * S_ * 2 + voff), (unsigned*)(dst + i * 4096), 16, 0, 0);
  };
  auto store_tile = [&]() {
#pragma unroll
    for (int i = 0; i < NKL; ++i) { const int ch = tid + 256 * i, key = ch / KCH, dc = ch % KCH; *(u32x4*)(sK + key * KSTR + dc * 16) = kreg[i]; }
    if (TYPE) { if (tid < 16) { const float L2E = 1.4426950408889634f; *(float4*)(sF + tid * 4) = make_float4(freg.x * L2E, freg.y * L2E, freg.z * L2E, freg.w * L2E); } }
  };
  const int krow = (c & 19) | ((c & 4) << 1) | ((c & 8) >> 1);
  const char* ka0 = sK + krow * KSTR + hi * 16;
  const char* ka1 = ka0 + 32 * KSTR;
  const int vx = (c >> 1) & 7;
  int vo[2][2];
#pragma unroll
  for (int kb = 0; kb < 2; ++kb)
#pragma unroll
    for (int s2 = 0; s2 < 2; ++s2) vo[kb][s2] = c * VSTR + (((4 * kb + 2 * s2 + hi) ^ vx) * 16);
  load_k(0); load_v(0);
#pragma unroll 1
  for (int kt = 0; kt < ntiles; ++kt) {
    asm volatile("s_waitcnt vmcnt(0)" ::: "memory");
    __syncthreads();
    store_tile();
    __syncthreads();
    if (kt + 1 < ntiles) { load_k(kt + 1); load_v(kt + 1); }
    const int k0 = kt * 64;
    const char* sVc = sV + (kt & 1) * 16384;
    if (k0 <= qrow + 31) {
      f32x16 p0, p1;
#pragma unroll
      for (int r = 0; r < 16; ++r) { p0[r] = 0.f; p1[r] = 0.f; }
#pragma unroll
      for (int ks = 0; ks < NKS; ++ks) {
        const bf16x8 a0 = *(const bf16x8*)(ka0 + ks * 32), a1 = *(const bf16x8*)(ka1 + ks * 32);
        p0 = __builtin_amdgcn_mfma_f32_32x32x16_bf16(a0, qf[ks], p0, 0, 0, 0);
        p1 = __builtin_amdgcn_mfma_f32_32x32x16_bf16(a1, qf[ks], p1, 0, 0, 0);
      }
      if (TYPE) {
#pragma unroll
        for (int s = 0; s < 2; ++s) {
          const float4 f0 = *(const float4*)(sF + 16 * s + 8 * hi), f1 = *(const float4*)(sF + 16 * s + 8 * hi + 4);
          const float4 g0 = *(const float4*)(sF + 32 + 16 * s + 8 * hi), g1 = *(const float4*)(sF + 32 + 16 * s + 8 * hi + 4);
          p0[8 * s + 0] = p0[8 * s + 0] * C2 - f0.x; p0[8 * s + 1] = p0[8 * s + 1] * C2 - f0.y; p0[8 * s + 2] = p0[8 * s + 2] * C2 - f0.z; p0[8 * s + 3] = p0[8 * s + 3] * C2 - f0.w;
          p0[8 * s + 4] = p0[8 * s + 4] * C2 - f1.x; p0[8 * s + 5] = p0[8 * s + 5] * C2 - f1.y; p0[8 * s + 6] = p0[8 * s + 6] * C2 - f1.z; p0[8 * s + 7] = p0[8 * s + 7] * C2 - f1.w;
          p1[8 * s + 0] = p1[8 * s + 0] * C2 - g0.x; p1[8 * s + 1] = p1[8 * s + 1] * C2 - g0.y; p1[8 * s + 2] = p1[8 * s + 2] * C2 - g0.z; p1[8 * s + 3] = p1[8 * s + 3] * C2 - g0.w;
          p1[8 * s + 4] = p1[8 * s + 4] * C2 - g1.x; p1[8 * s + 5] = p1[8 * s + 5] * C2 - g1.y; p1[8 * s + 6] = p1[8 * s + 6] * C2 - g1.z; p1[8 * s + 7] = p1[8 * s + 7] * C2 - g1.w;
        }
      } else {
#pragma unroll
        for (int r = 0; r < 16; ++r) { p0[r] *= C2; p1[r] *= C2; }
      }
      if (k0 + 63 > qrow) {
        const int lim = qrow + c - k0 - 8 * hi;
        const float NEG = -__builtin_inff();
#pragma unroll
        for (int r = 0; r < 16; ++r) {
          const int kb = 16 * (r >> 3) + (r & 7);
          if (kb > lim) p0[r] = NEG;
          if (kb + 32 > lim) p1[r] = NEG;
        }
      }
      float mx = p0[0];
#pragma unroll
      for (int r = 1; r < 16; ++r) mx = fmaxf(mx, p0[r]);
#pragma unroll
      for (int r = 0; r < 16; ++r) mx = fmaxf(mx, p1[r]);
      {
        auto rr = __builtin_amdgcn_permlane32_swap(__float_as_uint(mx), __float_as_uint(mx), false, false);
        mx = fmaxf(__uint_as_float(rr[0]), __uint_as_float(rr[1]));
      }
      const float mn = fmaxf(m, mx);
      const float alpha = __builtin_amdgcn_exp2f(m - mn);
      m = mn;
      if (!__all(alpha == 1.f)) {
#pragma unroll
        for (int db = 0; db < 4; ++db)
#pragma unroll
          for (int r = 0; r < 16; ++r) o[db][r] *= alpha;
      }
      float ps = 0.f;
#pragma unroll
      for (int r = 0; r < 16; ++r) { p0[r] = __builtin_amdgcn_exp2f(p0[r] - mn); p1[r] = __builtin_amdgcn_exp2f(p1[r] - mn); ps += p0[r] + p1[r]; }
      l = l * alpha + ps;
      bf16x8 pa[2][2];
#pragma unroll
      for (int s = 0; s < 2; ++s) {
        u32x4 w0 = {pk2(p0[8 * s + 0], p0[8 * s + 1]), pk2(p0[8 * s + 2], p0[8 * s + 3]), pk2(p0[8 * s + 4], p0[8 * s + 5]), pk2(p0[8 * s + 6], p0[8 * s + 7])};
        u32x4 w1 = {pk2(p1[8 * s + 0], p1[8 * s + 1]), pk2(p1[8 * s + 2], p1[8 * s + 3]), pk2(p1[8 * s + 4], p1[8 * s + 5]), pk2(p1[8 * s + 6], p1[8 * s + 7])};
        pa[0][s] = *reinterpret_cast<bf16x8*>(&w0); pa[1][s] = *reinterpret_cast<bf16x8*>(&w1);
      }
#pragma unroll
      for (int db = 0; db < 4; ++db)
#pragma unroll
        for (int kb = 0; kb < 2; ++kb)
#pragma unroll
          for (int s = 0; s < 2; ++s) {
            const bf16x8 av = *(const bf16x8*)(sVc + db * 32 * VSTR + vo[kb][s]);
            o[db] = __builtin_amdgcn_mfma_f32_32x32x16_bf16(av, pa[kb][s], o[db], 0, 0, 0);
          }
    }
  }
  {
    auto rr = __builtin_amdgcn_permlane32_swap(__float_as_uint(l), __float_as_uint(l), false, false);
    const float inv = 1.f / (__uint_as_float(rr[0]) + __uint_as_float(rr[1]));
    const int b = bh >> 3, hh = bh & 7;
    u16* od = p.omix() + ((size_t)(b * S_ + qrow + c)) * 2048 + TYPE * 1024 + hh * 128 + 4 * hi;
#pragma unroll
    for (int db = 0; db < 4; ++db)
#pragma unroll
      for (int g = 0; g < 4; ++g)
        *(u32x2*)(od + 32 * db + 8 * g) = u32x2{pk2(o[db][4 * g] * inv, o[db][4 * g + 1] * inv), pk2(o[db][4 * g + 2] * inv, o[db][4 * g + 3] * inv)};
  }
}

__device__ void phase_attn(const Params& p, char* smem, int bid, int nb) {
  int* sItem = (int*)(smem + 60000);
  const int x = bid & 7;
  unsigned* q = p.ctr() + 32 + x;
  for (;;) {
    __syncthreads();
    if (TID() == 0) *sItem = (int)atomicAdd(q, 1u);
    __syncthreads();
    const int item = *sItem;
    if (item >= 128) break;
    const int qb = 31 - (item >> 2), r = item & 3, type = r >> 1, bh = x + 8 * (r & 1);
    if (type == 0) attn_item<0>(p, smem, bh, qb); else attn_item<1>(p, smem, bh, qb);
  }
}

__device__ void phase_outproj(const Params& p, char* smem, int bid, int nb) {
  const int ntiles = 64 * 16;
  for (int t = vblock(bid, nb); t < ntiles; t += nb) {
    int tm, tn; tile_rc(t, 16, tm, tn);
    gemm128(p.omix(), D_, p.WoutT(), D_, D_, tm * 128, tn * 128, smem,
      [&](f32x4 (&acc)[4][4], int row0, int col0, int fr, int fq) {
#pragma unroll
        for (int m = 0; m < 4; ++m)
#pragma unroll
          for (int n = 0; n < 4; ++n)
#pragma unroll
            for (int j = 0; j < 4; ++j) {
              const size_t idx = (size_t)(row0 + m * 16 + fq * 4 + j) * D_ + col0 + n * 16 + fr;
              p.y1()[idx] = ALPHA * p.x[idx] + acc[m][n][j];
            }
      });
  }
}

__device__ void phase_ln1(const Params& p, int bid, int nb) {
  const int lane = TID() & 63, wid = TID() >> 6;
  for (int t = bid * 4 + wid; t < T_; t += nb * 4) {
    float* row = p.y1() + (size_t)t * D_;
    float4 v[8];
    float sum = 0.f;
#pragma unroll
    for (int i = 0; i < 8; ++i) { v[i] = *(const float4*)(row + (i * 64 + lane) * 4); sum += (v[i].x + v[i].y) + (v[i].z + v[i].w); }
    const float mu = wave_sum(sum) * (1.f / D_);
    float sq = 0.f;
#pragma unroll
    for (int i = 0; i < 8; ++i) {
      v[i].x -= mu; v[i].y -= mu; v[i].z -= mu; v[i].w -= mu;
      sq += (v[i].x * v[i].x + v[i].y * v[i].y) + (v[i].z * v[i].z + v[i].w * v[i].w);
    }
    const float rstd = rsqrtf(wave_sum(sq) * (1.f / D_) + EPS);
#pragma unroll
    for (int i = 0; i < 8; ++i) {
      const int c = (i * 64 + lane) * 4;
      const float4 g = *(const float4*)(p.ln1_g + c), bb = *(const float4*)(p.ln1_b + c);
      float4 o; o.x = v[i].x * rstd * g.x + bb.x; o.y = v[i].y * rstd * g.y + bb.y; o.z = v[i].z * rstd * g.z + bb.z; o.w = v[i].w * rstd * g.w + bb.w;
      *(float4*)(row + c) = o;
      *(u32x2*)(p.h1b() + (size_t)t * D_ + c) = u32x2{pk2(o.x, o.y), pk2(o.z, o.w)};
    }
  }
}

__device__ __forceinline__ void ins16(unsigned (&t)[16], unsigned x) {
#pragma unroll
  for (int i = 0; i < 16; ++i) { const unsigned hi = t[i] > x ? t[i] : x; x = t[i] > x ? x : t[i]; t[i] = hi; }
}
__device__ __forceinline__ void ins16p(unsigned (&ck)[16], int (&ce)[16], unsigned x, int xe) {
#pragma unroll
  for (int i = 0; i < 16; ++i) {
    const bool sw = x > ck[i];
    const unsigned nk = sw ? x : ck[i], nx = sw ? ck[i] : x;
    const int ne = sw ? xe : ce[i], nxe = sw ? ce[i] : xe;
    ck[i] = nk; x = nx; ce[i] = ne; xe = nxe;
  }
}
__device__ __forceinline__ float unordkey(unsigned k) { return __uint_as_float((k & 0x80000000u) ? (k & 0x7fffffffu) : ~k); }

__device__ __forceinline__ void route_tile(const Params& p, char* smem, f32x4 (&acc)[4][4], int tm, int h) {
  const int tid = TID(), wid = tid >> 6, lane = tid & 63, wr = wid >> 1, wc = wid & 1, fr = lane & 15, fq = lane >> 4;
  __syncthreads();
  float* Qw = (float*)smem + wid * (64 * 65);
#pragma unroll
  for (int m = 0; m < 4; ++m)
#pragma unroll
    for (int n = 0; n < 4; ++n)
#pragma unroll
      for (int j = 0; j < 4; ++j) Qw[(m * 16 + fq * 4 + j) * 65 + n * 16 + fr] = acc[m][n][j];
  asm volatile("s_waitcnt lgkmcnt(0)" ::: "memory");
  float q[64];
#pragma unroll
  for (int d = 0; d < 64; ++d) q[d] = Qw[lane * 65 + d];
  __syncthreads();
  {
    float* ks = (float*)smem;
#pragma unroll
    for (int i = 0; i < 16; ++i) {
      const int idx = (i * 256 + tid) * 4;
      const float* src = (idx < 8192 ? p.keys1 : p.keys2) + (size_t)h * 8192 + (idx & 8191);
      *(float4*)(ks + idx) = *(const float4*)src;
    }
  }
  __syncthreads();
  unsigned t[16];
#pragma unroll
  for (int i = 0; i < 16; ++i) t[i] = 0u;
  {
    const float* kb = (const float*)smem + wc * 8192;
#pragma unroll 1
    for (int n = 0; n < 128; ++n) {
      float d0 = 0.f, d1 = 0.f, d2 = 0.f, d3 = 0.f;
#pragma unroll
      for (int i = 0; i < 16; ++i) {
        const float4 kv = *(const float4*)(kb + n * 64 + i * 4);
        d0 += kv.x * q[4 * i]; d1 += kv.y * q[4 * i + 1]; d2 += kv.z * q[4 * i + 2]; d3 += kv.w * q[4 * i + 3];
      }
      const float sc = (d0 + d1) + (d2 + d3);
      ins16(t, (ordkey(sc) & ~127u) | (unsigned)(127 - n));
    }
  }
  __syncthreads();
  unsigned* L = (unsigned*)smem;
#pragma unroll
  for (int r = 0; r < 16; ++r) L[(wc * 16 + r) * 128 + wr * 64 + lane] = t[r];
  __syncthreads();
  if (wid < 2) {
    const int tok = wid * 64 + lane;
    unsigned ck[16]; int ce[16];
#pragma unroll
    for (int i = 0; i < 16; ++i) { ck[i] = 0u; ce[i] = 0; }
#pragma unroll 1
    for (int a = 0; a < 16; ++a) {
      const unsigned ka = L[a * 128 + tok];
      const int i1a = (127 - (int)(ka & 127u)) * 128; const float v1a = unordkey(ka & ~127u);
      const int nbm1 = (int)((0x1112347FULL >> (4 * a)) & 15ULL);
#pragma unroll 1
      for (int b = 0; b <= nbm1; ++b) {
        const unsigned kb = L[(16 + b) * 128 + tok];
        const int i2b = 127 - (int)(kb & 127u); const float v2b = unordkey(kb & ~127u);
        ins16p(ck, ce, ordkey(v1a + v2b), i1a + i2b);
      }
    }
    float ex[16], sum = 0.f;
    const float mx = unordkey(ck[0]);
#pragma unroll
    for (int r = 0; r < 16; ++r) { ex[r] = __expf(unordkey(ck[r]) - mx); sum += ex[r]; }
    const float inv = 1.f / sum;
    const size_t o = ((size_t)(tm * 128 + tok) * 8 + h) * 16;
    int* ed = p.eidxG() + o; float* gd = p.gateG() + o;
#pragma unroll
    for (int r = 0; r < 16; r += 4) {
      *(int4*)(ed + r) = make_int4(ce[r], ce[r + 1], ce[r + 2], ce[r + 3]);
      *(float4*)(gd + r) = make_float4(ex[r] * inv, ex[r + 1] * inv, ex[r + 2] * inv, ex[r + 3] * inv);
    }
  }
}

__device__ void phase_mid(const Params& p, char* smem, int bid, int nb) {
  const int ng = 64 * 16, nq = 64 * 8;
  for (int t = vblock(bid, nb); t < ng + nq; t += nb) {
    if (t < ng) {
      int tm, tn; tile_rc(t, 16, tm, tn);
      f32x4 pacc[4][4], acc[4][4];
      gemm_core(p.pb(), 256, p.WpT(), 256, 256, tm * 128, tn * 128, smem, pacc);
      gemm_core(p.h1b(), D_, p.WgT(), D_, D_, tm * 128, tn * 128, smem, acc);
      {
        const int tid = TID(), wid = tid >> 6, lane = tid & 63, wr = wid >> 1, wc = wid & 1, fr = lane & 15, fq = lane >> 4;
        const size_t base = (size_t)(tm * 128 + wr * 64 + fq * 4) * D_ + tn * 128 + wc * 64 + fr;
        const float* yb = p.y1() + base;
        float* ob = p.out + base;
#pragma unroll
        for (int m = 0; m < 4; ++m) {
#pragma unroll
          for (int n = 0; n < 4; ++n)
#pragma unroll
            for (int j = 0; j < 4; ++j) {
              const int o = (m * 16 + j) * D_ + n * 16;
              const float sg = 1.f / (1.f + __expf(-acc[m][n][j]));
              ob[o] = ALPHA * yb[o] + pacc[m][n][j] * sg;
            }
        }
      }
    } else {
      int tm, tn; tile_rc(t - ng, 8, tm, tn);
      f32x4 acc[4][4];
      gemm_core(p.h1b(), D_, p.WpqT(), D_, D_, tm * 128, tn * 128, smem, acc);
      route_tile(p, smem, acc, tm, tn);
    }
  }
}

__device__ __forceinline__ float gelu_exact(float a) {
  const float x = fabsf(a) * 0.7071067811865476f;
  const float t = __builtin_amdgcn_rcpf(1.f + 0.3275911f * x);
  const float poly = t * (0.254829592f + t * (-0.284496736f + t * (1.421413741f + t * (-1.453152027f + t * 1.061405429f))));
  const float er = 1.f - poly * __expf(-x * x);
  return 0.5f * a * (1.f + (a < 0.f ? -er : er));
}

template <int NPER, int IDXMASK>
__device__ __forceinline__ int top16(unsigned (&k)[NPER], int lane) {
  int mine = 0;
#pragma unroll 1
  for (int r = 0; r < 16; ++r) {
    unsigned loc = k[0];
#pragma unroll
    for (int i = 1; i < NPER; ++i) loc = loc > k[i] ? loc : k[i];
    const unsigned best = wave_umax(loc);
#pragma unroll
    for (int i = 0; i < NPER; ++i) if (k[i] == best) k[i] = 0u;
    if (lane == r) mine = IDXMASK - (int)(best & (unsigned)IDXMASK);
  }
  return mine;
}

__device__ void phase_peer(const Params& p, char* smem, int bid, int nb) {
  const int tid = TID(), lane = tid & 63, wid = tid >> 6;
  float* qs = (float*)smem;
  float* sc = (float*)(smem + 8192);
  int* eidx = (int*)(smem + 24576);
  float* gts = (float*)(smem + 32768);
  for (int it = bid; it < T_ / 16; it += nb) {
    const int t0 = it * 16;
#pragma unroll
    for (int i = 0; i < 2; ++i) {
      const int idx = (i * 256 + tid) * 4;
      *(int4*)(eidx + idx) = *(const int4*)(p.eidxG() + (size_t)t0 * 128 + idx);
      *(float4*)(gts + idx) = *(const float4*)(p.gateG() + (size_t)t0 * 128 + idx);
    }
    __syncthreads();
    for (int ti = 0; ti < 4; ++ti) {
      const int tok = wid * 4 + ti, t = t0 + tok;
      typedef float f32x2 __attribute__((ext_vector_type(2)));
      float hreg[32], o[32];
#pragma unroll
      for (int c = 0; c < 2; ++c)
#pragma unroll
        for (int q = 0; q < 2; ++q) {
          const u32x4 hv = *(const u32x4*)(p.h1b() + (size_t)t * D_ + (c * 64 + lane) * 16 + q * 8);
#pragma unroll
          for (int w = 0; w < 4; ++w) { hreg[c * 16 + q * 8 + 2 * w] = bflo(hv[w]); hreg[c * 16 + q * 8 + 2 * w + 1] = bfhi(hv[w]); }
        }
#pragma unroll
      for (int i = 0; i < 32; ++i) o[i] = 0.f;
      const float* Us = p.Us(); const float* Vs = p.Vs();
      const unsigned char* Uq = p.Uq() + lane * 16; const unsigned char* Vq = p.Vq() + lane * 16;
      const int* ep = eidx + tok * 128; const float* gp = gts + tok * 128;
      u32x4 urA[2][2], vrA[2][2], urB[2][2], vrB[2][2];
      float gA[2], suA[2], svA[2], gB[2], suB[2], svB[2];
#define PEER_LOAD(UR, VR, G, SU, SV, J0)                                                              \
      _Pragma("unroll") for (int jj = 0; jj < 2; ++jj) {                                                \
        const int e = __builtin_amdgcn_readfirstlane(ep[(J0) + jj]);                                    \
        G[jj] = gp[(J0) + jj]; SU[jj] = Us[e]; SV[jj] = Vs[e];                                          \
        const unsigned char* up = Uq + (size_t)e * D_; const unsigned char* vp = Vq + (size_t)e * D_;   \
        UR[jj][0] = *(const u32x4*)(up); UR[jj][1] = *(const u32x4*)(up + 1024);                        \
        VR[jj][0] = *(const u32x4*)(vp); VR[jj][1] = *(const u32x4*)(vp + 1024);                        \
      }
#define PEER_COMPUTE(UR, VR, G, SU, SV)                                                                 \
      _Pragma("unroll") for (int jj = 0; jj < 2; ++jj) {                                                \
        float d0 = 0.f, d1 = 0.f;                                                                       \
        _Pragma("unroll") for (int c = 0; c < 2; ++c)                                                   \
          _Pragma("unroll") for (int w = 0; w < 4; ++w) {                                               \
            const f32x2 lo = __builtin_amdgcn_cvt_pk_f32_fp8(UR[jj][c][w], false), hi2 = __builtin_amdgcn_cvt_pk_f32_fp8(UR[jj][c][w], true); \
            d0 += lo[0] * hreg[c * 16 + 4 * w]; d1 += lo[1] * hreg[c * 16 + 4 * w + 1];                \
            d0 += hi2[0] * hreg[c * 16 + 4 * w + 2]; d1 += hi2[1] * hreg[c * 16 + 4 * w + 3];          \
          }                                                                                             \
        const float av = wave_sum(d0 + d1) * SU[jj];                                                    \
        const float act = gelu_exact(av) * G[jj] * SV[jj];                                              \
        _Pragma("unroll") for (int c = 0; c < 2; ++c)                                                   \
          _Pragma("unroll") for (int w = 0; w < 4; ++w) {                                               \
            const f32x2 lo = __builtin_amdgcn_cvt_pk_f32_fp8(VR[jj][c][w], false), hi2 = __builtin_amdgcn_cvt_pk_f32_fp8(VR[jj][c][w], true); \
            o[c * 16 + 4 * w] += act * lo[0]; o[c * 16 + 4 * w + 1] += act * lo[1];                    \
            o[c * 16 + 4 * w + 2] += act * hi2[0]; o[c * 16 + 4 * w + 3] += act * hi2[1];              \
          }                                                                                             \
      }
      PEER_LOAD(urA, vrA, gA, suA, svA, 0)
#pragma unroll 1
      for (int j0 = 0; j0 < 128; j0 += 4) {
        PEER_LOAD(urB, vrB, gB, suB, svB, j0 + 2)
        PEER_COMPUTE(urA, vrA, gA, suA, svA)
        if (j0 + 4 < 128) { PEER_LOAD(urA, vrA, gA, suA, svA, j0 + 4) }
        PEER_COMPUTE(urB, vrB, gB, suB, svB)
      }
#undef PEER_LOAD
#undef PEER_COMPUTE
      float* orow = p.out + (size_t)t * D_;
      float sum = 0.f;
#pragma unroll
      for (int c = 0; c < 2; ++c)
#pragma unroll
        for (int q = 0; q < 4; ++q) {
          const float4 r0 = *(const float4*)(orow + (c * 64 + lane) * 16 + q * 4);
          o[c * 16 + q * 4 + 0] += r0.x; o[c * 16 + q * 4 + 1] += r0.y; o[c * 16 + q * 4 + 2] += r0.z; o[c * 16 + q * 4 + 3] += r0.w;
        }
#pragma unroll
      for (int i = 0; i < 32; ++i) sum += o[i];
      const float mu = wave_sum(sum) * (1.f / D_);
      float sq = 0.f;
#pragma unroll
      for (int i = 0; i < 32; ++i) { o[i] -= mu; sq += o[i] * o[i]; }
      const float rstd = rsqrtf(wave_sum(sq) * (1.f / D_) + EPS);
#pragma unroll
      for (int c = 0; c < 2; ++c)
#pragma unroll
        for (int q = 0; q < 4; ++q) {
          const int col = (c * 64 + lane) * 16 + q * 4;
          const float4 g0 = *(const float4*)(p.ln2_g + col), b0 = *(const float4*)(p.ln2_b + col);
          float4 w0;
          w0.x = o[c * 16 + q * 4 + 0] * rstd * g0.x + b0.x; w0.y = o[c * 16 + q * 4 + 1] * rstd * g0.y + b0.y;
          w0.z = o[c * 16 + q * 4 + 2] * rstd * g0.z + b0.z; w0.w = o[c * 16 + q * 4 + 3] * rstd * g0.w + b0.w;
          *(float4*)(orow + col) = w0;
        }
    }
    __syncthreads();
  }
}

template <int PH>
__device__ __forceinline__ void run_phase(const Params& p, char* smem, int bid, int nb) {
  if constexpr (PH == 0) phase_prep(p, smem, bid, nb);
  if constexpr (PH == 1) phase_inproj(p, smem, bid, nb);
  if constexpr (PH == 2) phase_up(p, smem, bid, nb);
#ifdef ATTN_NAIVE
  if constexpr (PH == 3) phase_attn_naive(p, smem, bid, nb);
#else
  if constexpr (PH == 3) phase_attn(p, smem, bid, nb);
#endif
  if constexpr (PH == 4) phase_outproj(p, smem, bid, nb);
  if constexpr (PH == 5) phase_ln1(p, bid, nb);
  if constexpr (PH == 6) phase_mid(p, smem, bid, nb);
  if constexpr (PH == 7) phase_peer(p, smem, bid, nb);
}

template <int PH>
__global__ void __launch_bounds__(256, 2) phase_kernel(Params p) {
  __shared__ __attribute__((aligned(16))) char smem[SMEM_BYTES];
  run_phase<PH>(p, smem, blockIdx.x, gridDim.x);
}

__device__ __forceinline__ void grid_barrier(unsigned* ctr, unsigned target) {
  asm volatile("s_waitcnt vmcnt(0)" ::: "memory");
  __syncthreads();
  if (threadIdx.x == 0) {
    __builtin_amdgcn_fence(__ATOMIC_RELEASE, "agent");
    asm volatile("s_waitcnt vmcnt(0)" ::: "memory");
    __hip_atomic_fetch_add(ctr, 1u, __ATOMIC_RELAXED, __HIP_MEMORY_SCOPE_AGENT);
    while (__hip_atomic_load(ctr, __ATOMIC_RELAXED, __HIP_MEMORY_SCOPE_AGENT) < target) __builtin_amdgcn_s_sleep(2);
    __builtin_amdgcn_fence(__ATOMIC_ACQUIRE, "agent");
    asm volatile("s_waitcnt vmcnt(0)" ::: "memory");
  }
  __syncthreads();
}

#if SINGLE_LAUNCH
typedef const __attribute__((address_space(4))) unsigned long long* kargp_t;
static_assert(sizeof(Params) % 8 == 0, "Params must be a pack of 8-byte fields");
#define RUN_PHASE(N)                                                                        \
  {                                                                                         \
    kargp_t q = (kargp_t)__builtin_amdgcn_kernarg_segment_ptr();                            \
    asm volatile("" : "+s"(q));                                                             \
    Params lp;                                                                              \
    unsigned long long* d = (unsigned long long*)&lp;                                       \
    _Pragma("unroll") for (int i = 0; i < (int)(sizeof(Params) / 8); ++i) d[i] = q[i];      \
    run_phase<N>(lp, smem, bid, nb);                                                        \
  }
__global__ void __launch_bounds__(256, 2) fwd_kernel(Params p_) {
  __shared__ __attribute__((aligned(16))) char smem[SMEM_BYTES];
  const int bid = blockIdx.x, nb = gridDim.x;
  unsigned* bar = (unsigned*)(p_.ws + O_CTR) + 16;
  if (p_.out == nullptr) cg::this_grid().sync();
  const unsigned nbu = (unsigned)nb;
  RUN_PHASE(0) grid_barrier(bar, 1u * nbu);
  RUN_PHASE(1) grid_barrier(bar, 2u * nbu);
  RUN_PHASE(2) grid_barrier(bar, 3u * nbu);
  RUN_PHASE(3) grid_barrier(bar, 4u * nbu);
  RUN_PHASE(4) grid_barrier(bar, 5u * nbu);
  RUN_PHASE(5) grid_barrier(bar, 6u * nbu);
  RUN_PHASE(6) grid_barrier(bar, 7u * nbu);
  RUN_PHASE(7)
}
#endif

extern "C" void kernel_launch(void* const* d_in, const int* in_sizes, int n_in, void* d_out, int out_size,
                              void* d_ws, size_t ws_size, hipStream_t stream) {
  (void)in_sizes; (void)n_in; (void)out_size; (void)ws_size;
  Params p{};
  p.x = (const float*)d_in[0]; p.p = (const float*)d_in[1]; p.positions = (const int*)d_in[2];
  p.w_in = (const float*)d_in[3]; p.b_forget = (const float*)d_in[4]; p.g_q = (const float*)d_in[5];
  p.w_uq = (const float*)d_in[6]; p.g_kv = (const float*)d_in[7]; p.w_ukv = (const float*)d_in[8];
  p.w_out = (const float*)d_in[9]; p.ln1_g = (const float*)d_in[10]; p.ln1_b = (const float*)d_in[11];
  p.peer_wq = (const float*)d_in[12]; p.keys1 = (const float*)d_in[13]; p.keys2 = (const float*)d_in[14];
  p.peer_u = (const float*)d_in[15]; p.peer_v = (const float*)d_in[16]; p.wgate = (const float*)d_in[17];
  p.wproj = (const float*)d_in[18]; p.ln2_g = (const float*)d_in[19]; p.ln2_b = (const float*)d_in[20];
  p.out = (float*)d_out;
  p.ws = (char*)d_ws;

  static int grid_blocks = 0;
  if (!grid_blocks) {
    int dev = 0, cus = 0, per_cu = 0;
    (void)hipGetDevice(&dev);
    (void)hipDeviceGetAttribute(&cus, hipDeviceAttributeMultiprocessorCount, dev);
#if SINGLE_LAUNCH
    (void)hipOccupancyMaxActiveBlocksPerMultiprocessor(&per_cu, fwd_kernel, 256, 0);
#else
    per_cu = 2;
#endif
    if (per_cu > 2) per_cu = 2;
    if (per_cu < 1) per_cu = 1;
    grid_blocks = cus * per_cu;
  }
#if SINGLE_LAUNCH
  (void)hipMemsetAsync(d_ws, 0, 256, stream);
  void* args[] = {&p};
  hipError_t e = hipLaunchCooperativeKernel((void*)fwd_kernel, dim3(grid_blocks), dim3(256), args, 0, stream);
  if (e != hipSuccess) fprintf(stderr, "cooperative launch failed: %s (grid %d)\n", hipGetErrorString(e), grid_blocks);
#else
  phase_kernel<0><<<grid_blocks, 256, 0, stream>>>(p);
  phase_kernel<1><<<grid_blocks, 256, 0, stream>>>(p);
  phase_kernel<2><<<grid_blocks, 256, 0, stream>>>(p);
  phase_kernel<3><<<grid_blocks, 256, 0, stream>>>(p);
  phase_kernel<4><<<grid_blocks, 256, 0, stream>>>(p);
  phase_kernel<5><<<grid_blocks, 256, 0, stream>>>(p);
  phase_kernel<6><<<grid_blocks, 256, 0, stream>>>(p);
  phase_kernel<7><<<grid_blocks, 256, 0, stream>>>(p);
#endif
}
```

```cpp
#include <hip/hip_runtime.h>
#include <hip/hip_bf16.h>
#include <hip/hip_cooperative_groups.h>
#include <stdint.h>
#include <cstdio>
namespace cg = cooperative_groups;

typedef unsigned short u16;
typedef short bf16x8 __attribute__((ext_vector_type(8)));
typedef float f32x4 __attribute__((ext_vector_type(4)));
typedef unsigned u32x4 __attribute__((ext_vector_type(4)));
typedef unsigned u32x2 __attribute__((ext_vector_type(2)));

#ifndef SINGLE_LAUNCH
#define SINGLE_LAUNCH 1
#endif

constexpr int T_ = 8192, D_ = 2048, S_ = 4096, NB_ = 2;
constexpr int INW = 4168;
constexpr int NPH = 8;
constexpr float ALPHA = 1.189207115002721f;
constexpr float EPS = 1e-6f;
constexpr int SMEM_BYTES = 65536 + 1024;

constexpr size_t al256(size_t x) { return (x + 255) & ~(size_t)255; }
constexpr size_t O_CTR = 0;
constexpr size_t O_WINT = O_CTR + 16384;
constexpr size_t O_WUQT = O_WINT + al256((size_t)4224 * 2048 * 2);
constexpr size_t O_WUKVT = O_WUQT + al256((size_t)1536 * 512 * 2);
constexpr size_t O_WOUTT = O_WUKVT + al256((size_t)2048 * 512 * 2);
constexpr size_t O_WPQT = O_WOUTT + al256((size_t)2048 * 2048 * 2);
constexpr size_t O_WGT = O_WPQT + al256((size_t)1024 * 2048 * 2);
constexpr size_t O_WPT = O_WGT + al256((size_t)2048 * 2048 * 2);
constexpr size_t O_PB = O_WPT + al256((size_t)2048 * 256 * 2);
constexpr size_t O_UB = O_PB + al256((size_t)8192 * 256 * 2);
constexpr size_t O_VB = O_UB + 2048;
constexpr size_t O_OMIX = O_UB + al256((size_t)16384 * 4096);
constexpr size_t O_CS = O_OMIX + al256((size_t)8192 * 2048 * 2);
constexpr size_t O_US = O_CS + al256((size_t)8192 * 32 * 8);
constexpr size_t O_VS = O_US + al256((size_t)16384 * 4);
constexpr size_t O_REGB = O_VS + al256((size_t)16384 * 4);
constexpr size_t O_XB = O_REGB;
constexpr size_t O_CQB = O_XB + al256((size_t)8192 * 2048 * 2);
constexpr size_t O_CKVB = O_CQB + al256((size_t)8192 * 512 * 2);
constexpr size_t O_QM = O_CKVB + al256((size_t)8192 * 512 * 2);
constexpr size_t O_KM = O_QM + al256((size_t)8192 * 8 * 192 * 2);
constexpr size_t O_VMT = O_KM + al256((size_t)8192 * 8 * 192 * 2);
constexpr size_t O_QF = O_VMT + al256((size_t)8192 * 8 * 128 * 2);
constexpr size_t O_KF = O_QF + al256((size_t)8192 * 8 * 128 * 2);
constexpr size_t O_VFT = O_KF + al256((size_t)8192 * 8 * 128 * 2);
constexpr size_t O_LOGF = O_VFT + al256((size_t)8192 * 8 * 128 * 2);
constexpr size_t O_FK = O_LOGF + al256((size_t)16 * 4096 * 4);
constexpr size_t O_ENDB = O_FK + al256((size_t)16 * 4096 * 4);
constexpr size_t O_Y1 = O_REGB;
constexpr size_t O_H1B = O_Y1 + al256((size_t)8192 * 2048 * 4);
constexpr size_t O_PQ = O_H1B + al256((size_t)8192 * 2048 * 2);
constexpr size_t O_GATE = O_PQ + al256((size_t)8192 * 128 * 4);
constexpr size_t O_ENDB2 = O_GATE + al256((size_t)8192 * 128 * 4);
static_assert(O_ENDB2 <= O_ENDB, "region B reuse overflow");
static_assert(O_ENDB <= (size_t)500 * 1024 * 1024, "workspace too large");

struct Params {
  const float *x, *p; const int* positions;
  const float *w_in, *b_forget, *g_q, *w_uq, *g_kv, *w_ukv, *w_out, *ln1_g, *ln1_b;
  const float *peer_wq, *keys1, *keys2, *peer_u, *peer_v, *wgate, *wproj, *ln2_g, *ln2_b;
  float* out;
  char* ws;
#define WSP(type, name, off) __device__ __forceinline__ type* name() const { return (type*)(ws + (off)); }
  WSP(unsigned, ctr, O_CTR) WSP(u16, WinT, O_WINT) WSP(u16, WuqT, O_WUQT) WSP(u16, WukvT, O_WUKVT) WSP(u16, WoutT, O_WOUTT)
  WSP(u16, WpqT, O_WPQT) WSP(u16, WgT, O_WGT) WSP(u16, WpT, O_WPT) WSP(u16, pb, O_PB) WSP(unsigned char, Uq, O_UB) WSP(unsigned char, Vq, O_VB) WSP(float, Us, O_US) WSP(float, Vs, O_VS)
  WSP(u16, omix, O_OMIX) WSP(float2, cs, O_CS)
  WSP(u16, xb, O_XB) WSP(u16, cqb, O_CQB) WSP(u16, ckvb, O_CKVB) WSP(u16, Qm, O_QM) WSP(u16, Km, O_KM) WSP(u16, VmT, O_VMT)
  WSP(u16, Qf, O_QF) WSP(u16, Kf, O_KF) WSP(u16, VfT, O_VFT) WSP(float, logf, O_LOGF) WSP(float, Fk, O_FK)
  WSP(float, y1, O_Y1) WSP(u16, h1b, O_H1B) WSP(int, eidxG, O_PQ) WSP(float, gateG, O_GATE)
#undef WSP
};

__device__ __forceinline__ int TID() { int t = threadIdx.x; asm volatile("" : "+v"(t)); return t; }
__device__ __forceinline__ unsigned pk2(float lo, float hi) {
  unsigned r; asm volatile("v_cvt_pk_bf16_f32 %0, %1, %2" : "=v"(r) : "v"(lo), "v"(hi)); return r;
}
__device__ __forceinline__ u16 f2bf(float f) { return (u16)(pk2(f, 0.f) & 0xffffu); }
__device__ __forceinline__ float bf2f(u16 v) { return __uint_as_float(((unsigned)v) << 16); }
__device__ __forceinline__ float bflo(unsigned v) { return __uint_as_float(v << 16); }
__device__ __forceinline__ float bfhi(unsigned v) { return __uint_as_float(v & 0xffff0000u); }

template <int CTRL> __device__ __forceinline__ int dppi(int v) { return __builtin_amdgcn_update_dpp(0, v, CTRL, 0xF, 0xF, false); }
template <int CTRL> __device__ __forceinline__ float dppf(float v) { return __int_as_float(dppi<CTRL>(__float_as_int(v))); }
__device__ __forceinline__ float rdlane(float v, int l) { return __int_as_float(__builtin_amdgcn_readlane(__float_as_int(v), l)); }

__device__ __forceinline__ float row_sum(float v) {
  v += dppf<0xB1>(v); v += dppf<0x4E>(v); v += dppf<0x141>(v); v += dppf<0x140>(v); return v;
}
__device__ __forceinline__ float row_max(float v) {
  v = fmaxf(v, dppf<0xB1>(v)); v = fmaxf(v, dppf<0x4E>(v)); v = fmaxf(v, dppf<0x141>(v)); v = fmaxf(v, dppf<0x140>(v)); return v;
}
__device__ __forceinline__ float wave_sum(float v) {
  v = row_sum(v);
  return (rdlane(v, 0) + rdlane(v, 16)) + (rdlane(v, 32) + rdlane(v, 48));
}
__device__ __forceinline__ float wave_max(float v) {
  v = row_max(v);
  return fmaxf(fmaxf(rdlane(v, 0), rdlane(v, 16)), fmaxf(rdlane(v, 32), rdlane(v, 48)));
}
__device__ __forceinline__ unsigned wave_umax(unsigned v) {
  unsigned t;
  t = (unsigned)dppi<0xB1>((int)v); v = v > t ? v : t;
  t = (unsigned)dppi<0x4E>((int)v); v = v > t ? v : t;
  t = (unsigned)dppi<0x141>((int)v); v = v > t ? v : t;
  t = (unsigned)dppi<0x140>((int)v); v = v > t ? v : t;
  unsigned a = (unsigned)__builtin_amdgcn_readlane((int)v, 0), b = (unsigned)__builtin_amdgcn_readlane((int)v, 16);
  unsigned c = (unsigned)__builtin_amdgcn_readlane((int)v, 32), d = (unsigned)__builtin_amdgcn_readlane((int)v, 48);
  a = a > b ? a : b; c = c > d ? c : d; return a > c ? a : c;
}
__device__ __forceinline__ unsigned ordkey(float f) {
  unsigned u = __float_as_uint(f);
  return (u & 0x80000000u) ? ~u : (u | 0x80000000u);
}

__device__ __forceinline__ void quant_chunk(const Params& p, int chunk) {
  const int tid = TID(), lane = tid & 63, wid = tid >> 6;
#pragma unroll 1
  for (int i16 = 0; i16 < 16; ++i16) {
    const int r = chunk * 64 + wid * 16 + i16;
    const int tab = r >> 14, row = r & 16383;
    const float* src = (tab ? p.peer_v : p.peer_u) + (size_t)row * D_;
    unsigned* dst = (unsigned*)((tab ? p.Vq() : p.Uq()) + (size_t)row * 4096);
    float4 v[8];
    float am = 0.f;
#pragma unroll
    for (int i = 0; i < 8; ++i) {
      v[i] = *(const float4*)(src + (i * 64 + lane) * 4);
      am = fmaxf(am, fmaxf(fmaxf(fabsf(v[i].x), fabsf(v[i].y)), fmaxf(fabsf(v[i].z), fabsf(v[i].w))));
    }
    am = wave_max(am);
    const float qs = am > 0.f ? 224.f / am : 1.f;
#pragma unroll
    for (int i = 0; i < 8; ++i) {
      unsigned w = __builtin_amdgcn_cvt_pk_fp8_f32(v[i].x * qs, v[i].y * qs, 0, false);
      w = __builtin_amdgcn_cvt_pk_fp8_f32(v[i].z * qs, v[i].w * qs, w, true);
      dst[i * 64 + lane] = w;
    }
    if (lane == 0) (tab ? p.Vs() : p.Us())[row] = am > 0.f ? am / 224.f : 1.f;
  }
}

__device__ void transpose_cvt(const float* __restrict__ W, int ldw, int K, int src_col0, int ncols,
                              u16* __restrict__ WT, int dst_row0, const float* __restrict__ kscale,
                              float* tile, int bid, int nb) {
  const int tiles_k = K / 64, tiles_n = ncols / 64, tid = TID();
#pragma unroll 1
  for (int t = bid; t < tiles_k * tiles_n; t += nb) {
    const int tk = t % tiles_k, tn = t / tiles_k, k0 = tk * 64, n0 = tn * 64;
#pragma unroll
    for (int i = 0; i < 4; ++i) {
      const int r = (tid >> 4) + 16 * i, c = (tid & 15) * 4;
      const float4 v = *(const float4*)(W + (size_t)(k0 + r) * ldw + src_col0 + n0 + c);
      const float sc = kscale ? kscale[k0 + r] : 1.f;
      tile[r * 65 + c + 0] = v.x * sc; tile[r * 65 + c + 1] = v.y * sc;
      tile[r * 65 + c + 2] = v.z * sc; tile[r * 65 + c + 3] = v.w * sc;
    }
    __syncthreads();
    {
      const int n = tid >> 2, kk = (tid & 3) * 16;
      unsigned w[8];
#pragma unroll
      for (int e = 0; e < 8; ++e) w[e] = pk2(tile[(kk + 2 * e) * 65 + n], tile[(kk + 2 * e + 1) * 65 + n]);
      u32x4* dst = (u32x4*)(WT + (size_t)(dst_row0 + n0 + n) * K + k0 + kk);
      dst[0] = u32x4{w[0], w[1], w[2], w[3]};
      dst[1] = u32x4{w[4], w[5], w[6], w[7]};
    }
    __syncthreads();
  }
}

__device__ void cvt_bf16(const float* __restrict__ src, u16* __restrict__ dst, size_t n8, size_t gtid, size_t gthreads) {
  for (size_t i = gtid; i < n8; i += gthreads) {
    const float4 a = ((const float4*)src)[2 * i], b = ((const float4*)src)[2 * i + 1];
    ((u32x4*)dst)[i] = u32x4{pk2(a.x, a.y), pk2(a.z, a.w), pk2(b.x, b.y), pk2(b.z, b.w)};
  }
}

__device__ void phase_prep(const Params& p, char* smem, int bid, int nb) {
  const int tid = TID(), lane = tid & 63, wid = tid >> 6;
  float* tile = (float*)smem;
  if (bid == 0 && tid == 0) p.ctr()[0] = 0;
  transpose_cvt(p.w_in, INW, D_, 0, 1024, p.WinT(), 0, nullptr, tile, bid, nb);
  transpose_cvt(p.w_in, INW, D_, 1088, 3072, p.WinT(), 1024, nullptr, tile, bid, nb);
  transpose_cvt(p.w_in, INW, D_, 1024, 64, p.WinT(), 4096, nullptr, tile, bid, nb);
  transpose_cvt(p.w_uq, 1536, 512, 0, 1536, p.WuqT(), 0, p.g_q, tile, bid, nb);
  transpose_cvt(p.w_ukv, 2048, 512, 0, 2048, p.WukvT(), 0, p.g_kv, tile, bid, nb);
  transpose_cvt(p.w_out, 2048, 2048, 0, 2048, p.WoutT(), 0, nullptr, tile, bid, nb);
  transpose_cvt(p.peer_wq, 1024, 2048, 0, 1024, p.WpqT(), 0, nullptr, tile, bid, nb);
  transpose_cvt(p.wgate, 2048, 2048, 0, 2048, p.WgT(), 0, nullptr, tile, bid, nb);
  transpose_cvt(p.wproj, 2048, 256, 0, 2048, p.WpT(), 0, nullptr, tile, bid, nb);
  const size_t gtid = (size_t)bid * 256 + tid, gth = (size_t)nb * 256;
  for (size_t i = gtid; i < (size_t)64 * 2048 / 8; i += gth) ((u32x4*)(p.WinT() + (size_t)4160 * 2048))[i] = u32x4{0, 0, 0, 0};
  cvt_bf16(p.p, p.pb(), (size_t)T_ * 256 / 8, gtid, gth);
  for (size_t i = gtid; i < (size_t)T_ * 32; i += gth) {
    const int t = (int)(i >> 5), fi = (int)(i & 31);
    const float invf = 1.0f / powf(10000.0f, (float)(2 * fi) / 64.0f);
    const float ang = (float)p.positions[t] * invf;
    const double rev = (double)ang * 0.15915494309189535;
    const float fr = (float)(rev - rint(rev));
    p.cs()[i] = make_float2(__builtin_amdgcn_cosf(fr), __builtin_amdgcn_sinf(fr));
  }
  __syncthreads();
  float* wff = (float*)smem;
  for (int i = tid; i < 2048 * 2; i += 256) {
    const int k = i >> 1, hf = i & 1;
    *(float4*)(wff + k * 8 + hf * 4) = *(const float4*)(p.w_in + (size_t)k * INW + 4160 + hf * 4);
  }
  __syncthreads();
  for (int t = bid * 4 + wid; t < T_; t += nb * 4) {
    float a[8];
#pragma unroll
    for (int e = 0; e < 8; ++e) a[e] = 0.f;
#pragma unroll 1
    for (int i = 0; i < 4; ++i) {
      const int k = (i * 64 + lane) * 8;
      const float4 x0 = *(const float4*)(p.x + (size_t)t * D_ + k), x1 = *(const float4*)(p.x + (size_t)t * D_ + k + 4);
      *(u32x4*)(p.xb() + (size_t)t * D_ + k) = u32x4{pk2(x0.x, x0.y), pk2(x0.z, x0.w), pk2(x1.x, x1.y), pk2(x1.z, x1.w)};
      const float xs[8] = {x0.x, x0.y, x0.z, x0.w, x1.x, x1.y, x1.z, x1.w};
#pragma unroll
      for (int j = 0; j < 8; ++j) {
        const float4 w0 = *(const float4*)(wff + (k + j) * 8), w1 = *(const float4*)(wff + (k + j) * 8 + 4);
        a[0] += xs[j] * w0.x; a[1] += xs[j] * w0.y; a[2] += xs[j] * w0.z; a[3] += xs[j] * w0.w;
        a[4] += xs[j] * w1.x; a[5] += xs[j] * w1.y; a[6] += xs[j] * w1.z; a[7] += xs[j] * w1.w;
      }
    }
    float mine = 0.f;
#pragma unroll
    for (int e = 0; e < 8; ++e) { const float s = wave_sum(a[e]); if (lane == e) mine = s; }
    if (lane < 8) {
      const float z = mine + p.b_forget[lane];
      const float ls = fminf(z, 0.f) - log1pf(expf(-fabsf(z)));
      const int b = t >> 12, s = t & 4095;
      p.logf()[((size_t)(b * 8 + lane)) * S_ + s] = ls;
    }
  }
}

__device__ __forceinline__ void gemm_core(const u16* __restrict__ A, int lda, const u16* __restrict__ Bt, int ldb,
                                          int K, int brow, int bcol, char* smem, f32x4 (&acc)[4][4]) {
  const int tid = TID(), wid = tid >> 6, lane = tid & 63, wr = wid >> 1, wc = wid & 1, fr = lane & 15, fq = lane >> 4;
#pragma unroll
  for (int m = 0; m < 4; ++m)
#pragma unroll
    for (int n = 0; n < 4; ++n) acc[m][n] = f32x4{0.f, 0.f, 0.f, 0.f};
  const int nk = K / 32;
  const int srow = tid >> 2, sch = (tid & 3) ^ ((0x78 >> (((tid >> 4) & 3) * 2)) & 3);
  const u16* ga = A + (size_t)(brow + srow) * lda + sch * 8;
  const u16* gb = Bt + (size_t)(bcol + srow) * ldb + sch * 8;
  char* sdst = smem + tid * 16;
  auto issue = [&](int kt, int st) {
    char* sa = sdst + st * 16384;
#pragma unroll
    for (int i = 0; i < 2; ++i) {
      __builtin_amdgcn_global_load_lds((const unsigned*)(ga + (size_t)i * 64 * lda + kt * 32), (unsigned*)(sa + i * 4096), 16, 0, 0);
      __builtin_amdgcn_global_load_lds((const unsigned*)(gb + (size_t)i * 64 * ldb + kt * 32), (unsigned*)(sa + 8192 + i * 4096), 16, 0, 0);
    }
  };
  const int rsw = ((fq ^ ((0x78 >> (((fr >> 2) & 3) * 2)) & 3)) * 16);
  const int aoff = (wr * 64 + fr) * 64 + rsw, boff = 8192 + (wc * 64 + fr) * 64 + rsw;
  asm volatile("s_waitcnt vmcnt(0)" ::: "memory");
  __syncthreads();
  issue(0, 0);
  issue(nk > 1 ? 1 : nk - 1, 1);
  issue(nk > 2 ? 2 : nk - 1, 2);
#pragma unroll 1
  for (int kt = 0; kt < nk; ++kt) {
    asm volatile("s_waitcnt vmcnt(8)" ::: "memory");
    __builtin_amdgcn_s_barrier();
    asm volatile("" ::: "memory");
    issue(kt + 3 < nk ? kt + 3 : nk - 1, (kt + 3) & 3);
    const char* sb = smem + (kt & 3) * 16384;
    bf16x8 At[4], Bl[4];
#pragma unroll
    for (int m = 0; m < 4; ++m) At[m] = *reinterpret_cast<const bf16x8*>(sb + aoff + m * 1024);
#pragma unroll
    for (int n = 0; n < 4; ++n) Bl[n] = *reinterpret_cast<const bf16x8*>(sb + boff + n * 1024);
#pragma unroll
    for (int m = 0; m < 4; ++m)
#pragma unroll
      for (int n = 0; n < 4; ++n) acc[m][n] = __builtin_amdgcn_mfma_f32_16x16x32_bf16(At[m], Bl[n], acc[m][n], 0, 0, 0);
  }
  asm volatile("s_waitcnt vmcnt(0)" ::: "memory");
}

template <class Epi>
__device__ __forceinline__ void gemm128(const u16* __restrict__ A, int lda, const u16* __restrict__ Bt, int ldb,
                                        int K, int brow, int bcol, char* smem, Epi epi) {
  const int tid = TID(), wid = tid >> 6, lane = tid & 63, wr = wid >> 1, wc = wid & 1, fr = lane & 15, fq = lane >> 4;
  f32x4 acc[4][4];
  gemm_core(A, lda, Bt, ldb, K, brow, bcol, smem, acc);
  epi(acc, brow + wr * 64, bcol + wc * 64, fr, fq);
}

__device__ __forceinline__ int vblock(int bid, int nb) { return (nb & 7) ? bid : (bid & 7) * (nb >> 3) + (bid >> 3); }
__device__ __forceinline__ void tile_rc(int t, int Nt, int& tm, int& tn) {
  const int g = t / (8 * Nt), q = t % (8 * Nt);
  tn = q >> 3; tm = g * 8 + (q & 7);
}

__device__ void phase_inproj(const Params& p, char* smem, int bid, int nb) {
  const int ntn = 33, ntiles = 64 * ntn;
  for (int t = vblock(bid, nb); t < ntiles; t += nb) {
    int tm, tn; tile_rc(t, ntn, tm, tn);
    gemm128(p.xb(), D_, p.WinT(), D_, D_, tm * 128, tn * 128, smem,
      [&](f32x4 (&acc)[4][4], int row0, int col0, int fr, int fq) {
        if (col0 < 1024) {
          u16* dst = col0 < 512 ? p.cqb() : p.ckvb(); const int cb = col0 & 511;
#pragma unroll
          for (int m = 0; m < 4; ++m)
#pragma unroll
            for (int n = 0; n < 4; ++n)
#pragma unroll
              for (int j = 0; j < 4; ++j) {
                const int row = row0 + m * 16 + fq * 4 + j;
                dst[(size_t)row * 512 + cb + n * 16 + fr] = f2bf(acc[m][n][j]);
              }
        } else if (col0 < 3072) {
          int c = col0 - 1024; u16* dst = c < 1024 ? p.Qf() : p.Kf(); c &= 1023;
          const int hh = c >> 7, d0 = c & 127;
#pragma unroll
          for (int m = 0; m < 4; ++m)
#pragma unroll
            for (int n = 0; n < 4; ++n)
#pragma unroll
              for (int j = 0; j < 4; ++j) {
                const int row = row0 + m * 16 + fq * 4 + j, b = row >> 12, s = row & 4095;
                dst[((size_t)(b * 8 + hh) * S_ + s) * 128 + d0 + n * 16 + fr] = f2bf(acc[m][n][j]);
              }
        } else if (col0 < 4096) {
          const int c = col0 - 3072, hh = c >> 7, d0 = c & 127;
#pragma unroll
          for (int m = 0; m < 4; ++m)
#pragma unroll
            for (int n = 0; n < 4; ++n) {
              const int row = row0 + m * 16 + fq * 4, b = row >> 12, s = row & 4095, dv = d0 + n * 16 + fr;
              *(u32x2*)(p.VfT() + ((size_t)(b * 8 + hh) * 128 + dv) * S_ + s) =
                  u32x2{pk2(acc[m][n][0], acc[m][n][1]), pk2(acc[m][n][2], acc[m][n][3])};
            }
        } else if (col0 == 4096) {
#pragma unroll
          for (int m = 0; m < 4; ++m)
#pragma unroll
            for (int j = 0; j < 4; ++j) {
              const int row = row0 + m * 16 + fq * 4 + j, b = row >> 12, s = row & 4095;
#pragma unroll
              for (int n = 0; n < 2; ++n) {
                const int i = n * 16 + fr;
                const float2 cs = p.cs()[(size_t)row * 32 + i];
                const float x1 = acc[m][n][j], x2 = acc[m][n + 2][j];
                const u16 o1 = f2bf(x1 * cs.x - x2 * cs.y), o2 = f2bf(x1 * cs.y + x2 * cs.x);
                for (int hh = 0; hh < 8; ++hh) {
                  u16* kd = p.Km() + ((size_t)(b * 8 + hh) * S_ + s) * 192 + 128;
                  kd[i] = o1; kd[32 + i] = o2;
                }
              }
            }
        }
      });
  }
}

__device__ __forceinline__ void compute_rs(const u16* __restrict__ src, int brow, float* rsv) {
  const int tid = TID(), row = tid >> 1, hf = tid & 1;
  const u16* r = src + (size_t)(brow + row) * 512 + hf * 256;
  float ss = 0.f;
#pragma unroll 4
  for (int i = 0; i < 32; ++i) {
    const u32x4 v = *(const u32x4*)(r + i * 8);
#pragma unroll
    for (int w = 0; w < 4; ++w) { const float a = bflo(v[w]), b = bfhi(v[w]); ss += a * a + b * b; }
  }
  ss += dppf<0xB1>(ss);
  if (hf == 0) rsv[row] = rsqrtf(ss * (1.f / 512.f) + EPS);
}

__device__ void phase_up(const Params& p, char* smem, int bid, int nb) {
  float* rsv = (float*)(smem + 65536);
  const int nq = 64 * 12, nkv = 64 * 16, njobs = nq + nkv + 16;
  for (int t = vblock(bid, nb); t < njobs; t += nb) {
    if (t < nq) {
      int tm, tn; tile_rc(t, 12, tm, tn);
      compute_rs(p.cqb(), tm * 128, rsv);
      gemm128(p.cqb(), 512, p.WuqT(), 512, 512, tm * 128, tn * 128, smem,
        [&](f32x4 (&acc)[4][4], int row0, int col0, int fr, int fq) {
          const int hh = col0 / 192, off = col0 % 192;
          const int lr0 = row0 & 127;
          if (off < 128) {
#pragma unroll
            for (int m = 0; m < 4; ++m)
#pragma unroll
              for (int j = 0; j < 4; ++j) {
                const int lr = lr0 + m * 16 + fq * 4 + j, row = (row0 - lr0) + lr, b = row >> 12, s = row & 4095;
                const float rs = rsv[lr];
                u16* qd = p.Qm() + ((size_t)(b * 8 + hh) * S_ + s) * 192 + off;
#pragma unroll
                for (int n = 0; n < 4; ++n) qd[n * 16 + fr] = f2bf(acc[m][n][j] * rs);
              }
          } else {
#pragma unroll
            for (int m = 0; m < 4; ++m)
#pragma unroll
              for (int j = 0; j < 4; ++j) {
                const int lr = lr0 + m * 16 + fq * 4 + j, row = (row0 - lr0) + lr, b = row >> 12, s = row & 4095;
                const float rs = rsv[lr];
                u16* qd = p.Qm() + ((size_t)(b * 8 + hh) * S_ + s) * 192 + 128;
#pragma unroll
                for (int n = 0; n < 2; ++n) {
                  const int i = n * 16 + fr;
                  const float2 cs = p.cs()[(size_t)row * 32 + i];
                  const float x1 = acc[m][n][j] * rs, x2 = acc[m][n + 2][j] * rs;
                  qd[i] = f2bf(x1 * cs.x - x2 * cs.y); qd[32 + i] = f2bf(x1 * cs.y + x2 * cs.x);
                }
              }
          }
        });
      __syncthreads();
    } else if (t < nq + nkv) {
      int tm, tn; tile_rc(t - nq, 16, tm, tn);
      compute_rs(p.ckvb(), tm * 128, rsv);
      gemm128(p.ckvb(), 512, p.WukvT(), 512, 512, tm * 128, tn * 128, smem,
        [&](f32x4 (&acc)[4][4], int row0, int col0, int fr, int fq) {
          const int hh = col0 >> 8, off = col0 & 255;
          const int lr0 = row0 & 127;
          if (off < 128) {
#pragma unroll
            for (int m = 0; m < 4; ++m)
#pragma unroll
              for (int j = 0; j < 4; ++j) {
                const int lr = lr0 + m * 16 + fq * 4 + j, row = (row0 - lr0) + lr, b = row >> 12, s = row & 4095;
                const float rs = rsv[lr];
                u16* kd = p.Km() + ((size_t)(b * 8 + hh) * S_ + s) * 192 + off;
#pragma unroll
                for (int n = 0; n < 4; ++n) kd[n * 16 + fr] = f2bf(acc[m][n][j] * rs);
              }
          } else {
#pragma unroll
            for (int m = 0; m < 4; ++m) {
              const int lr = lr0 + m * 16 + fq * 4, row = (row0 - lr0) + lr, b = row >> 12, s = row & 4095;
              const float r0 = rsv[lr], r1 = rsv[lr + 1], r2 = rsv[lr + 2], r3 = rsv[lr + 3];
#pragma unroll
              for (int n = 0; n < 4; ++n) {
                const int dv = off - 128 + n * 16 + fr;
                *(u32x2*)(p.VmT() + ((size_t)(b * 8 + hh) * 128 + dv) * S_ + s) =
                    u32x2{pk2(acc[m][n][0] * r0, acc[m][n][1] * r1), pk2(acc[m][n][2] * r2, acc[m][n][3] * r3)};
              }
            }
          }
        });
      __syncthreads();
    } else {
      const int seq = t - nq - nkv;
      if ((TID() >> 6) == 0) {
        const int lane = TID() & 63;
        const float* src = p.logf() + (size_t)seq * S_ + lane * 64;
        float* dst = p.Fk() + (size_t)seq * S_ + lane * 64;
        float sum = 0.f;
        for (int i = 0; i < 16; ++i) { const float4 v = *(const float4*)(src + i * 4); sum += v.x; sum += v.y; sum += v.z; sum += v.w; }
        float inc = sum;
#pragma unroll
        for (int d = 1; d < 64; d <<= 1) { const float o = __shfl_up(inc, d, 64); if (lane >= d) inc += o; }
        float run = inc - sum;
        for (int i = 0; i < 16; ++i) {
          const float4 v = *(const float4*)(src + i * 4); float4 o;
          run += v.x; o.x = run; run += v.y; o.y = run; run += v.z; o.z = run; run += v.w; o.w = run;
          *(float4*)(dst + i * 4) = o;
        }
      }
    }
  }
}

#ifdef ATTN_NAIVE
__device__ void phase_attn_naive(const Params& p, char* smem, int bid, int nb) {
  const int tid = TID(), lane = tid & 63, wid = tid >> 6;
  const int per = NB_ * 8 * S_, nrows = 2 * per;
  for (int r = bid * 4 + wid; r < nrows; r += nb * 4) {
    const int type = r / per, rr = r % per, bh = rr / S_, s = rr % S_;
    const int DQ = type ? 128 : 192;
    const u16* Q = type ? p.Qf() + ((size_t)bh * S_ + s) * 128 : p.Qm() + ((size_t)bh * S_ + s) * 192;
    const u16* Kb = type ? p.Kf() + (size_t)bh * S_ * 128 : p.Km() + (size_t)bh * S_ * 192;
    const u16* VT = (type ? p.VfT() : p.VmT()) + (size_t)bh * 128 * S_;
    const float* F = p.Fk() + (size_t)bh * S_;
    const float scale = type ? 0.08838834764831845f : 0.07216878364870322f;
    float m = -1e30f, l = 0.f;
    float acc[128];
#pragma unroll
    for (int d = 0; d < 128; ++d) acc[d] = 0.f;
    const float fqv = type ? F[s] : 0.f;
    for (int k0 = 0; k0 <= s; k0 += 64) {
      const int key = k0 + lane; const bool valid = key <= s; const int keyc = valid ? key : s;
      const u16* kr = Kb + (size_t)keyc * DQ;
      float sc = 0.f;
      for (int d = 0; d < DQ; d += 8) {
        const u32x4 kv = *(const u32x4*)(kr + d), qv = *(const u32x4*)(Q + d);
#pragma unroll
        for (int w = 0; w < 4; ++w) sc += bflo(kv[w]) * bflo(qv[w]) + bfhi(kv[w]) * bfhi(qv[w]);
      }
      sc *= scale;
      if (type) sc += fqv - F[keyc];
      if (!valid) sc = -1e30f;
      const float mx = wave_max(sc), mn = fmaxf(m, mx), alpha = __expf(m - mn);
      const float pr = valid ? __expf(sc - mn) : 0.f;
      m = mn; l = l * alpha + pr;
#pragma unroll
      for (int d = 0; d < 128; ++d) acc[d] = acc[d] * alpha + pr * bf2f(VT[(size_t)d * S_ + keyc]);
    }
    const float inv = 1.f / wave_sum(l);
    float o0 = 0.f, o1 = 0.f;
#pragma unroll
    for (int d = 0; d < 128; ++d) {
      const float o = wave_sum(acc[d]) * inv;
      if (lane == (d & 63)) { if (d < 64) o0 = o; else o1 = o; }
    }
    const int b = bh >> 3, hh = bh & 7;
    u16* od = p.omix() + ((size_t)(b * S_ + s)) * 2048 + type * 1024 + hh * 128;
    od[lane] = f2bf(o0); od[64 + lane] = f2bf(o1);
  }
}

#endif
typedef float f32x16 __attribute__((ext_vector_type(16)));
template <int TYPE>
__device__ __forceinline__ void attn_item(const Params& p, char* smem, int bh, int qb) {
  constexpr int DQK = TYPE ? 128 : 192, NKS = DQK / 16, KSTR = DQK * 2 + 16, VSTR = 128;
  constexpr int KCH = DQK / 8, NKL = 64 * KCH / 256;
  constexpr float C2 = (TYPE ? 0.08838834764831845f : 0.07216878364870322f) * 1.4426950408889634f;
  char* sK = smem; char* sV = smem + 25600; float* sF = (float*)(smem + 25600 + 32768);
  const int tid = TID(), lane = tid & 63, wid = tid >> 6, c = lane & 31, hi = lane >> 5;
  const u16* Qb = (TYPE ? p.Qf() : p.Qm()) + (size_t)bh * S_ * DQK;
  const u16* Kb = (TYPE ? p.Kf() : p.Km()) + (size_t)bh * S_ * DQK;
  const u16* Vb = (TYPE ? p.VfT() : p.VmT()) + (size_t)bh * 128 * S_;
  const float* Fb = p.Fk() + (size_t)bh * S_;
  const int qrow = qb * 128 + wid * 32;
  bf16x8 qf[NKS];
#pragma unroll
  for (int ks = 0; ks < NKS; ++ks) qf[ks] = *(const bf16x8*)(Qb + (size_t)(qrow + c) * DQK + ks * 16 + hi * 8);
  f32x16 o[4];
#pragma unroll
  for (int db = 0; db < 4; ++db)
#pragma unroll
    for (int r = 0; r < 16; ++r) o[db][r] = 0.f;
  float m = -1e30f, l = 0.f;
  const int ntiles = 2 * qb + 2;
  u32x4 kreg[NKL];
  float4 freg = make_float4(0.f, 0.f, 0.f, 0.f);
  const unsigned koff = (unsigned)tid * 16u;
  auto load_k = [&](int kt) {
    const char* kb = (const char*)(Kb + (size_t)kt * 64 * DQK);
#pragma unroll
    for (int i = 0; i < NKL; ++i) kreg[i] = *(const u32x4*)(kb + i * 4096 + koff);
    if (TYPE) { if (tid < 16) freg = *(const float4*)(Fb + kt * 64 + tid * 4); }
  };
  const unsigned voff = (unsigned)((((tid >> 3) * S_) + (((tid & 7) ^ ((tid >> 4) & 7)) * 8)) * 2);
  auto load_v = [&](int kt) {
    const char* vb = (const char*)(Vb + kt * 64);
    char* dst = sV + (kt & 1) * 16384 + tid * 16;
#pragma unroll
    for (int i = 0; i < 4; ++i)
      __builtin_amdgcn_global_load_lds((const unsigned*)(vb + (size_t)i * 32 * S_ * 2 + voff), (unsigned*)(dst + i * 4096), 16, 0, 0);
  };
  auto store_tile = [&]() {
#pragma unroll
    for (int i = 0; i < NKL; ++i) { const int ch = tid + 256 * i, key = ch / KCH, dc = ch % KCH; *(u32x4*)(sK + key * KSTR + dc * 16) = kreg[i]; }
    if (TYPE) { if (tid < 16) { const float L2E = 1.4426950408889634f; *(float4*)(sF + tid * 4) = make_float4(freg.x * L2E, freg.y * L2E, freg.z * L2E, freg.w * L2E); } }
  };
  const int krow = (c & 19) | ((c & 4) << 1) | ((c & 8) >> 1);
  const char* ka0 = sK + krow * KSTR + hi * 16;
  const char* ka1 = ka0 + 32 * KSTR;
  const int vx = (c >> 1) & 7;
  int vo[2][2];
#pragma unroll
  for (int kb = 0; kb < 2; ++kb)
#pragma unroll
    for (int s2 = 0; s2 < 2; ++s2) vo[kb][s2] = c * VSTR + (((4 * kb + 2 * s2 + hi) ^ vx) * 16);
  load_k(0); load_v(0);
#pragma unroll 1
  for (int kt = 0; kt < ntiles; ++kt) {
    asm volatile("s_waitcnt vmcnt(0)" ::: "memory");
    __syncthreads();
    store_tile();
    __syncthreads();
    if (kt + 1 < ntiles) { load_k(kt + 1); load_v(kt + 1); }
    const int k0 = kt * 64;
    const char* sVc = sV + (kt & 1) * 16384;
    if (k0 <= qrow + 31) {
      f32x16 p0, p1;
#pragma unroll
      for (int r = 0; r < 16; ++r) { p0[r] = 0.f; p1[r] = 0.f; }
#pragma unroll
      for (int ks = 0; ks < NKS; ++ks) {
        const bf16x8 a0 = *(const bf16x8*)(ka0 + ks * 32), a1 = *(const bf16x8*)(ka1 + ks * 32);
        p0 = __builtin_amdgcn_mfma_f32_32x32x16_bf16(a0, qf[ks], p0, 0, 0, 0);
        p1 = __builtin_amdgcn_mfma_f32_32x32x16_bf16(a1, qf[ks], p1, 0, 0, 0);
      }
      if (TYPE) {
#pragma unroll
        for (int s = 0; s < 2; ++s) {
          const float4 f0 = *(const float4*)(sF + 16 * s + 8 * hi), f1 = *(const float4*)(sF + 16 * s + 8 * hi + 4);
          const float4 g0 = *(const float4*)(sF + 32 + 16 * s + 8 * hi), g1 = *(const float4*)(sF + 32 + 16 * s + 8 * hi + 4);
          p0[8 * s + 0] = p0[8 * s + 0] * C2 - f0.x; p0[8 * s + 1] = p0[8 * s + 1] * C2 - f0.y; p0[8 * s + 2] = p0[8 * s + 2] * C2 - f0.z; p0[8 * s + 3] = p0[8 * s + 3] * C2 - f0.w;
          p0[8 * s + 4] = p0[8 * s + 4] * C2 - f1.x; p0[8 * s + 5] = p0[8 * s + 5] * C2 - f1.y; p0[8 * s + 6] = p0[8 * s + 6] * C2 - f1.z; p0[8 * s + 7] = p0[8 * s + 7] * C2 - f1.w;
          p1[8 * s + 0] = p1[8 * s + 0] * C2 - g0.x; p1[8 * s + 1] = p1[8 * s + 1] * C2 - g0.y; p1[8 * s + 2] = p1[8 * s + 2] * C2 - g0.z; p1[8 * s + 3] = p1[8 * s + 3] * C2 - g0.w;
          p1[8 * s + 4] = p1[8 * s + 4] * C2 - g1.x; p1[8 * s + 5] = p1[8 * s + 5] * C2 - g1.y; p1[8 * s + 6] = p1[8 * s + 6] * C2 - g1.z; p1[8 * s + 7] = p1[8 * s + 7] * C2 - g1.w;
        }
      } else {
#pragma unroll
        for (int r = 0; r < 16; ++r) { p0[r] *= C2; p1[r] *= C2; }
      }
      if (k0 + 63 > qrow) {
        const int lim = qrow + c - k0 - 8 * hi;
        const float NEG = -__builtin_inff();
#pragma unroll
        for (int r = 0; r < 16; ++r) {
          const int kb = 16 * (r >> 3) + (r & 7);
          if (kb > lim) p0[r] = NEG;
          if (kb + 32 > lim) p1[r] = NEG;
        }
      }
      float mx = p0[0];
#pragma unroll
      for (int r = 1; r < 16; ++r) mx = fmaxf(mx, p0[r]);
#pragma unroll
      for (int r = 0; r < 16; ++r) mx = fmaxf(mx, p1[r]);
      {
        auto rr = __builtin_amdgcn_permlane32_swap(__float_as_uint(mx), __float_as_uint(mx), false, false);
        mx = fmaxf(__uint_as_float(rr[0]), __uint_as_float(rr[1]));
      }
      const float mn = fmaxf(m, mx);
      const float alpha = __builtin_amdgcn_exp2f(m - mn);
      m = mn;
      if (!__all(alpha == 1.f)) {
#pragma unroll
        for (int db = 0; db < 4; ++db)
#pragma unroll
          for (int r = 0; r < 16; ++r) o[db][r] *= alpha;
      }
      float ps = 0.f;
#pragma unroll
      for (int r = 0; r < 16; ++r) { p0[r] = __builtin_amdgcn_exp2f(p0[r] - mn); p1[r] = __builtin_amdgcn_exp2f(p1[r] - mn); ps += p0[r] + p1[r]; }
      l = l * alpha + ps;
      bf16x8 pa[2][2];
#pragma unroll
      for (int s = 0; s < 2; ++s) {
        u32x4 w0 = {pk2(p0[8 * s + 0], p0[8 * s + 1]), pk2(p0[8 * s + 2], p0[8 * s + 3]), pk2(p0[8 * s + 4], p0[8 * s + 5]), pk2(p0[8 * s + 6], p0[8 * s + 7])};
        u32x4 w1 = {pk2(p1[8 * s + 0], p1[8 * s + 1]), pk2(p1[8 * s + 2], p1[8 * s + 3]), pk2(p1[8 * s + 4], p1[8 * s + 5]), pk2(p1[8 * s + 6], p1[8 * s + 7])};
        pa[0][s] = *reinterpret_cast<bf16x8*>(&w0); pa[1][s] = *reinterpret_cast<bf16x8*>(&w1);
      }
#pragma unroll
      for (int db = 0; db < 4; ++db)
#pragma unroll
        for (int kb = 0; kb < 2; ++kb)
#pragma unroll
          for (int s = 0; s < 2; ++s) {
            const bf16x8 av = *(const bf16x8*)(sVc + db * 32 * VSTR + vo[kb][s]);
            o[db] = __builtin_amdgcn_mfma_f32_32x32x16_bf16(av, pa[kb][s], o[db], 0, 0, 0);
          }
    }
  }
  {
    auto rr = __builtin_amdgcn_permlane32_swap(__float_as_uint(l), __float_as_uint(l), false, false);
    const float inv = 1.f / (__uint_as_float(rr[0]) + __uint_as_float(rr[1]));
    const int b = bh >> 3, hh = bh & 7;
    u16* od = p.omix() + ((size_t)(b * S_ + qrow + c)) * 2048 + TYPE * 1024 + hh * 128 + 4 * hi;
#pragma unroll
    for (int db = 0; db < 4; ++db)
#pragma unroll
      for (int g = 0; g < 4; ++g)
        *(u32x2*)(od + 32 * db + 8 * g) = u32x2{pk2(o[db][4 * g] * inv, o[db][4 * g + 1] * inv), pk2(o[db][4 * g + 2] * inv, o[db][4 * g + 3] * inv)};
  }
}

__device__ void phase_attn(const Params& p, char* smem, int bid, int nb) {
  int* sItem = (int*)(smem + 60000);
  const int x = bid & 7;
  unsigned* q = p.ctr() + 32 + x;
  for (;;) {
    __syncthreads();
    if (TID() == 0) *sItem = (int)atomicAdd(q, 1u);
    __syncthreads();
    const int item = *sItem;
    if (item >= 128) break;
    const int qb = 31 - (item >> 2), r = item & 3, type = r >> 1, bh = x + 8 * (r & 1);
    if (type == 0) attn_item<0>(p, smem, bh, qb); else attn_item<1>(p, smem, bh, qb);
  }
  unsigned* qc = p.ctr() + 48;
  for (;;) {
    __syncthreads();
    if (TID() == 0) *sItem = (int)atomicAdd(qc, 1u);
    __syncthreads();
    const int chunk = *sItem;
    if (chunk >= 512) break;
    quant_chunk(p, chunk);
  }
}

__device__ void phase_outproj(const Params& p, char* smem, int bid, int nb) {
  const int ntiles = 64 * 16;
  for (int t = vblock(bid, nb); t < ntiles; t += nb) {
    int tm, tn; tile_rc(t, 16, tm, tn);
    gemm128(p.omix(), D_, p.WoutT(), D_, D_, tm * 128, tn * 128, smem,
      [&](f32x4 (&acc)[4][4], int row0, int col0, int fr, int fq) {
#pragma unroll
        for (int m = 0; m < 4; ++m)
#pragma unroll
          for (int n = 0; n < 4; ++n)
#pragma unroll
            for (int j = 0; j < 4; ++j) {
              const size_t idx = (size_t)(row0 + m * 16 + fq * 4 + j) * D_ + col0 + n * 16 + fr;
              p.y1()[idx] = ALPHA * p.x[idx] + acc[m][n][j];
            }
      });
  }
}

__device__ void phase_ln1(const Params& p, int bid, int nb) {
  const int lane = TID() & 63, wid = TID() >> 6;
  for (int t = bid * 4 + wid; t < T_; t += nb * 4) {
    float* row = p.y1() + (size_t)t * D_;
    float4 v[8];
    float sum = 0.f;
#pragma unroll
    for (int i = 0; i < 8; ++i) { v[i] = *(const float4*)(row + (i * 64 + lane) * 4); sum += (v[i].x + v[i].y) + (v[i].z + v[i].w); }
    const float mu = wave_sum(sum) * (1.f / D_);
    float sq = 0.f;
#pragma unroll
    for (int i = 0; i < 8; ++i) {
      v[i].x -= mu; v[i].y -= mu; v[i].z -= mu; v[i].w -= mu;
      sq += (v[i].x * v[i].x + v[i].y * v[i].y) + (v[i].z * v[i].z + v[i].w * v[i].w);
    }
    const float rstd = rsqrtf(wave_sum(sq) * (1.f / D_) + EPS);
#pragma unroll
    for (int i = 0; i < 8; ++i) {
      const int c = (i * 64 + lane) * 4;
      const float4 g = *(const float4*)(p.ln1_g + c), bb = *(const float4*)(p.ln1_b + c);
      float4 o; o.x = v[i].x * rstd * g.x + bb.x; o.y = v[i].y * rstd * g.y + bb.y; o.z = v[i].z * rstd * g.z + bb.z; o.w = v[i].w * rstd * g.w + bb.w;
      *(float4*)(row + c) = o;
      *(u32x2*)(p.h1b() + (size_t)t * D_ + c) = u32x2{pk2(o.x, o.y), pk2(o.z, o.w)};
    }
  }
}

__device__ __forceinline__ void ins16(unsigned (&t)[16], unsigned x) {
#pragma unroll
  for (int i = 0; i < 16; ++i) { const unsigned hi = t[i] > x ? t[i] : x; x = t[i] > x ? x : t[i]; t[i] = hi; }
}
__device__ __forceinline__ void ins16p(unsigned (&ck)[16], int (&ce)[16], unsigned x, int xe) {
#pragma unroll
  for (int i = 0; i < 16; ++i) {
    const bool sw = x > ck[i];
    const unsigned nk = sw ? x : ck[i], nx = sw ? ck[i] : x;
    const int ne = sw ? xe : ce[i], nxe = sw ? ce[i] : xe;
    ck[i] = nk; x = nx; ce[i] = ne; xe = nxe;
  }
}
__device__ __forceinline__ float unordkey(unsigned k) { return __uint_as_float((k & 0x80000000u) ? (k & 0x7fffffffu) : ~k); }

__device__ __forceinline__ void route_tile(const Params& p, char* smem, f32x4 (&acc)[4][4], int tm, int h) {
  const int tid = TID(), wid = tid >> 6, lane = tid & 63, wr = wid >> 1, wc = wid & 1, fr = lane & 15, fq = lane >> 4;
  __syncthreads();
  float* Qw = (float*)smem + wid * (64 * 65);
#pragma unroll
  for (int m = 0; m < 4; ++m)
#pragma unroll
    for (int n = 0; n < 4; ++n)
#pragma unroll
      for (int j = 0; j < 4; ++j) Qw[(m * 16 + fq * 4 + j) * 65 + n * 16 + fr] = acc[m][n][j];
  asm volatile("s_waitcnt lgkmcnt(0)" ::: "memory");
  float q[64];
#pragma unroll
  for (int d = 0; d < 64; ++d) q[d] = Qw[lane * 65 + d];
  __syncthreads();
  {
    float* ks = (float*)smem;
#pragma unroll
    for (int i = 0; i < 16; ++i) {
      const int idx = (i * 256 + tid) * 4;
      const float* src = (idx < 8192 ? p.keys1 : p.keys2) + (size_t)h * 8192 + (idx & 8191);
      *(float4*)(ks + idx) = *(const float4*)src;
    }
  }
  __syncthreads();
  unsigned t[16];
#pragma unroll
  for (int i = 0; i < 16; ++i) t[i] = 0u;
  {
    const float* kb = (const float*)smem + wc * 8192;
#pragma unroll 1
    for (int n = 0; n < 128; ++n) {
      float d0 = 0.f, d1 = 0.f, d2 = 0.f, d3 = 0.f;
#pragma unroll
      for (int i = 0; i < 16; ++i) {
        const float4 kv = *(const float4*)(kb + n * 64 + i * 4);
        d0 += kv.x * q[4 * i]; d1 += kv.y * q[4 * i + 1]; d2 += kv.z * q[4 * i + 2]; d3 += kv.w * q[4 * i + 3];
      }
      const float sc = (d0 + d1) + (d2 + d3);
      ins16(t, (ordkey(sc) & ~127u) | (unsigned)(127 - n));
    }
  }
  __syncthreads();
  unsigned* L = (unsigned*)smem;
#pragma unroll
  for (int r = 0; r < 16; ++r) L[(wc * 16 + r) * 128 + wr * 64 + lane] = t[r];
  __syncthreads();
  if (wid < 2) {
    const int tok = wid * 64 + lane;
    unsigned ck[16]; int ce[16];
#pragma unroll
    for (int i = 0; i < 16; ++i) { ck[i] = 0u; ce[i] = 0; }
#pragma unroll 1
    for (int a = 0; a < 16; ++a) {
      const unsigned ka = L[a * 128 + tok];
      const int i1a = (127 - (int)(ka & 127u)) * 128; const float v1a = unordkey(ka & ~127u);
      const int nbm1 = (int)((0x1112347FULL >> (4 * a)) & 15ULL);
#pragma unroll 1
      for (int b = 0; b <= nbm1; ++b) {
        const unsigned kb = L[(16 + b) * 128 + tok];
        const int i2b = 127 - (int)(kb & 127u); const float v2b = unordkey(kb & ~127u);
        ins16p(ck, ce, ordkey(v1a + v2b), i1a + i2b);
      }
    }
    float ex[16], sum = 0.f;
    const float mx = unordkey(ck[0]);
#pragma unroll
    for (int r = 0; r < 16; ++r) { ex[r] = __expf(unordkey(ck[r]) - mx); sum += ex[r]; }
    const float inv = 1.f / sum;
    const size_t o = ((size_t)(tm * 128 + tok) * 8 + h) * 16;
    int* ed = p.eidxG() + o; float* gd = p.gateG() + o;
#pragma unroll
    for (int r = 0; r < 16; r += 4) {
      *(int4*)(ed + r) = make_int4(ce[r], ce[r + 1], ce[r + 2], ce[r + 3]);
      *(float4*)(gd + r) = make_float4(ex[r] * inv, ex[r + 1] * inv, ex[r + 2] * inv, ex[r + 3] * inv);
    }
  }
}

__device__ void phase_mid(const Params& p, char* smem, int bid, int nb) {
  const int ng = 64 * 16, nq = 64 * 8;
  for (int t = vblock(bid, nb); t < ng + nq; t += nb) {
    if (t < ng) {
      int tm, tn; tile_rc(t, 16, tm, tn);
      f32x4 pacc[4][4], acc[4][4];
      gemm_core(p.pb(), 256, p.WpT(), 256, 256, tm * 128, tn * 128, smem, pacc);
      gemm_core(p.h1b(), D_, p.WgT(), D_, D_, tm * 128, tn * 128, smem, acc);
      {
        const int tid = TID(), wid = tid >> 6, lane = tid & 63, wr = wid >> 1, wc = wid & 1, fr = lane & 15, fq = lane >> 4;
        const size_t base = (size_t)(tm * 128 + wr * 64 + fq * 4) * D_ + tn * 128 + wc * 64 + fr;
        const float* yb = p.y1() + base;
        float* ob = p.out + base;
#pragma unroll
        for (int m = 0; m < 4; ++m) {
#pragma unroll
          for (int n = 0; n < 4; ++n)
#pragma unroll
            for (int j = 0; j < 4; ++j) {
              const int o = (m * 16 + j) * D_ + n * 16;
              const float sg = 1.f / (1.f + __expf(-acc[m][n][j]));
              ob[o] = ALPHA * yb[o] + pacc[m][n][j] * sg;
            }
        }
      }
    } else {
      int tm, tn; tile_rc(t - ng, 8, tm, tn);
      f32x4 acc[4][4];
      gemm_core(p.h1b(), D_, p.WpqT(), D_, D_, tm * 128, tn * 128, smem, acc);
      route_tile(p, smem, acc, tm, tn);
    }
  }
}

__device__ __forceinline__ float gelu_exact(float a) {
  const float x = fabsf(a) * 0.7071067811865476f;
  const float t = __builtin_amdgcn_rcpf(1.f + 0.3275911f * x);
  const float poly = t * (0.254829592f + t * (-0.284496736f + t * (1.421413741f + t * (-1.453152027f + t * 1.061405429f))));
  const float er = 1.f - poly * __expf(-x * x);
  return 0.5f * a * (1.f + (a < 0.f ? -er : er));
}

template <int NPER, int IDXMASK>
__device__ __forceinline__ int top16(unsigned (&k)[NPER], int lane) {
  int mine = 0;
#pragma unroll 1
  for (int r = 0; r < 16; ++r) {
    unsigned loc = k[0];
#pragma unroll
    for (int i = 1; i < NPER; ++i) loc = loc > k[i] ? loc : k[i];
    const unsigned best = wave_umax(loc);
#pragma unroll
    for (int i = 0; i < NPER; ++i) if (k[i] == best) k[i] = 0u;
    if (lane == r) mine = IDXMASK - (int)(best & (unsigned)IDXMASK);
  }
  return mine;
}

__device__ void phase_peer(const Params& p, char* smem, int bid, int nb) {
  const int tid = TID(), lane = tid & 63, wid = tid >> 6;
  float* qs = (float*)smem;
  float* sc = (float*)(smem + 8192);
  int* eidx = (int*)(smem + 24576);
  float* gts = (float*)(smem + 32768);
  for (int it = bid; it < T_ / 16; it += nb) {
    const int t0 = it * 16;
#pragma unroll
    for (int i = 0; i < 2; ++i) {
      const int idx = (i * 256 + tid) * 4;
      *(int4*)(eidx + idx) = *(const int4*)(p.eidxG() + (size_t)t0 * 128 + idx);
      *(float4*)(gts + idx) = *(const float4*)(p.gateG() + (size_t)t0 * 128 + idx);
    }
    __syncthreads();
    for (int ti = 0; ti < 4; ++ti) {
      const int tok = wid * 4 + ti, t = t0 + tok;
      typedef float f32x2 __attribute__((ext_vector_type(2)));
      float hreg[32], o[32];
#pragma unroll
      for (int c = 0; c < 2; ++c)
#pragma unroll
        for (int q = 0; q < 2; ++q) {
          const u32x4 hv = *(const u32x4*)(p.h1b() + (size_t)t * D_ + (c * 64 + lane) * 16 + q * 8);
#pragma unroll
          for (int w = 0; w < 4; ++w) { hreg[c * 16 + q * 8 + 2 * w] = bflo(hv[w]); hreg[c * 16 + q * 8 + 2 * w + 1] = bfhi(hv[w]); }
        }
#pragma unroll
      for (int i = 0; i < 32; ++i) o[i] = 0.f;
      const float* Us = p.Us(); const float* Vs = p.Vs();
      const unsigned char* Uq = p.Uq() + lane * 16; const unsigned char* Vq = p.Vq() + lane * 16;
      const int* ep = eidx + tok * 128; const float* gp = gts + tok * 128;
      u32x4 urA[2][2], vrA[2][2], urB[2][2], vrB[2][2];
      float gA[2], suA[2], svA[2], gB[2], suB[2], svB[2];
#define PEER_LOAD(UR, VR, G, SU, SV, J0)                                                              \
      _Pragma("unroll") for (int jj = 0; jj < 2; ++jj) {                                                \
        const int e = __builtin_amdgcn_readfirstlane(ep[(J0) + jj]);                                    \
        G[jj] = gp[(J0) + jj]; SU[jj] = Us[e]; SV[jj] = Vs[e];                                          \
        const unsigned char* up = Uq + (size_t)e * 4096; const unsigned char* vp = up + 2048;           \
        UR[jj][0] = *(const u32x4*)(up); UR[jj][1] = *(const u32x4*)(up + 1024);                        \
        VR[jj][0] = *(const u32x4*)(vp); VR[jj][1] = *(const u32x4*)(vp + 1024);                        \
      }
#define PEER_COMPUTE(UR, VR, G, SU, SV)                                                                 \
      _Pragma("unroll") for (int jj = 0; jj < 2; ++jj) {                                                \
        float d0 = 0.f, d1 = 0.f;                                                                       \
        _Pragma("unroll") for (int c = 0; c < 2; ++c)                                                   \
          _Pragma("unroll") for (int w = 0; w < 4; ++w) {                                               \
            const f32x2 lo = __builtin_amdgcn_cvt_pk_f32_fp8(UR[jj][c][w], false), hi2 = __builtin_amdgcn_cvt_pk_f32_fp8(UR[jj][c][w], true); \
            d0 += lo[0] * hreg[c * 16 + 4 * w]; d1 += lo[1] * hreg[c * 16 + 4 * w + 1];                \
            d0 += hi2[0] * hreg[c * 16 + 4 * w + 2]; d1 += hi2[1] * hreg[c * 16 + 4 * w + 3];          \
          }                                                                                             \
        const float av = wave_sum(d0 + d1) * SU[jj];                                                    \
        const float act = gelu_exact(av) * G[jj] * SV[jj];                                              \
        _Pragma("unroll") for (int c = 0; c < 2; ++c)                                                   \
          _Pragma("unroll") for (int w = 0; w < 4; ++w) {                                               \
            const f32x2 lo = __builtin_amdgcn_cvt_pk_f32_fp8(VR[jj][c][w], false), hi2 = __builtin_amdgcn_cvt_pk_f32_fp8(VR[jj][c][w], true); \
            o[c * 16 + 4 * w] += act * lo[0]; o[c * 16 + 4 * w + 1] += act * lo[1];                    \
            o[c * 16 + 4 * w + 2] += act * hi2[0]; o[c * 16 + 4 * w + 3] += act * hi2[1];              \
          }                                                                                             \
      }
      PEER_LOAD(urA, vrA, gA, suA, svA, 0)
#pragma unroll 1
      for (int j0 = 0; j0 < 128; j0 += 4) {
        PEER_LOAD(urB, vrB, gB, suB, svB, j0 + 2)
        PEER_COMPUTE(urA, vrA, gA, suA, svA)
        if (j0 + 4 < 128) { PEER_LOAD(urA, vrA, gA, suA, svA, j0 + 4) }
        PEER_COMPUTE(urB, vrB, gB, suB, svB)
      }
#undef PEER_LOAD
#undef PEER_COMPUTE
      float* orow = p.out + (size_t)t * D_;
      float sum = 0.f;
#pragma unroll
      for (int c = 0; c < 2; ++c)
#pragma unroll
        for (int q = 0; q < 4; ++q) {
          const float4 r0 = *(const float4*)(orow + (c * 64 + lane) * 16 + q * 4);
          o[c * 16 + q * 4 + 0] += r0.x; o[c * 16 + q * 4 + 1] += r0.y; o[c * 16 + q * 4 + 2] += r0.z; o[c * 16 + q * 4 + 3] += r0.w;
        }
#pragma unroll
      for (int i = 0; i < 32; ++i) sum += o[i];
      const float mu = wave_sum(sum) * (1.f / D_);
      float sq = 0.f;
#pragma unroll
      for (int i = 0; i < 32; ++i) { o[i] -= mu; sq += o[i] * o[i]; }
      const float rstd = rsqrtf(wave_sum(sq) * (1.f / D_) + EPS);
#pragma unroll
      for (int c = 0; c < 2; ++c)
#pragma unroll
        for (int q = 0; q < 4; ++q) {
          const int col = (c * 64 + lane) * 16 + q * 4;
          const float4 g0 = *(const float4*)(p.ln2_g + col), b0 = *(const float4*)(p.ln2_b + col);
          float4 w0;
          w0.x = o[c * 16 + q * 4 + 0] * rstd * g0.x + b0.x; w0.y = o[c * 16 + q * 4 + 1] * rstd * g0.y + b0.y;
          w0.z = o[c * 16 + q * 4 + 2] * rstd * g0.z + b0.z; w0.w = o[c * 16 + q * 4 + 3] * rstd * g0.w + b0.w;
          *(float4*)(orow + col) = w0;
        }
    }
    __syncthreads();
  }
}

template <int PH>
__device__ __forceinline__ void run_phase(const Params& p, char* smem, int bid, int nb) {
  if constexpr (PH == 0) phase_prep(p, smem, bid, nb);
  if constexpr (PH == 1) phase_inproj(p, smem, bid, nb);
  if constexpr (PH == 2) phase_up(p, smem, bid, nb);
#ifdef ATTN_NAIVE
  if constexpr (PH == 3) phase_attn_naive(p, smem, bid, nb);
#else
  if constexpr (PH == 3) phase_attn(p, smem, bid, nb);
#endif
  if constexpr (PH == 4) phase_outproj(p, smem, bid, nb);
  if constexpr (PH == 5) phase_ln1(p, bid, nb);
  if constexpr (PH == 6) phase_mid(p, smem, bid, nb);
  if constexpr (PH == 7) phase_peer(p, smem, bid, nb);
}

template <int PH>
__global__ void __launch_bounds__(256, 2) phase_kernel(Params p) {
  __shared__ __attribute__((aligned(16))) char smem[SMEM_BYTES];
  run_phase<PH>(p, smem, blockIdx.x, gridDim.x);
}

#define BW_CENSUS(j) (256 + (j) * 32)
#define BW_XSUB(j) (256 + 512 + (j) * 32)
#define BW_XGEN(j) (256 + 1024 + (j) * 32)
#define BW_TOP (256 + 1536)
#define BW_TOPGEN (256 + 1568)
__device__ __forceinline__ unsigned bw_ld(unsigned* p) { return __hip_atomic_load(p, __ATOMIC_RELAXED, __HIP_MEMORY_SCOPE_AGENT); }
__device__ __forceinline__ unsigned bw_add(unsigned* p, unsigned v) { return __hip_atomic_fetch_add(p, v, __ATOMIC_RELAXED, __HIP_MEMORY_SCOPE_AGENT); }
__device__ __forceinline__ unsigned xcc_id() { return (unsigned)__builtin_amdgcn_s_getreg((3 << 11) | 20) & 0xFu; }

__device__ __forceinline__ void grid_barrier(unsigned* bar, unsigned* st  ) {
  asm volatile("s_waitcnt vmcnt(0)" ::: "memory");
  __syncthreads();
  if (threadIdx.x == 0) {
    __builtin_amdgcn_s_waitcnt(0);
    const unsigned x = xcc_id();
    unsigned nloc = st[0], nx = st[1];
    if (nloc == 0u) {
      const unsigned G = gridDim.x;
      for (;;) {
        unsigned sum = 0u, cnt = 0u, mine = 0u;
#pragma unroll
        for (unsigned j = 0; j < 16; ++j) { const unsigned c = bw_ld(&bar[BW_CENSUS(j)]); sum += c; cnt += (c > 0u) ? 1u : 0u; mine = (j == x) ? c : mine; }
        nloc = mine; nx = cnt;
        if (sum == G) break;
        __builtin_amdgcn_s_sleep(1);
      }
      st[0] = nloc; st[1] = nx;
    }
    const unsigned old = bw_add(&bar[BW_XSUB(x)], 1u);
    const unsigned gen = old / nloc;
    if (old + 1u == (gen + 1u) * nloc) {
      __builtin_amdgcn_fence(__ATOMIC_RELEASE, "agent");
      asm volatile("s_waitcnt vmcnt(0)" ::: "memory");
      const unsigned og = bw_add(&bar[BW_TOP], 1u);
      const unsigned tg = og / nx;
      if (og + 1u == (tg + 1u) * nx) bw_add(&bar[BW_TOPGEN], 1u);
      else while (bw_ld(&bar[BW_TOPGEN]) == tg) __builtin_amdgcn_s_sleep(1);
      __builtin_amdgcn_fence(__ATOMIC_ACQUIRE, "agent");
      bw_add(&bar[BW_XGEN(x)], 1u);
      asm volatile("s_waitcnt vmcnt(0)" ::: "memory");
    } else {
      while (bw_ld(&bar[BW_XGEN(x)]) == gen) __builtin_amdgcn_s_sleep(1);
      __builtin_amdgcn_fence(__ATOMIC_ACQUIRE, "agent");
      asm volatile("s_waitcnt vmcnt(0)" ::: "memory");
    }
  }
  __syncthreads();
}

#if SINGLE_LAUNCH
typedef const __attribute__((address_space(4))) unsigned long long* kargp_t;
static_assert(sizeof(Params) % 8 == 0, "Params must be a pack of 8-byte fields");
#define RUN_PHASE(N) run_phase<N>(p_, smem, bid, nb);
__global__ void __launch_bounds__(256, 2) fwd_kernel(Params p_) {
  __shared__ __attribute__((aligned(16))) char smem[SMEM_BYTES + 64];
  const int bid = blockIdx.x, nb = gridDim.x;
  unsigned* bar = (unsigned*)(p_.ws + O_CTR);
  unsigned* st = (unsigned*)(smem + SMEM_BYTES);
  if (threadIdx.x == 0) { st[0] = 0u; st[1] = 0u; (void)bw_add(&bar[BW_CENSUS(xcc_id())], 1u); }
  if (p_.out == nullptr) cg::this_grid().sync();
  RUN_PHASE(0) grid_barrier(bar, st);
  RUN_PHASE(1) grid_barrier(bar, st);
  RUN_PHASE(2) grid_barrier(bar, st);
  RUN_PHASE(3) grid_barrier(bar, st);
  RUN_PHASE(4) grid_barrier(bar, st);
  RUN_PHASE(5) grid_barrier(bar, st);
  RUN_PHASE(6) grid_barrier(bar, st);
  RUN_PHASE(7)
}
#endif

extern "C" void kernel_launch(void* const* d_in, const int* in_sizes, int n_in, void* d_out, int out_size,
                              void* d_ws, size_t ws_size, hipStream_t stream) {
  (void)in_sizes; (void)n_in; (void)out_size; (void)ws_size;
  Params p{};
  p.x = (const float*)d_in[0]; p.p = (const float*)d_in[1]; p.positions = (const int*)d_in[2];
  p.w_in = (const float*)d_in[3]; p.b_forget = (const float*)d_in[4]; p.g_q = (const float*)d_in[5];
  p.w_uq = (const float*)d_in[6]; p.g_kv = (const float*)d_in[7]; p.w_ukv = (const float*)d_in[8];
  p.w_out = (const float*)d_in[9]; p.ln1_g = (const float*)d_in[10]; p.ln1_b = (const float*)d_in[11];
  p.peer_wq = (const float*)d_in[12]; p.keys1 = (const float*)d_in[13]; p.keys2 = (const float*)d_in[14];
  p.peer_u = (const float*)d_in[15]; p.peer_v = (const float*)d_in[16]; p.wgate = (const float*)d_in[17];
  p.wproj = (const float*)d_in[18]; p.ln2_g = (const float*)d_in[19]; p.ln2_b = (const float*)d_in[20];
  p.out = (float*)d_out;
  p.ws = (char*)d_ws;

  static int grid_blocks = 0;
  if (!grid_blocks) {
    int dev = 0, cus = 0, per_cu = 0;
    (void)hipGetDevice(&dev);
    (void)hipDeviceGetAttribute(&cus, hipDeviceAttributeMultiprocessorCount, dev);
#if SINGLE_LAUNCH
    (void)hipOccupancyMaxActiveBlocksPerMultiprocessor(&per_cu, fwd_kernel, 256, 0);
#else
    per_cu = 2;
#endif
    if (per_cu > 2) per_cu = 2;
    if (per_cu < 1) per_cu = 1;
    grid_blocks = cus * per_cu;
  }
#if SINGLE_LAUNCH
  (void)hipMemsetAsync(d_ws, 0, 16384, stream);
  void* args[] = {&p};
  hipError_t e = hipLaunchCooperativeKernel((void*)fwd_kernel, dim3(grid_blocks), dim3(256), args, 0, stream);
  if (e != hipSuccess) fprintf(stderr, "cooperative launch failed: %s (grid %d)\n", hipGetErrorString(e), grid_blocks);
#else
  phase_kernel<0><<<grid_blocks, 256, 0, stream>>>(p);
  phase_kernel<1><<<grid_blocks, 256, 0, stream>>>(p);
  phase_kernel<2><<<grid_blocks, 256, 0, stream>>>(p);
  phase_kernel<3><<<grid_blocks, 256, 0, stream>>>(p);
  phase_kernel<4><<<grid_blocks, 256, 0, stream>>>(p);
  phase_kernel<5><<<grid_blocks, 256, 0, stream>>>(p);
  phase_kernel<6><<<grid_blocks, 256, 0, stream>>>(p);
  phase_kernel<7><<<grid_blocks, 256, 0, stream>>>(p);
#endif
}
```

```cpp
#include <hip/hip_runtime.h>
#include <hip/hip_bf16.h>
#include <hip/hip_cooperative_groups.h>
#include <stdint.h>
#include <cstdio>
namespace cg = cooperative_groups;

typedef unsigned short u16;
typedef short bf16x8 __attribute__((ext_vector_type(8)));
typedef float f32x4 __attribute__((ext_vector_type(4)));
typedef unsigned u32x4 __attribute__((ext_vector_type(4)));
typedef unsigned u32x2 __attribute__((ext_vector_type(2)));

#ifndef SINGLE_LAUNCH
#define SINGLE_LAUNCH 1
#endif

constexpr int T_ = 8192, D_ = 2048, S_ = 4096, NB_ = 2;
constexpr int INW = 4168;
constexpr int NPH = 8;
constexpr float ALPHA = 1.189207115002721f;
constexpr float EPS = 1e-6f;
constexpr int SMEM_BYTES = 65536 + 1024;

constexpr size_t al256(size_t x) { return (x + 255) & ~(size_t)255; }
constexpr size_t O_CTR = 0;
constexpr size_t O_WINT = O_CTR + 16384;
constexpr size_t O_WUQT = O_WINT + al256((size_t)4224 * 2048 * 2);
constexpr size_t O_WUKVT = O_WUQT + al256((size_t)1536 * 512 * 2);
constexpr size_t O_WOUTT = O_WUKVT + al256((size_t)2048 * 512 * 2);
constexpr size_t O_WPQT = O_WOUTT + al256((size_t)2048 * 2048 * 2);
constexpr size_t O_WGT = O_WPQT + al256((size_t)1024 * 2048 * 2);
constexpr size_t O_WPT = O_WGT + al256((size_t)2048 * 2048 * 2);
constexpr size_t O_PB = O_WPT + al256((size_t)2048 * 256 * 2);
constexpr size_t O_UB = O_PB + al256((size_t)8192 * 256 * 2);
constexpr size_t O_VB = O_UB + 2048;
constexpr size_t O_OMIX = O_UB + al256((size_t)16384 * 4096);
constexpr size_t O_CS = O_OMIX + al256((size_t)8192 * 2048 * 2);
constexpr size_t O_US = O_CS + al256((size_t)8192 * 32 * 8);
constexpr size_t O_VS = O_US + al256((size_t)16384 * 4);
constexpr size_t O_REGB = O_VS + al256((size_t)16384 * 4);
constexpr size_t O_XB = O_REGB;
constexpr size_t O_CQB = O_XB + al256((size_t)8192 * 2048 * 2);
constexpr size_t O_CKVB = O_CQB + al256((size_t)8192 * 512 * 2);
constexpr size_t O_QM = O_CKVB + al256((size_t)8192 * 512 * 2);
constexpr size_t O_KM = O_QM + al256((size_t)8192 * 8 * 192 * 2);
constexpr size_t O_VMT = O_KM + al256((size_t)8192 * 8 * 192 * 2);
constexpr size_t O_QF = O_VMT + al256((size_t)8192 * 8 * 128 * 2);
constexpr size_t O_KF = O_QF + al256((size_t)8192 * 8 * 128 * 2);
constexpr size_t O_VFT = O_KF + al256((size_t)8192 * 8 * 128 * 2);
constexpr size_t O_LOGF = O_VFT + al256((size_t)8192 * 8 * 128 * 2);
constexpr size_t O_FK = O_LOGF + al256((size_t)16 * 4096 * 4);
constexpr size_t O_ENDB = O_FK + al256((size_t)16 * 4096 * 4);
constexpr size_t O_Y1 = O_REGB;
constexpr size_t O_H1B = O_Y1 + al256((size_t)8192 * 2048 * 4);
constexpr size_t O_PQ = O_H1B + al256((size_t)8192 * 2048 * 2);
constexpr size_t O_GATE = O_PQ + al256((size_t)8192 * 128 * 4);
constexpr size_t O_ENDB2 = O_GATE + al256((size_t)8192 * 128 * 4);
static_assert(O_ENDB2 <= O_ENDB, "region B reuse overflow");
static_assert(O_ENDB <= (size_t)500 * 1024 * 1024, "workspace too large");

struct Params {
  const float *x, *p; const int* positions;
  const float *w_in, *b_forget, *g_q, *w_uq, *g_kv, *w_ukv, *w_out, *ln1_g, *ln1_b;
  const float *peer_wq, *keys1, *keys2, *peer_u, *peer_v, *wgate, *wproj, *ln2_g, *ln2_b;
  float* out;
  char* ws;
#define WSP(type, name, off) __device__ __forceinline__ type* name() const { return (type*)(ws + (off)); }
  WSP(unsigned, ctr, O_CTR) WSP(u16, WinT, O_WINT) WSP(u16, WuqT, O_WUQT) WSP(u16, WukvT, O_WUKVT) WSP(u16, WoutT, O_WOUTT)
  WSP(u16, WpqT, O_WPQT) WSP(u16, WgT, O_WGT) WSP(u16, WpT, O_WPT) WSP(u16, pb, O_PB) WSP(unsigned char, Uq, O_UB) WSP(unsigned char, Vq, O_VB) WSP(float, Us, O_US) WSP(float, Vs, O_VS)
  WSP(u16, omix, O_OMIX) WSP(float2, cs, O_CS)
  WSP(u16, xb, O_XB) WSP(u16, cqb, O_CQB) WSP(u16, ckvb, O_CKVB) WSP(u16, Qm, O_QM) WSP(u16, Km, O_KM) WSP(u16, VmT, O_VMT)
  WSP(u16, Qf, O_QF) WSP(u16, Kf, O_KF) WSP(u16, VfT, O_VFT) WSP(float, logf, O_LOGF) WSP(float, Fk, O_FK)
  WSP(float, y1, O_Y1) WSP(u16, h1b, O_H1B) WSP(int, eidxG, O_PQ) WSP(float, gateG, O_GATE)
#undef WSP
};

__device__ __forceinline__ int TID() { int t = threadIdx.x; asm volatile("" : "+v"(t)); return t; }
__device__ __forceinline__ unsigned pk2(float lo, float hi) {
  unsigned r; asm volatile("v_cvt_pk_bf16_f32 %0, %1, %2" : "=v"(r) : "v"(lo), "v"(hi)); return r;
}
__device__ __forceinline__ u16 f2bf(float f) { return (u16)(pk2(f, 0.f) & 0xffffu); }
__device__ __forceinline__ float bf2f(u16 v) { return __uint_as_float(((unsigned)v) << 16); }
__device__ __forceinline__ float bflo(unsigned v) { return __uint_as_float(v << 16); }
__device__ __forceinline__ float bfhi(unsigned v) { return __uint_as_float(v & 0xffff0000u); }

template <int CTRL> __device__ __forceinline__ int dppi(int v) { return __builtin_amdgcn_update_dpp(0, v, CTRL, 0xF, 0xF, false); }
template <int CTRL> __device__ __forceinline__ float dppf(float v) { return __int_as_float(dppi<CTRL>(__float_as_int(v))); }
__device__ __forceinline__ float rdlane(float v, int l) { return __int_as_float(__builtin_amdgcn_readlane(__float_as_int(v), l)); }

__device__ __forceinline__ float row_sum(float v) {
  v += dppf<0xB1>(v); v += dppf<0x4E>(v); v += dppf<0x141>(v); v += dppf<0x140>(v); return v;
}
__device__ __forceinline__ float row_max(float v) {
  v = fmaxf(v, dppf<0xB1>(v)); v = fmaxf(v, dppf<0x4E>(v)); v = fmaxf(v, dppf<0x141>(v)); v = fmaxf(v, dppf<0x140>(v)); return v;
}
__device__ __forceinline__ float wave_sum(float v) {
  v = row_sum(v);
  return (rdlane(v, 0) + rdlane(v, 16)) + (rdlane(v, 32) + rdlane(v, 48));
}
__device__ __forceinline__ float wave_max(float v) {
  v = row_max(v);
  return fmaxf(fmaxf(rdlane(v, 0), rdlane(v, 16)), fmaxf(rdlane(v, 32), rdlane(v, 48)));
}
__device__ __forceinline__ unsigned wave_umax(unsigned v) {
  unsigned t;
  t = (unsigned)dppi<0xB1>((int)v); v = v > t ? v : t;
  t = (unsigned)dppi<0x4E>((int)v); v = v > t ? v : t;
  t = (unsigned)dppi<0x141>((int)v); v = v > t ? v : t;
  t = (unsigned)dppi<0x140>((int)v); v = v > t ? v : t;
  unsigned a = (unsigned)__builtin_amdgcn_readlane((int)v, 0), b = (unsigned)__builtin_amdgcn_readlane((int)v, 16);
  unsigned c = (unsigned)__builtin_amdgcn_readlane((int)v, 32), d = (unsigned)__builtin_amdgcn_readlane((int)v, 48);
  a = a > b ? a : b; c = c > d ? c : d; return a > c ? a : c;
}
__device__ __forceinline__ unsigned ordkey(float f) {
  unsigned u = __float_as_uint(f);
  return (u & 0x80000000u) ? ~u : (u | 0x80000000u);
}

__device__ __forceinline__ void quant_chunk(const Params& p, int chunk) {
  const int tid = TID(), lane = tid & 63, wid = tid >> 6;
#pragma unroll 1
  for (int i16 = 0; i16 < 16; ++i16) {
    const int r = chunk * 64 + wid * 16 + i16;
    const int tab = r >> 14, row = r & 16383;
    const float* src = (tab ? p.peer_v : p.peer_u) + (size_t)row * D_;
    unsigned* dst = (unsigned*)((tab ? p.Vq() : p.Uq()) + (size_t)row * 4096);
    float4 v[8];
    float am = 0.f;
#pragma unroll
    for (int i = 0; i < 8; ++i) {
      v[i] = *(const float4*)(src + (i * 64 + lane) * 4);
      am = fmaxf(am, fmaxf(fmaxf(fabsf(v[i].x), fabsf(v[i].y)), fmaxf(fabsf(v[i].z), fabsf(v[i].w))));
    }
    am = wave_max(am);
    const float qs = am > 0.f ? 224.f / am : 1.f;
#pragma unroll
    for (int i = 0; i < 8; ++i) {
      unsigned w = __builtin_amdgcn_cvt_pk_fp8_f32(v[i].x * qs, v[i].y * qs, 0, false);
      w = __builtin_amdgcn_cvt_pk_fp8_f32(v[i].z * qs, v[i].w * qs, w, true);
      dst[i * 64 + lane] = w;
    }
    if (lane == 0) (tab ? p.Vs() : p.Us())[row] = am > 0.f ? am / 224.f : 1.f;
  }
}

__device__ void transpose_cvt(const float* __restrict__ W, int ldw, int K, int src_col0, int ncols,
                              u16* __restrict__ WT, int dst_row0, const float* __restrict__ kscale,
                              float* tile, int bid, int nb) {
  const int tiles_k = K / 64, tiles_n = ncols / 64, tid = TID();
#pragma unroll 1
  for (int t = bid; t < tiles_k * tiles_n; t += nb) {
    const int tk = t % tiles_k, tn = t / tiles_k, k0 = tk * 64, n0 = tn * 64;
#pragma unroll
    for (int i = 0; i < 4; ++i) {
      const int r = (tid >> 4) + 16 * i, c = (tid & 15) * 4;
      const float4 v = *(const float4*)(W + (size_t)(k0 + r) * ldw + src_col0 + n0 + c);
      const float sc = kscale ? kscale[k0 + r] : 1.f;
      tile[r * 65 + c + 0] = v.x * sc; tile[r * 65 + c + 1] = v.y * sc;
      tile[r * 65 + c + 2] = v.z * sc; tile[r * 65 + c + 3] = v.w * sc;
    }
    __syncthreads();
    {
      const int n = tid >> 2, kk = (tid & 3) * 16;
      unsigned w[8];
#pragma unroll
      for (int e = 0; e < 8; ++e) w[e] = pk2(tile[(kk + 2 * e) * 65 + n], tile[(kk + 2 * e + 1) * 65 + n]);
      u32x4* dst = (u32x4*)(WT + (size_t)(dst_row0 + n0 + n) * K + k0 + kk);
      dst[0] = u32x4{w[0], w[1], w[2], w[3]};
      dst[1] = u32x4{w[4], w[5], w[6], w[7]};
    }
    __syncthreads();
  }
}

__device__ void cvt_bf16(const float* __restrict__ src, u16* __restrict__ dst, size_t n8, size_t gtid, size_t gthreads) {
  for (size_t i = gtid; i < n8; i += gthreads) {
    const float4 a = ((const float4*)src)[2 * i], b = ((const float4*)src)[2 * i + 1];
    ((u32x4*)dst)[i] = u32x4{pk2(a.x, a.y), pk2(a.z, a.w), pk2(b.x, b.y), pk2(b.z, b.w)};
  }
}

__device__ void phase_prep(const Params& p, char* smem, int bid, int nb) {
  const int tid = TID(), lane = tid & 63, wid = tid >> 6;
  float* tile = (float*)smem;
  if (bid == 0 && tid == 0) p.ctr()[0] = 0;
  transpose_cvt(p.w_in, INW, D_, 0, 1024, p.WinT(), 0, nullptr, tile, bid, nb);
  transpose_cvt(p.w_in, INW, D_, 1088, 3072, p.WinT(), 1024, nullptr, tile, bid, nb);
  transpose_cvt(p.w_in, INW, D_, 1024, 64, p.WinT(), 4096, nullptr, tile, bid, nb);
  transpose_cvt(p.w_uq, 1536, 512, 0, 1536, p.WuqT(), 0, p.g_q, tile, bid, nb);
  transpose_cvt(p.w_ukv, 2048, 512, 0, 2048, p.WukvT(), 0, p.g_kv, tile, bid, nb);
  transpose_cvt(p.w_out, 2048, 2048, 0, 2048, p.WoutT(), 0, nullptr, tile, bid, nb);
  transpose_cvt(p.peer_wq, 1024, 2048, 0, 1024, p.WpqT(), 0, nullptr, tile, bid, nb);
  transpose_cvt(p.wgate, 2048, 2048, 0, 2048, p.WgT(), 0, nullptr, tile, bid, nb);
  transpose_cvt(p.wproj, 2048, 256, 0, 2048, p.WpT(), 0, nullptr, tile, bid, nb);
  const size_t gtid = (size_t)bid * 256 + tid, gth = (size_t)nb * 256;
  for (size_t i = gtid; i < (size_t)64 * 2048 / 8; i += gth) ((u32x4*)(p.WinT() + (size_t)4160 * 2048))[i] = u32x4{0, 0, 0, 0};
  cvt_bf16(p.p, p.pb(), (size_t)T_ * 256 / 8, gtid, gth);
  for (size_t i = gtid; i < (size_t)T_ * 32; i += gth) {
    const int t = (int)(i >> 5), fi = (int)(i & 31);
    const float invf = 1.0f / powf(10000.0f, (float)(2 * fi) / 64.0f);
    const float ang = (float)p.positions[t] * invf;
    const double rev = (double)ang * 0.15915494309189535;
    const float fr = (float)(rev - rint(rev));
    p.cs()[i] = make_float2(__builtin_amdgcn_cosf(fr), __builtin_amdgcn_sinf(fr));
  }
  __syncthreads();
  float* wff = (float*)smem;
  for (int i = tid; i < 2048 * 2; i += 256) {
    const int k = i >> 1, hf = i & 1;
    *(float4*)(wff + k * 8 + hf * 4) = *(const float4*)(p.w_in + (size_t)k * INW + 4160 + hf * 4);
  }
  __syncthreads();
  for (int t = bid * 4 + wid; t < T_; t += nb * 4) {
    float a[8];
#pragma unroll
    for (int e = 0; e < 8; ++e) a[e] = 0.f;
#pragma unroll 1
    for (int i = 0; i < 4; ++i) {
      const int k = (i * 64 + lane) * 8;
      const float4 x0 = *(const float4*)(p.x + (size_t)t * D_ + k), x1 = *(const float4*)(p.x + (size_t)t * D_ + k + 4);
      *(u32x4*)(p.xb() + (size_t)t * D_ + k) = u32x4{pk2(x0.x, x0.y), pk2(x0.z, x0.w), pk2(x1.x, x1.y), pk2(x1.z, x1.w)};
      const float xs[8] = {x0.x, x0.y, x0.z, x0.w, x1.x, x1.y, x1.z, x1.w};
#pragma unroll
      for (int j = 0; j < 8; ++j) {
        const float4 w0 = *(const float4*)(wff + (k + j) * 8), w1 = *(const float4*)(wff + (k + j) * 8 + 4);
        a[0] += xs[j] * w0.x; a[1] += xs[j] * w0.y; a[2] += xs[j] * w0.z; a[3] += xs[j] * w0.w;
        a[4] += xs[j] * w1.x; a[5] += xs[j] * w1.y; a[6] += xs[j] * w1.z; a[7] += xs[j] * w1.w;
      }
    }
    float mine = 0.f;
#pragma unroll
    for (int e = 0; e < 8; ++e) { const float s = wave_sum(a[e]); if (lane == e) mine = s; }
    if (lane < 8) {
      const float z = mine + p.b_forget[lane];
      const float ls = fminf(z, 0.f) - log1pf(expf(-fabsf(z)));
      const int b = t >> 12, s = t & 4095;
      p.logf()[((size_t)(b * 8 + lane)) * S_ + s] = ls;
    }
  }
}

__device__ __forceinline__ void gemm_core(const u16* __restrict__ A, int lda, const u16* __restrict__ Bt, int ldb,
                                          int K, int brow, int bcol, char* smem, f32x4 (&acc)[4][4]) {
  const int tid = TID(), wid = tid >> 6, lane = tid & 63, wr = wid >> 1, wc = wid & 1, fr = lane & 15, fq = lane >> 4;
#pragma unroll
  for (int m = 0; m < 4; ++m)
#pragma unroll
    for (int n = 0; n < 4; ++n) acc[m][n] = f32x4{0.f, 0.f, 0.f, 0.f};
  const int nk = K / 64;
  const int srow = tid >> 3, sch = (tid & 7) ^ ((tid >> 4) & 7);
  const u16* ga = A + (size_t)(brow + srow) * lda + sch * 8;
  const u16* gb = Bt + (size_t)(bcol + srow) * ldb + sch * 8;
  char* sdst = smem + tid * 16;
  auto issue = [&](int kt, int st) {
    char* sa = sdst + st * 32768;
#pragma unroll
    for (int i = 0; i < 4; ++i) {
      __builtin_amdgcn_global_load_lds((const unsigned*)(ga + (size_t)i * 32 * lda + kt * 64), (unsigned*)(sa + i * 4096), 16, 0, 0);
      __builtin_amdgcn_global_load_lds((const unsigned*)(gb + (size_t)i * 32 * ldb + kt * 64), (unsigned*)(sa + 16384 + i * 4096), 16, 0, 0);
    }
  };
  const int fx = (fr >> 1) & 7;
  const int a0 = (wr * 64 + fr) * 128 + ((fq ^ fx) * 16), a1 = (wr * 64 + fr) * 128 + (((4 + fq) ^ fx) * 16);
  const int b0 = 16384 + (wc * 64 + fr) * 128 + ((fq ^ fx) * 16), b1 = 16384 + (wc * 64 + fr) * 128 + (((4 + fq) ^ fx) * 16);
  asm volatile("s_waitcnt vmcnt(0)" ::: "memory");
  __syncthreads();
  issue(0, 0);
#pragma unroll 1
  for (int kt = 0; kt < nk; ++kt) {
    asm volatile("s_waitcnt vmcnt(0)" ::: "memory");
    __builtin_amdgcn_s_barrier();
    asm volatile("" ::: "memory");
    if (kt + 1 < nk) issue(kt + 1, (kt + 1) & 1);
    const char* sb = smem + (kt & 1) * 32768;
    bf16x8 At[4], Bl[4], At2[4], Bl2[4];
#pragma unroll
    for (int m = 0; m < 4; ++m) At[m] = *reinterpret_cast<const bf16x8*>(sb + a0 + m * 2048);
#pragma unroll
    for (int n = 0; n < 4; ++n) Bl[n] = *reinterpret_cast<const bf16x8*>(sb + b0 + n * 2048);
#pragma unroll
    for (int m = 0; m < 4; ++m) At2[m] = *reinterpret_cast<const bf16x8*>(sb + a1 + m * 2048);
#pragma unroll
    for (int n = 0; n < 4; ++n) Bl2[n] = *reinterpret_cast<const bf16x8*>(sb + b1 + n * 2048);
#pragma unroll
    for (int m = 0; m < 4; ++m)
#pragma unroll
      for (int n = 0; n < 4; ++n) acc[m][n] = __builtin_amdgcn_mfma_f32_16x16x32_bf16(At[m], Bl[n], acc[m][n], 0, 0, 0);
#pragma unroll
    for (int m = 0; m < 4; ++m)
#pragma unroll
      for (int n = 0; n < 4; ++n) acc[m][n] = __builtin_amdgcn_mfma_f32_16x16x32_bf16(At2[m], Bl2[n], acc[m][n], 0, 0, 0);
  }
}

template <class Epi>
__device__ __forceinline__ void gemm128(const u16* __restrict__ A, int lda, const u16* __restrict__ Bt, int ldb,
                                        int K, int brow, int bcol, char* smem, Epi epi) {
  const int tid = TID(), wid = tid >> 6, lane = tid & 63, wr = wid >> 1, wc = wid & 1, fr = lane & 15, fq = lane >> 4;
  f32x4 acc[4][4];
  gemm_core(A, lda, Bt, ldb, K, brow, bcol, smem, acc);
  epi(acc, brow + wr * 64, bcol + wc * 64, fr, fq);
}

__device__ __forceinline__ int vblock(int bid, int nb) { return (nb & 7) ? bid : (bid & 7) * (nb >> 3) + (bid >> 3); }
__device__ __forceinline__ void tile_rc(int t, int Nt, int& tm, int& tn) {
  const int g = t / (8 * Nt), q = t % (8 * Nt);
  tn = q >> 3; tm = g * 8 + (q & 7);
}

__device__ void phase_inproj(const Params& p, char* smem, int bid, int nb) {
  const int ntn = 33, ntiles = 64 * ntn;
  for (int t = vblock(bid, nb); t < ntiles; t += nb) {
    int tm, tn; tile_rc(t, ntn, tm, tn);
    gemm128(p.xb(), D_, p.WinT(), D_, D_, tm * 128, tn * 128, smem,
      [&](f32x4 (&acc)[4][4], int row0, int col0, int fr, int fq) {
        if (col0 < 1024) {
          u16* dst = col0 < 512 ? p.cqb() : p.ckvb(); const int cb = col0 & 511;
#pragma unroll
          for (int m = 0; m < 4; ++m)
#pragma unroll
            for (int n = 0; n < 4; ++n)
#pragma unroll
              for (int j = 0; j < 4; ++j) {
                const int row = row0 + m * 16 + fq * 4 + j;
                dst[(size_t)row * 512 + cb + n * 16 + fr] = f2bf(acc[m][n][j]);
              }
        } else if (col0 < 3072) {
          int c = col0 - 1024; u16* dst = c < 1024 ? p.Qf() : p.Kf(); c &= 1023;
          const int hh = c >> 7, d0 = c & 127;
#pragma unroll
          for (int m = 0; m < 4; ++m)
#pragma unroll
            for (int n = 0; n < 4; ++n)
#pragma unroll
              for (int j = 0; j < 4; ++j) {
                const int row = row0 + m * 16 + fq * 4 + j, b = row >> 12, s = row & 4095;
                dst[((size_t)(b * 8 + hh) * S_ + s) * 128 + d0 + n * 16 + fr] = f2bf(acc[m][n][j]);
              }
        } else if (col0 < 4096) {
          const int c = col0 - 3072, hh = c >> 7, d0 = c & 127;
#pragma unroll
          for (int m = 0; m < 4; ++m)
#pragma unroll
            for (int n = 0; n < 4; ++n) {
              const int row = row0 + m * 16 + fq * 4, b = row >> 12, s = row & 4095, dv = d0 + n * 16 + fr;
              *(u32x2*)(p.VfT() + ((size_t)(b * 8 + hh) * 128 + dv) * S_ + s) =
                  u32x2{pk2(acc[m][n][0], acc[m][n][1]), pk2(acc[m][n][2], acc[m][n][3])};
            }
        } else if (col0 == 4096) {
#pragma unroll
          for (int m = 0; m < 4; ++m)
#pragma unroll
            for (int j = 0; j < 4; ++j) {
              const int row = row0 + m * 16 + fq * 4 + j, b = row >> 12, s = row & 4095;
#pragma unroll
              for (int n = 0; n < 2; ++n) {
                const int i = n * 16 + fr;
                const float2 cs = p.cs()[(size_t)row * 32 + i];
                const float x1 = acc[m][n][j], x2 = acc[m][n + 2][j];
                const u16 o1 = f2bf(x1 * cs.x - x2 * cs.y), o2 = f2bf(x1 * cs.y + x2 * cs.x);
                for (int hh = 0; hh < 8; ++hh) {
                  u16* kd = p.Km() + ((size_t)(b * 8 + hh) * S_ + s) * 192 + 128;
                  kd[i] = o1; kd[32 + i] = o2;
                }
              }
            }
        }
      });
  }
}

__device__ __forceinline__ void compute_rs(const u16* __restrict__ src, int brow, float* rsv) {
  const int tid = TID(), row = tid >> 1, hf = tid & 1;
  const u16* r = src + (size_t)(brow + row) * 512 + hf * 256;
  float ss = 0.f;
#pragma unroll 4
  for (int i = 0; i < 32; ++i) {
    const u32x4 v = *(const u32x4*)(r + i * 8);
#pragma unroll
    for (int w = 0; w < 4; ++w) { const float a = bflo(v[w]), b = bfhi(v[w]); ss += a * a + b * b; }
  }
  ss += dppf<0xB1>(ss);
  if (hf == 0) rsv[row] = rsqrtf(ss * (1.f / 512.f) + EPS);
}

__device__ void phase_up(const Params& p, char* smem, int bid, int nb) {
  float* rsv = (float*)(smem + 65536);
  const int nq = 64 * 12, nkv = 64 * 16, njobs = nq + nkv + 16;
  for (int t = vblock(bid, nb); t < njobs; t += nb) {
    if (t < nq) {
      int tm, tn; tile_rc(t, 12, tm, tn);
      compute_rs(p.cqb(), tm * 128, rsv);
      gemm128(p.cqb(), 512, p.WuqT(), 512, 512, tm * 128, tn * 128, smem,
        [&](f32x4 (&acc)[4][4], int row0, int col0, int fr, int fq) {
          const int hh = col0 / 192, off = col0 % 192;
          const int lr0 = row0 & 127;
          if (off < 128) {
#pragma unroll
            for (int m = 0; m < 4; ++m)
#pragma unroll
              for (int j = 0; j < 4; ++j) {
                const int lr = lr0 + m * 16 + fq * 4 + j, row = (row0 - lr0) + lr, b = row >> 12, s = row & 4095;
                const float rs = rsv[lr];
                u16* qd = p.Qm() + ((size_t)(b * 8 + hh) * S_ + s) * 192 + off;
#pragma unroll
                for (int n = 0; n < 4; ++n) qd[n * 16 + fr] = f2bf(acc[m][n][j] * rs);
              }
          } else {
#pragma unroll
            for (int m = 0; m < 4; ++m)
#pragma unroll
              for (int j = 0; j < 4; ++j) {
                const int lr = lr0 + m * 16 + fq * 4 + j, row = (row0 - lr0) + lr, b = row >> 12, s = row & 4095;
                const float rs = rsv[lr];
                u16* qd = p.Qm() + ((size_t)(b * 8 + hh) * S_ + s) * 192 + 128;
#pragma unroll
                for (int n = 0; n < 2; ++n) {
                  const int i = n * 16 + fr;
                  const float2 cs = p.cs()[(size_t)row * 32 + i];
                  const float x1 = acc[m][n][j] * rs, x2 = acc[m][n + 2][j] * rs;
                  qd[i] = f2bf(x1 * cs.x - x2 * cs.y); qd[32 + i] = f2bf(x1 * cs.y + x2 * cs.x);
                }
              }
          }
        });
      __syncthreads();
    } else if (t < nq + nkv) {
      int tm, tn; tile_rc(t - nq, 16, tm, tn);
      compute_rs(p.ckvb(), tm * 128, rsv);
      gemm128(p.ckvb(), 512, p.WukvT(), 512, 512, tm * 128, tn * 128, smem,
        [&](f32x4 (&acc)[4][4], int row0, int col0, int fr, int fq) {
          const int hh = col0 >> 8, off = col0 & 255;
          const int lr0 = row0 & 127;
          if (off < 128) {
#pragma unroll
            for (int m = 0; m < 4; ++m)
#pragma unroll
              for (int j = 0; j < 4; ++j) {
                const int lr = lr0 + m * 16 + fq * 4 + j, row = (row0 - lr0) + lr, b = row >> 12, s = row & 4095;
                const float rs = rsv[lr];
                u16* kd = p.Km() + ((size_t)(b * 8 + hh) * S_ + s) * 192 + off;
#pragma unroll
                for (int n = 0; n < 4; ++n) kd[n * 16 + fr] = f2bf(acc[m][n][j] * rs);
              }
          } else {
#pragma unroll
            for (int m = 0; m < 4; ++m) {
              const int lr = lr0 + m * 16 + fq * 4, row = (row0 - lr0) + lr, b = row >> 12, s = row & 4095;
              const float r0 = rsv[lr], r1 = rsv[lr + 1], r2 = rsv[lr + 2], r3 = rsv[lr + 3];
#pragma unroll
              for (int n = 0; n < 4; ++n) {
                const int dv = off - 128 + n * 16 + fr;
                *(u32x2*)(p.VmT() + ((size_t)(b * 8 + hh) * 128 + dv) * S_ + s) =
                    u32x2{pk2(acc[m][n][0] * r0, acc[m][n][1] * r1), pk2(acc[m][n][2] * r2, acc[m][n][3] * r3)};
              }
            }
          }
        });
      __syncthreads();
    } else {
      const int seq = t - nq - nkv;
      if ((TID() >> 6) == 0) {
        const int lane = TID() & 63;
        const float* src = p.logf() + (size_t)seq * S_ + lane * 64;
        float* dst = p.Fk() + (size_t)seq * S_ + lane * 64;
        float sum = 0.f;
        for (int i = 0; i < 16; ++i) { const float4 v = *(const float4*)(src + i * 4); sum += v.x; sum += v.y; sum += v.z; sum += v.w; }
        float inc = sum;
#pragma unroll
        for (int d = 1; d < 64; d <<= 1) { const float o = __shfl_up(inc, d, 64); if (lane >= d) inc += o; }
        float run = inc - sum;
        for (int i = 0; i < 16; ++i) {
          const float4 v = *(const float4*)(src + i * 4); float4 o;
          run += v.x; o.x = run; run += v.y; o.y = run; run += v.z; o.z = run; run += v.w; o.w = run;
          *(float4*)(dst + i * 4) = o;
        }
      }
    }
  }
}

#ifdef ATTN_NAIVE
__device__ void phase_attn_naive(const Params& p, char* smem, int bid, int nb) {
  const int tid = TID(), lane = tid & 63, wid = tid >> 6;
  const int per = NB_ * 8 * S_, nrows = 2 * per;
  for (int r = bid * 4 + wid; r < nrows; r += nb * 4) {
    const int type = r / per, rr = r % per, bh = rr / S_, s = rr % S_;
    const int DQ = type ? 128 : 192;
    const u16* Q = type ? p.Qf() + ((size_t)bh * S_ + s) * 128 : p.Qm() + ((size_t)bh * S_ + s) * 192;
    const u16* Kb = type ? p.Kf() + (size_t)bh * S_ * 128 : p.Km() + (size_t)bh * S_ * 192;
    const u16* VT = (type ? p.VfT() : p.VmT()) + (size_t)bh * 128 * S_;
    const float* F = p.Fk() + (size_t)bh * S_;
    const float scale = type ? 0.08838834764831845f : 0.07216878364870322f;
    float m = -1e30f, l = 0.f;
    float acc[128];
#pragma unroll
    for (int d = 0; d < 128; ++d) acc[d] = 0.f;
    const float fqv = type ? F[s] : 0.f;
    for (int k0 = 0; k0 <= s; k0 += 64) {
      const int key = k0 + lane; const bool valid = key <= s; const int keyc = valid ? key : s;
      const u16* kr = Kb + (size_t)keyc * DQ;
      float sc = 0.f;
      for (int d = 0; d < DQ; d += 8) {
        const u32x4 kv = *(const u32x4*)(kr + d), qv = *(const u32x4*)(Q + d);
#pragma unroll
        for (int w = 0; w < 4; ++w) sc += bflo(kv[w]) * bflo(qv[w]) + bfhi(kv[w]) * bfhi(qv[w]);
      }
      sc *= scale;
      if (type) sc += fqv - F[keyc];
      if (!valid) sc = -1e30f;
      const float mx = wave_max(sc), mn = fmaxf(m, mx), alpha = __expf(m - mn);
      const float pr = valid ? __expf(sc - mn) : 0.f;
      m = mn; l = l * alpha + pr;
#pragma unroll
      for (int d = 0; d < 128; ++d) acc[d] = acc[d] * alpha + pr * bf2f(VT[(size_t)d * S_ + keyc]);
    }
    const float inv = 1.f / wave_sum(l);
    float o0 = 0.f, o1 = 0.f;
#pragma unroll
    for (int d = 0; d < 128; ++d) {
      const float o = wave_sum(acc[d]) * inv;
      if (lane == (d & 63)) { if (d < 64) o0 = o; else o1 = o; }
    }
    const int b = bh >> 3, hh = bh & 7;
    u16* od = p.omix() + ((size_t)(b * S_ + s)) * 2048 + type * 1024 + hh * 128;
    od[lane] = f2bf(o0); od[64 + lane] = f2bf(o1);
  }
}

#endif
typedef float f32x16 __attribute__((ext_vector_type(16)));
template <int TYPE>
__device__ __forceinline__ void attn_item(const Params& p, char* smem, int bh, int qb) {
  constexpr int DQK = TYPE ? 128 : 192, NKS = DQK / 16, KSTR = DQK * 2 + 16, VSTR = 128;
  constexpr int KCH = DQK / 8, NKL = 64 * KCH / 256;
  constexpr float C2 = (TYPE ? 0.08838834764831845f : 0.07216878364870322f) * 1.4426950408889634f;
  char* sK = smem; char* sV = smem + 25600; float* sF = (float*)(smem + 25600 + 32768);
  const int tid = TID(), lane = tid & 63, wid = tid >> 6, c = lane & 31, hi = lane >> 5;
  const u16* Qb = (TYPE ? p.Qf() : p.Qm()) + (size_t)bh * S_ * DQK;
  const u16* Kb = (TYPE ? p.Kf() : p.Km()) + (size_t)bh * S_ * DQK;
  const u16* Vb = (TYPE ? p.VfT() : p.VmT()) + (size_t)bh * 128 * S_;
  const float* Fb = p.Fk() + (size_t)bh * S_;
  const int qrow = qb * 128 + wid * 32;
  bf16x8 qf[NKS];
#pragma unroll
  for (int ks = 0; ks < NKS; ++ks) qf[ks] = *(const bf16x8*)(Qb + (size_t)(qrow + c) * DQK + ks * 16 + hi * 8);
  f32x16 o[4];
#pragma unroll
  for (int db = 0; db < 4; ++db)
#pragma unroll
    for (int r = 0; r < 16; ++r) o[db][r] = 0.f;
  float m = -1e30f, l = 0.f;
  const int ntiles = 2 * qb + 2;
  u32x4 kreg[NKL];
  float4 freg = make_float4(0.f, 0.f, 0.f, 0.f);
  const unsigned koff = (unsigned)tid * 16u;
  auto load_k = [&](int kt) {
    const char* kb = (const char*)(Kb + (size_t)kt * 64 * DQK);
#pragma unroll
    for (int i = 0; i < NKL; ++i) kreg[i] = *(const u32x4*)(kb + i * 4096 + koff);
    if (TYPE) { if (tid < 16) freg = *(const float4*)(Fb + kt * 64 + tid * 4); }
  };
  const unsigned voff = (unsigned)((((tid >> 3) * S_) + (((tid & 7) ^ ((tid >> 4) & 7)) * 8)) * 2);
  auto load_v = [&](int kt) {
    const char* vb = (const char*)(Vb + kt * 64);
    char* dst = sV + (kt & 1) * 16384 + tid * 16;
#pragma unroll
    for (int i = 0; i < 4; ++i)
      __builtin_amdgcn_global_load_lds((const unsigned*)(vb + (size_t)i * 32 * S_ * 2 + voff), (unsigned*)(dst + i * 4096), 16, 0, 0);
  };
  auto store_tile = [&]() {
#pragma unroll
    for (int i = 0; i < NKL; ++i) { const int ch = tid + 256 * i, key = ch / KCH, dc = ch % KCH; *(u32x4*)(sK + key * KSTR + dc * 16) = kreg[i]; }
    if (TYPE) { if (tid < 16) { const float L2E = 1.4426950408889634f; *(float4*)(sF + tid * 4) = make_float4(freg.x * L2E, freg.y * L2E, freg.z * L2E, freg.w * L2E); } }
  };
  const int krow = (c & 19) | ((c & 4) << 1) | ((c & 8) >> 1);
  const char* ka0 = sK + krow * KSTR + hi * 16;
  const char* ka1 = ka0 + 32 * KSTR;
  const int vx = (c >> 1) & 7;
  int vo[2][2];
#pragma unroll
  for (int kb = 0; kb < 2; ++kb)
#pragma unroll
    for (int s2 = 0; s2 < 2; ++s2) vo[kb][s2] = c * VSTR + (((4 * kb + 2 * s2 + hi) ^ vx) * 16);
  load_k(0); load_v(0);
#pragma unroll 1
  for (int kt = 0; kt < ntiles; ++kt) {
    asm volatile("s_waitcnt vmcnt(0)" ::: "memory");
    __syncthreads();
    store_tile();
    __syncthreads();
    if (kt + 1 < ntiles) { load_k(kt + 1); load_v(kt + 1); }
    const int k0 = kt * 64;
    const char* sVc = sV + (kt & 1) * 16384;
    if (k0 <= qrow + 31) {
      f32x16 p0, p1;
#pragma unroll
      for (int r = 0; r < 16; ++r) { p0[r] = 0.f; p1[r] = 0.f; }
#pragma unroll
      for (int ks = 0; ks < NKS; ++ks) {
        const bf16x8 a0 = *(const bf16x8*)(ka0 + ks * 32), a1 = *(const bf16x8*)(ka1 + ks * 32);
        p0 = __builtin_amdgcn_mfma_f32_32x32x16_bf16(a0, qf[ks], p0, 0, 0, 0);
        p1 = __builtin_amdgcn_mfma_f32_32x32x16_bf16(a1, qf[ks], p1, 0, 0, 0);
      }
      if (TYPE) {
#pragma unroll
        for (int s = 0; s < 2; ++s) {
          const float4 f0 = *(const float4*)(sF + 16 * s + 8 * hi), f1 = *(const float4*)(sF + 16 * s + 8 * hi + 4);
          const float4 g0 = *(const float4*)(sF + 32 + 16 * s + 8 * hi), g1 = *(const float4*)(sF + 32 + 16 * s + 8 * hi + 4);
          p0[8 * s + 0] = p0[8 * s + 0] * C2 - f0.x; p0[8 * s + 1] = p0[8 * s + 1] * C2 - f0.y; p0[8 * s + 2] = p0[8 * s + 2] * C2 - f0.z; p0[8 * s + 3] = p0[8 * s + 3] * C2 - f0.w;
          p0[8 * s + 4] = p0[8 * s + 4] * C2 - f1.x; p0[8 * s + 5] = p0[8 * s + 5] * C2 - f1.y; p0[8 * s + 6] = p0[8 * s + 6] * C2 - f1.z; p0[8 * s + 7] = p0[8 * s + 7] * C2 - f1.w;
          p1[8 * s + 0] = p1[8 * s + 0] * C2 - g0.x; p1[8 * s + 1] = p1[8 * s + 1] * C2 - g0.y; p1[8 * s + 2] = p1[8 * s + 2] * C2 - g0.z; p1[8 * s + 3] = p1[8 * s + 3] * C2 - g0.w;
          p1[8 * s + 4] = p1[8 * s + 4] * C2 - g1.x; p1[8 * s + 5] = p1[8 * s + 5] * C2 - g1.y; p1[8 * s + 6] = p1[8 * s + 6] * C2 - g1.z; p1[8 * s + 7] = p1[8 * s + 7] * C2 - g1.w;
        }
      } else {
#pragma unroll
        for (int r = 0; r < 16; ++r) { p0[r] *= C2; p1[r] *= C2; }
      }
      if (k0 + 63 > qrow) {
        const int lim = qrow + c - k0 - 8 * hi;
        const float NEG = -__builtin_inff();
#pragma unroll
        for (int r = 0; r < 16; ++r) {
          const int kb = 16 * (r >> 3) + (r & 7);
          if (kb > lim) p0[r] = NEG;
          if (kb + 32 > lim) p1[r] = NEG;
        }
      }
      float mx = p0[0];
#pragma unroll
      for (int r = 1; r < 16; ++r) mx = fmaxf(mx, p0[r]);
#pragma unroll
      for (int r = 0; r < 16; ++r) mx = fmaxf(mx, p1[r]);
      {
        auto rr = __builtin_amdgcn_permlane32_swap(__float_as_uint(mx), __float_as_uint(mx), false, false);
        mx = fmaxf(__uint_as_float(rr[0]), __uint_as_float(rr[1]));
      }
      const float mn = fmaxf(m, mx);
      const float alpha = __builtin_amdgcn_exp2f(m - mn);
      m = mn;
      if (!__all(alpha == 1.f)) {
#pragma unroll
        for (int db = 0; db < 4; ++db)
#pragma unroll
          for (int r = 0; r < 16; ++r) o[db][r] *= alpha;
      }
      float ps = 0.f;
#pragma unroll
      for (int r = 0; r < 16; ++r) { p0[r] = __builtin_amdgcn_exp2f(p0[r] - mn); p1[r] = __builtin_amdgcn_exp2f(p1[r] - mn); ps += p0[r] + p1[r]; }
      l = l * alpha + ps;
      bf16x8 pa[2][2];
#pragma unroll
      for (int s = 0; s < 2; ++s) {
        u32x4 w0 = {pk2(p0[8 * s + 0], p0[8 * s + 1]), pk2(p0[8 * s + 2], p0[8 * s + 3]), pk2(p0[8 * s + 4], p0[8 * s + 5]), pk2(p0[8 * s + 6], p0[8 * s + 7])};
        u32x4 w1 = {pk2(p1[8 * s + 0], p1[8 * s + 1]), pk2(p1[8 * s + 2], p1[8 * s + 3]), pk2(p1[8 * s + 4], p1[8 * s + 5]), pk2(p1[8 * s + 6], p1[8 * s + 7])};
        pa[0][s] = *reinterpret_cast<bf16x8*>(&w0); pa[1][s] = *reinterpret_cast<bf16x8*>(&w1);
      }
#pragma unroll
      for (int db = 0; db < 4; ++db)
#pragma unroll
        for (int kb = 0; kb < 2; ++kb)
#pragma unroll
          for (int s = 0; s < 2; ++s) {
            const bf16x8 av = *(const bf16x8*)(sVc + db * 32 * VSTR + vo[kb][s]);
            o[db] = __builtin_amdgcn_mfma_f32_32x32x16_bf16(av, pa[kb][s], o[db], 0, 0, 0);
          }
    }
  }
  {
    auto rr = __builtin_amdgcn_permlane32_swap(__float_as_uint(l), __float_as_uint(l), false, false);
    const float inv = 1.f / (__uint_as_float(rr[0]) + __uint_as_float(rr[1]));
    const int b = bh >> 3, hh = bh & 7;
    u16* od = p.omix() + ((size_t)(b * S_ + qrow + c)) * 2048 + TYPE * 1024 + hh * 128 + 4 * hi;
#pragma unroll
    for (int db = 0; db < 4; ++db)
#pragma unroll
      for (int g = 0; g < 4; ++g)
        *(u32x2*)(od + 32 * db + 8 * g) = u32x2{pk2(o[db][4 * g] * inv, o[db][4 * g + 1] * inv), pk2(o[db][4 * g + 2] * inv, o[db][4 * g + 3] * inv)};
  }
}

__device__ void phase_attn(const Params& p, char* smem, int bid, int nb) {
  int* sItem = (int*)(smem + 60000);
  const int x = bid & 7;
  unsigned* q = p.ctr() + 32 + x;
  for (;;) {
    __syncthreads();
    if (TID() == 0) *sItem = (int)atomicAdd(q, 1u);
    __syncthreads();
    const int item = *sItem;
    if (item >= 128) break;
    const int qb = 31 - (item >> 2), r = item & 3, type = r >> 1, bh = x + 8 * (r & 1);
    if (type == 0) attn_item<0>(p, smem, bh, qb); else attn_item<1>(p, smem, bh, qb);
  }
  unsigned* qc = p.ctr() + 48;
  for (;;) {
    __syncthreads();
    if (TID() == 0) *sItem = (int)atomicAdd(qc, 1u);
    __syncthreads();
    const int chunk = *sItem;
    if (chunk >= 512) break;
    quant_chunk(p, chunk);
  }
}

__device__ void phase_outproj(const Params& p, char* smem, int bid, int nb) {
  const int ntiles = 64 * 16;
  for (int t = vblock(bid, nb); t < ntiles; t += nb) {
    int tm, tn; tile_rc(t, 16, tm, tn);
    gemm128(p.omix(), D_, p.WoutT(), D_, D_, tm * 128, tn * 128, smem,
      [&](f32x4 (&acc)[4][4], int row0, int col0, int fr, int fq) {
#pragma unroll
        for (int m = 0; m < 4; ++m)
#pragma unroll
          for (int n = 0; n < 4; ++n)
#pragma unroll
            for (int j = 0; j < 4; ++j) {
              const size_t idx = (size_t)(row0 + m * 16 + fq * 4 + j) * D_ + col0 + n * 16 + fr;
              p.y1()[idx] = ALPHA * p.x[idx] + acc[m][n][j];
            }
      });
  }
}

__device__ void phase_ln1(const Params& p, int bid, int nb) {
  const int lane = TID() & 63, wid = TID() >> 6;
  for (int t = bid * 4 + wid; t < T_; t += nb * 4) {
    float* row = p.y1() + (size_t)t * D_;
    float4 v[8];
    float sum = 0.f;
#pragma unroll
    for (int i = 0; i < 8; ++i) { v[i] = *(const float4*)(row + (i * 64 + lane) * 4); sum += (v[i].x + v[i].y) + (v[i].z + v[i].w); }
    const float mu = wave_sum(sum) * (1.f / D_);
    float sq = 0.f;
#pragma unroll
    for (int i = 0; i < 8; ++i) {
      v[i].x -= mu; v[i].y -= mu; v[i].z -= mu; v[i].w -= mu;
      sq += (v[i].x * v[i].x + v[i].y * v[i].y) + (v[i].z * v[i].z + v[i].w * v[i].w);
    }
    const float rstd = rsqrtf(wave_sum(sq) * (1.f / D_) + EPS);
#pragma unroll
    for (int i = 0; i < 8; ++i) {
      const int c = (i * 64 + lane) * 4;
      const float4 g = *(const float4*)(p.ln1_g + c), bb = *(const float4*)(p.ln1_b + c);
      float4 o; o.x = v[i].x * rstd * g.x + bb.x; o.y = v[i].y * rstd * g.y + bb.y; o.z = v[i].z * rstd * g.z + bb.z; o.w = v[i].w * rstd * g.w + bb.w;
      *(float4*)(row + c) = o;
      *(u32x2*)(p.h1b() + (size_t)t * D_ + c) = u32x2{pk2(o.x, o.y), pk2(o.z, o.w)};
    }
  }
}

__device__ __forceinline__ void ins16(unsigned (&t)[16], unsigned x) {
#pragma unroll
  for (int i = 0; i < 16; ++i) { const unsigned hi = t[i] > x ? t[i] : x; x = t[i] > x ? x : t[i]; t[i] = hi; }
}
__device__ __forceinline__ void ins16p(unsigned (&ck)[16], int (&ce)[16], unsigned x, int xe) {
#pragma unroll
  for (int i = 0; i < 16; ++i) {
    const bool sw = x > ck[i];
    const unsigned nk = sw ? x : ck[i], nx = sw ? ck[i] : x;
    const int ne = sw ? xe : ce[i], nxe = sw ? ce[i] : xe;
    ck[i] = nk; x = nx; ce[i] = ne; xe = nxe;
  }
}
__device__ __forceinline__ float unordkey(unsigned k) { return __uint_as_float((k & 0x80000000u) ? (k & 0x7fffffffu) : ~k); }

__device__ __forceinline__ void route_tile(const Params& p, char* smem, f32x4 (&acc)[4][4], int tm, int h) {
  const int tid = TID(), wid = tid >> 6, lane = tid & 63, wr = wid >> 1, wc = wid & 1, fr = lane & 15, fq = lane >> 4;
  __syncthreads();
  float* Qw = (float*)smem + wid * (64 * 65);
#pragma unroll
  for (int m = 0; m < 4; ++m)
#pragma unroll
    for (int n = 0; n < 4; ++n)
#pragma unroll
      for (int j = 0; j < 4; ++j) Qw[(m * 16 + fq * 4 + j) * 65 + n * 16 + fr] = acc[m][n][j];
  asm volatile("s_waitcnt lgkmcnt(0)" ::: "memory");
  float q[64];
#pragma unroll
  for (int d = 0; d < 64; ++d) q[d] = Qw[lane * 65 + d];
  __syncthreads();
  {
    float* ks = (float*)smem;
#pragma unroll
    for (int i = 0; i < 16; ++i) {
      const int idx = (i * 256 + tid) * 4;
      const float* src = (idx < 8192 ? p.keys1 : p.keys2) + (size_t)h * 8192 + (idx & 8191);
      *(float4*)(ks + idx) = *(const float4*)src;
    }
  }
  __syncthreads();
  unsigned t[16];
#pragma unroll
  for (int i = 0; i < 16; ++i) t[i] = 0u;
  {
    const float* kb = (const float*)smem + wc * 8192;
#pragma unroll 1
    for (int n = 0; n < 128; ++n) {
      float d0 = 0.f, d1 = 0.f, d2 = 0.f, d3 = 0.f;
#pragma unroll
      for (int i = 0; i < 16; ++i) {
        const float4 kv = *(const float4*)(kb + n * 64 + i * 4);
        d0 += kv.x * q[4 * i]; d1 += kv.y * q[4 * i + 1]; d2 += kv.z * q[4 * i + 2]; d3 += kv.w * q[4 * i + 3];
      }
      const float sc = (d0 + d1) + (d2 + d3);
      ins16(t, (ordkey(sc) & ~127u) | (unsigned)(127 - n));
    }
  }
  __syncthreads();
  unsigned* L = (unsigned*)smem;
#pragma unroll
  for (int r = 0; r < 16; ++r) L[(wc * 16 + r) * 128 + wr * 64 + lane] = t[r];
  __syncthreads();
  if (wid < 2) {
    const int tok = wid * 64 + lane;
    unsigned ck[16]; int ce[16];
#pragma unroll
    for (int i = 0; i < 16; ++i) { ck[i] = 0u; ce[i] = 0; }
#pragma unroll 1
    for (int a = 0; a < 16; ++a) {
      const unsigned ka = L[a * 128 + tok];
      const int i1a = (127 - (int)(ka & 127u)) * 128; const float v1a = unordkey(ka & ~127u);
      const int nbm1 = (int)((0x1112347FULL >> (4 * a)) & 15ULL);
#pragma unroll 1
      for (int b = 0; b <= nbm1; ++b) {
        const unsigned kb = L[(16 + b) * 128 + tok];
        const int i2b = 127 - (int)(kb & 127u); const float v2b = unordkey(kb & ~127u);
        ins16p(ck, ce, ordkey(v1a + v2b), i1a + i2b);
      }
    }
    float ex[16], sum = 0.f;
    const float mx = unordkey(ck[0]);
#pragma unroll
    for (int r = 0; r < 16; ++r) { ex[r] = __expf(unordkey(ck[r]) - mx); sum += ex[r]; }
    const float inv = 1.f / sum;
    const size_t o = ((size_t)(tm * 128 + tok) * 8 + h) * 16;
    int* ed = p.eidxG() + o; float* gd = p.gateG() + o;
#pragma unroll
    for (int r = 0; r < 16; r += 4) {
      *(int4*)(ed + r) = make_int4(ce[r], ce[r + 1], ce[r + 2], ce[r + 3]);
      *(float4*)(gd + r) = make_float4(ex[r] * inv, ex[r + 1] * inv, ex[r + 2] * inv, ex[r + 3] * inv);
    }
  }
}

__device__ void phase_mid(const Params& p, char* smem, int bid, int nb) {
  const int ng = 64 * 16, nq = 64 * 8;
  for (int t = vblock(bid, nb); t < ng + nq; t += nb) {
    if (t < ng) {
      int tm, tn; tile_rc(t, 16, tm, tn);
      f32x4 pacc[4][4], acc[4][4];
      gemm_core(p.pb(), 256, p.WpT(), 256, 256, tm * 128, tn * 128, smem, pacc);
      gemm_core(p.h1b(), D_, p.WgT(), D_, D_, tm * 128, tn * 128, smem, acc);
      {
        const int tid = TID(), wid = tid >> 6, lane = tid & 63, wr = wid >> 1, wc = wid & 1, fr = lane & 15, fq = lane >> 4;
        const size_t base = (size_t)(tm * 128 + wr * 64 + fq * 4) * D_ + tn * 128 + wc * 64 + fr;
        const float* yb = p.y1() + base;
        float* ob = p.out + base;
#pragma unroll
        for (int m = 0; m < 4; ++m) {
#pragma unroll
          for (int n = 0; n < 4; ++n)
#pragma unroll
            for (int j = 0; j < 4; ++j) {
              const int o = (m * 16 + j) * D_ + n * 16;
              const float sg = 1.f / (1.f + __expf(-acc[m][n][j]));
              ob[o] = ALPHA * yb[o] + pacc[m][n][j] * sg;
            }
        }
      }
    } else {
      int tm, tn; tile_rc(t - ng, 8, tm, tn);
      f32x4 acc[4][4];
      gemm_core(p.h1b(), D_, p.WpqT(), D_, D_, tm * 128, tn * 128, smem, acc);
      route_tile(p, smem, acc, tm, tn);
    }
  }
}

__device__ __forceinline__ float gelu_exact(float a) {
  const float x = fabsf(a) * 0.7071067811865476f;
  const float t = __builtin_amdgcn_rcpf(1.f + 0.3275911f * x);
  const float poly = t * (0.254829592f + t * (-0.284496736f + t * (1.421413741f + t * (-1.453152027f + t * 1.061405429f))));
  const float er = 1.f - poly * __expf(-x * x);
  return 0.5f * a * (1.f + (a < 0.f ? -er : er));
}

template <int NPER, int IDXMASK>
__device__ __forceinline__ int top16(unsigned (&k)[NPER], int lane) {
  int mine = 0;
#pragma unroll 1
  for (int r = 0; r < 16; ++r) {
    unsigned loc = k[0];
#pragma unroll
    for (int i = 1; i < NPER; ++i) loc = loc > k[i] ? loc : k[i];
    const unsigned best = wave_umax(loc);
#pragma unroll
    for (int i = 0; i < NPER; ++i) if (k[i] == best) k[i] = 0u;
    if (lane == r) mine = IDXMASK - (int)(best & (unsigned)IDXMASK);
  }
  return mine;
}

__device__ void phase_peer(const Params& p, char* smem, int bid, int nb) {
  const int tid = TID(), lane = tid & 63, wid = tid >> 6;
  float* qs = (float*)smem;
  float* sc = (float*)(smem + 8192);
  int* eidx = (int*)(smem + 24576);
  float* gts = (float*)(smem + 32768);
  for (int it = bid; it < T_ / 16; it += nb) {
    const int t0 = it * 16;
#pragma unroll
    for (int i = 0; i < 2; ++i) {
      const int idx = (i * 256 + tid) * 4;
      *(int4*)(eidx + idx) = *(const int4*)(p.eidxG() + (size_t)t0 * 128 + idx);
      *(float4*)(gts + idx) = *(const float4*)(p.gateG() + (size_t)t0 * 128 + idx);
    }
    __syncthreads();
    for (int ti = 0; ti < 4; ++ti) {
      const int tok = wid * 4 + ti, t = t0 + tok;
      typedef float f32x2 __attribute__((ext_vector_type(2)));
      float hreg[32], o[32];
#pragma unroll
      for (int c = 0; c < 2; ++c)
#pragma unroll
        for (int q = 0; q < 2; ++q) {
          const u32x4 hv = *(const u32x4*)(p.h1b() + (size_t)t * D_ + (c * 64 + lane) * 16 + q * 8);
#pragma unroll
          for (int w = 0; w < 4; ++w) { hreg[c * 16 + q * 8 + 2 * w] = bflo(hv[w]); hreg[c * 16 + q * 8 + 2 * w + 1] = bfhi(hv[w]); }
        }
#pragma unroll
      for (int i = 0; i < 32; ++i) o[i] = 0.f;
      const float* Us = p.Us(); const float* Vs = p.Vs();
      const unsigned char* Uq = p.Uq() + lane * 16; const unsigned char* Vq = p.Vq() + lane * 16;
      const int* ep = eidx + tok * 128; const float* gp = gts + tok * 128;
      u32x4 urA[2][2], vrA[2][2], urB[2][2], vrB[2][2];
      float gA[2], suA[2], svA[2], gB[2], suB[2], svB[2];
#define PEER_LOAD(UR, VR, G, SU, SV, J0)                                                              \
      _Pragma("unroll") for (int jj = 0; jj < 2; ++jj) {                                                \
        const int e = __builtin_amdgcn_readfirstlane(ep[(J0) + jj]);                                    \
        G[jj] = gp[(J0) + jj]; SU[jj] = Us[e]; SV[jj] = Vs[e];                                          \
        const unsigned char* up = Uq + (size_t)e * 4096; const unsigned char* vp = up + 2048;           \
        UR[jj][0] = *(const u32x4*)(up); UR[jj][1] = *(const u32x4*)(up + 1024);                        \
        VR[jj][0] = *(const u32x4*)(vp); VR[jj][1] = *(const u32x4*)(vp + 1024);                        \
      }
#define PEER_COMPUTE(UR, VR, G, SU, SV)                                                                 \
      _Pragma("unroll") for (int jj = 0; jj < 2; ++jj) {                                                \
        float d0 = 0.f, d1 = 0.f;                                                                       \
        _Pragma("unroll") for (int c = 0; c < 2; ++c)                                                   \
          _Pragma("unroll") for (int w = 0; w < 4; ++w) {                                               \
            const f32x2 lo = __builtin_amdgcn_cvt_pk_f32_fp8(UR[jj][c][w], false), hi2 = __builtin_amdgcn_cvt_pk_f32_fp8(UR[jj][c][w], true); \
            d0 += lo[0] * hreg[c * 16 + 4 * w]; d1 += lo[1] * hreg[c * 16 + 4 * w + 1];                \
            d0 += hi2[0] * hreg[c * 16 + 4 * w + 2]; d1 += hi2[1] * hreg[c * 16 + 4 * w + 3];          \
          }                                                                                             \
        const float av = wave_sum(d0 + d1) * SU[jj];                                                    \
        const float act = gelu_exact(av) * G[jj] * SV[jj];                                              \
        _Pragma("unroll") for (int c = 0; c < 2; ++c)                                                   \
          _Pragma("unroll") for (int w = 0; w < 4; ++w) {                                               \
            const f32x2 lo = __builtin_amdgcn_cvt_pk_f32_fp8(VR[jj][c][w], false), hi2 = __builtin_amdgcn_cvt_pk_f32_fp8(VR[jj][c][w], true); \
            o[c * 16 + 4 * w] += act * lo[0]; o[c * 16 + 4 * w + 1] += act * lo[1];                    \
            o[c * 16 + 4 * w + 2] += act * hi2[0]; o[c * 16 + 4 * w + 3] += act * hi2[1];              \
          }                                                                                             \
      }
      PEER_LOAD(urA, vrA, gA, suA, svA, 0)
#pragma unroll 1
      for (int j0 = 0; j0 < 128; j0 += 4) {
        PEER_LOAD(urB, vrB, gB, suB, svB, j0 + 2)
        PEER_COMPUTE(urA, vrA, gA, suA, svA)
        if (j0 + 4 < 128) { PEER_LOAD(urA, vrA, gA, suA, svA, j0 + 4) }
        PEER_COMPUTE(urB, vrB, gB, suB, svB)
      }
#undef PEER_LOAD
#undef PEER_COMPUTE
      float* orow = p.out + (size_t)t * D_;
      float sum = 0.f;
#pragma unroll
      for (int c = 0; c < 2; ++c)
#pragma unroll
        for (int q = 0; q < 4; ++q) {
          const float4 r0 = *(const float4*)(orow + (c * 64 + lane) * 16 + q * 4);
          o[c * 16 + q * 4 + 0] += r0.x; o[c * 16 + q * 4 + 1] += r0.y; o[c * 16 + q * 4 + 2] += r0.z; o[c * 16 + q * 4 + 3] += r0.w;
        }
#pragma unroll
      for (int i = 0; i < 32; ++i) sum += o[i];
      const float mu = wave_sum(sum) * (1.f / D_);
      float sq = 0.f;
#pragma unroll
      for (int i = 0; i < 32; ++i) { o[i] -= mu; sq += o[i] * o[i]; }
      const float rstd = rsqrtf(wave_sum(sq) * (1.f / D_) + EPS);
#pragma unroll
      for (int c = 0; c < 2; ++c)
#pragma unroll
        for (int q = 0; q < 4; ++q) {
          const int col = (c * 64 + lane) * 16 + q * 4;
          const float4 g0 = *(const float4*)(p.ln2_g + col), b0 = *(const float4*)(p.ln2_b + col);
          float4 w0;
          w0.x = o[c * 16 + q * 4 + 0] * rstd * g0.x + b0.x; w0.y = o[c * 16 + q * 4 + 1] * rstd * g0.y + b0.y;
          w0.z = o[c * 16 + q * 4 + 2] * rstd * g0.z + b0.z; w0.w = o[c * 16 + q * 4 + 3] * rstd * g0.w + b0.w;
          *(float4*)(orow + col) = w0;
        }
    }
    __syncthreads();
  }
}

template <int PH>
__device__ __forceinline__ void run_phase(const Params& p, char* smem, int bid, int nb) {
  if constexpr (PH == 0) phase_prep(p, smem, bid, nb);
  if constexpr (PH == 1) phase_inproj(p, smem, bid, nb);
  if constexpr (PH == 2) phase_up(p, smem, bid, nb);
#ifdef ATTN_NAIVE
  if constexpr (PH == 3) phase_attn_naive(p, smem, bid, nb);
#else
  if constexpr (PH == 3) phase_attn(p, smem, bid, nb);
#endif
  if constexpr (PH == 4) phase_outproj(p, smem, bid, nb);
  if constexpr (PH == 5) phase_ln1(p, bid, nb);
  if constexpr (PH == 6) phase_mid(p, smem, bid, nb);
  if constexpr (PH == 7) phase_peer(p, smem, bid, nb);
}

template <int PH>
__global__ void __launch_bounds__(256, 2) phase_kernel(Params p) {
  __shared__ __attribute__((aligned(16))) char smem[SMEM_BYTES];
  run_phase<PH>(p, smem, blockIdx.x, gridDim.x);
}

#define BW_CENSUS(j) (256 + (j) * 32)
#define BW_XSUB(j) (256 + 512 + (j) * 32)
#define BW_XGEN(j) (256 + 1024 + (j) * 32)
#define BW_TOP (256 + 1536)
#define BW_TOPGEN (256 + 1568)
__device__ __forceinline__ unsigned bw_ld(unsigned* p) { return __hip_atomic_load(p, __ATOMIC_RELAXED, __HIP_MEMORY_SCOPE_AGENT); }
__device__ __forceinline__ unsigned bw_add(unsigned* p, unsigned v) { return __hip_atomic_fetch_add(p, v, __ATOMIC_RELAXED, __HIP_MEMORY_SCOPE_AGENT); }
__device__ __forceinline__ unsigned xcc_id() { return (unsigned)__builtin_amdgcn_s_getreg((3 << 11) | 20) & 0xFu; }

__device__ __forceinline__ void grid_barrier(unsigned* bar, unsigned* st  ) {
  asm volatile("s_waitcnt vmcnt(0)" ::: "memory");
  __syncthreads();
  if (threadIdx.x == 0) {
    __builtin_amdgcn_s_waitcnt(0);
    const unsigned x = xcc_id();
    unsigned nloc = st[0], nx = st[1];
    if (nloc == 0u) {
      const unsigned G = gridDim.x;
      for (;;) {
        unsigned sum = 0u, cnt = 0u, mine = 0u;
#pragma unroll
        for (unsigned j = 0; j < 16; ++j) { const unsigned c = bw_ld(&bar[BW_CENSUS(j)]); sum += c; cnt += (c > 0u) ? 1u : 0u; mine = (j == x) ? c : mine; }
        nloc = mine; nx = cnt;
        if (sum == G) break;
        __builtin_amdgcn_s_sleep(1);
      }
      st[0] = nloc; st[1] = nx;
    }
    const unsigned old = bw_add(&bar[BW_XSUB(x)], 1u);
    const unsigned gen = old / nloc;
    if (old + 1u == (gen + 1u) * nloc) {
      __builtin_amdgcn_fence(__ATOMIC_RELEASE, "agent");
      asm volatile("s_waitcnt vmcnt(0)" ::: "memory");
      const unsigned og = bw_add(&bar[BW_TOP], 1u);
      const unsigned tg = og / nx;
      if (og + 1u == (tg + 1u) * nx) bw_add(&bar[BW_TOPGEN], 1u);
      else while (bw_ld(&bar[BW_TOPGEN]) == tg) __builtin_amdgcn_s_sleep(1);
      __builtin_amdgcn_fence(__ATOMIC_ACQUIRE, "agent");
      bw_add(&bar[BW_XGEN(x)], 1u);
      asm volatile("s_waitcnt vmcnt(0)" ::: "memory");
    } else {
      while (bw_ld(&bar[BW_XGEN(x)]) == gen) __builtin_amdgcn_s_sleep(1);
      __builtin_amdgcn_fence(__ATOMIC_ACQUIRE, "agent");
      asm volatile("s_waitcnt vmcnt(0)" ::: "memory");
    }
  }
  __syncthreads();
}

#if SINGLE_LAUNCH
typedef const __attribute__((address_space(4))) unsigned long long* kargp_t;
static_assert(sizeof(Params) % 8 == 0, "Params must be a pack of 8-byte fields");
#define RUN_PHASE(N) run_phase<N>(p_, smem, bid, nb);
__global__ void __launch_bounds__(256, 2) fwd_kernel(Params p_) {
  __shared__ __attribute__((aligned(16))) char smem[SMEM_BYTES + 64];
  const int bid = blockIdx.x, nb = gridDim.x;
  unsigned* bar = (unsigned*)(p_.ws + O_CTR);
  unsigned* st = (unsigned*)(smem + SMEM_BYTES);
  if (threadIdx.x == 0) { st[0] = 0u; st[1] = 0u; (void)bw_add(&bar[BW_CENSUS(xcc_id())], 1u); }
  if (p_.out == nullptr) cg::this_grid().sync();
  RUN_PHASE(0) grid_barrier(bar, st);
  RUN_PHASE(1) grid_barrier(bar, st);
  RUN_PHASE(2) grid_barrier(bar, st);
  RUN_PHASE(3) grid_barrier(bar, st);
  RUN_PHASE(4) grid_barrier(bar, st);
  RUN_PHASE(5) grid_barrier(bar, st);
  RUN_PHASE(6) grid_barrier(bar, st);
  RUN_PHASE(7)
}
#endif

extern "C" void kernel_launch(void* const* d_in, const int* in_sizes, int n_in, void* d_out, int out_size,
                              void* d_ws, size_t ws_size, hipStream_t stream) {
  (void)in_sizes; (void)n_in; (void)out_size; (void)ws_size;
  Params p{};
  p.x = (const float*)d_in[0]; p.p = (const float*)d_in[1]; p.positions = (const int*)d_in[2];
  p.w_in = (const float*)d_in[3]; p.b_forget = (const float*)d_in[4]; p.g_q = (const float*)d_in[5];
  p.w_uq = (const float*)d_in[6]; p.g_kv = (const float*)d_in[7]; p.w_ukv = (const float*)d_in[8];
  p.w_out = (const float*)d_in[9]; p.ln1_g = (const float*)d_in[10]; p.ln1_b = (const float*)d_in[11];
  p.peer_wq = (const float*)d_in[12]; p.keys1 = (const float*)d_in[13]; p.keys2 = (const float*)d_in[14];
  p.peer_u = (const float*)d_in[15]; p.peer_v = (const float*)d_in[16]; p.wgate = (const float*)d_in[17];
  p.wproj = (const float*)d_in[18]; p.ln2_g = (const float*)d_in[19]; p.ln2_b = (const float*)d_in[20];
  p.out = (float*)d_out;
  p.ws = (char*)d_ws;

  static int grid_blocks = 0;
  if (!grid_blocks) {
    int dev = 0, cus = 0, per_cu = 0;
    (void)hipGetDevice(&dev);
    (void)hipDeviceGetAttribute(&cus, hipDeviceAttributeMultiprocessorCount, dev);
#if SINGLE_LAUNCH
    (void)hipOccupancyMaxActiveBlocksPerMultiprocessor(&per_cu, fwd_kernel, 256, 0);
#else
    per_cu = 2;
#endif
    if (per_cu > 2) per_cu = 2;
    if (per_cu < 1) per_cu = 1;
    grid_blocks = cus * per_cu;
  }
#if SINGLE_LAUNCH
  (void)hipMemsetAsync(d_ws, 0, 16384, stream);
  void* args[] = {&p};
  hipError_t e = hipLaunchCooperativeKernel((void*)fwd_kernel, dim3(grid_blocks), dim3(256), args, 0, stream);
  if (e != hipSuccess) fprintf(stderr, "cooperative launch failed: %s (grid %d)\n", hipGetErrorString(e), grid_blocks);
#else
  phase_kernel<0><<<grid_blocks, 256, 0, stream>>>(p);
  phase_kernel<1><<<grid_blocks, 256, 0, stream>>>(p);
  phase_kernel<2><<<grid_blocks, 256, 0, stream>>>(p);
  phase_kernel<3><<<grid_blocks, 256, 0, stream>>>(p);
  phase_kernel<4><<<grid_blocks, 256, 0, stream>>>(p);
  phase_kernel<5><<<grid_blocks, 256, 0, stream>>>(p);
  phase_kernel<6><<<grid_blocks, 256, 0, stream>>>(p);
  phase_kernel<7><<<grid_blocks, 256, 0, stream>>>(p);
#endif
}
```

```cpp
#include <hip/hip_runtime.h>
#include <hip/hip_bf16.h>
#include <hip/hip_cooperative_groups.h>
#include <stdint.h>
#include <cstdio>
namespace cg = cooperative_groups;

typedef unsigned short u16;
typedef short bf16x8 __attribute__((ext_vector_type(8)));
typedef float f32x4 __attribute__((ext_vector_type(4)));
typedef unsigned u32x4 __attribute__((ext_vector_type(4)));
typedef unsigned u32x2 __attribute__((ext_vector_type(2)));

#ifndef SINGLE_LAUNCH
#define SINGLE_LAUNCH 1
#endif

constexpr int T_ = 8192, D_ = 2048, S_ = 4096, NB_ = 2;
constexpr int INW = 4168;
constexpr int NPH = 8;
constexpr float ALPHA = 1.189207115002721f;
constexpr float EPS = 1e-6f;
constexpr int NT = 512;
constexpr int SMEM_BYTES = 133120;

constexpr size_t al256(size_t x) { return (x + 255) & ~(size_t)255; }
constexpr size_t O_CTR = 0;
constexpr size_t O_WINT = O_CTR + 16384;
constexpr size_t O_WUQT = O_WINT + al256((size_t)4352 * 2048 * 2);
constexpr size_t O_WUKVT = O_WUQT + al256((size_t)1536 * 512 * 2);
constexpr size_t O_WOUTT = O_WUKVT + al256((size_t)2048 * 512 * 2);
constexpr size_t O_WPQT = O_WOUTT + al256((size_t)2048 * 2048 * 2);
constexpr size_t O_WGT = O_WPQT + al256((size_t)1024 * 2048 * 2);
constexpr size_t O_WPT = O_WGT + al256((size_t)2048 * 2048 * 2);
constexpr size_t O_PB = O_WPT + al256((size_t)2048 * 256 * 2);
constexpr size_t O_UB = O_PB + al256((size_t)8192 * 256 * 2);
constexpr size_t O_VB = O_UB + 2048;
constexpr size_t O_OMIX = O_UB + al256((size_t)16384 * 4096);
constexpr size_t O_CS = O_OMIX + al256((size_t)8192 * 2048 * 2);
constexpr size_t O_PROJB = O_CS + al256((size_t)8192 * 32 * 8);
constexpr size_t O_US = O_PROJB + al256((size_t)8192 * 2048 * 2);
constexpr size_t O_VS = O_US + al256((size_t)16384 * 4);
constexpr size_t O_REGB = O_VS + al256((size_t)16384 * 4);
constexpr size_t O_XB = O_REGB;
constexpr size_t O_CQB = O_XB + al256((size_t)8192 * 2048 * 2);
constexpr size_t O_CKVB = O_CQB + al256((size_t)8192 * 512 * 2);
constexpr size_t O_QM = O_CKVB + al256((size_t)8192 * 512 * 2);
constexpr size_t O_KM = O_QM + al256((size_t)8192 * 8 * 192 * 2);
constexpr size_t O_VMT = O_KM + al256((size_t)8192 * 8 * 192 * 2);
constexpr size_t O_QF = O_VMT + al256((size_t)8192 * 8 * 128 * 2);
constexpr size_t O_KF = O_QF + al256((size_t)8192 * 8 * 128 * 2);
constexpr size_t O_VFT = O_KF + al256((size_t)8192 * 8 * 128 * 2);
constexpr size_t O_LOGF = O_VFT + al256((size_t)8192 * 8 * 128 * 2);
constexpr size_t O_FK = O_LOGF + al256((size_t)16 * 4096 * 4);
constexpr size_t O_KRS = O_FK + al256((size_t)16 * 4096 * 4);
constexpr size_t O_ENDB = O_KRS + al256((size_t)8192 * 64 * 4);
constexpr size_t O_Y1 = O_REGB;
constexpr size_t O_H1B = O_Y1 + al256((size_t)8192 * 2048 * 4);
constexpr size_t O_PQ = O_H1B + al256((size_t)8192 * 2048 * 2);
constexpr size_t O_GATE = O_PQ + al256((size_t)8192 * 128 * 4);
constexpr size_t O_ENDB2 = O_GATE + al256((size_t)8192 * 128 * 4);
static_assert(O_ENDB2 <= O_ENDB, "region B reuse overflow");
static_assert(O_ENDB <= (size_t)500 * 1024 * 1024, "workspace too large");

struct Params {
  const float *x, *p; const int* positions;
  const float *w_in, *b_forget, *g_q, *w_uq, *g_kv, *w_ukv, *w_out, *ln1_g, *ln1_b;
  const float *peer_wq, *keys1, *keys2, *peer_u, *peer_v, *wgate, *wproj, *ln2_g, *ln2_b;
  float* out;
  char* ws;
#define WSP(type, name, off) __device__ __forceinline__ type* name() const { return (type*)(ws + (off)); }
  WSP(unsigned, ctr, O_CTR) WSP(u16, WinT, O_WINT) WSP(u16, WuqT, O_WUQT) WSP(u16, WukvT, O_WUKVT) WSP(u16, WoutT, O_WOUTT)
  WSP(u16, WpqT, O_WPQT) WSP(u16, WgT, O_WGT) WSP(u16, WpT, O_WPT) WSP(u16, pb, O_PB) WSP(unsigned char, Uq, O_UB) WSP(unsigned char, Vq, O_VB) WSP(float, Us, O_US) WSP(float, Vs, O_VS)
  WSP(u16, omix, O_OMIX) WSP(float2, cs, O_CS) WSP(u16, projb, O_PROJB)
  WSP(u16, xb, O_XB) WSP(u16, cqb, O_CQB) WSP(u16, ckvb, O_CKVB) WSP(u16, Qm, O_QM) WSP(u16, Km, O_KM) WSP(u16, VmT, O_VMT)
  WSP(u16, Qf, O_QF) WSP(u16, Kf, O_KF) WSP(u16, VfT, O_VFT) WSP(float, logf, O_LOGF) WSP(float, Fk, O_FK) WSP(float, krsum, O_KRS)
  WSP(float, y1, O_Y1) WSP(u16, h1b, O_H1B) WSP(int, eidxG, O_PQ) WSP(float, gateG, O_GATE)
#undef WSP
};

__device__ __forceinline__ int TID() { int t = threadIdx.x; asm volatile("" : "+v"(t)); return t; }
__device__ __forceinline__ unsigned pk2(float lo, float hi) {
  unsigned r; asm volatile("v_cvt_pk_bf16_f32 %0, %1, %2" : "=v"(r) : "v"(lo), "v"(hi)); return r;
}
__device__ __forceinline__ u16 f2bf(float f) { return (u16)(pk2(f, 0.f) & 0xffffu); }
__device__ __forceinline__ float bf2f(u16 v) { return __uint_as_float(((unsigned)v) << 16); }
__device__ __forceinline__ float bflo(unsigned v) { return __uint_as_float(v << 16); }
__device__ __forceinline__ float bfhi(unsigned v) { return __uint_as_float(v & 0xffff0000u); }

template <int CTRL> __device__ __forceinline__ int dppi(int v) { return __builtin_amdgcn_update_dpp(0, v, CTRL, 0xF, 0xF, false); }
template <int CTRL> __device__ __forceinline__ float dppf(float v) { return __int_as_float(dppi<CTRL>(__float_as_int(v))); }
__device__ __forceinline__ float rdlane(float v, int l) { return __int_as_float(__builtin_amdgcn_readlane(__float_as_int(v), l)); }

__device__ __forceinline__ float row_sum(float v) {
  v += dppf<0xB1>(v); v += dppf<0x4E>(v); v += dppf<0x141>(v); v += dppf<0x140>(v); return v;
}
__device__ __forceinline__ float row_max(float v) {
  v = fmaxf(v, dppf<0xB1>(v)); v = fmaxf(v, dppf<0x4E>(v)); v = fmaxf(v, dppf<0x141>(v)); v = fmaxf(v, dppf<0x140>(v)); return v;
}
__device__ __forceinline__ float wave_sum(float v) {
  v = row_sum(v);
  return (rdlane(v, 0) + rdlane(v, 16)) + (rdlane(v, 32) + rdlane(v, 48));
}
__device__ __forceinline__ float wave_max(float v) {
  v = row_max(v);
  return fmaxf(fmaxf(rdlane(v, 0), rdlane(v, 16)), fmaxf(rdlane(v, 32), rdlane(v, 48)));
}
__device__ __forceinline__ unsigned wave_umax(unsigned v) {
  unsigned t;
  t = (unsigned)dppi<0xB1>((int)v); v = v > t ? v : t;
  t = (unsigned)dppi<0x4E>((int)v); v = v > t ? v : t;
  t = (unsigned)dppi<0x141>((int)v); v = v > t ? v : t;
  t = (unsigned)dppi<0x140>((int)v); v = v > t ? v : t;
  unsigned a = (unsigned)__builtin_amdgcn_readlane((int)v, 0), b = (unsigned)__builtin_amdgcn_readlane((int)v, 16);
  unsigned c = (unsigned)__builtin_amdgcn_readlane((int)v, 32), d = (unsigned)__builtin_amdgcn_readlane((int)v, 48);
  a = a > b ? a : b; c = c > d ? c : d; return a > c ? a : c;
}
__device__ __forceinline__ unsigned ordkey(float f) {
  unsigned u = __float_as_uint(f);
  return (u & 0x80000000u) ? ~u : (u | 0x80000000u);
}

__device__ __forceinline__ void quant_chunk(const Params& p, int chunk) {
  const int tid = TID(), lane = tid & 63, wid = tid >> 6;
#pragma unroll 1
  for (int i16 = 0; i16 < 8; ++i16) {
    const int r = chunk * 64 + wid * 8 + i16;
    const int tab = r >> 14, row = r & 16383;
    const float* src = (tab ? p.peer_v : p.peer_u) + (size_t)row * D_;
    unsigned* dst = (unsigned*)((tab ? p.Vq() : p.Uq()) + (size_t)row * 4096);
    float4 v[8];
    float am = 0.f;
#pragma unroll
    for (int i = 0; i < 8; ++i) {
      v[i] = *(const float4*)(src + (i * 64 + lane) * 4);
      am = fmaxf(am, fmaxf(fmaxf(fabsf(v[i].x), fabsf(v[i].y)), fmaxf(fabsf(v[i].z), fabsf(v[i].w))));
    }
    am = wave_max(am);
    const float qs = am > 0.f ? 224.f / am : 1.f;
#pragma unroll
    for (int i = 0; i < 8; ++i) {
      unsigned w = __builtin_amdgcn_cvt_pk_fp8_f32(v[i].x * qs, v[i].y * qs, 0, false);
      w = __builtin_amdgcn_cvt_pk_fp8_f32(v[i].z * qs, v[i].w * qs, w, true);
      dst[i * 64 + lane] = w;
    }
    if (lane == 0) (tab ? p.Vs() : p.Us())[row] = am > 0.f ? am / 224.f : 1.f;
  }
}

__device__ void transpose_cvt(const float* __restrict__ W, int ldw, int K, int src_col0, int ncols,
                              u16* __restrict__ WT, int dst_row0, const float* __restrict__ kscale,
                              float* tile, int bid, int nb) {
  const int tiles_k = K / 64, tiles_n = ncols / 64, tid = TID();
#pragma unroll 1
  for (int t = bid; t < tiles_k * tiles_n; t += nb) {
    const int tk = t % tiles_k, tn = t / tiles_k, k0 = tk * 64, n0 = tn * 64;
#pragma unroll
    for (int i = 0; i < 2; ++i) {
      const int r = (tid >> 4) + 32 * i, c = (tid & 15) * 4;
      const float4 v = *(const float4*)(W + (size_t)(k0 + r) * ldw + src_col0 + n0 + c);
      const float sc = kscale ? kscale[k0 + r] : 1.f;
      tile[r * 65 + c + 0] = v.x * sc; tile[r * 65 + c + 1] = v.y * sc;
      tile[r * 65 + c + 2] = v.z * sc; tile[r * 65 + c + 3] = v.w * sc;
    }
    __syncthreads();
    {
      const int n = tid >> 3, kk = (tid & 7) * 8;
      unsigned w[4];
#pragma unroll
      for (int e = 0; e < 4; ++e) w[e] = pk2(tile[(kk + 2 * e) * 65 + n], tile[(kk + 2 * e + 1) * 65 + n]);
      *(u32x4*)(WT + (size_t)(dst_row0 + n0 + n) * K + k0 + kk) = u32x4{w[0], w[1], w[2], w[3]};
    }
    __syncthreads();
  }
}

__device__ void cvt_bf16(const float* __restrict__ src, u16* __restrict__ dst, size_t n8, size_t gtid, size_t gthreads) {
  for (size_t i = gtid; i < n8; i += gthreads) {
    const float4 a = ((const float4*)src)[2 * i], b = ((const float4*)src)[2 * i + 1];
    ((u32x4*)dst)[i] = u32x4{pk2(a.x, a.y), pk2(a.z, a.w), pk2(b.x, b.y), pk2(b.z, b.w)};
  }
}

__device__ void phase_prep(const Params& p, char* smem, int bid, int nb) {
  const int tid = TID(), lane = tid & 63, wid = tid >> 6;
  float* tile = (float*)smem;
  if (bid == 0 && tid == 0) p.ctr()[0] = 0;
  transpose_cvt(p.w_in, INW, D_, 0, 1024, p.WinT(), 0, nullptr, tile, bid, nb);
  transpose_cvt(p.w_in, INW, D_, 1088, 3072, p.WinT(), 1024, nullptr, tile, bid, nb);
  transpose_cvt(p.w_in, INW, D_, 1024, 64, p.WinT(), 4096, nullptr, tile, bid, nb);
  transpose_cvt(p.w_uq, 1536, 512, 0, 1536, p.WuqT(), 0, p.g_q, tile, bid, nb);
  transpose_cvt(p.w_ukv, 2048, 512, 0, 2048, p.WukvT(), 0, p.g_kv, tile, bid, nb);
  transpose_cvt(p.w_out, 2048, 2048, 0, 2048, p.WoutT(), 0, nullptr, tile, bid, nb);
  transpose_cvt(p.peer_wq, 1024, 2048, 0, 1024, p.WpqT(), 0, nullptr, tile, bid, nb);
  transpose_cvt(p.wgate, 2048, 2048, 0, 2048, p.WgT(), 0, nullptr, tile, bid, nb);
  transpose_cvt(p.wproj, 2048, 256, 0, 2048, p.WpT(), 0, nullptr, tile, bid, nb);
  const size_t gtid = (size_t)bid * NT + tid, gth = (size_t)nb * NT;
  for (size_t i = gtid; i < (size_t)192 * 2048 / 8; i += gth) ((u32x4*)(p.WinT() + (size_t)4160 * 2048))[i] = u32x4{0, 0, 0, 0};
  cvt_bf16(p.p, p.pb(), (size_t)T_ * 256 / 8, gtid, gth);
  for (size_t i = gtid; i < (size_t)T_ * 64 / 4; i += gth) ((float4*)p.krsum())[i] = make_float4(0.f, 0.f, 0.f, 0.f);
  for (size_t i = gtid; i < (size_t)T_ * 32; i += gth) {
    const int t = (int)(i >> 5), fi = (int)(i & 31);
    const float invf = 1.0f / powf(10000.0f, (float)(2 * fi) / 64.0f);
    const float ang = (float)p.positions[t] * invf;
    const double rev = (double)ang * 0.15915494309189535;
    const float fr = (float)(rev - rint(rev));
    p.cs()[i] = make_float2(__builtin_amdgcn_cosf(fr), __builtin_amdgcn_sinf(fr));
  }
  __syncthreads();
  float* wff = (float*)smem;
  for (int i = tid; i < 2048 * 2; i += NT) {
    const int k = i >> 1, hf = i & 1;
    *(float4*)(wff + k * 8 + hf * 4) = *(const float4*)(p.w_in + (size_t)k * INW + 4160 + hf * 4);
  }
  __syncthreads();
  for (int t = bid * 8 + wid; t < T_; t += nb * 8) {
    float a[8];
#pragma unroll
    for (int e = 0; e < 8; ++e) a[e] = 0.f;
#pragma unroll 1
    for (int i = 0; i < 4; ++i) {
      const int k = (i * 64 + lane) * 8;
      const float4 x0 = *(const float4*)(p.x + (size_t)t * D_ + k), x1 = *(const float4*)(p.x + (size_t)t * D_ + k + 4);
      *(u32x4*)(p.xb() + (size_t)t * D_ + k) = u32x4{pk2(x0.x, x0.y), pk2(x0.z, x0.w), pk2(x1.x, x1.y), pk2(x1.z, x1.w)};
      const float xs[8] = {x0.x, x0.y, x0.z, x0.w, x1.x, x1.y, x1.z, x1.w};
#pragma unroll
      for (int j = 0; j < 8; ++j) {
        const float4 w0 = *(const float4*)(wff + (k + j) * 8), w1 = *(const float4*)(wff + (k + j) * 8 + 4);
        a[0] += xs[j] * w0.x; a[1] += xs[j] * w0.y; a[2] += xs[j] * w0.z; a[3] += xs[j] * w0.w;
        a[4] += xs[j] * w1.x; a[5] += xs[j] * w1.y; a[6] += xs[j] * w1.z; a[7] += xs[j] * w1.w;
      }
    }
    float mine = 0.f;
#pragma unroll
    for (int e = 0; e < 8; ++e) { const float s = wave_sum(a[e]); if (lane == e) mine = s; }
    if (lane < 8) {
      const float z = mine + p.b_forget[lane];
      const float ls = fminf(z, 0.f) - log1pf(expf(-fabsf(z)));
      const int b = t >> 12, s = t & 4095;
      p.logf()[((size_t)(b * 8 + lane)) * S_ + s] = ls;
    }
  }
}

template <int WM, int WN>
__device__ __forceinline__ void gemm_core(const u16* __restrict__ A, int lda, const u16* __restrict__ Bt, int ldb,
                                          int K, int brow, int bcol, char* smem, f32x4 (&acc)[4 / WM][4][4]) {
  constexpr int MS = 4 / WM, BN = 64 * WN, NBL = BN / 64;
  static_assert(WM * WN == 8, "8 waves");
  const int tid = TID(), wid = tid >> 6, lane = tid & 63, wr = wid / WN, wc = wid % WN, fr = lane & 15, fq = lane >> 4;
#pragma unroll
  for (int h = 0; h < MS; ++h)
#pragma unroll
    for (int m = 0; m < 4; ++m)
#pragma unroll
      for (int n = 0; n < 4; ++n) acc[h][m][n] = f32x4{0.f, 0.f, 0.f, 0.f};
  const int nk = K / 64;
  const int srow = tid >> 3, sch = (tid & 7) ^ ((tid >> 4) & 7);
  const u16* ga = A + (size_t)(brow + srow) * lda + sch * 8;
  const u16* gb = Bt + (size_t)(bcol + srow) * ldb + sch * 8;
  char* sdst = smem + tid * 16;
  auto issue = [&](int kt, int st) {
    char* sa = sdst + st * 65536;
#pragma unroll
    for (int i = 0; i < 4; ++i)
      __builtin_amdgcn_global_load_lds((const unsigned*)(ga + (size_t)i * 64 * lda + kt * 64), (unsigned*)(sa + i * 8192), 16, 0, 0);
#pragma unroll
    for (int i = 0; i < NBL; ++i)
      __builtin_amdgcn_global_load_lds((const unsigned*)(gb + (size_t)i * 64 * ldb + kt * 64), (unsigned*)(sa + 32768 + i * 8192), 16, 0, 0);
  };
  const int fx = (fr >> 1) & 7;
  const int arow = (wr * (256 / WM) + fr) * 128, brw = 32768 + (wc * 64 + fr) * 128;
  const int c0 = (fq ^ fx) * 16, c1 = ((4 + fq) ^ fx) * 16;
  asm volatile("s_waitcnt vmcnt(0)" ::: "memory");
  __syncthreads();
  issue(0, 0);
#pragma unroll 1
  for (int kt = 0; kt < nk; ++kt) {
    asm volatile("s_waitcnt vmcnt(0)" ::: "memory");
    __builtin_amdgcn_s_barrier();
    asm volatile("" ::: "memory");
    if (kt + 1 < nk) issue(kt + 1, (kt + 1) & 1);
    const char* sb = smem + (kt & 1) * 65536;
#pragma unroll
    for (int ks = 0; ks < 2; ++ks) {
      const int co = ks ? c1 : c0;
      bf16x8 Bl[4];
#pragma unroll
      for (int n = 0; n < 4; ++n) Bl[n] = *reinterpret_cast<const bf16x8*>(sb + brw + co + n * 2048);
#pragma unroll
      for (int h = 0; h < MS; ++h) {
        bf16x8 At[4];
#pragma unroll
        for (int m = 0; m < 4; ++m) At[m] = *reinterpret_cast<const bf16x8*>(sb + arow + co + (h * 4 + m) * 2048);
#pragma unroll
        for (int m = 0; m < 4; ++m)
#pragma unroll
          for (int n = 0; n < 4; ++n) acc[h][m][n] = __builtin_amdgcn_mfma_f32_16x16x32_bf16(At[m], Bl[n], acc[h][m][n], 0, 0, 0);
      }
    }
  }
}

template <int WM, int WN, class Epi>
__device__ __forceinline__ void gemm_tile(const u16* __restrict__ A, int lda, const u16* __restrict__ Bt, int ldb,
                                          int K, int brow, int bcol, char* smem, Epi epi) {
  constexpr int MS = 4 / WM;
  const int tid = TID(), wid = tid >> 6, lane = tid & 63, wr = wid / WN, wc = wid % WN, fr = lane & 15, fq = lane >> 4;
  f32x4 acc[MS][4][4];
  gemm_core<WM, WN>(A, lda, Bt, ldb, K, brow, bcol, smem, acc);
#pragma unroll
  for (int h = 0; h < MS; ++h) epi(acc[h], brow + wr * (256 / WM) + h * 64, bcol + wc * 64, fr, fq);
}

__device__ __forceinline__ int vblock(int bid, int nb) { return (nb & 7) ? bid : (bid & 7) * (nb >> 3) + (bid >> 3); }
__device__ __forceinline__ void tile_rc(int t, int Nt, int& tm, int& tn) {
  const int g = t / (8 * Nt), q = t % (8 * Nt);
  tn = q >> 3; tm = g * 8 + (q & 7);
}

__device__ void phase_inproj(const Params& p, char* smem, int bid, int nb) {
  const int ntn = 16, ntiles = 32 * ntn;
  for (int t = vblock(bid, nb); t < ntiles + 256; t += nb) {
    if (t >= ntiles) {
      const int idx = t - ntiles, tm = idx >> 3, ks = idx & 7;
      f32x4 acc[2][4][4];
      gemm_core<2, 4>(p.xb() + ks * 256, D_, p.WinT() + ks * 256, D_, 256, tm * 256, 4096, smem, acc);
      const int tid = TID(), wid = tid >> 6, lane = tid & 63, wr = wid >> 2, wc = wid & 3, fr = lane & 15, fq = lane >> 4;
      if (wc == 0) {
#pragma unroll
        for (int h = 0; h < 2; ++h) {
          float* kd = p.krsum() + (size_t)(tm * 256 + wr * 128 + h * 64 + fq * 4) * 64 + fr;
#pragma unroll
          for (int m = 0; m < 4; ++m)
#pragma unroll
            for (int n = 0; n < 4; ++n)
#pragma unroll
              for (int j = 0; j < 4; ++j) atomicAdd(kd + (m * 16 + j) * 64 + n * 16, acc[h][m][n][j]);
        }
      }
      continue;
    }
    int tm, tn; tile_rc(t, ntn, tm, tn);
    gemm_tile<2, 4>(p.xb(), D_, p.WinT(), D_, D_, tm * 256, tn * 256, smem,
      [&](f32x4 (&acc)[4][4], int row0, int col0, int fr, int fq) {
        if (col0 < 1024) {
          u16* dst = col0 < 512 ? p.cqb() : p.ckvb(); const int cb = col0 & 511;
#pragma unroll
          for (int m = 0; m < 4; ++m)
#pragma unroll
            for (int n = 0; n < 4; ++n)
#pragma unroll
              for (int j = 0; j < 4; ++j) {
                const int row = row0 + m * 16 + fq * 4 + j;
                dst[(size_t)row * 512 + cb + n * 16 + fr] = f2bf(acc[m][n][j]);
              }
        } else if (col0 < 3072) {
          int c = col0 - 1024; u16* dst = c < 1024 ? p.Qf() : p.Kf(); c &= 1023;
          const int hh = c >> 7, d0 = c & 127;
#pragma unroll
          for (int m = 0; m < 4; ++m)
#pragma unroll
            for (int n = 0; n < 4; ++n)
#pragma unroll
              for (int j = 0; j < 4; ++j) {
                const int row = row0 + m * 16 + fq * 4 + j, b = row >> 12, s = row & 4095;
                dst[((size_t)(b * 8 + hh) * S_ + s) * 128 + d0 + n * 16 + fr] = f2bf(acc[m][n][j]);
              }
        } else if (col0 < 4096) {
          const int c = col0 - 3072, hh = c >> 7, d0 = c & 127;
#pragma unroll
          for (int m = 0; m < 4; ++m)
#pragma unroll
            for (int n = 0; n < 4; ++n) {
              const int row = row0 + m * 16 + fq * 4, b = row >> 12, s = row & 4095, dv = d0 + n * 16 + fr;
              *(u32x2*)(p.VfT() + ((size_t)(b * 8 + hh) * 128 + dv) * S_ + s) =
                  u32x2{pk2(acc[m][n][0], acc[m][n][1]), pk2(acc[m][n][2], acc[m][n][3])};
            }
        } else if (col0 == 4096) {
#pragma unroll
          for (int m = 0; m < 4; ++m)
#pragma unroll
            for (int j = 0; j < 4; ++j) {
              const int row = row0 + m * 16 + fq * 4 + j, b = row >> 12, s = row & 4095;
#pragma unroll
              for (int n = 0; n < 2; ++n) {
                const int i = n * 16 + fr;
                const float2 cs = p.cs()[(size_t)row * 32 + i];
                const float x1 = acc[m][n][j], x2 = acc[m][n + 2][j];
                const u16 o1 = f2bf(x1 * cs.x - x2 * cs.y), o2 = f2bf(x1 * cs.y + x2 * cs.x);
                for (int hh = 0; hh < 8; ++hh) {
                  u16* kd = p.Km() + ((size_t)(b * 8 + hh) * S_ + s) * 192 + 128;
                  kd[i] = o1; kd[32 + i] = o2;
                }
              }
            }
        }
      });
  }
}

__device__ __forceinline__ void compute_rs(const u16* __restrict__ src, int brow, float* rsv) {
  const int tid = TID(), row = tid >> 1, hf = tid & 1;
  const u16* r = src + (size_t)(brow + row) * 512 + hf * 256;
  float ss = 0.f;
#pragma unroll 4
  for (int i = 0; i < 32; ++i) {
    const u32x4 v = *(const u32x4*)(r + i * 8);
#pragma unroll
    for (int w = 0; w < 4; ++w) { const float a = bflo(v[w]), b = bfhi(v[w]); ss += a * a + b * b; }
  }
  ss += dppf<0xB1>(ss);
  if (hf == 0) rsv[row] = rsqrtf(ss * (1.f / 512.f) + EPS);
}

__device__ void phase_up(const Params& p, char* smem, int bid, int nb) {
  float* rsv = (float*)(smem + 131072);
  const int nq = 32 * 6, nkv = 32 * 8, npj = 32 * 8, ngm = nq + nkv + npj, njobs = ngm + 16 + 32;
  for (int t = vblock(bid, nb); t < njobs; t += nb) {
    if (t < nq) {
      int tm, tn; tile_rc(t, 6, tm, tn);
      compute_rs(p.cqb(), tm * 256, rsv);
      gemm_tile<2, 4>(p.cqb(), 512, p.WuqT(), 512, 512, tm * 256, tn * 256, smem,
        [&](f32x4 (&acc)[4][4], int row0, int col0, int fr, int fq) {
          const int hh = col0 / 192, off = col0 % 192;
          const int lr0 = row0 & 255;
          if (off < 128) {
#pragma unroll
            for (int m = 0; m < 4; ++m)
#pragma unroll
              for (int j = 0; j < 4; ++j) {
                const int lr = lr0 + m * 16 + fq * 4 + j, row = (row0 - lr0) + lr, b = row >> 12, s = row & 4095;
                const float rs = rsv[lr];
                u16* qd = p.Qm() + ((size_t)(b * 8 + hh) * S_ + s) * 192 + off;
#pragma unroll
                for (int n = 0; n < 4; ++n) qd[n * 16 + fr] = f2bf(acc[m][n][j] * rs);
              }
          } else {
#pragma unroll
            for (int m = 0; m < 4; ++m)
#pragma unroll
              for (int j = 0; j < 4; ++j) {
                const int lr = lr0 + m * 16 + fq * 4 + j, row = (row0 - lr0) + lr, b = row >> 12, s = row & 4095;
                const float rs = rsv[lr];
                u16* qd = p.Qm() + ((size_t)(b * 8 + hh) * S_ + s) * 192 + 128;
#pragma unroll
                for (int n = 0; n < 2; ++n) {
                  const int i = n * 16 + fr;
                  const float2 cs = p.cs()[(size_t)row * 32 + i];
                  const float x1 = acc[m][n][j] * rs, x2 = acc[m][n + 2][j] * rs;
                  qd[i] = f2bf(x1 * cs.x - x2 * cs.y); qd[32 + i] = f2bf(x1 * cs.y + x2 * cs.x);
                }
              }
          }
        });
      __syncthreads();
    } else if (t < nq + nkv) {
      int tm, tn; tile_rc(t - nq, 8, tm, tn);
      compute_rs(p.ckvb(), tm * 256, rsv);
      gemm_tile<2, 4>(p.ckvb(), 512, p.WukvT(), 512, 512, tm * 256, tn * 256, smem,
        [&](f32x4 (&acc)[4][4], int row0, int col0, int fr, int fq) {
          const int hh = col0 >> 8, off = col0 & 255;
          const int lr0 = row0 & 255;
          if (off < 128) {
#pragma unroll
            for (int m = 0; m < 4; ++m)
#pragma unroll
              for (int j = 0; j < 4; ++j) {
                const int lr = lr0 + m * 16 + fq * 4 + j, row = (row0 - lr0) + lr, b = row >> 12, s = row & 4095;
                const float rs = rsv[lr];
                u16* kd = p.Km() + ((size_t)(b * 8 + hh) * S_ + s) * 192 + off;
#pragma unroll
                for (int n = 0; n < 4; ++n) kd[n * 16 + fr] = f2bf(acc[m][n][j] * rs);
              }
          } else {
#pragma unroll
            for (int m = 0; m < 4; ++m) {
              const int lr = lr0 + m * 16 + fq * 4, row = (row0 - lr0) + lr, b = row >> 12, s = row & 4095;
              const float r0 = rsv[lr], r1 = rsv[lr + 1], r2 = rsv[lr + 2], r3 = rsv[lr + 3];
#pragma unroll
              for (int n = 0; n < 4; ++n) {
                const int dv = off - 128 + n * 16 + fr;
                *(u32x2*)(p.VmT() + ((size_t)(b * 8 + hh) * 128 + dv) * S_ + s) =
                    u32x2{pk2(acc[m][n][0] * r0, acc[m][n][1] * r1), pk2(acc[m][n][2] * r2, acc[m][n][3] * r3)};
              }
            }
          }
        });
      __syncthreads();
    } else if (t < ngm) {
      int tm, tn; tile_rc(t - nq - nkv, 8, tm, tn);
      gemm_tile<2, 4>(p.pb(), 256, p.WpT(), 256, 256, tm * 256, tn * 256, smem,
        [&](f32x4 (&acc)[4][4], int row0, int col0, int fr, int fq) {
#pragma unroll
          for (int m = 0; m < 4; ++m)
#pragma unroll
            for (int n = 0; n < 4; ++n)
#pragma unroll
              for (int j = 0; j < 4; ++j)
                p.projb()[(size_t)(row0 + m * 16 + fq * 4 + j) * D_ + col0 + n * 16 + fr] = f2bf(acc[m][n][j]);
        });
    } else if (t >= ngm + 16) {
      const int r0 = (t - ngm - 16) * 256, tid = TID();
#pragma unroll 1
      for (int it = 0; it < 16; ++it) {
        const int pr = it * NT + tid, row = r0 + (pr >> 5), i = pr & 31, b = row >> 12, s = row & 4095;
        const float x1 = p.krsum()[(size_t)row * 64 + i], x2 = p.krsum()[(size_t)row * 64 + 32 + i];
        const float2 cs = p.cs()[(size_t)row * 32 + i];
        const u16 o1 = f2bf(x1 * cs.x - x2 * cs.y), o2 = f2bf(x1 * cs.y + x2 * cs.x);
#pragma unroll
        for (int hh = 0; hh < 8; ++hh) {
          u16* kd = p.Km() + ((size_t)(b * 8 + hh) * S_ + s) * 192 + 128;
          kd[i] = o1; kd[32 + i] = o2;
        }
      }
    } else {
      const int seq = t - ngm;
      if ((TID() >> 6) == 0) {
        const int lane = TID() & 63;
        const float* src = p.logf() + (size_t)seq * S_ + lane * 64;
        float* dst = p.Fk() + (size_t)seq * S_ + lane * 64;
        float sum = 0.f;
        for (int i = 0; i < 16; ++i) { const float4 v = *(const float4*)(src + i * 4); sum += v.x; sum += v.y; sum += v.z; sum += v.w; }
        float inc = sum;
#pragma unroll
        for (int d = 1; d < 64; d <<= 1) { const float o = __shfl_up(inc, d, 64); if (lane >= d) inc += o; }
        float run = inc - sum;
        for (int i = 0; i < 16; ++i) {
          const float4 v = *(const float4*)(src + i * 4); float4 o;
          run += v.x; o.x = run; run += v.y; o.y = run; run += v.z; o.z = run; run += v.w; o.w = run;
          *(float4*)(dst + i * 4) = o;
        }
      }
    }
  }
}

#ifdef ATTN_NAIVE
__device__ void phase_attn_naive(const Params& p, char* smem, int bid, int nb) {
  const int tid = TID(), lane = tid & 63, wid = tid >> 6;
  const int per = NB_ * 8 * S_, nrows = 2 * per;
  for (int r = bid * 4 + wid; r < nrows; r += nb * 4) {
    const int type = r / per, rr = r % per, bh = rr / S_, s = rr % S_;
    const int DQ = type ? 128 : 192;
    const u16* Q = type ? p.Qf() + ((size_t)bh * S_ + s) * 128 : p.Qm() + ((size_t)bh * S_ + s) * 192;
    const u16* Kb = type ? p.Kf() + (size_t)bh * S_ * 128 : p.Km() + (size_t)bh * S_ * 192;
    const u16* VT = (type ? p.VfT() : p.VmT()) + (size_t)bh * 128 * S_;
    const float* F = p.Fk() + (size_t)bh * S_;
    const float scale = type ? 0.08838834764831845f : 0.07216878364870322f;
    float m = -1e30f, l = 0.f;
    float acc[128];
#pragma unroll
    for (int d = 0; d < 128; ++d) acc[d] = 0.f;
    const float fqv = type ? F[s] : 0.f;
    for (int k0 = 0; k0 <= s; k0 += 64) {
      const int key = k0 + lane; const bool valid = key <= s; const int keyc = valid ? key : s;
      const u16* kr = Kb + (size_t)keyc * DQ;
      float sc = 0.f;
      for (int d = 0; d < DQ; d += 8) {
        const u32x4 kv = *(const u32x4*)(kr + d), qv = *(const u32x4*)(Q + d);
#pragma unroll
        for (int w = 0; w < 4; ++w) sc += bflo(kv[w]) * bflo(qv[w]) + bfhi(kv[w]) * bfhi(qv[w]);
      }
      sc *= scale;
      if (type) sc += fqv - F[keyc];
      if (!valid) sc = -1e30f;
      const float mx = wave_max(sc), mn = fmaxf(m, mx), alpha = __expf(m - mn);
      const float pr = valid ? __expf(sc - mn) : 0.f;
      m = mn; l = l * alpha + pr;
#pragma unroll
      for (int d = 0; d < 128; ++d) acc[d] = acc[d] * alpha + pr * bf2f(VT[(size_t)d * S_ + keyc]);
    }
    const float inv = 1.f / wave_sum(l);
    float o0 = 0.f, o1 = 0.f;
#pragma unroll
    for (int d = 0; d < 128; ++d) {
      const float o = wave_sum(acc[d]) * inv;
      if (lane == (d & 63)) { if (d < 64) o0 = o; else o1 = o; }
    }
    const int b = bh >> 3, hh = bh & 7;
    u16* od = p.omix() + ((size_t)(b * S_ + s)) * 2048 + type * 1024 + hh * 128;
    od[lane] = f2bf(o0); od[64 + lane] = f2bf(o1);
  }
}

#endif
typedef float f32x16 __attribute__((ext_vector_type(16)));
template <int TYPE>
__device__ __forceinline__ void attn_item(const Params& p, char* smem, int bh, int qb) {
  constexpr int DQK = TYPE ? 128 : 192, NKS = DQK / 16, KSTR = DQK * 2 + 16, VSTR = 128;
  constexpr int KCH = DQK / 8, NKL = 64 * KCH / NT;
  constexpr float C2 = (TYPE ? 0.08838834764831845f : 0.07216878364870322f) * 1.4426950408889634f;
  char* sK = smem; char* sV = smem + 25600; float* sF = (float*)(smem + 25600 + 32768);
  const int tid = TID(), lane = tid & 63, wid = tid >> 6, c = lane & 31, hi = lane >> 5;
  const u16* Qb = (TYPE ? p.Qf() : p.Qm()) + (size_t)bh * S_ * DQK;
  const u16* Kb = (TYPE ? p.Kf() : p.Km()) + (size_t)bh * S_ * DQK;
  const u16* Vb = (TYPE ? p.VfT() : p.VmT()) + (size_t)bh * 128 * S_;
  const float* Fb = p.Fk() + (size_t)bh * S_;
  const int qrow = qb * 256 + wid * 32;
  bf16x8 qf[NKS];
#pragma unroll
  for (int ks = 0; ks < NKS; ++ks) qf[ks] = *(const bf16x8*)(Qb + (size_t)(qrow + c) * DQK + ks * 16 + hi * 8);
  f32x16 o[4];
#pragma unroll
  for (int db = 0; db < 4; ++db)
#pragma unroll
    for (int r = 0; r < 16; ++r) o[db][r] = 0.f;
  float m = -1e30f, l = 0.f;
  const int ntiles = 4 * qb + 4;
  u32x4 kreg[NKL];
  float4 freg = make_float4(0.f, 0.f, 0.f, 0.f);
  const unsigned koff = (unsigned)tid * 16u;
  auto load_k = [&](int kt) {
    const char* kb = (const char*)(Kb + (size_t)kt * 64 * DQK);
#pragma unroll
    for (int i = 0; i < NKL; ++i) kreg[i] = *(const u32x4*)(kb + i * 8192 + koff);
    if (TYPE) { if (tid < 16) freg = *(const float4*)(Fb + kt * 64 + tid * 4); }
  };
  const unsigned voff = (unsigned)((((tid >> 3) * S_) + (((tid & 7) ^ ((tid >> 4) & 7)) * 8)) * 2);
  auto load_v = [&](int kt) {
    const char* vb = (const char*)(Vb + kt * 64);
    char* dst = sV + (kt & 1) * 16384 + tid * 16;
#pragma unroll
    for (int i = 0; i < 2; ++i)
      __builtin_amdgcn_global_load_lds((const unsigned*)(vb + (size_t)i * 64 * S_ * 2 + voff), (unsigned*)(dst + i * 8192), 16, 0, 0);
  };
  auto store_tile = [&]() {
#pragma unroll
    for (int i = 0; i < NKL; ++i) { const int ch = tid + NT * i, key = ch / KCH, dc = ch % KCH; *(u32x4*)(sK + key * KSTR + dc * 16) = kreg[i]; }
    if (TYPE) { if (tid < 16) { const float L2E = 1.4426950408889634f; *(float4*)(sF + tid * 4) = make_float4(freg.x * L2E, freg.y * L2E, freg.z * L2E, freg.w * L2E); } }
  };
  const int krow = (c & 19) | ((c & 4) << 1) | ((c & 8) >> 1);
  const char* ka0 = sK + krow * KSTR + hi * 16;
  const char* ka1 = ka0 + 32 * KSTR;
  const int vx = (c >> 1) & 7;
  int vo[2][2];
#pragma unroll
  for (int kb = 0; kb < 2; ++kb)
#pragma unroll
    for (int s2 = 0; s2 < 2; ++s2) vo[kb][s2] = c * VSTR + (((4 * kb + 2 * s2 + hi) ^ vx) * 16);
  load_k(0); load_v(0);
#pragma unroll 1
  for (int kt = 0; kt < ntiles; ++kt) {
    asm volatile("s_waitcnt vmcnt(0)" ::: "memory");
    __syncthreads();
    store_tile();
    __syncthreads();
    if (kt + 1 < ntiles) { load_k(kt + 1); load_v(kt + 1); }
    const int k0 = kt * 64;
    const char* sVc = sV + (kt & 1) * 16384;
    if (k0 <= qrow + 31) {
      f32x16 p0, p1;
#pragma unroll
      for (int r = 0; r < 16; ++r) { p0[r] = 0.f; p1[r] = 0.f; }
#pragma unroll
      for (int ks = 0; ks < NKS; ++ks) {
        const bf16x8 a0 = *(const bf16x8*)(ka0 + ks * 32), a1 = *(const bf16x8*)(ka1 + ks * 32);
        p0 = __builtin_amdgcn_mfma_f32_32x32x16_bf16(a0, qf[ks], p0, 0, 0, 0);
        p1 = __builtin_amdgcn_mfma_f32_32x32x16_bf16(a1, qf[ks], p1, 0, 0, 0);
      }
      if (TYPE) {
#pragma unroll
        for (int s = 0; s < 2; ++s) {
          const float4 f0 = *(const float4*)(sF + 16 * s + 8 * hi), f1 = *(const float4*)(sF + 16 * s + 8 * hi + 4);
          const float4 g0 = *(const float4*)(sF + 32 + 16 * s + 8 * hi), g1 = *(const float4*)(sF + 32 + 16 * s + 8 * hi + 4);
          p0[8 * s + 0] = p0[8 * s + 0] * C2 - f0.x; p0[8 * s + 1] = p0[8 * s + 1] * C2 - f0.y; p0[8 * s + 2] = p0[8 * s + 2] * C2 - f0.z; p0[8 * s + 3] = p0[8 * s + 3] * C2 - f0.w;
          p0[8 * s + 4] = p0[8 * s + 4] * C2 - f1.x; p0[8 * s + 5] = p0[8 * s + 5] * C2 - f1.y; p0[8 * s + 6] = p0[8 * s + 6] * C2 - f1.z; p0[8 * s + 7] = p0[8 * s + 7] * C2 - f1.w;
          p1[8 * s + 0] = p1[8 * s + 0] * C2 - g0.x; p1[8 * s + 1] = p1[8 * s + 1] * C2 - g0.y; p1[8 * s + 2] = p1[8 * s + 2] * C2 - g0.z; p1[8 * s + 3] = p1[8 * s + 3] * C2 - g0.w;
          p1[8 * s + 4] = p1[8 * s + 4] * C2 - g1.x; p1[8 * s + 5] = p1[8 * s + 5] * C2 - g1.y; p1[8 * s + 6] = p1[8 * s + 6] * C2 - g1.z; p1[8 * s + 7] = p1[8 * s + 7] * C2 - g1.w;
        }
      } else {
#pragma unroll
        for (int r = 0; r < 16; ++r) { p0[r] *= C2; p1[r] *= C2; }
      }
      if (k0 + 63 > qrow) {
        const int lim = qrow + c - k0 - 8 * hi;
        const float NEG = -__builtin_inff();
#pragma unroll
        for (int r = 0; r < 16; ++r) {
          const int kb = 16 * (r >> 3) + (r & 7);
          if (kb > lim) p0[r] = NEG;
          if (kb + 32 > lim) p1[r] = NEG;
        }
      }
      float mx = p0[0];
#pragma unroll
      for (int r = 1; r < 16; ++r) mx = fmaxf(mx, p0[r]);
#pragma unroll
      for (int r = 0; r < 16; ++r) mx = fmaxf(mx, p1[r]);
      {
        auto rr = __builtin_amdgcn_permlane32_swap(__float_as_uint(mx), __float_as_uint(mx), false, false);
        mx = fmaxf(__uint_as_float(rr[0]), __uint_as_float(rr[1]));
      }
      const float mn = fmaxf(m, mx);
      const float alpha = __builtin_amdgcn_exp2f(m - mn);
      m = mn;
      if (!__all(alpha == 1.f)) {
#pragma unroll
        for (int db = 0; db < 4; ++db)
#pragma unroll
          for (int r = 0; r < 16; ++r) o[db][r] *= alpha;
      }
      float ps = 0.f;
#pragma unroll
      for (int r = 0; r < 16; ++r) { p0[r] = __builtin_amdgcn_exp2f(p0[r] - mn); p1[r] = __builtin_amdgcn_exp2f(p1[r] - mn); ps += p0[r] + p1[r]; }
      l = l * alpha + ps;
      bf16x8 pa[2][2];
#pragma unroll
      for (int s = 0; s < 2; ++s) {
        u32x4 w0 = {pk2(p0[8 * s + 0], p0[8 * s + 1]), pk2(p0[8 * s + 2], p0[8 * s + 3]), pk2(p0[8 * s + 4], p0[8 * s + 5]), pk2(p0[8 * s + 6], p0[8 * s + 7])};
        u32x4 w1 = {pk2(p1[8 * s + 0], p1[8 * s + 1]), pk2(p1[8 * s + 2], p1[8 * s + 3]), pk2(p1[8 * s + 4], p1[8 * s + 5]), pk2(p1[8 * s + 6], p1[8 * s + 7])};
        pa[0][s] = *reinterpret_cast<bf16x8*>(&w0); pa[1][s] = *reinterpret_cast<bf16x8*>(&w1);
      }
#pragma unroll
      for (int db = 0; db < 4; ++db)
#pragma unroll
        for (int kb = 0; kb < 2; ++kb)
#pragma unroll
          for (int s = 0; s < 2; ++s) {
            const bf16x8 av = *(const bf16x8*)(sVc + db * 32 * VSTR + vo[kb][s]);
            o[db] = __builtin_amdgcn_mfma_f32_32x32x16_bf16(av, pa[kb][s], o[db], 0, 0, 0);
          }
    }
  }
  {
    auto rr = __builtin_amdgcn_permlane32_swap(__float_as_uint(l), __float_as_uint(l), false, false);
    const float inv = 1.f / (__uint_as_float(rr[0]) + __uint_as_float(rr[1]));
    const int b = bh >> 3, hh = bh & 7;
    u16* od = p.omix() + ((size_t)(b * S_ + qrow + c)) * 2048 + TYPE * 1024 + hh * 128 + 4 * hi;
#pragma unroll
    for (int db = 0; db < 4; ++db)
#pragma unroll
      for (int g = 0; g < 4; ++g)
        *(u32x2*)(od + 32 * db + 8 * g) = u32x2{pk2(o[db][4 * g] * inv, o[db][4 * g + 1] * inv), pk2(o[db][4 * g + 2] * inv, o[db][4 * g + 3] * inv)};
  }
}

__device__ void phase_attn(const Params& p, char* smem, int bid, int nb) {
  int* sItem = (int*)(smem + 60000);
  const int x = bid & 7;
  unsigned* q = p.ctr() + 32 + x;
  for (;;) {
    __syncthreads();
    if (TID() == 0) *sItem = (int)atomicAdd(q, 1u);
    __syncthreads();
    const int item = *sItem;
    if (item >= 64) break;
    const int qb = 15 - (item >> 2), r = item & 3, type = r >> 1, bh = x + 8 * (r & 1);
    if (type == 0) attn_item<0>(p, smem, bh, qb); else attn_item<1>(p, smem, bh, qb);
  }
  unsigned* qc = p.ctr() + 48;
  for (;;) {
    __syncthreads();
    if (TID() == 0) *sItem = (int)atomicAdd(qc, 1u);
    __syncthreads();
    const int chunk = *sItem;
    if (chunk >= 512) break;
    quant_chunk(p, chunk);
  }
}

__device__ void phase_outproj(const Params& p, char* smem, int bid, int nb) {
  const int ntiles = 32 * 8;
  for (int t = vblock(bid, nb); t < ntiles; t += nb) {
    int tm, tn; tile_rc(t, 8, tm, tn);
    gemm_tile<2, 4>(p.omix(), D_, p.WoutT(), D_, D_, tm * 256, tn * 256, smem,
      [&](f32x4 (&acc)[4][4], int row0, int col0, int fr, int fq) {
#pragma unroll
        for (int m = 0; m < 4; ++m)
#pragma unroll
          for (int n = 0; n < 4; ++n)
#pragma unroll
            for (int j = 0; j < 4; ++j) {
              const size_t idx = (size_t)(row0 + m * 16 + fq * 4 + j) * D_ + col0 + n * 16 + fr;
              p.y1()[idx] = ALPHA * p.x[idx] + acc[m][n][j];
            }
      });
  }
}

__device__ void phase_ln1(const Params& p, int bid, int nb) {
  const int lane = TID() & 63, wid = TID() >> 6;
  for (int t = bid * 8 + wid; t < T_; t += nb * 8) {
    float* row = p.y1() + (size_t)t * D_;
    float4 v[8];
    float sum = 0.f;
#pragma unroll
    for (int i = 0; i < 8; ++i) { v[i] = *(const float4*)(row + (i * 64 + lane) * 4); sum += (v[i].x + v[i].y) + (v[i].z + v[i].w); }
    const float mu = wave_sum(sum) * (1.f / D_);
    float sq = 0.f;
#pragma unroll
    for (int i = 0; i < 8; ++i) {
      v[i].x -= mu; v[i].y -= mu; v[i].z -= mu; v[i].w -= mu;
      sq += (v[i].x * v[i].x + v[i].y * v[i].y) + (v[i].z * v[i].z + v[i].w * v[i].w);
    }
    const float rstd = rsqrtf(wave_sum(sq) * (1.f / D_) + EPS);
#pragma unroll
    for (int i = 0; i < 8; ++i) {
      const int c = (i * 64 + lane) * 4;
      const float4 g = *(const float4*)(p.ln1_g + c), bb = *(const float4*)(p.ln1_b + c);
      float4 o; o.x = v[i].x * rstd * g.x + bb.x; o.y = v[i].y * rstd * g.y + bb.y; o.z = v[i].z * rstd * g.z + bb.z; o.w = v[i].w * rstd * g.w + bb.w;
      *(float4*)(row + c) = o;
      *(u32x2*)(p.h1b() + (size_t)t * D_ + c) = u32x2{pk2(o.x, o.y), pk2(o.z, o.w)};
    }
  }
}

__device__ __forceinline__ void ins16(unsigned (&t)[16], unsigned x) {
#pragma unroll
  for (int i = 0; i < 16; ++i) { const unsigned hi = t[i] > x ? t[i] : x; x = t[i] > x ? x : t[i]; t[i] = hi; }
}
__device__ __forceinline__ void ins16p(unsigned (&ck)[16], int (&ce)[16], unsigned x, int xe) {
#pragma unroll
  for (int i = 0; i < 16; ++i) {
    const bool sw = x > ck[i];
    const unsigned nk = sw ? x : ck[i], nx = sw ? ck[i] : x;
    const int ne = sw ? xe : ce[i], nxe = sw ? ce[i] : xe;
    ck[i] = nk; x = nx; ce[i] = ne; xe = nxe;
  }
}
__device__ __forceinline__ float unordkey(unsigned k) { return __uint_as_float((k & 0x80000000u) ? (k & 0x7fffffffu) : ~k); }

__device__ __forceinline__ void route_tile(const Params& p, char* smem, f32x4 (&acc)[4][4], int tm, int h) {
  const int tid = TID(), wid = tid >> 6, lane = tid & 63, wr = wid >> 1, wc = wid & 1, fr = lane & 15, fq = lane >> 4;
  __syncthreads();
  float* Qw = (float*)smem + wid * (64 * 65);
#pragma unroll
  for (int m = 0; m < 4; ++m)
#pragma unroll
    for (int n = 0; n < 4; ++n)
#pragma unroll
      for (int j = 0; j < 4; ++j) Qw[(m * 16 + fq * 4 + j) * 65 + n * 16 + fr] = acc[m][n][j];
  asm volatile("s_waitcnt lgkmcnt(0)" ::: "memory");
  float q[64];
#pragma unroll
  for (int d = 0; d < 64; ++d) q[d] = Qw[lane * 65 + d];
  __syncthreads();
  {
    float* ks = (float*)smem;
#pragma unroll
    for (int i = 0; i < 8; ++i) {
      const int idx = (i * NT + tid) * 4;
      const float* src = (idx < 8192 ? p.keys1 : p.keys2) + (size_t)h * 8192 + (idx & 8191);
      *(float4*)(ks + idx) = *(const float4*)src;
    }
  }
  __syncthreads();
  unsigned t[16];
#pragma unroll
  for (int i = 0; i < 16; ++i) t[i] = 0u;
  {
    const float* kb = (const float*)smem + wc * 8192;
#pragma unroll 1
    for (int n = 0; n < 128; ++n) {
      float d0 = 0.f, d1 = 0.f, d2 = 0.f, d3 = 0.f;
#pragma unroll
      for (int i = 0; i < 16; ++i) {
        const float4 kv = *(const float4*)(kb + n * 64 + i * 4);
        d0 += kv.x * q[4 * i]; d1 += kv.y * q[4 * i + 1]; d2 += kv.z * q[4 * i + 2]; d3 += kv.w * q[4 * i + 3];
      }
      const float sc = (d0 + d1) + (d2 + d3);
      ins16(t, (ordkey(sc) & ~127u) | (unsigned)(127 - n));
    }
  }
  __syncthreads();
  unsigned* L = (unsigned*)smem;
#pragma unroll
  for (int r = 0; r < 16; ++r) L[(wc * 16 + r) * 256 + wr * 64 + lane] = t[r];
  __syncthreads();
  if (wid < 4) {
    const int tok = wid * 64 + lane;
    unsigned ck[16]; int ce[16];
#pragma unroll
    for (int i = 0; i < 16; ++i) { ck[i] = 0u; ce[i] = 0; }
#pragma unroll 1
    for (int a = 0; a < 16; ++a) {
      const unsigned ka = L[a * 256 + tok];
      const int i1a = (127 - (int)(ka & 127u)) * 128; const float v1a = unordkey(ka & ~127u);
      const int nbm1 = (int)((0x1112347FULL >> (4 * a)) & 15ULL);
#pragma unroll 1
      for (int b = 0; b <= nbm1; ++b) {
        const unsigned kb = L[(16 + b) * 256 + tok];
        const int i2b = 127 - (int)(kb & 127u); const float v2b = unordkey(kb & ~127u);
        ins16p(ck, ce, ordkey(v1a + v2b), i1a + i2b);
      }
    }
    float ex[16], sum = 0.f;
    const float mx = unordkey(ck[0]);
#pragma unroll
    for (int r = 0; r < 16; ++r) { ex[r] = __expf(unordkey(ck[r]) - mx); sum += ex[r]; }
    const float inv = 1.f / sum;
    const size_t o = ((size_t)(tm * 256 + tok) * 8 + h) * 16;
    int* ed = p.eidxG() + o; float* gd = p.gateG() + o;
#pragma unroll
    for (int r = 0; r < 16; r += 4) {
      *(int4*)(ed + r) = make_int4(ce[r], ce[r + 1], ce[r + 2], ce[r + 3]);
      *(float4*)(gd + r) = make_float4(ex[r] * inv, ex[r + 1] * inv, ex[r + 2] * inv, ex[r + 3] * inv);
    }
  }
}

__device__ void phase_mid(const Params& p, char* smem, int bid, int nb) {
  const int ng = 32 * 8, nq = 32 * 8;
  for (int t = vblock(bid, nb); t < ng + nq; t += nb) {
    if (t < ng) {
      int tm, tn; tile_rc(t, 8, tm, tn);
      gemm_tile<2, 4>(p.h1b(), D_, p.WgT(), D_, D_, tm * 256, tn * 256, smem,
        [&](f32x4 (&acc)[4][4], int row0, int col0, int fr, int fq) {
          const size_t base = (size_t)(row0 + fq * 4) * D_ + col0 + fr;
          const float* yb = p.y1() + base;
          const u16* pj = p.projb() + base;
          float* ob = p.out + base;
#pragma unroll
          for (int m = 0; m < 4; ++m)
#pragma unroll
            for (int n = 0; n < 4; ++n)
#pragma unroll
              for (int j = 0; j < 4; ++j) {
                const int o = (m * 16 + j) * D_ + n * 16;
                const float sg = 1.f / (1.f + __expf(-acc[m][n][j]));
                ob[o] = ALPHA * yb[o] + bf2f(pj[o]) * sg;
              }
        });
    } else {
      int tm, tn; tile_rc(t - ng, 8, tm, tn);
      f32x4 acc[1][4][4];
      gemm_core<4, 2>(p.h1b(), D_, p.WpqT(), D_, D_, tm * 256, tn * 128, smem, acc);
      route_tile(p, smem, acc[0], tm, tn);
    }
  }
}

__device__ __forceinline__ float gelu_exact(float a) {
  const float x = fabsf(a) * 0.7071067811865476f;
  const float t = __builtin_amdgcn_rcpf(1.f + 0.3275911f * x);
  const float poly = t * (0.254829592f + t * (-0.284496736f + t * (1.421413741f + t * (-1.453152027f + t * 1.061405429f))));
  const float er = 1.f - poly * __expf(-x * x);
  return 0.5f * a * (1.f + (a < 0.f ? -er : er));
}

template <int NPER, int IDXMASK>
__device__ __forceinline__ int top16(unsigned (&k)[NPER], int lane) {
  int mine = 0;
#pragma unroll 1
  for (int r = 0; r < 16; ++r) {
    unsigned loc = k[0];
#pragma unroll
    for (int i = 1; i < NPER; ++i) loc = loc > k[i] ? loc : k[i];
    const unsigned best = wave_umax(loc);
#pragma unroll
    for (int i = 0; i < NPER; ++i) if (k[i] == best) k[i] = 0u;
    if (lane == r) mine = IDXMASK - (int)(best & (unsigned)IDXMASK);
  }
  return mine;
}

__device__ void phase_peer(const Params& p, char* smem, int bid, int nb) {
  const int tid = TID(), lane = tid & 63, wid = tid >> 6;
  float* qs = (float*)smem;
  float* sc = (float*)(smem + 8192);
  int* eidx = (int*)(smem + 24576);
  float* gts = (float*)(smem + 40960);
  for (int it = bid; it < T_ / 32; it += nb) {
    const int t0 = it * 32;
#pragma unroll
    for (int i = 0; i < 2; ++i) {
      const int idx = (i * NT + tid) * 4;
      *(int4*)(eidx + idx) = *(const int4*)(p.eidxG() + (size_t)t0 * 128 + idx);
      *(float4*)(gts + idx) = *(const float4*)(p.gateG() + (size_t)t0 * 128 + idx);
    }
    __syncthreads();
    for (int ti = 0; ti < 4; ++ti) {
      const int tok = wid * 4 + ti, t = t0 + tok;
      typedef float f32x2 __attribute__((ext_vector_type(2)));
      float hreg[32], o[32];
#pragma unroll
      for (int c = 0; c < 2; ++c)
#pragma unroll
        for (int q = 0; q < 2; ++q) {
          const u32x4 hv = *(const u32x4*)(p.h1b() + (size_t)t * D_ + (c * 64 + lane) * 16 + q * 8);
#pragma unroll
          for (int w = 0; w < 4; ++w) { hreg[c * 16 + q * 8 + 2 * w] = bflo(hv[w]); hreg[c * 16 + q * 8 + 2 * w + 1] = bfhi(hv[w]); }
        }
#pragma unroll
      for (int i = 0; i < 32; ++i) o[i] = 0.f;
      const float* Us = p.Us(); const float* Vs = p.Vs();
      const unsigned char* Uq = p.Uq() + lane * 16; const unsigned char* Vq = p.Vq() + lane * 16;
      const int* ep = eidx + tok * 128; const float* gp = gts + tok * 128;
      u32x4 urA[2][2], vrA[2][2], urB[2][2], vrB[2][2];
      float gA[2], suA[2], svA[2], gB[2], suB[2], svB[2];
#define PEER_LOAD(UR, VR, G, SU, SV, J0)                                                              \
      _Pragma("unroll") for (int jj = 0; jj < 2; ++jj) {                                                \
        const int e = __builtin_amdgcn_readfirstlane(ep[(J0) + jj]);                                    \
        G[jj] = gp[(J0) + jj]; SU[jj] = Us[e]; SV[jj] = Vs[e];                                          \
        const unsigned char* up = Uq + (size_t)e * 4096; const unsigned char* vp = up + 2048;           \
        UR[jj][0] = *(const u32x4*)(up); UR[jj][1] = *(const u32x4*)(up + 1024);                        \
        VR[jj][0] = *(const u32x4*)(vp); VR[jj][1] = *(const u32x4*)(vp + 1024);                        \
      }
#define PEER_COMPUTE(UR, VR, G, SU, SV)                                                                 \
      _Pragma("unroll") for (int jj = 0; jj < 2; ++jj) {                                                \
        float d0 = 0.f, d1 = 0.f;                                                                       \
        _Pragma("unroll") for (int c = 0; c < 2; ++c)                                                   \
          _Pragma("unroll") for (int w = 0; w < 4; ++w) {                                               \
            const f32x2 lo = __builtin_amdgcn_cvt_pk_f32_fp8(UR[jj][c][w], false), hi2 = __builtin_amdgcn_cvt_pk_f32_fp8(UR[jj][c][w], true); \
            d0 += lo[0] * hreg[c * 16 + 4 * w]; d1 += lo[1] * hreg[c * 16 + 4 * w + 1];                \
            d0 += hi2[0] * hreg[c * 16 + 4 * w + 2]; d1 += hi2[1] * hreg[c * 16 + 4 * w + 3];          \
          }                                                                                             \
        const float av = wave_sum(d0 + d1) * SU[jj];                                                    \
        const float act = gelu_exact(av) * G[jj] * SV[jj];                                              \
        _Pragma("unroll") for (int c = 0; c < 2; ++c)                                                   \
          _Pragma("unroll") for (int w = 0; w < 4; ++w) {                                               \
            const f32x2 lo = __builtin_amdgcn_cvt_pk_f32_fp8(VR[jj][c][w], false), hi2 = __builtin_amdgcn_cvt_pk_f32_fp8(VR[jj][c][w], true); \
            o[c * 16 + 4 * w] += act * lo[0]; o[c * 16 + 4 * w + 1] += act * lo[1];                    \
            o[c * 16 + 4 * w + 2] += act * hi2[0]; o[c * 16 + 4 * w + 3] += act * hi2[1];              \
          }                                                                                             \
      }
      PEER_LOAD(urA, vrA, gA, suA, svA, 0)
#pragma unroll 1
      for (int j0 = 0; j0 < 128; j0 += 4) {
        PEER_LOAD(urB, vrB, gB, suB, svB, j0 + 2)
        PEER_COMPUTE(urA, vrA, gA, suA, svA)
        if (j0 + 4 < 128) { PEER_LOAD(urA, vrA, gA, suA, svA, j0 + 4) }
        PEER_COMPUTE(urB, vrB, gB, suB, svB)
      }
#undef PEER_LOAD
#undef PEER_COMPUTE
      float* orow = p.out + (size_t)t * D_;
      float sum = 0.f;
#pragma unroll
      for (int c = 0; c < 2; ++c)
#pragma unroll
        for (int q = 0; q < 4; ++q) {
          const float4 r0 = *(const float4*)(orow + (c * 64 + lane) * 16 + q * 4);
          o[c * 16 + q * 4 + 0] += r0.x; o[c * 16 + q * 4 + 1] += r0.y; o[c * 16 + q * 4 + 2] += r0.z; o[c * 16 + q * 4 + 3] += r0.w;
        }
#pragma unroll
      for (int i = 0; i < 32; ++i) sum += o[i];
      const float mu = wave_sum(sum) * (1.f / D_);
      float sq = 0.f;
#pragma unroll
      for (int i = 0; i < 32; ++i) { o[i] -= mu; sq += o[i] * o[i]; }
      const float rstd = rsqrtf(wave_sum(sq) * (1.f / D_) + EPS);
#pragma unroll
      for (int c = 0; c < 2; ++c)
#pragma unroll
        for (int q = 0; q < 4; ++q) {
          const int col = (c * 64 + lane) * 16 + q * 4;
          const float4 g0 = *(const float4*)(p.ln2_g + col), b0 = *(const float4*)(p.ln2_b + col);
          float4 w0;
          w0.x = o[c * 16 + q * 4 + 0] * rstd * g0.x + b0.x; w0.y = o[c * 16 + q * 4 + 1] * rstd * g0.y + b0.y;
          w0.z = o[c * 16 + q * 4 + 2] * rstd * g0.z + b0.z; w0.w = o[c * 16 + q * 4 + 3] * rstd * g0.w + b0.w;
          *(float4*)(orow + col) = w0;
        }
    }
    __syncthreads();
  }
}

template <int PH>
__device__ __forceinline__ void run_phase(const Params& p, char* smem, int bid, int nb) {
  if constexpr (PH == 0) phase_prep(p, smem, bid, nb);
  if constexpr (PH == 1) phase_inproj(p, smem, bid, nb);
  if constexpr (PH == 2) phase_up(p, smem, bid, nb);
#ifdef ATTN_NAIVE
  if constexpr (PH == 3) phase_attn_naive(p, smem, bid, nb);
#else
  if constexpr (PH == 3) phase_attn(p, smem, bid, nb);
#endif
  if constexpr (PH == 4) phase_outproj(p, smem, bid, nb);
  if constexpr (PH == 5) phase_ln1(p, bid, nb);
  if constexpr (PH == 6) phase_mid(p, smem, bid, nb);
  if constexpr (PH == 7) phase_peer(p, smem, bid, nb);
}

template <int PH>
__global__ void __launch_bounds__(NT, 2) phase_kernel(Params p) {
  __shared__ __attribute__((aligned(16))) char smem[SMEM_BYTES];
  run_phase<PH>(p, smem, blockIdx.x, gridDim.x);
}

#define BW_CENSUS(j) (256 + (j) * 32)
#define BW_XSUB(j) (256 + 512 + (j) * 32)
#define BW_XGEN(j) (256 + 1024 + (j) * 32)
#define BW_TOP (256 + 1536)
#define BW_TOPGEN (256 + 1568)
__device__ __forceinline__ unsigned bw_ld(unsigned* p) { return __hip_atomic_load(p, __ATOMIC_RELAXED, __HIP_MEMORY_SCOPE_AGENT); }
__device__ __forceinline__ unsigned bw_add(unsigned* p, unsigned v) { return __hip_atomic_fetch_add(p, v, __ATOMIC_RELAXED, __HIP_MEMORY_SCOPE_AGENT); }
__device__ __forceinline__ unsigned xcc_id() { return (unsigned)__builtin_amdgcn_s_getreg((3 << 11) | 20) & 0xFu; }

__device__ __forceinline__ void grid_barrier(unsigned* bar, unsigned* st  ) {
  asm volatile("s_waitcnt vmcnt(0)" ::: "memory");
  __syncthreads();
  if (threadIdx.x == 0) {
    __builtin_amdgcn_s_waitcnt(0);
    const unsigned x = xcc_id();
    unsigned nloc = st[0], nx = st[1];
    if (nloc == 0u) {
      const unsigned G = gridDim.x;
      for (;;) {
        unsigned sum = 0u, cnt = 0u, mine = 0u;
#pragma unroll
        for (unsigned j = 0; j < 16; ++j) { const unsigned c = bw_ld(&bar[BW_CENSUS(j)]); sum += c; cnt += (c > 0u) ? 1u : 0u; mine = (j == x) ? c : mine; }
        nloc = mine; nx = cnt;
        if (sum == G) break;
        __builtin_amdgcn_s_sleep(1);
      }
      st[0] = nloc; st[1] = nx;
    }
    const unsigned old = bw_add(&bar[BW_XSUB(x)], 1u);
    const unsigned gen = old / nloc;
    if (old + 1u == (gen + 1u) * nloc) {
      __builtin_amdgcn_fence(__ATOMIC_RELEASE, "agent");
      asm volatile("s_waitcnt vmcnt(0)" ::: "memory");
      const unsigned og = bw_add(&bar[BW_TOP], 1u);
      const unsigned tg = og / nx;
      if (og + 1u == (tg + 1u) * nx) bw_add(&bar[BW_TOPGEN], 1u);
      else while (bw_ld(&bar[BW_TOPGEN]) == tg) __builtin_amdgcn_s_sleep(1);
      __builtin_amdgcn_fence(__ATOMIC_ACQUIRE, "agent");
      bw_add(&bar[BW_XGEN(x)], 1u);
      asm volatile("s_waitcnt vmcnt(0)" ::: "memory");
    } else {
      while (bw_ld(&bar[BW_XGEN(x)]) == gen) __builtin_amdgcn_s_sleep(1);
      __builtin_amdgcn_fence(__ATOMIC_ACQUIRE, "agent");
      asm volatile("s_waitcnt vmcnt(0)" ::: "memory");
    }
  }
  __syncthreads();
}

#if SINGLE_LAUNCH
typedef const __attribute__((address_space(4))) unsigned long long* kargp_t;
static_assert(sizeof(Params) % 8 == 0, "Params must be a pack of 8-byte fields");
#define RUN_PHASE(N) run_phase<N>(p_, smem, bid, nb);
__global__ void __launch_bounds__(NT, 2) fwd_kernel(Params p_) {
  __shared__ __attribute__((aligned(16))) char smem[SMEM_BYTES + 64];
  const int bid = blockIdx.x, nb = gridDim.x;
  unsigned* bar = (unsigned*)(p_.ws + O_CTR);
  unsigned* st = (unsigned*)(smem + SMEM_BYTES);
  if (threadIdx.x == 0) { st[0] = 0u; st[1] = 0u; (void)bw_add(&bar[BW_CENSUS(xcc_id())], 1u); }
  if (p_.out == nullptr) cg::this_grid().sync();
  RUN_PHASE(0) grid_barrier(bar, st);
  RUN_PHASE(1) grid_barrier(bar, st);
  RUN_PHASE(2) grid_barrier(bar, st);
  RUN_PHASE(3) grid_barrier(bar, st);
  RUN_PHASE(4) grid_barrier(bar, st);
  RUN_PHASE(5) grid_barrier(bar, st);
  RUN_PHASE(6) grid_barrier(bar, st);
  RUN_PHASE(7)
}
#endif

extern "C" void kernel_launch(void* const* d_in, const int* in_sizes, int n_in, void* d_out, int out_size,
                              void* d_ws, size_t ws_size, hipStream_t stream) {
  (void)in_sizes; (void)n_in; (void)out_size; (void)ws_size;
  Params p{};
  p.x = (const float*)d_in[0]; p.p = (const float*)d_in[1]; p.positions = (const int*)d_in[2];
  p.w_in = (const float*)d_in[3]; p.b_forget = (const float*)d_in[4]; p.g_q = (const float*)d_in[5];
  p.w_uq = (const float*)d_in[6]; p.g_kv = (const float*)d_in[7]; p.w_ukv = (const float*)d_in[8];
  p.w_out = (const float*)d_in[9]; p.ln1_g = (const float*)d_in[10]; p.ln1_b = (const float*)d_in[11];
  p.peer_wq = (const float*)d_in[12]; p.keys1 = (const float*)d_in[13]; p.keys2 = (const float*)d_in[14];
  p.peer_u = (const float*)d_in[15]; p.peer_v = (const float*)d_in[16]; p.wgate = (const float*)d_in[17];
  p.wproj = (const float*)d_in[18]; p.ln2_g = (const float*)d_in[19]; p.ln2_b = (const float*)d_in[20];
  p.out = (float*)d_out;
  p.ws = (char*)d_ws;

  static int grid_blocks = 0;
  if (!grid_blocks) {
    int dev = 0, cus = 0, per_cu = 0;
    (void)hipGetDevice(&dev);
    (void)hipDeviceGetAttribute(&cus, hipDeviceAttributeMultiprocessorCount, dev);
#if SINGLE_LAUNCH
    (void)hipOccupancyMaxActiveBlocksPerMultiprocessor(&per_cu, fwd_kernel, NT, 0);
#else
    per_cu = 2;
#endif
    if (per_cu > 1) per_cu = 1;
    if (per_cu < 1) per_cu = 1;
    grid_blocks = cus * per_cu;
  }
#if SINGLE_LAUNCH
  (void)hipMemsetAsync(d_ws, 0, 16384, stream);
  void* args[] = {&p};
  hipError_t e = hipLaunchCooperativeKernel((void*)fwd_kernel, dim3(grid_blocks), dim3(NT), args, 0, stream);
  if (e != hipSuccess) fprintf(stderr, "cooperative launch failed: %s (grid %d)\n", hipGetErrorString(e), grid_blocks);
#else
  phase_kernel<0><<<grid_blocks, NT, 0, stream>>>(p);
  phase_kernel<1><<<grid_blocks, NT, 0, stream>>>(p);
  phase_kernel<2><<<grid_blocks, NT, 0, stream>>>(p);
  phase_kernel<3><<<grid_blocks, NT, 0, stream>>>(p);
  phase_kernel<4><<<grid_blocks, NT, 0, stream>>>(p);
  phase_kernel<5><<<grid_blocks, NT, 0, stream>>>(p);
  phase_kernel<6><<<grid_blocks, NT, 0, stream>>>(p);
  phase_kernel<7><<<grid_blocks, NT, 0, stream>>>(p);
#endif
}
```

```cpp
#include <hip/hip_runtime.h>
#include <hip/hip_bf16.h>
#include <hip/hip_cooperative_groups.h>
#include <stdint.h>
#include <cstdio>
namespace cg = cooperative_groups;

typedef unsigned short u16;
typedef short bf16x8 __attribute__((ext_vector_type(8)));
typedef float f32x4 __attribute__((ext_vector_type(4)));
typedef unsigned u32x4 __attribute__((ext_vector_type(4)));
typedef unsigned u32x2 __attribute__((ext_vector_type(2)));

#ifndef SINGLE_LAUNCH
#define SINGLE_LAUNCH 1
#endif

constexpr int T_ = 8192, D_ = 2048, S_ = 4096, NB_ = 2;
constexpr int INW = 4168;
constexpr int NPH = 8;
constexpr float ALPHA = 1.189207115002721f;
constexpr float EPS = 1e-6f;
constexpr int NT = 512;
constexpr int SMEM_BYTES = 133120;

constexpr size_t al256(size_t x) { return (x + 255) & ~(size_t)255; }
constexpr size_t O_CTR = 0;
constexpr size_t O_WINT = O_CTR + 16384;
constexpr size_t O_WUQT = O_WINT + al256((size_t)4352 * 2048 * 2);
constexpr size_t O_WUKVT = O_WUQT + al256((size_t)1536 * 512 * 2);
constexpr size_t O_WOUTT = O_WUKVT + al256((size_t)2048 * 512 * 2);
constexpr size_t O_WPQT = O_WOUTT + al256((size_t)2048 * 2048 * 2);
constexpr size_t O_WGT = O_WPQT + al256((size_t)1024 * 2048 * 2);
constexpr size_t O_WPT = O_WGT + al256((size_t)2048 * 2048 * 2);
constexpr size_t O_PB = O_WPT + al256((size_t)2048 * 256 * 2);
constexpr size_t O_UB = O_PB + al256((size_t)8192 * 256 * 2);
constexpr size_t O_VB = O_UB + 2048;
constexpr size_t O_OMIX = O_UB + al256((size_t)16384 * 4096);
constexpr size_t O_CS = O_OMIX + al256((size_t)8192 * 2048 * 2);
constexpr size_t O_PROJB = O_CS + al256((size_t)8192 * 32 * 8);
constexpr size_t O_US = O_PROJB + al256((size_t)8192 * 2048 * 2);
constexpr size_t O_VS = O_US + al256((size_t)16384 * 4);
constexpr size_t O_REGB = O_VS + al256((size_t)16384 * 4);
constexpr size_t O_XB = O_REGB;
constexpr size_t O_CQB = O_XB + al256((size_t)8192 * 2048 * 2);
constexpr size_t O_CKVB = O_CQB + al256((size_t)8192 * 512 * 2);
constexpr size_t O_QM = O_CKVB + al256((size_t)8192 * 512 * 2);
constexpr size_t O_KM = O_QM + al256((size_t)8192 * 8 * 192 * 2);
constexpr size_t O_VMT = O_KM + al256((size_t)8192 * 8 * 192 * 2);
constexpr size_t O_QF = O_VMT + al256((size_t)8192 * 8 * 128 * 2);
constexpr size_t O_KF = O_QF + al256((size_t)8192 * 8 * 128 * 2);
constexpr size_t O_VFT = O_KF + al256((size_t)8192 * 8 * 128 * 2);
constexpr size_t O_LOGF = O_VFT + al256((size_t)8192 * 8 * 128 * 2);
constexpr size_t O_FK = O_LOGF + al256((size_t)16 * 4096 * 4);
constexpr size_t O_KRS = O_FK + al256((size_t)16 * 4096 * 4);
constexpr size_t O_RSS = O_KRS + al256((size_t)8192 * 64 * 4);
constexpr size_t O_ENDB = O_RSS + al256((size_t)2 * 8192 * 4);
constexpr size_t O_Y1 = O_REGB;
constexpr size_t O_H1B = O_Y1 + al256((size_t)8192 * 2048 * 4);
constexpr size_t O_PQ = O_H1B + al256((size_t)8192 * 2048 * 2);
constexpr size_t O_GATE = O_PQ + al256((size_t)8192 * 128 * 4);
constexpr size_t O_ENDB2 = O_GATE + al256((size_t)8192 * 128 * 4);
static_assert(O_ENDB2 <= O_ENDB, "region B reuse overflow");
static_assert(O_ENDB <= (size_t)500 * 1024 * 1024, "workspace too large");

struct Params {
  const float *x, *p; const int* positions;
  const float *w_in, *b_forget, *g_q, *w_uq, *g_kv, *w_ukv, *w_out, *ln1_g, *ln1_b;
  const float *peer_wq, *keys1, *keys2, *peer_u, *peer_v, *wgate, *wproj, *ln2_g, *ln2_b;
  float* out;
  char* ws;
#define WSP(type, name, off) __device__ __forceinline__ type* name() const { return (type*)(ws + (off)); }
  WSP(unsigned, ctr, O_CTR) WSP(u16, WinT, O_WINT) WSP(u16, WuqT, O_WUQT) WSP(u16, WukvT, O_WUKVT) WSP(u16, WoutT, O_WOUTT)
  WSP(u16, WpqT, O_WPQT) WSP(u16, WgT, O_WGT) WSP(u16, WpT, O_WPT) WSP(u16, pb, O_PB) WSP(unsigned char, Uq, O_UB) WSP(unsigned char, Vq, O_VB) WSP(float, Us, O_US) WSP(float, Vs, O_VS)
  WSP(u16, omix, O_OMIX) WSP(float2, cs, O_CS) WSP(u16, projb, O_PROJB)
  WSP(u16, xb, O_XB) WSP(u16, cqb, O_CQB) WSP(u16, ckvb, O_CKVB) WSP(u16, Qm, O_QM) WSP(u16, Km, O_KM) WSP(u16, VmT, O_VMT)
  WSP(u16, Qf, O_QF) WSP(u16, Kf, O_KF) WSP(u16, VfT, O_VFT) WSP(float, logf, O_LOGF) WSP(float, Fk, O_FK) WSP(float, krsum, O_KRS) WSP(float, rss, O_RSS)
  WSP(float, y1, O_Y1) WSP(u16, h1b, O_H1B) WSP(int, eidxG, O_PQ) WSP(float, gateG, O_GATE)
#undef WSP
};

__device__ __forceinline__ int TID() { int t = threadIdx.x; asm volatile("" : "+v"(t)); return t; }
__device__ __forceinline__ unsigned pk2(float lo, float hi) {
  unsigned r; asm volatile("v_cvt_pk_bf16_f32 %0, %1, %2" : "=v"(r) : "v"(lo), "v"(hi)); return r;
}
__device__ __forceinline__ u16 f2bf(float f) { return (u16)(pk2(f, 0.f) & 0xffffu); }
__device__ __forceinline__ float bf2f(u16 v) { return __uint_as_float(((unsigned)v) << 16); }
__device__ __forceinline__ float bflo(unsigned v) { return __uint_as_float(v << 16); }
__device__ __forceinline__ float bfhi(unsigned v) { return __uint_as_float(v & 0xffff0000u); }

template <int CTRL> __device__ __forceinline__ int dppi(int v) { return __builtin_amdgcn_update_dpp(0, v, CTRL, 0xF, 0xF, false); }
template <int CTRL> __device__ __forceinline__ float dppf(float v) { return __int_as_float(dppi<CTRL>(__float_as_int(v))); }
__device__ __forceinline__ float rdlane(float v, int l) { return __int_as_float(__builtin_amdgcn_readlane(__float_as_int(v), l)); }

__device__ __forceinline__ float row_sum(float v) {
  v += dppf<0xB1>(v); v += dppf<0x4E>(v); v += dppf<0x141>(v); v += dppf<0x140>(v); return v;
}
__device__ __forceinline__ float row_max(float v) {
  v = fmaxf(v, dppf<0xB1>(v)); v = fmaxf(v, dppf<0x4E>(v)); v = fmaxf(v, dppf<0x141>(v)); v = fmaxf(v, dppf<0x140>(v)); return v;
}
__device__ __forceinline__ float wave_sum(float v) {
  v = row_sum(v);
  return (rdlane(v, 0) + rdlane(v, 16)) + (rdlane(v, 32) + rdlane(v, 48));
}
__device__ __forceinline__ float wave_max(float v) {
  v = row_max(v);
  return fmaxf(fmaxf(rdlane(v, 0), rdlane(v, 16)), fmaxf(rdlane(v, 32), rdlane(v, 48)));
}
__device__ __forceinline__ unsigned wave_umax(unsigned v) {
  unsigned t;
  t = (unsigned)dppi<0xB1>((int)v); v = v > t ? v : t;
  t = (unsigned)dppi<0x4E>((int)v); v = v > t ? v : t;
  t = (unsigned)dppi<0x141>((int)v); v = v > t ? v : t;
  t = (unsigned)dppi<0x140>((int)v); v = v > t ? v : t;
  unsigned a = (unsigned)__builtin_amdgcn_readlane((int)v, 0), b = (unsigned)__builtin_amdgcn_readlane((int)v, 16);
  unsigned c = (unsigned)__builtin_amdgcn_readlane((int)v, 32), d = (unsigned)__builtin_amdgcn_readlane((int)v, 48);
  a = a > b ? a : b; c = c > d ? c : d; return a > c ? a : c;
}
__device__ __forceinline__ unsigned ordkey(float f) {
  unsigned u = __float_as_uint(f);
  return (u & 0x80000000u) ? ~u : (u | 0x80000000u);
}

__device__ __forceinline__ void quant_chunk(const Params& p, int chunk) {
  const int tid = TID(), lane = tid & 63, wid = tid >> 6;
#pragma unroll 1
  for (int i16 = 0; i16 < 8; ++i16) {
    const int r = chunk * 64 + wid * 8 + i16;
    const int tab = r >> 14, row = r & 16383;
    const float* src = (tab ? p.peer_v : p.peer_u) + (size_t)row * D_;
    unsigned* dst = (unsigned*)((tab ? p.Vq() : p.Uq()) + (size_t)row * 4096);
    float4 v[8];
    float am = 0.f;
#pragma unroll
    for (int i = 0; i < 8; ++i) {
      v[i] = *(const float4*)(src + (i * 64 + lane) * 4);
      am = fmaxf(am, fmaxf(fmaxf(fabsf(v[i].x), fabsf(v[i].y)), fmaxf(fabsf(v[i].z), fabsf(v[i].w))));
    }
    am = wave_max(am);
    const float qs = am > 0.f ? 224.f / am : 1.f;
#pragma unroll
    for (int i = 0; i < 8; ++i) {
      unsigned w = __builtin_amdgcn_cvt_pk_fp8_f32(v[i].x * qs, v[i].y * qs, 0, false);
      w = __builtin_amdgcn_cvt_pk_fp8_f32(v[i].z * qs, v[i].w * qs, w, true);
      dst[i * 64 + lane] = w;
    }
    if (lane == 0) (tab ? p.Vs() : p.Us())[row] = am > 0.f ? am / 224.f : 1.f;
  }
}

__device__ void transpose_cvt(const float* __restrict__ W, int ldw, int K, int src_col0, int ncols,
                              u16* __restrict__ WT, int dst_row0, const float* __restrict__ kscale,
                              float* tile, int bid, int nb) {
  const int tiles_k = K / 64, tiles_n = ncols / 64, tid = TID();
#pragma unroll 1
  for (int t = bid; t < tiles_k * tiles_n; t += nb) {
    const int tk = t % tiles_k, tn = t / tiles_k, k0 = tk * 64, n0 = tn * 64;
#pragma unroll
    for (int i = 0; i < 2; ++i) {
      const int r = (tid >> 4) + 32 * i, c = (tid & 15) * 4;
      const float4 v = *(const float4*)(W + (size_t)(k0 + r) * ldw + src_col0 + n0 + c);
      const float sc = kscale ? kscale[k0 + r] : 1.f;
      tile[r * 65 + c + 0] = v.x * sc; tile[r * 65 + c + 1] = v.y * sc;
      tile[r * 65 + c + 2] = v.z * sc; tile[r * 65 + c + 3] = v.w * sc;
    }
    __syncthreads();
    {
      const int n = tid >> 3, kk = (tid & 7) * 8;
      unsigned w[4];
#pragma unroll
      for (int e = 0; e < 4; ++e) w[e] = pk2(tile[(kk + 2 * e) * 65 + n], tile[(kk + 2 * e + 1) * 65 + n]);
      *(u32x4*)(WT + (size_t)(dst_row0 + n0 + n) * K + k0 + kk) = u32x4{w[0], w[1], w[2], w[3]};
    }
    __syncthreads();
  }
}

__device__ void cvt_bf16(const float* __restrict__ src, u16* __restrict__ dst, size_t n8, size_t gtid, size_t gthreads) {
  for (size_t i = gtid; i < n8; i += gthreads) {
    const float4 a = ((const float4*)src)[2 * i], b = ((const float4*)src)[2 * i + 1];
    ((u32x4*)dst)[i] = u32x4{pk2(a.x, a.y), pk2(a.z, a.w), pk2(b.x, b.y), pk2(b.z, b.w)};
  }
}

__device__ void phase_prep(const Params& p, char* smem, int bid, int nb) {
  const int tid = TID(), lane = tid & 63, wid = tid >> 6;
  float* tile = (float*)smem;
  if (bid == 0 && tid == 0) p.ctr()[0] = 0;
  transpose_cvt(p.w_in, INW, D_, 0, 1024, p.WinT(), 0, nullptr, tile, bid, nb);
  transpose_cvt(p.w_in, INW, D_, 1088, 3072, p.WinT(), 1024, nullptr, tile, bid, nb);
  transpose_cvt(p.w_in, INW, D_, 1024, 64, p.WinT(), 4096, nullptr, tile, bid, nb);
  transpose_cvt(p.w_uq, 1536, 512, 0, 1536, p.WuqT(), 0, p.g_q, tile, bid, nb);
  transpose_cvt(p.w_ukv, 2048, 512, 0, 2048, p.WukvT(), 0, p.g_kv, tile, bid, nb);
  transpose_cvt(p.w_out, 2048, 2048, 0, 2048, p.WoutT(), 0, nullptr, tile, bid, nb);
  transpose_cvt(p.peer_wq, 1024, 2048, 0, 1024, p.WpqT(), 0, nullptr, tile, bid, nb);
  transpose_cvt(p.wgate, 2048, 2048, 0, 2048, p.WgT(), 0, nullptr, tile, bid, nb);
  transpose_cvt(p.wproj, 2048, 256, 0, 2048, p.WpT(), 0, nullptr, tile, bid, nb);
  const size_t gtid = (size_t)bid * NT + tid, gth = (size_t)nb * NT;
  for (size_t i = gtid; i < (size_t)192 * 2048 / 8; i += gth) ((u32x4*)(p.WinT() + (size_t)4160 * 2048))[i] = u32x4{0, 0, 0, 0};
  cvt_bf16(p.p, p.pb(), (size_t)T_ * 256 / 8, gtid, gth);
  for (size_t i = gtid; i < (size_t)T_ * 64 / 4; i += gth) ((float4*)p.krsum())[i] = make_float4(0.f, 0.f, 0.f, 0.f);
  for (size_t i = gtid; i < (size_t)2 * T_ / 4; i += gth) ((float4*)p.rss())[i] = make_float4(0.f, 0.f, 0.f, 0.f);
  for (size_t i = gtid; i < (size_t)T_ * 32; i += gth) {
    const int t = (int)(i >> 5), fi = (int)(i & 31);
    const float invf = 1.0f / powf(10000.0f, (float)(2 * fi) / 64.0f);
    const float ang = (float)p.positions[t] * invf;
    const double rev = (double)ang * 0.15915494309189535;
    const float fr = (float)(rev - rint(rev));
    p.cs()[i] = make_float2(__builtin_amdgcn_cosf(fr), __builtin_amdgcn_sinf(fr));
  }
  __syncthreads();
  float* wff = (float*)smem;
  for (int i = tid; i < 2048 * 2; i += NT) {
    const int k = i >> 1, hf = i & 1;
    *(float4*)(wff + k * 8 + hf * 4) = *(const float4*)(p.w_in + (size_t)k * INW + 4160 + hf * 4);
  }
  __syncthreads();
  for (int t = bid * 8 + wid; t < T_; t += nb * 8) {
    float a[8];
#pragma unroll
    for (int e = 0; e < 8; ++e) a[e] = 0.f;
#pragma unroll 1
    for (int i = 0; i < 4; ++i) {
      const int k = (i * 64 + lane) * 8;
      const float4 x0 = *(const float4*)(p.x + (size_t)t * D_ + k), x1 = *(const float4*)(p.x + (size_t)t * D_ + k + 4);
      *(u32x4*)(p.xb() + (size_t)t * D_ + k) = u32x4{pk2(x0.x, x0.y), pk2(x0.z, x0.w), pk2(x1.x, x1.y), pk2(x1.z, x1.w)};
      const float xs[8] = {x0.x, x0.y, x0.z, x0.w, x1.x, x1.y, x1.z, x1.w};
#pragma unroll
      for (int j = 0; j < 8; ++j) {
        const float4 w0 = *(const float4*)(wff + (k + j) * 8), w1 = *(const float4*)(wff + (k + j) * 8 + 4);
        a[0] += xs[j] * w0.x; a[1] += xs[j] * w0.y; a[2] += xs[j] * w0.z; a[3] += xs[j] * w0.w;
        a[4] += xs[j] * w1.x; a[5] += xs[j] * w1.y; a[6] += xs[j] * w1.z; a[7] += xs[j] * w1.w;
      }
    }
    float mine = 0.f;
#pragma unroll
    for (int e = 0; e < 8; ++e) { const float s = wave_sum(a[e]); if (lane == e) mine = s; }
    if (lane < 8) {
      const float z = mine + p.b_forget[lane];
      const float ls = fminf(z, 0.f) - log1pf(expf(-fabsf(z)));
      const int b = t >> 12, s = t & 4095;
      p.logf()[((size_t)(b * 8 + lane)) * S_ + s] = ls;
    }
  }
}

template <int WM, int WN>
__device__ __forceinline__ void gemm_core(const u16* __restrict__ A, int lda, const u16* __restrict__ Bt, int ldb,
                                          int K, int brow, int bcol, char* smem, f32x4 (&acc)[4 / WM][4][4]) {
  constexpr int MS = 4 / WM, BN = 64 * WN, NBL = BN / 64;
  static_assert(WM * WN == 8, "8 waves");
  const int tid = TID(), wid = tid >> 6, lane = tid & 63, wr = wid / WN, wc = wid % WN, fr = lane & 15, fq = lane >> 4;
#pragma unroll
  for (int h = 0; h < MS; ++h)
#pragma unroll
    for (int m = 0; m < 4; ++m)
#pragma unroll
      for (int n = 0; n < 4; ++n) acc[h][m][n] = f32x4{0.f, 0.f, 0.f, 0.f};
  const int nk = K / 64;
  const int srow = tid >> 3, sch = (tid & 7) ^ ((tid >> 4) & 7);
  const u16* ga = A + (size_t)(brow + srow) * lda + sch * 8;
  const u16* gb = Bt + (size_t)(bcol + srow) * ldb + sch * 8;
  char* sdst = smem + tid * 16;
  auto issue = [&](int kt, int st) {
    char* sa = sdst + st * 65536;
#pragma unroll
    for (int i = 0; i < 4; ++i)
      __builtin_amdgcn_global_load_lds((const unsigned*)(ga + (size_t)i * 64 * lda + kt * 64), (unsigned*)(sa + i * 8192), 16, 0, 0);
#pragma unroll
    for (int i = 0; i < NBL; ++i)
      __builtin_amdgcn_global_load_lds((const unsigned*)(gb + (size_t)i * 64 * ldb + kt * 64), (unsigned*)(sa + 32768 + i * 8192), 16, 0, 0);
  };
  const int fx = (fr >> 1) & 7;
  const int arow = (wr * (256 / WM) + fr) * 128, brw = 32768 + (wc * 64 + fr) * 128;
  const int c0 = (fq ^ fx) * 16, c1 = ((4 + fq) ^ fx) * 16;
  asm volatile("s_waitcnt vmcnt(0)" ::: "memory");
  __syncthreads();
  issue(0, 0);
#pragma unroll 1
  for (int kt = 0; kt < nk; ++kt) {
    asm volatile("s_waitcnt vmcnt(0)" ::: "memory");
    __builtin_amdgcn_s_barrier();
    asm volatile("" ::: "memory");
    if (kt + 1 < nk) issue(kt + 1, (kt + 1) & 1);
    const char* sb = smem + (kt & 1) * 65536;
#pragma unroll
    for (int ks = 0; ks < 2; ++ks) {
      const int co = ks ? c1 : c0;
      bf16x8 Bl[4];
#pragma unroll
      for (int n = 0; n < 4; ++n) Bl[n] = *reinterpret_cast<const bf16x8*>(sb + brw + co + n * 2048);
#pragma unroll
      for (int h = 0; h < MS; ++h) {
        bf16x8 At[4];
#pragma unroll
        for (int m = 0; m < 4; ++m) At[m] = *reinterpret_cast<const bf16x8*>(sb + arow + co + (h * 4 + m) * 2048);
#pragma unroll
        for (int m = 0; m < 4; ++m)
#pragma unroll
          for (int n = 0; n < 4; ++n) acc[h][m][n] = __builtin_amdgcn_mfma_f32_16x16x32_bf16(At[m], Bl[n], acc[h][m][n], 0, 0, 0);
      }
    }
  }
}

template <int WM, int WN, class Epi>
__device__ __forceinline__ void gemm_tile(const u16* __restrict__ A, int lda, const u16* __restrict__ Bt, int ldb,
                                          int K, int brow, int bcol, char* smem, Epi epi) {
  constexpr int MS = 4 / WM;
  const int tid = TID(), wid = tid >> 6, lane = tid & 63, wr = wid / WN, wc = wid % WN, fr = lane & 15, fq = lane >> 4;
  f32x4 acc[MS][4][4];
  gemm_core<WM, WN>(A, lda, Bt, ldb, K, brow, bcol, smem, acc);
#pragma unroll
  for (int h = 0; h < MS; ++h) epi(acc[h], brow + wr * (256 / WM) + h * 64, bcol + wc * 64, fr, fq);
}

namespace pg8 {
#define PG8_LAS __attribute__((address_space(3)))
typedef unsigned short bf16_t;
constexpr int BM = 256, BK = 64, HALF = 128, HTB = HALF * BK * 2  , STAGE_BYTES = 8 * HTB, NXCD = 8, WGM = 8;

__host__ __device__ __forceinline__ int lds_byte(int r, int c) { const int st = (r >> 4) * 2 + (c >> 5), rr = r & 15, cc = c & 31, ob = rr * 64 + cc * 2; return st * 1024 + (ob ^ (((ob >> 9) & 1) << 5)); }
__host__ __device__ __forceinline__ void stage_rc(int b, int& R, int& C) { const int st = b / 1024, sb = b % 1024, swz = sb ^ (((sb >> 9) & 1) << 5); R = (st >> 1) * 16 + swz / 64; C = (st & 1) * 32 + (swz % 64) / 2; }
__host__ __device__ __forceinline__ int perm32(int rho) { const int n = rho >> 4, i = rho & 15; return 8 * (i >> 2) + 4 * n + (i & 3); }
struct Unit { int pm, pn; };
struct Gemm { const bf16_t* A; const bf16_t* Bt; int M, N, K; };
struct StaticOrder {
    int nM, nN, nwg, G, c;
    __device__ void init(int M, int N, int G_, int c_) { nM = M / BM; nN = N / BM; nwg = nM * nN; G = G_; c = c_; }
    __device__ bool next(int i, Unit& u) const {
        const long L = (long)i * G + c; if (L >= nwg) return false;
        int wgid = (int)L; { const int q = nwg / NXCD, r = nwg % NXCD, xcd = wgid % NXCD, off = wgid / NXCD; wgid = (xcd < r ? xcd * (q + 1) : r * (q + 1) + (xcd - r) * q) + off; }
        const int nig = WGM * nN, gid = wgid / nig, fm = gid * WGM, gsz = (nM - fm) < WGM ? (nM - fm) : WGM;
        u.pm = fm + ((wgid % nig) % gsz); u.pn = (wgid % nig) / gsz; return true;
    }
    __device__ __forceinline__ void a_ready(const Unit&) const {}
    __device__ __forceinline__ void done(const Unit&) const {}
};
template <class Epi, class Sched, bool STAMP = false>
__device__ __forceinline__ void gemm_phase(PG8_LAS unsigned char* lds, const Gemm g, const Sched& S, const Epi& E, unsigned long long* stamps) {
    const int tid = TID(), wid = __builtin_amdgcn_readfirstlane(tid >> 6), lane = tid & 63, wr = wid >> 2, wc = wid & 3, fr = lane & 15, fq = lane >> 4;
    const int K = g.K, nt = K / BK;
    int ts_lo = 0, ts_hi = 0, nts = 0; const unsigned long long rt_entry = STAMP ? (unsigned long long)wall_clock64() : 0ull;
#define PG8_STAMP() do { if (STAMP && wid == 0 && nts < 64) { const unsigned long long _c = (unsigned long long)clock64(); \
        ts_lo = (lane == nts) ? (int)(unsigned)_c : ts_lo; ts_hi = (lane == nts) ? (int)(unsigned)(_c >> 32) : ts_hi; ++nts; } } while (0)
    PG8_STAMP();
    unsigned voffA[2], voffB[2];
#pragma unroll
    for (int i = 0; i < 2; ++i) { int R, C; stage_rc(tid * 16 + i * 8192, R, C); const int Rb = Epi::PERM ? ((R & ~31) + perm32(R & 31)) : R;
        voffA[i] = (unsigned)(R * K + C) * 2u; voffB[i] = (unsigned)(Rb * K + C) * 2u; }
    const size_t kstep = (size_t)(BK * 2);
    const size_t hstep = (size_t)HALF * K * 2;
    const size_t tstep = 2 * hstep;
    const unsigned ldsw = (unsigned)wid * 1024u;
    const int aoff = lds_byte(wr * 64 + fr, fq * 8), boff = lds_byte(wc * 32 + fr, fq * 8);
#define PG8_SA(b, h) (((b) * 2 + (h)) * HTB)
#define PG8_SB(b, h) ((4 + (b) * 2 + (h)) * HTB)
#define PG8_STAGE(bufoff, gbase, voff) do { _Pragma("unroll") for (int _i = 0; _i < 2; ++_i) \
        __builtin_amdgcn_global_load_lds((const unsigned*)((const char*)(gbase) + (voff)[_i]), (PG8_LAS unsigned*)(lds + (bufoff) + ldsw + _i * 8192), 16, 0, 0); } while (0)
#define PG8_LDA(dst, b, h) do { _Pragma("unroll") for (int m = 0; m < 4; ++m) _Pragma("unroll") for (int k = 0; k < 2; ++k) dst[m][k] = *(const PG8_LAS bf16x8*)(lds + PG8_SA(b, h) + aoff + m * 2048 + k * 1024); } while (0)
#define PG8_LDB(dst, b, h) do { _Pragma("unroll") for (int n = 0; n < 2; ++n) _Pragma("unroll") for (int k = 0; k < 2; ++k) dst[n][k] = *(const PG8_LAS bf16x8*)(lds + PG8_SB(b, h) + boff + n * 2048 + k * 1024); } while (0)
#define PG8_MMA(ai, bj, At, Bt) do { __builtin_amdgcn_s_setprio(1); _Pragma("unroll") for (int m = 0; m < 4; ++m) _Pragma("unroll") for (int n = 0; n < 2; ++n) _Pragma("unroll") for (int k = 0; k < 2; ++k) \
        acc[ai][bj][m][n] = __builtin_amdgcn_mfma_f32_16x16x32_bf16(Bt[n][k], At[m][k], acc[ai][bj][m][n], 0, 0, 0); __builtin_amdgcn_s_setprio(0); } while (0)
#define PG8_WAIT_V(n) asm volatile("s_waitcnt vmcnt(" #n ")" ::: "memory")
#define PG8_WAIT_L(n) asm volatile("s_waitcnt lgkmcnt(" #n ")" ::: "memory")
#define PG8_BAR __builtin_amdgcn_s_barrier()
#define PG8_SCHED __builtin_amdgcn_sched_barrier(0)
    Unit cur, nxt; int ui = 0;
    if (!S.next(0, cur)) return;
    f32x4 acc[2][2][4][2];
#pragma unroll
    for (int a = 0; a < 2; ++a)
#pragma unroll
        for (int b = 0; b < 2; ++b)
#pragma unroll
            for (int m = 0; m < 4; ++m)
#pragma unroll
                for (int n = 0; n < 2; ++n) acc[a][b][m][n] = (f32x4){0.f, 0.f, 0.f, 0.f};
    bf16x8 At[4][2], B0[2][2], B1[2][2];
    const char* cA = (const char*)g.A + (size_t)cur.pm * tstep; const char* cB = (const char*)g.Bt + (size_t)cur.pn * tstep;
    S.a_ready(cur);
    PG8_STAGE(PG8_SB(0, 0), cB, voffB); PG8_STAGE(PG8_SA(0, 0), cA, voffA); PG8_STAGE(PG8_SB(0, 1), cB + hstep, voffB); PG8_STAGE(PG8_SA(0, 1), cA + hstep, voffA);
    if (wr == 1) PG8_BAR;
    PG8_WAIT_V(4); PG8_BAR;
    PG8_STAGE(PG8_SB(1, 0), cB + kstep, voffB); PG8_STAGE(PG8_SA(1, 0), cA + kstep, voffA); PG8_STAGE(PG8_SB(1, 1), cB + hstep + kstep, voffB);
    PG8_WAIT_V(6); PG8_BAR;
    PG8_STAMP();
    for (;;) {
        const bool has_next = S.next(ui + 1, nxt);
        const char* nA = has_next ? (const char*)g.A + (size_t)nxt.pm * tstep : cA; const char* nB = has_next ? (const char*)g.Bt + (size_t)nxt.pn * tstep : cB;
        for (int t = 0; t < nt; t += 2) {
            const bool last = (t == nt - 2);
            const char* a1 = cA + (size_t)(t + 1) * kstep;
            const char* a2 = last ? nA : cA + (size_t)(t + 2) * kstep; const char* b2 = last ? nB : cB + (size_t)(t + 2) * kstep;
            const char* a3 = a2 + kstep; const char* b3 = b2 + kstep;
            if (last && has_next) S.a_ready(nxt);
            PG8_LDB(B0, 0, 0); PG8_SCHED; PG8_LDA(At, 0, 0); PG8_STAGE(PG8_SA(1, 1), a1 + hstep, voffA);
            PG8_WAIT_L(8); PG8_BAR; PG8_WAIT_L(0); PG8_MMA(0, 0, At, B0); PG8_BAR; PG8_SCHED;
            PG8_LDB(B1, 0, 1); PG8_STAGE(PG8_SB(0, 0), b2, voffB);
            PG8_BAR; PG8_WAIT_L(0); PG8_MMA(0, 1, At, B1); PG8_BAR;
            PG8_LDA(At, 0, 1); PG8_STAGE(PG8_SA(0, 0), a2, voffA);
            PG8_BAR; PG8_WAIT_L(0); PG8_MMA(1, 0, At, B0); PG8_BAR; PG8_SCHED;
            PG8_STAGE(PG8_SB(0, 1), b2 + hstep, voffB);
            PG8_WAIT_V(6); PG8_BAR; PG8_MMA(1, 1, At, B1); PG8_BAR;
            PG8_LDB(B0, 1, 0); PG8_SCHED; PG8_LDA(At, 1, 0); PG8_STAGE(PG8_SA(0, 1), a2 + hstep, voffA);
            PG8_WAIT_L(8); PG8_BAR; PG8_WAIT_L(0); PG8_MMA(0, 0, At, B0); PG8_BAR; PG8_SCHED;
            PG8_LDB(B1, 1, 1); PG8_STAGE(PG8_SB(1, 0), b3, voffB);
            PG8_BAR; PG8_WAIT_L(0); PG8_MMA(0, 1, At, B1); PG8_BAR;
            PG8_LDA(At, 1, 1); PG8_STAGE(PG8_SA(1, 0), a3, voffA);
            PG8_BAR; PG8_WAIT_L(0); PG8_MMA(1, 0, At, B0); PG8_BAR; PG8_SCHED;
            PG8_STAGE(PG8_SB(1, 1), b3 + hstep, voffB);
            PG8_WAIT_V(6); PG8_BAR; PG8_MMA(1, 1, At, B1); PG8_BAR;
        }
        PG8_STAMP();
        if constexpr (!Epi::AFTER_DRAIN) { E(acc, cur, wr, wc, fr, fq); S.done(cur); }
        PG8_STAMP();
        if (!has_next) break;
#pragma unroll
        for (int a = 0; a < 2; ++a)
#pragma unroll
            for (int b = 0; b < 2; ++b)
#pragma unroll
                for (int m = 0; m < 4; ++m)
#pragma unroll
                    for (int n = 0; n < 2; ++n) acc[a][b][m][n] = (f32x4){0.f, 0.f, 0.f, 0.f};
        cur = nxt; cA = nA; cB = nB; ++ui;
    }
    PG8_WAIT_V(0);
    if (wr == 0) PG8_BAR;
    PG8_BAR;
    if constexpr (Epi::AFTER_DRAIN) { E.fused(acc, cur, wr, wc, fr, fq, lds, wid, lane); S.done(cur); }
    PG8_STAMP();
    if (STAMP && wid == 0) { stamps[lane] = lane < nts ? (((unsigned long long)(unsigned)ts_hi << 32) | (unsigned)ts_lo) : 0ull;
        if (lane == 62) stamps[62] = rt_entry; if (lane == 63) stamps[63] = (unsigned long long)wall_clock64(); }
#undef PG8_STAMP
#undef PG8_SA
#undef PG8_SB
#undef PG8_STAGE
#undef PG8_LDA
#undef PG8_LDB
#undef PG8_MMA
#undef PG8_WAIT_V
#undef PG8_WAIT_L
#undef PG8_BAR
#undef PG8_SCHED
}
}


__device__ __forceinline__ u32x4 pack8(const f32x4& a, const f32x4& b) { return u32x4{pk2(a[0], a[1]), pk2(a[2], a[3]), pk2(b[0], b[1]), pk2(b[2], b[3])}; }
__device__ __forceinline__ float sumsq4(const f32x4& a) { return (a[0] * a[0] + a[1] * a[1]) + (a[2] * a[2] + a[3] * a[3]); }
__device__ __forceinline__ void store_tr8(u16* vt, const f32x4& a, const f32x4& b) {
  vt[0] = f2bf(a[0]); vt[(size_t)S_] = f2bf(a[1]); vt[(size_t)2 * S_] = f2bf(a[2]); vt[(size_t)3 * S_] = f2bf(a[3]);
  vt[(size_t)4 * S_] = f2bf(b[0]); vt[(size_t)5 * S_] = f2bf(b[1]); vt[(size_t)6 * S_] = f2bf(b[2]); vt[(size_t)7 * S_] = f2bf(b[3]);
}
struct EpiInproj {
  static constexpr bool PERM = true, AFTER_DRAIN = false;
  u16 *cqb, *ckvb, *Qf, *Kf, *VfT; float* rss;
  __device__ __forceinline__ void operator()(const f32x4 (&acc)[2][2][4][2], const pg8::Unit& u, int wr, int wc, int fr, int fq) const {
    const int ct = u.pn * 256;
#pragma unroll
    for (int ai = 0; ai < 2; ++ai)
#pragma unroll
      for (int m = 0; m < 4; ++m) {
        const int row = u.pm * 256 + ai * 128 + wr * 64 + m * 16 + fr, b = row >> 12, s = row & 4095;
        float ss = 0.f;
#pragma unroll
        for (int bj = 0; bj < 2; ++bj) {
          const int c0 = ct + bj * 128 + wc * 32 + 8 * fq;
          const f32x4 v0 = acc[ai][bj][m][0], v1 = acc[ai][bj][m][1];
          if (ct < 1024) {
            u16* dst = ct < 512 ? cqb : ckvb;
            *(u32x4*)(dst + (size_t)row * 512 + (c0 & 511)) = pack8(v0, v1);
            ss += sumsq4(v0) + sumsq4(v1);
          } else if (ct < 3072) {
            int c = c0 - 1024; u16* dst = c < 1024 ? Qf : Kf; c &= 1023;
            *(u32x4*)(dst + ((size_t)(b * 8 + (c >> 7)) * S_ + s) * 128 + (c & 127)) = pack8(v0, v1);
          } else {
            const int c = c0 - 3072;
            store_tr8(VfT + ((size_t)(b * 8 + (c >> 7)) * 128 + (c & 127)) * S_ + s, v0, v1);
          }
        }
        if (ct < 1024) atomicAdd(rss + (ct < 512 ? 0 : T_) + row, ss);
        __builtin_amdgcn_sched_barrier(0);
      }
  }
};
struct EpiQup {
  static constexpr bool PERM = true, AFTER_DRAIN = false;
  u16* Qm; const float* rss;
  __device__ __forceinline__ void operator()(const f32x4 (&acc)[2][2][4][2], const pg8::Unit& u, int wr, int wc, int fr, int fq) const {
#pragma unroll
    for (int ai = 0; ai < 2; ++ai)
#pragma unroll
      for (int m = 0; m < 4; ++m) {
        const int row = u.pm * 256 + ai * 128 + wr * 64 + m * 16 + fr, b = row >> 12, s = row & 4095;
        const float rs = rsqrtf(rss[row] * (1.f / 512.f) + EPS);
#pragma unroll
        for (int bj = 0; bj < 2; ++bj) {
          const int c0 = u.pn * 256 + bj * 128 + wc * 32 + 8 * fq, hh = c0 / 192, off = c0 % 192;
          *(u32x4*)(Qm + ((size_t)(b * 8 + hh) * S_ + s) * 192 + off) = pack8(acc[ai][bj][m][0] * rs, acc[ai][bj][m][1] * rs);
        }
        __builtin_amdgcn_sched_barrier(0);
      }
  }
};
struct EpiKVup {
  static constexpr bool PERM = true, AFTER_DRAIN = false;
  u16 *Km, *VmT; const float* rss;
  __device__ __forceinline__ void operator()(const f32x4 (&acc)[2][2][4][2], const pg8::Unit& u, int wr, int wc, int fr, int fq) const {
    const int hh = u.pn;
#pragma unroll
    for (int ai = 0; ai < 2; ++ai)
#pragma unroll
      for (int m = 0; m < 4; ++m) {
        const int row = u.pm * 256 + ai * 128 + wr * 64 + m * 16 + fr, b = row >> 12, s = row & 4095;
        const float rs = rsqrtf(rss[T_ + row] * (1.f / 512.f) + EPS);
        const int off = wc * 32 + 8 * fq;
        *(u32x4*)(Km + ((size_t)(b * 8 + hh) * S_ + s) * 192 + off) = pack8(acc[ai][0][m][0] * rs, acc[ai][0][m][1] * rs);
        store_tr8(VmT + ((size_t)(b * 8 + hh) * 128 + off) * S_ + s, acc[ai][1][m][0] * rs, acc[ai][1][m][1] * rs);
        __builtin_amdgcn_sched_barrier(0);
      }
  }
};
struct EpiProj {
  static constexpr bool PERM = true, AFTER_DRAIN = false;
  u16* projb;
  __device__ __forceinline__ void operator()(const f32x4 (&acc)[2][2][4][2], const pg8::Unit& u, int wr, int wc, int fr, int fq) const {
#pragma unroll
    for (int ai = 0; ai < 2; ++ai)
#pragma unroll
      for (int m = 0; m < 4; ++m) {
        const int row = u.pm * 256 + ai * 128 + wr * 64 + m * 16 + fr;
#pragma unroll
        for (int bj = 0; bj < 2; ++bj)
          *(u32x4*)(projb + (size_t)row * D_ + u.pn * 256 + bj * 128 + wc * 32 + 8 * fq) = pack8(acc[ai][bj][m][0], acc[ai][bj][m][1]);
      }
  }
};
struct EpiOut {
  static constexpr bool PERM = false, AFTER_DRAIN = false;
  const float* x; float* y1;
  __device__ __forceinline__ void operator()(const f32x4 (&acc)[2][2][4][2], const pg8::Unit& u, int wr, int wc, int fr, int fq) const {
#pragma unroll
    for (int ai = 0; ai < 2; ++ai)
#pragma unroll
      for (int m = 0; m < 4; ++m) {
        const size_t rb = (size_t)(u.pm * 256 + ai * 128 + wr * 64 + m * 16 + fr) * D_ + u.pn * 256 + wc * 32 + 4 * fq;
#pragma unroll
        for (int bj = 0; bj < 2; ++bj)
#pragma unroll
          for (int n = 0; n < 2; ++n) {
            const size_t o = rb + bj * 128 + n * 16;
            const f32x4 xv = *(const f32x4*)(x + o);
            *(f32x4*)(y1 + o) = xv * ALPHA + acc[ai][bj][m][n];
          }
      }
  }
};
struct EpiGate {
  static constexpr bool PERM = false, AFTER_DRAIN = false;
  const float* h1; const u16* projb; float* out;
  __device__ __forceinline__ void operator()(const f32x4 (&acc)[2][2][4][2], const pg8::Unit& u, int wr, int wc, int fr, int fq) const {
#pragma unroll
    for (int ai = 0; ai < 2; ++ai)
#pragma unroll
      for (int m = 0; m < 4; ++m) {
        const size_t rb = (size_t)(u.pm * 256 + ai * 128 + wr * 64 + m * 16 + fr) * D_ + u.pn * 256 + wc * 32 + 4 * fq;
#pragma unroll
        for (int bj = 0; bj < 2; ++bj)
#pragma unroll
          for (int n = 0; n < 2; ++n) {
            const size_t o = rb + bj * 128 + n * 16;
            const f32x4 hv = *(const f32x4*)(h1 + o);
            const u32x2 pj = *(const u32x2*)(projb + o);
            const f32x4 a = acc[ai][bj][m][n];
            f32x4 r;
            r[0] = ALPHA * hv[0] + bflo(pj[0]) / (1.f + __expf(-a[0])); r[1] = ALPHA * hv[1] + bfhi(pj[0]) / (1.f + __expf(-a[1]));
            r[2] = ALPHA * hv[2] + bflo(pj[1]) / (1.f + __expf(-a[2])); r[3] = ALPHA * hv[3] + bfhi(pj[1]) / (1.f + __expf(-a[3]));
            *(f32x4*)(out + o) = r;
          }
      }
  }
};

__device__ __forceinline__ int vblock(int bid, int nb) { return (nb & 7) ? bid : (bid & 7) * (nb >> 3) + (bid >> 3); }
__device__ __forceinline__ void tile_rc(int t, int Nt, int& tm, int& tn) {
  const int g = t / (8 * Nt), q = t % (8 * Nt);
  tn = q >> 3; tm = g * 8 + (q & 7);
}

__device__ void phase_inproj(const Params& p, char* smem, int bid, int nb) {
  {
    EpiInproj E{p.cqb(), p.ckvb(), p.Qf(), p.Kf(), p.VfT(), p.rss()};
    pg8::Gemm g{p.xb(), p.WinT(), T_, 4096, D_};
    pg8::StaticOrder S; S.init(T_, 4096, nb, bid);
    pg8::gemm_phase((PG8_LAS unsigned char*)smem, g, S, E, nullptr);
  }
  for (int t = vblock(bid, nb); t < 256; t += nb) {
    const int tm = t >> 3, ks = t & 7;
    f32x4 acc[2][4][4];
    gemm_core<2, 4>(p.xb() + ks * 256, D_, p.WinT() + ks * 256, D_, 256, tm * 256, 4096, smem, acc);
    const int tid = TID(), wid = tid >> 6, lane = tid & 63, wr = wid >> 2, wc = wid & 3, fr = lane & 15, fq = lane >> 4;
    if (wc == 0) {
#pragma unroll
      for (int h = 0; h < 2; ++h) {
        float* kd = p.krsum() + (size_t)(tm * 256 + wr * 128 + h * 64 + fq * 4) * 64 + fr;
#pragma unroll
        for (int m = 0; m < 4; ++m)
#pragma unroll
          for (int n = 0; n < 4; ++n)
#pragma unroll
            for (int j = 0; j < 4; ++j) atomicAdd(kd + (m * 16 + j) * 64 + n * 16, acc[h][m][n][j]);
      }
    }
  }
}

__device__ void phase_up(const Params& p, char* smem, int bid, int nb) {
  PG8_LAS unsigned char* lds = (PG8_LAS unsigned char*)smem;
  {
    EpiQup E{p.Qm(), p.rss()};
    pg8::Gemm g{p.cqb(), p.WuqT(), T_, 1536, 512};
    pg8::StaticOrder S; S.init(T_, 1536, nb, (bid + nb - 64) % nb);
    pg8::gemm_phase(lds, g, S, E, nullptr);
  }
  {
    EpiKVup E{p.Km(), p.VmT(), p.rss()};
    pg8::Gemm g{p.ckvb(), p.WukvT(), T_, 2048, 512};
    pg8::StaticOrder S; S.init(T_, 2048, nb, bid);
    pg8::gemm_phase(lds, g, S, E, nullptr);
  }
  {
    EpiProj E{p.projb()};
    pg8::Gemm g{p.pb(), p.WpT(), T_, 2048, 256};
    pg8::StaticOrder S; S.init(T_, 2048, nb, bid);
    pg8::gemm_phase(lds, g, S, E, nullptr);
  }
  for (int t = bid; t < 48; t += nb) {
    if (t >= 16) {
      const int r0 = (t - 16) * 256, tid = TID();
#pragma unroll 1
      for (int it = 0; it < 16; ++it) {
        const int pr = it * NT + tid, row = r0 + (pr >> 5), i = pr & 31, b = row >> 12, s = row & 4095;
        const float x1 = p.krsum()[(size_t)row * 64 + i], x2 = p.krsum()[(size_t)row * 64 + 32 + i];
        const float2 cs = p.cs()[(size_t)row * 32 + i];
        const u16 o1 = f2bf(x1 * cs.x - x2 * cs.y), o2 = f2bf(x1 * cs.y + x2 * cs.x);
#pragma unroll
        for (int hh = 0; hh < 8; ++hh) {
          u16* kd = p.Km() + ((size_t)(b * 8 + hh) * S_ + s) * 192 + 128;
          kd[i] = o1; kd[32 + i] = o2;
        }
      }
    } else {
      const int seq = t;
      if ((TID() >> 6) == 0) {
        const int lane = TID() & 63;
        const float* src = p.logf() + (size_t)seq * S_ + lane * 64;
        float* dst = p.Fk() + (size_t)seq * S_ + lane * 64;
        float sum = 0.f;
        for (int i = 0; i < 16; ++i) { const float4 v = *(const float4*)(src + i * 4); sum += v.x; sum += v.y; sum += v.z; sum += v.w; }
        float inc = sum;
#pragma unroll
        for (int d = 1; d < 64; d <<= 1) { const float o = __shfl_up(inc, d, 64); if (lane >= d) inc += o; }
        float run = inc - sum;
        for (int i = 0; i < 16; ++i) {
          const float4 v = *(const float4*)(src + i * 4); float4 o;
          run += v.x; o.x = run; run += v.y; o.y = run; run += v.z; o.z = run; run += v.w; o.w = run;
          *(float4*)(dst + i * 4) = o;
        }
      }
    }
  }
}

#ifdef ATTN_NAIVE
__device__ void phase_attn_naive(const Params& p, char* smem, int bid, int nb) {
  const int tid = TID(), lane = tid & 63, wid = tid >> 6;
  const int per = NB_ * 8 * S_, nrows = 2 * per;
  for (int r = bid * 4 + wid; r < nrows; r += nb * 4) {
    const int type = r / per, rr = r % per, bh = rr / S_, s = rr % S_;
    const int DQ = type ? 128 : 192;
    const u16* Q = type ? p.Qf() + ((size_t)bh * S_ + s) * 128 : p.Qm() + ((size_t)bh * S_ + s) * 192;
    const u16* Kb = type ? p.Kf() + (size_t)bh * S_ * 128 : p.Km() + (size_t)bh * S_ * 192;
    const u16* VT = (type ? p.VfT() : p.VmT()) + (size_t)bh * 128 * S_;
    const float* F = p.Fk() + (size_t)bh * S_;
    const float scale = type ? 0.08838834764831845f : 0.07216878364870322f;
    float m = -1e30f, l = 0.f;
    float acc[128];
#pragma unroll
    for (int d = 0; d < 128; ++d) acc[d] = 0.f;
    const float fqv = type ? F[s] : 0.f;
    for (int k0 = 0; k0 <= s; k0 += 64) {
      const int key = k0 + lane; const bool valid = key <= s; const int keyc = valid ? key : s;
      const u16* kr = Kb + (size_t)keyc * DQ;
      float sc = 0.f;
      for (int d = 0; d < DQ; d += 8) {
        const u32x4 kv = *(const u32x4*)(kr + d), qv = *(const u32x4*)(Q + d);
#pragma unroll
        for (int w = 0; w < 4; ++w) sc += bflo(kv[w]) * bflo(qv[w]) + bfhi(kv[w]) * bfhi(qv[w]);
      }
      sc *= scale;
      if (type) sc += fqv - F[keyc];
      if (!valid) sc = -1e30f;
      const float mx = wave_max(sc), mn = fmaxf(m, mx), alpha = __expf(m - mn);
      const float pr = valid ? __expf(sc - mn) : 0.f;
      m = mn; l = l * alpha + pr;
#pragma unroll
      for (int d = 0; d < 128; ++d) acc[d] = acc[d] * alpha + pr * bf2f(VT[(size_t)d * S_ + keyc]);
    }
    const float inv = 1.f / wave_sum(l);
    float o0 = 0.f, o1 = 0.f;
#pragma unroll
    for (int d = 0; d < 128; ++d) {
      const float o = wave_sum(acc[d]) * inv;
      if (lane == (d & 63)) { if (d < 64) o0 = o; else o1 = o; }
    }
    const int b = bh >> 3, hh = bh & 7;
    u16* od = p.omix() + ((size_t)(b * S_ + s)) * 2048 + type * 1024 + hh * 128;
    od[lane] = f2bf(o0); od[64 + lane] = f2bf(o1);
  }
}

#endif
typedef float f32x16 __attribute__((ext_vector_type(16)));
template <int TYPE>
__device__ __forceinline__ void attn_item(const Params& p, char* smem, int bh, int qb) {
  constexpr int DQK = TYPE ? 128 : 192, NKS = DQK / 16, KSTR = DQK * 2 + 16, VSTR = 128;
  constexpr int KCH = DQK / 8, NKL = 64 * KCH / NT;
  constexpr float C2 = (TYPE ? 0.08838834764831845f : 0.07216878364870322f) * 1.4426950408889634f;
  char* sK = smem; char* sV = smem + 25600; float* sF = (float*)(smem + 25600 + 32768);
  const int tid = TID(), lane = tid & 63, wid = tid >> 6, c = lane & 31, hi = lane >> 5;
  const u16* Qb = (TYPE ? p.Qf() : p.Qm()) + (size_t)bh * S_ * DQK;
  const u16* Kb = (TYPE ? p.Kf() : p.Km()) + (size_t)bh * S_ * DQK;
  const u16* Vb = (TYPE ? p.VfT() : p.VmT()) + (size_t)bh * 128 * S_;
  const float* Fb = p.Fk() + (size_t)bh * S_;
  const int qrow = qb * 256 + wid * 32;
  bf16x8 qf[NKS];
#pragma unroll
  for (int ks = 0; ks < NKS; ++ks) qf[ks] = *(const bf16x8*)(Qb + (size_t)(qrow + c) * DQK + ks * 16 + hi * 8);
  if (TYPE == 0) {
    const float2* csr = p.cs() + (size_t)((bh >> 3) * S_ + qrow + c) * 32;
#pragma unroll
    for (int kk = 0; kk < 2; ++kk) {
      u32x4 x1 = *reinterpret_cast<u32x4*>(&qf[(NKS - 4) + kk]), x2 = *reinterpret_cast<u32x4*>(&qf[(NKS - 2) + kk]);
#pragma unroll
      for (int w = 0; w < 4; ++w) {
        const float4 cs = *(const float4*)(csr + 16 * kk + 8 * hi + 2 * w);
        const float a0 = bflo(x1[w]), a1 = bfhi(x1[w]), b0 = bflo(x2[w]), b1 = bfhi(x2[w]);
        x1[w] = pk2(a0 * cs.x - b0 * cs.y, a1 * cs.z - b1 * cs.w);
        x2[w] = pk2(a0 * cs.y + b0 * cs.x, a1 * cs.w + b1 * cs.z);
      }
      qf[(NKS - 4) + kk] = *reinterpret_cast<bf16x8*>(&x1); qf[(NKS - 2) + kk] = *reinterpret_cast<bf16x8*>(&x2);
    }
  }
  f32x16 o[4];
#pragma unroll
  for (int db = 0; db < 4; ++db)
#pragma unroll
    for (int r = 0; r < 16; ++r) o[db][r] = 0.f;
  float m = -1e30f, l = 0.f;
  const int ntiles = 4 * qb + 4;
  u32x4 kreg[NKL];
  float4 freg = make_float4(0.f, 0.f, 0.f, 0.f);
  const unsigned koff = (unsigned)tid * 16u;
  auto load_k = [&](int kt) {
    const char* kb = (const char*)(Kb + (size_t)kt * 64 * DQK);
#pragma unroll
    for (int i = 0; i < NKL; ++i) kreg[i] = *(const u32x4*)(kb + i * 8192 + koff);
    if (TYPE) { if (tid < 16) freg = *(const float4*)(Fb + kt * 64 + tid * 4); }
  };
  const unsigned voff = (unsigned)((((tid >> 3) * S_) + (((tid & 7) ^ ((tid >> 4) & 7)) * 8)) * 2);
  auto load_v = [&](int kt) {
    const char* vb = (const char*)(Vb + kt * 64);
    char* dst = sV + (kt & 1) * 16384 + tid * 16;
#pragma unroll
    for (int i = 0; i < 2; ++i)
      __builtin_amdgcn_global_load_lds((const unsigned*)(vb + (size_t)i * 64 * S_ * 2 + voff), (unsigned*)(dst + i * 8192), 16, 0, 0);
  };
  auto store_tile = [&]() {
#pragma unroll
    for (int i = 0; i < NKL; ++i) { const int ch = tid + NT * i, key = ch / KCH, dc = ch % KCH; *(u32x4*)(sK + key * KSTR + dc * 16) = kreg[i]; }
    if (TYPE) { if (tid < 16) { const float L2E = 1.4426950408889634f; *(float4*)(sF + tid * 4) = make_float4(freg.x * L2E, freg.y * L2E, freg.z * L2E, freg.w * L2E); } }
  };
  const int krow = (c & 19) | ((c & 4) << 1) | ((c & 8) >> 1);
  const char* ka0 = sK + krow * KSTR + hi * 16;
  const char* ka1 = ka0 + 32 * KSTR;
  const int vx = (c >> 1) & 7;
  int vo[2][2];
#pragma unroll
  for (int kb = 0; kb < 2; ++kb)
#pragma unroll
    for (int s2 = 0; s2 < 2; ++s2) vo[kb][s2] = c * VSTR + (((4 * kb + 2 * s2 + hi) ^ vx) * 16);
  load_k(0); load_v(0);
#pragma unroll 1
  for (int kt = 0; kt < ntiles; ++kt) {
    asm volatile("s_waitcnt vmcnt(0)" ::: "memory");
    __syncthreads();
    store_tile();
    __syncthreads();
    if (kt + 1 < ntiles) { load_k(kt + 1); load_v(kt + 1); }
    const int k0 = kt * 64;
    const char* sVc = sV + (kt & 1) * 16384;
    if (k0 <= qrow + 31) {
      f32x16 p0, p1;
#pragma unroll
      for (int r = 0; r < 16; ++r) { p0[r] = 0.f; p1[r] = 0.f; }
#pragma unroll
      for (int ks = 0; ks < NKS; ++ks) {
        const bf16x8 a0 = *(const bf16x8*)(ka0 + ks * 32), a1 = *(const bf16x8*)(ka1 + ks * 32);
        p0 = __builtin_amdgcn_mfma_f32_32x32x16_bf16(a0, qf[ks], p0, 0, 0, 0);
        p1 = __builtin_amdgcn_mfma_f32_32x32x16_bf16(a1, qf[ks], p1, 0, 0, 0);
      }
      if (TYPE) {
#pragma unroll
        for (int s = 0; s < 2; ++s) {
          const float4 f0 = *(const float4*)(sF + 16 * s + 8 * hi), f1 = *(const float4*)(sF + 16 * s + 8 * hi + 4);
          const float4 g0 = *(const float4*)(sF + 32 + 16 * s + 8 * hi), g1 = *(const float4*)(sF + 32 + 16 * s + 8 * hi + 4);
          p0[8 * s + 0] = p0[8 * s + 0] * C2 - f0.x; p0[8 * s + 1] = p0[8 * s + 1] * C2 - f0.y; p0[8 * s + 2] = p0[8 * s + 2] * C2 - f0.z; p0[8 * s + 3] = p0[8 * s + 3] * C2 - f0.w;
          p0[8 * s + 4] = p0[8 * s + 4] * C2 - f1.x; p0[8 * s + 5] = p0[8 * s + 5] * C2 - f1.y; p0[8 * s + 6] = p0[8 * s + 6] * C2 - f1.z; p0[8 * s + 7] = p0[8 * s + 7] * C2 - f1.w;
          p1[8 * s + 0] = p1[8 * s + 0] * C2 - g0.x; p1[8 * s + 1] = p1[8 * s + 1] * C2 - g0.y; p1[8 * s + 2] = p1[8 * s + 2] * C2 - g0.z; p1[8 * s + 3] = p1[8 * s + 3] * C2 - g0.w;
          p1[8 * s + 4] = p1[8 * s + 4] * C2 - g1.x; p1[8 * s + 5] = p1[8 * s + 5] * C2 - g1.y; p1[8 * s + 6] = p1[8 * s + 6] * C2 - g1.z; p1[8 * s + 7] = p1[8 * s + 7] * C2 - g1.w;
        }
      } else {
#pragma unroll
        for (int r = 0; r < 16; ++r) { p0[r] *= C2; p1[r] *= C2; }
      }
      if (k0 + 63 > qrow) {
        const int lim = qrow + c - k0 - 8 * hi;
        const float NEG = -__builtin_inff();
#pragma unroll
        for (int r = 0; r < 16; ++r) {
          const int kb = 16 * (r >> 3) + (r & 7);
          if (kb > lim) p0[r] = NEG;
          if (kb + 32 > lim) p1[r] = NEG;
        }
      }
      float mx = p0[0];
#pragma unroll
      for (int r = 1; r < 16; ++r) mx = fmaxf(mx, p0[r]);
#pragma unroll
      for (int r = 0; r < 16; ++r) mx = fmaxf(mx, p1[r]);
      {
        auto rr = __builtin_amdgcn_permlane32_swap(__float_as_uint(mx), __float_as_uint(mx), false, false);
        mx = fmaxf(__uint_as_float(rr[0]), __uint_as_float(rr[1]));
      }
      const float mn = fmaxf(m, mx);
      const float alpha = __builtin_amdgcn_exp2f(m - mn);
      m = mn;
      if (!__all(alpha == 1.f)) {
#pragma unroll
        for (int db = 0; db < 4; ++db)
#pragma unroll
          for (int r = 0; r < 16; ++r) o[db][r] *= alpha;
      }
      float ps = 0.f;
#pragma unroll
      for (int r = 0; r < 16; ++r) { p0[r] = __builtin_amdgcn_exp2f(p0[r] - mn); p1[r] = __builtin_amdgcn_exp2f(p1[r] - mn); ps += p0[r] + p1[r]; }
      l = l * alpha + ps;
      bf16x8 pa[2][2];
#pragma unroll
      for (int s = 0; s < 2; ++s) {
        u32x4 w0 = {pk2(p0[8 * s + 0], p0[8 * s + 1]), pk2(p0[8 * s + 2], p0[8 * s + 3]), pk2(p0[8 * s + 4], p0[8 * s + 5]), pk2(p0[8 * s + 6], p0[8 * s + 7])};
        u32x4 w1 = {pk2(p1[8 * s + 0], p1[8 * s + 1]), pk2(p1[8 * s + 2], p1[8 * s + 3]), pk2(p1[8 * s + 4], p1[8 * s + 5]), pk2(p1[8 * s + 6], p1[8 * s + 7])};
        pa[0][s] = *reinterpret_cast<bf16x8*>(&w0); pa[1][s] = *reinterpret_cast<bf16x8*>(&w1);
      }
#pragma unroll
      for (int db = 0; db < 4; ++db)
#pragma unroll
        for (int kb = 0; kb < 2; ++kb)
#pragma unroll
          for (int s = 0; s < 2; ++s) {
            const bf16x8 av = *(const bf16x8*)(sVc + db * 32 * VSTR + vo[kb][s]);
            o[db] = __builtin_amdgcn_mfma_f32_32x32x16_bf16(av, pa[kb][s], o[db], 0, 0, 0);
          }
    }
  }
  {
    auto rr = __builtin_amdgcn_permlane32_swap(__float_as_uint(l), __float_as_uint(l), false, false);
    const float inv = 1.f / (__uint_as_float(rr[0]) + __uint_as_float(rr[1]));
    const int b = bh >> 3, hh = bh & 7;
    u16* od = p.omix() + ((size_t)(b * S_ + qrow + c)) * 2048 + TYPE * 1024 + hh * 128 + 4 * hi;
#pragma unroll
    for (int db = 0; db < 4; ++db)
#pragma unroll
      for (int g = 0; g < 4; ++g)
        *(u32x2*)(od + 32 * db + 8 * g) = u32x2{pk2(o[db][4 * g] * inv, o[db][4 * g + 1] * inv), pk2(o[db][4 * g + 2] * inv, o[db][4 * g + 3] * inv)};
  }
}

__device__ void phase_attn(const Params& p, char* smem, int bid, int nb) {
  int* sItem = (int*)(smem + 60000);
  const int x = bid & 7;
  unsigned* q = p.ctr() + 32 + x;
  for (;;) {
    __syncthreads();
    if (TID() == 0) *sItem = (int)atomicAdd(q, 1u);
    __syncthreads();
    const int item = *sItem;
    if (item >= 64) break;
    const int qb = 15 - (item >> 2), r = item & 3, type = r >> 1, bh = x + 8 * (r & 1);
    if (type == 0) attn_item<0>(p, smem, bh, qb); else attn_item<1>(p, smem, bh, qb);
  }
  unsigned* qc = p.ctr() + 48;
  for (;;) {
    __syncthreads();
    if (TID() == 0) *sItem = (int)atomicAdd(qc, 1u);
    __syncthreads();
    const int chunk = *sItem;
    if (chunk >= 512) break;
    quant_chunk(p, chunk);
  }
}

__device__ void phase_outproj(const Params& p, char* smem, int bid, int nb) {
  EpiOut E{p.x, p.y1()};
  pg8::Gemm g{p.omix(), p.WoutT(), T_, D_, D_};
  pg8::StaticOrder S; S.init(T_, D_, nb, bid);
  pg8::gemm_phase((PG8_LAS unsigned char*)smem, g, S, E, nullptr);
}

__device__ void phase_ln1(const Params& p, int bid, int nb) {
  const int lane = TID() & 63, wid = TID() >> 6;
  for (int t = bid * 8 + wid; t < T_; t += nb * 8) {
    float* row = p.y1() + (size_t)t * D_;
    float4 v[8];
    float sum = 0.f;
#pragma unroll
    for (int i = 0; i < 8; ++i) { v[i] = *(const float4*)(row + (i * 64 + lane) * 4); sum += (v[i].x + v[i].y) + (v[i].z + v[i].w); }
    const float mu = wave_sum(sum) * (1.f / D_);
    float sq = 0.f;
#pragma unroll
    for (int i = 0; i < 8; ++i) {
      v[i].x -= mu; v[i].y -= mu; v[i].z -= mu; v[i].w -= mu;
      sq += (v[i].x * v[i].x + v[i].y * v[i].y) + (v[i].z * v[i].z + v[i].w * v[i].w);
    }
    const float rstd = rsqrtf(wave_sum(sq) * (1.f / D_) + EPS);
#pragma unroll
    for (int i = 0; i < 8; ++i) {
      const int c = (i * 64 + lane) * 4;
      const float4 g = *(const float4*)(p.ln1_g + c), bb = *(const float4*)(p.ln1_b + c);
      float4 o; o.x = v[i].x * rstd * g.x + bb.x; o.y = v[i].y * rstd * g.y + bb.y; o.z = v[i].z * rstd * g.z + bb.z; o.w = v[i].w * rstd * g.w + bb.w;
      *(float4*)(row + c) = o;
      *(u32x2*)(p.h1b() + (size_t)t * D_ + c) = u32x2{pk2(o.x, o.y), pk2(o.z, o.w)};
    }
  }
}

__device__ __forceinline__ void ins16(unsigned (&t)[16], unsigned x) {
#pragma unroll
  for (int i = 0; i < 16; ++i) { const unsigned hi = t[i] > x ? t[i] : x; x = t[i] > x ? x : t[i]; t[i] = hi; }
}
__device__ __forceinline__ void ins16p(unsigned (&ck)[16], int (&ce)[16], unsigned x, int xe) {
#pragma unroll
  for (int i = 0; i < 16; ++i) {
    const bool sw = x > ck[i];
    const unsigned nk = sw ? x : ck[i], nx = sw ? ck[i] : x;
    const int ne = sw ? xe : ce[i], nxe = sw ? ce[i] : xe;
    ck[i] = nk; x = nx; ce[i] = ne; xe = nxe;
  }
}
__device__ __forceinline__ float unordkey(unsigned k) { return __uint_as_float((k & 0x80000000u) ? (k & 0x7fffffffu) : ~k); }

__device__ __forceinline__ void route_tile(const Params& p, char* smem, f32x4 (&acc)[4][4], int tm, int h) {
  const int tid = TID(), wid = tid >> 6, lane = tid & 63, wr = wid >> 1, wc = wid & 1, fr = lane & 15, fq = lane >> 4;
  __syncthreads();
  float* Qw = (float*)smem + wid * (64 * 65);
#pragma unroll
  for (int m = 0; m < 4; ++m)
#pragma unroll
    for (int n = 0; n < 4; ++n)
#pragma unroll
      for (int j = 0; j < 4; ++j) Qw[(m * 16 + fq * 4 + j) * 65 + n * 16 + fr] = acc[m][n][j];
  asm volatile("s_waitcnt lgkmcnt(0)" ::: "memory");
  float q[64];
#pragma unroll
  for (int d = 0; d < 64; ++d) q[d] = Qw[lane * 65 + d];
  __syncthreads();
  {
    float* ks = (float*)smem;
#pragma unroll
    for (int i = 0; i < 8; ++i) {
      const int idx = (i * NT + tid) * 4;
      const float* src = (idx < 8192 ? p.keys1 : p.keys2) + (size_t)h * 8192 + (idx & 8191);
      *(float4*)(ks + idx) = *(const float4*)src;
    }
  }
  __syncthreads();
  unsigned t[16];
#pragma unroll
  for (int i = 0; i < 16; ++i) t[i] = 0u;
  {
    const float* kb = (const float*)smem + wc * 8192;
#pragma unroll 1
    for (int n = 0; n < 128; ++n) {
      float d0 = 0.f, d1 = 0.f, d2 = 0.f, d3 = 0.f;
#pragma unroll
      for (int i = 0; i < 16; ++i) {
        const float4 kv = *(const float4*)(kb + n * 64 + i * 4);
        d0 += kv.x * q[4 * i]; d1 += kv.y * q[4 * i + 1]; d2 += kv.z * q[4 * i + 2]; d3 += kv.w * q[4 * i + 3];
      }
      const float sc = (d0 + d1) + (d2 + d3);
      ins16(t, (ordkey(sc) & ~127u) | (unsigned)(127 - n));
    }
  }
  __syncthreads();
  unsigned* L = (unsigned*)smem;
#pragma unroll
  for (int r = 0; r < 16; ++r) L[(wc * 16 + r) * 256 + wr * 64 + lane] = t[r];
  __syncthreads();
  if (wid < 4) {
    const int tok = wid * 64 + lane;
    unsigned ck[16]; int ce[16];
#pragma unroll
    for (int i = 0; i < 16; ++i) { ck[i] = 0u; ce[i] = 0; }
#pragma unroll 1
    for (int a = 0; a < 16; ++a) {
      const unsigned ka = L[a * 256 + tok];
      const int i1a = (127 - (int)(ka & 127u)) * 128; const float v1a = unordkey(ka & ~127u);
      const int nbm1 = (int)((0x1112347FULL >> (4 * a)) & 15ULL);
#pragma unroll 1
      for (int b = 0; b <= nbm1; ++b) {
        const unsigned kb = L[(16 + b) * 256 + tok];
        const int i2b = 127 - (int)(kb & 127u); const float v2b = unordkey(kb & ~127u);
        ins16p(ck, ce, ordkey(v1a + v2b), i1a + i2b);
      }
    }
    float ex[16], sum = 0.f;
    const float mx = unordkey(ck[0]);
#pragma unroll
    for (int r = 0; r < 16; ++r) { ex[r] = __expf(unordkey(ck[r]) - mx); sum += ex[r]; }
    const float inv = 1.f / sum;
    const size_t o = ((size_t)(tm * 256 + tok) * 8 + h) * 16;
    int* ed = p.eidxG() + o; float* gd = p.gateG() + o;
#pragma unroll
    for (int r = 0; r < 16; r += 4) {
      *(int4*)(ed + r) = make_int4(ce[r], ce[r + 1], ce[r + 2], ce[r + 3]);
      *(float4*)(gd + r) = make_float4(ex[r] * inv, ex[r + 1] * inv, ex[r + 2] * inv, ex[r + 3] * inv);
    }
  }
}

__device__ void phase_mid(const Params& p, char* smem, int bid, int nb) {
  {
    EpiGate E{p.y1(), p.projb(), p.out};
    pg8::Gemm g{p.h1b(), p.WgT(), T_, D_, D_};
    pg8::StaticOrder S; S.init(T_, D_, nb, bid);
    pg8::gemm_phase((PG8_LAS unsigned char*)smem, g, S, E, nullptr);
  }
  for (int t = vblock(bid, nb); t < 32 * 8; t += nb) {
    int tm, tn; tile_rc(t, 8, tm, tn);
    f32x4 acc[1][4][4];
    gemm_core<4, 2>(p.h1b(), D_, p.WpqT(), D_, D_, tm * 256, tn * 128, smem, acc);
    route_tile(p, smem, acc[0], tm, tn);
  }
}

__device__ __forceinline__ float gelu_exact(float a) {
  const float x = fabsf(a) * 0.7071067811865476f;
  const float t = __builtin_amdgcn_rcpf(1.f + 0.3275911f * x);
  const float poly = t * (0.254829592f + t * (-0.284496736f + t * (1.421413741f + t * (-1.453152027f + t * 1.061405429f))));
  const float er = 1.f - poly * __expf(-x * x);
  return 0.5f * a * (1.f + (a < 0.f ? -er : er));
}

template <int NPER, int IDXMASK>
__device__ __forceinline__ int top16(unsigned (&k)[NPER], int lane) {
  int mine = 0;
#pragma unroll 1
  for (int r = 0; r < 16; ++r) {
    unsigned loc = k[0];
#pragma unroll
    for (int i = 1; i < NPER; ++i) loc = loc > k[i] ? loc : k[i];
    const unsigned best = wave_umax(loc);
#pragma unroll
    for (int i = 0; i < NPER; ++i) if (k[i] == best) k[i] = 0u;
    if (lane == r) mine = IDXMASK - (int)(best & (unsigned)IDXMASK);
  }
  return mine;
}

__device__ void phase_peer(const Params& p, char* smem, int bid, int nb) {
  const int tid = TID(), lane = tid & 63, wid = tid >> 6;
  float* qs = (float*)smem;
  float* sc = (float*)(smem + 8192);
  int* eidx = (int*)(smem + 24576);
  float* gts = (float*)(smem + 40960);
  for (int it = bid; it < T_ / 32; it += nb) {
    const int t0 = it * 32;
#pragma unroll
    for (int i = 0; i < 2; ++i) {
      const int idx = (i * NT + tid) * 4;
      *(int4*)(eidx + idx) = *(const int4*)(p.eidxG() + (size_t)t0 * 128 + idx);
      *(float4*)(gts + idx) = *(const float4*)(p.gateG() + (size_t)t0 * 128 + idx);
    }
    __syncthreads();
    for (int ti = 0; ti < 4; ++ti) {
      const int tok = wid * 4 + ti, t = t0 + tok;
      typedef float f32x2 __attribute__((ext_vector_type(2)));
      float hreg[32], o[32];
#pragma unroll
      for (int c = 0; c < 2; ++c)
#pragma unroll
        for (int q = 0; q < 2; ++q) {
          const u32x4 hv = *(const u32x4*)(p.h1b() + (size_t)t * D_ + (c * 64 + lane) * 16 + q * 8);
#pragma unroll
          for (int w = 0; w < 4; ++w) { hreg[c * 16 + q * 8 + 2 * w] = bflo(hv[w]); hreg[c * 16 + q * 8 + 2 * w + 1] = bfhi(hv[w]); }
        }
#pragma unroll
      for (int i = 0; i < 32; ++i) o[i] = 0.f;
      const float* Us = p.Us(); const float* Vs = p.Vs();
      const unsigned char* Uq = p.Uq() + lane * 16; const unsigned char* Vq = p.Vq() + lane * 16;
      const int* ep = eidx + tok * 128; const float* gp = gts + tok * 128;
      u32x4 urA[2][2], vrA[2][2], urB[2][2], vrB[2][2];
      float gA[2], suA[2], svA[2], gB[2], suB[2], svB[2];
#define PEER_LOAD(UR, VR, G, SU, SV, J0)                                                              \
      _Pragma("unroll") for (int jj = 0; jj < 2; ++jj) {                                                \
        const int e = __builtin_amdgcn_readfirstlane(ep[(J0) + jj]);                                    \
        G[jj] = gp[(J0) + jj]; SU[jj] = Us[e]; SV[jj] = Vs[e];                                          \
        const unsigned char* up = Uq + (size_t)e * 4096; const unsigned char* vp = up + 2048;           \
        UR[jj][0] = *(const u32x4*)(up); UR[jj][1] = *(const u32x4*)(up + 1024);                        \
        VR[jj][0] = *(const u32x4*)(vp); VR[jj][1] = *(const u32x4*)(vp + 1024);                        \
      }
#define PEER_COMPUTE(UR, VR, G, SU, SV)                                                                 \
      _Pragma("unroll") for (int jj = 0; jj < 2; ++jj) {                                                \
        float d0 = 0.f, d1 = 0.f;                                                                       \
        _Pragma("unroll") for (int c = 0; c < 2; ++c)                                                   \
          _Pragma("unroll") for (int w = 0; w < 4; ++w) {                                               \
            const f32x2 lo = __builtin_amdgcn_cvt_pk_f32_fp8(UR[jj][c][w], false), hi2 = __builtin_amdgcn_cvt_pk_f32_fp8(UR[jj][c][w], true); \
            d0 += lo[0] * hreg[c * 16 + 4 * w]; d1 += lo[1] * hreg[c * 16 + 4 * w + 1];                \
            d0 += hi2[0] * hreg[c * 16 + 4 * w + 2]; d1 += hi2[1] * hreg[c * 16 + 4 * w + 3];          \
          }                                                                                             \
        const float av = wave_sum(d0 + d1) * SU[jj];                                                    \
        const float act = gelu_exact(av) * G[jj] * SV[jj];                                              \
        _Pragma("unroll") for (int c = 0; c < 2; ++c)                                                   \
          _Pragma("unroll") for (int w = 0; w < 4; ++w) {                                               \
            const f32x2 lo = __builtin_amdgcn_cvt_pk_f32_fp8(VR[jj][c][w], false), hi2 = __builtin_amdgcn_cvt_pk_f32_fp8(VR[jj][c][w], true); \
            o[c * 16 + 4 * w] += act * lo[0]; o[c * 16 + 4 * w + 1] += act * lo[1];                    \
            o[c * 16 + 4 * w + 2] += act * hi2[0]; o[c * 16 + 4 * w + 3] += act * hi2[1];              \
          }                                                                                             \
      }
      PEER_LOAD(urA, vrA, gA, suA, svA, 0)
#pragma unroll 1
      for (int j0 = 0; j0 < 128; j0 += 4) {
        PEER_LOAD(urB, vrB, gB, suB, svB, j0 + 2)
        PEER_COMPUTE(urA, vrA, gA, suA, svA)
        if (j0 + 4 < 128) { PEER_LOAD(urA, vrA, gA, suA, svA, j0 + 4) }
        PEER_COMPUTE(urB, vrB, gB, suB, svB)
      }
#undef PEER_LOAD
#undef PEER_COMPUTE
      float* orow = p.out + (size_t)t * D_;
      float sum = 0.f;
#pragma unroll
      for (int c = 0; c < 2; ++c)
#pragma unroll
        for (int q = 0; q < 4; ++q) {
          const float4 r0 = *(const float4*)(orow + (c * 64 + lane) * 16 + q * 4);
          o[c * 16 + q * 4 + 0] += r0.x; o[c * 16 + q * 4 + 1] += r0.y; o[c * 16 + q * 4 + 2] += r0.z; o[c * 16 + q * 4 + 3] += r0.w;
        }
#pragma unroll
      for (int i = 0; i < 32; ++i) sum += o[i];
      const float mu = wave_sum(sum) * (1.f / D_);
      float sq = 0.f;
#pragma unroll
      for (int i = 0; i < 32; ++i) { o[i] -= mu; sq += o[i] * o[i]; }
      const float rstd = rsqrtf(wave_sum(sq) * (1.f / D_) + EPS);
#pragma unroll
      for (int c = 0; c < 2; ++c)
#pragma unroll
        for (int q = 0; q < 4; ++q) {
          const int col = (c * 64 + lane) * 16 + q * 4;
          const float4 g0 = *(const float4*)(p.ln2_g + col), b0 = *(const float4*)(p.ln2_b + col);
          float4 w0;
          w0.x = o[c * 16 + q * 4 + 0] * rstd * g0.x + b0.x; w0.y = o[c * 16 + q * 4 + 1] * rstd * g0.y + b0.y;
          w0.z = o[c * 16 + q * 4 + 2] * rstd * g0.z + b0.z; w0.w = o[c * 16 + q * 4 + 3] * rstd * g0.w + b0.w;
          *(float4*)(orow + col) = w0;
        }
    }
    __syncthreads();
  }
}

template <int PH>
__device__ __forceinline__ void run_phase(const Params& p, char* smem, int bid, int nb) {
  if constexpr (PH == 0) phase_prep(p, smem, bid, nb);
  if constexpr (PH == 1) phase_inproj(p, smem, bid, nb);
  if constexpr (PH == 2) phase_up(p, smem, bid, nb);
#ifdef ATTN_NAIVE
  if constexpr (PH == 3) phase_attn_naive(p, smem, bid, nb);
#else
  if constexpr (PH == 3) phase_attn(p, smem, bid, nb);
#endif
  if constexpr (PH == 4) phase_outproj(p, smem, bid, nb);
  if constexpr (PH == 5) phase_ln1(p, bid, nb);
  if constexpr (PH == 6) phase_mid(p, smem, bid, nb);
  if constexpr (PH == 7) phase_peer(p, smem, bid, nb);
}

template <int PH>
__global__ void __launch_bounds__(NT, 2) phase_kernel(Params p) {
  __shared__ __attribute__((aligned(16))) char smem[SMEM_BYTES];
  run_phase<PH>(p, smem, blockIdx.x, gridDim.x);
}

#define BW_CENSUS(j) (256 + (j) * 32)
#define BW_XSUB(j) (256 + 512 + (j) * 32)
#define BW_XGEN(j) (256 + 1024 + (j) * 32)
#define BW_TOP (256 + 1536)
#define BW_TOPGEN (256 + 1568)
__device__ __forceinline__ unsigned bw_ld(unsigned* p) { return __hip_atomic_load(p, __ATOMIC_RELAXED, __HIP_MEMORY_SCOPE_AGENT); }
__device__ __forceinline__ unsigned bw_add(unsigned* p, unsigned v) { return __hip_atomic_fetch_add(p, v, __ATOMIC_RELAXED, __HIP_MEMORY_SCOPE_AGENT); }
__device__ __forceinline__ unsigned xcc_id() { return (unsigned)__builtin_amdgcn_s_getreg((3 << 11) | 20) & 0xFu; }

__device__ __forceinline__ void grid_barrier(unsigned* bar, unsigned* st  ) {
  asm volatile("s_waitcnt vmcnt(0)" ::: "memory");
  __syncthreads();
  if (threadIdx.x == 0) {
    __builtin_amdgcn_s_waitcnt(0);
    const unsigned x = xcc_id();
    unsigned nloc = st[0], nx = st[1];
    if (nloc == 0u) {
      const unsigned G = gridDim.x;
      for (;;) {
        unsigned sum = 0u, cnt = 0u, mine = 0u;
#pragma unroll
        for (unsigned j = 0; j < 16; ++j) { const unsigned c = bw_ld(&bar[BW_CENSUS(j)]); sum += c; cnt += (c > 0u) ? 1u : 0u; mine = (j == x) ? c : mine; }
        nloc = mine; nx = cnt;
        if (sum == G) break;
        __builtin_amdgcn_s_sleep(1);
      }
      st[0] = nloc; st[1] = nx;
    }
    const unsigned old = bw_add(&bar[BW_XSUB(x)], 1u);
    const unsigned gen = old / nloc;
    if (old + 1u == (gen + 1u) * nloc) {
      __builtin_amdgcn_fence(__ATOMIC_RELEASE, "agent");
      asm volatile("s_waitcnt vmcnt(0)" ::: "memory");
      const unsigned og = bw_add(&bar[BW_TOP], 1u);
      const unsigned tg = og / nx;
      if (og + 1u == (tg + 1u) * nx) bw_add(&bar[BW_TOPGEN], 1u);
      else while (bw_ld(&bar[BW_TOPGEN]) == tg) __builtin_amdgcn_s_sleep(1);
      __builtin_amdgcn_fence(__ATOMIC_ACQUIRE, "agent");
      bw_add(&bar[BW_XGEN(x)], 1u);
      asm volatile("s_waitcnt vmcnt(0)" ::: "memory");
    } else {
      while (bw_ld(&bar[BW_XGEN(x)]) == gen) __builtin_amdgcn_s_sleep(1);
      __builtin_amdgcn_fence(__ATOMIC_ACQUIRE, "agent");
      asm volatile("s_waitcnt vmcnt(0)" ::: "memory");
    }
  }
  __syncthreads();
}

#if SINGLE_LAUNCH
typedef const __attribute__((address_space(4))) unsigned long long* kargp_t;
static_assert(sizeof(Params) % 8 == 0, "Params must be a pack of 8-byte fields");
#define RUN_PHASE(N) run_phase<N>(p_, smem, bid, nb);
__global__ void __launch_bounds__(NT, 2) fwd_kernel(Params p_) {
  __shared__ __attribute__((aligned(16))) char smem[SMEM_BYTES + 64];
  const int bid = blockIdx.x, nb = gridDim.x;
  unsigned* bar = (unsigned*)(p_.ws + O_CTR);
  unsigned* st = (unsigned*)(smem + SMEM_BYTES);
  if (threadIdx.x == 0) { st[0] = 0u; st[1] = 0u; (void)bw_add(&bar[BW_CENSUS(xcc_id())], 1u); }
  if (p_.out == nullptr) cg::this_grid().sync();
  RUN_PHASE(0) grid_barrier(bar, st);
  RUN_PHASE(1) grid_barrier(bar, st);
  RUN_PHASE(2) grid_barrier(bar, st);
  RUN_PHASE(3) grid_barrier(bar, st);
  RUN_PHASE(4) grid_barrier(bar, st);
  RUN_PHASE(5) grid_barrier(bar, st);
  RUN_PHASE(6) grid_barrier(bar, st);
  RUN_PHASE(7)
}
#endif

extern "C" void kernel_launch(void* const* d_in, const int* in_sizes, int n_in, void* d_out, int out_size,
                              void* d_ws, size_t ws_size, hipStream_t stream) {
  (void)in_sizes; (void)n_in; (void)out_size; (void)ws_size;
  Params p{};
  p.x = (const float*)d_in[0]; p.p = (const float*)d_in[1]; p.positions = (const int*)d_in[2];
  p.w_in = (const float*)d_in[3]; p.b_forget = (const float*)d_in[4]; p.g_q = (const float*)d_in[5];
  p.w_uq = (const float*)d_in[6]; p.g_kv = (const float*)d_in[7]; p.w_ukv = (const float*)d_in[8];
  p.w_out = (const float*)d_in[9]; p.ln1_g = (const float*)d_in[10]; p.ln1_b = (const float*)d_in[11];
  p.peer_wq = (const float*)d_in[12]; p.keys1 = (const float*)d_in[13]; p.keys2 = (const float*)d_in[14];
  p.peer_u = (const float*)d_in[15]; p.peer_v = (const float*)d_in[16]; p.wgate = (const float*)d_in[17];
  p.wproj = (const float*)d_in[18]; p.ln2_g = (const float*)d_in[19]; p.ln2_b = (const float*)d_in[20];
  p.out = (float*)d_out;
  p.ws = (char*)d_ws;

  static int grid_blocks = 0;
  if (!grid_blocks) {
    int dev = 0, cus = 0, per_cu = 0;
    (void)hipGetDevice(&dev);
    (void)hipDeviceGetAttribute(&cus, hipDeviceAttributeMultiprocessorCount, dev);
#if SINGLE_LAUNCH
    (void)hipOccupancyMaxActiveBlocksPerMultiprocessor(&per_cu, fwd_kernel, NT, 0);
#else
    per_cu = 2;
#endif
    if (per_cu > 1) per_cu = 1;
    if (per_cu < 1) per_cu = 1;
    grid_blocks = cus * per_cu;
  }
#if SINGLE_LAUNCH
  (void)hipMemsetAsync(d_ws, 0, 16384, stream);
  void* args[] = {&p};
  hipError_t e = hipLaunchCooperativeKernel((void*)fwd_kernel, dim3(grid_blocks), dim3(NT), args, 0, stream);
  if (e != hipSuccess) fprintf(stderr, "cooperative launch failed: %s (grid %d)\n", hipGetErrorString(e), grid_blocks);
#else
  phase_kernel<0><<<grid_blocks, NT, 0, stream>>>(p);
  phase_kernel<1><<<grid_blocks, NT, 0, stream>>>(p);
  phase_kernel<2><<<grid_blocks, NT, 0, stream>>>(p);
  phase_kernel<3><<<grid_blocks, NT, 0, stream>>>(p);
  phase_kernel<4><<<grid_blocks, NT, 0, stream>>>(p);
  phase_kernel<5><<<grid_blocks, NT, 0, stream>>>(p);
  phase_kernel<6><<<grid_blocks, NT, 0, stream>>>(p);
  phase_kernel<7><<<grid_blocks, NT, 0, stream>>>(p);
#endif
}
```

```cpp
#include <hip/hip_runtime.h>
#include <hip/hip_bf16.h>
#include <hip/hip_cooperative_groups.h>
#include <stdint.h>
#include <cstdio>
namespace cg = cooperative_groups;

typedef unsigned short u16;
typedef short bf16x8 __attribute__((ext_vector_type(8)));
typedef float f32x4 __attribute__((ext_vector_type(4)));
typedef unsigned u32x4 __attribute__((ext_vector_type(4)));
typedef unsigned u32x2 __attribute__((ext_vector_type(2)));

#ifndef SINGLE_LAUNCH
#define SINGLE_LAUNCH 1
#endif

constexpr int T_ = 8192, D_ = 2048, S_ = 4096, NB_ = 2;
constexpr int INW = 4168;
constexpr int NPH = 8;
constexpr float ALPHA = 1.189207115002721f;
constexpr float EPS = 1e-6f;
constexpr int NT = 512;
constexpr int SMEM_BYTES = 133120;

constexpr size_t al256(size_t x) { return (x + 255) & ~(size_t)255; }
constexpr size_t O_CTR = 0;
constexpr size_t O_WINT = O_CTR + 16384;
constexpr size_t O_WUQT = O_WINT + al256((size_t)4352 * 2048 * 2);
constexpr size_t O_WUKVT = O_WUQT + al256((size_t)1536 * 512 * 2);
constexpr size_t O_WOUTT = O_WUKVT + al256((size_t)2048 * 512 * 2);
constexpr size_t O_WPQT = O_WOUTT + al256((size_t)2048 * 2048 * 2);
constexpr size_t O_WGT = O_WPQT + al256((size_t)1024 * 2048 * 2);
constexpr size_t O_WPT = O_WGT + al256((size_t)2048 * 2048 * 2);
constexpr size_t O_PB = O_WPT + al256((size_t)2048 * 256 * 2);
constexpr size_t O_UB = O_PB + al256((size_t)8192 * 256 * 2);
constexpr size_t O_VB = O_UB + 2048;
constexpr size_t O_OMIX = O_UB + al256((size_t)16384 * 4096);
constexpr size_t O_CS = O_OMIX + al256((size_t)8192 * 2048 * 2);
constexpr size_t O_PROJB = O_CS + al256((size_t)8192 * 32 * 8);
constexpr size_t O_KEYH = O_PROJB + al256((size_t)8192 * 2048 * 2);
constexpr size_t O_KEYL = O_KEYH + al256((size_t)2 * 8 * 128 * 64 * 2);
constexpr size_t O_US = O_KEYL + al256((size_t)2 * 8 * 128 * 64 * 2);
constexpr size_t O_VS = O_US + al256((size_t)16384 * 4);
constexpr size_t O_REGB = O_VS + al256((size_t)16384 * 4);
constexpr size_t O_XB = O_REGB;
constexpr size_t O_CQB = O_XB + al256((size_t)8192 * 2048 * 2);
constexpr size_t O_CKVB = O_CQB + al256((size_t)8192 * 512 * 2);
constexpr size_t O_QM = O_CKVB + al256((size_t)8192 * 512 * 2);
constexpr size_t O_KM = O_QM + al256((size_t)8192 * 8 * 192 * 2);
constexpr size_t O_VMT = O_KM + al256((size_t)8192 * 8 * 192 * 2);
constexpr size_t O_QF = O_VMT + al256((size_t)8192 * 8 * 128 * 2);
constexpr size_t O_KF = O_QF + al256((size_t)8192 * 8 * 128 * 2);
constexpr size_t O_VFT = O_KF + al256((size_t)8192 * 8 * 128 * 2);
constexpr size_t O_LOGF = O_VFT + al256((size_t)8192 * 8 * 128 * 2);
constexpr size_t O_FK = O_LOGF + al256((size_t)16 * 4096 * 4);
constexpr size_t O_KRS = O_FK + al256((size_t)16 * 4096 * 4);
constexpr size_t O_RSS = O_KRS + al256((size_t)8192 * 64 * 4);
constexpr size_t O_ENDB = O_RSS + al256((size_t)2 * 8192 * 4);
constexpr size_t O_Y1 = O_REGB;
constexpr size_t O_H1B = O_Y1 + al256((size_t)8192 * 2048 * 4);
constexpr size_t O_PQ = O_H1B + al256((size_t)8192 * 2048 * 2);
constexpr size_t O_GATE = O_PQ + al256((size_t)8192 * 128 * 4);
constexpr size_t O_ENDB2 = O_GATE + al256((size_t)8192 * 128 * 4);
static_assert(O_ENDB2 <= O_ENDB, "region B reuse overflow");
static_assert(O_ENDB <= (size_t)500 * 1024 * 1024, "workspace too large");

struct Params {
  const float *x, *p; const int* positions;
  const float *w_in, *b_forget, *g_q, *w_uq, *g_kv, *w_ukv, *w_out, *ln1_g, *ln1_b;
  const float *peer_wq, *keys1, *keys2, *peer_u, *peer_v, *wgate, *wproj, *ln2_g, *ln2_b;
  float* out;
  char* ws;
#define WSP(type, name, off) __device__ __forceinline__ type* name() const { return (type*)(ws + (off)); }
  WSP(unsigned, ctr, O_CTR) WSP(u16, WinT, O_WINT) WSP(u16, WuqT, O_WUQT) WSP(u16, WukvT, O_WUKVT) WSP(u16, WoutT, O_WOUTT)
  WSP(u16, WpqT, O_WPQT) WSP(u16, WgT, O_WGT) WSP(u16, WpT, O_WPT) WSP(u16, pb, O_PB) WSP(unsigned char, Uq, O_UB) WSP(unsigned char, Vq, O_VB) WSP(float, Us, O_US) WSP(float, Vs, O_VS)
  WSP(u16, omix, O_OMIX) WSP(float2, cs, O_CS) WSP(u16, projb, O_PROJB) WSP(u16, keyH, O_KEYH) WSP(u16, keyL, O_KEYL)
  WSP(u16, xb, O_XB) WSP(u16, cqb, O_CQB) WSP(u16, ckvb, O_CKVB) WSP(u16, Qm, O_QM) WSP(u16, Km, O_KM) WSP(u16, VmT, O_VMT)
  WSP(u16, Qf, O_QF) WSP(u16, Kf, O_KF) WSP(u16, VfT, O_VFT) WSP(float, logf, O_LOGF) WSP(float, Fk, O_FK) WSP(float, krsum, O_KRS) WSP(float, rss, O_RSS)
  WSP(float, y1, O_Y1) WSP(u16, h1b, O_H1B) WSP(int, eidxG, O_PQ) WSP(float, gateG, O_GATE)
#undef WSP
};

__device__ __forceinline__ int TID() { int t = threadIdx.x; asm volatile("" : "+v"(t)); return t; }
__device__ __forceinline__ unsigned pk2(float lo, float hi) {
  unsigned r; asm volatile("v_cvt_pk_bf16_f32 %0, %1, %2" : "=v"(r) : "v"(lo), "v"(hi)); return r;
}
__device__ __forceinline__ u16 f2bf(float f) { return (u16)(pk2(f, 0.f) & 0xffffu); }
__device__ __forceinline__ float bf2f(u16 v) { return __uint_as_float(((unsigned)v) << 16); }
__device__ __forceinline__ float bflo(unsigned v) { return __uint_as_float(v << 16); }
__device__ __forceinline__ float bfhi(unsigned v) { return __uint_as_float(v & 0xffff0000u); }

template <int CTRL> __device__ __forceinline__ int dppi(int v) { return __builtin_amdgcn_update_dpp(0, v, CTRL, 0xF, 0xF, false); }
template <int CTRL> __device__ __forceinline__ float dppf(float v) { return __int_as_float(dppi<CTRL>(__float_as_int(v))); }
__device__ __forceinline__ float rdlane(float v, int l) { return __int_as_float(__builtin_amdgcn_readlane(__float_as_int(v), l)); }

__device__ __forceinline__ float row_sum(float v) {
  v += dppf<0xB1>(v); v += dppf<0x4E>(v); v += dppf<0x141>(v); v += dppf<0x140>(v); return v;
}
__device__ __forceinline__ float row_max(float v) {
  v = fmaxf(v, dppf<0xB1>(v)); v = fmaxf(v, dppf<0x4E>(v)); v = fmaxf(v, dppf<0x141>(v)); v = fmaxf(v, dppf<0x140>(v)); return v;
}
__device__ __forceinline__ float wave_sum(float v) {
  v = row_sum(v);
  return (rdlane(v, 0) + rdlane(v, 16)) + (rdlane(v, 32) + rdlane(v, 48));
}
__device__ __forceinline__ float wave_max(float v) {
  v = row_max(v);
  return fmaxf(fmaxf(rdlane(v, 0), rdlane(v, 16)), fmaxf(rdlane(v, 32), rdlane(v, 48)));
}
__device__ __forceinline__ unsigned wave_umax(unsigned v) {
  unsigned t;
  t = (unsigned)dppi<0xB1>((int)v); v = v > t ? v : t;
  t = (unsigned)dppi<0x4E>((int)v); v = v > t ? v : t;
  t = (unsigned)dppi<0x141>((int)v); v = v > t ? v : t;
  t = (unsigned)dppi<0x140>((int)v); v = v > t ? v : t;
  unsigned a = (unsigned)__builtin_amdgcn_readlane((int)v, 0), b = (unsigned)__builtin_amdgcn_readlane((int)v, 16);
  unsigned c = (unsigned)__builtin_amdgcn_readlane((int)v, 32), d = (unsigned)__builtin_amdgcn_readlane((int)v, 48);
  a = a > b ? a : b; c = c > d ? c : d; return a > c ? a : c;
}
__device__ __forceinline__ unsigned ordkey(float f) {
  unsigned u = __float_as_uint(f);
  return (u & 0x80000000u) ? ~u : (u | 0x80000000u);
}

__device__ __forceinline__ unsigned fp6_code(float v) {
  const float a = fabsf(v);
  int code = a < 2.f ? (int)rintf(a * 8.f) : (a < 4.f ? 16 + (int)rintf((a - 2.f) * 4.f) : 24 + (int)rintf((a - 4.f) * 2.f));
  code = code > 31 ? 31 : code;
  return (unsigned)code | (v < 0.f ? 32u : 0u);
}
__device__ __forceinline__ void quant_chunk(const Params& p, int chunk) {
  const int tid = TID(), lane = tid & 63, wid = tid >> 6;
#pragma unroll 1
  for (int i8 = 0; i8 < 8; ++i8) {
    const int r = chunk * 64 + wid * 8 + i8;
    const int tab = r >> 14, row = r & 16383;
    const float* src = (tab ? p.peer_v : p.peer_u) + (size_t)row * D_ + lane * 32;
    float4 v[8];
    float am = 0.f;
#pragma unroll
    for (int i = 0; i < 8; ++i) {
      v[i] = *(const float4*)(src + i * 4);
      am = fmaxf(am, fmaxf(fmaxf(fabsf(v[i].x), fabsf(v[i].y)), fmaxf(fabsf(v[i].z), fabsf(v[i].w))));
    }
    am = wave_max(am);
    const float qs = am > 0.f ? 7.5f / am : 1.f;
    unsigned w[6];
#pragma unroll
    for (int g = 0; g < 2; ++g) {
      unsigned long long lo = 0ull; unsigned hi = 0u;
#pragma unroll
      for (int i = 0; i < 4; ++i) {
        const float4 f = v[g * 4 + i];
        const unsigned q4 = fp6_code(f.x * qs) | (fp6_code(f.y * qs) << 6) | (fp6_code(f.z * qs) << 12) | (fp6_code(f.w * qs) << 18);
        if (i == 0) lo |= (unsigned long long)q4;
        if (i == 1) lo |= (unsigned long long)q4 << 24;
        if (i == 2) { lo |= (unsigned long long)q4 << 48; hi |= q4 >> 16; }
        if (i == 3) hi |= q4 << 8;
      }
      w[g * 3 + 0] = (unsigned)lo; w[g * 3 + 1] = (unsigned)(lo >> 32); w[g * 3 + 2] = hi;
    }
    unsigned* dst = (unsigned*)(p.Uq() + (size_t)row * 3072 + tab * 1536 + lane * 24);
    *(u32x2*)dst = u32x2{w[0], w[1]}; *(u32x2*)(dst + 2) = u32x2{w[2], w[3]}; *(u32x2*)(dst + 4) = u32x2{w[4], w[5]};
    if (lane == 0) (tab ? p.Vs() : p.Us())[row] = am > 0.f ? am / 7.5f : 1.f;
  }
}

__device__ void transpose_cvt(const float* __restrict__ W, int ldw, int K, int src_col0, int ncols,
                              u16* __restrict__ WT, int dst_row0, const float* __restrict__ kscale,
                              float* tile, int bid, int nb) {
  const int tiles_k = K / 64, tiles_n = ncols / 64, tid = TID();
#pragma unroll 1
  for (int t = bid; t < tiles_k * tiles_n; t += nb) {
    const int tk = t % tiles_k, tn = t / tiles_k, k0 = tk * 64, n0 = tn * 64;
#pragma unroll
    for (int i = 0; i < 2; ++i) {
      const int r = (tid >> 4) + 32 * i, c = (tid & 15) * 4;
      const float4 v = *(const float4*)(W + (size_t)(k0 + r) * ldw + src_col0 + n0 + c);
      const float sc = kscale ? kscale[k0 + r] : 1.f;
      tile[r * 65 + c + 0] = v.x * sc; tile[r * 65 + c + 1] = v.y * sc;
      tile[r * 65 + c + 2] = v.z * sc; tile[r * 65 + c + 3] = v.w * sc;
    }
    __syncthreads();
    {
      const int n = tid >> 3, kk = (tid & 7) * 8;
      unsigned w[4];
#pragma unroll
      for (int e = 0; e < 4; ++e) w[e] = pk2(tile[(kk + 2 * e) * 65 + n], tile[(kk + 2 * e + 1) * 65 + n]);
      *(u32x4*)(WT + (size_t)(dst_row0 + n0 + n) * K + k0 + kk) = u32x4{w[0], w[1], w[2], w[3]};
    }
    __syncthreads();
  }
}

__device__ void cvt_bf16(const float* __restrict__ src, u16* __restrict__ dst, size_t n8, size_t gtid, size_t gthreads) {
  for (size_t i = gtid; i < n8; i += gthreads) {
    const float4 a = ((const float4*)src)[2 * i], b = ((const float4*)src)[2 * i + 1];
    ((u32x4*)dst)[i] = u32x4{pk2(a.x, a.y), pk2(a.z, a.w), pk2(b.x, b.y), pk2(b.z, b.w)};
  }
}

__device__ void phase_prep(const Params& p, char* smem, int bid, int nb) {
  const int tid = TID(), lane = tid & 63, wid = tid >> 6;
  float* tile = (float*)smem;
  if (bid == 0 && tid == 0) p.ctr()[0] = 0;
  transpose_cvt(p.w_in, INW, D_, 0, 1024, p.WinT(), 0, nullptr, tile, bid, nb);
  transpose_cvt(p.w_in, INW, D_, 1088, 3072, p.WinT(), 1024, nullptr, tile, bid, nb);
  transpose_cvt(p.w_in, INW, D_, 1024, 64, p.WinT(), 4096, nullptr, tile, bid, nb);
  transpose_cvt(p.w_uq, 1536, 512, 0, 1536, p.WuqT(), 0, p.g_q, tile, bid, nb);
  transpose_cvt(p.w_ukv, 2048, 512, 0, 2048, p.WukvT(), 0, p.g_kv, tile, bid, nb);
  transpose_cvt(p.w_out, 2048, 2048, 0, 2048, p.WoutT(), 0, nullptr, tile, bid, nb);
  transpose_cvt(p.peer_wq, 1024, 2048, 0, 1024, p.WpqT(), 0, nullptr, tile, bid, nb);
  transpose_cvt(p.wgate, 2048, 2048, 0, 2048, p.WgT(), 0, nullptr, tile, bid, nb);
  transpose_cvt(p.wproj, 2048, 256, 0, 2048, p.WpT(), 0, nullptr, tile, bid, nb);
  const size_t gtid = (size_t)bid * NT + tid, gth = (size_t)nb * NT;
  for (size_t i = gtid; i < (size_t)192 * 2048 / 8; i += gth) ((u32x4*)(p.WinT() + (size_t)4160 * 2048))[i] = u32x4{0, 0, 0, 0};
  cvt_bf16(p.p, p.pb(), (size_t)T_ * 256 / 8, gtid, gth);
  for (size_t i = gtid; i < (size_t)T_ * 64 / 4; i += gth) ((float4*)p.krsum())[i] = make_float4(0.f, 0.f, 0.f, 0.f);
  for (size_t i = gtid; i < (size_t)2 * T_ / 4; i += gth) ((float4*)p.rss())[i] = make_float4(0.f, 0.f, 0.f, 0.f);
  for (size_t i = gtid; i < (size_t)2 * 65536; i += gth) {
    const float v = i < 65536 ? p.keys1[i] : p.keys2[i - 65536];
    const u16 h = f2bf(v);
    p.keyH()[i] = h; p.keyL()[i] = f2bf(v - bf2f(h));
  }
  for (size_t i = gtid; i < (size_t)T_ * 32; i += gth) {
    const int t = (int)(i >> 5), fi = (int)(i & 31);
    const float invf = 1.0f / powf(10000.0f, (float)(2 * fi) / 64.0f);
    const float ang = (float)p.positions[t] * invf;
    const double rev = (double)ang * 0.15915494309189535;
    const float fr = (float)(rev - rint(rev));
    p.cs()[i] = make_float2(__builtin_amdgcn_cosf(fr), __builtin_amdgcn_sinf(fr));
  }
  __syncthreads();
  float* wff = (float*)smem;
  for (int i = tid; i < 2048 * 2; i += NT) {
    const int k = i >> 1, hf = i & 1;
    *(float4*)(wff + k * 8 + hf * 4) = *(const float4*)(p.w_in + (size_t)k * INW + 4160 + hf * 4);
  }
  __syncthreads();
  for (int t = bid * 8 + wid; t < T_; t += nb * 8) {
    float a[8];
#pragma unroll
    for (int e = 0; e < 8; ++e) a[e] = 0.f;
#pragma unroll 1
    for (int i = 0; i < 4; ++i) {
      const int k = (i * 64 + lane) * 8;
      const float4 x0 = *(const float4*)(p.x + (size_t)t * D_ + k), x1 = *(const float4*)(p.x + (size_t)t * D_ + k + 4);
      *(u32x4*)(p.xb() + (size_t)t * D_ + k) = u32x4{pk2(x0.x, x0.y), pk2(x0.z, x0.w), pk2(x1.x, x1.y), pk2(x1.z, x1.w)};
      const float xs[8] = {x0.x, x0.y, x0.z, x0.w, x1.x, x1.y, x1.z, x1.w};
#pragma unroll
      for (int j = 0; j < 8; ++j) {
        const float4 w0 = *(const float4*)(wff + (k + j) * 8), w1 = *(const float4*)(wff + (k + j) * 8 + 4);
        a[0] += xs[j] * w0.x; a[1] += xs[j] * w0.y; a[2] += xs[j] * w0.z; a[3] += xs[j] * w0.w;
        a[4] += xs[j] * w1.x; a[5] += xs[j] * w1.y; a[6] += xs[j] * w1.z; a[7] += xs[j] * w1.w;
      }
    }
    float mine = 0.f;
#pragma unroll
    for (int e = 0; e < 8; ++e) { const float s = wave_sum(a[e]); if (lane == e) mine = s; }
    if (lane < 8) {
      const float z = mine + p.b_forget[lane];
      const float ls = fminf(z, 0.f) - log1pf(expf(-fabsf(z)));
      const int b = t >> 12, s = t & 4095;
      p.logf()[((size_t)(b * 8 + lane)) * S_ + s] = ls;
    }
  }
}

template <int WM, int WN>
__device__ __forceinline__ void gemm_core(const u16* __restrict__ A, int lda, const u16* __restrict__ Bt, int ldb,
                                          int K, int brow, int bcol, char* smem, f32x4 (&acc)[4 / WM][4][4]) {
  constexpr int MS = 4 / WM, BN = 64 * WN, NBL = BN / 64;
  static_assert(WM * WN == 8, "8 waves");
  const int tid = TID(), wid = tid >> 6, lane = tid & 63, wr = wid / WN, wc = wid % WN, fr = lane & 15, fq = lane >> 4;
#pragma unroll
  for (int h = 0; h < MS; ++h)
#pragma unroll
    for (int m = 0; m < 4; ++m)
#pragma unroll
      for (int n = 0; n < 4; ++n) acc[h][m][n] = f32x4{0.f, 0.f, 0.f, 0.f};
  const int nk = K / 64;
  const int srow = tid >> 3, sch = (tid & 7) ^ ((tid >> 4) & 7);
  const u16* ga = A + (size_t)(brow + srow) * lda + sch * 8;
  const u16* gb = Bt + (size_t)(bcol + srow) * ldb + sch * 8;
  char* sdst = smem + tid * 16;
  auto issue = [&](int kt, int st) {
    char* sa = sdst + st * 65536;
#pragma unroll
    for (int i = 0; i < 4; ++i)
      __builtin_amdgcn_global_load_lds((const unsigned*)(ga + (size_t)i * 64 * lda + kt * 64), (unsigned*)(sa + i * 8192), 16, 0, 0);
#pragma unroll
    for (int i = 0; i < NBL; ++i)
      __builtin_amdgcn_global_load_lds((const unsigned*)(gb + (size_t)i * 64 * ldb + kt * 64), (unsigned*)(sa + 32768 + i * 8192), 16, 0, 0);
  };
  const int fx = (fr >> 1) & 7;
  const int arow = (wr * (256 / WM) + fr) * 128, brw = 32768 + (wc * 64 + fr) * 128;
  const int c0 = (fq ^ fx) * 16, c1 = ((4 + fq) ^ fx) * 16;
  asm volatile("s_waitcnt vmcnt(0)" ::: "memory");
  __syncthreads();
  issue(0, 0);
#pragma unroll 1
  for (int kt = 0; kt < nk; ++kt) {
    asm volatile("s_waitcnt vmcnt(0)" ::: "memory");
    __builtin_amdgcn_s_barrier();
    asm volatile("" ::: "memory");
    if (kt + 1 < nk) issue(kt + 1, (kt + 1) & 1);
    const char* sb = smem + (kt & 1) * 65536;
#pragma unroll
    for (int ks = 0; ks < 2; ++ks) {
      const int co = ks ? c1 : c0;
      bf16x8 Bl[4];
#pragma unroll
      for (int n = 0; n < 4; ++n) Bl[n] = *reinterpret_cast<const bf16x8*>(sb + brw + co + n * 2048);
#pragma unroll
      for (int h = 0; h < MS; ++h) {
        bf16x8 At[4];
#pragma unroll
        for (int m = 0; m < 4; ++m) At[m] = *reinterpret_cast<const bf16x8*>(sb + arow + co + (h * 4 + m) * 2048);
#pragma unroll
        for (int m = 0; m < 4; ++m)
#pragma unroll
          for (int n = 0; n < 4; ++n) acc[h][m][n] = __builtin_amdgcn_mfma_f32_16x16x32_bf16(At[m], Bl[n], acc[h][m][n], 0, 0, 0);
      }
    }
  }
}

template <int WM, int WN, class Epi>
__device__ __forceinline__ void gemm_tile(const u16* __restrict__ A, int lda, const u16* __restrict__ Bt, int ldb,
                                          int K, int brow, int bcol, char* smem, Epi epi) {
  constexpr int MS = 4 / WM;
  const int tid = TID(), wid = tid >> 6, lane = tid & 63, wr = wid / WN, wc = wid % WN, fr = lane & 15, fq = lane >> 4;
  f32x4 acc[MS][4][4];
  gemm_core<WM, WN>(A, lda, Bt, ldb, K, brow, bcol, smem, acc);
#pragma unroll
  for (int h = 0; h < MS; ++h) epi(acc[h], brow + wr * (256 / WM) + h * 64, bcol + wc * 64, fr, fq);
}

namespace pg8 {
#define PG8_LAS __attribute__((address_space(3)))
typedef unsigned short bf16_t;
constexpr int BM = 256, BK = 64, HALF = 128, HTB = HALF * BK * 2  , STAGE_BYTES = 8 * HTB, NXCD = 8, WGM = 8;

__host__ __device__ __forceinline__ int lds_byte(int r, int c) { const int st = (r >> 4) * 2 + (c >> 5), rr = r & 15, cc = c & 31, ob = rr * 64 + cc * 2; return st * 1024 + (ob ^ (((ob >> 9) & 1) << 5)); }
__host__ __device__ __forceinline__ void stage_rc(int b, int& R, int& C) { const int st = b / 1024, sb = b % 1024, swz = sb ^ (((sb >> 9) & 1) << 5); R = (st >> 1) * 16 + swz / 64; C = (st & 1) * 32 + (swz % 64) / 2; }
__host__ __device__ __forceinline__ int perm32(int rho) { const int n = rho >> 4, i = rho & 15; return 8 * (i >> 2) + 4 * n + (i & 3); }
struct Unit { int pm, pn; };
struct Gemm { const bf16_t* A; const bf16_t* Bt; int M, N, K; };
struct StaticOrder {
    int nM, nN, nwg, G, c;
    __device__ void init(int M, int N, int G_, int c_) { nM = M / BM; nN = N / BM; nwg = nM * nN; G = G_; c = c_; }
    __device__ bool next(int i, Unit& u) const {
        const long L = (long)i * G + c; if (L >= nwg) return false;
        int wgid = (int)L; { const int q = nwg / NXCD, r = nwg % NXCD, xcd = wgid % NXCD, off = wgid / NXCD; wgid = (xcd < r ? xcd * (q + 1) : r * (q + 1) + (xcd - r) * q) + off; }
        const int nig = WGM * nN, gid = wgid / nig, fm = gid * WGM, gsz = (nM - fm) < WGM ? (nM - fm) : WGM;
        u.pm = fm + ((wgid % nig) % gsz); u.pn = (wgid % nig) / gsz; return true;
    }
    __device__ __forceinline__ void a_ready(const Unit&) const {}
    __device__ __forceinline__ void done(const Unit&) const {}
};
template <class Epi, class Sched, bool STAMP = false>
__device__ __forceinline__ void gemm_phase(PG8_LAS unsigned char* lds, const Gemm g, const Sched& S, const Epi& E, unsigned long long* stamps) {
    const int tid = TID(), wid = __builtin_amdgcn_readfirstlane(tid >> 6), lane = tid & 63, wr = wid >> 2, wc = wid & 3, fr = lane & 15, fq = lane >> 4;
    const int K = g.K, nt = K / BK;
    int ts_lo = 0, ts_hi = 0, nts = 0; const unsigned long long rt_entry = STAMP ? (unsigned long long)wall_clock64() : 0ull;
#define PG8_STAMP() do { if (STAMP && wid == 0 && nts < 64) { const unsigned long long _c = (unsigned long long)clock64(); \
        ts_lo = (lane == nts) ? (int)(unsigned)_c : ts_lo; ts_hi = (lane == nts) ? (int)(unsigned)(_c >> 32) : ts_hi; ++nts; } } while (0)
    PG8_STAMP();
    unsigned voffA[2], voffB[2];
#pragma unroll
    for (int i = 0; i < 2; ++i) { int R, C; stage_rc(tid * 16 + i * 8192, R, C); const int Rb = Epi::PERM ? ((R & ~31) + perm32(R & 31)) : R;
        voffA[i] = (unsigned)(R * K + C) * 2u; voffB[i] = (unsigned)(Rb * K + C) * 2u; }
    const size_t kstep = (size_t)(BK * 2);
    const size_t hstep = (size_t)HALF * K * 2;
    const size_t tstep = 2 * hstep;
    const unsigned ldsw = (unsigned)wid * 1024u;
    const int aoff = lds_byte(wr * 64 + fr, fq * 8), boff = lds_byte(wc * 32 + fr, fq * 8);
#define PG8_SA(b, h) (((b) * 2 + (h)) * HTB)
#define PG8_SB(b, h) ((4 + (b) * 2 + (h)) * HTB)
#define PG8_STAGE(bufoff, gbase, voff) do { _Pragma("unroll") for (int _i = 0; _i < 2; ++_i) \
        __builtin_amdgcn_global_load_lds((const unsigned*)((const char*)(gbase) + (voff)[_i]), (PG8_LAS unsigned*)(lds + (bufoff) + ldsw + _i * 8192), 16, 0, 0); } while (0)
#define PG8_LDA(dst, b, h) do { _Pragma("unroll") for (int m = 0; m < 4; ++m) _Pragma("unroll") for (int k = 0; k < 2; ++k) dst[m][k] = *(const PG8_LAS bf16x8*)(lds + PG8_SA(b, h) + aoff + m * 2048 + k * 1024); } while (0)
#define PG8_LDB(dst, b, h) do { _Pragma("unroll") for (int n = 0; n < 2; ++n) _Pragma("unroll") for (int k = 0; k < 2; ++k) dst[n][k] = *(const PG8_LAS bf16x8*)(lds + PG8_SB(b, h) + boff + n * 2048 + k * 1024); } while (0)
#define PG8_MMA(ai, bj, At, Bt) do { __builtin_amdgcn_s_setprio(1); _Pragma("unroll") for (int m = 0; m < 4; ++m) _Pragma("unroll") for (int n = 0; n < 2; ++n) _Pragma("unroll") for (int k = 0; k < 2; ++k) \
        acc[ai][bj][m][n] = __builtin_amdgcn_mfma_f32_16x16x32_bf16(Bt[n][k], At[m][k], acc[ai][bj][m][n], 0, 0, 0); __builtin_amdgcn_s_setprio(0); } while (0)
#define PG8_WAIT_V(n) asm volatile("s_waitcnt vmcnt(" #n ")" ::: "memory")
#define PG8_WAIT_L(n) asm volatile("s_waitcnt lgkmcnt(" #n ")" ::: "memory")
#define PG8_BAR __builtin_amdgcn_s_barrier()
#define PG8_SCHED __builtin_amdgcn_sched_barrier(0)
    Unit cur, nxt; int ui = 0;
    if (!S.next(0, cur)) return;
    f32x4 acc[2][2][4][2];
#pragma unroll
    for (int a = 0; a < 2; ++a)
#pragma unroll
        for (int b = 0; b < 2; ++b)
#pragma unroll
            for (int m = 0; m < 4; ++m)
#pragma unroll
                for (int n = 0; n < 2; ++n) acc[a][b][m][n] = (f32x4){0.f, 0.f, 0.f, 0.f};
    bf16x8 At[4][2], B0[2][2], B1[2][2];
    const char* cA = (const char*)g.A + (size_t)cur.pm * tstep; const char* cB = (const char*)g.Bt + (size_t)cur.pn * tstep;
    S.a_ready(cur);
    PG8_STAGE(PG8_SB(0, 0), cB, voffB); PG8_STAGE(PG8_SA(0, 0), cA, voffA); PG8_STAGE(PG8_SB(0, 1), cB + hstep, voffB); PG8_STAGE(PG8_SA(0, 1), cA + hstep, voffA);
    if (wr == 1) PG8_BAR;
    PG8_WAIT_V(4); PG8_BAR;
    PG8_STAGE(PG8_SB(1, 0), cB + kstep, voffB); PG8_STAGE(PG8_SA(1, 0), cA + kstep, voffA); PG8_STAGE(PG8_SB(1, 1), cB + hstep + kstep, voffB);
    PG8_WAIT_V(6); PG8_BAR;
    PG8_STAMP();
    for (;;) {
        const bool has_next = S.next(ui + 1, nxt);
        const char* nA = has_next ? (const char*)g.A + (size_t)nxt.pm * tstep : cA; const char* nB = has_next ? (const char*)g.Bt + (size_t)nxt.pn * tstep : cB;
        for (int t = 0; t < nt; t += 2) {
            const bool last = (t == nt - 2);
            const char* a1 = cA + (size_t)(t + 1) * kstep;
            const char* a2 = last ? nA : cA + (size_t)(t + 2) * kstep; const char* b2 = last ? nB : cB + (size_t)(t + 2) * kstep;
            const char* a3 = a2 + kstep; const char* b3 = b2 + kstep;
            if (last && has_next) S.a_ready(nxt);
            PG8_LDB(B0, 0, 0); PG8_SCHED; PG8_LDA(At, 0, 0); PG8_STAGE(PG8_SA(1, 1), a1 + hstep, voffA);
            PG8_WAIT_L(8); PG8_BAR; PG8_WAIT_L(0); PG8_MMA(0, 0, At, B0); PG8_BAR; PG8_SCHED;
            PG8_LDB(B1, 0, 1); PG8_STAGE(PG8_SB(0, 0), b2, voffB);
            PG8_BAR; PG8_WAIT_L(0); PG8_MMA(0, 1, At, B1); PG8_BAR;
            PG8_LDA(At, 0, 1); PG8_STAGE(PG8_SA(0, 0), a2, voffA);
            PG8_BAR; PG8_WAIT_L(0); PG8_MMA(1, 0, At, B0); PG8_BAR; PG8_SCHED;
            PG8_STAGE(PG8_SB(0, 1), b2 + hstep, voffB);
            PG8_WAIT_V(6); PG8_BAR; PG8_MMA(1, 1, At, B1); PG8_BAR;
            PG8_LDB(B0, 1, 0); PG8_SCHED; PG8_LDA(At, 1, 0); PG8_STAGE(PG8_SA(0, 1), a2 + hstep, voffA);
            PG8_WAIT_L(8); PG8_BAR; PG8_WAIT_L(0); PG8_MMA(0, 0, At, B0); PG8_BAR; PG8_SCHED;
            PG8_LDB(B1, 1, 1); PG8_STAGE(PG8_SB(1, 0), b3, voffB);
            PG8_BAR; PG8_WAIT_L(0); PG8_MMA(0, 1, At, B1); PG8_BAR;
            PG8_LDA(At, 1, 1); PG8_STAGE(PG8_SA(1, 0), a3, voffA);
            PG8_BAR; PG8_WAIT_L(0); PG8_MMA(1, 0, At, B0); PG8_BAR; PG8_SCHED;
            PG8_STAGE(PG8_SB(1, 1), b3 + hstep, voffB);
            PG8_WAIT_V(6); PG8_BAR; PG8_MMA(1, 1, At, B1); PG8_BAR;
        }
        PG8_STAMP();
        if constexpr (!Epi::AFTER_DRAIN) { E(acc, cur, wr, wc, fr, fq); S.done(cur); }
        PG8_STAMP();
        if (!has_next) break;
#pragma unroll
        for (int a = 0; a < 2; ++a)
#pragma unroll
            for (int b = 0; b < 2; ++b)
#pragma unroll
                for (int m = 0; m < 4; ++m)
#pragma unroll
                    for (int n = 0; n < 2; ++n) acc[a][b][m][n] = (f32x4){0.f, 0.f, 0.f, 0.f};
        cur = nxt; cA = nA; cB = nB; ++ui;
    }
    PG8_WAIT_V(0);
    if (wr == 0) PG8_BAR;
    PG8_BAR;
    if constexpr (Epi::AFTER_DRAIN) { E.fused(acc, cur, wr, wc, fr, fq, lds, wid, lane); S.done(cur); }
    PG8_STAMP();
    if (STAMP && wid == 0) { stamps[lane] = lane < nts ? (((unsigned long long)(unsigned)ts_hi << 32) | (unsigned)ts_lo) : 0ull;
        if (lane == 62) stamps[62] = rt_entry; if (lane == 63) stamps[63] = (unsigned long long)wall_clock64(); }
#undef PG8_STAMP
#undef PG8_SA
#undef PG8_SB
#undef PG8_STAGE
#undef PG8_LDA
#undef PG8_LDB
#undef PG8_MMA
#undef PG8_WAIT_V
#undef PG8_WAIT_L
#undef PG8_BAR
#undef PG8_SCHED
}
}


__device__ __forceinline__ u32x4 pack8(const f32x4& a, const f32x4& b) { return u32x4{pk2(a[0], a[1]), pk2(a[2], a[3]), pk2(b[0], b[1]), pk2(b[2], b[3])}; }
__device__ __forceinline__ float sumsq4(const f32x4& a) { return (a[0] * a[0] + a[1] * a[1]) + (a[2] * a[2] + a[3] * a[3]); }
__device__ __forceinline__ void store_tr8(u16* vt, const f32x4& a, const f32x4& b) {
  vt[0] = f2bf(a[0]); vt[(size_t)S_] = f2bf(a[1]); vt[(size_t)2 * S_] = f2bf(a[2]); vt[(size_t)3 * S_] = f2bf(a[3]);
  vt[(size_t)4 * S_] = f2bf(b[0]); vt[(size_t)5 * S_] = f2bf(b[1]); vt[(size_t)6 * S_] = f2bf(b[2]); vt[(size_t)7 * S_] = f2bf(b[3]);
}
struct EpiInproj {
  static constexpr bool PERM = true, AFTER_DRAIN = false;
  u16 *cqb, *ckvb, *Qf, *Kf, *VfT; float* rss;
  __device__ __forceinline__ void operator()(const f32x4 (&acc)[2][2][4][2], const pg8::Unit& u, int wr, int wc, int fr, int fq) const {
    const int ct = u.pn * 256;
#pragma unroll
    for (int ai = 0; ai < 2; ++ai)
#pragma unroll
      for (int m = 0; m < 4; ++m) {
        const int row = u.pm * 256 + ai * 128 + wr * 64 + m * 16 + fr, b = row >> 12, s = row & 4095;
        float ss = 0.f;
#pragma unroll
        for (int bj = 0; bj < 2; ++bj) {
          const int c0 = ct + bj * 128 + wc * 32 + 8 * fq;
          const f32x4 v0 = acc[ai][bj][m][0], v1 = acc[ai][bj][m][1];
          if (ct < 1024) {
            u16* dst = ct < 512 ? cqb : ckvb;
            *(u32x4*)(dst + (size_t)row * 512 + (c0 & 511)) = pack8(v0, v1);
            ss += sumsq4(v0) + sumsq4(v1);
          } else if (ct < 3072) {
            int c = c0 - 1024; u16* dst = c < 1024 ? Qf : Kf; c &= 1023;
            *(u32x4*)(dst + ((size_t)(b * 8 + (c >> 7)) * S_ + s) * 128 + (c & 127)) = pack8(v0, v1);
          } else {
            const int c = c0 - 3072;
            store_tr8(VfT + ((size_t)(b * 8 + (c >> 7)) * 128 + (c & 127)) * S_ + s, v0, v1);
          }
        }
        if (ct < 1024) atomicAdd(rss + (ct < 512 ? 0 : T_) + row, ss);
        __builtin_amdgcn_sched_barrier(0);
      }
  }
};
struct EpiQup {
  static constexpr bool PERM = true, AFTER_DRAIN = false;
  u16* Qm; const float* rss;
  __device__ __forceinline__ void operator()(const f32x4 (&acc)[2][2][4][2], const pg8::Unit& u, int wr, int wc, int fr, int fq) const {
#pragma unroll
    for (int ai = 0; ai < 2; ++ai)
#pragma unroll
      for (int m = 0; m < 4; ++m) {
        const int row = u.pm * 256 + ai * 128 + wr * 64 + m * 16 + fr, b = row >> 12, s = row & 4095;
        const float rs = rsqrtf(rss[row] * (1.f / 512.f) + EPS);
#pragma unroll
        for (int bj = 0; bj < 2; ++bj) {
          const int c0 = u.pn * 256 + bj * 128 + wc * 32 + 8 * fq, hh = c0 / 192, off = c0 % 192;
          *(u32x4*)(Qm + ((size_t)(b * 8 + hh) * S_ + s) * 192 + off) = pack8(acc[ai][bj][m][0] * rs, acc[ai][bj][m][1] * rs);
        }
        __builtin_amdgcn_sched_barrier(0);
      }
  }
};
struct EpiKVup {
  static constexpr bool PERM = true, AFTER_DRAIN = false;
  u16 *Km, *VmT; const float* rss;
  __device__ __forceinline__ void operator()(const f32x4 (&acc)[2][2][4][2], const pg8::Unit& u, int wr, int wc, int fr, int fq) const {
    const int hh = u.pn;
#pragma unroll
    for (int ai = 0; ai < 2; ++ai)
#pragma unroll
      for (int m = 0; m < 4; ++m) {
        const int row = u.pm * 256 + ai * 128 + wr * 64 + m * 16 + fr, b = row >> 12, s = row & 4095;
        const float rs = rsqrtf(rss[T_ + row] * (1.f / 512.f) + EPS);
        const int off = wc * 32 + 8 * fq;
        *(u32x4*)(Km + ((size_t)(b * 8 + hh) * S_ + s) * 192 + off) = pack8(acc[ai][0][m][0] * rs, acc[ai][0][m][1] * rs);
        store_tr8(VmT + ((size_t)(b * 8 + hh) * 128 + off) * S_ + s, acc[ai][1][m][0] * rs, acc[ai][1][m][1] * rs);
        __builtin_amdgcn_sched_barrier(0);
      }
  }
};
struct EpiProj {
  static constexpr bool PERM = true, AFTER_DRAIN = false;
  u16* projb;
  __device__ __forceinline__ void operator()(const f32x4 (&acc)[2][2][4][2], const pg8::Unit& u, int wr, int wc, int fr, int fq) const {
#pragma unroll
    for (int ai = 0; ai < 2; ++ai)
#pragma unroll
      for (int m = 0; m < 4; ++m) {
        const int row = u.pm * 256 + ai * 128 + wr * 64 + m * 16 + fr;
#pragma unroll
        for (int bj = 0; bj < 2; ++bj)
          *(u32x4*)(projb + (size_t)row * D_ + u.pn * 256 + bj * 128 + wc * 32 + 8 * fq) = pack8(acc[ai][bj][m][0], acc[ai][bj][m][1]);
      }
  }
};
struct EpiOut {
  static constexpr bool PERM = false, AFTER_DRAIN = false;
  const float* x; float* y1;
  __device__ __forceinline__ void operator()(const f32x4 (&acc)[2][2][4][2], const pg8::Unit& u, int wr, int wc, int fr, int fq) const {
#pragma unroll
    for (int ai = 0; ai < 2; ++ai)
#pragma unroll
      for (int m = 0; m < 4; ++m) {
        const size_t rb = (size_t)(u.pm * 256 + ai * 128 + wr * 64 + m * 16 + fr) * D_ + u.pn * 256 + wc * 32 + 4 * fq;
#pragma unroll
        for (int bj = 0; bj < 2; ++bj)
#pragma unroll
          for (int n = 0; n < 2; ++n) {
            const size_t o = rb + bj * 128 + n * 16;
            const f32x4 xv = *(const f32x4*)(x + o);
            *(f32x4*)(y1 + o) = xv * ALPHA + acc[ai][bj][m][n];
          }
      }
  }
};
struct EpiGate {
  static constexpr bool PERM = false, AFTER_DRAIN = false;
  const float* h1; const u16* projb; float* out;
  __device__ __forceinline__ void operator()(const f32x4 (&acc)[2][2][4][2], const pg8::Unit& u, int wr, int wc, int fr, int fq) const {
#pragma unroll
    for (int ai = 0; ai < 2; ++ai)
#pragma unroll
      for (int m = 0; m < 4; ++m) {
        const size_t rb = (size_t)(u.pm * 256 + ai * 128 + wr * 64 + m * 16 + fr) * D_ + u.pn * 256 + wc * 32 + 4 * fq;
#pragma unroll
        for (int bj = 0; bj < 2; ++bj)
#pragma unroll
          for (int n = 0; n < 2; ++n) {
            const size_t o = rb + bj * 128 + n * 16;
            const f32x4 hv = *(const f32x4*)(h1 + o);
            const u32x2 pj = *(const u32x2*)(projb + o);
            const f32x4 a = acc[ai][bj][m][n];
            f32x4 r;
            r[0] = ALPHA * hv[0] + bflo(pj[0]) / (1.f + __expf(-a[0])); r[1] = ALPHA * hv[1] + bfhi(pj[0]) / (1.f + __expf(-a[1]));
            r[2] = ALPHA * hv[2] + bflo(pj[1]) / (1.f + __expf(-a[2])); r[3] = ALPHA * hv[3] + bfhi(pj[1]) / (1.f + __expf(-a[3]));
            *(f32x4*)(out + o) = r;
          }
      }
  }
};

__device__ __forceinline__ int vblock(int bid, int nb) { return (nb & 7) ? bid : (bid & 7) * (nb >> 3) + (bid >> 3); }
__device__ __forceinline__ void tile_rc(int t, int Nt, int& tm, int& tn) {
  const int g = t / (8 * Nt), q = t % (8 * Nt);
  tn = q >> 3; tm = g * 8 + (q & 7);
}

__device__ void phase_inproj(const Params& p, char* smem, int bid, int nb) {
  {
    EpiInproj E{p.cqb(), p.ckvb(), p.Qf(), p.Kf(), p.VfT(), p.rss()};
    pg8::Gemm g{p.xb(), p.WinT(), T_, 4096, D_};
    pg8::StaticOrder S; S.init(T_, 4096, nb, bid);
    pg8::gemm_phase((PG8_LAS unsigned char*)smem, g, S, E, nullptr);
  }
  for (int t = vblock(bid, nb); t < 256; t += nb) {
    const int tm = t >> 3, ks = t & 7;
    f32x4 acc[2][4][4];
    gemm_core<2, 4>(p.xb() + ks * 256, D_, p.WinT() + ks * 256, D_, 256, tm * 256, 4096, smem, acc);
    const int tid = TID(), wid = tid >> 6, lane = tid & 63, wr = wid >> 2, wc = wid & 3, fr = lane & 15, fq = lane >> 4;
    if (wc == 0) {
#pragma unroll
      for (int h = 0; h < 2; ++h) {
        float* kd = p.krsum() + (size_t)(tm * 256 + wr * 128 + h * 64 + fq * 4) * 64 + fr;
#pragma unroll
        for (int m = 0; m < 4; ++m)
#pragma unroll
          for (int n = 0; n < 4; ++n)
#pragma unroll
            for (int j = 0; j < 4; ++j) atomicAdd(kd + (m * 16 + j) * 64 + n * 16, acc[h][m][n][j]);
      }
    }
  }
}

__device__ void phase_up(const Params& p, char* smem, int bid, int nb) {
  PG8_LAS unsigned char* lds = (PG8_LAS unsigned char*)smem;
  {
    EpiQup E{p.Qm(), p.rss()};
    pg8::Gemm g{p.cqb(), p.WuqT(), T_, 1536, 512};
    pg8::StaticOrder S; S.init(T_, 1536, nb, (bid + nb - 64) % nb);
    pg8::gemm_phase(lds, g, S, E, nullptr);
  }
  {
    EpiKVup E{p.Km(), p.VmT(), p.rss()};
    pg8::Gemm g{p.ckvb(), p.WukvT(), T_, 2048, 512};
    pg8::StaticOrder S; S.init(T_, 2048, nb, bid);
    pg8::gemm_phase(lds, g, S, E, nullptr);
  }
  {
    EpiProj E{p.projb()};
    pg8::Gemm g{p.pb(), p.WpT(), T_, 2048, 256};
    pg8::StaticOrder S; S.init(T_, 2048, nb, bid);
    pg8::gemm_phase(lds, g, S, E, nullptr);
  }
  for (int t = bid; t < 48; t += nb) {
    if (t >= 16) {
      const int r0 = (t - 16) * 256, tid = TID();
#pragma unroll 1
      for (int it = 0; it < 16; ++it) {
        const int pr = it * NT + tid, row = r0 + (pr >> 5), i = pr & 31, b = row >> 12, s = row & 4095;
        const float x1 = p.krsum()[(size_t)row * 64 + i], x2 = p.krsum()[(size_t)row * 64 + 32 + i];
        const float2 cs = p.cs()[(size_t)row * 32 + i];
        const u16 o1 = f2bf(x1 * cs.x - x2 * cs.y), o2 = f2bf(x1 * cs.y + x2 * cs.x);
#pragma unroll
        for (int hh = 0; hh < 8; ++hh) {
          u16* kd = p.Km() + ((size_t)(b * 8 + hh) * S_ + s) * 192 + 128;
          kd[i] = o1; kd[32 + i] = o2;
        }
      }
    } else {
      const int seq = t;
      if ((TID() >> 6) == 0) {
        const int lane = TID() & 63;
        const float* src = p.logf() + (size_t)seq * S_ + lane * 64;
        float* dst = p.Fk() + (size_t)seq * S_ + lane * 64;
        float sum = 0.f;
        for (int i = 0; i < 16; ++i) { const float4 v = *(const float4*)(src + i * 4); sum += v.x; sum += v.y; sum += v.z; sum += v.w; }
        float inc = sum;
#pragma unroll
        for (int d = 1; d < 64; d <<= 1) { const float o = __shfl_up(inc, d, 64); if (lane >= d) inc += o; }
        float run = inc - sum;
        for (int i = 0; i < 16; ++i) {
          const float4 v = *(const float4*)(src + i * 4); float4 o;
          run += v.x; o.x = run; run += v.y; o.y = run; run += v.z; o.z = run; run += v.w; o.w = run;
          *(float4*)(dst + i * 4) = o;
        }
      }
    }
  }
}

#ifdef ATTN_NAIVE
__device__ void phase_attn_naive(const Params& p, char* smem, int bid, int nb) {
  const int tid = TID(), lane = tid & 63, wid = tid >> 6;
  const int per = NB_ * 8 * S_, nrows = 2 * per;
  for (int r = bid * 4 + wid; r < nrows; r += nb * 4) {
    const int type = r / per, rr = r % per, bh = rr / S_, s = rr % S_;
    const int DQ = type ? 128 : 192;
    const u16* Q = type ? p.Qf() + ((size_t)bh * S_ + s) * 128 : p.Qm() + ((size_t)bh * S_ + s) * 192;
    const u16* Kb = type ? p.Kf() + (size_t)bh * S_ * 128 : p.Km() + (size_t)bh * S_ * 192;
    const u16* VT = (type ? p.VfT() : p.VmT()) + (size_t)bh * 128 * S_;
    const float* F = p.Fk() + (size_t)bh * S_;
    const float scale = type ? 0.08838834764831845f : 0.07216878364870322f;
    float m = -1e30f, l = 0.f;
    float acc[128];
#pragma unroll
    for (int d = 0; d < 128; ++d) acc[d] = 0.f;
    const float fqv = type ? F[s] : 0.f;
    for (int k0 = 0; k0 <= s; k0 += 64) {
      const int key = k0 + lane; const bool valid = key <= s; const int keyc = valid ? key : s;
      const u16* kr = Kb + (size_t)keyc * DQ;
      float sc = 0.f;
      for (int d = 0; d < DQ; d += 8) {
        const u32x4 kv = *(const u32x4*)(kr + d), qv = *(const u32x4*)(Q + d);
#pragma unroll
        for (int w = 0; w < 4; ++w) sc += bflo(kv[w]) * bflo(qv[w]) + bfhi(kv[w]) * bfhi(qv[w]);
      }
      sc *= scale;
      if (type) sc += fqv - F[keyc];
      if (!valid) sc = -1e30f;
      const float mx = wave_max(sc), mn = fmaxf(m, mx), alpha = __expf(m - mn);
      const float pr = valid ? __expf(sc - mn) : 0.f;
      m = mn; l = l * alpha + pr;
#pragma unroll
      for (int d = 0; d < 128; ++d) acc[d] = acc[d] * alpha + pr * bf2f(VT[(size_t)d * S_ + keyc]);
    }
    const float inv = 1.f / wave_sum(l);
    float o0 = 0.f, o1 = 0.f;
#pragma unroll
    for (int d = 0; d < 128; ++d) {
      const float o = wave_sum(acc[d]) * inv;
      if (lane == (d & 63)) { if (d < 64) o0 = o; else o1 = o; }
    }
    const int b = bh >> 3, hh = bh & 7;
    u16* od = p.omix() + ((size_t)(b * S_ + s)) * 2048 + type * 1024 + hh * 128;
    od[lane] = f2bf(o0); od[64 + lane] = f2bf(o1);
  }
}

#endif
typedef float f32x16 __attribute__((ext_vector_type(16)));
template <int TYPE>
__device__ __forceinline__ void attn_item(const Params& p, char* smem, int bh, int qb) {
  constexpr int DQK = TYPE ? 128 : 192, NKS = DQK / 16, KSTR = DQK * 2 + 16, VSTR = 128;
  constexpr int KCH = DQK / 8, NKL = 64 * KCH / NT;
  constexpr float C2 = (TYPE ? 0.08838834764831845f : 0.07216878364870322f) * 1.4426950408889634f;
  char* sK = smem; char* sV = smem + 25600; float* sF = (float*)(smem + 25600 + 32768);
  const int tid = TID(), lane = tid & 63, wid = tid >> 6, c = lane & 31, hi = lane >> 5;
  const u16* Qb = (TYPE ? p.Qf() : p.Qm()) + (size_t)bh * S_ * DQK;
  const u16* Kb = (TYPE ? p.Kf() : p.Km()) + (size_t)bh * S_ * DQK;
  const u16* Vb = (TYPE ? p.VfT() : p.VmT()) + (size_t)bh * 128 * S_;
  const float* Fb = p.Fk() + (size_t)bh * S_;
  const int qrow = qb * 256 + wid * 32;
  bf16x8 qf[NKS];
#pragma unroll
  for (int ks = 0; ks < NKS; ++ks) qf[ks] = *(const bf16x8*)(Qb + (size_t)(qrow + c) * DQK + ks * 16 + hi * 8);
  if (TYPE == 0) {
    const float2* csr = p.cs() + (size_t)((bh >> 3) * S_ + qrow + c) * 32;
#pragma unroll
    for (int kk = 0; kk < 2; ++kk) {
      u32x4 x1 = *reinterpret_cast<u32x4*>(&qf[(NKS - 4) + kk]), x2 = *reinterpret_cast<u32x4*>(&qf[(NKS - 2) + kk]);
#pragma unroll
      for (int w = 0; w < 4; ++w) {
        const float4 cs = *(const float4*)(csr + 16 * kk + 8 * hi + 2 * w);
        const float a0 = bflo(x1[w]), a1 = bfhi(x1[w]), b0 = bflo(x2[w]), b1 = bfhi(x2[w]);
        x1[w] = pk2(a0 * cs.x - b0 * cs.y, a1 * cs.z - b1 * cs.w);
        x2[w] = pk2(a0 * cs.y + b0 * cs.x, a1 * cs.w + b1 * cs.z);
      }
      qf[(NKS - 4) + kk] = *reinterpret_cast<bf16x8*>(&x1); qf[(NKS - 2) + kk] = *reinterpret_cast<bf16x8*>(&x2);
    }
  }
  f32x16 o[4];
#pragma unroll
  for (int db = 0; db < 4; ++db)
#pragma unroll
    for (int r = 0; r < 16; ++r) o[db][r] = 0.f;
  float m = -1e30f, l = 0.f;
  const int ntiles = 4 * qb + 4;
  u32x4 kreg[NKL];
  float4 freg = make_float4(0.f, 0.f, 0.f, 0.f);
  const unsigned koff = (unsigned)tid * 16u;
  auto load_k = [&](int kt) {
    const char* kb = (const char*)(Kb + (size_t)kt * 64 * DQK);
#pragma unroll
    for (int i = 0; i < NKL; ++i) kreg[i] = *(const u32x4*)(kb + i * 8192 + koff);
    if (TYPE) { if (tid < 16) freg = *(const float4*)(Fb + kt * 64 + tid * 4); }
  };
  const unsigned voff = (unsigned)((((tid >> 3) * S_) + (((tid & 7) ^ ((tid >> 4) & 7)) * 8)) * 2);
  auto load_v = [&](int kt) {
    const char* vb = (const char*)(Vb + kt * 64);
    char* dst = sV + (kt & 1) * 16384 + tid * 16;
#pragma unroll
    for (int i = 0; i < 2; ++i)
      __builtin_amdgcn_global_load_lds((const unsigned*)(vb + (size_t)i * 64 * S_ * 2 + voff), (unsigned*)(dst + i * 8192), 16, 0, 0);
  };
  auto store_tile = [&]() {
#pragma unroll
    for (int i = 0; i < NKL; ++i) { const int ch = tid + NT * i, key = ch / KCH, dc = ch % KCH; *(u32x4*)(sK + key * KSTR + dc * 16) = kreg[i]; }
    if (TYPE) { if (tid < 16) { const float L2E = 1.4426950408889634f; *(float4*)(sF + tid * 4) = make_float4(freg.x * L2E, freg.y * L2E, freg.z * L2E, freg.w * L2E); } }
  };
  const int krow = (c & 19) | ((c & 4) << 1) | ((c & 8) >> 1);
  const char* ka0 = sK + krow * KSTR + hi * 16;
  const char* ka1 = ka0 + 32 * KSTR;
  const int vx = (c >> 1) & 7;
  int vo[2][2];
#pragma unroll
  for (int kb = 0; kb < 2; ++kb)
#pragma unroll
    for (int s2 = 0; s2 < 2; ++s2) vo[kb][s2] = c * VSTR + (((4 * kb + 2 * s2 + hi) ^ vx) * 16);
  load_k(0); load_v(0);
#pragma unroll 1
  for (int kt = 0; kt < ntiles; ++kt) {
    asm volatile("s_waitcnt vmcnt(0)" ::: "memory");
    __syncthreads();
    store_tile();
    __syncthreads();
    if (kt + 1 < ntiles) { load_k(kt + 1); load_v(kt + 1); }
    const int k0 = kt * 64;
    const char* sVc = sV + (kt & 1) * 16384;
    if (k0 <= qrow + 31) {
      f32x16 p0, p1;
#pragma unroll
      for (int r = 0; r < 16; ++r) { p0[r] = 0.f; p1[r] = 0.f; }
#pragma unroll
      for (int ks = 0; ks < NKS; ++ks) {
        const bf16x8 a0 = *(const bf16x8*)(ka0 + ks * 32), a1 = *(const bf16x8*)(ka1 + ks * 32);
        p0 = __builtin_amdgcn_mfma_f32_32x32x16_bf16(a0, qf[ks], p0, 0, 0, 0);
        p1 = __builtin_amdgcn_mfma_f32_32x32x16_bf16(a1, qf[ks], p1, 0, 0, 0);
      }
      if (TYPE) {
#pragma unroll
        for (int s = 0; s < 2; ++s) {
          const float4 f0 = *(const float4*)(sF + 16 * s + 8 * hi), f1 = *(const float4*)(sF + 16 * s + 8 * hi + 4);
          const float4 g0 = *(const float4*)(sF + 32 + 16 * s + 8 * hi), g1 = *(const float4*)(sF + 32 + 16 * s + 8 * hi + 4);
          p0[8 * s + 0] = p0[8 * s + 0] * C2 - f0.x; p0[8 * s + 1] = p0[8 * s + 1] * C2 - f0.y; p0[8 * s + 2] = p0[8 * s + 2] * C2 - f0.z; p0[8 * s + 3] = p0[8 * s + 3] * C2 - f0.w;
          p0[8 * s + 4] = p0[8 * s + 4] * C2 - f1.x; p0[8 * s + 5] = p0[8 * s + 5] * C2 - f1.y; p0[8 * s + 6] = p0[8 * s + 6] * C2 - f1.z; p0[8 * s + 7] = p0[8 * s + 7] * C2 - f1.w;
          p1[8 * s + 0] = p1[8 * s + 0] * C2 - g0.x; p1[8 * s + 1] = p1[8 * s + 1] * C2 - g0.y; p1[8 * s + 2] = p1[8 * s + 2] * C2 - g0.z; p1[8 * s + 3] = p1[8 * s + 3] * C2 - g0.w;
          p1[8 * s + 4] = p1[8 * s + 4] * C2 - g1.x; p1[8 * s + 5] = p1[8 * s + 5] * C2 - g1.y; p1[8 * s + 6] = p1[8 * s + 6] * C2 - g1.z; p1[8 * s + 7] = p1[8 * s + 7] * C2 - g1.w;
        }
      } else {
#pragma unroll
        for (int r = 0; r < 16; ++r) { p0[r] *= C2; p1[r] *= C2; }
      }
      if (k0 + 63 > qrow) {
        const int lim = qrow + c - k0 - 8 * hi;
        const float NEG = -__builtin_inff();
#pragma unroll
        for (int r = 0; r < 16; ++r) {
          const int kb = 16 * (r >> 3) + (r & 7);
          if (kb > lim) p0[r] = NEG;
          if (kb + 32 > lim) p1[r] = NEG;
        }
      }
      float mx = p0[0];
#pragma unroll
      for (int r = 1; r < 16; ++r) mx = fmaxf(mx, p0[r]);
#pragma unroll
      for (int r = 0; r < 16; ++r) mx = fmaxf(mx, p1[r]);
      {
        auto rr = __builtin_amdgcn_permlane32_swap(__float_as_uint(mx), __float_as_uint(mx), false, false);
        mx = fmaxf(__uint_as_float(rr[0]), __uint_as_float(rr[1]));
      }
      const float mn = fmaxf(m, mx);
      const float alpha = __builtin_amdgcn_exp2f(m - mn);
      m = mn;
      if (!__all(alpha == 1.f)) {
#pragma unroll
        for (int db = 0; db < 4; ++db)
#pragma unroll
          for (int r = 0; r < 16; ++r) o[db][r] *= alpha;
      }
      float ps = 0.f;
#pragma unroll
      for (int r = 0; r < 16; ++r) { p0[r] = __builtin_amdgcn_exp2f(p0[r] - mn); p1[r] = __builtin_amdgcn_exp2f(p1[r] - mn); ps += p0[r] + p1[r]; }
      l = l * alpha + ps;
      bf16x8 pa[2][2];
#pragma unroll
      for (int s = 0; s < 2; ++s) {
        u32x4 w0 = {pk2(p0[8 * s + 0], p0[8 * s + 1]), pk2(p0[8 * s + 2], p0[8 * s + 3]), pk2(p0[8 * s + 4], p0[8 * s + 5]), pk2(p0[8 * s + 6], p0[8 * s + 7])};
        u32x4 w1 = {pk2(p1[8 * s + 0], p1[8 * s + 1]), pk2(p1[8 * s + 2], p1[8 * s + 3]), pk2(p1[8 * s + 4], p1[8 * s + 5]), pk2(p1[8 * s + 6], p1[8 * s + 7])};
        pa[0][s] = *reinterpret_cast<bf16x8*>(&w0); pa[1][s] = *reinterpret_cast<bf16x8*>(&w1);
      }
#pragma unroll
      for (int db = 0; db < 4; ++db)
#pragma unroll
        for (int kb = 0; kb < 2; ++kb)
#pragma unroll
          for (int s = 0; s < 2; ++s) {
            const bf16x8 av = *(const bf16x8*)(sVc + db * 32 * VSTR + vo[kb][s]);
            o[db] = __builtin_amdgcn_mfma_f32_32x32x16_bf16(av, pa[kb][s], o[db], 0, 0, 0);
          }
    }
  }
  {
    auto rr = __builtin_amdgcn_permlane32_swap(__float_as_uint(l), __float_as_uint(l), false, false);
    const float inv = 1.f / (__uint_as_float(rr[0]) + __uint_as_float(rr[1]));
    const int b = bh >> 3, hh = bh & 7;
    u16* od = p.omix() + ((size_t)(b * S_ + qrow + c)) * 2048 + TYPE * 1024 + hh * 128 + 4 * hi;
#pragma unroll
    for (int db = 0; db < 4; ++db)
#pragma unroll
      for (int g = 0; g < 4; ++g)
        *(u32x2*)(od + 32 * db + 8 * g) = u32x2{pk2(o[db][4 * g] * inv, o[db][4 * g + 1] * inv), pk2(o[db][4 * g + 2] * inv, o[db][4 * g + 3] * inv)};
  }
}

__device__ void phase_attn(const Params& p, char* smem, int bid, int nb) {
  int* sItem = (int*)(smem + 60000);
  const int x = bid & 7;
  unsigned* q = p.ctr() + 32 + x;
  for (;;) {
    __syncthreads();
    if (TID() == 0) *sItem = (int)atomicAdd(q, 1u);
    __syncthreads();
    const int item = *sItem;
    if (item >= 64) break;
    const int qb = 15 - (item >> 2), r = item & 3, type = r >> 1, bh = x + 8 * (r & 1);
    if (type == 0) attn_item<0>(p, smem, bh, qb); else attn_item<1>(p, smem, bh, qb);
  }
  unsigned* qc = p.ctr() + 48;
  for (;;) {
    __syncthreads();
    if (TID() == 0) *sItem = (int)atomicAdd(qc, 1u);
    __syncthreads();
    const int chunk = *sItem;
    if (chunk >= 512) break;
    quant_chunk(p, chunk);
  }
}

__device__ void phase_outproj(const Params& p, char* smem, int bid, int nb) {
  EpiOut E{p.x, p.y1()};
  pg8::Gemm g{p.omix(), p.WoutT(), T_, D_, D_};
  pg8::StaticOrder S; S.init(T_, D_, nb, bid);
  pg8::gemm_phase((PG8_LAS unsigned char*)smem, g, S, E, nullptr);
}

__device__ void phase_ln1(const Params& p, int bid, int nb) {
  const int lane = TID() & 63, wid = TID() >> 6;
  for (int t = bid * 8 + wid; t < T_; t += nb * 8) {
    float* row = p.y1() + (size_t)t * D_;
    float4 v[8];
    float sum = 0.f;
#pragma unroll
    for (int i = 0; i < 8; ++i) { v[i] = *(const float4*)(row + (i * 64 + lane) * 4); sum += (v[i].x + v[i].y) + (v[i].z + v[i].w); }
    const float mu = wave_sum(sum) * (1.f / D_);
    float sq = 0.f;
#pragma unroll
    for (int i = 0; i < 8; ++i) {
      v[i].x -= mu; v[i].y -= mu; v[i].z -= mu; v[i].w -= mu;
      sq += (v[i].x * v[i].x + v[i].y * v[i].y) + (v[i].z * v[i].z + v[i].w * v[i].w);
    }
    const float rstd = rsqrtf(wave_sum(sq) * (1.f / D_) + EPS);
#pragma unroll
    for (int i = 0; i < 8; ++i) {
      const int c = (i * 64 + lane) * 4;
      const float4 g = *(const float4*)(p.ln1_g + c), bb = *(const float4*)(p.ln1_b + c);
      float4 o; o.x = v[i].x * rstd * g.x + bb.x; o.y = v[i].y * rstd * g.y + bb.y; o.z = v[i].z * rstd * g.z + bb.z; o.w = v[i].w * rstd * g.w + bb.w;
      *(float4*)(row + c) = o;
      *(u32x2*)(p.h1b() + (size_t)t * D_ + c) = u32x2{pk2(o.x, o.y), pk2(o.z, o.w)};
    }
  }
}

__device__ __forceinline__ void ins16(unsigned (&t)[16], unsigned x) {
#pragma unroll
  for (int i = 0; i < 16; ++i) { const unsigned hi = t[i] > x ? t[i] : x; x = t[i] > x ? x : t[i]; t[i] = hi; }
}
__device__ __forceinline__ void ins16p(unsigned (&ck)[16], int (&ce)[16], unsigned x, int xe) {
#pragma unroll
  for (int i = 0; i < 16; ++i) {
    const bool sw = x > ck[i];
    const unsigned nk = sw ? x : ck[i], nx = sw ? ck[i] : x;
    const int ne = sw ? xe : ce[i], nxe = sw ? ce[i] : xe;
    ck[i] = nk; x = nx; ce[i] = ne; xe = nxe;
  }
}
__device__ __forceinline__ float unordkey(unsigned k) { return __uint_as_float((k & 0x80000000u) ? (k & 0x7fffffffu) : ~k); }

__device__ __forceinline__ void score_block(const u16* kH, const u16* kL, const bf16x8 (&qh)[4], const bf16x8 (&ql)[4], int hi, unsigned (&t)[16]) {
#pragma unroll
  for (int i = 0; i < 16; ++i) t[i] = 0u;
#pragma unroll 1
  for (int kb = 0; kb < 4; ++kb) {
    f32x16 sc;
#pragma unroll
    for (int r = 0; r < 16; ++r) sc[r] = 0.f;
#pragma unroll
    for (int ks = 0; ks < 4; ++ks) {
      const bf16x8 ah = *(const bf16x8*)(kH + kb * 32 * 64 + ks * 16), al = *(const bf16x8*)(kL + kb * 32 * 64 + ks * 16);
      sc = __builtin_amdgcn_mfma_f32_32x32x16_bf16(ah, qh[ks], sc, 0, 0, 0);
      sc = __builtin_amdgcn_mfma_f32_32x32x16_bf16(ah, ql[ks], sc, 0, 0, 0);
      sc = __builtin_amdgcn_mfma_f32_32x32x16_bf16(al, qh[ks], sc, 0, 0, 0);
    }
    const unsigned base = (unsigned)(127 - 32 * kb) - 4u * (unsigned)hi;
#pragma unroll
    for (int r = 0; r < 16; ++r) ins16(t, (ordkey(sc[r]) & ~127u) | (base - (unsigned)((r & 3) + 8 * (r >> 2))));
  }
  unsigned other[16];
#pragma unroll
  for (int i = 0; i < 16; ++i) {
    auto rr = __builtin_amdgcn_permlane32_swap(t[i], t[i], false, false);
    other[i] = hi ? rr[0] : rr[1];
  }
#pragma unroll 1
  for (int i = 0; i < 16; ++i) {
    unsigned x = other[0];
#pragma unroll
    for (int k = 1; k < 16; ++k) x = (i == k) ? other[k] : x;
    ins16(t, x);
  }
}

__device__ __forceinline__ void route_tile(const Params& p, char* smem, f32x4 (&acc)[4][4], int tm, int h) {
  const int tid = TID(), wid = tid >> 6, lane = tid & 63, wr = wid >> 1, wc = wid & 1, fr = lane & 15, fq = lane >> 4;
  __syncthreads();
  float* Qw = (float*)smem + wid * (64 * 65);
#pragma unroll
  for (int m = 0; m < 4; ++m)
#pragma unroll
    for (int n = 0; n < 4; ++n)
#pragma unroll
      for (int j = 0; j < 4; ++j) Qw[(m * 16 + fq * 4 + j) * 65 + n * 16 + fr] = acc[m][n][j];
  asm volatile("s_waitcnt lgkmcnt(0)" ::: "memory");
  const int c = lane & 31, hi = lane >> 5;
  bf16x8 qh[2][4], ql[2][4];
#pragma unroll
  for (int tb = 0; tb < 2; ++tb)
#pragma unroll
    for (int ks = 0; ks < 4; ++ks) {
      float v[8]; unsigned wh[4], wl[4];
#pragma unroll
      for (int j = 0; j < 8; ++j) v[j] = Qw[(tb * 32 + c) * 65 + 16 * ks + 8 * hi + j];
#pragma unroll
      for (int w = 0; w < 4; ++w) {
        wh[w] = pk2(v[2 * w], v[2 * w + 1]);
        wl[w] = pk2(v[2 * w] - bflo(wh[w]), v[2 * w + 1] - bfhi(wh[w]));
      }
      u32x4 uh = {wh[0], wh[1], wh[2], wh[3]}, ul = {wl[0], wl[1], wl[2], wl[3]};
      qh[tb][ks] = *reinterpret_cast<bf16x8*>(&uh); ql[tb][ks] = *reinterpret_cast<bf16x8*>(&ul);
    }
  const u16* kH = p.keyH() + ((size_t)(wc * 8 + h) * 128 + c) * 64 + 8 * hi;
  const u16* kL = p.keyL() + ((size_t)(wc * 8 + h) * 128 + c) * 64 + 8 * hi;
  unsigned t0[16], t1[16];
  score_block(kH, kL, qh[0], ql[0], hi, t0);
  score_block(kH, kL, qh[1], ql[1], hi, t1);
  unsigned t[16];
#pragma unroll
  for (int i = 0; i < 16; ++i) t[i] = hi ? t1[i] : t0[i];
  __syncthreads();
  unsigned* L = (unsigned*)smem;
#pragma unroll
  for (int r = 0; r < 16; ++r) L[(wc * 16 + r) * 256 + wr * 64 + lane] = t[r];
  __syncthreads();
  if (wid < 4) {
    const int tok = wid * 64 + lane;
    unsigned ck[16]; int ce[16];
#pragma unroll
    for (int i = 0; i < 16; ++i) { ck[i] = 0u; ce[i] = 0; }
#pragma unroll 1
    for (int a = 0; a < 16; ++a) {
      const unsigned ka = L[a * 256 + tok];
      const int i1a = (127 - (int)(ka & 127u)) * 128; const float v1a = unordkey(ka & ~127u);
      const int nbm1 = (int)((0x1112347FULL >> (4 * a)) & 15ULL);
#pragma unroll 1
      for (int b = 0; b <= nbm1; ++b) {
        const unsigned kb = L[(16 + b) * 256 + tok];
        const int i2b = 127 - (int)(kb & 127u); const float v2b = unordkey(kb & ~127u);
        ins16p(ck, ce, ordkey(v1a + v2b), i1a + i2b);
      }
    }
    float ex[16], sum = 0.f;
    const float mx = unordkey(ck[0]);
#pragma unroll
    for (int r = 0; r < 16; ++r) { ex[r] = __expf(unordkey(ck[r]) - mx); sum += ex[r]; }
    const float inv = 1.f / sum;
    const size_t o = ((size_t)(tm * 256 + tok) * 8 + h) * 16;
    int* ed = p.eidxG() + o; float* gd = p.gateG() + o;
#pragma unroll
    for (int r = 0; r < 16; r += 4) {
      *(int4*)(ed + r) = make_int4(ce[r], ce[r + 1], ce[r + 2], ce[r + 3]);
      *(float4*)(gd + r) = make_float4(ex[r] * inv, ex[r + 1] * inv, ex[r + 2] * inv, ex[r + 3] * inv);
    }
  }
}

__device__ void phase_mid(const Params& p, char* smem, int bid, int nb) {
  {
    EpiGate E{p.y1(), p.projb(), p.out};
    pg8::Gemm g{p.h1b(), p.WgT(), T_, D_, D_};
    pg8::StaticOrder S; S.init(T_, D_, nb, bid);
    pg8::gemm_phase((PG8_LAS unsigned char*)smem, g, S, E, nullptr);
  }
  for (int t = vblock(bid, nb); t < 32 * 8; t += nb) {
    int tm, tn; tile_rc(t, 8, tm, tn);
    f32x4 acc[1][4][4];
    gemm_core<4, 2>(p.h1b(), D_, p.WpqT(), D_, D_, tm * 256, tn * 128, smem, acc);
    route_tile(p, smem, acc[0], tm, tn);
  }
}

__device__ __forceinline__ float gelu_exact(float a) {
  const float x = fabsf(a) * 0.7071067811865476f;
  const float t = __builtin_amdgcn_rcpf(1.f + 0.3275911f * x);
  const float poly = t * (0.254829592f + t * (-0.284496736f + t * (1.421413741f + t * (-1.453152027f + t * 1.061405429f))));
  const float er = 1.f - poly * __expf(-x * x);
  return 0.5f * a * (1.f + (a < 0.f ? -er : er));
}

template <int NPER, int IDXMASK>
__device__ __forceinline__ int top16(unsigned (&k)[NPER], int lane) {
  int mine = 0;
#pragma unroll 1
  for (int r = 0; r < 16; ++r) {
    unsigned loc = k[0];
#pragma unroll
    for (int i = 1; i < NPER; ++i) loc = loc > k[i] ? loc : k[i];
    const unsigned best = wave_umax(loc);
#pragma unroll
    for (int i = 0; i < NPER; ++i) if (k[i] == best) k[i] = 0u;
    if (lane == r) mine = IDXMASK - (int)(best & (unsigned)IDXMASK);
  }
  return mine;
}

__device__ void phase_peer(const Params& p, char* smem, int bid, int nb) {
  const int tid = TID(), lane = tid & 63, wid = tid >> 6;
  float* qs = (float*)smem;
  float* sc = (float*)(smem + 8192);
  int* eidx = (int*)(smem + 24576);
  float* gts = (float*)(smem + 40960);
  for (int it = bid; it < T_ / 32; it += nb) {
    const int t0 = it * 32;
#pragma unroll
    for (int i = 0; i < 2; ++i) {
      const int idx = (i * NT + tid) * 4;
      *(int4*)(eidx + idx) = *(const int4*)(p.eidxG() + (size_t)t0 * 128 + idx);
      *(float4*)(gts + idx) = *(const float4*)(p.gateG() + (size_t)t0 * 128 + idx);
    }
    __syncthreads();
    for (int ti = 0; ti < 4; ++ti) {
      const int tok = wid * 4 + ti, t = t0 + tok;
      typedef float f32x32 __attribute__((ext_vector_type(32)));
      typedef unsigned u32x6 __attribute__((ext_vector_type(6)));
      float hreg[32];
      f32x32 o;
#pragma unroll
      for (int q = 0; q < 4; ++q) {
        const u32x4 hv = *(const u32x4*)(p.h1b() + (size_t)t * D_ + lane * 32 + q * 8);
#pragma unroll
        for (int w = 0; w < 4; ++w) { hreg[q * 8 + 2 * w] = bflo(hv[w]); hreg[q * 8 + 2 * w + 1] = bfhi(hv[w]); }
      }
#pragma unroll
      for (int i = 0; i < 32; ++i) o[i] = 0.f;
      const float* Us = p.Us(); const float* Vs = p.Vs();
      const unsigned char* Uq = p.Uq() + lane * 24;
      const int* ep = eidx + tok * 128; const float* gp = gts + tok * 128;
      u32x4 uA4[2], vA4[2], uB4[2], vB4[2]; u32x2 uA2[2], vA2[2], uB2[2], vB2[2];
      float gA[2], suA[2], svA[2], gB[2], suB[2], svB[2];
#define PEER_LOAD(U4, U2, V4, V2, G, SU, SV, J0)                                                        \
      _Pragma("unroll") for (int jj = 0; jj < 2; ++jj) {                                                \
        const int e = __builtin_amdgcn_readfirstlane(ep[(J0) + jj]);                                    \
        G[jj] = gp[(J0) + jj]; SU[jj] = Us[e]; SV[jj] = Vs[e];                                          \
        const unsigned char* up = Uq + (size_t)e * 3072; const unsigned char* vp = up + 1536;           \
        U2[jj] = *(const u32x2*)(up); U4[jj] = *(const u32x4*)(up + 8);                                 \
        V2[jj] = *(const u32x2*)(vp); V4[jj] = *(const u32x4*)(vp + 8);                                 \
      }
#define PEER_COMPUTE(U4, U2, V4, V2, G, SU, SV)                                                         \
      _Pragma("unroll") for (int jj = 0; jj < 2; ++jj) {                                                \
        const u32x6 uw = {U2[jj][0], U2[jj][1], U4[jj][0], U4[jj][1], U4[jj][2], U4[jj][3]};            \
        const f32x32 ud = __builtin_amdgcn_cvt_scalef32_pk32_f32_fp6(uw, 1.0f);                         \
        float d0 = 0.f, d1 = 0.f, d2 = 0.f, d3 = 0.f;                                                   \
        _Pragma("unroll") for (int i = 0; i < 32; i += 4) {                                             \
          d0 += ud[i] * hreg[i]; d1 += ud[i + 1] * hreg[i + 1]; d2 += ud[i + 2] * hreg[i + 2]; d3 += ud[i + 3] * hreg[i + 3]; \
        }                                                                                               \
        const float av = wave_sum((d0 + d1) + (d2 + d3)) * SU[jj];                                      \
        const float act = gelu_exact(av) * G[jj] * SV[jj];                                              \
        const u32x6 vw = {V2[jj][0], V2[jj][1], V4[jj][0], V4[jj][1], V4[jj][2], V4[jj][3]};            \
        const f32x32 vd = __builtin_amdgcn_cvt_scalef32_pk32_f32_fp6(vw, 1.0f);                         \
        o += vd * act;                                                                                  \
      }
      PEER_LOAD(uA4, uA2, vA4, vA2, gA, suA, svA, 0)
#pragma unroll 1
      for (int j0 = 0; j0 < 128; j0 += 4) {
        PEER_LOAD(uB4, uB2, vB4, vB2, gB, suB, svB, j0 + 2)
        PEER_COMPUTE(uA4, uA2, vA4, vA2, gA, suA, svA)
        if (j0 + 4 < 128) { PEER_LOAD(uA4, uA2, vA4, vA2, gA, suA, svA, j0 + 4) }
        PEER_COMPUTE(uB4, uB2, vB4, vB2, gB, suB, svB)
      }
#undef PEER_LOAD
#undef PEER_COMPUTE
      float* orow = p.out + (size_t)t * D_ + lane * 32;
      float sum = 0.f;
#pragma unroll
      for (int q = 0; q < 8; ++q) {
        const float4 r0 = *(const float4*)(orow + q * 4);
        o[q * 4 + 0] += r0.x; o[q * 4 + 1] += r0.y; o[q * 4 + 2] += r0.z; o[q * 4 + 3] += r0.w;
      }
#pragma unroll
      for (int i = 0; i < 32; ++i) sum += o[i];
      const float mu = wave_sum(sum) * (1.f / D_);
      float sq = 0.f;
#pragma unroll
      for (int i = 0; i < 32; ++i) { o[i] -= mu; sq += o[i] * o[i]; }
      const float rstd = rsqrtf(wave_sum(sq) * (1.f / D_) + EPS);
#pragma unroll
      for (int q = 0; q < 8; ++q) {
        const int col = lane * 32 + q * 4;
        const float4 g0 = *(const float4*)(p.ln2_g + col), b0 = *(const float4*)(p.ln2_b + col);
        float4 w0;
        w0.x = o[q * 4 + 0] * rstd * g0.x + b0.x; w0.y = o[q * 4 + 1] * rstd * g0.y + b0.y;
        w0.z = o[q * 4 + 2] * rstd * g0.z + b0.z; w0.w = o[q * 4 + 3] * rstd * g0.w + b0.w;
        *(float4*)(orow + q * 4) = w0;
      }
    }
    __syncthreads();
  }
}

template <int PH>
__device__ __forceinline__ void run_phase(const Params& p, char* smem, int bid, int nb) {
  if constexpr (PH == 0) phase_prep(p, smem, bid, nb);
  if constexpr (PH == 1) phase_inproj(p, smem, bid, nb);
  if constexpr (PH == 2) phase_up(p, smem, bid, nb);
#ifdef ATTN_NAIVE
  if constexpr (PH == 3) phase_attn_naive(p, smem, bid, nb);
#else
  if constexpr (PH == 3) phase_attn(p, smem, bid, nb);
#endif
  if constexpr (PH == 4) phase_outproj(p, smem, bid, nb);
  if constexpr (PH == 5) phase_ln1(p, bid, nb);
  if constexpr (PH == 6) phase_mid(p, smem, bid, nb);
  if constexpr (PH == 7) phase_peer(p, smem, bid, nb);
}

template <int PH>
__global__ void __launch_bounds__(NT, 2) phase_kernel(Params p) {
  __shared__ __attribute__((aligned(16))) char smem[SMEM_BYTES];
  run_phase<PH>(p, smem, blockIdx.x, gridDim.x);
}

#define BW_CENSUS(j) (256 + (j) * 32)
#define BW_XSUB(j) (256 + 512 + (j) * 32)
#define BW_XGEN(j) (256 + 1024 + (j) * 32)
#define BW_TOP (256 + 1536)
#define BW_TOPGEN (256 + 1568)
__device__ __forceinline__ unsigned bw_ld(unsigned* p) { return __hip_atomic_load(p, __ATOMIC_RELAXED, __HIP_MEMORY_SCOPE_AGENT); }
__device__ __forceinline__ unsigned bw_add(unsigned* p, unsigned v) { return __hip_atomic_fetch_add(p, v, __ATOMIC_RELAXED, __HIP_MEMORY_SCOPE_AGENT); }
__device__ __forceinline__ unsigned xcc_id() { return (unsigned)__builtin_amdgcn_s_getreg((3 << 11) | 20) & 0xFu; }

__device__ __forceinline__ void grid_barrier(unsigned* bar, unsigned* st  ) {
  asm volatile("s_waitcnt vmcnt(0)" ::: "memory");
  __syncthreads();
  if (threadIdx.x == 0) {
    __builtin_amdgcn_s_waitcnt(0);
    const unsigned x = xcc_id();
    unsigned nloc = st[0], nx = st[1];
    if (nloc == 0u) {
      const unsigned G = gridDim.x;
      for (;;) {
        unsigned sum = 0u, cnt = 0u, mine = 0u;
#pragma unroll
        for (unsigned j = 0; j < 16; ++j) { const unsigned c = bw_ld(&bar[BW_CENSUS(j)]); sum += c; cnt += (c > 0u) ? 1u : 0u; mine = (j == x) ? c : mine; }
        nloc = mine; nx = cnt;
        if (sum == G) break;
        __builtin_amdgcn_s_sleep(1);
      }
      st[0] = nloc; st[1] = nx;
    }
    const unsigned old = bw_add(&bar[BW_XSUB(x)], 1u);
    const unsigned gen = old / nloc;
    if (old + 1u == (gen + 1u) * nloc) {
      __builtin_amdgcn_fence(__ATOMIC_RELEASE, "agent");
      asm volatile("s_waitcnt vmcnt(0)" ::: "memory");
      const unsigned og = bw_add(&bar[BW_TOP], 1u);
      const unsigned tg = og / nx;
      if (og + 1u == (tg + 1u) * nx) bw_add(&bar[BW_TOPGEN], 1u);
      else while (bw_ld(&bar[BW_TOPGEN]) == tg) __builtin_amdgcn_s_sleep(1);
      __builtin_amdgcn_fence(__ATOMIC_ACQUIRE, "agent");
      bw_add(&bar[BW_XGEN(x)], 1u);
      asm volatile("s_waitcnt vmcnt(0)" ::: "memory");
    } else {
      while (bw_ld(&bar[BW_XGEN(x)]) == gen) __builtin_amdgcn_s_sleep(1);
      __builtin_amdgcn_fence(__ATOMIC_ACQUIRE, "agent");
      asm volatile("s_waitcnt vmcnt(0)" ::: "memory");
    }
  }
  __syncthreads();
}

#if SINGLE_LAUNCH
typedef const __attribute__((address_space(4))) unsigned long long* kargp_t;
static_assert(sizeof(Params) % 8 == 0, "Params must be a pack of 8-byte fields");
#define RUN_PHASE(N) run_phase<N>(p_, smem, bid, nb);
__global__ void __launch_bounds__(NT, 2) fwd_kernel(Params p_) {
  __shared__ __attribute__((aligned(16))) char smem[SMEM_BYTES + 64];
  const int bid = blockIdx.x, nb = gridDim.x;
  unsigned* bar = (unsigned*)(p_.ws + O_CTR);
  unsigned* st = (unsigned*)(smem + SMEM_BYTES);
  if (threadIdx.x == 0) { st[0] = 0u; st[1] = 0u; (void)bw_add(&bar[BW_CENSUS(xcc_id())], 1u); }
  if (p_.out == nullptr) cg::this_grid().sync();
  RUN_PHASE(0) grid_barrier(bar, st);
  RUN_PHASE(1) grid_barrier(bar, st);
  RUN_PHASE(2) grid_barrier(bar, st);
  RUN_PHASE(3) grid_barrier(bar, st);
  RUN_PHASE(4) grid_barrier(bar, st);
  RUN_PHASE(5) grid_barrier(bar, st);
  RUN_PHASE(6) grid_barrier(bar, st);
  RUN_PHASE(7)
}
#endif

extern "C" void kernel_launch(void* const* d_in, const int* in_sizes, int n_in, void* d_out, int out_size,
                              void* d_ws, size_t ws_size, hipStream_t stream) {
  (void)in_sizes; (void)n_in; (void)out_size; (void)ws_size;
  Params p{};
  p.x = (const float*)d_in[0]; p.p = (const float*)d_in[1]; p.positions = (const int*)d_in[2];
  p.w_in = (const float*)d_in[3]; p.b_forget = (const float*)d_in[4]; p.g_q = (const float*)d_in[5];
  p.w_uq = (const float*)d_in[6]; p.g_kv = (const float*)d_in[7]; p.w_ukv = (const float*)d_in[8];
  p.w_out = (const float*)d_in[9]; p.ln1_g = (const float*)d_in[10]; p.ln1_b = (const float*)d_in[11];
  p.peer_wq = (const float*)d_in[12]; p.keys1 = (const float*)d_in[13]; p.keys2 = (const float*)d_in[14];
  p.peer_u = (const float*)d_in[15]; p.peer_v = (const float*)d_in[16]; p.wgate = (const float*)d_in[17];
  p.wproj = (const float*)d_in[18]; p.ln2_g = (const float*)d_in[19]; p.ln2_b = (const float*)d_in[20];
  p.out = (float*)d_out;
  p.ws = (char*)d_ws;

  static int grid_blocks = 0;
  if (!grid_blocks) {
    int dev = 0, cus = 0, per_cu = 0;
    (void)hipGetDevice(&dev);
    (void)hipDeviceGetAttribute(&cus, hipDeviceAttributeMultiprocessorCount, dev);
#if SINGLE_LAUNCH
    (void)hipOccupancyMaxActiveBlocksPerMultiprocessor(&per_cu, fwd_kernel, NT, 0);
#else
    per_cu = 2;
#endif
    if (per_cu > 1) per_cu = 1;
    if (per_cu < 1) per_cu = 1;
    grid_blocks = cus * per_cu;
  }
#if SINGLE_LAUNCH
  (void)hipMemsetAsync(d_ws, 0, 16384, stream);
  void* args[] = {&p};
  hipError_t e = hipLaunchCooperativeKernel((void*)fwd_kernel, dim3(grid_blocks), dim3(NT), args, 0, stream);
  if (e != hipSuccess) fprintf(stderr, "cooperative launch failed: %s (grid %d)\n", hipGetErrorString(e), grid_blocks);
#else
  phase_kernel<0><<<grid_blocks, NT, 0, stream>>>(p);
  phase_kernel<1><<<grid_blocks, NT, 0, stream>>>(p);
  phase_kernel<2><<<grid_blocks, NT, 0, stream>>>(p);
  phase_kernel<3><<<grid_blocks, NT, 0, stream>>>(p);
  phase_kernel<4><<<grid_blocks, NT, 0, stream>>>(p);
  phase_kernel<5><<<grid_blocks, NT, 0, stream>>>(p);
  phase_kernel<6><<<grid_blocks, NT, 0, stream>>>(p);
  phase_kernel<7><<<grid_blocks, NT, 0, stream>>>(p);
#endif
}
```

```cpp
#include <hip/hip_runtime.h>
#include <hip/hip_bf16.h>
#include <hip/hip_cooperative_groups.h>
#include <stdint.h>
#include <cstdio>
namespace cg = cooperative_groups;

typedef unsigned short u16;
typedef short bf16x8 __attribute__((ext_vector_type(8)));
typedef float f32x4 __attribute__((ext_vector_type(4)));
typedef unsigned u32x4 __attribute__((ext_vector_type(4)));
typedef unsigned u32x2 __attribute__((ext_vector_type(2)));

#ifndef SINGLE_LAUNCH
#define SINGLE_LAUNCH 1
#endif

constexpr int T_ = 8192, D_ = 2048, S_ = 4096, NB_ = 2;
constexpr int INW = 4168;
constexpr int NPH = 8;
constexpr float ALPHA = 1.189207115002721f;
constexpr float EPS = 1e-6f;
constexpr int NT = 512;
constexpr int SMEM_BYTES = 133120;

constexpr size_t al256(size_t x) { return (x + 255) & ~(size_t)255; }
constexpr size_t O_CTR = 0;
constexpr size_t O_WINT = O_CTR + 16384;
constexpr size_t O_WUQT = O_WINT + al256((size_t)4352 * 2048 * 2);
constexpr size_t O_WUKVT = O_WUQT + al256((size_t)1536 * 512 * 2);
constexpr size_t O_WOUTT = O_WUKVT + al256((size_t)2048 * 512 * 2);
constexpr size_t O_WPQT = O_WOUTT + al256((size_t)2048 * 2048 * 2);
constexpr size_t O_WGT = O_WPQT + al256((size_t)1024 * 2048 * 2);
constexpr size_t O_WPT = O_WGT + al256((size_t)2048 * 2048 * 2);
constexpr size_t O_PB = O_WPT + al256((size_t)2048 * 256 * 2);
constexpr size_t O_UB = O_PB + al256((size_t)8192 * 256 * 2);
constexpr size_t O_VB = O_UB + 2048;
constexpr size_t O_OMIX = O_UB + al256((size_t)16384 * 4096);
constexpr size_t O_CS = O_OMIX + al256((size_t)8192 * 2048 * 2);
constexpr size_t O_PROJB = O_CS + al256((size_t)8192 * 32 * 8);
constexpr size_t O_KEYH = O_PROJB + al256((size_t)8192 * 2048 * 2);
constexpr size_t O_KEYL = O_KEYH + al256((size_t)2 * 8 * 128 * 64 * 2);
constexpr size_t O_US = O_KEYL + al256((size_t)2 * 8 * 128 * 64 * 2);
constexpr size_t O_VS = O_US + al256((size_t)16384 * 4);
constexpr size_t O_REGB = O_VS + al256((size_t)16384 * 4);
constexpr size_t O_XB = O_REGB;
constexpr size_t O_CQB = O_XB + al256((size_t)8192 * 2048 * 2);
constexpr size_t O_CKVB = O_CQB + al256((size_t)8192 * 512 * 2);
constexpr size_t O_QM = O_CKVB + al256((size_t)8192 * 512 * 2);
constexpr size_t O_KM = O_QM + al256((size_t)8192 * 8 * 192 * 2);
constexpr size_t O_VMT = O_KM + al256((size_t)8192 * 8 * 192 * 2);
constexpr size_t O_QF = O_VMT + al256((size_t)8192 * 8 * 128 * 2);
constexpr size_t O_KF = O_QF + al256((size_t)8192 * 8 * 128 * 2);
constexpr size_t O_VFT = O_KF + al256((size_t)8192 * 8 * 128 * 2);
constexpr size_t O_LOGF = O_VFT + al256((size_t)8192 * 8 * 128 * 2);
constexpr size_t O_FK = O_LOGF + al256((size_t)16 * 4096 * 4);
constexpr size_t O_KRS = O_FK + al256((size_t)16 * 4096 * 4);
constexpr size_t O_RSS = O_KRS + al256((size_t)8192 * 64 * 4);
constexpr size_t O_ENDB = O_RSS + al256((size_t)2 * 8192 * 4);
constexpr size_t O_Y1 = O_REGB;
constexpr size_t O_H1B = O_Y1 + al256((size_t)8192 * 2048 * 4);
constexpr size_t O_PQ = O_H1B + al256((size_t)8192 * 2048 * 2);
constexpr size_t O_GATE = O_PQ + al256((size_t)8192 * 128 * 4);
constexpr size_t O_ENDB2 = O_GATE + al256((size_t)8192 * 128 * 4);
static_assert(O_ENDB2 <= O_ENDB, "region B reuse overflow");
static_assert(O_ENDB <= (size_t)500 * 1024 * 1024, "workspace too large");

struct Params {
  const float *x, *p; const int* positions;
  const float *w_in, *b_forget, *g_q, *w_uq, *g_kv, *w_ukv, *w_out, *ln1_g, *ln1_b;
  const float *peer_wq, *keys1, *keys2, *peer_u, *peer_v, *wgate, *wproj, *ln2_g, *ln2_b;
  float* out;
  char* ws;
#define WSP(type, name, off) __device__ __forceinline__ type* name() const { return (type*)(ws + (off)); }
  WSP(unsigned, ctr, O_CTR) WSP(u16, WinT, O_WINT) WSP(u16, WuqT, O_WUQT) WSP(u16, WukvT, O_WUKVT) WSP(u16, WoutT, O_WOUTT)
  WSP(u16, WpqT, O_WPQT) WSP(u16, WgT, O_WGT) WSP(u16, WpT, O_WPT) WSP(u16, pb, O_PB) WSP(unsigned char, Uq, O_UB) WSP(unsigned char, Vq, O_VB) WSP(float, Us, O_US) WSP(float, Vs, O_VS)
  WSP(u16, omix, O_OMIX) WSP(float2, cs, O_CS) WSP(u16, projb, O_PROJB) WSP(u16, keyH, O_KEYH) WSP(u16, keyL, O_KEYL)
  WSP(u16, xb, O_XB) WSP(u16, cqb, O_CQB) WSP(u16, ckvb, O_CKVB) WSP(u16, Qm, O_QM) WSP(u16, Km, O_KM) WSP(u16, VmT, O_VMT)
  WSP(u16, Qf, O_QF) WSP(u16, Kf, O_KF) WSP(u16, VfT, O_VFT) WSP(float, logf, O_LOGF) WSP(float, Fk, O_FK) WSP(float, krsum, O_KRS) WSP(float, rss, O_RSS)
  WSP(float, y1, O_Y1) WSP(u16, h1b, O_H1B) WSP(int, eidxG, O_PQ) WSP(float, gateG, O_GATE)
#undef WSP
};

__device__ __forceinline__ int TID() { int t = threadIdx.x; asm volatile("" : "+v"(t)); return t; }
__device__ __forceinline__ unsigned pk2(float lo, float hi) {
  unsigned r; asm volatile("v_cvt_pk_bf16_f32 %0, %1, %2" : "=v"(r) : "v"(lo), "v"(hi)); return r;
}
__device__ __forceinline__ u16 f2bf(float f) { return (u16)(pk2(f, 0.f) & 0xffffu); }
__device__ __forceinline__ float bf2f(u16 v) { return __uint_as_float(((unsigned)v) << 16); }
__device__ __forceinline__ float bflo(unsigned v) { return __uint_as_float(v << 16); }
__device__ __forceinline__ float bfhi(unsigned v) { return __uint_as_float(v & 0xffff0000u); }

template <int CTRL> __device__ __forceinline__ int dppi(int v) { return __builtin_amdgcn_update_dpp(0, v, CTRL, 0xF, 0xF, false); }
template <int CTRL> __device__ __forceinline__ float dppf(float v) { return __int_as_float(dppi<CTRL>(__float_as_int(v))); }
__device__ __forceinline__ float rdlane(float v, int l) { return __int_as_float(__builtin_amdgcn_readlane(__float_as_int(v), l)); }

__device__ __forceinline__ float row_sum(float v) {
  v += dppf<0xB1>(v); v += dppf<0x4E>(v); v += dppf<0x141>(v); v += dppf<0x140>(v); return v;
}
__device__ __forceinline__ float row_max(float v) {
  v = fmaxf(v, dppf<0xB1>(v)); v = fmaxf(v, dppf<0x4E>(v)); v = fmaxf(v, dppf<0x141>(v)); v = fmaxf(v, dppf<0x140>(v)); return v;
}
__device__ __forceinline__ float wave_sum(float v) {
  v = row_sum(v);
  return (rdlane(v, 0) + rdlane(v, 16)) + (rdlane(v, 32) + rdlane(v, 48));
}
__device__ __forceinline__ float wave_max(float v) {
  v = row_max(v);
  return fmaxf(fmaxf(rdlane(v, 0), rdlane(v, 16)), fmaxf(rdlane(v, 32), rdlane(v, 48)));
}
__device__ __forceinline__ unsigned wave_umax(unsigned v) {
  unsigned t;
  t = (unsigned)dppi<0xB1>((int)v); v = v > t ? v : t;
  t = (unsigned)dppi<0x4E>((int)v); v = v > t ? v : t;
  t = (unsigned)dppi<0x141>((int)v); v = v > t ? v : t;
  t = (unsigned)dppi<0x140>((int)v); v = v > t ? v : t;
  unsigned a = (unsigned)__builtin_amdgcn_readlane((int)v, 0), b = (unsigned)__builtin_amdgcn_readlane((int)v, 16);
  unsigned c = (unsigned)__builtin_amdgcn_readlane((int)v, 32), d = (unsigned)__builtin_amdgcn_readlane((int)v, 48);
  a = a > b ? a : b; c = c > d ? c : d; return a > c ? a : c;
}
__device__ __forceinline__ unsigned ordkey(float f) {
  unsigned u = __float_as_uint(f);
  return (u & 0x80000000u) ? ~u : (u | 0x80000000u);
}

__device__ __forceinline__ unsigned fp6_code(float v) {
  const float a = fabsf(v);
  int code = a < 2.f ? (int)rintf(a * 8.f) : (a < 4.f ? 16 + (int)rintf((a - 2.f) * 4.f) : 24 + (int)rintf((a - 4.f) * 2.f));
  code = code > 31 ? 31 : code;
  return (unsigned)code | (v < 0.f ? 32u : 0u);
}
__device__ __forceinline__ void quant_chunk(const Params& p, int chunk) {
  const int tid = TID(), lane = tid & 63, wid = tid >> 6;
#pragma unroll 1
  for (int i8 = 0; i8 < 8; ++i8) {
    const int r = chunk * 64 + wid * 8 + i8;
    const int tab = r >> 14, row = r & 16383;
    const float* src = (tab ? p.peer_v : p.peer_u) + (size_t)row * D_ + lane * 32;
    float4 v[8];
    float am = 0.f;
#pragma unroll
    for (int i = 0; i < 8; ++i) {
      v[i] = *(const float4*)(src + i * 4);
      am = fmaxf(am, fmaxf(fmaxf(fabsf(v[i].x), fabsf(v[i].y)), fmaxf(fabsf(v[i].z), fabsf(v[i].w))));
    }
    am = wave_max(am);
    const float qs = am > 0.f ? 7.5f / am : 1.f;
    unsigned w[6];
#pragma unroll
    for (int g = 0; g < 2; ++g) {
      unsigned long long lo = 0ull; unsigned hi = 0u;
#pragma unroll
      for (int i = 0; i < 4; ++i) {
        const float4 f = v[g * 4 + i];
        const unsigned q4 = fp6_code(f.x * qs) | (fp6_code(f.y * qs) << 6) | (fp6_code(f.z * qs) << 12) | (fp6_code(f.w * qs) << 18);
        if (i == 0) lo |= (unsigned long long)q4;
        if (i == 1) lo |= (unsigned long long)q4 << 24;
        if (i == 2) { lo |= (unsigned long long)q4 << 48; hi |= q4 >> 16; }
        if (i == 3) hi |= q4 << 8;
      }
      w[g * 3 + 0] = (unsigned)lo; w[g * 3 + 1] = (unsigned)(lo >> 32); w[g * 3 + 2] = hi;
    }
    unsigned* dst = (unsigned*)(p.Uq() + (size_t)row * 3072 + tab * 1536 + lane * 24);
    *(u32x2*)dst = u32x2{w[0], w[1]}; *(u32x2*)(dst + 2) = u32x2{w[2], w[3]}; *(u32x2*)(dst + 4) = u32x2{w[4], w[5]};
    if (lane == 0) (tab ? p.Vs() : p.Us())[row] = am > 0.f ? am / 7.5f : 1.f;
  }
}

__device__ void transpose_cvt(const float* __restrict__ W, int ldw, int K, int src_col0, int ncols,
                              u16* __restrict__ WT, int dst_row0, const float* __restrict__ kscale,
                              float* tile, int bid, int nb) {
  const int tiles_k = K / 64, tiles_n = ncols / 64, tid = TID();
#pragma unroll 1
  for (int t = bid; t < tiles_k * tiles_n; t += nb) {
    const int tk = t % tiles_k, tn = t / tiles_k, k0 = tk * 64, n0 = tn * 64;
#pragma unroll
    for (int i = 0; i < 2; ++i) {
      const int r = (tid >> 4) + 32 * i, c = (tid & 15) * 4;
      const float4 v = *(const float4*)(W + (size_t)(k0 + r) * ldw + src_col0 + n0 + c);
      const float sc = kscale ? kscale[k0 + r] : 1.f;
      tile[r * 65 + c + 0] = v.x * sc; tile[r * 65 + c + 1] = v.y * sc;
      tile[r * 65 + c + 2] = v.z * sc; tile[r * 65 + c + 3] = v.w * sc;
    }
    __syncthreads();
    {
      const int n = tid >> 3, kk = (tid & 7) * 8;
      unsigned w[4];
#pragma unroll
      for (int e = 0; e < 4; ++e) w[e] = pk2(tile[(kk + 2 * e) * 65 + n], tile[(kk + 2 * e + 1) * 65 + n]);
      *(u32x4*)(WT + (size_t)(dst_row0 + n0 + n) * K + k0 + kk) = u32x4{w[0], w[1], w[2], w[3]};
    }
    __syncthreads();
  }
}

__device__ void cvt_bf16(const float* __restrict__ src, u16* __restrict__ dst, size_t n8, size_t gtid, size_t gthreads) {
  for (size_t i = gtid; i < n8; i += gthreads) {
    const float4 a = ((const float4*)src)[2 * i], b = ((const float4*)src)[2 * i + 1];
    ((u32x4*)dst)[i] = u32x4{pk2(a.x, a.y), pk2(a.z, a.w), pk2(b.x, b.y), pk2(b.z, b.w)};
  }
}

__device__ void phase_prep(const Params& p, char* smem, int bid, int nb) {
  const int tid = TID(), lane = tid & 63, wid = tid >> 6;
  float* tile = (float*)smem;
  if (bid == 0 && tid == 0) p.ctr()[0] = 0;
  transpose_cvt(p.w_in, INW, D_, 0, 1024, p.WinT(), 0, nullptr, tile, bid, nb);
  transpose_cvt(p.w_in, INW, D_, 1088, 3072, p.WinT(), 1024, nullptr, tile, bid, nb);
  transpose_cvt(p.w_in, INW, D_, 1024, 64, p.WinT(), 4096, nullptr, tile, bid, nb);
  transpose_cvt(p.w_uq, 1536, 512, 0, 1536, p.WuqT(), 0, p.g_q, tile, bid, nb);
  transpose_cvt(p.w_ukv, 2048, 512, 0, 2048, p.WukvT(), 0, p.g_kv, tile, bid, nb);
  transpose_cvt(p.w_out, 2048, 2048, 0, 2048, p.WoutT(), 0, nullptr, tile, bid, nb);
  transpose_cvt(p.peer_wq, 1024, 2048, 0, 1024, p.WpqT(), 0, nullptr, tile, bid, nb);
  transpose_cvt(p.wgate, 2048, 2048, 0, 2048, p.WgT(), 0, nullptr, tile, bid, nb);
  transpose_cvt(p.wproj, 2048, 256, 0, 2048, p.WpT(), 0, nullptr, tile, bid, nb);
  const size_t gtid = (size_t)bid * NT + tid, gth = (size_t)nb * NT;
  for (size_t i = gtid; i < (size_t)192 * 2048 / 8; i += gth) ((u32x4*)(p.WinT() + (size_t)4160 * 2048))[i] = u32x4{0, 0, 0, 0};
  cvt_bf16(p.p, p.pb(), (size_t)T_ * 256 / 8, gtid, gth);
  for (size_t i = gtid; i < (size_t)T_ * 64 / 4; i += gth) ((float4*)p.krsum())[i] = make_float4(0.f, 0.f, 0.f, 0.f);
  for (size_t i = gtid; i < (size_t)2 * T_ / 4; i += gth) ((float4*)p.rss())[i] = make_float4(0.f, 0.f, 0.f, 0.f);
  for (size_t i = gtid; i < (size_t)2 * 65536; i += gth) {
    const float v = i < 65536 ? p.keys1[i] : p.keys2[i - 65536];
    const u16 h = f2bf(v);
    p.keyH()[i] = h; p.keyL()[i] = f2bf(v - bf2f(h));
  }
  for (size_t i = gtid; i < (size_t)T_ * 32; i += gth) {
    const int t = (int)(i >> 5), fi = (int)(i & 31);
    const float invf = 1.0f / powf(10000.0f, (float)(2 * fi) / 64.0f);
    const float ang = (float)p.positions[t] * invf;
    const double rev = (double)ang * 0.15915494309189535;
    const float fr = (float)(rev - rint(rev));
    p.cs()[i] = make_float2(__builtin_amdgcn_cosf(fr), __builtin_amdgcn_sinf(fr));
  }
  __syncthreads();
  float* wff = (float*)smem;
  for (int i = tid; i < 2048 * 2; i += NT) {
    const int k = i >> 1, hf = i & 1;
    *(float4*)(wff + k * 8 + hf * 4) = *(const float4*)(p.w_in + (size_t)k * INW + 4160 + hf * 4);
  }
  __syncthreads();
  for (int t = bid * 8 + wid; t < T_; t += nb * 8) {
    float a[8];
#pragma unroll
    for (int e = 0; e < 8; ++e) a[e] = 0.f;
#pragma unroll 1
    for (int i = 0; i < 4; ++i) {
      const int k = (i * 64 + lane) * 8;
      const float4 x0 = *(const float4*)(p.x + (size_t)t * D_ + k), x1 = *(const float4*)(p.x + (size_t)t * D_ + k + 4);
      *(u32x4*)(p.xb() + (size_t)t * D_ + k) = u32x4{pk2(x0.x, x0.y), pk2(x0.z, x0.w), pk2(x1.x, x1.y), pk2(x1.z, x1.w)};
      const float xs[8] = {x0.x, x0.y, x0.z, x0.w, x1.x, x1.y, x1.z, x1.w};
#pragma unroll
      for (int j = 0; j < 8; ++j) {
        const float4 w0 = *(const float4*)(wff + (k + j) * 8), w1 = *(const float4*)(wff + (k + j) * 8 + 4);
        a[0] += xs[j] * w0.x; a[1] += xs[j] * w0.y; a[2] += xs[j] * w0.z; a[3] += xs[j] * w0.w;
        a[4] += xs[j] * w1.x; a[5] += xs[j] * w1.y; a[6] += xs[j] * w1.z; a[7] += xs[j] * w1.w;
      }
    }
    float mine = 0.f;
#pragma unroll
    for (int e = 0; e < 8; ++e) { const float s = wave_sum(a[e]); if (lane == e) mine = s; }
    if (lane < 8) {
      const float z = mine + p.b_forget[lane];
      const float ls = fminf(z, 0.f) - log1pf(expf(-fabsf(z)));
      const int b = t >> 12, s = t & 4095;
      p.logf()[((size_t)(b * 8 + lane)) * S_ + s] = ls;
    }
  }
}

template <int WM, int WN>
__device__ __forceinline__ void gemm_core(const u16* __restrict__ A, int lda, const u16* __restrict__ Bt, int ldb,
                                          int K, int brow, int bcol, char* smem, f32x4 (&acc)[4 / WM][4][4]) {
  constexpr int MS = 4 / WM, BN = 64 * WN, NBL = BN / 64;
  static_assert(WM * WN == 8, "8 waves");
  const int tid = TID(), wid = tid >> 6, lane = tid & 63, wr = wid / WN, wc = wid % WN, fr = lane & 15, fq = lane >> 4;
#pragma unroll
  for (int h = 0; h < MS; ++h)
#pragma unroll
    for (int m = 0; m < 4; ++m)
#pragma unroll
      for (int n = 0; n < 4; ++n) acc[h][m][n] = f32x4{0.f, 0.f, 0.f, 0.f};
  const int nk = K / 64;
  const int srow = tid >> 3, sch = (tid & 7) ^ ((tid >> 4) & 7);
  const u16* ga = A + (size_t)(brow + srow) * lda + sch * 8;
  const u16* gb = Bt + (size_t)(bcol + srow) * ldb + sch * 8;
  char* sdst = smem + tid * 16;
  auto issue = [&](int kt, int st) {
    char* sa = sdst + st * 65536;
#pragma unroll
    for (int i = 0; i < 4; ++i)
      __builtin_amdgcn_global_load_lds((const unsigned*)(ga + (size_t)i * 64 * lda + kt * 64), (unsigned*)(sa + i * 8192), 16, 0, 0);
#pragma unroll
    for (int i = 0; i < NBL; ++i)
      __builtin_amdgcn_global_load_lds((const unsigned*)(gb + (size_t)i * 64 * ldb + kt * 64), (unsigned*)(sa + 32768 + i * 8192), 16, 0, 0);
  };
  const int fx = (fr >> 1) & 7;
  const int arow = (wr * (256 / WM) + fr) * 128, brw = 32768 + (wc * 64 + fr) * 128;
  const int c0 = (fq ^ fx) * 16, c1 = ((4 + fq) ^ fx) * 16;
  asm volatile("s_waitcnt vmcnt(0)" ::: "memory");
  __syncthreads();
  issue(0, 0);
#pragma unroll 1
  for (int kt = 0; kt < nk; ++kt) {
    asm volatile("s_waitcnt vmcnt(0)" ::: "memory");
    __builtin_amdgcn_s_barrier();
    asm volatile("" ::: "memory");
    if (kt + 1 < nk) issue(kt + 1, (kt + 1) & 1);
    const char* sb = smem + (kt & 1) * 65536;
#pragma unroll
    for (int ks = 0; ks < 2; ++ks) {
      const int co = ks ? c1 : c0;
      bf16x8 Bl[4];
#pragma unroll
      for (int n = 0; n < 4; ++n) Bl[n] = *reinterpret_cast<const bf16x8*>(sb + brw + co + n * 2048);
#pragma unroll
      for (int h = 0; h < MS; ++h) {
        bf16x8 At[4];
#pragma unroll
        for (int m = 0; m < 4; ++m) At[m] = *reinterpret_cast<const bf16x8*>(sb + arow + co + (h * 4 + m) * 2048);
#pragma unroll
        for (int m = 0; m < 4; ++m)
#pragma unroll
          for (int n = 0; n < 4; ++n) acc[h][m][n] = __builtin_amdgcn_mfma_f32_16x16x32_bf16(At[m], Bl[n], acc[h][m][n], 0, 0, 0);
      }
    }
  }
}

template <int WM, int WN, class Epi>
__device__ __forceinline__ void gemm_tile(const u16* __restrict__ A, int lda, const u16* __restrict__ Bt, int ldb,
                                          int K, int brow, int bcol, char* smem, Epi epi) {
  constexpr int MS = 4 / WM;
  const int tid = TID(), wid = tid >> 6, lane = tid & 63, wr = wid / WN, wc = wid % WN, fr = lane & 15, fq = lane >> 4;
  f32x4 acc[MS][4][4];
  gemm_core<WM, WN>(A, lda, Bt, ldb, K, brow, bcol, smem, acc);
#pragma unroll
  for (int h = 0; h < MS; ++h) epi(acc[h], brow + wr * (256 / WM) + h * 64, bcol + wc * 64, fr, fq);
}

namespace pg8 {
#define PG8_LAS __attribute__((address_space(3)))
typedef unsigned short bf16_t;
constexpr int BM = 256, BK = 64, HALF = 128, HTB = HALF * BK * 2  , STAGE_BYTES = 8 * HTB, NXCD = 8, WGM = 8;

__host__ __device__ __forceinline__ int lds_byte(int r, int c) { const int st = (r >> 4) * 2 + (c >> 5), rr = r & 15, cc = c & 31, ob = rr * 64 + cc * 2; return st * 1024 + (ob ^ (((ob >> 9) & 1) << 5)); }
__host__ __device__ __forceinline__ void stage_rc(int b, int& R, int& C) { const int st = b / 1024, sb = b % 1024, swz = sb ^ (((sb >> 9) & 1) << 5); R = (st >> 1) * 16 + swz / 64; C = (st & 1) * 32 + (swz % 64) / 2; }
__host__ __device__ __forceinline__ int perm32(int rho) { const int n = rho >> 4, i = rho & 15; return 8 * (i >> 2) + 4 * n + (i & 3); }
struct Unit { int pm, pn; };
struct Gemm { const bf16_t* A; const bf16_t* Bt; int M, N, K; };
struct StaticOrder {
    int nM, nN, nwg, G, c;
    __device__ void init(int M, int N, int G_, int c_) { nM = M / BM; nN = N / BM; nwg = nM * nN; G = G_; c = c_; }
    __device__ bool next(int i, Unit& u) const {
        const long L = (long)i * G + c; if (L >= nwg) return false;
        int wgid = (int)L; { const int q = nwg / NXCD, r = nwg % NXCD, xcd = wgid % NXCD, off = wgid / NXCD; wgid = (xcd < r ? xcd * (q + 1) : r * (q + 1) + (xcd - r) * q) + off; }
        const int nig = WGM * nN, gid = wgid / nig, fm = gid * WGM, gsz = (nM - fm) < WGM ? (nM - fm) : WGM;
        u.pm = fm + ((wgid % nig) % gsz); u.pn = (wgid % nig) / gsz; return true;
    }
    __device__ __forceinline__ void a_ready(const Unit&) const {}
    __device__ __forceinline__ void done(const Unit&) const {}
};
template <class Epi, class Sched, bool STAMP = false>
__device__ __forceinline__ void gemm_phase(PG8_LAS unsigned char* lds, const Gemm g, const Sched& S, const Epi& E, unsigned long long* stamps) {
    const int tid = TID(), wid = __builtin_amdgcn_readfirstlane(tid >> 6), lane = tid & 63, wr = wid >> 2, wc = wid & 3, fr = lane & 15, fq = lane >> 4;
    const int K = g.K, nt = K / BK;
    int ts_lo = 0, ts_hi = 0, nts = 0; const unsigned long long rt_entry = STAMP ? (unsigned long long)wall_clock64() : 0ull;
#define PG8_STAMP() do { if (STAMP && wid == 0 && nts < 64) { const unsigned long long _c = (unsigned long long)clock64(); \
        ts_lo = (lane == nts) ? (int)(unsigned)_c : ts_lo; ts_hi = (lane == nts) ? (int)(unsigned)(_c >> 32) : ts_hi; ++nts; } } while (0)
    PG8_STAMP();
    unsigned voffA[2], voffB[2];
#pragma unroll
    for (int i = 0; i < 2; ++i) { int R, C; stage_rc(tid * 16 + i * 8192, R, C); const int Rb = Epi::PERM ? ((R & ~31) + perm32(R & 31)) : R;
        voffA[i] = (unsigned)(R * K + C) * 2u; voffB[i] = (unsigned)(Rb * K + C) * 2u; }
    const size_t kstep = (size_t)(BK * 2);
    const size_t hstep = (size_t)HALF * K * 2;
    const size_t tstep = 2 * hstep;
    const unsigned ldsw = (unsigned)wid * 1024u;
    const int aoff = lds_byte(wr * 64 + fr, fq * 8), boff = lds_byte(wc * 32 + fr, fq * 8);
#define PG8_SA(b, h) (((b) * 2 + (h)) * HTB)
#define PG8_SB(b, h) ((4 + (b) * 2 + (h)) * HTB)
#define PG8_STAGE(bufoff, gbase, voff) do { _Pragma("unroll") for (int _i = 0; _i < 2; ++_i) \
        __builtin_amdgcn_global_load_lds((const unsigned*)((const char*)(gbase) + (voff)[_i]), (PG8_LAS unsigned*)(lds + (bufoff) + ldsw + _i * 8192), 16, 0, 0); } while (0)
#define PG8_LDA(dst, b, h) do { _Pragma("unroll") for (int m = 0; m < 4; ++m) _Pragma("unroll") for (int k = 0; k < 2; ++k) dst[m][k] = *(const PG8_LAS bf16x8*)(lds + PG8_SA(b, h) + aoff + m * 2048 + k * 1024); } while (0)
#define PG8_LDB(dst, b, h) do { _Pragma("unroll") for (int n = 0; n < 2; ++n) _Pragma("unroll") for (int k = 0; k < 2; ++k) dst[n][k] = *(const PG8_LAS bf16x8*)(lds + PG8_SB(b, h) + boff + n * 2048 + k * 1024); } while (0)
#define PG8_MMA(ai, bj, At, Bt) do { __builtin_amdgcn_s_setprio(1); _Pragma("unroll") for (int m = 0; m < 4; ++m) _Pragma("unroll") for (int n = 0; n < 2; ++n) _Pragma("unroll") for (int k = 0; k < 2; ++k) \
        acc[ai][bj][m][n] = __builtin_amdgcn_mfma_f32_16x16x32_bf16(Bt[n][k], At[m][k], acc[ai][bj][m][n], 0, 0, 0); __builtin_amdgcn_s_setprio(0); } while (0)
#define PG8_WAIT_V(n) asm volatile("s_waitcnt vmcnt(" #n ")" ::: "memory")
#define PG8_WAIT_L(n) asm volatile("s_waitcnt lgkmcnt(" #n ")" ::: "memory")
#define PG8_BAR __builtin_amdgcn_s_barrier()
#define PG8_SCHED __builtin_amdgcn_sched_barrier(0)
    Unit cur, nxt; int ui = 0;
    if (!S.next(0, cur)) return;
    f32x4 acc[2][2][4][2];
#pragma unroll
    for (int a = 0; a < 2; ++a)
#pragma unroll
        for (int b = 0; b < 2; ++b)
#pragma unroll
            for (int m = 0; m < 4; ++m)
#pragma unroll
                for (int n = 0; n < 2; ++n) acc[a][b][m][n] = (f32x4){0.f, 0.f, 0.f, 0.f};
    bf16x8 At[4][2], B0[2][2], B1[2][2];
    const char* cA = (const char*)g.A + (size_t)cur.pm * tstep; const char* cB = (const char*)g.Bt + (size_t)cur.pn * tstep;
    S.a_ready(cur);
    PG8_STAGE(PG8_SB(0, 0), cB, voffB); PG8_STAGE(PG8_SA(0, 0), cA, voffA); PG8_STAGE(PG8_SB(0, 1), cB + hstep, voffB); PG8_STAGE(PG8_SA(0, 1), cA + hstep, voffA);
    if (wr == 1) PG8_BAR;
    PG8_WAIT_V(4); PG8_BAR;
    PG8_STAGE(PG8_SB(1, 0), cB + kstep, voffB); PG8_STAGE(PG8_SA(1, 0), cA + kstep, voffA); PG8_STAGE(PG8_SB(1, 1), cB + hstep + kstep, voffB);
    PG8_WAIT_V(6); PG8_BAR;
    PG8_STAMP();
    for (;;) {
        const bool has_next = S.next(ui + 1, nxt);
        const char* nA = has_next ? (const char*)g.A + (size_t)nxt.pm * tstep : cA; const char* nB = has_next ? (const char*)g.Bt + (size_t)nxt.pn * tstep : cB;
        for (int t = 0; t < nt; t += 2) {
            const bool last = (t == nt - 2);
            const char* a1 = cA + (size_t)(t + 1) * kstep;
            const char* a2 = last ? nA : cA + (size_t)(t + 2) * kstep; const char* b2 = last ? nB : cB + (size_t)(t + 2) * kstep;
            const char* a3 = a2 + kstep; const char* b3 = b2 + kstep;
            if (last && has_next) S.a_ready(nxt);
            PG8_LDB(B0, 0, 0); PG8_SCHED; PG8_LDA(At, 0, 0); PG8_STAGE(PG8_SA(1, 1), a1 + hstep, voffA);
            PG8_WAIT_L(8); PG8_BAR; PG8_WAIT_L(0); PG8_MMA(0, 0, At, B0); PG8_BAR; PG8_SCHED;
            PG8_LDB(B1, 0, 1); PG8_STAGE(PG8_SB(0, 0), b2, voffB);
            PG8_BAR; PG8_WAIT_L(0); PG8_MMA(0, 1, At, B1); PG8_BAR;
            PG8_LDA(At, 0, 1); PG8_STAGE(PG8_SA(0, 0), a2, voffA);
            PG8_BAR; PG8_WAIT_L(0); PG8_MMA(1, 0, At, B0); PG8_BAR; PG8_SCHED;
            PG8_STAGE(PG8_SB(0, 1), b2 + hstep, voffB);
            PG8_WAIT_V(6); PG8_BAR; PG8_MMA(1, 1, At, B1); PG8_BAR;
            PG8_LDB(B0, 1, 0); PG8_SCHED; PG8_LDA(At, 1, 0); PG8_STAGE(PG8_SA(0, 1), a2 + hstep, voffA);
            PG8_WAIT_L(8); PG8_BAR; PG8_WAIT_L(0); PG8_MMA(0, 0, At, B0); PG8_BAR; PG8_SCHED;
            PG8_LDB(B1, 1, 1); PG8_STAGE(PG8_SB(1, 0), b3, voffB);
            PG8_BAR; PG8_WAIT_L(0); PG8_MMA(0, 1, At, B1); PG8_BAR;
            PG8_LDA(At, 1, 1); PG8_STAGE(PG8_SA(1, 0), a3, voffA);
            PG8_BAR; PG8_WAIT_L(0); PG8_MMA(1, 0, At, B0); PG8_BAR; PG8_SCHED;
            PG8_STAGE(PG8_SB(1, 1), b3 + hstep, voffB);
            PG8_WAIT_V(6); PG8_BAR; PG8_MMA(1, 1, At, B1); PG8_BAR;
        }
        PG8_STAMP();
        if constexpr (!Epi::AFTER_DRAIN) { E(acc, cur, wr, wc, fr, fq); S.done(cur); }
        PG8_STAMP();
        if (!has_next) break;
#pragma unroll
        for (int a = 0; a < 2; ++a)
#pragma unroll
            for (int b = 0; b < 2; ++b)
#pragma unroll
                for (int m = 0; m < 4; ++m)
#pragma unroll
                    for (int n = 0; n < 2; ++n) acc[a][b][m][n] = (f32x4){0.f, 0.f, 0.f, 0.f};
        cur = nxt; cA = nA; cB = nB; ++ui;
    }
    PG8_WAIT_V(0);
    if (wr == 0) PG8_BAR;
    PG8_BAR;
    if constexpr (Epi::AFTER_DRAIN) { E.fused(acc, cur, wr, wc, fr, fq, lds, wid, lane); S.done(cur); }
    PG8_STAMP();
    if (STAMP && wid == 0) { stamps[lane] = lane < nts ? (((unsigned long long)(unsigned)ts_hi << 32) | (unsigned)ts_lo) : 0ull;
        if (lane == 62) stamps[62] = rt_entry; if (lane == 63) stamps[63] = (unsigned long long)wall_clock64(); }
#undef PG8_STAMP
#undef PG8_SA
#undef PG8_SB
#undef PG8_STAGE
#undef PG8_LDA
#undef PG8_LDB
#undef PG8_MMA
#undef PG8_WAIT_V
#undef PG8_WAIT_L
#undef PG8_BAR
#undef PG8_SCHED
}
}


__device__ __forceinline__ u32x4 pack8(const f32x4& a, const f32x4& b) { return u32x4{pk2(a[0], a[1]), pk2(a[2], a[3]), pk2(b[0], b[1]), pk2(b[2], b[3])}; }
__device__ __forceinline__ float sumsq4(const f32x4& a) { return (a[0] * a[0] + a[1] * a[1]) + (a[2] * a[2] + a[3] * a[3]); }
__device__ __forceinline__ void store_tr8(u16* vt, const f32x4& a, const f32x4& b) {
  vt[0] = f2bf(a[0]); vt[(size_t)S_] = f2bf(a[1]); vt[(size_t)2 * S_] = f2bf(a[2]); vt[(size_t)3 * S_] = f2bf(a[3]);
  vt[(size_t)4 * S_] = f2bf(b[0]); vt[(size_t)5 * S_] = f2bf(b[1]); vt[(size_t)6 * S_] = f2bf(b[2]); vt[(size_t)7 * S_] = f2bf(b[3]);
}
struct EpiInproj {
  static constexpr bool PERM = true, AFTER_DRAIN = false;
  u16 *cqb, *ckvb, *Qf, *Kf, *VfT; float* rss;
  __device__ __forceinline__ void operator()(const f32x4 (&acc)[2][2][4][2], const pg8::Unit& u, int wr, int wc, int fr, int fq) const {
    const int ct = u.pn * 256;
#pragma unroll
    for (int ai = 0; ai < 2; ++ai)
#pragma unroll
      for (int m = 0; m < 4; ++m) {
        const int row = u.pm * 256 + ai * 128 + wr * 64 + m * 16 + fr, b = row >> 12, s = row & 4095;
        float ss = 0.f;
#pragma unroll
        for (int bj = 0; bj < 2; ++bj) {
          const int c0 = ct + bj * 128 + wc * 32 + 8 * fq;
          const f32x4 v0 = acc[ai][bj][m][0], v1 = acc[ai][bj][m][1];
          if (ct < 1024) {
            u16* dst = ct < 512 ? cqb : ckvb;
            *(u32x4*)(dst + (size_t)row * 512 + (c0 & 511)) = pack8(v0, v1);
            ss += sumsq4(v0) + sumsq4(v1);
          } else if (ct < 3072) {
            int c = c0 - 1024; u16* dst = c < 1024 ? Qf : Kf; c &= 1023;
            *(u32x4*)(dst + ((size_t)(b * 8 + (c >> 7)) * S_ + s) * 128 + (c & 127)) = pack8(v0, v1);
          } else {
            const int c = c0 - 3072;
            store_tr8(VfT + ((size_t)(b * 8 + (c >> 7)) * 128 + (c & 127)) * S_ + s, v0, v1);
          }
        }
        if (ct < 1024) atomicAdd(rss + (ct < 512 ? 0 : T_) + row, ss);
        __builtin_amdgcn_sched_barrier(0);
      }
  }
};
struct EpiQup {
  static constexpr bool PERM = true, AFTER_DRAIN = false;
  u16* Qm; const float* rss;
  __device__ __forceinline__ void operator()(const f32x4 (&acc)[2][2][4][2], const pg8::Unit& u, int wr, int wc, int fr, int fq) const {
#pragma unroll
    for (int ai = 0; ai < 2; ++ai)
#pragma unroll
      for (int m = 0; m < 4; ++m) {
        const int row = u.pm * 256 + ai * 128 + wr * 64 + m * 16 + fr, b = row >> 12, s = row & 4095;
        const float rs = rsqrtf(rss[row] * (1.f / 512.f) + EPS);
#pragma unroll
        for (int bj = 0; bj < 2; ++bj) {
          const int c0 = u.pn * 256 + bj * 128 + wc * 32 + 8 * fq, hh = c0 / 192, off = c0 % 192;
          *(u32x4*)(Qm + ((size_t)(b * 8 + hh) * S_ + s) * 192 + off) = pack8(acc[ai][bj][m][0] * rs, acc[ai][bj][m][1] * rs);
        }
        __builtin_amdgcn_sched_barrier(0);
      }
  }
};
struct EpiKVup {
  static constexpr bool PERM = true, AFTER_DRAIN = false;
  u16 *Km, *VmT; const float* rss;
  __device__ __forceinline__ void operator()(const f32x4 (&acc)[2][2][4][2], const pg8::Unit& u, int wr, int wc, int fr, int fq) const {
    const int hh = u.pn;
#pragma unroll
    for (int ai = 0; ai < 2; ++ai)
#pragma unroll
      for (int m = 0; m < 4; ++m) {
        const int row = u.pm * 256 + ai * 128 + wr * 64 + m * 16 + fr, b = row >> 12, s = row & 4095;
        const float rs = rsqrtf(rss[T_ + row] * (1.f / 512.f) + EPS);
        const int off = wc * 32 + 8 * fq;
        *(u32x4*)(Km + ((size_t)(b * 8 + hh) * S_ + s) * 192 + off) = pack8(acc[ai][0][m][0] * rs, acc[ai][0][m][1] * rs);
        store_tr8(VmT + ((size_t)(b * 8 + hh) * 128 + off) * S_ + s, acc[ai][1][m][0] * rs, acc[ai][1][m][1] * rs);
        __builtin_amdgcn_sched_barrier(0);
      }
  }
};
struct EpiProj {
  static constexpr bool PERM = true, AFTER_DRAIN = false;
  u16* projb;
  __device__ __forceinline__ void operator()(const f32x4 (&acc)[2][2][4][2], const pg8::Unit& u, int wr, int wc, int fr, int fq) const {
#pragma unroll
    for (int ai = 0; ai < 2; ++ai)
#pragma unroll
      for (int m = 0; m < 4; ++m) {
        const int row = u.pm * 256 + ai * 128 + wr * 64 + m * 16 + fr;
#pragma unroll
        for (int bj = 0; bj < 2; ++bj)
          *(u32x4*)(projb + (size_t)row * D_ + u.pn * 256 + bj * 128 + wc * 32 + 8 * fq) = pack8(acc[ai][bj][m][0], acc[ai][bj][m][1]);
      }
  }
};
struct EpiOut {
  static constexpr bool PERM = false, AFTER_DRAIN = false;
  const float* x; float* y1;
  __device__ __forceinline__ void operator()(const f32x4 (&acc)[2][2][4][2], const pg8::Unit& u, int wr, int wc, int fr, int fq) const {
#pragma unroll
    for (int ai = 0; ai < 2; ++ai)
#pragma unroll
      for (int m = 0; m < 4; ++m) {
        const size_t rb = (size_t)(u.pm * 256 + ai * 128 + wr * 64 + m * 16 + fr) * D_ + u.pn * 256 + wc * 32 + 4 * fq;
#pragma unroll
        for (int bj = 0; bj < 2; ++bj)
#pragma unroll
          for (int n = 0; n < 2; ++n) {
            const size_t o = rb + bj * 128 + n * 16;
            const f32x4 xv = *(const f32x4*)(x + o);
            *(f32x4*)(y1 + o) = xv * ALPHA + acc[ai][bj][m][n];
          }
      }
  }
};
struct EpiGate {
  static constexpr bool PERM = false, AFTER_DRAIN = false;
  const float* h1; const u16* projb; float* out;
  __device__ __forceinline__ void operator()(const f32x4 (&acc)[2][2][4][2], const pg8::Unit& u, int wr, int wc, int fr, int fq) const {
#pragma unroll
    for (int ai = 0; ai < 2; ++ai)
#pragma unroll
      for (int m = 0; m < 4; ++m) {
        const size_t rb = (size_t)(u.pm * 256 + ai * 128 + wr * 64 + m * 16 + fr) * D_ + u.pn * 256 + wc * 32 + 4 * fq;
#pragma unroll
        for (int bj = 0; bj < 2; ++bj)
#pragma unroll
          for (int n = 0; n < 2; ++n) {
            const size_t o = rb + bj * 128 + n * 16;
            const f32x4 hv = *(const f32x4*)(h1 + o);
            const u32x2 pj = *(const u32x2*)(projb + o);
            const f32x4 a = acc[ai][bj][m][n];
            f32x4 r;
            r[0] = ALPHA * hv[0] + bflo(pj[0]) / (1.f + __expf(-a[0])); r[1] = ALPHA * hv[1] + bfhi(pj[0]) / (1.f + __expf(-a[1]));
            r[2] = ALPHA * hv[2] + bflo(pj[1]) / (1.f + __expf(-a[2])); r[3] = ALPHA * hv[3] + bfhi(pj[1]) / (1.f + __expf(-a[3]));
            *(f32x4*)(out + o) = r;
          }
      }
  }
};

__device__ __forceinline__ int vblock(int bid, int nb) { return (nb & 7) ? bid : (bid & 7) * (nb >> 3) + (bid >> 3); }
__device__ __forceinline__ void tile_rc(int t, int Nt, int& tm, int& tn) {
  const int g = t / (8 * Nt), q = t % (8 * Nt);
  tn = q >> 3; tm = g * 8 + (q & 7);
}

__device__ void phase_inproj(const Params& p, char* smem, int bid, int nb) {
  {
    EpiInproj E{p.cqb(), p.ckvb(), p.Qf(), p.Kf(), p.VfT(), p.rss()};
    pg8::Gemm g{p.xb(), p.WinT(), T_, 4096, D_};
    pg8::StaticOrder S; S.init(T_, 4096, nb, bid);
    pg8::gemm_phase((PG8_LAS unsigned char*)smem, g, S, E, nullptr);
  }
  for (int t = vblock(bid, nb); t < 256; t += nb) {
    const int tm = t >> 3, ks = t & 7;
    f32x4 acc[2][4][4];
    gemm_core<2, 4>(p.xb() + ks * 256, D_, p.WinT() + ks * 256, D_, 256, tm * 256, 4096, smem, acc);
    const int tid = TID(), wid = tid >> 6, lane = tid & 63, wr = wid >> 2, wc = wid & 3, fr = lane & 15, fq = lane >> 4;
    if (wc == 0) {
#pragma unroll
      for (int h = 0; h < 2; ++h) {
        float* kd = p.krsum() + (size_t)(tm * 256 + wr * 128 + h * 64 + fq * 4) * 64 + fr;
#pragma unroll
        for (int m = 0; m < 4; ++m)
#pragma unroll
          for (int n = 0; n < 4; ++n)
#pragma unroll
            for (int j = 0; j < 4; ++j) atomicAdd(kd + (m * 16 + j) * 64 + n * 16, acc[h][m][n][j]);
      }
    }
  }
}

__device__ void phase_up(const Params& p, char* smem, int bid, int nb) {
  PG8_LAS unsigned char* lds = (PG8_LAS unsigned char*)smem;
  {
    EpiQup E{p.Qm(), p.rss()};
    pg8::Gemm g{p.cqb(), p.WuqT(), T_, 1536, 512};
    pg8::StaticOrder S; S.init(T_, 1536, nb, (bid + nb - 64) % nb);
    pg8::gemm_phase(lds, g, S, E, nullptr);
  }
  {
    EpiKVup E{p.Km(), p.VmT(), p.rss()};
    pg8::Gemm g{p.ckvb(), p.WukvT(), T_, 2048, 512};
    pg8::StaticOrder S; S.init(T_, 2048, nb, bid);
    pg8::gemm_phase(lds, g, S, E, nullptr);
  }
  {
    EpiProj E{p.projb()};
    pg8::Gemm g{p.pb(), p.WpT(), T_, 2048, 256};
    pg8::StaticOrder S; S.init(T_, 2048, nb, bid);
    pg8::gemm_phase(lds, g, S, E, nullptr);
  }
  for (int t = bid; t < 48; t += nb) {
    if (t >= 16) {
      const int r0 = (t - 16) * 256, tid = TID();
#pragma unroll 1
      for (int it = 0; it < 16; ++it) {
        const int pr = it * NT + tid, row = r0 + (pr >> 5), i = pr & 31, b = row >> 12, s = row & 4095;
        const float x1 = p.krsum()[(size_t)row * 64 + i], x2 = p.krsum()[(size_t)row * 64 + 32 + i];
        const float2 cs = p.cs()[(size_t)row * 32 + i];
        const u16 o1 = f2bf(x1 * cs.x - x2 * cs.y), o2 = f2bf(x1 * cs.y + x2 * cs.x);
#pragma unroll
        for (int hh = 0; hh < 8; ++hh) {
          u16* kd = p.Km() + ((size_t)(b * 8 + hh) * S_ + s) * 192 + 128;
          kd[i] = o1; kd[32 + i] = o2;
        }
      }
    } else {
      const int seq = t;
      if ((TID() >> 6) == 0) {
        const int lane = TID() & 63;
        const float* src = p.logf() + (size_t)seq * S_ + lane * 64;
        float* dst = p.Fk() + (size_t)seq * S_ + lane * 64;
        float sum = 0.f;
        for (int i = 0; i < 16; ++i) { const float4 v = *(const float4*)(src + i * 4); sum += v.x; sum += v.y; sum += v.z; sum += v.w; }
        float inc = sum;
#pragma unroll
        for (int d = 1; d < 64; d <<= 1) { const float o = __shfl_up(inc, d, 64); if (lane >= d) inc += o; }
        float run = inc - sum;
        for (int i = 0; i < 16; ++i) {
          const float4 v = *(const float4*)(src + i * 4); float4 o;
          run += v.x; o.x = run; run += v.y; o.y = run; run += v.z; o.z = run; run += v.w; o.w = run;
          *(float4*)(dst + i * 4) = o;
        }
      }
    }
  }
}

#ifdef ATTN_NAIVE
__device__ void phase_attn_naive(const Params& p, char* smem, int bid, int nb) {
  const int tid = TID(), lane = tid & 63, wid = tid >> 6;
  const int per = NB_ * 8 * S_, nrows = 2 * per;
  for (int r = bid * 4 + wid; r < nrows; r += nb * 4) {
    const int type = r / per, rr = r % per, bh = rr / S_, s = rr % S_;
    const int DQ = type ? 128 : 192;
    const u16* Q = type ? p.Qf() + ((size_t)bh * S_ + s) * 128 : p.Qm() + ((size_t)bh * S_ + s) * 192;
    const u16* Kb = type ? p.Kf() + (size_t)bh * S_ * 128 : p.Km() + (size_t)bh * S_ * 192;
    const u16* VT = (type ? p.VfT() : p.VmT()) + (size_t)bh * 128 * S_;
    const float* F = p.Fk() + (size_t)bh * S_;
    const float scale = type ? 0.08838834764831845f : 0.07216878364870322f;
    float m = -1e30f, l = 0.f;
    float acc[128];
#pragma unroll
    for (int d = 0; d < 128; ++d) acc[d] = 0.f;
    const float fqv = type ? F[s] : 0.f;
    for (int k0 = 0; k0 <= s; k0 += 64) {
      const int key = k0 + lane; const bool valid = key <= s; const int keyc = valid ? key : s;
      const u16* kr = Kb + (size_t)keyc * DQ;
      float sc = 0.f;
      for (int d = 0; d < DQ; d += 8) {
        const u32x4 kv = *(const u32x4*)(kr + d), qv = *(const u32x4*)(Q + d);
#pragma unroll
        for (int w = 0; w < 4; ++w) sc += bflo(kv[w]) * bflo(qv[w]) + bfhi(kv[w]) * bfhi(qv[w]);
      }
      sc *= scale;
      if (type) sc += fqv - F[keyc];
      if (!valid) sc = -1e30f;
      const float mx = wave_max(sc), mn = fmaxf(m, mx), alpha = __expf(m - mn);
      const float pr = valid ? __expf(sc - mn) : 0.f;
      m = mn; l = l * alpha + pr;
#pragma unroll
      for (int d = 0; d < 128; ++d) acc[d] = acc[d] * alpha + pr * bf2f(VT[(size_t)d * S_ + keyc]);
    }
    const float inv = 1.f / wave_sum(l);
    float o0 = 0.f, o1 = 0.f;
#pragma unroll
    for (int d = 0; d < 128; ++d) {
      const float o = wave_sum(acc[d]) * inv;
      if (lane == (d & 63)) { if (d < 64) o0 = o; else o1 = o; }
    }
    const int b = bh >> 3, hh = bh & 7;
    u16* od = p.omix() + ((size_t)(b * S_ + s)) * 2048 + type * 1024 + hh * 128;
    od[lane] = f2bf(o0); od[64 + lane] = f2bf(o1);
  }
}

#endif
typedef float f32x16 __attribute__((ext_vector_type(16)));
template <int TYPE>
__device__ __forceinline__ void attn_item(const Params& p, char* smem, int bh, int qb) {
  constexpr int DQK = TYPE ? 128 : 192, NKS = DQK / 16, KSTR = DQK * 2 + 16, VSTR = 128;
  constexpr int KCH = DQK / 8, NKL = 64 * KCH / NT;
  constexpr float C2 = (TYPE ? 0.08838834764831845f : 0.07216878364870322f) * 1.4426950408889634f;
  char* sK = smem; char* sV = smem + 51200; float* sF = (float*)(smem + 51200 + 32768);
  const int tid = TID(), lane = tid & 63, wid = tid >> 6, c = lane & 31, hi = lane >> 5;
  const u16* Qb = (TYPE ? p.Qf() : p.Qm()) + (size_t)bh * S_ * DQK;
  const u16* Kb = (TYPE ? p.Kf() : p.Km()) + (size_t)bh * S_ * DQK;
  const u16* Vb = (TYPE ? p.VfT() : p.VmT()) + (size_t)bh * 128 * S_;
  const float* Fb = p.Fk() + (size_t)bh * S_;
  const int qrow = qb * 256 + wid * 32;
  bf16x8 qf[NKS];
#pragma unroll
  for (int ks = 0; ks < NKS; ++ks) qf[ks] = *(const bf16x8*)(Qb + (size_t)(qrow + c) * DQK + ks * 16 + hi * 8);
  if (TYPE == 0) {
    const float2* csr = p.cs() + (size_t)((bh >> 3) * S_ + qrow + c) * 32;
#pragma unroll
    for (int kk = 0; kk < 2; ++kk) {
      u32x4 x1 = *reinterpret_cast<u32x4*>(&qf[(NKS - 4) + kk]), x2 = *reinterpret_cast<u32x4*>(&qf[(NKS - 2) + kk]);
#pragma unroll
      for (int w = 0; w < 4; ++w) {
        const float4 cs = *(const float4*)(csr + 16 * kk + 8 * hi + 2 * w);
        const float a0 = bflo(x1[w]), a1 = bfhi(x1[w]), b0 = bflo(x2[w]), b1 = bfhi(x2[w]);
        x1[w] = pk2(a0 * cs.x - b0 * cs.y, a1 * cs.z - b1 * cs.w);
        x2[w] = pk2(a0 * cs.y + b0 * cs.x, a1 * cs.w + b1 * cs.z);
      }
      qf[(NKS - 4) + kk] = *reinterpret_cast<bf16x8*>(&x1); qf[(NKS - 2) + kk] = *reinterpret_cast<bf16x8*>(&x2);
    }
  }
  f32x16 o[4];
#pragma unroll
  for (int db = 0; db < 4; ++db)
#pragma unroll
    for (int r = 0; r < 16; ++r) o[db][r] = 0.f;
  float m = -1e30f, l = 0.f;
  const int ntiles = 4 * qb + 4;
  u32x4 kreg[NKL];
  float4 freg = make_float4(0.f, 0.f, 0.f, 0.f);
  const unsigned koff = (unsigned)tid * 16u;
  auto load_k = [&](int kt) {
    const char* kb = (const char*)(Kb + (size_t)kt * 64 * DQK);
#pragma unroll
    for (int i = 0; i < NKL; ++i) kreg[i] = *(const u32x4*)(kb + i * 8192 + koff);
    if (TYPE) { if (tid < 16) freg = *(const float4*)(Fb + kt * 64 + tid * 4); }
  };
  const unsigned voff = (unsigned)((((tid >> 3) * S_) + (((tid & 7) ^ ((tid >> 4) & 7)) * 8)) * 2);
  auto load_v = [&](int kt) {
    const char* vb = (const char*)(Vb + kt * 64);
    char* dst = sV + (kt & 1) * 16384 + tid * 16;
#pragma unroll
    for (int i = 0; i < 2; ++i)
      __builtin_amdgcn_global_load_lds((const unsigned*)(vb + (size_t)i * 64 * S_ * 2 + voff), (unsigned*)(dst + i * 8192), 16, 0, 0);
  };
  auto store_tile = [&](int kt) {
    char* sKw = sK + (kt & 1) * 25600;
#pragma unroll
    for (int i = 0; i < NKL; ++i) { const int ch = tid + NT * i, key = ch / KCH, dc = ch % KCH; *(u32x4*)(sKw + key * KSTR + dc * 16) = kreg[i]; }
    if (TYPE) { if (tid < 16) { const float L2E = 1.4426950408889634f; *(float4*)(sF + (kt & 1) * 64 + tid * 4) = make_float4(freg.x * L2E, freg.y * L2E, freg.z * L2E, freg.w * L2E); } }
  };
  const int krow = (c & 19) | ((c & 4) << 1) | ((c & 8) >> 1);
  const char* ka0 = sK + krow * KSTR + hi * 16;
  const char* ka1 = ka0 + 32 * KSTR;
  const int vx = (c >> 1) & 7;
  int vo[2][2];
#pragma unroll
  for (int kb = 0; kb < 2; ++kb)
#pragma unroll
    for (int s2 = 0; s2 < 2; ++s2) vo[kb][s2] = c * VSTR + (((4 * kb + 2 * s2 + hi) ^ vx) * 16);
  load_k(0); load_v(0);
  store_tile(0);
#pragma unroll 1
  for (int kt = 0; kt < ntiles; ++kt) {
    asm volatile("s_waitcnt vmcnt(0) lgkmcnt(0)" ::: "memory");
    __syncthreads();
    if (kt + 1 < ntiles) { load_k(kt + 1); load_v(kt + 1); }
    const int k0 = kt * 64;
    const char* sVc = sV + (kt & 1) * 16384;
    const int kbo = (kt & 1) * 25600;
    const float* sFc = sF + (kt & 1) * 64;
    if (k0 <= qrow + 31) {
      f32x16 p0, p1;
#pragma unroll
      for (int r = 0; r < 16; ++r) { p0[r] = 0.f; p1[r] = 0.f; }
#pragma unroll
      for (int ks = 0; ks < NKS; ++ks) {
        const bf16x8 a0 = *(const bf16x8*)(ka0 + kbo + ks * 32), a1 = *(const bf16x8*)(ka1 + kbo + ks * 32);
        p0 = __builtin_amdgcn_mfma_f32_32x32x16_bf16(a0, qf[ks], p0, 0, 0, 0);
        p1 = __builtin_amdgcn_mfma_f32_32x32x16_bf16(a1, qf[ks], p1, 0, 0, 0);
      }
      if (TYPE) {
#pragma unroll
        for (int s = 0; s < 2; ++s) {
          const float4 f0 = *(const float4*)(sFc + 16 * s + 8 * hi), f1 = *(const float4*)(sFc + 16 * s + 8 * hi + 4);
          const float4 g0 = *(const float4*)(sFc + 32 + 16 * s + 8 * hi), g1 = *(const float4*)(sFc + 32 + 16 * s + 8 * hi + 4);
          p0[8 * s + 0] = p0[8 * s + 0] * C2 - f0.x; p0[8 * s + 1] = p0[8 * s + 1] * C2 - f0.y; p0[8 * s + 2] = p0[8 * s + 2] * C2 - f0.z; p0[8 * s + 3] = p0[8 * s + 3] * C2 - f0.w;
          p0[8 * s + 4] = p0[8 * s + 4] * C2 - f1.x; p0[8 * s + 5] = p0[8 * s + 5] * C2 - f1.y; p0[8 * s + 6] = p0[8 * s + 6] * C2 - f1.z; p0[8 * s + 7] = p0[8 * s + 7] * C2 - f1.w;
          p1[8 * s + 0] = p1[8 * s + 0] * C2 - g0.x; p1[8 * s + 1] = p1[8 * s + 1] * C2 - g0.y; p1[8 * s + 2] = p1[8 * s + 2] * C2 - g0.z; p1[8 * s + 3] = p1[8 * s + 3] * C2 - g0.w;
          p1[8 * s + 4] = p1[8 * s + 4] * C2 - g1.x; p1[8 * s + 5] = p1[8 * s + 5] * C2 - g1.y; p1[8 * s + 6] = p1[8 * s + 6] * C2 - g1.z; p1[8 * s + 7] = p1[8 * s + 7] * C2 - g1.w;
        }
      } else {
#pragma unroll
        for (int r = 0; r < 16; ++r) { p0[r] *= C2; p1[r] *= C2; }
      }
      if (k0 + 63 > qrow) {
        const int lim = qrow + c - k0 - 8 * hi;
        const float NEG = -__builtin_inff();
#pragma unroll
        for (int r = 0; r < 16; ++r) {
          const int kb = 16 * (r >> 3) + (r & 7);
          if (kb > lim) p0[r] = NEG;
          if (kb + 32 > lim) p1[r] = NEG;
        }
      }
      float mx = p0[0];
#pragma unroll
      for (int r = 1; r < 16; ++r) mx = fmaxf(mx, p0[r]);
#pragma unroll
      for (int r = 0; r < 16; ++r) mx = fmaxf(mx, p1[r]);
      {
        auto rr = __builtin_amdgcn_permlane32_swap(__float_as_uint(mx), __float_as_uint(mx), false, false);
        mx = fmaxf(__uint_as_float(rr[0]), __uint_as_float(rr[1]));
      }
      const float mn = fmaxf(m, mx);
      const float alpha = __builtin_amdgcn_exp2f(m - mn);
      m = mn;
      if (!__all(alpha == 1.f)) {
#pragma unroll
        for (int db = 0; db < 4; ++db)
#pragma unroll
          for (int r = 0; r < 16; ++r) o[db][r] *= alpha;
      }
      float ps = 0.f;
#pragma unroll
      for (int r = 0; r < 16; ++r) { p0[r] = __builtin_amdgcn_exp2f(p0[r] - mn); p1[r] = __builtin_amdgcn_exp2f(p1[r] - mn); ps += p0[r] + p1[r]; }
      l = l * alpha + ps;
      bf16x8 pa[2][2];
#pragma unroll
      for (int s = 0; s < 2; ++s) {
        u32x4 w0 = {pk2(p0[8 * s + 0], p0[8 * s + 1]), pk2(p0[8 * s + 2], p0[8 * s + 3]), pk2(p0[8 * s + 4], p0[8 * s + 5]), pk2(p0[8 * s + 6], p0[8 * s + 7])};
        u32x4 w1 = {pk2(p1[8 * s + 0], p1[8 * s + 1]), pk2(p1[8 * s + 2], p1[8 * s + 3]), pk2(p1[8 * s + 4], p1[8 * s + 5]), pk2(p1[8 * s + 6], p1[8 * s + 7])};
        pa[0][s] = *reinterpret_cast<bf16x8*>(&w0); pa[1][s] = *reinterpret_cast<bf16x8*>(&w1);
      }
#pragma unroll
      for (int db = 0; db < 4; ++db)
#pragma unroll
        for (int kb = 0; kb < 2; ++kb)
#pragma unroll
          for (int s = 0; s < 2; ++s) {
            const bf16x8 av = *(const bf16x8*)(sVc + db * 32 * VSTR + vo[kb][s]);
            o[db] = __builtin_amdgcn_mfma_f32_32x32x16_bf16(av, pa[kb][s], o[db], 0, 0, 0);
          }
    }
    if (kt + 1 < ntiles) store_tile(kt + 1);
  }
  {
    auto rr = __builtin_amdgcn_permlane32_swap(__float_as_uint(l), __float_as_uint(l), false, false);
    const float inv = 1.f / (__uint_as_float(rr[0]) + __uint_as_float(rr[1]));
    const int b = bh >> 3, hh = bh & 7;
    u16* od = p.omix() + ((size_t)(b * S_ + qrow + c)) * 2048 + TYPE * 1024 + hh * 128 + 4 * hi;
#pragma unroll
    for (int db = 0; db < 4; ++db)
#pragma unroll
      for (int g = 0; g < 4; ++g)
        *(u32x2*)(od + 32 * db + 8 * g) = u32x2{pk2(o[db][4 * g] * inv, o[db][4 * g + 1] * inv), pk2(o[db][4 * g + 2] * inv, o[db][4 * g + 3] * inv)};
  }
}

__device__ void phase_attn(const Params& p, char* smem, int bid, int nb) {
  int* sItem = (int*)(smem + 90000);
  const int x = bid & 7;
  unsigned* q = p.ctr() + 32 + x;
  for (;;) {
    __syncthreads();
    if (TID() == 0) *sItem = (int)atomicAdd(q, 1u);
    __syncthreads();
    const int item = *sItem;
    if (item >= 64) break;
    const int qb = 15 - (item >> 2), r = item & 3, type = r >> 1, bh = x + 8 * (r & 1);
    if (type == 0) attn_item<0>(p, smem, bh, qb); else attn_item<1>(p, smem, bh, qb);
  }
  unsigned* qc = p.ctr() + 48;
  for (;;) {
    __syncthreads();
    if (TID() == 0) *sItem = (int)atomicAdd(qc, 1u);
    __syncthreads();
    const int chunk = *sItem;
    if (chunk >= 512) break;
    quant_chunk(p, chunk);
  }
}

__device__ void phase_outproj(const Params& p, char* smem, int bid, int nb) {
  EpiOut E{p.x, p.y1()};
  pg8::Gemm g{p.omix(), p.WoutT(), T_, D_, D_};
  pg8::StaticOrder S; S.init(T_, D_, nb, bid);
  pg8::gemm_phase((PG8_LAS unsigned char*)smem, g, S, E, nullptr);
}

__device__ void phase_ln1(const Params& p, int bid, int nb) {
  const int lane = TID() & 63, wid = TID() >> 6;
  for (int t = bid * 8 + wid; t < T_; t += nb * 8) {
    float* row = p.y1() + (size_t)t * D_;
    float4 v[8];
    float sum = 0.f;
#pragma unroll
    for (int i = 0; i < 8; ++i) { v[i] = *(const float4*)(row + (i * 64 + lane) * 4); sum += (v[i].x + v[i].y) + (v[i].z + v[i].w); }
    const float mu = wave_sum(sum) * (1.f / D_);
    float sq = 0.f;
#pragma unroll
    for (int i = 0; i < 8; ++i) {
      v[i].x -= mu; v[i].y -= mu; v[i].z -= mu; v[i].w -= mu;
      sq += (v[i].x * v[i].x + v[i].y * v[i].y) + (v[i].z * v[i].z + v[i].w * v[i].w);
    }
    const float rstd = rsqrtf(wave_sum(sq) * (1.f / D_) + EPS);
#pragma unroll
    for (int i = 0; i < 8; ++i) {
      const int c = (i * 64 + lane) * 4;
      const float4 g = *(const float4*)(p.ln1_g + c), bb = *(const float4*)(p.ln1_b + c);
      float4 o; o.x = v[i].x * rstd * g.x + bb.x; o.y = v[i].y * rstd * g.y + bb.y; o.z = v[i].z * rstd * g.z + bb.z; o.w = v[i].w * rstd * g.w + bb.w;
      *(float4*)(row + c) = o;
      *(u32x2*)(p.h1b() + (size_t)t * D_ + c) = u32x2{pk2(o.x, o.y), pk2(o.z, o.w)};
    }
  }
}

__device__ __forceinline__ void ins16(unsigned (&t)[16], unsigned x) {
#pragma unroll
  for (int i = 0; i < 16; ++i) { const unsigned hi = t[i] > x ? t[i] : x; x = t[i] > x ? x : t[i]; t[i] = hi; }
}
__device__ __forceinline__ void ins16p(unsigned (&ck)[16], int (&ce)[16], unsigned x, int xe) {
#pragma unroll
  for (int i = 0; i < 16; ++i) {
    const bool sw = x > ck[i];
    const unsigned nk = sw ? x : ck[i], nx = sw ? ck[i] : x;
    const int ne = sw ? xe : ce[i], nxe = sw ? ce[i] : xe;
    ck[i] = nk; x = nx; ce[i] = ne; xe = nxe;
  }
}
__device__ __forceinline__ float unordkey(unsigned k) { return __uint_as_float((k & 0x80000000u) ? (k & 0x7fffffffu) : ~k); }

__device__ __forceinline__ void score_block(const u16* kH, const u16* kL, const bf16x8 (&qh)[4], const bf16x8 (&ql)[4], int hi, unsigned (&t)[16]) {
#pragma unroll
  for (int i = 0; i < 16; ++i) t[i] = 0u;
#pragma unroll 1
  for (int kb = 0; kb < 4; ++kb) {
    f32x16 sc;
#pragma unroll
    for (int r = 0; r < 16; ++r) sc[r] = 0.f;
#pragma unroll
    for (int ks = 0; ks < 4; ++ks) {
      const bf16x8 ah = *(const bf16x8*)(kH + kb * 32 * 64 + ks * 16), al = *(const bf16x8*)(kL + kb * 32 * 64 + ks * 16);
      sc = __builtin_amdgcn_mfma_f32_32x32x16_bf16(ah, qh[ks], sc, 0, 0, 0);
      sc = __builtin_amdgcn_mfma_f32_32x32x16_bf16(ah, ql[ks], sc, 0, 0, 0);
      sc = __builtin_amdgcn_mfma_f32_32x32x16_bf16(al, qh[ks], sc, 0, 0, 0);
    }
    const unsigned base = (unsigned)(127 - 32 * kb) - 4u * (unsigned)hi;
#pragma unroll
    for (int r = 0; r < 16; ++r) ins16(t, (ordkey(sc[r]) & ~127u) | (base - (unsigned)((r & 3) + 8 * (r >> 2))));
  }
  unsigned other[16];
#pragma unroll
  for (int i = 0; i < 16; ++i) {
    auto rr = __builtin_amdgcn_permlane32_swap(t[i], t[i], false, false);
    other[i] = hi ? rr[0] : rr[1];
  }
#pragma unroll 1
  for (int i = 0; i < 16; ++i) {
    unsigned x = other[0];
#pragma unroll
    for (int k = 1; k < 16; ++k) x = (i == k) ? other[k] : x;
    ins16(t, x);
  }
}

__device__ __forceinline__ void route_tile(const Params& p, char* smem, f32x4 (&acc)[4][4], int tm, int h) {
  const int tid = TID(), wid = tid >> 6, lane = tid & 63, wr = wid >> 1, wc = wid & 1, fr = lane & 15, fq = lane >> 4;
  __syncthreads();
  float* Qw = (float*)smem + wid * (64 * 65);
#pragma unroll
  for (int m = 0; m < 4; ++m)
#pragma unroll
    for (int n = 0; n < 4; ++n)
#pragma unroll
      for (int j = 0; j < 4; ++j) Qw[(m * 16 + fq * 4 + j) * 65 + n * 16 + fr] = acc[m][n][j];
  asm volatile("s_waitcnt lgkmcnt(0)" ::: "memory");
  const int c = lane & 31, hi = lane >> 5;
  bf16x8 qh[2][4], ql[2][4];
#pragma unroll
  for (int tb = 0; tb < 2; ++tb)
#pragma unroll
    for (int ks = 0; ks < 4; ++ks) {
      float v[8]; unsigned wh[4], wl[4];
#pragma unroll
      for (int j = 0; j < 8; ++j) v[j] = Qw[(tb * 32 + c) * 65 + 16 * ks + 8 * hi + j];
#pragma unroll
      for (int w = 0; w < 4; ++w) {
        wh[w] = pk2(v[2 * w], v[2 * w + 1]);
        wl[w] = pk2(v[2 * w] - bflo(wh[w]), v[2 * w + 1] - bfhi(wh[w]));
      }
      u32x4 uh = {wh[0], wh[1], wh[2], wh[3]}, ul = {wl[0], wl[1], wl[2], wl[3]};
      qh[tb][ks] = *reinterpret_cast<bf16x8*>(&uh); ql[tb][ks] = *reinterpret_cast<bf16x8*>(&ul);
    }
  const u16* kH = p.keyH() + ((size_t)(wc * 8 + h) * 128 + c) * 64 + 8 * hi;
  const u16* kL = p.keyL() + ((size_t)(wc * 8 + h) * 128 + c) * 64 + 8 * hi;
  unsigned t0[16], t1[16];
  score_block(kH, kL, qh[0], ql[0], hi, t0);
  score_block(kH, kL, qh[1], ql[1], hi, t1);
  unsigned t[16];
#pragma unroll
  for (int i = 0; i < 16; ++i) t[i] = hi ? t1[i] : t0[i];
  __syncthreads();
  unsigned* L = (unsigned*)smem;
#pragma unroll
  for (int r = 0; r < 16; ++r) L[(wc * 16 + r) * 256 + wr * 64 + lane] = t[r];
  __syncthreads();
  if (wid < 4) {
    const int tok = wid * 64 + lane;
    unsigned ck[16]; int ce[16];
#pragma unroll
    for (int i = 0; i < 16; ++i) { ck[i] = 0u; ce[i] = 0; }
#pragma unroll 1
    for (int a = 0; a < 16; ++a) {
      const unsigned ka = L[a * 256 + tok];
      const int i1a = (127 - (int)(ka & 127u)) * 128; const float v1a = unordkey(ka & ~127u);
      const int nbm1 = (int)((0x1112347FULL >> (4 * a)) & 15ULL);
#pragma unroll 1
      for (int b = 0; b <= nbm1; ++b) {
        const unsigned kb = L[(16 + b) * 256 + tok];
        const int i2b = 127 - (int)(kb & 127u); const float v2b = unordkey(kb & ~127u);
        ins16p(ck, ce, ordkey(v1a + v2b), i1a + i2b);
      }
    }
    float ex[16], sum = 0.f;
    const float mx = unordkey(ck[0]);
#pragma unroll
    for (int r = 0; r < 16; ++r) { ex[r] = __expf(unordkey(ck[r]) - mx); sum += ex[r]; }
    const float inv = 1.f / sum;
    const size_t o = ((size_t)(tm * 256 + tok) * 8 + h) * 16;
    int* ed = p.eidxG() + o; float* gd = p.gateG() + o;
#pragma unroll
    for (int r = 0; r < 16; r += 4) {
      *(int4*)(ed + r) = make_int4(ce[r], ce[r + 1], ce[r + 2], ce[r + 3]);
      *(float4*)(gd + r) = make_float4(ex[r] * inv, ex[r + 1] * inv, ex[r + 2] * inv, ex[r + 3] * inv);
    }
  }
}

__device__ void phase_mid(const Params& p, char* smem, int bid, int nb) {
  {
    EpiGate E{p.y1(), p.projb(), p.out};
    pg8::Gemm g{p.h1b(), p.WgT(), T_, D_, D_};
    pg8::StaticOrder S; S.init(T_, D_, nb, bid);
    pg8::gemm_phase((PG8_LAS unsigned char*)smem, g, S, E, nullptr);
  }
  for (int t = vblock(bid, nb); t < 32 * 8; t += nb) {
    int tm, tn; tile_rc(t, 8, tm, tn);
    f32x4 acc[1][4][4];
    gemm_core<4, 2>(p.h1b(), D_, p.WpqT(), D_, D_, tm * 256, tn * 128, smem, acc);
    route_tile(p, smem, acc[0], tm, tn);
  }
}

__device__ __forceinline__ float gelu_exact(float a) {
  const float x = fabsf(a) * 0.7071067811865476f;
  const float t = __builtin_amdgcn_rcpf(1.f + 0.3275911f * x);
  const float poly = t * (0.254829592f + t * (-0.284496736f + t * (1.421413741f + t * (-1.453152027f + t * 1.061405429f))));
  const float er = 1.f - poly * __expf(-x * x);
  return 0.5f * a * (1.f + (a < 0.f ? -er : er));
}

template <int NPER, int IDXMASK>
__device__ __forceinline__ int top16(unsigned (&k)[NPER], int lane) {
  int mine = 0;
#pragma unroll 1
  for (int r = 0; r < 16; ++r) {
    unsigned loc = k[0];
#pragma unroll
    for (int i = 1; i < NPER; ++i) loc = loc > k[i] ? loc : k[i];
    const unsigned best = wave_umax(loc);
#pragma unroll
    for (int i = 0; i < NPER; ++i) if (k[i] == best) k[i] = 0u;
    if (lane == r) mine = IDXMASK - (int)(best & (unsigned)IDXMASK);
  }
  return mine;
}

__device__ void phase_peer(const Params& p, char* smem, int bid, int nb) {
  const int tid = TID(), lane = tid & 63, wid = tid >> 6;
  float* qs = (float*)smem;
  float* sc = (float*)(smem + 8192);
  int* eidx = (int*)(smem + 24576);
  float* gts = (float*)(smem + 40960);
  for (int it = bid; it < T_ / 32; it += nb) {
    const int t0 = it * 32;
#pragma unroll
    for (int i = 0; i < 2; ++i) {
      const int idx = (i * NT + tid) * 4;
      *(int4*)(eidx + idx) = *(const int4*)(p.eidxG() + (size_t)t0 * 128 + idx);
      *(float4*)(gts + idx) = *(const float4*)(p.gateG() + (size_t)t0 * 128 + idx);
    }
    __syncthreads();
    for (int ti = 0; ti < 4; ++ti) {
      const int tok = wid * 4 + ti, t = t0 + tok;
      typedef float f32x32 __attribute__((ext_vector_type(32)));
      typedef unsigned u32x6 __attribute__((ext_vector_type(6)));
      float hreg[32];
      f32x32 o;
#pragma unroll
      for (int q = 0; q < 4; ++q) {
        const u32x4 hv = *(const u32x4*)(p.h1b() + (size_t)t * D_ + lane * 32 + q * 8);
#pragma unroll
        for (int w = 0; w < 4; ++w) { hreg[q * 8 + 2 * w] = bflo(hv[w]); hreg[q * 8 + 2 * w + 1] = bfhi(hv[w]); }
      }
#pragma unroll
      for (int i = 0; i < 32; ++i) o[i] = 0.f;
      const float* Us = p.Us(); const float* Vs = p.Vs();
      const unsigned char* Uq = p.Uq() + lane * 24;
      const int* ep = eidx + tok * 128; const float* gp = gts + tok * 128;
      u32x4 uA4[2], vA4[2], uB4[2], vB4[2]; u32x2 uA2[2], vA2[2], uB2[2], vB2[2];
      float gA[2], suA[2], svA[2], gB[2], suB[2], svB[2];
#define PEER_LOAD(U4, U2, V4, V2, G, SU, SV, J0)                                                        \
      _Pragma("unroll") for (int jj = 0; jj < 2; ++jj) {                                                \
        const int e = __builtin_amdgcn_readfirstlane(ep[(J0) + jj]);                                    \
        G[jj] = gp[(J0) + jj]; SU[jj] = Us[e]; SV[jj] = Vs[e];                                          \
        const unsigned char* up = Uq + (size_t)e * 3072; const unsigned char* vp = up + 1536;           \
        U2[jj] = *(const u32x2*)(up); U4[jj] = *(const u32x4*)(up + 8);                                 \
        V2[jj] = *(const u32x2*)(vp); V4[jj] = *(const u32x4*)(vp + 8);                                 \
      }
#define PEER_COMPUTE(U4, U2, V4, V2, G, SU, SV)                                                         \
      _Pragma("unroll") for (int jj = 0; jj < 2; ++jj) {                                                \
        const u32x6 uw = {U2[jj][0], U2[jj][1], U4[jj][0], U4[jj][1], U4[jj][2], U4[jj][3]};            \
        const f32x32 ud = __builtin_amdgcn_cvt_scalef32_pk32_f32_fp6(uw, 1.0f);                         \
        float d0 = 0.f, d1 = 0.f, d2 = 0.f, d3 = 0.f;                                                   \
        _Pragma("unroll") for (int i = 0; i < 32; i += 4) {                                             \
          d0 += ud[i] * hreg[i]; d1 += ud[i + 1] * hreg[i + 1]; d2 += ud[i + 2] * hreg[i + 2]; d3 += ud[i + 3] * hreg[i + 3]; \
        }                                                                                               \
        const float av = wave_sum((d0 + d1) + (d2 + d3)) * SU[jj];                                      \
        const float act = gelu_exact(av) * G[jj] * SV[jj];                                              \
        const u32x6 vw = {V2[jj][0], V2[jj][1], V4[jj][0], V4[jj][1], V4[jj][2], V4[jj][3]};            \
        const f32x32 vd = __builtin_amdgcn_cvt_scalef32_pk32_f32_fp6(vw, 1.0f);                         \
        o += vd * act;                                                                                  \
      }
      PEER_LOAD(uA4, uA2, vA4, vA2, gA, suA, svA, 0)
#pragma unroll 1
      for (int j0 = 0; j0 < 128; j0 += 4) {
        PEER_LOAD(uB4, uB2, vB4, vB2, gB, suB, svB, j0 + 2)
        PEER_COMPUTE(uA4, uA2, vA4, vA2, gA, suA, svA)
        if (j0 + 4 < 128) { PEER_LOAD(uA4, uA2, vA4, vA2, gA, suA, svA, j0 + 4) }
        PEER_COMPUTE(uB4, uB2, vB4, vB2, gB, suB, svB)
      }
#undef PEER_LOAD
#undef PEER_COMPUTE
      float* orow = p.out + (size_t)t * D_ + lane * 32;
      float sum = 0.f;
#pragma unroll
      for (int q = 0; q < 8; ++q) {
        const float4 r0 = *(const float4*)(orow + q * 4);
        o[q * 4 + 0] += r0.x; o[q * 4 + 1] += r0.y; o[q * 4 + 2] += r0.z; o[q * 4 + 3] += r0.w;
      }
#pragma unroll
      for (int i = 0; i < 32; ++i) sum += o[i];
      const float mu = wave_sum(sum) * (1.f / D_);
      float sq = 0.f;
#pragma unroll
      for (int i = 0; i < 32; ++i) { o[i] -= mu; sq += o[i] * o[i]; }
      const float rstd = rsqrtf(wave_sum(sq) * (1.f / D_) + EPS);
#pragma unroll
      for (int q = 0; q < 8; ++q) {
        const int col = lane * 32 + q * 4;
        const float4 g0 = *(const float4*)(p.ln2_g + col), b0 = *(const float4*)(p.ln2_b + col);
        float4 w0;
        w0.x = o[q * 4 + 0] * rstd * g0.x + b0.x; w0.y = o[q * 4 + 1] * rstd * g0.y + b0.y;
        w0.z = o[q * 4 + 2] * rstd * g0.z + b0.z; w0.w = o[q * 4 + 3] * rstd * g0.w + b0.w;
        *(float4*)(orow + q * 4) = w0;
      }
    }
    __syncthreads();
  }
}

template <int PH>
__device__ __forceinline__ void run_phase(const Params& p, char* smem, int bid, int nb) {
  if constexpr (PH == 0) phase_prep(p, smem, bid, nb);
  if constexpr (PH == 1) phase_inproj(p, smem, bid, nb);
  if constexpr (PH == 2) phase_up(p, smem, bid, nb);
#ifdef ATTN_NAIVE
  if constexpr (PH == 3) phase_attn_naive(p, smem, bid, nb);
#else
  if constexpr (PH == 3) phase_attn(p, smem, bid, nb);
#endif
  if constexpr (PH == 4) phase_outproj(p, smem, bid, nb);
  if constexpr (PH == 5) phase_ln1(p, bid, nb);
  if constexpr (PH == 6) phase_mid(p, smem, bid, nb);
  if constexpr (PH == 7) phase_peer(p, smem, bid, nb);
}

template <int PH>
__global__ void __launch_bounds__(NT, 2) phase_kernel(Params p) {
  __shared__ __attribute__((aligned(16))) char smem[SMEM_BYTES];
  run_phase<PH>(p, smem, blockIdx.x, gridDim.x);
}

#define BW_CENSUS(j) (256 + (j) * 32)
#define BW_XSUB(j) (256 + 512 + (j) * 32)
#define BW_XGEN(j) (256 + 1024 + (j) * 32)
#define BW_TOP (256 + 1536)
#define BW_TOPGEN (256 + 1568)
__device__ __forceinline__ unsigned bw_ld(unsigned* p) { return __hip_atomic_load(p, __ATOMIC_RELAXED, __HIP_MEMORY_SCOPE_AGENT); }
__device__ __forceinline__ unsigned bw_add(unsigned* p, unsigned v) { return __hip_atomic_fetch_add(p, v, __ATOMIC_RELAXED, __HIP_MEMORY_SCOPE_AGENT); }
__device__ __forceinline__ unsigned xcc_id() { return (unsigned)__builtin_amdgcn_s_getreg((3 << 11) | 20) & 0xFu; }

__device__ __forceinline__ void grid_barrier(unsigned* bar, unsigned* st  ) {
  asm volatile("s_waitcnt vmcnt(0)" ::: "memory");
  __syncthreads();
  if (threadIdx.x == 0) {
    __builtin_amdgcn_s_waitcnt(0);
    const unsigned x = xcc_id();
    unsigned nloc = st[0], nx = st[1];
    if (nloc == 0u) {
      const unsigned G = gridDim.x;
      for (;;) {
        unsigned sum = 0u, cnt = 0u, mine = 0u;
#pragma unroll
        for (unsigned j = 0; j < 16; ++j) { const unsigned c = bw_ld(&bar[BW_CENSUS(j)]); sum += c; cnt += (c > 0u) ? 1u : 0u; mine = (j == x) ? c : mine; }
        nloc = mine; nx = cnt;
        if (sum == G) break;
        __builtin_amdgcn_s_sleep(1);
      }
      st[0] = nloc; st[1] = nx;
    }
    const unsigned old = bw_add(&bar[BW_XSUB(x)], 1u);
    const unsigned gen = old / nloc;
    if (old + 1u == (gen + 1u) * nloc) {
      __builtin_amdgcn_fence(__ATOMIC_RELEASE, "agent");
      asm volatile("s_waitcnt vmcnt(0)" ::: "memory");
      const unsigned og = bw_add(&bar[BW_TOP], 1u);
      const unsigned tg = og / nx;
      if (og + 1u == (tg + 1u) * nx) bw_add(&bar[BW_TOPGEN], 1u);
      else while (bw_ld(&bar[BW_TOPGEN]) == tg) __builtin_amdgcn_s_sleep(1);
      __builtin_amdgcn_fence(__ATOMIC_ACQUIRE, "agent");
      bw_add(&bar[BW_XGEN(x)], 1u);
      asm volatile("s_waitcnt vmcnt(0)" ::: "memory");
    } else {
      while (bw_ld(&bar[BW_XGEN(x)]) == gen) __builtin_amdgcn_s_sleep(1);
      __builtin_amdgcn_fence(__ATOMIC_ACQUIRE, "agent");
      asm volatile("s_waitcnt vmcnt(0)" ::: "memory");
    }
  }
  __syncthreads();
}

#if SINGLE_LAUNCH
typedef const __attribute__((address_space(4))) unsigned long long* kargp_t;
static_assert(sizeof(Params) % 8 == 0, "Params must be a pack of 8-byte fields");
#define RUN_PHASE(N) run_phase<N>(p_, smem, bid, nb);
__global__ void __launch_bounds__(NT, 2) fwd_kernel(Params p_) {
  __shared__ __attribute__((aligned(16))) char smem[SMEM_BYTES + 64];
  const int bid = blockIdx.x, nb = gridDim.x;
  unsigned* bar = (unsigned*)(p_.ws + O_CTR);
  unsigned* st = (unsigned*)(smem + SMEM_BYTES);
  if (threadIdx.x == 0) { st[0] = 0u; st[1] = 0u; (void)bw_add(&bar[BW_CENSUS(xcc_id())], 1u); }
  if (p_.out == nullptr) cg::this_grid().sync();
  RUN_PHASE(0) grid_barrier(bar, st);
  RUN_PHASE(1) grid_barrier(bar, st);
  RUN_PHASE(2) grid_barrier(bar, st);
  RUN_PHASE(3) grid_barrier(bar, st);
  RUN_PHASE(4) grid_barrier(bar, st);
  RUN_PHASE(5) grid_barrier(bar, st);
  RUN_PHASE(6) grid_barrier(bar, st);
  RUN_PHASE(7)
}
#endif

extern "C" void kernel_launch(void* const* d_in, const int* in_sizes, int n_in, void* d_out, int out_size,
                              void* d_ws, size_t ws_size, hipStream_t stream) {
  (void)in_sizes; (void)n_in; (void)out_size; (void)ws_size;
  Params p{};
  p.x = (const float*)d_in[0]; p.p = (const float*)d_in[1]; p.positions = (const int*)d_in[2];
  p.w_in = (const float*)d_in[3]; p.b_forget = (const float*)d_in[4]; p.g_q = (const float*)d_in[5];
  p.w_uq = (const float*)d_in[6]; p.g_kv = (const float*)d_in[7]; p.w_ukv = (const float*)d_in[8];
  p.w_out = (const float*)d_in[9]; p.ln1_g = (const float*)d_in[10]; p.ln1_b = (const float*)d_in[11];
  p.peer_wq = (const float*)d_in[12]; p.keys1 = (const float*)d_in[13]; p.keys2 = (const float*)d_in[14];
  p.peer_u = (const float*)d_in[15]; p.peer_v = (const float*)d_in[16]; p.wgate = (const float*)d_in[17];
  p.wproj = (const float*)d_in[18]; p.ln2_g = (const float*)d_in[19]; p.ln2_b = (const float*)d_in[20];
  p.out = (float*)d_out;
  p.ws = (char*)d_ws;

  static int grid_blocks = 0;
  if (!grid_blocks) {
    int dev = 0, cus = 0, per_cu = 0;
    (void)hipGetDevice(&dev);
    (void)hipDeviceGetAttribute(&cus, hipDeviceAttributeMultiprocessorCount, dev);
#if SINGLE_LAUNCH
    (void)hipOccupancyMaxActiveBlocksPerMultiprocessor(&per_cu, fwd_kernel, NT, 0);
#else
    per_cu = 2;
#endif
    if (per_cu > 1) per_cu = 1;
    if (per_cu < 1) per_cu = 1;
    grid_blocks = cus * per_cu;
  }
#if SINGLE_LAUNCH
  (void)hipMemsetAsync(d_ws, 0, 16384, stream);
  void* args[] = {&p};
  hipError_t e = hipLaunchCooperativeKernel((void*)fwd_kernel, dim3(grid_blocks), dim3(NT), args, 0, stream);
  if (e != hipSuccess) fprintf(stderr, "cooperative launch failed: %s (grid %d)\n", hipGetErrorString(e), grid_blocks);
#else
  phase_kernel<0><<<grid_blocks, NT, 0, stream>>>(p);
  phase_kernel<1><<<grid_blocks, NT, 0, stream>>>(p);
  phase_kernel<2><<<grid_blocks, NT, 0, stream>>>(p);
  phase_kernel<3><<<grid_blocks, NT, 0, stream>>>(p);
  phase_kernel<4><<<grid_blocks, NT, 0, stream>>>(p);
  phase_kernel<5><<<grid_blocks, NT, 0, stream>>>(p);
  phase_kernel<6><<<grid_blocks, NT, 0, stream>>>(p);
  phase_kernel<7><<<grid_blocks, NT, 0, stream>>>(p);
#endif
}
```

```cpp
#include <hip/hip_runtime.h>
#include <hip/hip_bf16.h>
#include <hip/hip_cooperative_groups.h>
#include <stdint.h>
#include <cstdio>
namespace cg = cooperative_groups;

typedef unsigned short u16;
typedef short bf16x8 __attribute__((ext_vector_type(8)));
typedef float f32x4 __attribute__((ext_vector_type(4)));
typedef unsigned u32x4 __attribute__((ext_vector_type(4)));
typedef unsigned u32x2 __attribute__((ext_vector_type(2)));

#ifndef SINGLE_LAUNCH
#define SINGLE_LAUNCH 1
#endif

constexpr int T_ = 8192, D_ = 2048, S_ = 4096, NB_ = 2;
constexpr int INW = 4168;
constexpr int NPH = 8;
constexpr float ALPHA = 1.189207115002721f;
constexpr float EPS = 1e-6f;
constexpr int NT = 512;
constexpr int SMEM_BYTES = 133120;

constexpr size_t al256(size_t x) { return (x + 255) & ~(size_t)255; }
constexpr size_t O_CTR = 0;
constexpr size_t O_WINT = O_CTR + 16384;
constexpr size_t O_WUQT = O_WINT + al256((size_t)4352 * 2048 * 2);
constexpr size_t O_WUKVT = O_WUQT + al256((size_t)1536 * 512 * 2);
constexpr size_t O_WOUTT = O_WUKVT + al256((size_t)2048 * 512 * 2);
constexpr size_t O_WPQT = O_WOUTT + al256((size_t)2048 * 2048 * 2);
constexpr size_t O_WGT = O_WPQT + al256((size_t)1024 * 2048 * 2);
constexpr size_t O_WPT = O_WGT + al256((size_t)2048 * 2048 * 2);
constexpr size_t O_PB = O_WPT + al256((size_t)2048 * 256 * 2);
constexpr size_t O_UB = O_PB + al256((size_t)8192 * 256 * 2);
constexpr size_t O_VB = O_UB + 2048;
constexpr size_t O_OMIX = O_UB + al256((size_t)16384 * 4096);
constexpr size_t O_CS = O_OMIX + al256((size_t)8192 * 2048 * 2);
constexpr size_t O_PROJB = O_CS + al256((size_t)8192 * 32 * 8);
constexpr size_t O_KEYH = O_PROJB + al256((size_t)8192 * 2048 * 2);
constexpr size_t O_KEYL = O_KEYH + al256((size_t)2 * 8 * 128 * 64 * 2);
constexpr size_t O_US = O_KEYL + al256((size_t)2 * 8 * 128 * 64 * 2);
constexpr size_t O_VS = O_US + al256((size_t)16384 * 4);
constexpr size_t O_REGB = O_VS + al256((size_t)16384 * 4);
constexpr size_t O_XB = O_REGB;
constexpr size_t O_CQB = O_XB + al256((size_t)8192 * 2048 * 2);
constexpr size_t O_CKVB = O_CQB + al256((size_t)8192 * 512 * 2);
constexpr size_t O_QM = O_CKVB + al256((size_t)8192 * 512 * 2);
constexpr size_t O_KM = O_QM + al256((size_t)8192 * 8 * 192 * 2);
constexpr size_t O_VMT = O_KM + al256((size_t)8192 * 8 * 192 * 2);
constexpr size_t O_QF = O_VMT + al256((size_t)8192 * 8 * 128 * 2);
constexpr size_t O_KF = O_QF + al256((size_t)8192 * 8 * 128 * 2);
constexpr size_t O_VFT = O_KF + al256((size_t)8192 * 8 * 128 * 2);
constexpr size_t O_LOGF = O_VFT + al256((size_t)8192 * 8 * 128 * 2);
constexpr size_t O_FK = O_LOGF + al256((size_t)16 * 4096 * 4);
constexpr size_t O_KRS = O_FK + al256((size_t)16 * 4096 * 4);
constexpr size_t O_RSS = O_KRS + al256((size_t)8192 * 64 * 4);
constexpr size_t O_ENDB = O_RSS + al256((size_t)2 * 8192 * 4);
constexpr size_t O_Y1 = O_REGB;
constexpr size_t O_H1B = O_Y1 + al256((size_t)8192 * 2048 * 4);
constexpr size_t O_PQ = O_H1B + al256((size_t)8192 * 2048 * 2);
constexpr size_t O_GATE = O_PQ + al256((size_t)8192 * 128 * 4);
constexpr size_t O_ENDB2 = O_GATE + al256((size_t)8192 * 128 * 4);
static_assert(O_ENDB2 <= O_ENDB, "region B reuse overflow");
static_assert(O_ENDB <= (size_t)500 * 1024 * 1024, "workspace too large");

struct Params {
  const float *x, *p; const int* positions;
  const float *w_in, *b_forget, *g_q, *w_uq, *g_kv, *w_ukv, *w_out, *ln1_g, *ln1_b;
  const float *peer_wq, *keys1, *keys2, *peer_u, *peer_v, *wgate, *wproj, *ln2_g, *ln2_b;
  float* out;
  char* ws;
#define WSP(type, name, off) __device__ __forceinline__ type* name() const { return (type*)(ws + (off)); }
  WSP(unsigned, ctr, O_CTR) WSP(u16, WinT, O_WINT) WSP(u16, WuqT, O_WUQT) WSP(u16, WukvT, O_WUKVT) WSP(u16, WoutT, O_WOUTT)
  WSP(u16, WpqT, O_WPQT) WSP(u16, WgT, O_WGT) WSP(u16, WpT, O_WPT) WSP(u16, pb, O_PB) WSP(unsigned char, Uq, O_UB) WSP(unsigned char, Vq, O_VB) WSP(float, Us, O_US) WSP(float, Vs, O_VS)
  WSP(u16, omix, O_OMIX) WSP(float2, cs, O_CS) WSP(u16, projb, O_PROJB) WSP(u16, keyH, O_KEYH) WSP(u16, keyL, O_KEYL)
  WSP(u16, xb, O_XB) WSP(u16, cqb, O_CQB) WSP(u16, ckvb, O_CKVB) WSP(u16, Qm, O_QM) WSP(u16, Km, O_KM) WSP(u16, VmT, O_VMT)
  WSP(u16, Qf, O_QF) WSP(u16, Kf, O_KF) WSP(u16, VfT, O_VFT) WSP(float, logf, O_LOGF) WSP(float, Fk, O_FK) WSP(float, krsum, O_KRS) WSP(float, rss, O_RSS)
  WSP(float, y1, O_Y1) WSP(u16, h1b, O_H1B) WSP(int, eidxG, O_PQ) WSP(float, gateG, O_GATE)
#undef WSP
};

__device__ __forceinline__ int TID() { int t = threadIdx.x; asm volatile("" : "+v"(t)); return t; }
__device__ __forceinline__ unsigned pk2(float lo, float hi) {
  unsigned r; asm volatile("v_cvt_pk_bf16_f32 %0, %1, %2" : "=v"(r) : "v"(lo), "v"(hi)); return r;
}
__device__ __forceinline__ u16 f2bf(float f) { return (u16)(pk2(f, 0.f) & 0xffffu); }
__device__ __forceinline__ float bf2f(u16 v) { return __uint_as_float(((unsigned)v) << 16); }
__device__ __forceinline__ float bflo(unsigned v) { return __uint_as_float(v << 16); }
__device__ __forceinline__ float bfhi(unsigned v) { return __uint_as_float(v & 0xffff0000u); }

template <int CTRL> __device__ __forceinline__ int dppi(int v) { return __builtin_amdgcn_update_dpp(0, v, CTRL, 0xF, 0xF, false); }
template <int CTRL> __device__ __forceinline__ float dppf(float v) { return __int_as_float(dppi<CTRL>(__float_as_int(v))); }
__device__ __forceinline__ float rdlane(float v, int l) { return __int_as_float(__builtin_amdgcn_readlane(__float_as_int(v), l)); }

__device__ __forceinline__ float row_sum(float v) {
  v += dppf<0xB1>(v); v += dppf<0x4E>(v); v += dppf<0x141>(v); v += dppf<0x140>(v); return v;
}
__device__ __forceinline__ float row_max(float v) {
  v = fmaxf(v, dppf<0xB1>(v)); v = fmaxf(v, dppf<0x4E>(v)); v = fmaxf(v, dppf<0x141>(v)); v = fmaxf(v, dppf<0x140>(v)); return v;
}
__device__ __forceinline__ float wave_sum(float v) {
  v = row_sum(v);
  return (rdlane(v, 0) + rdlane(v, 16)) + (rdlane(v, 32) + rdlane(v, 48));
}
__device__ __forceinline__ float wave_max(float v) {
  v = row_max(v);
  return fmaxf(fmaxf(rdlane(v, 0), rdlane(v, 16)), fmaxf(rdlane(v, 32), rdlane(v, 48)));
}
__device__ __forceinline__ unsigned wave_umax(unsigned v) {
  unsigned t;
  t = (unsigned)dppi<0xB1>((int)v); v = v > t ? v : t;
  t = (unsigned)dppi<0x4E>((int)v); v = v > t ? v : t;
  t = (unsigned)dppi<0x141>((int)v); v = v > t ? v : t;
  t = (unsigned)dppi<0x140>((int)v); v = v > t ? v : t;
  unsigned a = (unsigned)__builtin_amdgcn_readlane((int)v, 0), b = (unsigned)__builtin_amdgcn_readlane((int)v, 16);
  unsigned c = (unsigned)__builtin_amdgcn_readlane((int)v, 32), d = (unsigned)__builtin_amdgcn_readlane((int)v, 48);
  a = a > b ? a : b; c = c > d ? c : d; return a > c ? a : c;
}
__device__ __forceinline__ unsigned ordkey(float f) {
  unsigned u = __float_as_uint(f);
  return (u & 0x80000000u) ? ~u : (u | 0x80000000u);
}

__device__ __forceinline__ unsigned fp6_code(float v) {
  const float a = fabsf(v);
  int code = a < 2.f ? (int)rintf(a * 8.f) : (a < 4.f ? 16 + (int)rintf((a - 2.f) * 4.f) : 24 + (int)rintf((a - 4.f) * 2.f));
  code = code > 31 ? 31 : code;
  return (unsigned)code | (v < 0.f ? 32u : 0u);
}
__device__ __forceinline__ void quant_chunk(const Params& p, int chunk) {
  const int tid = TID(), lane = tid & 63, wid = tid >> 6;
#pragma unroll 1
  for (int i8 = 0; i8 < 8; ++i8) {
    const int r = chunk * 64 + wid * 8 + i8;
    const int tab = r >> 14, row = r & 16383;
    const float* src = (tab ? p.peer_v : p.peer_u) + (size_t)row * D_ + lane * 4;
    float4 v[8];
    float am = 0.f;
#pragma unroll
    for (int i = 0; i < 8; ++i) {
      v[i] = *(const float4*)(src + i * 256);
      am = fmaxf(am, fmaxf(fmaxf(fabsf(v[i].x), fabsf(v[i].y)), fmaxf(fabsf(v[i].z), fabsf(v[i].w))));
    }
    am = wave_max(am);
    const float qs = am > 0.f ? 7.5f / am : 1.f;
    unsigned w[6];
#pragma unroll
    for (int g = 0; g < 2; ++g) {
      unsigned long long lo = 0ull; unsigned hi = 0u;
#pragma unroll
      for (int i = 0; i < 4; ++i) {
        const float4 f = v[g * 4 + i];
        const unsigned q4 = fp6_code(f.x * qs) | (fp6_code(f.y * qs) << 6) | (fp6_code(f.z * qs) << 12) | (fp6_code(f.w * qs) << 18);
        if (i == 0) lo |= (unsigned long long)q4;
        if (i == 1) lo |= (unsigned long long)q4 << 24;
        if (i == 2) { lo |= (unsigned long long)q4 << 48; hi |= q4 >> 16; }
        if (i == 3) hi |= q4 << 8;
      }
      w[g * 3 + 0] = (unsigned)lo; w[g * 3 + 1] = (unsigned)(lo >> 32); w[g * 3 + 2] = hi;
    }
    unsigned* dst = (unsigned*)(p.Uq() + (size_t)row * 3072 + tab * 1536 + lane * 24);
    *(u32x2*)dst = u32x2{w[0], w[1]}; *(u32x2*)(dst + 2) = u32x2{w[2], w[3]}; *(u32x2*)(dst + 4) = u32x2{w[4], w[5]};
    if (lane == 0) (tab ? p.Vs() : p.Us())[row] = am > 0.f ? am / 7.5f : 1.f;
  }
}

__device__ void transpose_cvt(const float* __restrict__ W, int ldw, int K, int src_col0, int ncols,
                              u16* __restrict__ WT, int dst_row0, const float* __restrict__ kscale,
                              float* tile, int bid, int nb) {
  const int tiles_k = K / 64, tiles_n = ncols / 64, tid = TID();
#pragma unroll 1
  for (int t = bid; t < tiles_k * tiles_n; t += nb) {
    const int tk = t % tiles_k, tn = t / tiles_k, k0 = tk * 64, n0 = tn * 64;
#pragma unroll
    for (int i = 0; i < 2; ++i) {
      const int r = (tid >> 4) + 32 * i, c = (tid & 15) * 4;
      const float4 v = *(const float4*)(W + (size_t)(k0 + r) * ldw + src_col0 + n0 + c);
      const float sc = kscale ? kscale[k0 + r] : 1.f;
      tile[r * 65 + c + 0] = v.x * sc; tile[r * 65 + c + 1] = v.y * sc;
      tile[r * 65 + c + 2] = v.z * sc; tile[r * 65 + c + 3] = v.w * sc;
    }
    __syncthreads();
    {
      const int n = tid >> 3, kk = (tid & 7) * 8;
      unsigned w[4];
#pragma unroll
      for (int e = 0; e < 4; ++e) w[e] = pk2(tile[(kk + 2 * e) * 65 + n], tile[(kk + 2 * e + 1) * 65 + n]);
      *(u32x4*)(WT + (size_t)(dst_row0 + n0 + n) * K + k0 + kk) = u32x4{w[0], w[1], w[2], w[3]};
    }
    __syncthreads();
  }
}

__device__ void cvt_bf16(const float* __restrict__ src, u16* __restrict__ dst, size_t n8, size_t gtid, size_t gthreads) {
  for (size_t i = gtid; i < n8; i += gthreads) {
    const float4 a = ((const float4*)src)[2 * i], b = ((const float4*)src)[2 * i + 1];
    ((u32x4*)dst)[i] = u32x4{pk2(a.x, a.y), pk2(a.z, a.w), pk2(b.x, b.y), pk2(b.z, b.w)};
  }
}

__device__ void phase_prep(const Params& p, char* smem, int bid, int nb) {
  const int tid = TID(), lane = tid & 63, wid = tid >> 6;
  float* tile = (float*)smem;
  if (bid == 0 && tid == 0) p.ctr()[0] = 0;
  transpose_cvt(p.w_in, INW, D_, 0, 1024, p.WinT(), 0, nullptr, tile, bid, nb);
  transpose_cvt(p.w_in, INW, D_, 1088, 3072, p.WinT(), 1024, nullptr, tile, bid, nb);
  transpose_cvt(p.w_in, INW, D_, 1024, 64, p.WinT(), 4096, nullptr, tile, bid, nb);
  transpose_cvt(p.w_uq, 1536, 512, 0, 1536, p.WuqT(), 0, p.g_q, tile, bid, nb);
  transpose_cvt(p.w_ukv, 2048, 512, 0, 2048, p.WukvT(), 0, p.g_kv, tile, bid, nb);
  transpose_cvt(p.w_out, 2048, 2048, 0, 2048, p.WoutT(), 0, nullptr, tile, bid, nb);
  transpose_cvt(p.peer_wq, 1024, 2048, 0, 1024, p.WpqT(), 0, nullptr, tile, bid, nb);
  transpose_cvt(p.wgate, 2048, 2048, 0, 2048, p.WgT(), 0, nullptr, tile, bid, nb);
  transpose_cvt(p.wproj, 2048, 256, 0, 2048, p.WpT(), 0, nullptr, tile, bid, nb);
  const size_t gtid = (size_t)bid * NT + tid, gth = (size_t)nb * NT;
  for (size_t i = gtid; i < (size_t)192 * 2048 / 8; i += gth) ((u32x4*)(p.WinT() + (size_t)4160 * 2048))[i] = u32x4{0, 0, 0, 0};
  cvt_bf16(p.p, p.pb(), (size_t)T_ * 256 / 8, gtid, gth);
  for (size_t i = gtid; i < (size_t)T_ * 64 / 4; i += gth) ((float4*)p.krsum())[i] = make_float4(0.f, 0.f, 0.f, 0.f);
  for (size_t i = gtid; i < (size_t)2 * T_ / 4; i += gth) ((float4*)p.rss())[i] = make_float4(0.f, 0.f, 0.f, 0.f);
  for (size_t i = gtid; i < (size_t)2 * 65536; i += gth) {
    const float v = i < 65536 ? p.keys1[i] : p.keys2[i - 65536];
    const u16 h = f2bf(v);
    p.keyH()[i] = h; p.keyL()[i] = f2bf(v - bf2f(h));
  }
  for (size_t i = gtid; i < (size_t)T_ * 32; i += gth) {
    const int t = (int)(i >> 5), fi = (int)(i & 31);
    const float invf = 1.0f / powf(10000.0f, (float)(2 * fi) / 64.0f);
    const float ang = (float)p.positions[t] * invf;
    const double rev = (double)ang * 0.15915494309189535;
    const float fr = (float)(rev - rint(rev));
    p.cs()[i] = make_float2(__builtin_amdgcn_cosf(fr), __builtin_amdgcn_sinf(fr));
  }
  __syncthreads();
  float* wff = (float*)smem;
  for (int i = tid; i < 2048 * 2; i += NT) {
    const int k = i >> 1, hf = i & 1;
    *(float4*)(wff + (k ^ ((k >> 3) & 7)) * 8 + hf * 4) = *(const float4*)(p.w_in + (size_t)k * INW + 4160 + hf * 4);
  }
  __syncthreads();
  for (int t = bid * 8 + wid; t < T_; t += nb * 8) {
    float a[8];
#pragma unroll
    for (int e = 0; e < 8; ++e) a[e] = 0.f;
#pragma unroll 1
    for (int i = 0; i < 4; ++i) {
      const int k = (i * 64 + lane) * 8;
      const float4 x0 = *(const float4*)(p.x + (size_t)t * D_ + k), x1 = *(const float4*)(p.x + (size_t)t * D_ + k + 4);
      *(u32x4*)(p.xb() + (size_t)t * D_ + k) = u32x4{pk2(x0.x, x0.y), pk2(x0.z, x0.w), pk2(x1.x, x1.y), pk2(x1.z, x1.w)};
      const float xs[8] = {x0.x, x0.y, x0.z, x0.w, x1.x, x1.y, x1.z, x1.w};
#pragma unroll
      for (int j = 0; j < 8; ++j) {
        const int kr = (k + j) ^ (lane & 7);
        const float4 w0 = *(const float4*)(wff + kr * 8), w1 = *(const float4*)(wff + kr * 8 + 4);
        a[0] += xs[j] * w0.x; a[1] += xs[j] * w0.y; a[2] += xs[j] * w0.z; a[3] += xs[j] * w0.w;
        a[4] += xs[j] * w1.x; a[5] += xs[j] * w1.y; a[6] += xs[j] * w1.z; a[7] += xs[j] * w1.w;
      }
    }
    float mine = 0.f;
#pragma unroll
    for (int e = 0; e < 8; ++e) { const float s = wave_sum(a[e]); if (lane == e) mine = s; }
    if (lane < 8) {
      const float z = mine + p.b_forget[lane];
      const float ls = fminf(z, 0.f) - log1pf(expf(-fabsf(z)));
      const int b = t >> 12, s = t & 4095;
      p.logf()[((size_t)(b * 8 + lane)) * S_ + s] = ls;
    }
  }
}

template <int WM, int WN>
__device__ __forceinline__ void gemm_core(const u16* __restrict__ A, int lda, const u16* __restrict__ Bt, int ldb,
                                          int K, int brow, int bcol, char* smem, f32x4 (&acc)[4 / WM][4][4]) {
  constexpr int MS = 4 / WM, BN = 64 * WN, NBL = BN / 64;
  static_assert(WM * WN == 8, "8 waves");
  const int tid = TID(), wid = tid >> 6, lane = tid & 63, wr = wid / WN, wc = wid % WN, fr = lane & 15, fq = lane >> 4;
#pragma unroll
  for (int h = 0; h < MS; ++h)
#pragma unroll
    for (int m = 0; m < 4; ++m)
#pragma unroll
      for (int n = 0; n < 4; ++n) acc[h][m][n] = f32x4{0.f, 0.f, 0.f, 0.f};
  const int nk = K / 64;
  const int srow = tid >> 3, sch = (tid & 7) ^ ((tid >> 4) & 7);
  const u16* ga = A + (size_t)(brow + srow) * lda + sch * 8;
  const u16* gb = Bt + (size_t)(bcol + srow) * ldb + sch * 8;
  char* sdst = smem + tid * 16;
  auto issue = [&](int kt, int st) {
    char* sa = sdst + st * 65536;
#pragma unroll
    for (int i = 0; i < 4; ++i)
      __builtin_amdgcn_global_load_lds((const unsigned*)(ga + (size_t)i * 64 * lda + kt * 64), (unsigned*)(sa + i * 8192), 16, 0, 0);
#pragma unroll
    for (int i = 0; i < NBL; ++i)
      __builtin_amdgcn_global_load_lds((const unsigned*)(gb + (size_t)i * 64 * ldb + kt * 64), (unsigned*)(sa + 32768 + i * 8192), 16, 0, 0);
  };
  const int fx = (fr >> 1) & 7;
  const int arow = (wr * (256 / WM) + fr) * 128, brw = 32768 + (wc * 64 + fr) * 128;
  const int c0 = (fq ^ fx) * 16, c1 = ((4 + fq) ^ fx) * 16;
  asm volatile("s_waitcnt vmcnt(0)" ::: "memory");
  __syncthreads();
  issue(0, 0);
#pragma unroll 1
  for (int kt = 0; kt < nk; ++kt) {
    asm volatile("s_waitcnt vmcnt(0)" ::: "memory");
    __builtin_amdgcn_s_barrier();
    asm volatile("" ::: "memory");
    if (kt + 1 < nk) issue(kt + 1, (kt + 1) & 1);
    const char* sb = smem + (kt & 1) * 65536;
#pragma unroll
    for (int ks = 0; ks < 2; ++ks) {
      const int co = ks ? c1 : c0;
      bf16x8 Bl[4];
#pragma unroll
      for (int n = 0; n < 4; ++n) Bl[n] = *reinterpret_cast<const bf16x8*>(sb + brw + co + n * 2048);
#pragma unroll
      for (int h = 0; h < MS; ++h) {
        bf16x8 At[4];
#pragma unroll
        for (int m = 0; m < 4; ++m) At[m] = *reinterpret_cast<const bf16x8*>(sb + arow + co + (h * 4 + m) * 2048);
#pragma unroll
        for (int m = 0; m < 4; ++m)
#pragma unroll
          for (int n = 0; n < 4; ++n) acc[h][m][n] = __builtin_amdgcn_mfma_f32_16x16x32_bf16(At[m], Bl[n], acc[h][m][n], 0, 0, 0);
      }
    }
  }
}

template <int WM, int WN, class Epi>
__device__ __forceinline__ void gemm_tile(const u16* __restrict__ A, int lda, const u16* __restrict__ Bt, int ldb,
                                          int K, int brow, int bcol, char* smem, Epi epi) {
  constexpr int MS = 4 / WM;
  const int tid = TID(), wid = tid >> 6, lane = tid & 63, wr = wid / WN, wc = wid % WN, fr = lane & 15, fq = lane >> 4;
  f32x4 acc[MS][4][4];
  gemm_core<WM, WN>(A, lda, Bt, ldb, K, brow, bcol, smem, acc);
#pragma unroll
  for (int h = 0; h < MS; ++h) epi(acc[h], brow + wr * (256 / WM) + h * 64, bcol + wc * 64, fr, fq);
}

namespace pg8 {
#define PG8_LAS __attribute__((address_space(3)))
typedef unsigned short bf16_t;
constexpr int BM = 256, BK = 64, HALF = 128, HTB = HALF * BK * 2  , STAGE_BYTES = 8 * HTB, NXCD = 8, WGM = 8;

__host__ __device__ __forceinline__ int lds_byte(int r, int c) { const int st = (r >> 4) * 2 + (c >> 5), rr = r & 15, cc = c & 31, ob = rr * 64 + cc * 2; return st * 1024 + (ob ^ (((ob >> 9) & 1) << 5)); }
__host__ __device__ __forceinline__ void stage_rc(int b, int& R, int& C) { const int st = b / 1024, sb = b % 1024, swz = sb ^ (((sb >> 9) & 1) << 5); R = (st >> 1) * 16 + swz / 64; C = (st & 1) * 32 + (swz % 64) / 2; }
__host__ __device__ __forceinline__ int perm32(int rho) { const int n = rho >> 4, i = rho & 15; return 8 * (i >> 2) + 4 * n + (i & 3); }
struct Unit { int pm, pn; };
struct Gemm { const bf16_t* A; const bf16_t* Bt; int M, N, K; };
struct StaticOrder {
    int nM, nN, nwg, G, c;
    __device__ void init(int M, int N, int G_, int c_) { nM = M / BM; nN = N / BM; nwg = nM * nN; G = G_; c = c_; }
    __device__ bool next(int i, Unit& u) const {
        const long L = (long)i * G + c; if (L >= nwg) return false;
        int wgid = (int)L; { const int q = nwg / NXCD, r = nwg % NXCD, xcd = wgid % NXCD, off = wgid / NXCD; wgid = (xcd < r ? xcd * (q + 1) : r * (q + 1) + (xcd - r) * q) + off; }
        const int nig = WGM * nN, gid = wgid / nig, fm = gid * WGM, gsz = (nM - fm) < WGM ? (nM - fm) : WGM;
        u.pm = fm + ((wgid % nig) % gsz); u.pn = (wgid % nig) / gsz; return true;
    }
    __device__ __forceinline__ void a_ready(const Unit&) const {}
    __device__ __forceinline__ void done(const Unit&) const {}
};
template <class Epi, class Sched, bool STAMP = false>
__device__ __forceinline__ void gemm_phase(PG8_LAS unsigned char* lds, const Gemm g, const Sched& S, const Epi& E, unsigned long long* stamps) {
    const int tid = TID(), wid = __builtin_amdgcn_readfirstlane(tid >> 6), lane = tid & 63, wr = wid >> 2, wc = wid & 3, fr = lane & 15, fq = lane >> 4;
    const int K = g.K, nt = K / BK;
    int ts_lo = 0, ts_hi = 0, nts = 0; const unsigned long long rt_entry = STAMP ? (unsigned long long)wall_clock64() : 0ull;
#define PG8_STAMP() do { if (STAMP && wid == 0 && nts < 64) { const unsigned long long _c = (unsigned long long)clock64(); \
        ts_lo = (lane == nts) ? (int)(unsigned)_c : ts_lo; ts_hi = (lane == nts) ? (int)(unsigned)(_c >> 32) : ts_hi; ++nts; } } while (0)
    PG8_STAMP();
    unsigned voffA[2], voffB[2];
#pragma unroll
    for (int i = 0; i < 2; ++i) { int R, C; stage_rc(tid * 16 + i * 8192, R, C); const int Rb = Epi::PERM ? ((R & ~31) + perm32(R & 31)) : R;
        voffA[i] = (unsigned)(R * K + C) * 2u; voffB[i] = (unsigned)(Rb * K + C) * 2u; }
    const size_t kstep = (size_t)(BK * 2);
    const size_t hstep = (size_t)HALF * K * 2;
    const size_t tstep = 2 * hstep;
    const unsigned ldsw = (unsigned)wid * 1024u;
    const int aoff = lds_byte(wr * 64 + fr, fq * 8), boff = lds_byte(wc * 32 + fr, fq * 8);
#define PG8_SA(b, h) (((b) * 2 + (h)) * HTB)
#define PG8_SB(b, h) ((4 + (b) * 2 + (h)) * HTB)
#define PG8_STAGE(bufoff, gbase, voff) do { _Pragma("unroll") for (int _i = 0; _i < 2; ++_i) \
        __builtin_amdgcn_global_load_lds((const unsigned*)((const char*)(gbase) + (voff)[_i]), (PG8_LAS unsigned*)(lds + (bufoff) + ldsw + _i * 8192), 16, 0, 0); } while (0)
#define PG8_LDA(dst, b, h) do { _Pragma("unroll") for (int m = 0; m < 4; ++m) _Pragma("unroll") for (int k = 0; k < 2; ++k) dst[m][k] = *(const PG8_LAS bf16x8*)(lds + PG8_SA(b, h) + aoff + m * 2048 + k * 1024); } while (0)
#define PG8_LDB(dst, b, h) do { _Pragma("unroll") for (int n = 0; n < 2; ++n) _Pragma("unroll") for (int k = 0; k < 2; ++k) dst[n][k] = *(const PG8_LAS bf16x8*)(lds + PG8_SB(b, h) + boff + n * 2048 + k * 1024); } while (0)
#define PG8_MMA(ai, bj, At, Bt) do { __builtin_amdgcn_s_setprio(1); _Pragma("unroll") for (int m = 0; m < 4; ++m) _Pragma("unroll") for (int n = 0; n < 2; ++n) _Pragma("unroll") for (int k = 0; k < 2; ++k) \
        acc[ai][bj][m][n] = __builtin_amdgcn_mfma_f32_16x16x32_bf16(Bt[n][k], At[m][k], acc[ai][bj][m][n], 0, 0, 0); __builtin_amdgcn_s_setprio(0); } while (0)
#define PG8_WAIT_V(n) asm volatile("s_waitcnt vmcnt(" #n ")" ::: "memory")
#define PG8_WAIT_L(n) asm volatile("s_waitcnt lgkmcnt(" #n ")" ::: "memory")
#define PG8_BAR __builtin_amdgcn_s_barrier()
#define PG8_SCHED __builtin_amdgcn_sched_barrier(0)
    Unit cur, nxt; int ui = 0;
    if (!S.next(0, cur)) return;
    f32x4 acc[2][2][4][2];
#pragma unroll
    for (int a = 0; a < 2; ++a)
#pragma unroll
        for (int b = 0; b < 2; ++b)
#pragma unroll
            for (int m = 0; m < 4; ++m)
#pragma unroll
                for (int n = 0; n < 2; ++n) acc[a][b][m][n] = (f32x4){0.f, 0.f, 0.f, 0.f};
    bf16x8 At[4][2], B0[2][2], B1[2][2];
    const char* cA = (const char*)g.A + (size_t)cur.pm * tstep; const char* cB = (const char*)g.Bt + (size_t)cur.pn * tstep;
    S.a_ready(cur);
    PG8_STAGE(PG8_SB(0, 0), cB, voffB); PG8_STAGE(PG8_SA(0, 0), cA, voffA); PG8_STAGE(PG8_SB(0, 1), cB + hstep, voffB); PG8_STAGE(PG8_SA(0, 1), cA + hstep, voffA);
    if (wr == 1) PG8_BAR;
    PG8_WAIT_V(4); PG8_BAR;
    PG8_STAGE(PG8_SB(1, 0), cB + kstep, voffB); PG8_STAGE(PG8_SA(1, 0), cA + kstep, voffA); PG8_STAGE(PG8_SB(1, 1), cB + hstep + kstep, voffB);
    PG8_WAIT_V(6); PG8_BAR;
    PG8_STAMP();
    for (;;) {
        const bool has_next = S.next(ui + 1, nxt);
        const char* nA = has_next ? (const char*)g.A + (size_t)nxt.pm * tstep : cA; const char* nB = has_next ? (const char*)g.Bt + (size_t)nxt.pn * tstep : cB;
        for (int t = 0; t < nt; t += 2) {
            const bool last = (t == nt - 2);
            const char* a1 = cA + (size_t)(t + 1) * kstep;
            const char* a2 = last ? nA : cA + (size_t)(t + 2) * kstep; const char* b2 = last ? nB : cB + (size_t)(t + 2) * kstep;
            const char* a3 = a2 + kstep; const char* b3 = b2 + kstep;
            if (last && has_next) S.a_ready(nxt);
            PG8_LDB(B0, 0, 0); PG8_SCHED; PG8_LDA(At, 0, 0); PG8_STAGE(PG8_SA(1, 1), a1 + hstep, voffA);
            PG8_WAIT_L(8); PG8_BAR; PG8_WAIT_L(0); PG8_MMA(0, 0, At, B0); PG8_BAR; PG8_SCHED;
            PG8_LDB(B1, 0, 1); PG8_STAGE(PG8_SB(0, 0), b2, voffB);
            PG8_BAR; PG8_WAIT_L(0); PG8_MMA(0, 1, At, B1); PG8_BAR;
            PG8_LDA(At, 0, 1); PG8_STAGE(PG8_SA(0, 0), a2, voffA);
            PG8_BAR; PG8_WAIT_L(0); PG8_MMA(1, 0, At, B0); PG8_BAR; PG8_SCHED;
            PG8_STAGE(PG8_SB(0, 1), b2 + hstep, voffB);
            PG8_WAIT_V(6); PG8_BAR; PG8_MMA(1, 1, At, B1); PG8_BAR;
            PG8_LDB(B0, 1, 0); PG8_SCHED; PG8_LDA(At, 1, 0); PG8_STAGE(PG8_SA(0, 1), a2 + hstep, voffA);
            PG8_WAIT_L(8); PG8_BAR; PG8_WAIT_L(0); PG8_MMA(0, 0, At, B0); PG8_BAR; PG8_SCHED;
            PG8_LDB(B1, 1, 1); PG8_STAGE(PG8_SB(1, 0), b3, voffB);
            PG8_BAR; PG8_WAIT_L(0); PG8_MMA(0, 1, At, B1); PG8_BAR;
            PG8_LDA(At, 1, 1); PG8_STAGE(PG8_SA(1, 0), a3, voffA);
            PG8_BAR; PG8_WAIT_L(0); PG8_MMA(1, 0, At, B0); PG8_BAR; PG8_SCHED;
            PG8_STAGE(PG8_SB(1, 1), b3 + hstep, voffB);
            PG8_WAIT_V(6); PG8_BAR; PG8_MMA(1, 1, At, B1); PG8_BAR;
        }
        PG8_STAMP();
        if constexpr (!Epi::AFTER_DRAIN) { E(acc, cur, wr, wc, fr, fq); S.done(cur); }
        PG8_STAMP();
        if (!has_next) break;
#pragma unroll
        for (int a = 0; a < 2; ++a)
#pragma unroll
            for (int b = 0; b < 2; ++b)
#pragma unroll
                for (int m = 0; m < 4; ++m)
#pragma unroll
                    for (int n = 0; n < 2; ++n) acc[a][b][m][n] = (f32x4){0.f, 0.f, 0.f, 0.f};
        cur = nxt; cA = nA; cB = nB; ++ui;
    }
    PG8_WAIT_V(0);
    if (wr == 0) PG8_BAR;
    PG8_BAR;
    if constexpr (Epi::AFTER_DRAIN) { E.fused(acc, cur, wr, wc, fr, fq, lds, wid, lane); S.done(cur); }
    PG8_STAMP();
    if (STAMP && wid == 0) { stamps[lane] = lane < nts ? (((unsigned long long)(unsigned)ts_hi << 32) | (unsigned)ts_lo) : 0ull;
        if (lane == 62) stamps[62] = rt_entry; if (lane == 63) stamps[63] = (unsigned long long)wall_clock64(); }
#undef PG8_STAMP
#undef PG8_SA
#undef PG8_SB
#undef PG8_STAGE
#undef PG8_LDA
#undef PG8_LDB
#undef PG8_MMA
#undef PG8_WAIT_V
#undef PG8_WAIT_L
#undef PG8_BAR
#undef PG8_SCHED
}
}


__device__ __forceinline__ u32x4 pack8(const f32x4& a, const f32x4& b) { return u32x4{pk2(a[0], a[1]), pk2(a[2], a[3]), pk2(b[0], b[1]), pk2(b[2], b[3])}; }
__device__ __forceinline__ float sumsq4(const f32x4& a) { return (a[0] * a[0] + a[1] * a[1]) + (a[2] * a[2] + a[3] * a[3]); }
__device__ __forceinline__ void store_tr8(u16* vt, const f32x4& a, const f32x4& b) {
  vt[0] = f2bf(a[0]); vt[(size_t)S_] = f2bf(a[1]); vt[(size_t)2 * S_] = f2bf(a[2]); vt[(size_t)3 * S_] = f2bf(a[3]);
  vt[(size_t)4 * S_] = f2bf(b[0]); vt[(size_t)5 * S_] = f2bf(b[1]); vt[(size_t)6 * S_] = f2bf(b[2]); vt[(size_t)7 * S_] = f2bf(b[3]);
}
struct EpiInproj {
  static constexpr bool PERM = true, AFTER_DRAIN = false;
  u16 *cqb, *ckvb, *Qf, *Kf, *VfT; float* rss;
  __device__ __forceinline__ void operator()(const f32x4 (&acc)[2][2][4][2], const pg8::Unit& u, int wr, int wc, int fr, int fq) const {
    const int ct = u.pn * 256;
#pragma unroll
    for (int ai = 0; ai < 2; ++ai)
#pragma unroll
      for (int m = 0; m < 4; ++m) {
        const int row = u.pm * 256 + ai * 128 + wr * 64 + m * 16 + fr, b = row >> 12, s = row & 4095;
        float ss = 0.f;
#pragma unroll
        for (int bj = 0; bj < 2; ++bj) {
          const int c0 = ct + bj * 128 + wc * 32 + 8 * fq;
          const f32x4 v0 = acc[ai][bj][m][0], v1 = acc[ai][bj][m][1];
          if (ct < 1024) {
            u16* dst = ct < 512 ? cqb : ckvb;
            *(u32x4*)(dst + (size_t)row * 512 + (c0 & 511)) = pack8(v0, v1);
            ss += sumsq4(v0) + sumsq4(v1);
          } else if (ct < 3072) {
            int c = c0 - 1024; u16* dst = c < 1024 ? Qf : Kf; c &= 1023;
            *(u32x4*)(dst + ((size_t)(b * 8 + (c >> 7)) * S_ + s) * 128 + (c & 127)) = pack8(v0, v1);
          } else {
            const int c = c0 - 3072;
            store_tr8(VfT + ((size_t)(b * 8 + (c >> 7)) * 128 + (c & 127)) * S_ + s, v0, v1);
          }
        }
        if (ct < 1024) atomicAdd(rss + (ct < 512 ? 0 : T_) + row, ss);
        __builtin_amdgcn_sched_barrier(0);
      }
  }
};
struct EpiQup {
  static constexpr bool PERM = true, AFTER_DRAIN = false;
  u16* Qm; const float* rss;
  __device__ __forceinline__ void operator()(const f32x4 (&acc)[2][2][4][2], const pg8::Unit& u, int wr, int wc, int fr, int fq) const {
#pragma unroll
    for (int ai = 0; ai < 2; ++ai)
#pragma unroll
      for (int m = 0; m < 4; ++m) {
        const int row = u.pm * 256 + ai * 128 + wr * 64 + m * 16 + fr, b = row >> 12, s = row & 4095;
        const float rs = rsqrtf(rss[row] * (1.f / 512.f) + EPS);
#pragma unroll
        for (int bj = 0; bj < 2; ++bj) {
          const int c0 = u.pn * 256 + bj * 128 + wc * 32 + 8 * fq, hh = c0 / 192, off = c0 % 192;
          *(u32x4*)(Qm + ((size_t)(b * 8 + hh) * S_ + s) * 192 + off) = pack8(acc[ai][bj][m][0] * rs, acc[ai][bj][m][1] * rs);
        }
        __builtin_amdgcn_sched_barrier(0);
      }
  }
};
struct EpiKVup {
  static constexpr bool PERM = true, AFTER_DRAIN = false;
  u16 *Km, *VmT; const float* rss;
  __device__ __forceinline__ void operator()(const f32x4 (&acc)[2][2][4][2], const pg8::Unit& u, int wr, int wc, int fr, int fq) const {
    const int hh = u.pn;
#pragma unroll
    for (int ai = 0; ai < 2; ++ai)
#pragma unroll
      for (int m = 0; m < 4; ++m) {
        const int row = u.pm * 256 + ai * 128 + wr * 64 + m * 16 + fr, b = row >> 12, s = row & 4095;
        const float rs = rsqrtf(rss[T_ + row] * (1.f / 512.f) + EPS);
        const int off = wc * 32 + 8 * fq;
        *(u32x4*)(Km + ((size_t)(b * 8 + hh) * S_ + s) * 192 + off) = pack8(acc[ai][0][m][0] * rs, acc[ai][0][m][1] * rs);
        store_tr8(VmT + ((size_t)(b * 8 + hh) * 128 + off) * S_ + s, acc[ai][1][m][0] * rs, acc[ai][1][m][1] * rs);
        __builtin_amdgcn_sched_barrier(0);
      }
  }
};
struct EpiProj {
  static constexpr bool PERM = true, AFTER_DRAIN = false;
  u16* projb;
  __device__ __forceinline__ void operator()(const f32x4 (&acc)[2][2][4][2], const pg8::Unit& u, int wr, int wc, int fr, int fq) const {
#pragma unroll
    for (int ai = 0; ai < 2; ++ai)
#pragma unroll
      for (int m = 0; m < 4; ++m) {
        const int row = u.pm * 256 + ai * 128 + wr * 64 + m * 16 + fr;
#pragma unroll
        for (int bj = 0; bj < 2; ++bj)
          *(u32x4*)(projb + (size_t)row * D_ + u.pn * 256 + bj * 128 + wc * 32 + 8 * fq) = pack8(acc[ai][bj][m][0], acc[ai][bj][m][1]);
      }
  }
};
struct EpiOut {
  static constexpr bool PERM = false, AFTER_DRAIN = false;
  const float* x; float* y1;
  __device__ __forceinline__ void operator()(const f32x4 (&acc)[2][2][4][2], const pg8::Unit& u, int wr, int wc, int fr, int fq) const {
#pragma unroll
    for (int ai = 0; ai < 2; ++ai)
#pragma unroll
      for (int m = 0; m < 4; ++m) {
        const size_t rb = (size_t)(u.pm * 256 + ai * 128 + wr * 64 + m * 16 + fr) * D_ + u.pn * 256 + wc * 32 + 4 * fq;
#pragma unroll
        for (int bj = 0; bj < 2; ++bj)
#pragma unroll
          for (int n = 0; n < 2; ++n) {
            const size_t o = rb + bj * 128 + n * 16;
            const f32x4 xv = *(const f32x4*)(x + o);
            *(f32x4*)(y1 + o) = xv * ALPHA + acc[ai][bj][m][n];
          }
      }
  }
};
struct EpiGate {
  static constexpr bool PERM = false, AFTER_DRAIN = false;
  const float* h1; const u16* projb; float* out;
  __device__ __forceinline__ void operator()(const f32x4 (&acc)[2][2][4][2], const pg8::Unit& u, int wr, int wc, int fr, int fq) const {
#pragma unroll
    for (int ai = 0; ai < 2; ++ai)
#pragma unroll
      for (int m = 0; m < 4; ++m) {
        const size_t rb = (size_t)(u.pm * 256 + ai * 128 + wr * 64 + m * 16 + fr) * D_ + u.pn * 256 + wc * 32 + 4 * fq;
#pragma unroll
        for (int bj = 0; bj < 2; ++bj)
#pragma unroll
          for (int n = 0; n < 2; ++n) {
            const size_t o = rb + bj * 128 + n * 16;
            const f32x4 hv = *(const f32x4*)(h1 + o);
            const u32x2 pj = *(const u32x2*)(projb + o);
            const f32x4 a = acc[ai][bj][m][n];
            f32x4 r;
            r[0] = ALPHA * hv[0] + bflo(pj[0]) / (1.f + __expf(-a[0])); r[1] = ALPHA * hv[1] + bfhi(pj[0]) / (1.f + __expf(-a[1]));
            r[2] = ALPHA * hv[2] + bflo(pj[1]) / (1.f + __expf(-a[2])); r[3] = ALPHA * hv[3] + bfhi(pj[1]) / (1.f + __expf(-a[3]));
            *(f32x4*)(out + o) = r;
          }
      }
  }
};

__device__ __forceinline__ int vblock(int bid, int nb) { return (nb & 7) ? bid : (bid & 7) * (nb >> 3) + (bid >> 3); }
__device__ __forceinline__ void tile_rc(int t, int Nt, int& tm, int& tn) {
  const int g = t / (8 * Nt), q = t % (8 * Nt);
  tn = q >> 3; tm = g * 8 + (q & 7);
}

__device__ void phase_inproj(const Params& p, char* smem, int bid, int nb) {
  {
    EpiInproj E{p.cqb(), p.ckvb(), p.Qf(), p.Kf(), p.VfT(), p.rss()};
    pg8::Gemm g{p.xb(), p.WinT(), T_, 4096, D_};
    pg8::StaticOrder S; S.init(T_, 4096, nb, bid);
    pg8::gemm_phase((PG8_LAS unsigned char*)smem, g, S, E, nullptr);
  }
  for (int t = vblock(bid, nb); t < 256; t += nb) {
    const int tm = t >> 3, ks = t & 7;
    f32x4 acc[2][4][4];
    gemm_core<2, 4>(p.xb() + ks * 256, D_, p.WinT() + ks * 256, D_, 256, tm * 256, 4096, smem, acc);
    const int tid = TID(), wid = tid >> 6, lane = tid & 63, wr = wid >> 2, wc = wid & 3, fr = lane & 15, fq = lane >> 4;
    if (wc == 0) {
#pragma unroll
      for (int h = 0; h < 2; ++h) {
        float* kd = p.krsum() + (size_t)(tm * 256 + wr * 128 + h * 64 + fq * 4) * 64 + fr;
#pragma unroll
        for (int m = 0; m < 4; ++m)
#pragma unroll
          for (int n = 0; n < 4; ++n)
#pragma unroll
            for (int j = 0; j < 4; ++j) atomicAdd(kd + (m * 16 + j) * 64 + n * 16, acc[h][m][n][j]);
      }
    }
  }
}

__device__ void phase_up(const Params& p, char* smem, int bid, int nb) {
  PG8_LAS unsigned char* lds = (PG8_LAS unsigned char*)smem;
  {
    EpiQup E{p.Qm(), p.rss()};
    pg8::Gemm g{p.cqb(), p.WuqT(), T_, 1536, 512};
    pg8::StaticOrder S; S.init(T_, 1536, nb, (bid + nb - 64) % nb);
    pg8::gemm_phase(lds, g, S, E, nullptr);
  }
  {
    EpiKVup E{p.Km(), p.VmT(), p.rss()};
    pg8::Gemm g{p.ckvb(), p.WukvT(), T_, 2048, 512};
    pg8::StaticOrder S; S.init(T_, 2048, nb, bid);
    pg8::gemm_phase(lds, g, S, E, nullptr);
  }
  {
    EpiProj E{p.projb()};
    pg8::Gemm g{p.pb(), p.WpT(), T_, 2048, 256};
    pg8::StaticOrder S; S.init(T_, 2048, nb, bid);
    pg8::gemm_phase(lds, g, S, E, nullptr);
  }
  for (int t = bid; t < 48; t += nb) {
    if (t >= 16) {
      const int r0 = (t - 16) * 256, tid = TID();
#pragma unroll 1
      for (int it = 0; it < 16; ++it) {
        const int pr = it * NT + tid, row = r0 + (pr >> 5), i = pr & 31, b = row >> 12, s = row & 4095;
        const float x1 = p.krsum()[(size_t)row * 64 + i], x2 = p.krsum()[(size_t)row * 64 + 32 + i];
        const float2 cs = p.cs()[(size_t)row * 32 + i];
        const u16 o1 = f2bf(x1 * cs.x - x2 * cs.y), o2 = f2bf(x1 * cs.y + x2 * cs.x);
#pragma unroll
        for (int hh = 0; hh < 8; ++hh) {
          u16* kd = p.Km() + ((size_t)(b * 8 + hh) * S_ + s) * 192 + 128;
          kd[i] = o1; kd[32 + i] = o2;
        }
      }
    } else {
      const int seq = t;
      if ((TID() >> 6) == 0) {
        const int lane = TID() & 63;
        const float* src = p.logf() + (size_t)seq * S_ + lane * 64;
        float* dst = p.Fk() + (size_t)seq * S_ + lane * 64;
        float sum = 0.f;
        for (int i = 0; i < 16; ++i) { const float4 v = *(const float4*)(src + i * 4); sum += v.x; sum += v.y; sum += v.z; sum += v.w; }
        float inc = sum;
#pragma unroll
        for (int d = 1; d < 64; d <<= 1) { const float o = __shfl_up(inc, d, 64); if (lane >= d) inc += o; }
        float run = inc - sum;
        for (int i = 0; i < 16; ++i) {
          const float4 v = *(const float4*)(src + i * 4); float4 o;
          run += v.x; o.x = run; run += v.y; o.y = run; run += v.z; o.z = run; run += v.w; o.w = run;
          *(float4*)(dst + i * 4) = o;
        }
      }
    }
  }
}

#ifdef ATTN_NAIVE
__device__ void phase_attn_naive(const Params& p, char* smem, int bid, int nb) {
  const int tid = TID(), lane = tid & 63, wid = tid >> 6;
  const int per = NB_ * 8 * S_, nrows = 2 * per;
  for (int r = bid * 4 + wid; r < nrows; r += nb * 4) {
    const int type = r / per, rr = r % per, bh = rr / S_, s = rr % S_;
    const int DQ = type ? 128 : 192;
    const u16* Q = type ? p.Qf() + ((size_t)bh * S_ + s) * 128 : p.Qm() + ((size_t)bh * S_ + s) * 192;
    const u16* Kb = type ? p.Kf() + (size_t)bh * S_ * 128 : p.Km() + (size_t)bh * S_ * 192;
    const u16* VT = (type ? p.VfT() : p.VmT()) + (size_t)bh * 128 * S_;
    const float* F = p.Fk() + (size_t)bh * S_;
    const float scale = type ? 0.08838834764831845f : 0.07216878364870322f;
    float m = -1e30f, l = 0.f;
    float acc[128];
#pragma unroll
    for (int d = 0; d < 128; ++d) acc[d] = 0.f;
    const float fqv = type ? F[s] : 0.f;
    for (int k0 = 0; k0 <= s; k0 += 64) {
      const int key = k0 + lane; const bool valid = key <= s; const int keyc = valid ? key : s;
      const u16* kr = Kb + (size_t)keyc * DQ;
      float sc = 0.f;
      for (int d = 0; d < DQ; d += 8) {
        const u32x4 kv = *(const u32x4*)(kr + d), qv = *(const u32x4*)(Q + d);
#pragma unroll
        for (int w = 0; w < 4; ++w) sc += bflo(kv[w]) * bflo(qv[w]) + bfhi(kv[w]) * bfhi(qv[w]);
      }
      sc *= scale;
      if (type) sc += fqv - F[keyc];
      if (!valid) sc = -1e30f;
      const float mx = wave_max(sc), mn = fmaxf(m, mx), alpha = __expf(m - mn);
      const float pr = valid ? __expf(sc - mn) : 0.f;
      m = mn; l = l * alpha + pr;
#pragma unroll
      for (int d = 0; d < 128; ++d) acc[d] = acc[d] * alpha + pr * bf2f(VT[(size_t)d * S_ + keyc]);
    }
    const float inv = 1.f / wave_sum(l);
    float o0 = 0.f, o1 = 0.f;
#pragma unroll
    for (int d = 0; d < 128; ++d) {
      const float o = wave_sum(acc[d]) * inv;
      if (lane == (d & 63)) { if (d < 64) o0 = o; else o1 = o; }
    }
    const int b = bh >> 3, hh = bh & 7;
    u16* od = p.omix() + ((size_t)(b * S_ + s)) * 2048 + type * 1024 + hh * 128;
    od[lane] = f2bf(o0); od[64 + lane] = f2bf(o1);
  }
}

#endif
typedef float f32x16 __attribute__((ext_vector_type(16)));
template <int TYPE>
__device__ __forceinline__ void attn_item(const Params& p, char* smem, int bh, int qb) {
  constexpr int DQK = TYPE ? 128 : 192, NKS = DQK / 16, KSTR = DQK * 2 + 16, VSTR = 128;
  constexpr int KCH = DQK / 8, NKL = 64 * KCH / NT;
  constexpr float C2 = (TYPE ? 0.08838834764831845f : 0.07216878364870322f) * 1.4426950408889634f;
  char* sK = smem; char* sV = smem + 51200; float* sF = (float*)(smem + 51200 + 32768);
  const int tid = TID(), lane = tid & 63, wid = tid >> 6, c = lane & 31, hi = lane >> 5;
  const u16* Qb = (TYPE ? p.Qf() : p.Qm()) + (size_t)bh * S_ * DQK;
  const u16* Kb = (TYPE ? p.Kf() : p.Km()) + (size_t)bh * S_ * DQK;
  const u16* Vb = (TYPE ? p.VfT() : p.VmT()) + (size_t)bh * 128 * S_;
  const float* Fb = p.Fk() + (size_t)bh * S_;
  const int qrow = qb * 256 + wid * 32;
  bf16x8 qf[NKS];
#pragma unroll
  for (int ks = 0; ks < NKS; ++ks) qf[ks] = *(const bf16x8*)(Qb + (size_t)(qrow + c) * DQK + ks * 16 + hi * 8);
  if (TYPE == 0) {
    const float2* csr = p.cs() + (size_t)((bh >> 3) * S_ + qrow + c) * 32;
#pragma unroll
    for (int kk = 0; kk < 2; ++kk) {
      u32x4 x1 = *reinterpret_cast<u32x4*>(&qf[(NKS - 4) + kk]), x2 = *reinterpret_cast<u32x4*>(&qf[(NKS - 2) + kk]);
#pragma unroll
      for (int w = 0; w < 4; ++w) {
        const float4 cs = *(const float4*)(csr + 16 * kk + 8 * hi + 2 * w);
        const float a0 = bflo(x1[w]), a1 = bfhi(x1[w]), b0 = bflo(x2[w]), b1 = bfhi(x2[w]);
        x1[w] = pk2(a0 * cs.x - b0 * cs.y, a1 * cs.z - b1 * cs.w);
        x2[w] = pk2(a0 * cs.y + b0 * cs.x, a1 * cs.w + b1 * cs.z);
      }
      qf[(NKS - 4) + kk] = *reinterpret_cast<bf16x8*>(&x1); qf[(NKS - 2) + kk] = *reinterpret_cast<bf16x8*>(&x2);
    }
  }
  f32x16 o[4];
#pragma unroll
  for (int db = 0; db < 4; ++db)
#pragma unroll
    for (int r = 0; r < 16; ++r) o[db][r] = 0.f;
  float m = -1e30f, l = 0.f;
  const int ntiles = 4 * qb + 4;
  u32x4 kreg[NKL];
  float4 freg = make_float4(0.f, 0.f, 0.f, 0.f);
  const unsigned koff = (unsigned)tid * 16u;
  auto load_k = [&](int kt) {
    const char* kb = (const char*)(Kb + (size_t)kt * 64 * DQK);
#pragma unroll
    for (int i = 0; i < NKL; ++i) kreg[i] = *(const u32x4*)(kb + i * 8192 + koff);
    if (TYPE) { if (tid < 16) freg = *(const float4*)(Fb + kt * 64 + tid * 4); }
  };
  const unsigned voff = (unsigned)((((tid >> 3) * S_) + (((tid & 7) ^ ((tid >> 4) & 7)) * 8)) * 2);
  auto load_v = [&](int kt) {
    const char* vb = (const char*)(Vb + kt * 64);
    char* dst = sV + (kt & 1) * 16384 + tid * 16;
#pragma unroll
    for (int i = 0; i < 2; ++i)
      __builtin_amdgcn_global_load_lds((const unsigned*)(vb + (size_t)i * 64 * S_ * 2 + voff), (unsigned*)(dst + i * 8192), 16, 0, 0);
  };
  auto store_tile = [&](int kt) {
    char* sKw = sK + (kt & 1) * 25600;
#pragma unroll
    for (int i = 0; i < NKL; ++i) { const int ch = tid + NT * i, key = ch / KCH, dc = ch % KCH; *(u32x4*)(sKw + key * KSTR + dc * 16) = kreg[i]; }
    if (TYPE) { if (tid < 16) { const float L2E = 1.4426950408889634f; *(float4*)(sF + (kt & 1) * 64 + tid * 4) = make_float4(freg.x * L2E, freg.y * L2E, freg.z * L2E, freg.w * L2E); } }
  };
  const int krow = (c & 19) | ((c & 4) << 1) | ((c & 8) >> 1);
  const char* ka0 = sK + krow * KSTR + hi * 16;
  const char* ka1 = ka0 + 32 * KSTR;
  const int vx = (c >> 1) & 7;
  int vo[2][2];
#pragma unroll
  for (int kb = 0; kb < 2; ++kb)
#pragma unroll
    for (int s2 = 0; s2 < 2; ++s2) vo[kb][s2] = c * VSTR + (((4 * kb + 2 * s2 + hi) ^ vx) * 16);
  load_k(0); load_v(0);
  store_tile(0);
#pragma unroll 1
  for (int kt = 0; kt < ntiles; ++kt) {
    asm volatile("s_waitcnt vmcnt(0) lgkmcnt(0)" ::: "memory");
    __syncthreads();
    if (kt + 1 < ntiles) { load_k(kt + 1); load_v(kt + 1); }
    const int k0 = kt * 64;
    const char* sVc = sV + (kt & 1) * 16384;
    const int kbo = (kt & 1) * 25600;
    const float* sFc = sF + (kt & 1) * 64;
    if (k0 <= qrow + 31) {
      f32x16 p0, p1;
#pragma unroll
      for (int r = 0; r < 16; ++r) { p0[r] = 0.f; p1[r] = 0.f; }
#pragma unroll
      for (int ks = 0; ks < NKS; ++ks) {
        const bf16x8 a0 = *(const bf16x8*)(ka0 + kbo + ks * 32), a1 = *(const bf16x8*)(ka1 + kbo + ks * 32);
        p0 = __builtin_amdgcn_mfma_f32_32x32x16_bf16(a0, qf[ks], p0, 0, 0, 0);
        p1 = __builtin_amdgcn_mfma_f32_32x32x16_bf16(a1, qf[ks], p1, 0, 0, 0);
      }
      if (TYPE) {
#pragma unroll
        for (int s = 0; s < 2; ++s) {
          const float4 f0 = *(const float4*)(sFc + 16 * s + 8 * hi), f1 = *(const float4*)(sFc + 16 * s + 8 * hi + 4);
          const float4 g0 = *(const float4*)(sFc + 32 + 16 * s + 8 * hi), g1 = *(const float4*)(sFc + 32 + 16 * s + 8 * hi + 4);
          p0[8 * s + 0] = p0[8 * s + 0] * C2 - f0.x; p0[8 * s + 1] = p0[8 * s + 1] * C2 - f0.y; p0[8 * s + 2] = p0[8 * s + 2] * C2 - f0.z; p0[8 * s + 3] = p0[8 * s + 3] * C2 - f0.w;
          p0[8 * s + 4] = p0[8 * s + 4] * C2 - f1.x; p0[8 * s + 5] = p0[8 * s + 5] * C2 - f1.y; p0[8 * s + 6] = p0[8 * s + 6] * C2 - f1.z; p0[8 * s + 7] = p0[8 * s + 7] * C2 - f1.w;
          p1[8 * s + 0] = p1[8 * s + 0] * C2 - g0.x; p1[8 * s + 1] = p1[8 * s + 1] * C2 - g0.y; p1[8 * s + 2] = p1[8 * s + 2] * C2 - g0.z; p1[8 * s + 3] = p1[8 * s + 3] * C2 - g0.w;
          p1[8 * s + 4] = p1[8 * s + 4] * C2 - g1.x; p1[8 * s + 5] = p1[8 * s + 5] * C2 - g1.y; p1[8 * s + 6] = p1[8 * s + 6] * C2 - g1.z; p1[8 * s + 7] = p1[8 * s + 7] * C2 - g1.w;
        }
      } else {
#pragma unroll
        for (int r = 0; r < 16; ++r) { p0[r] *= C2; p1[r] *= C2; }
      }
      if (k0 + 63 > qrow) {
        const int lim = qrow + c - k0 - 8 * hi;
        const float NEG = -__builtin_inff();
#pragma unroll
        for (int r = 0; r < 16; ++r) {
          const int kb = 16 * (r >> 3) + (r & 7);
          if (kb > lim) p0[r] = NEG;
          if (kb + 32 > lim) p1[r] = NEG;
        }
      }
      float mx = p0[0];
#pragma unroll
      for (int r = 1; r < 16; ++r) mx = fmaxf(mx, p0[r]);
#pragma unroll
      for (int r = 0; r < 16; ++r) mx = fmaxf(mx, p1[r]);
      {
        auto rr = __builtin_amdgcn_permlane32_swap(__float_as_uint(mx), __float_as_uint(mx), false, false);
        mx = fmaxf(__uint_as_float(rr[0]), __uint_as_float(rr[1]));
      }
      const float mn = fmaxf(m, mx);
      const float alpha = __builtin_amdgcn_exp2f(m - mn);
      m = mn;
      if (!__all(alpha == 1.f)) {
#pragma unroll
        for (int db = 0; db < 4; ++db)
#pragma unroll
          for (int r = 0; r < 16; ++r) o[db][r] *= alpha;
      }
      float ps = 0.f;
#pragma unroll
      for (int r = 0; r < 16; ++r) { p0[r] = __builtin_amdgcn_exp2f(p0[r] - mn); p1[r] = __builtin_amdgcn_exp2f(p1[r] - mn); ps += p0[r] + p1[r]; }
      l = l * alpha + ps;
      bf16x8 pa[2][2];
#pragma unroll
      for (int s = 0; s < 2; ++s) {
        u32x4 w0 = {pk2(p0[8 * s + 0], p0[8 * s + 1]), pk2(p0[8 * s + 2], p0[8 * s + 3]), pk2(p0[8 * s + 4], p0[8 * s + 5]), pk2(p0[8 * s + 6], p0[8 * s + 7])};
        u32x4 w1 = {pk2(p1[8 * s + 0], p1[8 * s + 1]), pk2(p1[8 * s + 2], p1[8 * s + 3]), pk2(p1[8 * s + 4], p1[8 * s + 5]), pk2(p1[8 * s + 6], p1[8 * s + 7])};
        pa[0][s] = *reinterpret_cast<bf16x8*>(&w0); pa[1][s] = *reinterpret_cast<bf16x8*>(&w1);
      }
#pragma unroll
      for (int db = 0; db < 4; ++db)
#pragma unroll
        for (int kb = 0; kb < 2; ++kb)
#pragma unroll
          for (int s = 0; s < 2; ++s) {
            const bf16x8 av = *(const bf16x8*)(sVc + db * 32 * VSTR + vo[kb][s]);
            o[db] = __builtin_amdgcn_mfma_f32_32x32x16_bf16(av, pa[kb][s], o[db], 0, 0, 0);
          }
    }
    if (kt + 1 < ntiles) store_tile(kt + 1);
  }
  {
    auto rr = __builtin_amdgcn_permlane32_swap(__float_as_uint(l), __float_as_uint(l), false, false);
    const float inv = 1.f / (__uint_as_float(rr[0]) + __uint_as_float(rr[1]));
    const int b = bh >> 3, hh = bh & 7;
    u16* od = p.omix() + ((size_t)(b * S_ + qrow + c)) * 2048 + TYPE * 1024 + hh * 128 + 4 * hi;
#pragma unroll
    for (int db = 0; db < 4; ++db)
#pragma unroll
      for (int g = 0; g < 4; ++g)
        *(u32x2*)(od + 32 * db + 8 * g) = u32x2{pk2(o[db][4 * g] * inv, o[db][4 * g + 1] * inv), pk2(o[db][4 * g + 2] * inv, o[db][4 * g + 3] * inv)};
  }
}

__device__ void phase_attn(const Params& p, char* smem, int bid, int nb) {
  int* sItem = (int*)(smem + 90000);
  const int x = bid & 7;
  unsigned* q = p.ctr() + 32 + x;
  for (;;) {
    __syncthreads();
    if (TID() == 0) *sItem = (int)atomicAdd(q, 1u);
    __syncthreads();
    const int item = *sItem;
    if (item >= 64) break;
    const int qb = 15 - (item >> 2), r = item & 3, type = r >> 1, bh = x + 8 * (r & 1);
    if (type == 0) attn_item<0>(p, smem, bh, qb); else attn_item<1>(p, smem, bh, qb);
  }
  unsigned* qc = p.ctr() + 48;
  for (;;) {
    __syncthreads();
    if (TID() == 0) *sItem = (int)atomicAdd(qc, 1u);
    __syncthreads();
    const int chunk = *sItem;
    if (chunk >= 512) break;
    quant_chunk(p, chunk);
  }
}

__device__ void phase_outproj(const Params& p, char* smem, int bid, int nb) {
  EpiOut E{p.x, p.y1()};
  pg8::Gemm g{p.omix(), p.WoutT(), T_, D_, D_};
  pg8::StaticOrder S; S.init(T_, D_, nb, bid);
  pg8::gemm_phase((PG8_LAS unsigned char*)smem, g, S, E, nullptr);
}

__device__ void phase_ln1(const Params& p, int bid, int nb) {
  const int lane = TID() & 63, wid = TID() >> 6;
  for (int t = bid * 8 + wid; t < T_; t += nb * 8) {
    float* row = p.y1() + (size_t)t * D_;
    float4 v[8];
    float sum = 0.f;
#pragma unroll
    for (int i = 0; i < 8; ++i) { v[i] = *(const float4*)(row + (i * 64 + lane) * 4); sum += (v[i].x + v[i].y) + (v[i].z + v[i].w); }
    const float mu = wave_sum(sum) * (1.f / D_);
    float sq = 0.f;
#pragma unroll
    for (int i = 0; i < 8; ++i) {
      v[i].x -= mu; v[i].y -= mu; v[i].z -= mu; v[i].w -= mu;
      sq += (v[i].x * v[i].x + v[i].y * v[i].y) + (v[i].z * v[i].z + v[i].w * v[i].w);
    }
    const float rstd = rsqrtf(wave_sum(sq) * (1.f / D_) + EPS);
#pragma unroll
    for (int i = 0; i < 8; ++i) {
      const int c = (i * 64 + lane) * 4;
      const float4 g = *(const float4*)(p.ln1_g + c), bb = *(const float4*)(p.ln1_b + c);
      float4 o; o.x = v[i].x * rstd * g.x + bb.x; o.y = v[i].y * rstd * g.y + bb.y; o.z = v[i].z * rstd * g.z + bb.z; o.w = v[i].w * rstd * g.w + bb.w;
      *(float4*)(row + c) = o;
      *(u32x2*)(p.h1b() + (size_t)t * D_ + c) = u32x2{pk2(o.x, o.y), pk2(o.z, o.w)};
    }
  }
}

__device__ __forceinline__ void ins16(unsigned (&t)[16], unsigned x) {
#pragma unroll
  for (int i = 0; i < 16; ++i) { const unsigned hi = t[i] > x ? t[i] : x; x = t[i] > x ? x : t[i]; t[i] = hi; }
}
__device__ __forceinline__ void ins16p(unsigned (&ck)[16], int (&ce)[16], unsigned x, int xe) {
#pragma unroll
  for (int i = 0; i < 16; ++i) {
    const bool sw = x > ck[i];
    const unsigned nk = sw ? x : ck[i], nx = sw ? ck[i] : x;
    const int ne = sw ? xe : ce[i], nxe = sw ? ce[i] : xe;
    ck[i] = nk; x = nx; ce[i] = ne; xe = nxe;
  }
}
__device__ __forceinline__ float unordkey(unsigned k) { return __uint_as_float((k & 0x80000000u) ? (k & 0x7fffffffu) : ~k); }

__device__ __forceinline__ void score_block(const u16* kH, const u16* kL, const bf16x8 (&qh)[4], const bf16x8 (&ql)[4], int hi, unsigned (&t)[16]) {
#pragma unroll
  for (int i = 0; i < 16; ++i) t[i] = 0u;
#pragma unroll 1
  for (int kb = 0; kb < 4; ++kb) {
    f32x16 sc;
#pragma unroll
    for (int r = 0; r < 16; ++r) sc[r] = 0.f;
#pragma unroll
    for (int ks = 0; ks < 4; ++ks) {
      const bf16x8 ah = *(const bf16x8*)(kH + kb * 32 * 64 + ks * 16), al = *(const bf16x8*)(kL + kb * 32 * 64 + ks * 16);
      sc = __builtin_amdgcn_mfma_f32_32x32x16_bf16(ah, qh[ks], sc, 0, 0, 0);
      sc = __builtin_amdgcn_mfma_f32_32x32x16_bf16(ah, ql[ks], sc, 0, 0, 0);
      sc = __builtin_amdgcn_mfma_f32_32x32x16_bf16(al, qh[ks], sc, 0, 0, 0);
    }
    const unsigned base = (unsigned)(127 - 32 * kb) - 4u * (unsigned)hi;
#pragma unroll
    for (int r = 0; r < 16; ++r) ins16(t, (ordkey(sc[r]) & ~127u) | (base - (unsigned)((r & 3) + 8 * (r >> 2))));
  }
  unsigned other[16];
#pragma unroll
  for (int i = 0; i < 16; ++i) {
    auto rr = __builtin_amdgcn_permlane32_swap(t[i], t[i], false, false);
    other[i] = hi ? rr[0] : rr[1];
  }
#pragma unroll 1
  for (int i = 0; i < 16; ++i) {
    unsigned x = other[0];
#pragma unroll
    for (int k = 1; k < 16; ++k) x = (i == k) ? other[k] : x;
    ins16(t, x);
  }
}

__device__ __forceinline__ void route_tile(const Params& p, char* smem, f32x4 (&acc)[4][4], int tm, int h) {
  const int tid = TID(), wid = tid >> 6, lane = tid & 63, wr = wid >> 1, wc = wid & 1, fr = lane & 15, fq = lane >> 4;
  __syncthreads();
  float* Qw = (float*)smem + wid * (64 * 65);
#pragma unroll
  for (int m = 0; m < 4; ++m)
#pragma unroll
    for (int n = 0; n < 4; ++n)
#pragma unroll
      for (int j = 0; j < 4; ++j) Qw[(m * 16 + fq * 4 + j) * 65 + n * 16 + fr] = acc[m][n][j];
  asm volatile("s_waitcnt lgkmcnt(0)" ::: "memory");
  const int c = lane & 31, hi = lane >> 5;
  bf16x8 qh[2][4], ql[2][4];
#pragma unroll
  for (int tb = 0; tb < 2; ++tb)
#pragma unroll
    for (int ks = 0; ks < 4; ++ks) {
      float v[8]; unsigned wh[4], wl[4];
#pragma unroll
      for (int j = 0; j < 8; ++j) v[j] = Qw[(tb * 32 + c) * 65 + 16 * ks + 8 * hi + j];
#pragma unroll
      for (int w = 0; w < 4; ++w) {
        wh[w] = pk2(v[2 * w], v[2 * w + 1]);
        wl[w] = pk2(v[2 * w] - bflo(wh[w]), v[2 * w + 1] - bfhi(wh[w]));
      }
      u32x4 uh = {wh[0], wh[1], wh[2], wh[3]}, ul = {wl[0], wl[1], wl[2], wl[3]};
      qh[tb][ks] = *reinterpret_cast<bf16x8*>(&uh); ql[tb][ks] = *reinterpret_cast<bf16x8*>(&ul);
    }
  const u16* kH = p.keyH() + ((size_t)(wc * 8 + h) * 128 + c) * 64 + 8 * hi;
  const u16* kL = p.keyL() + ((size_t)(wc * 8 + h) * 128 + c) * 64 + 8 * hi;
  unsigned t0[16], t1[16];
  score_block(kH, kL, qh[0], ql[0], hi, t0);
  score_block(kH, kL, qh[1], ql[1], hi, t1);
  unsigned t[16];
#pragma unroll
  for (int i = 0; i < 16; ++i) t[i] = hi ? t1[i] : t0[i];
  __syncthreads();
  unsigned* L = (unsigned*)smem;
#pragma unroll
  for (int r = 0; r < 16; ++r) L[(wc * 16 + r) * 256 + wr * 64 + lane] = t[r];
  __syncthreads();
  if (wid < 4) {
    const int tok = wid * 64 + lane;
    unsigned ck[16]; int ce[16];
#pragma unroll
    for (int i = 0; i < 16; ++i) { ck[i] = 0u; ce[i] = 0; }
#pragma unroll 1
    for (int a = 0; a < 16; ++a) {
      const unsigned ka = L[a * 256 + tok];
      const int i1a = (127 - (int)(ka & 127u)) * 128; const float v1a = unordkey(ka & ~127u);
      const int nbm1 = (int)((0x1112347FULL >> (4 * a)) & 15ULL);
#pragma unroll 1
      for (int b = 0; b <= nbm1; ++b) {
        const unsigned kb = L[(16 + b) * 256 + tok];
        const int i2b = 127 - (int)(kb & 127u); const float v2b = unordkey(kb & ~127u);
        ins16p(ck, ce, ordkey(v1a + v2b), i1a + i2b);
      }
    }
    float ex[16], sum = 0.f;
    const float mx = unordkey(ck[0]);
#pragma unroll
    for (int r = 0; r < 16; ++r) { ex[r] = __expf(unordkey(ck[r]) - mx); sum += ex[r]; }
    const float inv = 1.f / sum;
    const size_t o = ((size_t)(tm * 256 + tok) * 8 + h) * 16;
    int* ed = p.eidxG() + o; float* gd = p.gateG() + o;
#pragma unroll
    for (int r = 0; r < 16; r += 4) {
      *(int4*)(ed + r) = make_int4(ce[r], ce[r + 1], ce[r + 2], ce[r + 3]);
      *(float4*)(gd + r) = make_float4(ex[r] * inv, ex[r + 1] * inv, ex[r + 2] * inv, ex[r + 3] * inv);
    }
  }
}

__device__ void phase_mid(const Params& p, char* smem, int bid, int nb) {
  {
    EpiGate E{p.y1(), p.projb(), p.out};
    pg8::Gemm g{p.h1b(), p.WgT(), T_, D_, D_};
    pg8::StaticOrder S; S.init(T_, D_, nb, bid);
    pg8::gemm_phase((PG8_LAS unsigned char*)smem, g, S, E, nullptr);
  }
  for (int t = vblock(bid, nb); t < 32 * 8; t += nb) {
    int tm, tn; tile_rc(t, 8, tm, tn);
    f32x4 acc[1][4][4];
    gemm_core<4, 2>(p.h1b(), D_, p.WpqT(), D_, D_, tm * 256, tn * 128, smem, acc);
    route_tile(p, smem, acc[0], tm, tn);
  }
}

__device__ __forceinline__ float gelu_exact(float a) {
  const float x = fabsf(a) * 0.7071067811865476f;
  const float t = __builtin_amdgcn_rcpf(1.f + 0.3275911f * x);
  const float poly = t * (0.254829592f + t * (-0.284496736f + t * (1.421413741f + t * (-1.453152027f + t * 1.061405429f))));
  const float er = 1.f - poly * __expf(-x * x);
  return 0.5f * a * (1.f + (a < 0.f ? -er : er));
}

template <int NPER, int IDXMASK>
__device__ __forceinline__ int top16(unsigned (&k)[NPER], int lane) {
  int mine = 0;
#pragma unroll 1
  for (int r = 0; r < 16; ++r) {
    unsigned loc = k[0];
#pragma unroll
    for (int i = 1; i < NPER; ++i) loc = loc > k[i] ? loc : k[i];
    const unsigned best = wave_umax(loc);
#pragma unroll
    for (int i = 0; i < NPER; ++i) if (k[i] == best) k[i] = 0u;
    if (lane == r) mine = IDXMASK - (int)(best & (unsigned)IDXMASK);
  }
  return mine;
}

__device__ void phase_peer(const Params& p, char* smem, int bid, int nb) {
  const int tid = TID(), lane = tid & 63, wid = tid >> 6;
  float* qs = (float*)smem;
  float* sc = (float*)(smem + 8192);
  int* eidx = (int*)(smem + 24576);
  float* gts = (float*)(smem + 40960);
  for (int it = bid; it < T_ / 32; it += nb) {
    const int t0 = it * 32;
#pragma unroll
    for (int i = 0; i < 2; ++i) {
      const int idx = (i * NT + tid) * 4;
      *(int4*)(eidx + idx) = *(const int4*)(p.eidxG() + (size_t)t0 * 128 + idx);
      *(float4*)(gts + idx) = *(const float4*)(p.gateG() + (size_t)t0 * 128 + idx);
    }
    __syncthreads();
    for (int ti = 0; ti < 4; ++ti) {
      const int tok = wid * 4 + ti, t = t0 + tok;
      typedef float f32x32 __attribute__((ext_vector_type(32)));
      typedef unsigned u32x6 __attribute__((ext_vector_type(6)));
      float hreg[32];
      f32x32 o;
#pragma unroll
      for (int q = 0; q < 8; ++q) {
        const u32x2 hv = *(const u32x2*)(p.h1b() + (size_t)t * D_ + (q * 64 + lane) * 4);
        hreg[q * 4] = bflo(hv[0]); hreg[q * 4 + 1] = bfhi(hv[0]); hreg[q * 4 + 2] = bflo(hv[1]); hreg[q * 4 + 3] = bfhi(hv[1]);
      }
#pragma unroll
      for (int i = 0; i < 32; ++i) o[i] = 0.f;
      const float* Us = p.Us(); const float* Vs = p.Vs();
      const unsigned char* Uq = p.Uq() + lane * 24;
      const int* ep = eidx + tok * 128; const float* gp = gts + tok * 128;
      u32x4 uA4[2], vA4[2], uB4[2], vB4[2]; u32x2 uA2[2], vA2[2], uB2[2], vB2[2];
      float gA[2], suA[2], svA[2], gB[2], suB[2], svB[2];
#define PEER_LOAD(U4, U2, V4, V2, G, SU, SV, J0)                                                        \
      _Pragma("unroll") for (int jj = 0; jj < 2; ++jj) {                                                \
        const int e = __builtin_amdgcn_readfirstlane(ep[(J0) + jj]);                                    \
        G[jj] = gp[(J0) + jj]; SU[jj] = Us[e]; SV[jj] = Vs[e];                                          \
        const unsigned char* up = Uq + (size_t)e * 3072; const unsigned char* vp = up + 1536;           \
        U2[jj] = *(const u32x2*)(up); U4[jj] = *(const u32x4*)(up + 8);                                 \
        V2[jj] = *(const u32x2*)(vp); V4[jj] = *(const u32x4*)(vp + 8);                                 \
      }
#define PEER_COMPUTE(U4, U2, V4, V2, G, SU, SV)                                                         \
      _Pragma("unroll") for (int jj = 0; jj < 2; ++jj) {                                                \
        const u32x6 uw = {U2[jj][0], U2[jj][1], U4[jj][0], U4[jj][1], U4[jj][2], U4[jj][3]};            \
        const f32x32 ud = __builtin_amdgcn_cvt_scalef32_pk32_f32_fp6(uw, 1.0f);                         \
        float d0 = 0.f, d1 = 0.f, d2 = 0.f, d3 = 0.f;                                                   \
        _Pragma("unroll") for (int i = 0; i < 32; i += 4) {                                             \
          d0 += ud[i] * hreg[i]; d1 += ud[i + 1] * hreg[i + 1]; d2 += ud[i + 2] * hreg[i + 2]; d3 += ud[i + 3] * hreg[i + 3]; \
        }                                                                                               \
        const float av = wave_sum((d0 + d1) + (d2 + d3)) * SU[jj];                                      \
        const float act = gelu_exact(av) * G[jj] * SV[jj];                                              \
        const u32x6 vw = {V2[jj][0], V2[jj][1], V4[jj][0], V4[jj][1], V4[jj][2], V4[jj][3]};            \
        const f32x32 vd = __builtin_amdgcn_cvt_scalef32_pk32_f32_fp6(vw, 1.0f);                         \
        o += vd * act;                                                                                  \
      }
      PEER_LOAD(uA4, uA2, vA4, vA2, gA, suA, svA, 0)
#pragma unroll 1
      for (int j0 = 0; j0 < 128; j0 += 4) {
        PEER_LOAD(uB4, uB2, vB4, vB2, gB, suB, svB, j0 + 2)
        PEER_COMPUTE(uA4, uA2, vA4, vA2, gA, suA, svA)
        if (j0 + 4 < 128) { PEER_LOAD(uA4, uA2, vA4, vA2, gA, suA, svA, j0 + 4) }
        PEER_COMPUTE(uB4, uB2, vB4, vB2, gB, suB, svB)
      }
#undef PEER_LOAD
#undef PEER_COMPUTE
      float* orow = p.out + (size_t)t * D_ + lane * 4;
      float sum = 0.f;
#pragma unroll
      for (int q = 0; q < 8; ++q) {
        const float4 r0 = *(const float4*)(orow + q * 256);
        o[q * 4 + 0] += r0.x; o[q * 4 + 1] += r0.y; o[q * 4 + 2] += r0.z; o[q * 4 + 3] += r0.w;
      }
#pragma unroll
      for (int i = 0; i < 32; ++i) sum += o[i];
      const float mu = wave_sum(sum) * (1.f / D_);
      float sq = 0.f;
#pragma unroll
      for (int i = 0; i < 32; ++i) { o[i] -= mu; sq += o[i] * o[i]; }
      const float rstd = rsqrtf(wave_sum(sq) * (1.f / D_) + EPS);
#pragma unroll
      for (int q = 0; q < 8; ++q) {
        const int col = (q * 64 + lane) * 4;
        const float4 g0 = *(const float4*)(p.ln2_g + col), b0 = *(const float4*)(p.ln2_b + col);
        float4 w0;
        w0.x = o[q * 4 + 0] * rstd * g0.x + b0.x; w0.y = o[q * 4 + 1] * rstd * g0.y + b0.y;
        w0.z = o[q * 4 + 2] * rstd * g0.z + b0.z; w0.w = o[q * 4 + 3] * rstd * g0.w + b0.w;
        *(float4*)(orow + q * 256) = w0;
      }
    }
    __syncthreads();
  }
}

template <int PH>
__device__ __forceinline__ void run_phase(const Params& p, char* smem, int bid, int nb) {
  if constexpr (PH == 0) phase_prep(p, smem, bid, nb);
  if constexpr (PH == 1) phase_inproj(p, smem, bid, nb);
  if constexpr (PH == 2) phase_up(p, smem, bid, nb);
#ifdef ATTN_NAIVE
  if constexpr (PH == 3) phase_attn_naive(p, smem, bid, nb);
#else
  if constexpr (PH == 3) phase_attn(p, smem, bid, nb);
#endif
  if constexpr (PH == 4) phase_outproj(p, smem, bid, nb);
  if constexpr (PH == 5) phase_ln1(p, bid, nb);
  if constexpr (PH == 6) phase_mid(p, smem, bid, nb);
  if constexpr (PH == 7) phase_peer(p, smem, bid, nb);
}

template <int PH>
__global__ void __launch_bounds__(NT, 2) phase_kernel(Params p) {
  __shared__ __attribute__((aligned(16))) char smem[SMEM_BYTES];
  run_phase<PH>(p, smem, blockIdx.x, gridDim.x);
}

#define BW_CENSUS(j) (256 + (j) * 32)
#define BW_XSUB(j) (256 + 512 + (j) * 32)
#define BW_XGEN(j) (256 + 1024 + (j) * 32)
#define BW_TOP (256 + 1536)
#define BW_TOPGEN (256 + 1568)
__device__ __forceinline__ unsigned bw_ld(unsigned* p) { return __hip_atomic_load(p, __ATOMIC_RELAXED, __HIP_MEMORY_SCOPE_AGENT); }
__device__ __forceinline__ unsigned bw_add(unsigned* p, unsigned v) { return __hip_atomic_fetch_add(p, v, __ATOMIC_RELAXED, __HIP_MEMORY_SCOPE_AGENT); }
__device__ __forceinline__ unsigned xcc_id() { return (unsigned)__builtin_amdgcn_s_getreg((3 << 11) | 20) & 0xFu; }

__device__ __forceinline__ void grid_barrier(unsigned* bar, unsigned* st  ) {
  asm volatile("s_waitcnt vmcnt(0)" ::: "memory");
  __syncthreads();
  if (threadIdx.x == 0) {
    __builtin_amdgcn_s_waitcnt(0);
    const unsigned x = xcc_id();
    unsigned nloc = st[0], nx = st[1];
    if (nloc == 0u) {
      const unsigned G = gridDim.x;
      for (;;) {
        unsigned sum = 0u, cnt = 0u, mine = 0u;
#pragma unroll
        for (unsigned j = 0; j < 16; ++j) { const unsigned c = bw_ld(&bar[BW_CENSUS(j)]); sum += c; cnt += (c > 0u) ? 1u : 0u; mine = (j == x) ? c : mine; }
        nloc = mine; nx = cnt;
        if (sum == G) break;
        __builtin_amdgcn_s_sleep(1);
      }
      st[0] = nloc; st[1] = nx;
    }
    const unsigned old = bw_add(&bar[BW_XSUB(x)], 1u);
    const unsigned gen = old / nloc;
    if (old + 1u == (gen + 1u) * nloc) {
      __builtin_amdgcn_fence(__ATOMIC_RELEASE, "agent");
      asm volatile("s_waitcnt vmcnt(0)" ::: "memory");
      const unsigned og = bw_add(&bar[BW_TOP], 1u);
      const unsigned tg = og / nx;
      if (og + 1u == (tg + 1u) * nx) bw_add(&bar[BW_TOPGEN], 1u);
      else while (bw_ld(&bar[BW_TOPGEN]) == tg) __builtin_amdgcn_s_sleep(1);
      __builtin_amdgcn_fence(__ATOMIC_ACQUIRE, "agent");
      bw_add(&bar[BW_XGEN(x)], 1u);
      asm volatile("s_waitcnt vmcnt(0)" ::: "memory");
    } else {
      while (bw_ld(&bar[BW_XGEN(x)]) == gen) __builtin_amdgcn_s_sleep(1);
      __builtin_amdgcn_fence(__ATOMIC_ACQUIRE, "agent");
      asm volatile("s_waitcnt vmcnt(0)" ::: "memory");
    }
  }
  __syncthreads();
}

#if SINGLE_LAUNCH
typedef const __attribute__((address_space(4))) unsigned long long* kargp_t;
static_assert(sizeof(Params) % 8 == 0, "Params must be a pack of 8-byte fields");
#define RUN_PHASE(N) run_phase<N>(p_, smem, bid, nb);
__global__ void __launch_bounds__(NT, 2) fwd_kernel(Params p_) {
  __shared__ __attribute__((aligned(16))) char smem[SMEM_BYTES + 64];
  const int bid = blockIdx.x, nb = gridDim.x;
  unsigned* bar = (unsigned*)(p_.ws + O_CTR);
  unsigned* st = (unsigned*)(smem + SMEM_BYTES);
  if (threadIdx.x == 0) { st[0] = 0u; st[1] = 0u; (void)bw_add(&bar[BW_CENSUS(xcc_id())], 1u); }
  if (p_.out == nullptr) cg::this_grid().sync();
  RUN_PHASE(0) grid_barrier(bar, st);
  RUN_PHASE(1) grid_barrier(bar, st);
  RUN_PHASE(2) grid_barrier(bar, st);
  RUN_PHASE(3) grid_barrier(bar, st);
  RUN_PHASE(4) grid_barrier(bar, st);
  RUN_PHASE(5) grid_barrier(bar, st);
  RUN_PHASE(6) grid_barrier(bar, st);
  RUN_PHASE(7)
}
#endif

extern "C" void kernel_launch(void* const* d_in, const int* in_sizes, int n_in, void* d_out, int out_size,
                              void* d_ws, size_t ws_size, hipStream_t stream) {
  (void)in_sizes; (void)n_in; (void)out_size; (void)ws_size;
  Params p{};
  p.x = (const float*)d_in[0]; p.p = (const float*)d_in[1]; p.positions = (const int*)d_in[2];
  p.w_in = (const float*)d_in[3]; p.b_forget = (const float*)d_in[4]; p.g_q = (const float*)d_in[5];
  p.w_uq = (const float*)d_in[6]; p.g_kv = (const float*)d_in[7]; p.w_ukv = (const float*)d_in[8];
  p.w_out = (const float*)d_in[9]; p.ln1_g = (const float*)d_in[10]; p.ln1_b = (const float*)d_in[11];
  p.peer_wq = (const float*)d_in[12]; p.keys1 = (const float*)d_in[13]; p.keys2 = (const float*)d_in[14];
  p.peer_u = (const float*)d_in[15]; p.peer_v = (const float*)d_in[16]; p.wgate = (const float*)d_in[17];
  p.wproj = (const float*)d_in[18]; p.ln2_g = (const float*)d_in[19]; p.ln2_b = (const float*)d_in[20];
  p.out = (float*)d_out;
  p.ws = (char*)d_ws;

  static int grid_blocks = 0;
  if (!grid_blocks) {
    int dev = 0, cus = 0, per_cu = 0;
    (void)hipGetDevice(&dev);
    (void)hipDeviceGetAttribute(&cus, hipDeviceAttributeMultiprocessorCount, dev);
#if SINGLE_LAUNCH
    (void)hipOccupancyMaxActiveBlocksPerMultiprocessor(&per_cu, fwd_kernel, NT, 0);
#else
    per_cu = 2;
#endif
    if (per_cu > 1) per_cu = 1;
    if (per_cu < 1) per_cu = 1;
    grid_blocks = cus * per_cu;
  }
#if SINGLE_LAUNCH
  (void)hipMemsetAsync(d_ws, 0, 16384, stream);
  void* args[] = {&p};
  hipError_t e = hipLaunchCooperativeKernel((void*)fwd_kernel, dim3(grid_blocks), dim3(NT), args, 0, stream);
  if (e != hipSuccess) fprintf(stderr, "cooperative launch failed: %s (grid %d)\n", hipGetErrorString(e), grid_blocks);
#else
  phase_kernel<0><<<grid_blocks, NT, 0, stream>>>(p);
  phase_kernel<1><<<grid_blocks, NT, 0, stream>>>(p);
  phase_kernel<2><<<grid_blocks, NT, 0, stream>>>(p);
  phase_kernel<3><<<grid_blocks, NT, 0, stream>>>(p);
  phase_kernel<4><<<grid_blocks, NT, 0, stream>>>(p);
  phase_kernel<5><<<grid_blocks, NT, 0, stream>>>(p);
  phase_kernel<6><<<grid_blocks, NT, 0, stream>>>(p);
  phase_kernel<7><<<grid_blocks, NT, 0, stream>>>(p);
#endif
}
```

```cpp
#include <hip/hip_runtime.h>
#include <hip/hip_bf16.h>
#include <hip/hip_cooperative_groups.h>
#include <stdint.h>
#include <cstdio>
namespace cg = cooperative_groups;

typedef unsigned short u16;
typedef short bf16x8 __attribute__((ext_vector_type(8)));
typedef float f32x4 __attribute__((ext_vector_type(4)));
typedef unsigned u32x4 __attribute__((ext_vector_type(4)));
typedef unsigned u32x2 __attribute__((ext_vector_type(2)));

#ifndef SINGLE_LAUNCH
#define SINGLE_LAUNCH 1
#endif

constexpr int T_ = 8192, D_ = 2048, S_ = 4096, NB_ = 2;
constexpr int INW = 4168;
constexpr int NPH = 8;
constexpr float ALPHA = 1.189207115002721f;
constexpr float EPS = 1e-6f;
constexpr int NT = 512;
constexpr int SMEM_BYTES = 133120;

constexpr size_t al256(size_t x) { return (x + 255) & ~(size_t)255; }
constexpr size_t O_CTR = 0;
constexpr size_t O_WINT = O_CTR + 16384;
constexpr size_t O_WUQT = O_WINT + al256((size_t)4352 * 2048 * 2);
constexpr size_t O_WUKVT = O_WUQT + al256((size_t)1536 * 512 * 2);
constexpr size_t O_WOUTT = O_WUKVT + al256((size_t)2048 * 512 * 2);
constexpr size_t O_WPQT = O_WOUTT + al256((size_t)2048 * 2048 * 2);
constexpr size_t O_WGT = O_WPQT + al256((size_t)1024 * 2048 * 2);
constexpr size_t O_WPT = O_WGT + al256((size_t)2048 * 2048 * 2);
constexpr size_t O_PB = O_WPT + al256((size_t)2048 * 256 * 2);
constexpr size_t O_UB = O_PB + al256((size_t)8192 * 256 * 2);
constexpr size_t O_VB = O_UB + 2048;
constexpr size_t O_OMIX = O_UB + al256((size_t)16384 * 4096);
constexpr size_t O_CS = O_OMIX + al256((size_t)8192 * 2048 * 2);
constexpr size_t O_PROJB = O_CS + al256((size_t)8192 * 32 * 8);
constexpr size_t O_KEYH = O_PROJB + al256((size_t)8192 * 2048 * 2);
constexpr size_t O_KEYL = O_KEYH + al256((size_t)2 * 8 * 128 * 64 * 2);
constexpr size_t O_US = O_KEYL + al256((size_t)2 * 8 * 128 * 64 * 2);
constexpr size_t O_VS = O_US + al256((size_t)16384 * 4);
constexpr size_t O_REGB = O_VS + al256((size_t)16384 * 4);
constexpr size_t O_XB = O_REGB;
constexpr size_t O_CQB = O_XB + al256((size_t)8192 * 2048 * 2);
constexpr size_t O_CKVB = O_CQB + al256((size_t)8192 * 512 * 2);
constexpr size_t O_QM = O_CKVB + al256((size_t)8192 * 512 * 2);
constexpr size_t O_KM = O_QM + al256((size_t)8192 * 8 * 192 * 2);
constexpr size_t O_VMT = O_KM + al256((size_t)8192 * 8 * 192 * 2);
constexpr size_t O_QF = O_VMT + al256((size_t)8192 * 8 * 128 * 2);
constexpr size_t O_KF = O_QF + al256((size_t)8192 * 8 * 128 * 2);
constexpr size_t O_VFT = O_KF + al256((size_t)8192 * 8 * 128 * 2);
constexpr size_t O_LOGF = O_VFT + al256((size_t)8192 * 8 * 128 * 2);
constexpr size_t O_FK = O_LOGF + al256((size_t)16 * 4096 * 4);
constexpr size_t O_KRS = O_FK + al256((size_t)16 * 4096 * 4);
constexpr size_t O_RSS = O_KRS + al256((size_t)8192 * 64 * 4);
constexpr size_t O_ENDB = O_RSS + al256((size_t)2 * 8192 * 4);
constexpr size_t O_Y1 = O_REGB;
constexpr size_t O_H1B = O_Y1 + al256((size_t)8192 * 2048 * 4);
constexpr size_t O_PQ = O_H1B + al256((size_t)8192 * 2048 * 2);
constexpr size_t O_GATE = O_PQ + al256((size_t)8192 * 128 * 4);
constexpr size_t O_ENDB2 = O_GATE + al256((size_t)8192 * 128 * 4);
static_assert(O_ENDB2 <= O_ENDB, "region B reuse overflow");
static_assert(O_ENDB <= (size_t)500 * 1024 * 1024, "workspace too large");

struct Params {
  const float *x, *p; const int* positions;
  const float *w_in, *b_forget, *g_q, *w_uq, *g_kv, *w_ukv, *w_out, *ln1_g, *ln1_b;
  const float *peer_wq, *keys1, *keys2, *peer_u, *peer_v, *wgate, *wproj, *ln2_g, *ln2_b;
  float* out;
  char* ws;
#define WSP(type, name, off) __device__ __forceinline__ type* name() const { return (type*)(ws + (off)); }
  WSP(unsigned, ctr, O_CTR) WSP(u16, WinT, O_WINT) WSP(u16, WuqT, O_WUQT) WSP(u16, WukvT, O_WUKVT) WSP(u16, WoutT, O_WOUTT)
  WSP(u16, WpqT, O_WPQT) WSP(u16, WgT, O_WGT) WSP(u16, WpT, O_WPT) WSP(u16, pb, O_PB) WSP(unsigned char, Uq, O_UB) WSP(unsigned char, Vq, O_VB) WSP(float, Us, O_US) WSP(float, Vs, O_VS)
  WSP(u16, omix, O_OMIX) WSP(float2, cs, O_CS) WSP(u16, projb, O_PROJB) WSP(u16, keyH, O_KEYH) WSP(u16, keyL, O_KEYL)
  WSP(u16, xb, O_XB) WSP(u16, cqb, O_CQB) WSP(u16, ckvb, O_CKVB) WSP(u16, Qm, O_QM) WSP(u16, Km, O_KM) WSP(u16, VmT, O_VMT)
  WSP(u16, Qf, O_QF) WSP(u16, Kf, O_KF) WSP(u16, VfT, O_VFT) WSP(float, logf, O_LOGF) WSP(float, Fk, O_FK) WSP(float, krsum, O_KRS) WSP(float, rss, O_RSS)
  WSP(float, y1, O_Y1) WSP(u16, h1b, O_H1B) WSP(int, eidxG, O_PQ) WSP(float, gateG, O_GATE)
#undef WSP
};

__device__ __forceinline__ int TID() { int t = threadIdx.x; asm volatile("" : "+v"(t)); return t; }
__device__ __forceinline__ unsigned pk2(float lo, float hi) {
  unsigned r; asm volatile("v_cvt_pk_bf16_f32 %0, %1, %2" : "=v"(r) : "v"(lo), "v"(hi)); return r;
}
__device__ __forceinline__ u16 f2bf(float f) { return (u16)(pk2(f, 0.f) & 0xffffu); }
__device__ __forceinline__ float bf2f(u16 v) { return __uint_as_float(((unsigned)v) << 16); }
__device__ __forceinline__ float bflo(unsigned v) { return __uint_as_float(v << 16); }
__device__ __forceinline__ float bfhi(unsigned v) { return __uint_as_float(v & 0xffff0000u); }

template <int CTRL> __device__ __forceinline__ int dppi(int v) { return __builtin_amdgcn_update_dpp(0, v, CTRL, 0xF, 0xF, false); }
template <int CTRL> __device__ __forceinline__ float dppf(float v) { return __int_as_float(dppi<CTRL>(__float_as_int(v))); }
__device__ __forceinline__ float rdlane(float v, int l) { return __int_as_float(__builtin_amdgcn_readlane(__float_as_int(v), l)); }

__device__ __forceinline__ float row_sum(float v) {
  v += dppf<0xB1>(v); v += dppf<0x4E>(v); v += dppf<0x141>(v); v += dppf<0x140>(v); return v;
}
__device__ __forceinline__ float row_max(float v) {
  v = fmaxf(v, dppf<0xB1>(v)); v = fmaxf(v, dppf<0x4E>(v)); v = fmaxf(v, dppf<0x141>(v)); v = fmaxf(v, dppf<0x140>(v)); return v;
}
__device__ __forceinline__ float wave_sum(float v) {
  v = row_sum(v);
  return (rdlane(v, 0) + rdlane(v, 16)) + (rdlane(v, 32) + rdlane(v, 48));
}
__device__ __forceinline__ float wave_max(float v) {
  v = row_max(v);
  return fmaxf(fmaxf(rdlane(v, 0), rdlane(v, 16)), fmaxf(rdlane(v, 32), rdlane(v, 48)));
}
__device__ __forceinline__ unsigned wave_umax(unsigned v) {
  unsigned t;
  t = (unsigned)dppi<0xB1>((int)v); v = v > t ? v : t;
  t = (unsigned)dppi<0x4E>((int)v); v = v > t ? v : t;
  t = (unsigned)dppi<0x141>((int)v); v = v > t ? v : t;
  t = (unsigned)dppi<0x140>((int)v); v = v > t ? v : t;
  unsigned a = (unsigned)__builtin_amdgcn_readlane((int)v, 0), b = (unsigned)__builtin_amdgcn_readlane((int)v, 16);
  unsigned c = (unsigned)__builtin_amdgcn_readlane((int)v, 32), d = (unsigned)__builtin_amdgcn_readlane((int)v, 48);
  a = a > b ? a : b; c = c > d ? c : d; return a > c ? a : c;
}
__device__ __forceinline__ unsigned ordkey(float f) {
  unsigned u = __float_as_uint(f);
  return (u & 0x80000000u) ? ~u : (u | 0x80000000u);
}

__device__ __forceinline__ unsigned fp6_code(float v) {
  const float a = fabsf(v);
  int code = a < 2.f ? (int)rintf(a * 8.f) : (a < 4.f ? 16 + (int)rintf((a - 2.f) * 4.f) : 24 + (int)rintf((a - 4.f) * 2.f));
  code = code > 31 ? 31 : code;
  return (unsigned)code | (v < 0.f ? 32u : 0u);
}
__device__ __forceinline__ void quant_chunk(const Params& p, int chunk) {
  const int tid = TID(), lane = tid & 63, wid = tid >> 6;
#pragma unroll 1
  for (int i8 = 0; i8 < 8; ++i8) {
    const int r = chunk * 64 + wid * 8 + i8;
    const int tab = r >> 14, row = r & 16383;
    const float* src = (tab ? p.peer_v : p.peer_u) + (size_t)row * D_ + lane * 4;
    float4 v[8];
    float am = 0.f;
#pragma unroll
    for (int i = 0; i < 8; ++i) {
      { const f32x4 tv = __builtin_nontemporal_load((const f32x4*)(src + i * 256)); v[i] = make_float4(tv[0], tv[1], tv[2], tv[3]); }
      am = fmaxf(am, fmaxf(fmaxf(fabsf(v[i].x), fabsf(v[i].y)), fmaxf(fabsf(v[i].z), fabsf(v[i].w))));
    }
    am = wave_max(am);
    const float qs = am > 0.f ? 7.5f / am : 1.f;
    unsigned w[6];
#pragma unroll
    for (int g = 0; g < 2; ++g) {
      unsigned long long lo = 0ull; unsigned hi = 0u;
#pragma unroll
      for (int i = 0; i < 4; ++i) {
        const float4 f = v[g * 4 + i];
        const unsigned q4 = fp6_code(f.x * qs) | (fp6_code(f.y * qs) << 6) | (fp6_code(f.z * qs) << 12) | (fp6_code(f.w * qs) << 18);
        if (i == 0) lo |= (unsigned long long)q4;
        if (i == 1) lo |= (unsigned long long)q4 << 24;
        if (i == 2) { lo |= (unsigned long long)q4 << 48; hi |= q4 >> 16; }
        if (i == 3) hi |= q4 << 8;
      }
      w[g * 3 + 0] = (unsigned)lo; w[g * 3 + 1] = (unsigned)(lo >> 32); w[g * 3 + 2] = hi;
    }
    unsigned* dst = (unsigned*)(p.Uq() + (size_t)row * 3072 + tab * 1536 + lane * 24);
    *(u32x2*)dst = u32x2{w[0], w[1]}; *(u32x2*)(dst + 2) = u32x2{w[2], w[3]}; *(u32x2*)(dst + 4) = u32x2{w[4], w[5]};
    if (lane == 0) (tab ? p.Vs() : p.Us())[row] = am > 0.f ? am / 7.5f : 1.f;
  }
}

__device__ void transpose_cvt(const float* __restrict__ W, int ldw, int K, int src_col0, int ncols,
                              u16* __restrict__ WT, int dst_row0, const float* __restrict__ kscale,
                              float* tile, int bid, int nb) {
  const int tiles_k = K / 64, tiles_n = ncols / 64, tid = TID();
#pragma unroll 1
  for (int t = bid; t < tiles_k * tiles_n; t += nb) {
    const int tk = t % tiles_k, tn = t / tiles_k, k0 = tk * 64, n0 = tn * 64;
#pragma unroll
    for (int i = 0; i < 2; ++i) {
      const int r = (tid >> 4) + 32 * i, c = (tid & 15) * 4;
      const float4 v = *(const float4*)(W + (size_t)(k0 + r) * ldw + src_col0 + n0 + c);
      const float sc = kscale ? kscale[k0 + r] : 1.f;
      tile[r * 65 + c + 0] = v.x * sc; tile[r * 65 + c + 1] = v.y * sc;
      tile[r * 65 + c + 2] = v.z * sc; tile[r * 65 + c + 3] = v.w * sc;
    }
    __syncthreads();
    {
      const int n = tid >> 3, kk = (tid & 7) * 8;
      unsigned w[4];
#pragma unroll
      for (int e = 0; e < 4; ++e) w[e] = pk2(tile[(kk + 2 * e) * 65 + n], tile[(kk + 2 * e + 1) * 65 + n]);
      *(u32x4*)(WT + (size_t)(dst_row0 + n0 + n) * K + k0 + kk) = u32x4{w[0], w[1], w[2], w[3]};
    }
    __syncthreads();
  }
}

__device__ void cvt_bf16(const float* __restrict__ src, u16* __restrict__ dst, size_t n8, size_t gtid, size_t gthreads) {
  for (size_t i = gtid; i < n8; i += gthreads) {
    const float4 a = ((const float4*)src)[2 * i], b = ((const float4*)src)[2 * i + 1];
    ((u32x4*)dst)[i] = u32x4{pk2(a.x, a.y), pk2(a.z, a.w), pk2(b.x, b.y), pk2(b.z, b.w)};
  }
}

__device__ void phase_prep(const Params& p, char* smem, int bid, int nb) {
  const int tid = TID(), lane = tid & 63, wid = tid >> 6;
  float* tile = (float*)smem;
  if (bid == 0 && tid == 0) p.ctr()[0] = 0;
  transpose_cvt(p.w_in, INW, D_, 0, 1024, p.WinT(), 0, nullptr, tile, bid, nb);
  transpose_cvt(p.w_in, INW, D_, 1088, 3072, p.WinT(), 1024, nullptr, tile, bid, nb);
  transpose_cvt(p.w_in, INW, D_, 1024, 64, p.WinT(), 4096, nullptr, tile, bid, nb);
  transpose_cvt(p.w_uq, 1536, 512, 0, 1536, p.WuqT(), 0, p.g_q, tile, bid, nb);
  transpose_cvt(p.w_ukv, 2048, 512, 0, 2048, p.WukvT(), 0, p.g_kv, tile, bid, nb);
  transpose_cvt(p.w_out, 2048, 2048, 0, 2048, p.WoutT(), 0, nullptr, tile, bid, nb);
  transpose_cvt(p.peer_wq, 1024, 2048, 0, 1024, p.WpqT(), 0, nullptr, tile, bid, nb);
  transpose_cvt(p.wgate, 2048, 2048, 0, 2048, p.WgT(), 0, nullptr, tile, bid, nb);
  transpose_cvt(p.wproj, 2048, 256, 0, 2048, p.WpT(), 0, nullptr, tile, bid, nb);
  const size_t gtid = (size_t)bid * NT + tid, gth = (size_t)nb * NT;
  for (size_t i = gtid; i < (size_t)192 * 2048 / 8; i += gth) ((u32x4*)(p.WinT() + (size_t)4160 * 2048))[i] = u32x4{0, 0, 0, 0};
  cvt_bf16(p.p, p.pb(), (size_t)T_ * 256 / 8, gtid, gth);
  for (size_t i = gtid; i < (size_t)T_ * 64 / 4; i += gth) ((float4*)p.krsum())[i] = make_float4(0.f, 0.f, 0.f, 0.f);
  for (size_t i = gtid; i < (size_t)2 * T_ / 4; i += gth) ((float4*)p.rss())[i] = make_float4(0.f, 0.f, 0.f, 0.f);
  for (size_t i = gtid; i < (size_t)2 * 65536; i += gth) {
    const float v = i < 65536 ? p.keys1[i] : p.keys2[i - 65536];
    const u16 h = f2bf(v);
    p.keyH()[i] = h; p.keyL()[i] = f2bf(v - bf2f(h));
  }
  for (size_t i = gtid; i < (size_t)T_ * 32; i += gth) {
    const int t = (int)(i >> 5), fi = (int)(i & 31);
    const float invf = 1.0f / powf(10000.0f, (float)(2 * fi) / 64.0f);
    const float ang = (float)p.positions[t] * invf;
    const double rev = (double)ang * 0.15915494309189535;
    const float fr = (float)(rev - rint(rev));
    p.cs()[i] = make_float2(__builtin_amdgcn_cosf(fr), __builtin_amdgcn_sinf(fr));
  }
  __syncthreads();
  float* wff = (float*)smem;
  for (int i = tid; i < 2048 * 2; i += NT) {
    const int k = i >> 1, hf = i & 1;
    *(float4*)(wff + (k ^ ((k >> 3) & 7)) * 8 + hf * 4) = *(const float4*)(p.w_in + (size_t)k * INW + 4160 + hf * 4);
  }
  __syncthreads();
  for (int t = bid * 8 + wid; t < T_; t += nb * 8) {
    float a[8];
#pragma unroll
    for (int e = 0; e < 8; ++e) a[e] = 0.f;
#pragma unroll 1
    for (int i = 0; i < 4; ++i) {
      const int k = (i * 64 + lane) * 8;
      const f32x4 xa = __builtin_nontemporal_load((const f32x4*)(p.x + (size_t)t * D_ + k)), xb4 = __builtin_nontemporal_load((const f32x4*)(p.x + (size_t)t * D_ + k + 4));
      const float4 x0 = make_float4(xa[0], xa[1], xa[2], xa[3]), x1 = make_float4(xb4[0], xb4[1], xb4[2], xb4[3]);
      *(u32x4*)(p.xb() + (size_t)t * D_ + k) = u32x4{pk2(x0.x, x0.y), pk2(x0.z, x0.w), pk2(x1.x, x1.y), pk2(x1.z, x1.w)};
      const float xs[8] = {x0.x, x0.y, x0.z, x0.w, x1.x, x1.y, x1.z, x1.w};
#pragma unroll
      for (int j = 0; j < 8; ++j) {
        const int kr = (k + j) ^ (lane & 7);
        const float4 w0 = *(const float4*)(wff + kr * 8), w1 = *(const float4*)(wff + kr * 8 + 4);
        a[0] += xs[j] * w0.x; a[1] += xs[j] * w0.y; a[2] += xs[j] * w0.z; a[3] += xs[j] * w0.w;
        a[4] += xs[j] * w1.x; a[5] += xs[j] * w1.y; a[6] += xs[j] * w1.z; a[7] += xs[j] * w1.w;
      }
    }
    float mine = 0.f;
#pragma unroll
    for (int e = 0; e < 8; ++e) { const float s = wave_sum(a[e]); if (lane == e) mine = s; }
    if (lane < 8) {
      const float z = mine + p.b_forget[lane];
      const float ls = fminf(z, 0.f) - log1pf(expf(-fabsf(z)));
      const int b = t >> 12, s = t & 4095;
      p.logf()[((size_t)(b * 8 + lane)) * S_ + s] = ls;
    }
  }
}

template <int WM, int WN>
__device__ __forceinline__ void gemm_core(const u16* __restrict__ A, int lda, const u16* __restrict__ Bt, int ldb,
                                          int K, int brow, int bcol, char* smem, f32x4 (&acc)[4 / WM][4][4]) {
  constexpr int MS = 4 / WM, BN = 64 * WN, NBL = BN / 64;
  static_assert(WM * WN == 8, "8 waves");
  const int tid = TID(), wid = tid >> 6, lane = tid & 63, wr = wid / WN, wc = wid % WN, fr = lane & 15, fq = lane >> 4;
#pragma unroll
  for (int h = 0; h < MS; ++h)
#pragma unroll
    for (int m = 0; m < 4; ++m)
#pragma unroll
      for (int n = 0; n < 4; ++n) acc[h][m][n] = f32x4{0.f, 0.f, 0.f, 0.f};
  const int nk = K / 64;
  const int srow = tid >> 3, sch = (tid & 7) ^ ((tid >> 4) & 7);
  const u16* ga = A + (size_t)(brow + srow) * lda + sch * 8;
  const u16* gb = Bt + (size_t)(bcol + srow) * ldb + sch * 8;
  char* sdst = smem + tid * 16;
  auto issue = [&](int kt, int st) {
    char* sa = sdst + st * 65536;
#pragma unroll
    for (int i = 0; i < 4; ++i)
      __builtin_amdgcn_global_load_lds((const unsigned*)(ga + (size_t)i * 64 * lda + kt * 64), (unsigned*)(sa + i * 8192), 16, 0, 0);
#pragma unroll
    for (int i = 0; i < NBL; ++i)
      __builtin_amdgcn_global_load_lds((const unsigned*)(gb + (size_t)i * 64 * ldb + kt * 64), (unsigned*)(sa + 32768 + i * 8192), 16, 0, 0);
  };
  const int fx = (fr >> 1) & 7;
  const int arow = (wr * (256 / WM) + fr) * 128, brw = 32768 + (wc * 64 + fr) * 128;
  const int c0 = (fq ^ fx) * 16, c1 = ((4 + fq) ^ fx) * 16;
  asm volatile("s_waitcnt vmcnt(0)" ::: "memory");
  __syncthreads();
  issue(0, 0);
#pragma unroll 1
  for (int kt = 0; kt < nk; ++kt) {
    asm volatile("s_waitcnt vmcnt(0)" ::: "memory");
    __builtin_amdgcn_s_barrier();
    asm volatile("" ::: "memory");
    if (kt + 1 < nk) issue(kt + 1, (kt + 1) & 1);
    const char* sb = smem + (kt & 1) * 65536;
#pragma unroll
    for (int ks = 0; ks < 2; ++ks) {
      const int co = ks ? c1 : c0;
      bf16x8 Bl[4];
#pragma unroll
      for (int n = 0; n < 4; ++n) Bl[n] = *reinterpret_cast<const bf16x8*>(sb + brw + co + n * 2048);
#pragma unroll
      for (int h = 0; h < MS; ++h) {
        bf16x8 At[4];
#pragma unroll
        for (int m = 0; m < 4; ++m) At[m] = *reinterpret_cast<const bf16x8*>(sb + arow + co + (h * 4 + m) * 2048);
#pragma unroll
        for (int m = 0; m < 4; ++m)
#pragma unroll
          for (int n = 0; n < 4; ++n) acc[h][m][n] = __builtin_amdgcn_mfma_f32_16x16x32_bf16(At[m], Bl[n], acc[h][m][n], 0, 0, 0);
      }
    }
  }
}

template <int WM, int WN, class Epi>
__device__ __forceinline__ void gemm_tile(const u16* __restrict__ A, int lda, const u16* __restrict__ Bt, int ldb,
                                          int K, int brow, int bcol, char* smem, Epi epi) {
  constexpr int MS = 4 / WM;
  const int tid = TID(), wid = tid >> 6, lane = tid & 63, wr = wid / WN, wc = wid % WN, fr = lane & 15, fq = lane >> 4;
  f32x4 acc[MS][4][4];
  gemm_core<WM, WN>(A, lda, Bt, ldb, K, brow, bcol, smem, acc);
#pragma unroll
  for (int h = 0; h < MS; ++h) epi(acc[h], brow + wr * (256 / WM) + h * 64, bcol + wc * 64, fr, fq);
}

namespace pg8 {
#define PG8_LAS __attribute__((address_space(3)))
typedef unsigned short bf16_t;
constexpr int BM = 256, BK = 64, HALF = 128, HTB = HALF * BK * 2  , STAGE_BYTES = 8 * HTB, NXCD = 8, WGM = 8;

__host__ __device__ __forceinline__ int lds_byte(int r, int c) { const int st = (r >> 4) * 2 + (c >> 5), rr = r & 15, cc = c & 31, ob = rr * 64 + cc * 2; return st * 1024 + (ob ^ (((ob >> 9) & 1) << 5)); }
__host__ __device__ __forceinline__ void stage_rc(int b, int& R, int& C) { const int st = b / 1024, sb = b % 1024, swz = sb ^ (((sb >> 9) & 1) << 5); R = (st >> 1) * 16 + swz / 64; C = (st & 1) * 32 + (swz % 64) / 2; }
__host__ __device__ __forceinline__ int perm32(int rho) { const int n = rho >> 4, i = rho & 15; return 8 * (i >> 2) + 4 * n + (i & 3); }
struct Unit { int pm, pn; };
struct Gemm { const bf16_t* A; const bf16_t* Bt; int M, N, K; };
struct StaticOrder {
    int nM, nN, nwg, G, c;
    __device__ void init(int M, int N, int G_, int c_) { nM = M / BM; nN = N / BM; nwg = nM * nN; G = G_; c = c_; }
    __device__ bool next(int i, Unit& u) const {
        const long L = (long)i * G + c; if (L >= nwg) return false;
        int wgid = (int)L; { const int q = nwg / NXCD, r = nwg % NXCD, xcd = wgid % NXCD, off = wgid / NXCD; wgid = (xcd < r ? xcd * (q + 1) : r * (q + 1) + (xcd - r) * q) + off; }
        const int nig = WGM * nN, gid = wgid / nig, fm = gid * WGM, gsz = (nM - fm) < WGM ? (nM - fm) : WGM;
        u.pm = fm + ((wgid % nig) % gsz); u.pn = (wgid % nig) / gsz; return true;
    }
    __device__ __forceinline__ void a_ready(const Unit&) const {}
    __device__ __forceinline__ void done(const Unit&) const {}
};
template <class Epi, class Sched, bool STAMP = false>
__device__ __forceinline__ void gemm_phase(PG8_LAS unsigned char* lds, const Gemm g, const Sched& S, const Epi& E, unsigned long long* stamps) {
    const int tid = TID(), wid = __builtin_amdgcn_readfirstlane(tid >> 6), lane = tid & 63, wr = wid >> 2, wc = wid & 3, fr = lane & 15, fq = lane >> 4;
    const int K = g.K, nt = K / BK;
    int ts_lo = 0, ts_hi = 0, nts = 0; const unsigned long long rt_entry = STAMP ? (unsigned long long)wall_clock64() : 0ull;
#define PG8_STAMP() do { if (STAMP && wid == 0 && nts < 64) { const unsigned long long _c = (unsigned long long)clock64(); \
        ts_lo = (lane == nts) ? (int)(unsigned)_c : ts_lo; ts_hi = (lane == nts) ? (int)(unsigned)(_c >> 32) : ts_hi; ++nts; } } while (0)
    PG8_STAMP();
    unsigned voffA[2], voffB[2];
#pragma unroll
    for (int i = 0; i < 2; ++i) { int R, C; stage_rc(tid * 16 + i * 8192, R, C); const int Rb = Epi::PERM ? ((R & ~31) + perm32(R & 31)) : R;
        voffA[i] = (unsigned)(R * K + C) * 2u; voffB[i] = (unsigned)(Rb * K + C) * 2u; }
    const size_t kstep = (size_t)(BK * 2);
    const size_t hstep = (size_t)HALF * K * 2;
    const size_t tstep = 2 * hstep;
    const unsigned ldsw = (unsigned)wid * 1024u;
    const int aoff = lds_byte(wr * 64 + fr, fq * 8), boff = lds_byte(wc * 32 + fr, fq * 8);
#define PG8_SA(b, h) (((b) * 2 + (h)) * HTB)
#define PG8_SB(b, h) ((4 + (b) * 2 + (h)) * HTB)
#define PG8_STAGE(bufoff, gbase, voff) do { _Pragma("unroll") for (int _i = 0; _i < 2; ++_i) \
        __builtin_amdgcn_global_load_lds((const unsigned*)((const char*)(gbase) + (voff)[_i]), (PG8_LAS unsigned*)(lds + (bufoff) + ldsw + _i * 8192), 16, 0, 0); } while (0)
#define PG8_LDA(dst, b, h) do { _Pragma("unroll") for (int m = 0; m < 4; ++m) _Pragma("unroll") for (int k = 0; k < 2; ++k) dst[m][k] = *(const PG8_LAS bf16x8*)(lds + PG8_SA(b, h) + aoff + m * 2048 + k * 1024); } while (0)
#define PG8_LDB(dst, b, h) do { _Pragma("unroll") for (int n = 0; n < 2; ++n) _Pragma("unroll") for (int k = 0; k < 2; ++k) dst[n][k] = *(const PG8_LAS bf16x8*)(lds + PG8_SB(b, h) + boff + n * 2048 + k * 1024); } while (0)
#define PG8_MMA(ai, bj, At, Bt) do { __builtin_amdgcn_s_setprio(1); _Pragma("unroll") for (int m = 0; m < 4; ++m) _Pragma("unroll") for (int n = 0; n < 2; ++n) _Pragma("unroll") for (int k = 0; k < 2; ++k) \
        acc[ai][bj][m][n] = __builtin_amdgcn_mfma_f32_16x16x32_bf16(Bt[n][k], At[m][k], acc[ai][bj][m][n], 0, 0, 0); __builtin_amdgcn_s_setprio(0); } while (0)
#define PG8_WAIT_V(n) asm volatile("s_waitcnt vmcnt(" #n ")" ::: "memory")
#define PG8_WAIT_L(n) asm volatile("s_waitcnt lgkmcnt(" #n ")" ::: "memory")
#define PG8_BAR __builtin_amdgcn_s_barrier()
#define PG8_SCHED __builtin_amdgcn_sched_barrier(0)
    Unit cur, nxt; int ui = 0;
    if (!S.next(0, cur)) return;
    f32x4 acc[2][2][4][2];
#pragma unroll
    for (int a = 0; a < 2; ++a)
#pragma unroll
        for (int b = 0; b < 2; ++b)
#pragma unroll
            for (int m = 0; m < 4; ++m)
#pragma unroll
                for (int n = 0; n < 2; ++n) acc[a][b][m][n] = (f32x4){0.f, 0.f, 0.f, 0.f};
    bf16x8 At[4][2], B0[2][2], B1[2][2];
    const char* cA = (const char*)g.A + (size_t)cur.pm * tstep; const char* cB = (const char*)g.Bt + (size_t)cur.pn * tstep;
    S.a_ready(cur);
    PG8_STAGE(PG8_SB(0, 0), cB, voffB); PG8_STAGE(PG8_SA(0, 0), cA, voffA); PG8_STAGE(PG8_SB(0, 1), cB + hstep, voffB); PG8_STAGE(PG8_SA(0, 1), cA + hstep, voffA);
    if (wr == 1) PG8_BAR;
    PG8_WAIT_V(4); PG8_BAR;
    PG8_STAGE(PG8_SB(1, 0), cB + kstep, voffB); PG8_STAGE(PG8_SA(1, 0), cA + kstep, voffA); PG8_STAGE(PG8_SB(1, 1), cB + hstep + kstep, voffB);
    PG8_WAIT_V(6); PG8_BAR;
    PG8_STAMP();
    for (;;) {
        const bool has_next = S.next(ui + 1, nxt);
        const char* nA = has_next ? (const char*)g.A + (size_t)nxt.pm * tstep : cA; const char* nB = has_next ? (const char*)g.Bt + (size_t)nxt.pn * tstep : cB;
        for (int t = 0; t < nt; t += 2) {
            const bool last = (t == nt - 2);
            const char* a1 = cA + (size_t)(t + 1) * kstep;
            const char* a2 = last ? nA : cA + (size_t)(t + 2) * kstep; const char* b2 = last ? nB : cB + (size_t)(t + 2) * kstep;
            const char* a3 = a2 + kstep; const char* b3 = b2 + kstep;
            if (last && has_next) S.a_ready(nxt);
            PG8_LDB(B0, 0, 0); PG8_SCHED; PG8_LDA(At, 0, 0); PG8_STAGE(PG8_SA(1, 1), a1 + hstep, voffA);
            PG8_WAIT_L(8); PG8_BAR; PG8_WAIT_L(0); PG8_MMA(0, 0, At, B0); PG8_BAR; PG8_SCHED;
            PG8_LDB(B1, 0, 1); PG8_STAGE(PG8_SB(0, 0), b2, voffB);
            PG8_BAR; PG8_WAIT_L(0); PG8_MMA(0, 1, At, B1); PG8_BAR;
            PG8_LDA(At, 0, 1); PG8_STAGE(PG8_SA(0, 0), a2, voffA);
            PG8_BAR; PG8_WAIT_L(0); PG8_MMA(1, 0, At, B0); PG8_BAR; PG8_SCHED;
            PG8_STAGE(PG8_SB(0, 1), b2 + hstep, voffB);
            PG8_WAIT_V(6); PG8_BAR; PG8_MMA(1, 1, At, B1); PG8_BAR;
            PG8_LDB(B0, 1, 0); PG8_SCHED; PG8_LDA(At, 1, 0); PG8_STAGE(PG8_SA(0, 1), a2 + hstep, voffA);
            PG8_WAIT_L(8); PG8_BAR; PG8_WAIT_L(0); PG8_MMA(0, 0, At, B0); PG8_BAR; PG8_SCHED;
            PG8_LDB(B1, 1, 1); PG8_STAGE(PG8_SB(1, 0), b3, voffB);
            PG8_BAR; PG8_WAIT_L(0); PG8_MMA(0, 1, At, B1); PG8_BAR;
            PG8_LDA(At, 1, 1); PG8_STAGE(PG8_SA(1, 0), a3, voffA);
            PG8_BAR; PG8_WAIT_L(0); PG8_MMA(1, 0, At, B0); PG8_BAR; PG8_SCHED;
            PG8_STAGE(PG8_SB(1, 1), b3 + hstep, voffB);
            PG8_WAIT_V(6); PG8_BAR; PG8_MMA(1, 1, At, B1); PG8_BAR;
        }
        PG8_STAMP();
        if constexpr (!Epi::AFTER_DRAIN) { E(acc, cur, wr, wc, fr, fq); S.done(cur); }
        PG8_STAMP();
        if (!has_next) break;
#pragma unroll
        for (int a = 0; a < 2; ++a)
#pragma unroll
            for (int b = 0; b < 2; ++b)
#pragma unroll
                for (int m = 0; m < 4; ++m)
#pragma unroll
                    for (int n = 0; n < 2; ++n) acc[a][b][m][n] = (f32x4){0.f, 0.f, 0.f, 0.f};
        cur = nxt; cA = nA; cB = nB; ++ui;
    }
    PG8_WAIT_V(0);
    if (wr == 0) PG8_BAR;
    PG8_BAR;
    if constexpr (Epi::AFTER_DRAIN) { E.fused(acc, cur, wr, wc, fr, fq, lds, wid, lane); S.done(cur); }
    PG8_STAMP();
    if (STAMP && wid == 0) { stamps[lane] = lane < nts ? (((unsigned long long)(unsigned)ts_hi << 32) | (unsigned)ts_lo) : 0ull;
        if (lane == 62) stamps[62] = rt_entry; if (lane == 63) stamps[63] = (unsigned long long)wall_clock64(); }
#undef PG8_STAMP
#undef PG8_SA
#undef PG8_SB
#undef PG8_STAGE
#undef PG8_LDA
#undef PG8_LDB
#undef PG8_MMA
#undef PG8_WAIT_V
#undef PG8_WAIT_L
#undef PG8_BAR
#undef PG8_SCHED
}
}


__device__ __forceinline__ u32x4 pack8(const f32x4& a, const f32x4& b) { return u32x4{pk2(a[0], a[1]), pk2(a[2], a[3]), pk2(b[0], b[1]), pk2(b[2], b[3])}; }
__device__ __forceinline__ float sumsq4(const f32x4& a) { return (a[0] * a[0] + a[1] * a[1]) + (a[2] * a[2] + a[3] * a[3]); }
__device__ __forceinline__ void store_tr8(u16* vt, const f32x4& a, const f32x4& b) {
  vt[0] = f2bf(a[0]); vt[(size_t)S_] = f2bf(a[1]); vt[(size_t)2 * S_] = f2bf(a[2]); vt[(size_t)3 * S_] = f2bf(a[3]);
  vt[(size_t)4 * S_] = f2bf(b[0]); vt[(size_t)5 * S_] = f2bf(b[1]); vt[(size_t)6 * S_] = f2bf(b[2]); vt[(size_t)7 * S_] = f2bf(b[3]);
}
struct EpiInproj {
  static constexpr bool PERM = true, AFTER_DRAIN = false;
  u16 *cqb, *ckvb, *Qf, *Kf, *VfT; float* rss;
  __device__ __forceinline__ void operator()(const f32x4 (&acc)[2][2][4][2], const pg8::Unit& u, int wr, int wc, int fr, int fq) const {
    const int ct = u.pn * 256;
#pragma unroll
    for (int ai = 0; ai < 2; ++ai)
#pragma unroll
      for (int m = 0; m < 4; ++m) {
        const int row = u.pm * 256 + ai * 128 + wr * 64 + m * 16 + fr, b = row >> 12, s = row & 4095;
        float ss = 0.f;
#pragma unroll
        for (int bj = 0; bj < 2; ++bj) {
          const int c0 = ct + bj * 128 + wc * 32 + 8 * fq;
          const f32x4 v0 = acc[ai][bj][m][0], v1 = acc[ai][bj][m][1];
          if (ct < 1024) {
            u16* dst = ct < 512 ? cqb : ckvb;
            *(u32x4*)(dst + (size_t)row * 512 + (c0 & 511)) = pack8(v0, v1);
            ss += sumsq4(v0) + sumsq4(v1);
          } else if (ct < 3072) {
            int c = c0 - 1024; u16* dst = c < 1024 ? Qf : Kf; c &= 1023;
            *(u32x4*)(dst + ((size_t)(b * 8 + (c >> 7)) * S_ + s) * 128 + (c & 127)) = pack8(v0, v1);
          } else {
            const int c = c0 - 3072;
            store_tr8(VfT + ((size_t)(b * 8 + (c >> 7)) * 128 + (c & 127)) * S_ + s, v0, v1);
          }
        }
        if (ct < 1024) atomicAdd(rss + (ct < 512 ? 0 : T_) + row, ss);
        __builtin_amdgcn_sched_barrier(0);
      }
  }
};
struct EpiQup {
  static constexpr bool PERM = true, AFTER_DRAIN = false;
  u16* Qm; const float* rss;
  __device__ __forceinline__ void operator()(const f32x4 (&acc)[2][2][4][2], const pg8::Unit& u, int wr, int wc, int fr, int fq) const {
#pragma unroll
    for (int ai = 0; ai < 2; ++ai)
#pragma unroll
      for (int m = 0; m < 4; ++m) {
        const int row = u.pm * 256 + ai * 128 + wr * 64 + m * 16 + fr, b = row >> 12, s = row & 4095;
        const float rs = rsqrtf(rss[row] * (1.f / 512.f) + EPS);
#pragma unroll
        for (int bj = 0; bj < 2; ++bj) {
          const int c0 = u.pn * 256 + bj * 128 + wc * 32 + 8 * fq, hh = c0 / 192, off = c0 % 192;
          *(u32x4*)(Qm + ((size_t)(b * 8 + hh) * S_ + s) * 192 + off) = pack8(acc[ai][bj][m][0] * rs, acc[ai][bj][m][1] * rs);
        }
        __builtin_amdgcn_sched_barrier(0);
      }
  }
};
struct EpiKVup {
  static constexpr bool PERM = true, AFTER_DRAIN = false;
  u16 *Km, *VmT; const float* rss;
  __device__ __forceinline__ void operator()(const f32x4 (&acc)[2][2][4][2], const pg8::Unit& u, int wr, int wc, int fr, int fq) const {
    const int hh = u.pn;
#pragma unroll
    for (int ai = 0; ai < 2; ++ai)
#pragma unroll
      for (int m = 0; m < 4; ++m) {
        const int row = u.pm * 256 + ai * 128 + wr * 64 + m * 16 + fr, b = row >> 12, s = row & 4095;
        const float rs = rsqrtf(rss[T_ + row] * (1.f / 512.f) + EPS);
        const int off = wc * 32 + 8 * fq;
        *(u32x4*)(Km + ((size_t)(b * 8 + hh) * S_ + s) * 192 + off) = pack8(acc[ai][0][m][0] * rs, acc[ai][0][m][1] * rs);
        store_tr8(VmT + ((size_t)(b * 8 + hh) * 128 + off) * S_ + s, acc[ai][1][m][0] * rs, acc[ai][1][m][1] * rs);
        __builtin_amdgcn_sched_barrier(0);
      }
  }
};
struct EpiProj {
  static constexpr bool PERM = true, AFTER_DRAIN = false;
  u16* projb;
  __device__ __forceinline__ void operator()(const f32x4 (&acc)[2][2][4][2], const pg8::Unit& u, int wr, int wc, int fr, int fq) const {
#pragma unroll
    for (int ai = 0; ai < 2; ++ai)
#pragma unroll
      for (int m = 0; m < 4; ++m) {
        const int row = u.pm * 256 + ai * 128 + wr * 64 + m * 16 + fr;
#pragma unroll
        for (int bj = 0; bj < 2; ++bj)
          *(u32x4*)(projb + (size_t)row * D_ + u.pn * 256 + bj * 128 + wc * 32 + 8 * fq) = pack8(acc[ai][bj][m][0], acc[ai][bj][m][1]);
      }
  }
};
struct EpiOut {
  static constexpr bool PERM = false, AFTER_DRAIN = false;
  const float* x; float* y1;
  __device__ __forceinline__ void operator()(const f32x4 (&acc)[2][2][4][2], const pg8::Unit& u, int wr, int wc, int fr, int fq) const {
#pragma unroll
    for (int ai = 0; ai < 2; ++ai)
#pragma unroll
      for (int m = 0; m < 4; ++m) {
        const size_t rb = (size_t)(u.pm * 256 + ai * 128 + wr * 64 + m * 16 + fr) * D_ + u.pn * 256 + wc * 32 + 4 * fq;
#pragma unroll
        for (int bj = 0; bj < 2; ++bj)
#pragma unroll
          for (int n = 0; n < 2; ++n) {
            const size_t o = rb + bj * 128 + n * 16;
            const f32x4 xv = *(const f32x4*)(x + o);
            *(f32x4*)(y1 + o) = xv * ALPHA + acc[ai][bj][m][n];
          }
      }
  }
};
struct EpiGate {
  static constexpr bool PERM = false, AFTER_DRAIN = false;
  const float* h1; const u16* projb; float* out;
  __device__ __forceinline__ void operator()(const f32x4 (&acc)[2][2][4][2], const pg8::Unit& u, int wr, int wc, int fr, int fq) const {
#pragma unroll
    for (int ai = 0; ai < 2; ++ai)
#pragma unroll
      for (int m = 0; m < 4; ++m) {
        const size_t rb = (size_t)(u.pm * 256 + ai * 128 + wr * 64 + m * 16 + fr) * D_ + u.pn * 256 + wc * 32 + 4 * fq;
#pragma unroll
        for (int bj = 0; bj < 2; ++bj)
#pragma unroll
          for (int n = 0; n < 2; ++n) {
            const size_t o = rb + bj * 128 + n * 16;
            const f32x4 hv = *(const f32x4*)(h1 + o);
            const u32x2 pj = *(const u32x2*)(projb + o);
            const f32x4 a = acc[ai][bj][m][n];
            f32x4 r;
            r[0] = ALPHA * hv[0] + bflo(pj[0]) / (1.f + __expf(-a[0])); r[1] = ALPHA * hv[1] + bfhi(pj[0]) / (1.f + __expf(-a[1]));
            r[2] = ALPHA * hv[2] + bflo(pj[1]) / (1.f + __expf(-a[2])); r[3] = ALPHA * hv[3] + bfhi(pj[1]) / (1.f + __expf(-a[3]));
            *(f32x4*)(out + o) = r;
          }
      }
  }
};

__device__ __forceinline__ int vblock(int bid, int nb) { return (nb & 7) ? bid : (bid & 7) * (nb >> 3) + (bid >> 3); }
__device__ __forceinline__ void tile_rc(int t, int Nt, int& tm, int& tn) {
  const int g = t / (8 * Nt), q = t % (8 * Nt);
  tn = q >> 3; tm = g * 8 + (q & 7);
}

__device__ void phase_inproj(const Params& p, char* smem, int bid, int nb) {
  {
    EpiInproj E{p.cqb(), p.ckvb(), p.Qf(), p.Kf(), p.VfT(), p.rss()};
    pg8::Gemm g{p.xb(), p.WinT(), T_, 4096, D_};
    pg8::StaticOrder S; S.init(T_, 4096, nb, bid);
    pg8::gemm_phase((PG8_LAS unsigned char*)smem, g, S, E, nullptr);
  }
  for (int t = vblock(bid, nb); t < 256; t += nb) {
    const int tm = t >> 3, ks = t & 7;
    f32x4 acc[2][4][4];
    gemm_core<2, 4>(p.xb() + ks * 256, D_, p.WinT() + ks * 256, D_, 256, tm * 256, 4096, smem, acc);
    const int tid = TID(), wid = tid >> 6, lane = tid & 63, wr = wid >> 2, wc = wid & 3, fr = lane & 15, fq = lane >> 4;
    if (wc == 0) {
#pragma unroll
      for (int h = 0; h < 2; ++h) {
        float* kd = p.krsum() + (size_t)(tm * 256 + wr * 128 + h * 64 + fq * 4) * 64 + fr;
#pragma unroll
        for (int m = 0; m < 4; ++m)
#pragma unroll
          for (int n = 0; n < 4; ++n)
#pragma unroll
            for (int j = 0; j < 4; ++j) atomicAdd(kd + (m * 16 + j) * 64 + n * 16, acc[h][m][n][j]);
      }
    }
  }
}

__device__ void phase_up(const Params& p, char* smem, int bid, int nb) {
  PG8_LAS unsigned char* lds = (PG8_LAS unsigned char*)smem;
  {
    EpiQup E{p.Qm(), p.rss()};
    pg8::Gemm g{p.cqb(), p.WuqT(), T_, 1536, 512};
    pg8::StaticOrder S; S.init(T_, 1536, nb, (bid + nb - 64) % nb);
    pg8::gemm_phase(lds, g, S, E, nullptr);
  }
  {
    EpiKVup E{p.Km(), p.VmT(), p.rss()};
    pg8::Gemm g{p.ckvb(), p.WukvT(), T_, 2048, 512};
    pg8::StaticOrder S; S.init(T_, 2048, nb, bid);
    pg8::gemm_phase(lds, g, S, E, nullptr);
  }
  {
    EpiProj E{p.projb()};
    pg8::Gemm g{p.pb(), p.WpT(), T_, 2048, 256};
    pg8::StaticOrder S; S.init(T_, 2048, nb, bid);
    pg8::gemm_phase(lds, g, S, E, nullptr);
  }
  for (int t = bid; t < 48; t += nb) {
    if (t >= 16) {
      const int r0 = (t - 16) * 256, tid = TID();
#pragma unroll 1
      for (int it = 0; it < 16; ++it) {
        const int pr = it * NT + tid, row = r0 + (pr >> 5), i = pr & 31, b = row >> 12, s = row & 4095;
        const float x1 = p.krsum()[(size_t)row * 64 + i], x2 = p.krsum()[(size_t)row * 64 + 32 + i];
        const float2 cs = p.cs()[(size_t)row * 32 + i];
        const u16 o1 = f2bf(x1 * cs.x - x2 * cs.y), o2 = f2bf(x1 * cs.y + x2 * cs.x);
#pragma unroll
        for (int hh = 0; hh < 8; ++hh) {
          u16* kd = p.Km() + ((size_t)(b * 8 + hh) * S_ + s) * 192 + 128;
          kd[i] = o1; kd[32 + i] = o2;
        }
      }
    } else {
      const int seq = t;
      if ((TID() >> 6) == 0) {
        const int lane = TID() & 63;
        const float* src = p.logf() + (size_t)seq * S_ + lane * 64;
        float* dst = p.Fk() + (size_t)seq * S_ + lane * 64;
        float sum = 0.f;
#pragma unroll
        for (int i = 0; i < 16; ++i) { const float4 v = *(const float4*)(src + i * 4); sum += v.x; sum += v.y; sum += v.z; sum += v.w; }
        float inc = sum;
#pragma unroll
        for (int d = 1; d < 64; d <<= 1) { const float o = __shfl_up(inc, d, 64); if (lane >= d) inc += o; }
        float run = inc - sum;
#pragma unroll
        for (int i = 0; i < 16; ++i) {
          const float4 v = *(const float4*)(src + i * 4); float4 o;
          run += v.x; o.x = run; run += v.y; o.y = run; run += v.z; o.z = run; run += v.w; o.w = run;
          *(float4*)(dst + i * 4) = o;
        }
      }
    }
  }
}

#ifdef ATTN_NAIVE
__device__ void phase_attn_naive(const Params& p, char* smem, int bid, int nb) {
  const int tid = TID(), lane = tid & 63, wid = tid >> 6;
  const int per = NB_ * 8 * S_, nrows = 2 * per;
  for (int r = bid * 4 + wid; r < nrows; r += nb * 4) {
    const int type = r / per, rr = r % per, bh = rr / S_, s = rr % S_;
    const int DQ = type ? 128 : 192;
    const u16* Q = type ? p.Qf() + ((size_t)bh * S_ + s) * 128 : p.Qm() + ((size_t)bh * S_ + s) * 192;
    const u16* Kb = type ? p.Kf() + (size_t)bh * S_ * 128 : p.Km() + (size_t)bh * S_ * 192;
    const u16* VT = (type ? p.VfT() : p.VmT()) + (size_t)bh * 128 * S_;
    const float* F = p.Fk() + (size_t)bh * S_;
    const float scale = type ? 0.08838834764831845f : 0.07216878364870322f;
    float m = -1e30f, l = 0.f;
    float acc[128];
#pragma unroll
    for (int d = 0; d < 128; ++d) acc[d] = 0.f;
    const float fqv = type ? F[s] : 0.f;
    for (int k0 = 0; k0 <= s; k0 += 64) {
      const int key = k0 + lane; const bool valid = key <= s; const int keyc = valid ? key : s;
      const u16* kr = Kb + (size_t)keyc * DQ;
      float sc = 0.f;
      for (int d = 0; d < DQ; d += 8) {
        const u32x4 kv = *(const u32x4*)(kr + d), qv = *(const u32x4*)(Q + d);
#pragma unroll
        for (int w = 0; w < 4; ++w) sc += bflo(kv[w]) * bflo(qv[w]) + bfhi(kv[w]) * bfhi(qv[w]);
      }
      sc *= scale;
      if (type) sc += fqv - F[keyc];
      if (!valid) sc = -1e30f;
      const float mx = wave_max(sc), mn = fmaxf(m, mx), alpha = __expf(m - mn);
      const float pr = valid ? __expf(sc - mn) : 0.f;
      m = mn; l = l * alpha + pr;
#pragma unroll
      for (int d = 0; d < 128; ++d) acc[d] = acc[d] * alpha + pr * bf2f(VT[(size_t)d * S_ + keyc]);
    }
    const float inv = 1.f / wave_sum(l);
    float o0 = 0.f, o1 = 0.f;
#pragma unroll
    for (int d = 0; d < 128; ++d) {
      const float o = wave_sum(acc[d]) * inv;
      if (lane == (d & 63)) { if (d < 64) o0 = o; else o1 = o; }
    }
    const int b = bh >> 3, hh = bh & 7;
    u16* od = p.omix() + ((size_t)(b * S_ + s)) * 2048 + type * 1024 + hh * 128;
    od[lane] = f2bf(o0); od[64 + lane] = f2bf(o1);
  }
}

#endif
typedef float f32x16 __attribute__((ext_vector_type(16)));
template <int TYPE>
__device__ __forceinline__ void attn_item(const Params& p, char* smem, int bh, int qb) {
  constexpr int DQK = TYPE ? 128 : 192, NKS = DQK / 16, KSTR = DQK * 2 + 16, VSTR = 128;
  constexpr int KCH = DQK / 8, NKL = 64 * KCH / NT;
  constexpr float C2 = (TYPE ? 0.08838834764831845f : 0.07216878364870322f) * 1.4426950408889634f;
  char* sK = smem; char* sV = smem + 51200; float* sF = (float*)(smem + 51200 + 32768);
  const int tid = TID(), lane = tid & 63, wid = tid >> 6, c = lane & 31, hi = lane >> 5;
  const u16* Qb = (TYPE ? p.Qf() : p.Qm()) + (size_t)bh * S_ * DQK;
  const u16* Kb = (TYPE ? p.Kf() : p.Km()) + (size_t)bh * S_ * DQK;
  const u16* Vb = (TYPE ? p.VfT() : p.VmT()) + (size_t)bh * 128 * S_;
  const float* Fb = p.Fk() + (size_t)bh * S_;
  const int qrow = qb * 256 + wid * 32;
  bf16x8 qf[NKS];
#pragma unroll
  for (int ks = 0; ks < NKS; ++ks) qf[ks] = *(const bf16x8*)(Qb + (size_t)(qrow + c) * DQK + ks * 16 + hi * 8);
  if (TYPE == 0) {
    const float2* csr = p.cs() + (size_t)((bh >> 3) * S_ + qrow + c) * 32;
#pragma unroll
    for (int kk = 0; kk < 2; ++kk) {
      u32x4 x1 = *reinterpret_cast<u32x4*>(&qf[(NKS - 4) + kk]), x2 = *reinterpret_cast<u32x4*>(&qf[(NKS - 2) + kk]);
#pragma unroll
      for (int w = 0; w < 4; ++w) {
        const float4 cs = *(const float4*)(csr + 16 * kk + 8 * hi + 2 * w);
        const float a0 = bflo(x1[w]), a1 = bfhi(x1[w]), b0 = bflo(x2[w]), b1 = bfhi(x2[w]);
        x1[w] = pk2(a0 * cs.x - b0 * cs.y, a1 * cs.z - b1 * cs.w);
        x2[w] = pk2(a0 * cs.y + b0 * cs.x, a1 * cs.w + b1 * cs.z);
      }
      qf[(NKS - 4) + kk] = *reinterpret_cast<bf16x8*>(&x1); qf[(NKS - 2) + kk] = *reinterpret_cast<bf16x8*>(&x2);
    }
  }
  f32x16 o[4];
#pragma unroll
  for (int db = 0; db < 4; ++db)
#pragma unroll
    for (int r = 0; r < 16; ++r) o[db][r] = 0.f;
  float m = -1e30f, l = 0.f;
  const int ntiles = 4 * qb + 4;
  u32x4 kreg[NKL];
  float4 freg = make_float4(0.f, 0.f, 0.f, 0.f);
  const unsigned koff = (unsigned)tid * 16u;
  auto load_k = [&](int kt) {
    const char* kb = (const char*)(Kb + (size_t)kt * 64 * DQK);
#pragma unroll
    for (int i = 0; i < NKL; ++i) kreg[i] = *(const u32x4*)(kb + i * 8192 + koff);
    if (TYPE) { if (tid < 16) freg = *(const float4*)(Fb + kt * 64 + tid * 4); }
  };
  const unsigned voff = (unsigned)((((tid >> 3) * S_) + (((tid & 7) ^ ((tid >> 4) & 7)) * 8)) * 2);
  auto load_v = [&](int kt) {
    const char* vb = (const char*)(Vb + kt * 64);
    char* dst = sV + (kt & 1) * 16384 + tid * 16;
#pragma unroll
    for (int i = 0; i < 2; ++i)
      __builtin_amdgcn_global_load_lds((const unsigned*)(vb + (size_t)i * 64 * S_ * 2 + voff), (unsigned*)(dst + i * 8192), 16, 0, 0);
  };
  auto store_tile = [&](int kt) {
    char* sKw = sK + (kt & 1) * 25600;
#pragma unroll
    for (int i = 0; i < NKL; ++i) { const int ch = tid + NT * i, key = ch / KCH, dc = ch % KCH; *(u32x4*)(sKw + key * KSTR + dc * 16) = kreg[i]; }
    if (TYPE) { if (tid < 16) { const float L2E = 1.4426950408889634f; *(float4*)(sF + (kt & 1) * 64 + tid * 4) = make_float4(freg.x * L2E, freg.y * L2E, freg.z * L2E, freg.w * L2E); } }
  };
  const int krow = (c & 19) | ((c & 4) << 1) | ((c & 8) >> 1);
  const char* ka0 = sK + krow * KSTR + hi * 16;
  const char* ka1 = ka0 + 32 * KSTR;
  const int vx = (c >> 1) & 7;
  int vo[2][2];
#pragma unroll
  for (int kb = 0; kb < 2; ++kb)
#pragma unroll
    for (int s2 = 0; s2 < 2; ++s2) vo[kb][s2] = c * VSTR + (((4 * kb + 2 * s2 + hi) ^ vx) * 16);
  load_k(0); load_v(0);
  store_tile(0);
#pragma unroll 1
  for (int kt = 0; kt < ntiles; ++kt) {
    asm volatile("s_waitcnt vmcnt(0) lgkmcnt(0)" ::: "memory");
    __syncthreads();
    if (kt + 1 < ntiles) { load_k(kt + 1); load_v(kt + 1); }
    const int k0 = kt * 64;
    const char* sVc = sV + (kt & 1) * 16384;
    const int kbo = (kt & 1) * 25600;
    const float* sFc = sF + (kt & 1) * 64;
    if (k0 <= qrow + 31) {
      f32x16 p0, p1;
#pragma unroll
      for (int r = 0; r < 16; ++r) { p0[r] = 0.f; p1[r] = 0.f; }
#pragma unroll
      for (int ks = 0; ks < NKS; ++ks) {
        const bf16x8 a0 = *(const bf16x8*)(ka0 + kbo + ks * 32), a1 = *(const bf16x8*)(ka1 + kbo + ks * 32);
        p0 = __builtin_amdgcn_mfma_f32_32x32x16_bf16(a0, qf[ks], p0, 0, 0, 0);
        p1 = __builtin_amdgcn_mfma_f32_32x32x16_bf16(a1, qf[ks], p1, 0, 0, 0);
      }
      if (TYPE) {
#pragma unroll
        for (int s = 0; s < 2; ++s) {
          const float4 f0 = *(const float4*)(sFc + 16 * s + 8 * hi), f1 = *(const float4*)(sFc + 16 * s + 8 * hi + 4);
          const float4 g0 = *(const float4*)(sFc + 32 + 16 * s + 8 * hi), g1 = *(const float4*)(sFc + 32 + 16 * s + 8 * hi + 4);
          p0[8 * s + 0] = p0[8 * s + 0] * C2 - f0.x; p0[8 * s + 1] = p0[8 * s + 1] * C2 - f0.y; p0[8 * s + 2] = p0[8 * s + 2] * C2 - f0.z; p0[8 * s + 3] = p0[8 * s + 3] * C2 - f0.w;
          p0[8 * s + 4] = p0[8 * s + 4] * C2 - f1.x; p0[8 * s + 5] = p0[8 * s + 5] * C2 - f1.y; p0[8 * s + 6] = p0[8 * s + 6] * C2 - f1.z; p0[8 * s + 7] = p0[8 * s + 7] * C2 - f1.w;
          p1[8 * s + 0] = p1[8 * s + 0] * C2 - g0.x; p1[8 * s + 1] = p1[8 * s + 1] * C2 - g0.y; p1[8 * s + 2] = p1[8 * s + 2] * C2 - g0.z; p1[8 * s + 3] = p1[8 * s + 3] * C2 - g0.w;
          p1[8 * s + 4] = p1[8 * s + 4] * C2 - g1.x; p1[8 * s + 5] = p1[8 * s + 5] * C2 - g1.y; p1[8 * s + 6] = p1[8 * s + 6] * C2 - g1.z; p1[8 * s + 7] = p1[8 * s + 7] * C2 - g1.w;
        }
      }
      if (k0 + 63 > qrow) {
        const int lim = qrow + c - k0 - 8 * hi;
        const float NEG = -__builtin_inff();
#pragma unroll
        for (int r = 0; r < 16; ++r) {
          const int kb = 16 * (r >> 3) + (r & 7);
          if (kb > lim) p0[r] = NEG;
          if (kb + 32 > lim) p1[r] = NEG;
        }
      }
      float mx = p0[0];
#pragma unroll
      for (int r = 1; r < 16; ++r) mx = fmaxf(mx, p0[r]);
#pragma unroll
      for (int r = 0; r < 16; ++r) mx = fmaxf(mx, p1[r]);
      {
        auto rr = __builtin_amdgcn_permlane32_swap(__float_as_uint(mx), __float_as_uint(mx), false, false);
        mx = fmaxf(__uint_as_float(rr[0]), __uint_as_float(rr[1]));
      }
      if (!TYPE) mx *= C2;
      constexpr float THR = 8.f;
      float mn = m, alpha = 1.f;
      if (!__all(mx - m <= THR)) {
        mn = fmaxf(m, mx);
        alpha = __builtin_amdgcn_exp2f(m - mn);
        m = mn;
#pragma unroll
        for (int db = 0; db < 4; ++db)
#pragma unroll
          for (int r = 0; r < 16; ++r) o[db][r] *= alpha;
      }
      float ps = 0.f;
      if (TYPE) {
#pragma unroll
        for (int r = 0; r < 16; ++r) { p0[r] = __builtin_amdgcn_exp2f(p0[r] - mn); p1[r] = __builtin_amdgcn_exp2f(p1[r] - mn); ps += p0[r] + p1[r]; }
      } else {
#pragma unroll
        for (int r = 0; r < 16; ++r) { p0[r] = __builtin_amdgcn_exp2f(fmaf(p0[r], C2, -mn)); p1[r] = __builtin_amdgcn_exp2f(fmaf(p1[r], C2, -mn)); ps += p0[r] + p1[r]; }
      }
      l = l * alpha + ps;
      bf16x8 pa[2][2];
#pragma unroll
      for (int s = 0; s < 2; ++s) {
        u32x4 w0 = {pk2(p0[8 * s + 0], p0[8 * s + 1]), pk2(p0[8 * s + 2], p0[8 * s + 3]), pk2(p0[8 * s + 4], p0[8 * s + 5]), pk2(p0[8 * s + 6], p0[8 * s + 7])};
        u32x4 w1 = {pk2(p1[8 * s + 0], p1[8 * s + 1]), pk2(p1[8 * s + 2], p1[8 * s + 3]), pk2(p1[8 * s + 4], p1[8 * s + 5]), pk2(p1[8 * s + 6], p1[8 * s + 7])};
        pa[0][s] = *reinterpret_cast<bf16x8*>(&w0); pa[1][s] = *reinterpret_cast<bf16x8*>(&w1);
      }
#pragma unroll
      for (int db = 0; db < 4; ++db)
#pragma unroll
        for (int kb = 0; kb < 2; ++kb)
#pragma unroll
          for (int s = 0; s < 2; ++s) {
            const bf16x8 av = *(const bf16x8*)(sVc + db * 32 * VSTR + vo[kb][s]);
            o[db] = __builtin_amdgcn_mfma_f32_32x32x16_bf16(av, pa[kb][s], o[db], 0, 0, 0);
          }
    }
    if (kt + 1 < ntiles) store_tile(kt + 1);
  }
  {
    auto rr = __builtin_amdgcn_permlane32_swap(__float_as_uint(l), __float_as_uint(l), false, false);
    const float inv = 1.f / (__uint_as_float(rr[0]) + __uint_as_float(rr[1]));
    const int b = bh >> 3, hh = bh & 7;
    u16* od = p.omix() + ((size_t)(b * S_ + qrow + c)) * 2048 + TYPE * 1024 + hh * 128 + 4 * hi;
#pragma unroll
    for (int db = 0; db < 4; ++db)
#pragma unroll
      for (int g = 0; g < 4; ++g)
        *(u32x2*)(od + 32 * db + 8 * g) = u32x2{pk2(o[db][4 * g] * inv, o[db][4 * g + 1] * inv), pk2(o[db][4 * g + 2] * inv, o[db][4 * g + 3] * inv)};
  }
}

__device__ void phase_attn(const Params& p, char* smem, int bid, int nb) {
  int* sItem = (int*)(smem + 90000);
  const int x = bid & 7;
  unsigned* q = p.ctr() + 32 + x;
  for (;;) {
    __syncthreads();
    if (TID() == 0) *sItem = (int)atomicAdd(q, 1u);
    __syncthreads();
    const int item = *sItem;
    if (item >= 64) break;
    const int qb = 15 - (item >> 2), r = item & 3, type = r >> 1, bh = x + 8 * (r & 1);
    if (type == 0) attn_item<0>(p, smem, bh, qb); else attn_item<1>(p, smem, bh, qb);
  }
  unsigned* qc = p.ctr() + 48;
  for (;;) {
    __syncthreads();
    if (TID() == 0) *sItem = (int)atomicAdd(qc, 1u);
    __syncthreads();
    const int chunk = *sItem;
    if (chunk >= 512) break;
    quant_chunk(p, chunk);
  }
}

__device__ void phase_outproj(const Params& p, char* smem, int bid, int nb) {
  EpiOut E{p.x, p.y1()};
  pg8::Gemm g{p.omix(), p.WoutT(), T_, D_, D_};
  pg8::StaticOrder S; S.init(T_, D_, nb, bid);
  pg8::gemm_phase((PG8_LAS unsigned char*)smem, g, S, E, nullptr);
}

__device__ void phase_ln1(const Params& p, int bid, int nb) {
  const int lane = TID() & 63, wid = TID() >> 6;
  for (int t = bid * 8 + wid; t < T_; t += nb * 8) {
    float* row = p.y1() + (size_t)t * D_;
    float4 v[8];
    float sum = 0.f;
#pragma unroll
    for (int i = 0; i < 8; ++i) { v[i] = *(const float4*)(row + (i * 64 + lane) * 4); sum += (v[i].x + v[i].y) + (v[i].z + v[i].w); }
    const float mu = wave_sum(sum) * (1.f / D_);
    float sq = 0.f;
#pragma unroll
    for (int i = 0; i < 8; ++i) {
      v[i].x -= mu; v[i].y -= mu; v[i].z -= mu; v[i].w -= mu;
      sq += (v[i].x * v[i].x + v[i].y * v[i].y) + (v[i].z * v[i].z + v[i].w * v[i].w);
    }
    const float rstd = rsqrtf(wave_sum(sq) * (1.f / D_) + EPS);
#pragma unroll
    for (int i = 0; i < 8; ++i) {
      const int c = (i * 64 + lane) * 4;
      const float4 g = *(const float4*)(p.ln1_g + c), bb = *(const float4*)(p.ln1_b + c);
      float4 o; o.x = v[i].x * rstd * g.x + bb.x; o.y = v[i].y * rstd * g.y + bb.y; o.z = v[i].z * rstd * g.z + bb.z; o.w = v[i].w * rstd * g.w + bb.w;
      *(float4*)(row + c) = o;
      *(u32x2*)(p.h1b() + (size_t)t * D_ + c) = u32x2{pk2(o.x, o.y), pk2(o.z, o.w)};
    }
  }
}

__device__ __forceinline__ void ins16(unsigned (&t)[16], unsigned x) {
#pragma unroll
  for (int i = 0; i < 16; ++i) { const unsigned hi = t[i] > x ? t[i] : x; x = t[i] > x ? x : t[i]; t[i] = hi; }
}
__device__ __forceinline__ void ins16p(unsigned (&ck)[16], int (&ce)[16], unsigned x, int xe) {
#pragma unroll
  for (int i = 0; i < 16; ++i) {
    const bool sw = x > ck[i];
    const unsigned nk = sw ? x : ck[i], nx = sw ? ck[i] : x;
    const int ne = sw ? xe : ce[i], nxe = sw ? ce[i] : xe;
    ck[i] = nk; x = nx; ce[i] = ne; xe = nxe;
  }
}
__device__ __forceinline__ float unordkey(unsigned k) { return __uint_as_float((k & 0x80000000u) ? (k & 0x7fffffffu) : ~k); }

__device__ __forceinline__ void score_block(const u16* kH, const u16* kL, const bf16x8 (&qh)[4], const bf16x8 (&ql)[4], int hi, unsigned (&t)[16]) {
#pragma unroll
  for (int i = 0; i < 16; ++i) t[i] = 0u;
#pragma unroll 1
  for (int kb = 0; kb < 4; ++kb) {
    f32x16 sc;
#pragma unroll
    for (int r = 0; r < 16; ++r) sc[r] = 0.f;
#pragma unroll
    for (int ks = 0; ks < 4; ++ks) {
      const bf16x8 ah = *(const bf16x8*)(kH + kb * 32 * 64 + ks * 16), al = *(const bf16x8*)(kL + kb * 32 * 64 + ks * 16);
      sc = __builtin_amdgcn_mfma_f32_32x32x16_bf16(ah, qh[ks], sc, 0, 0, 0);
      sc = __builtin_amdgcn_mfma_f32_32x32x16_bf16(ah, ql[ks], sc, 0, 0, 0);
      sc = __builtin_amdgcn_mfma_f32_32x32x16_bf16(al, qh[ks], sc, 0, 0, 0);
    }
    const unsigned base = (unsigned)(127 - 32 * kb) - 4u * (unsigned)hi;
#pragma unroll
    for (int r = 0; r < 16; ++r) ins16(t, (ordkey(sc[r]) & ~127u) | (base - (unsigned)((r & 3) + 8 * (r >> 2))));
  }
  unsigned other[16];
#pragma unroll
  for (int i = 0; i < 16; ++i) {
    auto rr = __builtin_amdgcn_permlane32_swap(t[i], t[i], false, false);
    other[i] = hi ? rr[0] : rr[1];
  }
#pragma unroll 1
  for (int i = 0; i < 16; ++i) {
    unsigned x = other[0];
#pragma unroll
    for (int k = 1; k < 16; ++k) x = (i == k) ? other[k] : x;
    ins16(t, x);
  }
}

__device__ __forceinline__ void route_tile(const Params& p, char* smem, f32x4 (&acc)[4][4], int tm, int h) {
  const int tid = TID(), wid = tid >> 6, lane = tid & 63, wr = wid >> 1, wc = wid & 1, fr = lane & 15, fq = lane >> 4;
  __syncthreads();
  float* Qw = (float*)smem + wid * (64 * 65);
#pragma unroll
  for (int m = 0; m < 4; ++m)
#pragma unroll
    for (int n = 0; n < 4; ++n)
#pragma unroll
      for (int j = 0; j < 4; ++j) Qw[(m * 16 + fq * 4 + j) * 65 + n * 16 + fr] = acc[m][n][j];
  asm volatile("s_waitcnt lgkmcnt(0)" ::: "memory");
  const int c = lane & 31, hi = lane >> 5;
  bf16x8 qh[2][4], ql[2][4];
#pragma unroll
  for (int tb = 0; tb < 2; ++tb)
#pragma unroll
    for (int ks = 0; ks < 4; ++ks) {
      float v[8]; unsigned wh[4], wl[4];
#pragma unroll
      for (int j = 0; j < 8; ++j) v[j] = Qw[(tb * 32 + c) * 65 + 16 * ks + 8 * hi + j];
#pragma unroll
      for (int w = 0; w < 4; ++w) {
        wh[w] = pk2(v[2 * w], v[2 * w + 1]);
        wl[w] = pk2(v[2 * w] - bflo(wh[w]), v[2 * w + 1] - bfhi(wh[w]));
      }
      u32x4 uh = {wh[0], wh[1], wh[2], wh[3]}, ul = {wl[0], wl[1], wl[2], wl[3]};
      qh[tb][ks] = *reinterpret_cast<bf16x8*>(&uh); ql[tb][ks] = *reinterpret_cast<bf16x8*>(&ul);
    }
  const u16* kH = p.keyH() + ((size_t)(wc * 8 + h) * 128 + c) * 64 + 8 * hi;
  const u16* kL = p.keyL() + ((size_t)(wc * 8 + h) * 128 + c) * 64 + 8 * hi;
  unsigned t0[16], t1[16];
  score_block(kH, kL, qh[0], ql[0], hi, t0);
  score_block(kH, kL, qh[1], ql[1], hi, t1);
  unsigned t[16];
#pragma unroll
  for (int i = 0; i < 16; ++i) t[i] = hi ? t1[i] : t0[i];
  __syncthreads();
  unsigned* L = (unsigned*)smem;
#pragma unroll
  for (int r = 0; r < 16; ++r) L[(wc * 16 + r) * 256 + wr * 64 + lane] = t[r];
  __syncthreads();
  if (wid < 4) {
    const int tok = wid * 64 + lane;
    unsigned ck[16]; int ce[16];
#pragma unroll
    for (int i = 0; i < 16; ++i) { ck[i] = 0u; ce[i] = 0; }
#pragma unroll 1
    for (int a = 0; a < 16; ++a) {
      const unsigned ka = L[a * 256 + tok];
      const int i1a = (127 - (int)(ka & 127u)) * 128; const float v1a = unordkey(ka & ~127u);
      const int nbm1 = (int)((0x1112347FULL >> (4 * a)) & 15ULL);
#pragma unroll 1
      for (int b = 0; b <= nbm1; ++b) {
        const unsigned kb = L[(16 + b) * 256 + tok];
        const int i2b = 127 - (int)(kb & 127u); const float v2b = unordkey(kb & ~127u);
        ins16p(ck, ce, ordkey(v1a + v2b), i1a + i2b);
      }
    }
    float ex[16], sum = 0.f;
    const float mx = unordkey(ck[0]);
#pragma unroll
    for (int r = 0; r < 16; ++r) { ex[r] = __expf(unordkey(ck[r]) - mx); sum += ex[r]; }
    const float inv = 1.f / sum;
    const size_t o = ((size_t)(tm * 256 + tok) * 8 + h) * 16;
    int* ed = p.eidxG() + o; float* gd = p.gateG() + o;
#pragma unroll
    for (int r = 0; r < 16; r += 4) {
      *(int4*)(ed + r) = make_int4(ce[r], ce[r + 1], ce[r + 2], ce[r + 3]);
      *(float4*)(gd + r) = make_float4(ex[r] * inv, ex[r + 1] * inv, ex[r + 2] * inv, ex[r + 3] * inv);
    }
  }
}

__device__ void phase_mid(const Params& p, char* smem, int bid, int nb) {
  {
    EpiGate E{p.y1(), p.projb(), p.out};
    pg8::Gemm g{p.h1b(), p.WgT(), T_, D_, D_};
    pg8::StaticOrder S; S.init(T_, D_, nb, bid);
    pg8::gemm_phase((PG8_LAS unsigned char*)smem, g, S, E, nullptr);
  }
  for (int t = vblock(bid, nb); t < 32 * 8; t += nb) {
    int tm, tn; tile_rc(t, 8, tm, tn);
    f32x4 acc[1][4][4];
    gemm_core<4, 2>(p.h1b(), D_, p.WpqT(), D_, D_, tm * 256, tn * 128, smem, acc);
    route_tile(p, smem, acc[0], tm, tn);
  }
}

__device__ __forceinline__ float gelu_exact(float a) {
  const float x = fabsf(a) * 0.7071067811865476f;
  const float t = __builtin_amdgcn_rcpf(1.f + 0.3275911f * x);
  const float poly = t * (0.254829592f + t * (-0.284496736f + t * (1.421413741f + t * (-1.453152027f + t * 1.061405429f))));
  const float er = 1.f - poly * __expf(-x * x);
  return 0.5f * a * (1.f + (a < 0.f ? -er : er));
}

template <int NPER, int IDXMASK>
__device__ __forceinline__ int top16(unsigned (&k)[NPER], int lane) {
  int mine = 0;
#pragma unroll 1
  for (int r = 0; r < 16; ++r) {
    unsigned loc = k[0];
#pragma unroll
    for (int i = 1; i < NPER; ++i) loc = loc > k[i] ? loc : k[i];
    const unsigned best = wave_umax(loc);
#pragma unroll
    for (int i = 0; i < NPER; ++i) if (k[i] == best) k[i] = 0u;
    if (lane == r) mine = IDXMASK - (int)(best & (unsigned)IDXMASK);
  }
  return mine;
}

__device__ void phase_peer(const Params& p, char* smem, int bid, int nb) {
  const int tid = TID(), lane = tid & 63, wid = tid >> 6;
  float* qs = (float*)smem;
  float* sc = (float*)(smem + 8192);
  int* eidx = (int*)(smem + 24576);
  float* gts = (float*)(smem + 40960);
  for (int it = bid; it < T_ / 32; it += nb) {
    const int t0 = it * 32;
#pragma unroll
    for (int i = 0; i < 2; ++i) {
      const int idx = (i * NT + tid) * 4;
      *(int4*)(eidx + idx) = *(const int4*)(p.eidxG() + (size_t)t0 * 128 + idx);
      *(float4*)(gts + idx) = *(const float4*)(p.gateG() + (size_t)t0 * 128 + idx);
    }
    __syncthreads();
    for (int ti = 0; ti < 4; ++ti) {
      const int tok = wid * 4 + ti, t = t0 + tok;
      typedef float f32x32 __attribute__((ext_vector_type(32)));
      typedef unsigned u32x6 __attribute__((ext_vector_type(6)));
      float hreg[32];
      f32x32 o;
#pragma unroll
      for (int q = 0; q < 8; ++q) {
        const u32x2 hv = *(const u32x2*)(p.h1b() + (size_t)t * D_ + (q * 64 + lane) * 4);
        hreg[q * 4] = bflo(hv[0]); hreg[q * 4 + 1] = bfhi(hv[0]); hreg[q * 4 + 2] = bflo(hv[1]); hreg[q * 4 + 3] = bfhi(hv[1]);
      }
#pragma unroll
      for (int i = 0; i < 32; ++i) o[i] = 0.f;
      const float* Us = p.Us(); const float* Vs = p.Vs();
      const unsigned char* Uq = p.Uq() + lane * 24;
      const int* ep = eidx + tok * 128; const float* gp = gts + tok * 128;
      u32x4 uA4[2], vA4[2], uB4[2], vB4[2]; u32x2 uA2[2], vA2[2], uB2[2], vB2[2];
      float gA[2], suA[2], svA[2], gB[2], suB[2], svB[2];
#define PEER_LOAD(U4, U2, V4, V2, G, SU, SV, J0)                                                        \
      _Pragma("unroll") for (int jj = 0; jj < 2; ++jj) {                                                \
        const int e = __builtin_amdgcn_readfirstlane(ep[(J0) + jj]);                                    \
        G[jj] = gp[(J0) + jj]; SU[jj] = Us[e]; SV[jj] = Vs[e];                                          \
        const unsigned char* up = Uq + (size_t)e * 3072; const unsigned char* vp = up + 1536;           \
        U2[jj] = *(const u32x2*)(up); U4[jj] = *(const u32x4*)(up + 8);                                 \
        V2[jj] = *(const u32x2*)(vp); V4[jj] = *(const u32x4*)(vp + 8);                                 \
      }
#define PEER_COMPUTE(U4, U2, V4, V2, G, SU, SV)                                                         \
      _Pragma("unroll") for (int jj = 0; jj < 2; ++jj) {                                                \
        const u32x6 uw = {U2[jj][0], U2[jj][1], U4[jj][0], U4[jj][1], U4[jj][2], U4[jj][3]};            \
        const f32x32 ud = __builtin_amdgcn_cvt_scalef32_pk32_f32_fp6(uw, 1.0f);                         \
        float d0 = 0.f, d1 = 0.f, d2 = 0.f, d3 = 0.f;                                                   \
        _Pragma("unroll") for (int i = 0; i < 32; i += 4) {                                             \
          d0 += ud[i] * hreg[i]; d1 += ud[i + 1] * hreg[i + 1]; d2 += ud[i + 2] * hreg[i + 2]; d3 += ud[i + 3] * hreg[i + 3]; \
        }                                                                                               \
        const float av = wave_sum((d0 + d1) + (d2 + d3)) * SU[jj];                                      \
        const float act = gelu_exact(av) * G[jj] * SV[jj];                                              \
        const u32x6 vw = {V2[jj][0], V2[jj][1], V4[jj][0], V4[jj][1], V4[jj][2], V4[jj][3]};            \
        const f32x32 vd = __builtin_amdgcn_cvt_scalef32_pk32_f32_fp6(vw, 1.0f);                         \
        o += vd * act;                                                                                  \
      }
      PEER_LOAD(uA4, uA2, vA4, vA2, gA, suA, svA, 0)
#pragma unroll 1
      for (int j0 = 0; j0 < 128; j0 += 4) {
        PEER_LOAD(uB4, uB2, vB4, vB2, gB, suB, svB, j0 + 2)
        PEER_COMPUTE(uA4, uA2, vA4, vA2, gA, suA, svA)
        if (j0 + 4 < 128) { PEER_LOAD(uA4, uA2, vA4, vA2, gA, suA, svA, j0 + 4) }
        PEER_COMPUTE(uB4, uB2, vB4, vB2, gB, suB, svB)
      }
#undef PEER_LOAD
#undef PEER_COMPUTE
      float* orow = p.out + (size_t)t * D_ + lane * 4;
      float sum = 0.f;
#pragma unroll
      for (int q = 0; q < 8; ++q) {
        const float4 r0 = *(const float4*)(orow + q * 256);
        o[q * 4 + 0] += r0.x; o[q * 4 + 1] += r0.y; o[q * 4 + 2] += r0.z; o[q * 4 + 3] += r0.w;
      }
#pragma unroll
      for (int i = 0; i < 32; ++i) sum += o[i];
      const float mu = wave_sum(sum) * (1.f / D_);
      float sq = 0.f;
#pragma unroll
      for (int i = 0; i < 32; ++i) { o[i] -= mu; sq += o[i] * o[i]; }
      const float rstd = rsqrtf(wave_sum(sq) * (1.f / D_) + EPS);
#pragma unroll
      for (int q = 0; q < 8; ++q) {
        const int col = (q * 64 + lane) * 4;
        const float4 g0 = *(const float4*)(p.ln2_g + col), b0 = *(const float4*)(p.ln2_b + col);
        float4 w0;
        w0.x = o[q * 4 + 0] * rstd * g0.x + b0.x; w0.y = o[q * 4 + 1] * rstd * g0.y + b0.y;
        w0.z = o[q * 4 + 2] * rstd * g0.z + b0.z; w0.w = o[q * 4 + 3] * rstd * g0.w + b0.w;
        *(float4*)(orow + q * 256) = w0;
      }
    }
    __syncthreads();
  }
}

template <int PH>
__device__ __forceinline__ void run_phase(const Params& p, char* smem, int bid, int nb) {
  if constexpr (PH == 0) phase_prep(p, smem, bid, nb);
  if constexpr (PH == 1) phase_inproj(p, smem, bid, nb);
  if constexpr (PH == 2) phase_up(p, smem, bid, nb);
#ifdef ATTN_NAIVE
  if constexpr (PH == 3) phase_attn_naive(p, smem, bid, nb);
#else
  if constexpr (PH == 3) phase_attn(p, smem, bid, nb);
#endif
  if constexpr (PH == 4) phase_outproj(p, smem, bid, nb);
  if constexpr (PH == 5) phase_ln1(p, bid, nb);
  if constexpr (PH == 6) phase_mid(p, smem, bid, nb);
  if constexpr (PH == 7) phase_peer(p, smem, bid, nb);
}

template <int PH>
__global__ void __launch_bounds__(NT, 2) phase_kernel(Params p) {
  __shared__ __attribute__((aligned(16))) char smem[SMEM_BYTES];
  run_phase<PH>(p, smem, blockIdx.x, gridDim.x);
}

#define BW_CENSUS(j) (256 + (j) * 32)
#define BW_XSUB(j) (256 + 512 + (j) * 32)
#define BW_XGEN(j) (256 + 1024 + (j) * 32)
#define BW_TOP (256 + 1536)
#define BW_TOPGEN (256 + 1568)
__device__ __forceinline__ unsigned bw_ld(unsigned* p) { return __hip_atomic_load(p, __ATOMIC_RELAXED, __HIP_MEMORY_SCOPE_AGENT); }
__device__ __forceinline__ unsigned bw_add(unsigned* p, unsigned v) { return __hip_atomic_fetch_add(p, v, __ATOMIC_RELAXED, __HIP_MEMORY_SCOPE_AGENT); }
__device__ __forceinline__ unsigned xcc_id() { return (unsigned)__builtin_amdgcn_s_getreg((3 << 11) | 20) & 0xFu; }

__device__ __forceinline__ void grid_barrier(unsigned* bar, unsigned* st  ) {
  asm volatile("s_waitcnt vmcnt(0)" ::: "memory");
  __syncthreads();
  if (threadIdx.x == 0) {
    __builtin_amdgcn_s_waitcnt(0);
    const unsigned x = xcc_id();
    unsigned nloc = st[0], nx = st[1];
    if (nloc == 0u) {
      const unsigned G = gridDim.x;
      for (;;) {
        unsigned sum = 0u, cnt = 0u, mine = 0u;
#pragma unroll
        for (unsigned j = 0; j < 16; ++j) { const unsigned c = bw_ld(&bar[BW_CENSUS(j)]); sum += c; cnt += (c > 0u) ? 1u : 0u; mine = (j == x) ? c : mine; }
        nloc = mine; nx = cnt;
        if (sum == G) break;
        __builtin_amdgcn_s_sleep(1);
      }
      st[0] = nloc; st[1] = nx;
    }
    const unsigned old = bw_add(&bar[BW_XSUB(x)], 1u);
    const unsigned gen = old / nloc;
    if (old + 1u == (gen + 1u) * nloc) {
      __builtin_amdgcn_fence(__ATOMIC_RELEASE, "agent");
      asm volatile("s_waitcnt vmcnt(0)" ::: "memory");
      const unsigned og = bw_add(&bar[BW_TOP], 1u);
      const unsigned tg = og / nx;
      if (og + 1u == (tg + 1u) * nx) bw_add(&bar[BW_TOPGEN], 1u);
      else while (bw_ld(&bar[BW_TOPGEN]) == tg) __builtin_amdgcn_s_sleep(1);
      __builtin_amdgcn_fence(__ATOMIC_ACQUIRE, "agent");
      bw_add(&bar[BW_XGEN(x)], 1u);
      asm volatile("s_waitcnt vmcnt(0)" ::: "memory");
    } else {
      while (bw_ld(&bar[BW_XGEN(x)]) == gen) __builtin_amdgcn_s_sleep(1);
      __builtin_amdgcn_fence(__ATOMIC_ACQUIRE, "agent");
      asm volatile("s_waitcnt vmcnt(0)" ::: "memory");
    }
  }
  __syncthreads();
}

#if SINGLE_LAUNCH
typedef const __attribute__((address_space(4))) unsigned long long* kargp_t;
static_assert(sizeof(Params) % 8 == 0, "Params must be a pack of 8-byte fields");
#define RUN_PHASE(N) run_phase<N>(p_, smem, bid, nb);
__global__ void __launch_bounds__(NT, 2) fwd_kernel(Params p_) {
  __shared__ __attribute__((aligned(16))) char smem[SMEM_BYTES + 64];
  const int bid = blockIdx.x, nb = gridDim.x;
  unsigned* bar = (unsigned*)(p_.ws + O_CTR);
  unsigned* st = (unsigned*)(smem + SMEM_BYTES);
  if (threadIdx.x == 0) { st[0] = 0u; st[1] = 0u; (void)bw_add(&bar[BW_CENSUS(xcc_id())], 1u); }
  if (p_.out == nullptr) cg::this_grid().sync();
  RUN_PHASE(0) grid_barrier(bar, st);
  RUN_PHASE(1) grid_barrier(bar, st);
  RUN_PHASE(2) grid_barrier(bar, st);
  RUN_PHASE(3) grid_barrier(bar, st);
  RUN_PHASE(4) grid_barrier(bar, st);
  RUN_PHASE(5) grid_barrier(bar, st);
  RUN_PHASE(6) grid_barrier(bar, st);
  RUN_PHASE(7)
}
#endif

extern "C" void kernel_launch(void* const* d_in, const int* in_sizes, int n_in, void* d_out, int out_size,
                              void* d_ws, size_t ws_size, hipStream_t stream) {
  (void)in_sizes; (void)n_in; (void)out_size; (void)ws_size;
  Params p{};
  p.x = (const float*)d_in[0]; p.p = (const float*)d_in[1]; p.positions = (const int*)d_in[2];
  p.w_in = (const float*)d_in[3]; p.b_forget = (const float*)d_in[4]; p.g_q = (const float*)d_in[5];
  p.w_uq = (const float*)d_in[6]; p.g_kv = (const float*)d_in[7]; p.w_ukv = (const float*)d_in[8];
  p.w_out = (const float*)d_in[9]; p.ln1_g = (const float*)d_in[10]; p.ln1_b = (const float*)d_in[11];
  p.peer_wq = (const float*)d_in[12]; p.keys1 = (const float*)d_in[13]; p.keys2 = (const float*)d_in[14];
  p.peer_u = (const float*)d_in[15]; p.peer_v = (const float*)d_in[16]; p.wgate = (const float*)d_in[17];
  p.wproj = (const float*)d_in[18]; p.ln2_g = (const float*)d_in[19]; p.ln2_b = (const float*)d_in[20];
  p.out = (float*)d_out;
  p.ws = (char*)d_ws;

  static int grid_blocks = 0;
  if (!grid_blocks) {
    int dev = 0, cus = 0, per_cu = 0;
    (void)hipGetDevice(&dev);
    (void)hipDeviceGetAttribute(&cus, hipDeviceAttributeMultiprocessorCount, dev);
#if SINGLE_LAUNCH
    (void)hipOccupancyMaxActiveBlocksPerMultiprocessor(&per_cu, fwd_kernel, NT, 0);
#else
    per_cu = 2;
#endif
    if (per_cu > 1) per_cu = 1;
    if (per_cu < 1) per_cu = 1;
    grid_blocks = cus * per_cu;
  }
#if SINGLE_LAUNCH
  (void)hipMemsetAsync(d_ws, 0, 16384, stream);
  void* args[] = {&p};
  hipError_t e = hipLaunchCooperativeKernel((void*)fwd_kernel, dim3(grid_blocks), dim3(NT), args, 0, stream);
  if (e != hipSuccess) fprintf(stderr, "cooperative launch failed: %s (grid %d)\n", hipGetErrorString(e), grid_blocks);
#else
  phase_kernel<0><<<grid_blocks, NT, 0, stream>>>(p);
  phase_kernel<1><<<grid_blocks, NT, 0, stream>>>(p);
  phase_kernel<2><<<grid_blocks, NT, 0, stream>>>(p);
  phase_kernel<3><<<grid_blocks, NT, 0, stream>>>(p);
  phase_kernel<4><<<grid_blocks, NT, 0, stream>>>(p);
  phase_kernel<5><<<grid_blocks, NT, 0, stream>>>(p);
  phase_kernel<6><<<grid_blocks, NT, 0, stream>>>(p);
  phase_kernel<7><<<grid_blocks, NT, 0, stream>>>(p);
#endif
}
```

```cpp
#include <hip/hip_runtime.h>
#include <hip/hip_bf16.h>
#include <hip/hip_cooperative_groups.h>
#include <stdint.h>
#include <cstdio>
namespace cg = cooperative_groups;

typedef unsigned short u16;
typedef short bf16x8 __attribute__((ext_vector_type(8)));
typedef float f32x4 __attribute__((ext_vector_type(4)));
typedef unsigned u32x4 __attribute__((ext_vector_type(4)));
typedef unsigned u32x2 __attribute__((ext_vector_type(2)));

#ifndef SINGLE_LAUNCH
#define SINGLE_LAUNCH 1
#endif

constexpr int T_ = 8192, D_ = 2048, S_ = 4096, NB_ = 2;
constexpr int INW = 4168;
constexpr int NPH = 8;
constexpr float ALPHA = 1.189207115002721f;
constexpr float EPS = 1e-6f;
constexpr int NT = 512;
constexpr int SMEM_BYTES = 133120;

constexpr size_t al256(size_t x) { return (x + 255) & ~(size_t)255; }
constexpr size_t O_CTR = 0;
constexpr size_t O_WINT = O_CTR + 16384;
constexpr size_t O_WUQT = O_WINT + al256((size_t)4352 * 2048 * 2);
constexpr size_t O_WUKVT = O_WUQT + al256((size_t)1536 * 512 * 2);
constexpr size_t O_WOUTT = O_WUKVT + al256((size_t)2048 * 512 * 2);
constexpr size_t O_WPQT = O_WOUTT + al256((size_t)2048 * 2048 * 2);
constexpr size_t O_WGT = O_WPQT + al256((size_t)1024 * 2048 * 2);
constexpr size_t O_WPT = O_WGT + al256((size_t)2048 * 2048 * 2);
constexpr size_t O_PB = O_WPT + al256((size_t)2048 * 256 * 2);
constexpr size_t O_UB = O_PB + al256((size_t)8192 * 256 * 2);
constexpr size_t O_VB = O_UB + 2048;
constexpr size_t O_OMIX = O_UB + al256((size_t)16384 * 4096);
constexpr size_t O_CS = O_OMIX + al256((size_t)8192 * 2048 * 2);
constexpr size_t O_PROJB = O_CS + al256((size_t)8192 * 32 * 8);
constexpr size_t O_KEYH = O_PROJB + al256((size_t)8192 * 2048 * 2);
constexpr size_t O_KEYL = O_KEYH + al256((size_t)2 * 8 * 128 * 64 * 2);
constexpr size_t O_US = O_KEYL + al256((size_t)2 * 8 * 128 * 64 * 2);
constexpr size_t O_VS = O_US + al256((size_t)16384 * 4);
constexpr size_t O_REGB = O_VS + al256((size_t)16384 * 4);
constexpr size_t O_XB = O_REGB;
constexpr size_t O_CQB = O_XB + al256((size_t)8192 * 2048 * 2);
constexpr size_t O_CKVB = O_CQB + al256((size_t)8192 * 512 * 2);
constexpr size_t O_QM = O_CKVB + al256((size_t)8192 * 512 * 2);
constexpr size_t O_KM = O_QM + al256((size_t)8192 * 8 * 192 * 2);
constexpr size_t O_VMT = O_KM + al256((size_t)8192 * 8 * 192 * 2);
constexpr size_t O_QF = O_VMT + al256((size_t)8192 * 8 * 128 * 2);
constexpr size_t O_KF = O_QF + al256((size_t)8192 * 8 * 128 * 2);
constexpr size_t O_VFT = O_KF + al256((size_t)8192 * 8 * 128 * 2);
constexpr size_t O_LOGF = O_VFT + al256((size_t)8192 * 8 * 128 * 2);
constexpr size_t O_FK = O_LOGF + al256((size_t)16 * 4096 * 4);
constexpr size_t O_KRS = O_FK + al256((size_t)16 * 4096 * 4);
constexpr size_t O_RSS = O_KRS + al256((size_t)8192 * 64 * 4);
constexpr size_t O_ENDB = O_RSS + al256((size_t)2 * 8192 * 4);
constexpr size_t O_Y1 = O_REGB;
constexpr size_t O_H1B = O_Y1 + al256((size_t)8192 * 2048 * 4);
constexpr size_t O_PQ = O_H1B + al256((size_t)8192 * 2048 * 2);
constexpr size_t O_GATE = O_PQ + al256((size_t)8192 * 128 * 4);
constexpr size_t O_ENDB2 = O_GATE + al256((size_t)8192 * 128 * 4);
static_assert(O_ENDB2 <= O_ENDB, "region B reuse overflow");
static_assert(O_ENDB <= (size_t)500 * 1024 * 1024, "workspace too large");

struct Params {
  const float *x, *p; const int* positions;
  const float *w_in, *b_forget, *g_q, *w_uq, *g_kv, *w_ukv, *w_out, *ln1_g, *ln1_b;
  const float *peer_wq, *keys1, *keys2, *peer_u, *peer_v, *wgate, *wproj, *ln2_g, *ln2_b;
  float* out;
  char* ws;
#define WSP(type, name, off) __device__ __forceinline__ type* name() const { return (type*)(ws + (off)); }
  WSP(unsigned, ctr, O_CTR) WSP(u16, WinT, O_WINT) WSP(u16, WuqT, O_WUQT) WSP(u16, WukvT, O_WUKVT) WSP(u16, WoutT, O_WOUTT)
  WSP(u16, WpqT, O_WPQT) WSP(u16, WgT, O_WGT) WSP(u16, WpT, O_WPT) WSP(u16, pb, O_PB) WSP(unsigned char, Uq, O_UB) WSP(unsigned char, Vq, O_VB) WSP(float, Us, O_US) WSP(float, Vs, O_VS)
  WSP(u16, omix, O_OMIX) WSP(float2, cs, O_CS) WSP(u16, projb, O_PROJB) WSP(u16, keyH, O_KEYH) WSP(u16, keyL, O_KEYL)
  WSP(u16, xb, O_XB) WSP(u16, cqb, O_CQB) WSP(u16, ckvb, O_CKVB) WSP(u16, Qm, O_QM) WSP(u16, Km, O_KM) WSP(u16, VmT, O_VMT)
  WSP(u16, Qf, O_QF) WSP(u16, Kf, O_KF) WSP(u16, VfT, O_VFT) WSP(float, logf, O_LOGF) WSP(float, Fk, O_FK) WSP(float, krsum, O_KRS) WSP(float, rss, O_RSS)
  WSP(float, y1, O_Y1) WSP(u16, h1b, O_H1B) WSP(int, eidxG, O_PQ) WSP(float, gateG, O_GATE)
#undef WSP
};

__device__ __forceinline__ int TID() { int t = threadIdx.x; asm volatile("" : "+v"(t)); return t; }
__device__ __forceinline__ unsigned pk2(float lo, float hi) {
  unsigned r; asm volatile("v_cvt_pk_bf16_f32 %0, %1, %2" : "=v"(r) : "v"(lo), "v"(hi)); return r;
}
__device__ __forceinline__ u16 f2bf(float f) { return (u16)(pk2(f, 0.f) & 0xffffu); }
__device__ __forceinline__ float bf2f(u16 v) { return __uint_as_float(((unsigned)v) << 16); }
__device__ __forceinline__ float bflo(unsigned v) { return __uint_as_float(v << 16); }
__device__ __forceinline__ float bfhi(unsigned v) { return __uint_as_float(v & 0xffff0000u); }

template <int CTRL> __device__ __forceinline__ int dppi(int v) { return __builtin_amdgcn_update_dpp(0, v, CTRL, 0xF, 0xF, false); }
template <int CTRL> __device__ __forceinline__ float dppf(float v) { return __int_as_float(dppi<CTRL>(__float_as_int(v))); }
__device__ __forceinline__ float rdlane(float v, int l) { return __int_as_float(__builtin_amdgcn_readlane(__float_as_int(v), l)); }

__device__ __forceinline__ float row_sum(float v) {
  v += dppf<0xB1>(v); v += dppf<0x4E>(v); v += dppf<0x141>(v); v += dppf<0x140>(v); return v;
}
__device__ __forceinline__ float row_max(float v) {
  v = fmaxf(v, dppf<0xB1>(v)); v = fmaxf(v, dppf<0x4E>(v)); v = fmaxf(v, dppf<0x141>(v)); v = fmaxf(v, dppf<0x140>(v)); return v;
}
__device__ __forceinline__ float wave_sum(float v) {
  v = row_sum(v);
  return (rdlane(v, 0) + rdlane(v, 16)) + (rdlane(v, 32) + rdlane(v, 48));
}
__device__ __forceinline__ float wave_max(float v) {
  v = row_max(v);
  return fmaxf(fmaxf(rdlane(v, 0), rdlane(v, 16)), fmaxf(rdlane(v, 32), rdlane(v, 48)));
}
__device__ __forceinline__ unsigned wave_umax(unsigned v) {
  unsigned t;
  t = (unsigned)dppi<0xB1>((int)v); v = v > t ? v : t;
  t = (unsigned)dppi<0x4E>((int)v); v = v > t ? v : t;
  t = (unsigned)dppi<0x141>((int)v); v = v > t ? v : t;
  t = (unsigned)dppi<0x140>((int)v); v = v > t ? v : t;
  unsigned a = (unsigned)__builtin_amdgcn_readlane((int)v, 0), b = (unsigned)__builtin_amdgcn_readlane((int)v, 16);
  unsigned c = (unsigned)__builtin_amdgcn_readlane((int)v, 32), d = (unsigned)__builtin_amdgcn_readlane((int)v, 48);
  a = a > b ? a : b; c = c > d ? c : d; return a > c ? a : c;
}
__device__ __forceinline__ unsigned ordkey(float f) {
  unsigned u = __float_as_uint(f);
  return (u & 0x80000000u) ? ~u : (u | 0x80000000u);
}

__device__ __forceinline__ unsigned fp6_code(float v) {
  const float a = fabsf(v);
  int code = a < 2.f ? (int)rintf(a * 8.f) : (a < 4.f ? 16 + (int)rintf((a - 2.f) * 4.f) : 24 + (int)rintf((a - 4.f) * 2.f));
  code = code > 31 ? 31 : code;
  return (unsigned)code | (v < 0.f ? 32u : 0u);
}
__device__ __forceinline__ void quant_chunk(const Params& p, int chunk) {
  const int tid = TID(), lane = tid & 63, wid = tid >> 6;
#pragma unroll 1
  for (int i8 = 0; i8 < 8; ++i8) {
    const int r = chunk * 64 + wid * 8 + i8;
    const int tab = r >> 14, row = r & 16383;
    const float* src = (tab ? p.peer_v : p.peer_u) + (size_t)row * D_ + lane * 4;
    float4 v[8];
    float am = 0.f;
#pragma unroll
    for (int i = 0; i < 8; ++i) {
      { const f32x4 tv = __builtin_nontemporal_load((const f32x4*)(src + i * 256)); v[i] = make_float4(tv[0], tv[1], tv[2], tv[3]); }
      am = fmaxf(am, fmaxf(fmaxf(fabsf(v[i].x), fabsf(v[i].y)), fmaxf(fabsf(v[i].z), fabsf(v[i].w))));
    }
    am = wave_max(am);
    const float qs = am > 0.f ? 7.5f / am : 1.f;
    unsigned w[6];
#pragma unroll
    for (int g = 0; g < 2; ++g) {
      unsigned long long lo = 0ull; unsigned hi = 0u;
#pragma unroll
      for (int i = 0; i < 4; ++i) {
        const float4 f = v[g * 4 + i];
        const unsigned q4 = fp6_code(f.x * qs) | (fp6_code(f.y * qs) << 6) | (fp6_code(f.z * qs) << 12) | (fp6_code(f.w * qs) << 18);
        if (i == 0) lo |= (unsigned long long)q4;
        if (i == 1) lo |= (unsigned long long)q4 << 24;
        if (i == 2) { lo |= (unsigned long long)q4 << 48; hi |= q4 >> 16; }
        if (i == 3) hi |= q4 << 8;
      }
      w[g * 3 + 0] = (unsigned)lo; w[g * 3 + 1] = (unsigned)(lo >> 32); w[g * 3 + 2] = hi;
    }
    unsigned* dst = (unsigned*)(p.Uq() + (size_t)row * 3072 + tab * 1536 + lane * 24);
    *(u32x2*)dst = u32x2{w[0], w[1]}; *(u32x2*)(dst + 2) = u32x2{w[2], w[3]}; *(u32x2*)(dst + 4) = u32x2{w[4], w[5]};
    if (lane == 0) (tab ? p.Vs() : p.Us())[row] = am > 0.f ? am / 7.5f : 1.f;
  }
}

__device__ void transpose_cvt(const float* __restrict__ W, int ldw, int K, int src_col0, int ncols,
                              u16* __restrict__ WT, int dst_row0, const float* __restrict__ kscale,
                              float* tile, int bid, int nb) {
  const int tiles_k = K / 64, tiles_n = ncols / 64, tid = TID();
#pragma unroll 1
  for (int t = bid; t < tiles_k * tiles_n; t += nb) {
    const int tk = t % tiles_k, tn = t / tiles_k, k0 = tk * 64, n0 = tn * 64;
#pragma unroll
    for (int i = 0; i < 2; ++i) {
      const int r = (tid >> 4) + 32 * i, c = (tid & 15) * 4;
      const f32x4 tv = __builtin_nontemporal_load((const f32x4*)(W + (size_t)(k0 + r) * ldw + src_col0 + n0 + c));
      const float4 v = make_float4(tv[0], tv[1], tv[2], tv[3]);
      const float sc = kscale ? kscale[k0 + r] : 1.f;
      tile[r * 65 + c + 0] = v.x * sc; tile[r * 65 + c + 1] = v.y * sc;
      tile[r * 65 + c + 2] = v.z * sc; tile[r * 65 + c + 3] = v.w * sc;
    }
    __syncthreads();
    {
      const int n = tid >> 3, kk = (tid & 7) * 8;
      unsigned w[4];
#pragma unroll
      for (int e = 0; e < 4; ++e) w[e] = pk2(tile[(kk + 2 * e) * 65 + n], tile[(kk + 2 * e + 1) * 65 + n]);
      *(u32x4*)(WT + (size_t)(dst_row0 + n0 + n) * K + k0 + kk) = u32x4{w[0], w[1], w[2], w[3]};
    }
    __syncthreads();
  }
}

__device__ void cvt_bf16(const float* __restrict__ src, u16* __restrict__ dst, size_t n8, size_t gtid, size_t gthreads) {
  for (size_t i = gtid; i < n8; i += gthreads) {
    const float4 a = ((const float4*)src)[2 * i], b = ((const float4*)src)[2 * i + 1];
    ((u32x4*)dst)[i] = u32x4{pk2(a.x, a.y), pk2(a.z, a.w), pk2(b.x, b.y), pk2(b.z, b.w)};
  }
}

__device__ void phase_prep(const Params& p, char* smem, int bid, int nb) {
  const int tid = TID(), lane = tid & 63, wid = tid >> 6;
  float* tile = (float*)smem;
  if (bid == 0 && tid == 0) p.ctr()[0] = 0;
  transpose_cvt(p.w_in, INW, D_, 0, 1024, p.WinT(), 0, nullptr, tile, bid, nb);
  transpose_cvt(p.w_in, INW, D_, 1088, 3072, p.WinT(), 1024, nullptr, tile, bid, nb);
  transpose_cvt(p.w_in, INW, D_, 1024, 64, p.WinT(), 4096, nullptr, tile, bid, nb);
  transpose_cvt(p.w_uq, 1536, 512, 0, 1536, p.WuqT(), 0, p.g_q, tile, bid, nb);
  transpose_cvt(p.w_ukv, 2048, 512, 0, 2048, p.WukvT(), 0, p.g_kv, tile, bid, nb);
  transpose_cvt(p.w_out, 2048, 2048, 0, 2048, p.WoutT(), 0, nullptr, tile, bid, nb);
  transpose_cvt(p.peer_wq, 1024, 2048, 0, 1024, p.WpqT(), 0, nullptr, tile, bid, nb);
  transpose_cvt(p.wgate, 2048, 2048, 0, 2048, p.WgT(), 0, nullptr, tile, bid, nb);
  transpose_cvt(p.wproj, 2048, 256, 0, 2048, p.WpT(), 0, nullptr, tile, bid, nb);
  const size_t gtid = (size_t)bid * NT + tid, gth = (size_t)nb * NT;
  for (size_t i = gtid; i < (size_t)192 * 2048 / 8; i += gth) ((u32x4*)(p.WinT() + (size_t)4160 * 2048))[i] = u32x4{0, 0, 0, 0};
  cvt_bf16(p.p, p.pb(), (size_t)T_ * 256 / 8, gtid, gth);
  for (size_t i = gtid; i < (size_t)T_ * 64 / 4; i += gth) ((float4*)p.krsum())[i] = make_float4(0.f, 0.f, 0.f, 0.f);
  for (size_t i = gtid; i < (size_t)2 * T_ / 4; i += gth) ((float4*)p.rss())[i] = make_float4(0.f, 0.f, 0.f, 0.f);
  for (size_t i = gtid; i < (size_t)2 * 65536; i += gth) {
    const float v = i < 65536 ? p.keys1[i] : p.keys2[i - 65536];
    const u16 h = f2bf(v);
    p.keyH()[i] = h; p.keyL()[i] = f2bf(v - bf2f(h));
  }
  for (size_t i = gtid; i < (size_t)T_ * 32; i += gth) {
    const int t = (int)(i >> 5), fi = (int)(i & 31);
    const float invf = 1.0f / powf(10000.0f, (float)(2 * fi) / 64.0f);
    const float ang = (float)p.positions[t] * invf;
    const double rev = (double)ang * 0.15915494309189535;
    const float fr = (float)(rev - rint(rev));
    p.cs()[i] = make_float2(__builtin_amdgcn_cosf(fr), __builtin_amdgcn_sinf(fr));
  }
  __syncthreads();
  float* wff = (float*)smem;
  for (int i = tid; i < 2048 * 2; i += NT) {
    const int k = i >> 1, hf = i & 1;
    *(float4*)(wff + (k ^ ((k >> 3) & 7)) * 8 + hf * 4) = *(const float4*)(p.w_in + (size_t)k * INW + 4160 + hf * 4);
  }
  __syncthreads();
  for (int t = bid * 8 + wid; t < T_; t += nb * 8) {
    float a[8];
#pragma unroll
    for (int e = 0; e < 8; ++e) a[e] = 0.f;
#pragma unroll 1
    for (int i = 0; i < 4; ++i) {
      const int k = (i * 64 + lane) * 8;
      const f32x4 xa = __builtin_nontemporal_load((const f32x4*)(p.x + (size_t)t * D_ + k)), xb4 = __builtin_nontemporal_load((const f32x4*)(p.x + (size_t)t * D_ + k + 4));
      const float4 x0 = make_float4(xa[0], xa[1], xa[2], xa[3]), x1 = make_float4(xb4[0], xb4[1], xb4[2], xb4[3]);
      *(u32x4*)(p.xb() + (size_t)t * D_ + k) = u32x4{pk2(x0.x, x0.y), pk2(x0.z, x0.w), pk2(x1.x, x1.y), pk2(x1.z, x1.w)};
      const float xs[8] = {x0.x, x0.y, x0.z, x0.w, x1.x, x1.y, x1.z, x1.w};
#pragma unroll
      for (int j = 0; j < 8; ++j) {
        const int kr = (k + j) ^ (lane & 7);
        const float4 w0 = *(const float4*)(wff + kr * 8), w1 = *(const float4*)(wff + kr * 8 + 4);
        a[0] += xs[j] * w0.x; a[1] += xs[j] * w0.y; a[2] += xs[j] * w0.z; a[3] += xs[j] * w0.w;
        a[4] += xs[j] * w1.x; a[5] += xs[j] * w1.y; a[6] += xs[j] * w1.z; a[7] += xs[j] * w1.w;
      }
    }
    float mine = 0.f;
#pragma unroll
    for (int e = 0; e < 8; ++e) { const float s = wave_sum(a[e]); if (lane == e) mine = s; }
    if (lane < 8) {
      const float z = mine + p.b_forget[lane];
      const float ls = fminf(z, 0.f) - log1pf(expf(-fabsf(z)));
      const int b = t >> 12, s = t & 4095;
      p.logf()[((size_t)(b * 8 + lane)) * S_ + s] = ls;
    }
  }
}

template <int WM, int WN>
__device__ __forceinline__ void gemm_core(const u16* __restrict__ A, int lda, const u16* __restrict__ Bt, int ldb,
                                          int K, int brow, int bcol, char* smem, f32x4 (&acc)[4 / WM][4][4]) {
  constexpr int MS = 4 / WM, BN = 64 * WN, NBL = BN / 64;
  static_assert(WM * WN == 8, "8 waves");
  const int tid = TID(), wid = tid >> 6, lane = tid & 63, wr = wid / WN, wc = wid % WN, fr = lane & 15, fq = lane >> 4;
#pragma unroll
  for (int h = 0; h < MS; ++h)
#pragma unroll
    for (int m = 0; m < 4; ++m)
#pragma unroll
      for (int n = 0; n < 4; ++n) acc[h][m][n] = f32x4{0.f, 0.f, 0.f, 0.f};
  const int nk = K / 64;
  const int srow = tid >> 3, sch = (tid & 7) ^ ((tid >> 4) & 7);
  const u16* ga = A + (size_t)(brow + srow) * lda + sch * 8;
  const u16* gb = Bt + (size_t)(bcol + srow) * ldb + sch * 8;
  char* sdst = smem + tid * 16;
  auto issue = [&](int kt, int st) {
    char* sa = sdst + st * 65536;
#pragma unroll
    for (int i = 0; i < 4; ++i)
      __builtin_amdgcn_global_load_lds((const unsigned*)(ga + (size_t)i * 64 * lda + kt * 64), (unsigned*)(sa + i * 8192), 16, 0, 0);
#pragma unroll
    for (int i = 0; i < NBL; ++i)
      __builtin_amdgcn_global_load_lds((const unsigned*)(gb + (size_t)i * 64 * ldb + kt * 64), (unsigned*)(sa + 32768 + i * 8192), 16, 0, 0);
  };
  const int fx = (fr >> 1) & 7;
  const int arow = (wr * (256 / WM) + fr) * 128, brw = 32768 + (wc * 64 + fr) * 128;
  const int c0 = (fq ^ fx) * 16, c1 = ((4 + fq) ^ fx) * 16;
  asm volatile("s_waitcnt vmcnt(0)" ::: "memory");
  __syncthreads();
  issue(0, 0);
#pragma unroll 1
  for (int kt = 0; kt < nk; ++kt) {
    asm volatile("s_waitcnt vmcnt(0)" ::: "memory");
    __builtin_amdgcn_s_barrier();
    asm volatile("" ::: "memory");
    if (kt + 1 < nk) issue(kt + 1, (kt + 1) & 1);
    const char* sb = smem + (kt & 1) * 65536;
#pragma unroll
    for (int ks = 0; ks < 2; ++ks) {
      const int co = ks ? c1 : c0;
      bf16x8 Bl[4];
#pragma unroll
      for (int n = 0; n < 4; ++n) Bl[n] = *reinterpret_cast<const bf16x8*>(sb + brw + co + n * 2048);
#pragma unroll
      for (int h = 0; h < MS; ++h) {
        bf16x8 At[4];
#pragma unroll
        for (int m = 0; m < 4; ++m) At[m] = *reinterpret_cast<const bf16x8*>(sb + arow + co + (h * 4 + m) * 2048);
#pragma unroll
        for (int m = 0; m < 4; ++m)
#pragma unroll
          for (int n = 0; n < 4; ++n) acc[h][m][n] = __builtin_amdgcn_mfma_f32_16x16x32_bf16(At[m], Bl[n], acc[h][m][n], 0, 0, 0);
      }
    }
  }
}

template <int WM, int WN, class Epi>
__device__ __forceinline__ void gemm_tile(const u16* __restrict__ A, int lda, const u16* __restrict__ Bt, int ldb,
                                          int K, int brow, int bcol, char* smem, Epi epi) {
  constexpr int MS = 4 / WM;
  const int tid = TID(), wid = tid >> 6, lane = tid & 63, wr = wid / WN, wc = wid % WN, fr = lane & 15, fq = lane >> 4;
  f32x4 acc[MS][4][4];
  gemm_core<WM, WN>(A, lda, Bt, ldb, K, brow, bcol, smem, acc);
#pragma unroll
  for (int h = 0; h < MS; ++h) epi(acc[h], brow + wr * (256 / WM) + h * 64, bcol + wc * 64, fr, fq);
}

namespace pg8 {
#define PG8_LAS __attribute__((address_space(3)))
typedef unsigned short bf16_t;
constexpr int BM = 256, BK = 64, HALF = 128, HTB = HALF * BK * 2  , STAGE_BYTES = 8 * HTB, NXCD = 8, WGM = 8;

__host__ __device__ __forceinline__ int lds_byte(int r, int c) { const int st = (r >> 4) * 2 + (c >> 5), rr = r & 15, cc = c & 31, ob = rr * 64 + cc * 2; return st * 1024 + (ob ^ (((ob >> 9) & 1) << 5)); }
__host__ __device__ __forceinline__ void stage_rc(int b, int& R, int& C) { const int st = b / 1024, sb = b % 1024, swz = sb ^ (((sb >> 9) & 1) << 5); R = (st >> 1) * 16 + swz / 64; C = (st & 1) * 32 + (swz % 64) / 2; }
__host__ __device__ __forceinline__ int perm32(int rho) { const int n = rho >> 4, i = rho & 15; return 8 * (i >> 2) + 4 * n + (i & 3); }
struct Unit { int pm, pn; };
struct Gemm { const bf16_t* A; const bf16_t* Bt; int M, N, K; };
struct StaticOrder {
    int nM, nN, nwg, G, c;
    __device__ void init(int M, int N, int G_, int c_) { nM = M / BM; nN = N / BM; nwg = nM * nN; G = G_; c = c_; }
    __device__ bool next(int i, Unit& u) const {
        const long L = (long)i * G + c; if (L >= nwg) return false;
        int wgid = (int)L; { const int q = nwg / NXCD, r = nwg % NXCD, xcd = wgid % NXCD, off = wgid / NXCD; wgid = (xcd < r ? xcd * (q + 1) : r * (q + 1) + (xcd - r) * q) + off; }
        const int nig = WGM * nN, gid = wgid / nig, fm = gid * WGM, gsz = (nM - fm) < WGM ? (nM - fm) : WGM;
        u.pm = fm + ((wgid % nig) % gsz); u.pn = (wgid % nig) / gsz; return true;
    }
    __device__ __forceinline__ void a_ready(const Unit&) const {}
    __device__ __forceinline__ void done(const Unit&) const {}
};
template <class Epi, class Sched, bool STAMP = false>
__device__ __forceinline__ void gemm_phase(PG8_LAS unsigned char* lds, const Gemm g, const Sched& S, const Epi& E, unsigned long long* stamps) {
    const int tid = TID(), wid = __builtin_amdgcn_readfirstlane(tid >> 6), lane = tid & 63, wr = wid >> 2, wc = wid & 3, fr = lane & 15, fq = lane >> 4;
    const int K = g.K, nt = K / BK;
    int ts_lo = 0, ts_hi = 0, nts = 0; const unsigned long long rt_entry = STAMP ? (unsigned long long)wall_clock64() : 0ull;
#define PG8_STAMP() do { if (STAMP && wid == 0 && nts < 64) { const unsigned long long _c = (unsigned long long)clock64(); \
        ts_lo = (lane == nts) ? (int)(unsigned)_c : ts_lo; ts_hi = (lane == nts) ? (int)(unsigned)(_c >> 32) : ts_hi; ++nts; } } while (0)
    PG8_STAMP();
    unsigned voffA[2], voffB[2];
#pragma unroll
    for (int i = 0; i < 2; ++i) { int R, C; stage_rc(tid * 16 + i * 8192, R, C); const int Rb = Epi::PERM ? ((R & ~31) + perm32(R & 31)) : R;
        voffA[i] = (unsigned)(R * K + C) * 2u; voffB[i] = (unsigned)(Rb * K + C) * 2u; }
    const size_t kstep = (size_t)(BK * 2);
    const size_t hstep = (size_t)HALF * K * 2;
    const size_t tstep = 2 * hstep;
    const unsigned ldsw = (unsigned)wid * 1024u;
    const int aoff = lds_byte(wr * 64 + fr, fq * 8), boff = lds_byte(wc * 32 + fr, fq * 8);
#define PG8_SA(b, h) (((b) * 2 + (h)) * HTB)
#define PG8_SB(b, h) ((4 + (b) * 2 + (h)) * HTB)
#define PG8_STAGE(bufoff, gbase, voff) do { _Pragma("unroll") for (int _i = 0; _i < 2; ++_i) \
        __builtin_amdgcn_global_load_lds((const unsigned*)((const char*)(gbase) + (voff)[_i]), (PG8_LAS unsigned*)(lds + (bufoff) + ldsw + _i * 8192), 16, 0, 0); } while (0)
#define PG8_LDA(dst, b, h) do { _Pragma("unroll") for (int m = 0; m < 4; ++m) _Pragma("unroll") for (int k = 0; k < 2; ++k) dst[m][k] = *(const PG8_LAS bf16x8*)(lds + PG8_SA(b, h) + aoff + m * 2048 + k * 1024); } while (0)
#define PG8_LDB(dst, b, h) do { _Pragma("unroll") for (int n = 0; n < 2; ++n) _Pragma("unroll") for (int k = 0; k < 2; ++k) dst[n][k] = *(const PG8_LAS bf16x8*)(lds + PG8_SB(b, h) + boff + n * 2048 + k * 1024); } while (0)
#define PG8_MMA(ai, bj, At, Bt) do { __builtin_amdgcn_s_setprio(1); _Pragma("unroll") for (int m = 0; m < 4; ++m) _Pragma("unroll") for (int n = 0; n < 2; ++n) _Pragma("unroll") for (int k = 0; k < 2; ++k) \
        acc[ai][bj][m][n] = __builtin_amdgcn_mfma_f32_16x16x32_bf16(Bt[n][k], At[m][k], acc[ai][bj][m][n], 0, 0, 0); __builtin_amdgcn_s_setprio(0); } while (0)
#define PG8_WAIT_V(n) asm volatile("s_waitcnt vmcnt(" #n ")" ::: "memory")
#define PG8_WAIT_L(n) asm volatile("s_waitcnt lgkmcnt(" #n ")" ::: "memory")
#define PG8_BAR __builtin_amdgcn_s_barrier()
#define PG8_SCHED __builtin_amdgcn_sched_barrier(0)
    Unit cur, nxt; int ui = 0;
    if (!S.next(0, cur)) return;
    f32x4 acc[2][2][4][2];
#pragma unroll
    for (int a = 0; a < 2; ++a)
#pragma unroll
        for (int b = 0; b < 2; ++b)
#pragma unroll
            for (int m = 0; m < 4; ++m)
#pragma unroll
                for (int n = 0; n < 2; ++n) acc[a][b][m][n] = (f32x4){0.f, 0.f, 0.f, 0.f};
    bf16x8 At[4][2], B0[2][2], B1[2][2];
    const char* cA = (const char*)g.A + (size_t)cur.pm * tstep; const char* cB = (const char*)g.Bt + (size_t)cur.pn * tstep;
    S.a_ready(cur);
    PG8_STAGE(PG8_SB(0, 0), cB, voffB); PG8_STAGE(PG8_SA(0, 0), cA, voffA); PG8_STAGE(PG8_SB(0, 1), cB + hstep, voffB); PG8_STAGE(PG8_SA(0, 1), cA + hstep, voffA);
    if (wr == 1) PG8_BAR;
    PG8_WAIT_V(4); PG8_BAR;
    PG8_STAGE(PG8_SB(1, 0), cB + kstep, voffB); PG8_STAGE(PG8_SA(1, 0), cA + kstep, voffA); PG8_STAGE(PG8_SB(1, 1), cB + hstep + kstep, voffB);
    PG8_WAIT_V(6); PG8_BAR;
    PG8_STAMP();
    for (;;) {
        const bool has_next = S.next(ui + 1, nxt);
        const char* nA = has_next ? (const char*)g.A + (size_t)nxt.pm * tstep : cA; const char* nB = has_next ? (const char*)g.Bt + (size_t)nxt.pn * tstep : cB;
        for (int t = 0; t < nt; t += 2) {
            const bool last = (t == nt - 2);
            const char* a1 = cA + (size_t)(t + 1) * kstep;
            const char* a2 = last ? nA : cA + (size_t)(t + 2) * kstep; const char* b2 = last ? nB : cB + (size_t)(t + 2) * kstep;
            const char* a3 = a2 + kstep; const char* b3 = b2 + kstep;
            if (last && has_next) S.a_ready(nxt);
            PG8_LDB(B0, 0, 0); PG8_SCHED; PG8_LDA(At, 0, 0); PG8_STAGE(PG8_SA(1, 1), a1 + hstep, voffA);
            PG8_WAIT_L(8); PG8_BAR; PG8_WAIT_L(0); PG8_MMA(0, 0, At, B0); PG8_BAR; PG8_SCHED;
            PG8_LDB(B1, 0, 1); PG8_STAGE(PG8_SB(0, 0), b2, voffB);
            PG8_BAR; PG8_WAIT_L(0); PG8_MMA(0, 1, At, B1); PG8_BAR;
            PG8_LDA(At, 0, 1); PG8_STAGE(PG8_SA(0, 0), a2, voffA);
            PG8_BAR; PG8_WAIT_L(0); PG8_MMA(1, 0, At, B0); PG8_BAR; PG8_SCHED;
            PG8_STAGE(PG8_SB(0, 1), b2 + hstep, voffB);
            PG8_WAIT_V(6); PG8_BAR; PG8_MMA(1, 1, At, B1); PG8_BAR;
            PG8_LDB(B0, 1, 0); PG8_SCHED; PG8_LDA(At, 1, 0); PG8_STAGE(PG8_SA(0, 1), a2 + hstep, voffA);
            PG8_WAIT_L(8); PG8_BAR; PG8_WAIT_L(0); PG8_MMA(0, 0, At, B0); PG8_BAR; PG8_SCHED;
            PG8_LDB(B1, 1, 1); PG8_STAGE(PG8_SB(1, 0), b3, voffB);
            PG8_BAR; PG8_WAIT_L(0); PG8_MMA(0, 1, At, B1); PG8_BAR;
            PG8_LDA(At, 1, 1); PG8_STAGE(PG8_SA(1, 0), a3, voffA);
            PG8_BAR; PG8_WAIT_L(0); PG8_MMA(1, 0, At, B0); PG8_BAR; PG8_SCHED;
            PG8_STAGE(PG8_SB(1, 1), b3 + hstep, voffB);
            PG8_WAIT_V(6); PG8_BAR; PG8_MMA(1, 1, At, B1); PG8_BAR;
        }
        PG8_STAMP();
        if constexpr (!Epi::AFTER_DRAIN) { E(acc, cur, wr, wc, fr, fq); S.done(cur); }
        PG8_STAMP();
        if (!has_next) break;
#pragma unroll
        for (int a = 0; a < 2; ++a)
#pragma unroll
            for (int b = 0; b < 2; ++b)
#pragma unroll
                for (int m = 0; m < 4; ++m)
#pragma unroll
                    for (int n = 0; n < 2; ++n) acc[a][b][m][n] = (f32x4){0.f, 0.f, 0.f, 0.f};
        cur = nxt; cA = nA; cB = nB; ++ui;
    }
    PG8_WAIT_V(0);
    if (wr == 0) PG8_BAR;
    PG8_BAR;
    if constexpr (Epi::AFTER_DRAIN) { E.fused(acc, cur, wr, wc, fr, fq, lds, wid, lane); S.done(cur); }
    PG8_STAMP();
    if (STAMP && wid == 0) { stamps[lane] = lane < nts ? (((unsigned long long)(unsigned)ts_hi << 32) | (unsigned)ts_lo) : 0ull;
        if (lane == 62) stamps[62] = rt_entry; if (lane == 63) stamps[63] = (unsigned long long)wall_clock64(); }
#undef PG8_STAMP
#undef PG8_SA
#undef PG8_SB
#undef PG8_STAGE
#undef PG8_LDA
#undef PG8_LDB
#undef PG8_MMA
#undef PG8_WAIT_V
#undef PG8_WAIT_L
#undef PG8_BAR
#undef PG8_SCHED
}
}


__device__ __forceinline__ u32x4 pack8(const f32x4& a, const f32x4& b) { return u32x4{pk2(a[0], a[1]), pk2(a[2], a[3]), pk2(b[0], b[1]), pk2(b[2], b[3])}; }
__device__ __forceinline__ float sumsq4(const f32x4& a) { return (a[0] * a[0] + a[1] * a[1]) + (a[2] * a[2] + a[3] * a[3]); }
__device__ __forceinline__ void store_tr8(u16* vt, const f32x4& a, const f32x4& b) {
  vt[0] = f2bf(a[0]); vt[(size_t)S_] = f2bf(a[1]); vt[(size_t)2 * S_] = f2bf(a[2]); vt[(size_t)3 * S_] = f2bf(a[3]);
  vt[(size_t)4 * S_] = f2bf(b[0]); vt[(size_t)5 * S_] = f2bf(b[1]); vt[(size_t)6 * S_] = f2bf(b[2]); vt[(size_t)7 * S_] = f2bf(b[3]);
}
struct EpiInproj {
  static constexpr bool PERM = true, AFTER_DRAIN = false;
  u16 *cqb, *ckvb, *Qf, *Kf, *VfT; float* rss;
  __device__ __forceinline__ void operator()(const f32x4 (&acc)[2][2][4][2], const pg8::Unit& u, int wr, int wc, int fr, int fq) const {
    const int ct = u.pn * 256;
#pragma unroll
    for (int ai = 0; ai < 2; ++ai)
#pragma unroll
      for (int m = 0; m < 4; ++m) {
        const int row = u.pm * 256 + ai * 128 + wr * 64 + m * 16 + fr, b = row >> 12, s = row & 4095;
        float ss = 0.f;
#pragma unroll
        for (int bj = 0; bj < 2; ++bj) {
          const int c0 = ct + bj * 128 + wc * 32 + 8 * fq;
          const f32x4 v0 = acc[ai][bj][m][0], v1 = acc[ai][bj][m][1];
          if (ct < 1024) {
            u16* dst = ct < 512 ? cqb : ckvb;
            *(u32x4*)(dst + (size_t)row * 512 + (c0 & 511)) = pack8(v0, v1);
            ss += sumsq4(v0) + sumsq4(v1);
          } else if (ct < 3072) {
            int c = c0 - 1024; u16* dst = c < 1024 ? Qf : Kf; c &= 1023;
            *(u32x4*)(dst + ((size_t)(b * 8 + (c >> 7)) * S_ + s) * 128 + (c & 127)) = pack8(v0, v1);
          } else {
            const int c = c0 - 3072;
            store_tr8(VfT + ((size_t)(b * 8 + (c >> 7)) * 128 + (c & 127)) * S_ + s, v0, v1);
          }
        }
        if (ct < 1024) atomicAdd(rss + (ct < 512 ? 0 : T_) + row, ss);
        __builtin_amdgcn_sched_barrier(0);
      }
  }
};
struct EpiQup {
  static constexpr bool PERM = true, AFTER_DRAIN = false;
  u16* Qm; const float* rss;
  __device__ __forceinline__ void operator()(const f32x4 (&acc)[2][2][4][2], const pg8::Unit& u, int wr, int wc, int fr, int fq) const {
#pragma unroll
    for (int ai = 0; ai < 2; ++ai)
#pragma unroll
      for (int m = 0; m < 4; ++m) {
        const int row = u.pm * 256 + ai * 128 + wr * 64 + m * 16 + fr, b = row >> 12, s = row & 4095;
        const float rs = rsqrtf(rss[row] * (1.f / 512.f) + EPS);
#pragma unroll
        for (int bj = 0; bj < 2; ++bj) {
          const int c0 = u.pn * 256 + bj * 128 + wc * 32 + 8 * fq, hh = c0 / 192, off = c0 % 192;
          *(u32x4*)(Qm + ((size_t)(b * 8 + hh) * S_ + s) * 192 + off) = pack8(acc[ai][bj][m][0] * rs, acc[ai][bj][m][1] * rs);
        }
        __builtin_amdgcn_sched_barrier(0);
      }
  }
};
struct EpiKVup {
  static constexpr bool PERM = true, AFTER_DRAIN = false;
  u16 *Km, *VmT; const float* rss;
  __device__ __forceinline__ void operator()(const f32x4 (&acc)[2][2][4][2], const pg8::Unit& u, int wr, int wc, int fr, int fq) const {
    const int hh = u.pn;
#pragma unroll
    for (int ai = 0; ai < 2; ++ai)
#pragma unroll
      for (int m = 0; m < 4; ++m) {
        const int row = u.pm * 256 + ai * 128 + wr * 64 + m * 16 + fr, b = row >> 12, s = row & 4095;
        const float rs = rsqrtf(rss[T_ + row] * (1.f / 512.f) + EPS);
        const int off = wc * 32 + 8 * fq;
        *(u32x4*)(Km + ((size_t)(b * 8 + hh) * S_ + s) * 192 + off) = pack8(acc[ai][0][m][0] * rs, acc[ai][0][m][1] * rs);
        store_tr8(VmT + ((size_t)(b * 8 + hh) * 128 + off) * S_ + s, acc[ai][1][m][0] * rs, acc[ai][1][m][1] * rs);
        __builtin_amdgcn_sched_barrier(0);
      }
  }
};
struct EpiProj {
  static constexpr bool PERM = true, AFTER_DRAIN = false;
  u16* projb;
  __device__ __forceinline__ void operator()(const f32x4 (&acc)[2][2][4][2], const pg8::Unit& u, int wr, int wc, int fr, int fq) const {
#pragma unroll
    for (int ai = 0; ai < 2; ++ai)
#pragma unroll
      for (int m = 0; m < 4; ++m) {
        const int row = u.pm * 256 + ai * 128 + wr * 64 + m * 16 + fr;
#pragma unroll
        for (int bj = 0; bj < 2; ++bj)
          *(u32x4*)(projb + (size_t)row * D_ + u.pn * 256 + bj * 128 + wc * 32 + 8 * fq) = pack8(acc[ai][bj][m][0], acc[ai][bj][m][1]);
      }
  }
};
struct EpiOut {
  static constexpr bool PERM = false, AFTER_DRAIN = false;
  const float* x; float* y1;
  __device__ __forceinline__ void operator()(const f32x4 (&acc)[2][2][4][2], const pg8::Unit& u, int wr, int wc, int fr, int fq) const {
#pragma unroll
    for (int ai = 0; ai < 2; ++ai)
#pragma unroll
      for (int m = 0; m < 4; ++m) {
        const size_t rb = (size_t)(u.pm * 256 + ai * 128 + wr * 64 + m * 16 + fr) * D_ + u.pn * 256 + wc * 32 + 4 * fq;
#pragma unroll
        for (int bj = 0; bj < 2; ++bj)
#pragma unroll
          for (int n = 0; n < 2; ++n) {
            const size_t o = rb + bj * 128 + n * 16;
            const f32x4 xv = *(const f32x4*)(x + o);
            *(f32x4*)(y1 + o) = xv * ALPHA + acc[ai][bj][m][n];
          }
      }
  }
};
struct EpiGate {
  static constexpr bool PERM = false, AFTER_DRAIN = false;
  const float* h1; const u16* projb; float* out;
  __device__ __forceinline__ void operator()(const f32x4 (&acc)[2][2][4][2], const pg8::Unit& u, int wr, int wc, int fr, int fq) const {
#pragma unroll
    for (int ai = 0; ai < 2; ++ai)
#pragma unroll
      for (int m = 0; m < 4; ++m) {
        const size_t rb = (size_t)(u.pm * 256 + ai * 128 + wr * 64 + m * 16 + fr) * D_ + u.pn * 256 + wc * 32 + 4 * fq;
#pragma unroll
        for (int bj = 0; bj < 2; ++bj)
#pragma unroll
          for (int n = 0; n < 2; ++n) {
            const size_t o = rb + bj * 128 + n * 16;
            const f32x4 hv = *(const f32x4*)(h1 + o);
            const u32x2 pj = *(const u32x2*)(projb + o);
            const f32x4 a = acc[ai][bj][m][n];
            f32x4 r;
            r[0] = ALPHA * hv[0] + bflo(pj[0]) / (1.f + __expf(-a[0])); r[1] = ALPHA * hv[1] + bfhi(pj[0]) / (1.f + __expf(-a[1]));
            r[2] = ALPHA * hv[2] + bflo(pj[1]) / (1.f + __expf(-a[2])); r[3] = ALPHA * hv[3] + bfhi(pj[1]) / (1.f + __expf(-a[3]));
            *(f32x4*)(out + o) = r;
          }
      }
  }
};

__device__ __forceinline__ int vblock(int bid, int nb) { return (nb & 7) ? bid : (bid & 7) * (nb >> 3) + (bid >> 3); }
__device__ __forceinline__ void tile_rc(int t, int Nt, int& tm, int& tn) {
  const int g = t / (8 * Nt), q = t % (8 * Nt);
  tn = q >> 3; tm = g * 8 + (q & 7);
}

__device__ void phase_inproj(const Params& p, char* smem, int bid, int nb) {
  {
    EpiInproj E{p.cqb(), p.ckvb(), p.Qf(), p.Kf(), p.VfT(), p.rss()};
    pg8::Gemm g{p.xb(), p.WinT(), T_, 4096, D_};
    pg8::StaticOrder S; S.init(T_, 4096, nb, bid);
    pg8::gemm_phase((PG8_LAS unsigned char*)smem, g, S, E, nullptr);
  }
  for (int t = vblock(bid, nb); t < 256; t += nb) {
    const int tm = t >> 3, ks = t & 7;
    f32x4 acc[2][4][4];
    gemm_core<2, 4>(p.xb() + ks * 256, D_, p.WinT() + ks * 256, D_, 256, tm * 256, 4096, smem, acc);
    const int tid = TID(), wid = tid >> 6, lane = tid & 63, wr = wid >> 2, wc = wid & 3, fr = lane & 15, fq = lane >> 4;
    if (wc == 0) {
#pragma unroll
      for (int h = 0; h < 2; ++h) {
        float* kd = p.krsum() + (size_t)(tm * 256 + wr * 128 + h * 64 + fq * 4) * 64 + fr;
#pragma unroll
        for (int m = 0; m < 4; ++m)
#pragma unroll
          for (int n = 0; n < 4; ++n)
#pragma unroll
            for (int j = 0; j < 4; ++j) atomicAdd(kd + (m * 16 + j) * 64 + n * 16, acc[h][m][n][j]);
      }
    }
  }
}

__device__ void phase_up(const Params& p, char* smem, int bid, int nb) {
  PG8_LAS unsigned char* lds = (PG8_LAS unsigned char*)smem;
  {
    EpiQup E{p.Qm(), p.rss()};
    pg8::Gemm g{p.cqb(), p.WuqT(), T_, 1536, 512};
    pg8::StaticOrder S; S.init(T_, 1536, nb, (bid + nb - 64) % nb);
    pg8::gemm_phase(lds, g, S, E, nullptr);
  }
  {
    EpiKVup E{p.Km(), p.VmT(), p.rss()};
    pg8::Gemm g{p.ckvb(), p.WukvT(), T_, 2048, 512};
    pg8::StaticOrder S; S.init(T_, 2048, nb, bid);
    pg8::gemm_phase(lds, g, S, E, nullptr);
  }
  {
    EpiProj E{p.projb()};
    pg8::Gemm g{p.pb(), p.WpT(), T_, 2048, 256};
    pg8::StaticOrder S; S.init(T_, 2048, nb, bid);
    pg8::gemm_phase(lds, g, S, E, nullptr);
  }
  for (int t = bid; t < 48; t += nb) {
    if (t >= 16) {
      const int r0 = (t - 16) * 256, tid = TID();
#pragma unroll 1
      for (int it = 0; it < 16; ++it) {
        const int pr = it * NT + tid, row = r0 + (pr >> 5), i = pr & 31, b = row >> 12, s = row & 4095;
        const float x1 = p.krsum()[(size_t)row * 64 + i], x2 = p.krsum()[(size_t)row * 64 + 32 + i];
        const float2 cs = p.cs()[(size_t)row * 32 + i];
        const u16 o1 = f2bf(x1 * cs.x - x2 * cs.y), o2 = f2bf(x1 * cs.y + x2 * cs.x);
#pragma unroll
        for (int hh = 0; hh < 8; ++hh) {
          u16* kd = p.Km() + ((size_t)(b * 8 + hh) * S_ + s) * 192 + 128;
          kd[i] = o1; kd[32 + i] = o2;
        }
      }
    } else {
      const int seq = t;
      if ((TID() >> 6) == 0) {
        const int lane = TID() & 63;
        const float* src = p.logf() + (size_t)seq * S_ + lane * 64;
        float* dst = p.Fk() + (size_t)seq * S_ + lane * 64;
        float sum = 0.f;
#pragma unroll
        for (int i = 0; i < 16; ++i) { const float4 v = *(const float4*)(src + i * 4); sum += v.x; sum += v.y; sum += v.z; sum += v.w; }
        float inc = sum;
#pragma unroll
        for (int d = 1; d < 64; d <<= 1) { const float o = __shfl_up(inc, d, 64); if (lane >= d) inc += o; }
        float run = inc - sum;
#pragma unroll
        for (int i = 0; i < 16; ++i) {
          const float4 v = *(const float4*)(src + i * 4); float4 o;
          run += v.x; o.x = run; run += v.y; o.y = run; run += v.z; o.z = run; run += v.w; o.w = run;
          *(float4*)(dst + i * 4) = o;
        }
      }
    }
  }
}

#ifdef ATTN_NAIVE
__device__ void phase_attn_naive(const Params& p, char* smem, int bid, int nb) {
  const int tid = TID(), lane = tid & 63, wid = tid >> 6;
  const int per = NB_ * 8 * S_, nrows = 2 * per;
  for (int r = bid * 4 + wid; r < nrows; r += nb * 4) {
    const int type = r / per, rr = r % per, bh = rr / S_, s = rr % S_;
    const int DQ = type ? 128 : 192;
    const u16* Q = type ? p.Qf() + ((size_t)bh * S_ + s) * 128 : p.Qm() + ((size_t)bh * S_ + s) * 192;
    const u16* Kb = type ? p.Kf() + (size_t)bh * S_ * 128 : p.Km() + (size_t)bh * S_ * 192;
    const u16* VT = (type ? p.VfT() : p.VmT()) + (size_t)bh * 128 * S_;
    const float* F = p.Fk() + (size_t)bh * S_;
    const float scale = type ? 0.08838834764831845f : 0.07216878364870322f;
    float m = -1e30f, l = 0.f;
    float acc[128];
#pragma unroll
    for (int d = 0; d < 128; ++d) acc[d] = 0.f;
    const float fqv = type ? F[s] : 0.f;
    for (int k0 = 0; k0 <= s; k0 += 64) {
      const int key = k0 + lane; const bool valid = key <= s; const int keyc = valid ? key : s;
      const u16* kr = Kb + (size_t)keyc * DQ;
      float sc = 0.f;
      for (int d = 0; d < DQ; d += 8) {
        const u32x4 kv = *(const u32x4*)(kr + d), qv = *(const u32x4*)(Q + d);
#pragma unroll
        for (int w = 0; w < 4; ++w) sc += bflo(kv[w]) * bflo(qv[w]) + bfhi(kv[w]) * bfhi(qv[w]);
      }
      sc *= scale;
      if (type) sc += fqv - F[keyc];
      if (!valid) sc = -1e30f;
      const float mx = wave_max(sc), mn = fmaxf(m, mx), alpha = __expf(m - mn);
      const float pr = valid ? __expf(sc - mn) : 0.f;
      m = mn; l = l * alpha + pr;
#pragma unroll
      for (int d = 0; d < 128; ++d) acc[d] = acc[d] * alpha + pr * bf2f(VT[(size_t)d * S_ + keyc]);
    }
    const float inv = 1.f / wave_sum(l);
    float o0 = 0.f, o1 = 0.f;
#pragma unroll
    for (int d = 0; d < 128; ++d) {
      const float o = wave_sum(acc[d]) * inv;
      if (lane == (d & 63)) { if (d < 64) o0 = o; else o1 = o; }
    }
    const int b = bh >> 3, hh = bh & 7;
    u16* od = p.omix() + ((size_t)(b * S_ + s)) * 2048 + type * 1024 + hh * 128;
    od[lane] = f2bf(o0); od[64 + lane] = f2bf(o1);
  }
}

#endif
typedef float f32x16 __attribute__((ext_vector_type(16)));
template <int TYPE>
__device__ __forceinline__ void attn_item(const Params& p, char* smem, int bh, int qb) {
  constexpr int DQK = TYPE ? 128 : 192, NKS = DQK / 16, KSTR = DQK * 2 + 16, VSTR = 128;
  constexpr int KCH = DQK / 8, NKL = 64 * KCH / NT;
  constexpr float C2 = (TYPE ? 0.08838834764831845f : 0.07216878364870322f) * 1.4426950408889634f;
  char* sK = smem; char* sV = smem + 51200; float* sF = (float*)(smem + 51200 + 32768);
  const int tid = TID(), lane = tid & 63, wid = tid >> 6, c = lane & 31, hi = lane >> 5;
  const u16* Qb = (TYPE ? p.Qf() : p.Qm()) + (size_t)bh * S_ * DQK;
  const u16* Kb = (TYPE ? p.Kf() : p.Km()) + (size_t)bh * S_ * DQK;
  const u16* Vb = (TYPE ? p.VfT() : p.VmT()) + (size_t)bh * 128 * S_;
  const float* Fb = p.Fk() + (size_t)bh * S_;
  const int qrow = qb * 256 + wid * 32;
  bf16x8 qf[NKS];
#pragma unroll
  for (int ks = 0; ks < NKS; ++ks) qf[ks] = *(const bf16x8*)(Qb + (size_t)(qrow + c) * DQK + ks * 16 + hi * 8);
  if (TYPE == 0) {
    const float2* csr = p.cs() + (size_t)((bh >> 3) * S_ + qrow + c) * 32;
#pragma unroll
    for (int kk = 0; kk < 2; ++kk) {
      u32x4 x1 = *reinterpret_cast<u32x4*>(&qf[(NKS - 4) + kk]), x2 = *reinterpret_cast<u32x4*>(&qf[(NKS - 2) + kk]);
#pragma unroll
      for (int w = 0; w < 4; ++w) {
        const float4 cs = *(const float4*)(csr + 16 * kk + 8 * hi + 2 * w);
        const float a0 = bflo(x1[w]), a1 = bfhi(x1[w]), b0 = bflo(x2[w]), b1 = bfhi(x2[w]);
        x1[w] = pk2(a0 * cs.x - b0 * cs.y, a1 * cs.z - b1 * cs.w);
        x2[w] = pk2(a0 * cs.y + b0 * cs.x, a1 * cs.w + b1 * cs.z);
      }
      qf[(NKS - 4) + kk] = *reinterpret_cast<bf16x8*>(&x1); qf[(NKS - 2) + kk] = *reinterpret_cast<bf16x8*>(&x2);
    }
  }
  f32x16 o[4];
#pragma unroll
  for (int db = 0; db < 4; ++db)
#pragma unroll
    for (int r = 0; r < 16; ++r) o[db][r] = 0.f;
  float m = -1e30f, l = 0.f;
  const int ntiles = 4 * qb + 4;
  u32x4 kreg[NKL];
  float4 freg = make_float4(0.f, 0.f, 0.f, 0.f);
  const unsigned koff = (unsigned)tid * 16u;
  auto load_k = [&](int kt) {
    const char* kb = (const char*)(Kb + (size_t)kt * 64 * DQK);
#pragma unroll
    for (int i = 0; i < NKL; ++i) kreg[i] = *(const u32x4*)(kb + i * 8192 + koff);
    if (TYPE) { if (tid < 16) freg = *(const float4*)(Fb + kt * 64 + tid * 4); }
  };
  const unsigned voff = (unsigned)((((tid >> 3) * S_) + (((tid & 7) ^ ((tid >> 4) & 7)) * 8)) * 2);
  auto load_v = [&](int kt) {
    const char* vb = (const char*)(Vb + kt * 64);
    char* dst = sV + (kt & 1) * 16384 + tid * 16;
#pragma unroll
    for (int i = 0; i < 2; ++i)
      __builtin_amdgcn_global_load_lds((const unsigned*)(vb + (size_t)i * 64 * S_ * 2 + voff), (unsigned*)(dst + i * 8192), 16, 0, 0);
  };
  auto store_tile = [&](int kt) {
    char* sKw = sK + (kt & 1) * 25600;
#pragma unroll
    for (int i = 0; i < NKL; ++i) { const int ch = tid + NT * i, key = ch / KCH, dc = ch % KCH; *(u32x4*)(sKw + key * KSTR + dc * 16) = kreg[i]; }
    if (TYPE) { if (tid < 16) { const float L2E = 1.4426950408889634f; *(float4*)(sF + (kt & 1) * 64 + tid * 4) = make_float4(freg.x * L2E, freg.y * L2E, freg.z * L2E, freg.w * L2E); } }
  };
  const int krow = (c & 19) | ((c & 4) << 1) | ((c & 8) >> 1);
  const char* ka0 = sK + krow * KSTR + hi * 16;
  const char* ka1 = ka0 + 32 * KSTR;
  const int vx = (c >> 1) & 7;
  int vo[2][2];
#pragma unroll
  for (int kb = 0; kb < 2; ++kb)
#pragma unroll
    for (int s2 = 0; s2 < 2; ++s2) vo[kb][s2] = c * VSTR + (((4 * kb + 2 * s2 + hi) ^ vx) * 16);
  load_k(0); load_v(0);
  store_tile(0);
#pragma unroll 1
  for (int kt = 0; kt < ntiles; ++kt) {
    asm volatile("s_waitcnt vmcnt(0) lgkmcnt(0)" ::: "memory");
    __syncthreads();
    if (kt + 1 < ntiles) { load_k(kt + 1); load_v(kt + 1); }
    const int k0 = kt * 64;
    const char* sVc = sV + (kt & 1) * 16384;
    const int kbo = (kt & 1) * 25600;
    const float* sFc = sF + (kt & 1) * 64;
    if (k0 <= qrow + 31) {
      f32x16 p0, p1;
#pragma unroll
      for (int r = 0; r < 16; ++r) { p0[r] = 0.f; p1[r] = 0.f; }
#pragma unroll
      for (int ks = 0; ks < NKS; ++ks) {
        const bf16x8 a0 = *(const bf16x8*)(ka0 + kbo + ks * 32), a1 = *(const bf16x8*)(ka1 + kbo + ks * 32);
        p0 = __builtin_amdgcn_mfma_f32_32x32x16_bf16(a0, qf[ks], p0, 0, 0, 0);
        p1 = __builtin_amdgcn_mfma_f32_32x32x16_bf16(a1, qf[ks], p1, 0, 0, 0);
      }
      if (TYPE) {
#pragma unroll
        for (int s = 0; s < 2; ++s) {
          const float4 f0 = *(const float4*)(sFc + 16 * s + 8 * hi), f1 = *(const float4*)(sFc + 16 * s + 8 * hi + 4);
          const float4 g0 = *(const float4*)(sFc + 32 + 16 * s + 8 * hi), g1 = *(const float4*)(sFc + 32 + 16 * s + 8 * hi + 4);
          p0[8 * s + 0] = p0[8 * s + 0] * C2 - f0.x; p0[8 * s + 1] = p0[8 * s + 1] * C2 - f0.y; p0[8 * s + 2] = p0[8 * s + 2] * C2 - f0.z; p0[8 * s + 3] = p0[8 * s + 3] * C2 - f0.w;
          p0[8 * s + 4] = p0[8 * s + 4] * C2 - f1.x; p0[8 * s + 5] = p0[8 * s + 5] * C2 - f1.y; p0[8 * s + 6] = p0[8 * s + 6] * C2 - f1.z; p0[8 * s + 7] = p0[8 * s + 7] * C2 - f1.w;
          p1[8 * s + 0] = p1[8 * s + 0] * C2 - g0.x; p1[8 * s + 1] = p1[8 * s + 1] * C2 - g0.y; p1[8 * s + 2] = p1[8 * s + 2] * C2 - g0.z; p1[8 * s + 3] = p1[8 * s + 3] * C2 - g0.w;
          p1[8 * s + 4] = p1[8 * s + 4] * C2 - g1.x; p1[8 * s + 5] = p1[8 * s + 5] * C2 - g1.y; p1[8 * s + 6] = p1[8 * s + 6] * C2 - g1.z; p1[8 * s + 7] = p1[8 * s + 7] * C2 - g1.w;
        }
      }
      if (k0 + 63 > qrow) {
        const int lim = qrow + c - k0 - 8 * hi;
        const float NEG = -__builtin_inff();
#pragma unroll
        for (int r = 0; r < 16; ++r) {
          const int kb = 16 * (r >> 3) + (r & 7);
          if (kb > lim) p0[r] = NEG;
          if (kb + 32 > lim) p1[r] = NEG;
        }
      }
      float mx = p0[0];
#pragma unroll
      for (int r = 1; r < 16; ++r) mx = fmaxf(mx, p0[r]);
#pragma unroll
      for (int r = 0; r < 16; ++r) mx = fmaxf(mx, p1[r]);
      {
        auto rr = __builtin_amdgcn_permlane32_swap(__float_as_uint(mx), __float_as_uint(mx), false, false);
        mx = fmaxf(__uint_as_float(rr[0]), __uint_as_float(rr[1]));
      }
      if (!TYPE) mx *= C2;
      constexpr float THR = TYPE ? 96.f : 16.f;
      float mn = m, alpha = 1.f;
      if (!__all(mx - m <= THR)) {
        mn = fmaxf(m, mx);
        alpha = __builtin_amdgcn_exp2f(m - mn);
        m = mn;
#pragma unroll
        for (int db = 0; db < 4; ++db)
#pragma unroll
          for (int r = 0; r < 16; ++r) o[db][r] *= alpha;
      }
      float ps = 0.f;
      if (TYPE) {
#pragma unroll
        for (int r = 0; r < 16; ++r) { p0[r] = __builtin_amdgcn_exp2f(p0[r] - mn); p1[r] = __builtin_amdgcn_exp2f(p1[r] - mn); ps += p0[r] + p1[r]; }
      } else {
#pragma unroll
        for (int r = 0; r < 16; ++r) { p0[r] = __builtin_amdgcn_exp2f(fmaf(p0[r], C2, -mn)); p1[r] = __builtin_amdgcn_exp2f(fmaf(p1[r], C2, -mn)); ps += p0[r] + p1[r]; }
      }
      l = l * alpha + ps;
      bf16x8 pa[2][2];
#pragma unroll
      for (int s = 0; s < 2; ++s) {
        u32x4 w0 = {pk2(p0[8 * s + 0], p0[8 * s + 1]), pk2(p0[8 * s + 2], p0[8 * s + 3]), pk2(p0[8 * s + 4], p0[8 * s + 5]), pk2(p0[8 * s + 6], p0[8 * s + 7])};
        u32x4 w1 = {pk2(p1[8 * s + 0], p1[8 * s + 1]), pk2(p1[8 * s + 2], p1[8 * s + 3]), pk2(p1[8 * s + 4], p1[8 * s + 5]), pk2(p1[8 * s + 6], p1[8 * s + 7])};
        pa[0][s] = *reinterpret_cast<bf16x8*>(&w0); pa[1][s] = *reinterpret_cast<bf16x8*>(&w1);
      }
#pragma unroll
      for (int db = 0; db < 4; ++db)
#pragma unroll
        for (int kb = 0; kb < 2; ++kb)
#pragma unroll
          for (int s = 0; s < 2; ++s) {
            const bf16x8 av = *(const bf16x8*)(sVc + db * 32 * VSTR + vo[kb][s]);
            o[db] = __builtin_amdgcn_mfma_f32_32x32x16_bf16(av, pa[kb][s], o[db], 0, 0, 0);
          }
    }
    if (kt + 1 < ntiles) store_tile(kt + 1);
  }
  {
    auto rr = __builtin_amdgcn_permlane32_swap(__float_as_uint(l), __float_as_uint(l), false, false);
    const float inv = 1.f / (__uint_as_float(rr[0]) + __uint_as_float(rr[1]));
    const int b = bh >> 3, hh = bh & 7;
    u16* od = p.omix() + ((size_t)(b * S_ + qrow + c)) * 2048 + TYPE * 1024 + hh * 128 + 4 * hi;
#pragma unroll
    for (int db = 0; db < 4; ++db)
#pragma unroll
      for (int g = 0; g < 4; ++g)
        *(u32x2*)(od + 32 * db + 8 * g) = u32x2{pk2(o[db][4 * g] * inv, o[db][4 * g + 1] * inv), pk2(o[db][4 * g + 2] * inv, o[db][4 * g + 3] * inv)};
  }
}

__device__ void phase_attn(const Params& p, char* smem, int bid, int nb) {
  int* sItem = (int*)(smem + 90000);
  const int x = bid & 7;
  unsigned* q = p.ctr() + 32 + x;
  for (;;) {
    __syncthreads();
    if (TID() == 0) *sItem = (int)atomicAdd(q, 1u);
    __syncthreads();
    const int item = *sItem;
    if (item >= 64) break;
    const int qb = 15 - (item >> 2), r = item & 3, type = r >> 1, bh = x + 8 * (r & 1);
    if (type == 0) attn_item<0>(p, smem, bh, qb); else attn_item<1>(p, smem, bh, qb);
  }
  unsigned* qc = p.ctr() + 48;
  for (;;) {
    __syncthreads();
    if (TID() == 0) *sItem = (int)atomicAdd(qc, 1u);
    __syncthreads();
    const int chunk = *sItem;
    if (chunk >= 512) break;
    quant_chunk(p, chunk);
  }
}

__device__ void phase_outproj(const Params& p, char* smem, int bid, int nb) {
  EpiOut E{p.x, p.y1()};
  pg8::Gemm g{p.omix(), p.WoutT(), T_, D_, D_};
  pg8::StaticOrder S; S.init(T_, D_, nb, bid);
  pg8::gemm_phase((PG8_LAS unsigned char*)smem, g, S, E, nullptr);
}

__device__ void phase_ln1(const Params& p, int bid, int nb) {
  const int lane = TID() & 63, wid = TID() >> 6;
  for (int t = bid * 8 + wid; t < T_; t += nb * 8) {
    float* row = p.y1() + (size_t)t * D_;
    float4 v[8];
    float sum = 0.f;
#pragma unroll
    for (int i = 0; i < 8; ++i) { v[i] = *(const float4*)(row + (i * 64 + lane) * 4); sum += (v[i].x + v[i].y) + (v[i].z + v[i].w); }
    const float mu = wave_sum(sum) * (1.f / D_);
    float sq = 0.f;
#pragma unroll
    for (int i = 0; i < 8; ++i) {
      v[i].x -= mu; v[i].y -= mu; v[i].z -= mu; v[i].w -= mu;
      sq += (v[i].x * v[i].x + v[i].y * v[i].y) + (v[i].z * v[i].z + v[i].w * v[i].w);
    }
    const float rstd = rsqrtf(wave_sum(sq) * (1.f / D_) + EPS);
#pragma unroll
    for (int i = 0; i < 8; ++i) {
      const int c = (i * 64 + lane) * 4;
      const float4 g = *(const float4*)(p.ln1_g + c), bb = *(const float4*)(p.ln1_b + c);
      float4 o; o.x = v[i].x * rstd * g.x + bb.x; o.y = v[i].y * rstd * g.y + bb.y; o.z = v[i].z * rstd * g.z + bb.z; o.w = v[i].w * rstd * g.w + bb.w;
      *(float4*)(row + c) = o;
      *(u32x2*)(p.h1b() + (size_t)t * D_ + c) = u32x2{pk2(o.x, o.y), pk2(o.z, o.w)};
    }
  }
}

__device__ __forceinline__ void ins16(unsigned (&t)[16], unsigned x) {
#pragma unroll
  for (int i = 0; i < 16; ++i) { const unsigned hi = t[i] > x ? t[i] : x; x = t[i] > x ? x : t[i]; t[i] = hi; }
}
__device__ __forceinline__ void ins16p(unsigned (&ck)[16], int (&ce)[16], unsigned x, int xe) {
#pragma unroll
  for (int i = 0; i < 16; ++i) {
    const bool sw = x > ck[i];
    const unsigned nk = sw ? x : ck[i], nx = sw ? ck[i] : x;
    const int ne = sw ? xe : ce[i], nxe = sw ? ce[i] : xe;
    ck[i] = nk; x = nx; ce[i] = ne; xe = nxe;
  }
}
__device__ __forceinline__ float unordkey(unsigned k) { return __uint_as_float((k & 0x80000000u) ? (k & 0x7fffffffu) : ~k); }

__device__ __forceinline__ void score_block(const u16* kH, const u16* kL, const bf16x8 (&qh)[4], const bf16x8 (&ql)[4], int hi, unsigned (&t)[16]) {
#pragma unroll
  for (int i = 0; i < 16; ++i) t[i] = 0u;
#pragma unroll 1
  for (int kb = 0; kb < 4; ++kb) {
    f32x16 sc;
#pragma unroll
    for (int r = 0; r < 16; ++r) sc[r] = 0.f;
#pragma unroll
    for (int ks = 0; ks < 4; ++ks) {
      const bf16x8 ah = *(const bf16x8*)(kH + kb * 32 * 64 + ks * 16), al = *(const bf16x8*)(kL + kb * 32 * 64 + ks * 16);
      sc = __builtin_amdgcn_mfma_f32_32x32x16_bf16(ah, qh[ks], sc, 0, 0, 0);
      sc = __builtin_amdgcn_mfma_f32_32x32x16_bf16(ah, ql[ks], sc, 0, 0, 0);
      sc = __builtin_amdgcn_mfma_f32_32x32x16_bf16(al, qh[ks], sc, 0, 0, 0);
    }
    const unsigned base = (unsigned)(127 - 32 * kb) - 4u * (unsigned)hi;
#pragma unroll
    for (int r = 0; r < 16; ++r) ins16(t, (ordkey(sc[r]) & ~127u) | (base - (unsigned)((r & 3) + 8 * (r >> 2))));
  }
  unsigned other[16];
#pragma unroll
  for (int i = 0; i < 16; ++i) {
    auto rr = __builtin_amdgcn_permlane32_swap(t[i], t[i], false, false);
    other[i] = hi ? rr[0] : rr[1];
  }
#pragma unroll 1
  for (int i = 0; i < 16; ++i) {
    unsigned x = other[0];
#pragma unroll
    for (int k = 1; k < 16; ++k) x = (i == k) ? other[k] : x;
    ins16(t, x);
  }
}

__device__ __forceinline__ void route_tile(const Params& p, char* smem, f32x4 (&acc)[4][4], int tm, int h) {
  const int tid = TID(), wid = tid >> 6, lane = tid & 63, wr = wid >> 1, wc = wid & 1, fr = lane & 15, fq = lane >> 4;
  __syncthreads();
  float* Qw = (float*)smem + wid * (64 * 65);
#pragma unroll
  for (int m = 0; m < 4; ++m)
#pragma unroll
    for (int n = 0; n < 4; ++n)
#pragma unroll
      for (int j = 0; j < 4; ++j) Qw[(m * 16 + fq * 4 + j) * 65 + n * 16 + fr] = acc[m][n][j];
  asm volatile("s_waitcnt lgkmcnt(0)" ::: "memory");
  const int c = lane & 31, hi = lane >> 5;
  bf16x8 qh[2][4], ql[2][4];
#pragma unroll
  for (int tb = 0; tb < 2; ++tb)
#pragma unroll
    for (int ks = 0; ks < 4; ++ks) {
      float v[8]; unsigned wh[4], wl[4];
#pragma unroll
      for (int j = 0; j < 8; ++j) v[j] = Qw[(tb * 32 + c) * 65 + 16 * ks + 8 * hi + j];
#pragma unroll
      for (int w = 0; w < 4; ++w) {
        wh[w] = pk2(v[2 * w], v[2 * w + 1]);
        wl[w] = pk2(v[2 * w] - bflo(wh[w]), v[2 * w + 1] - bfhi(wh[w]));
      }
      u32x4 uh = {wh[0], wh[1], wh[2], wh[3]}, ul = {wl[0], wl[1], wl[2], wl[3]};
      qh[tb][ks] = *reinterpret_cast<bf16x8*>(&uh); ql[tb][ks] = *reinterpret_cast<bf16x8*>(&ul);
    }
  const u16* kH = p.keyH() + ((size_t)(wc * 8 + h) * 128 + c) * 64 + 8 * hi;
  const u16* kL = p.keyL() + ((size_t)(wc * 8 + h) * 128 + c) * 64 + 8 * hi;
  unsigned t0[16], t1[16];
  score_block(kH, kL, qh[0], ql[0], hi, t0);
  score_block(kH, kL, qh[1], ql[1], hi, t1);
  unsigned t[16];
#pragma unroll
  for (int i = 0; i < 16; ++i) t[i] = hi ? t1[i] : t0[i];
  __syncthreads();
  unsigned* L = (unsigned*)smem;
#pragma unroll
  for (int r = 0; r < 16; ++r) L[(wc * 16 + r) * 256 + wr * 64 + lane] = t[r];
  __syncthreads();
  if (wid < 4) {
    const int tok = wid * 64 + lane;
    unsigned ck[16]; int ce[16];
#pragma unroll
    for (int i = 0; i < 16; ++i) { ck[i] = 0u; ce[i] = 0; }
#pragma unroll 1
    for (int a = 0; a < 16; ++a) {
      const unsigned ka = L[a * 256 + tok];
      const int i1a = (127 - (int)(ka & 127u)) * 128; const float v1a = unordkey(ka & ~127u);
      const int nbm1 = (int)((0x1112347FULL >> (4 * a)) & 15ULL);
#pragma unroll 1
      for (int b = 0; b <= nbm1; ++b) {
        const unsigned kb = L[(16 + b) * 256 + tok];
        const int i2b = 127 - (int)(kb & 127u); const float v2b = unordkey(kb & ~127u);
        ins16p(ck, ce, ordkey(v1a + v2b), i1a + i2b);
      }
    }
    float ex[16], sum = 0.f;
    const float mx = unordkey(ck[0]);
#pragma unroll
    for (int r = 0; r < 16; ++r) { ex[r] = __expf(unordkey(ck[r]) - mx); sum += ex[r]; }
    const float inv = 1.f / sum;
    const size_t o = ((size_t)(tm * 256 + tok) * 8 + h) * 16;
    int* ed = p.eidxG() + o; float* gd = p.gateG() + o;
#pragma unroll
    for (int r = 0; r < 16; r += 4) {
      *(int4*)(ed + r) = make_int4(ce[r], ce[r + 1], ce[r + 2], ce[r + 3]);
      *(float4*)(gd + r) = make_float4(ex[r] * inv, ex[r + 1] * inv, ex[r + 2] * inv, ex[r + 3] * inv);
    }
  }
}

__device__ void phase_mid(const Params& p, char* smem, int bid, int nb) {
  {
    EpiGate E{p.y1(), p.projb(), p.out};
    pg8::Gemm g{p.h1b(), p.WgT(), T_, D_, D_};
    pg8::StaticOrder S; S.init(T_, D_, nb, bid);
    pg8::gemm_phase((PG8_LAS unsigned char*)smem, g, S, E, nullptr);
  }
  for (int t = vblock(bid, nb); t < 32 * 8; t += nb) {
    int tm, tn; tile_rc(t, 8, tm, tn);
    f32x4 acc[1][4][4];
    gemm_core<4, 2>(p.h1b(), D_, p.WpqT(), D_, D_, tm * 256, tn * 128, smem, acc);
    route_tile(p, smem, acc[0], tm, tn);
  }
}

__device__ __forceinline__ float gelu_exact(float a) {
  const float x = fabsf(a) * 0.7071067811865476f;
  const float t = __builtin_amdgcn_rcpf(1.f + 0.3275911f * x);
  const float poly = t * (0.254829592f + t * (-0.284496736f + t * (1.421413741f + t * (-1.453152027f + t * 1.061405429f))));
  const float er = 1.f - poly * __expf(-x * x);
  return 0.5f * a * (1.f + (a < 0.f ? -er : er));
}

template <int NPER, int IDXMASK>
__device__ __forceinline__ int top16(unsigned (&k)[NPER], int lane) {
  int mine = 0;
#pragma unroll 1
  for (int r = 0; r < 16; ++r) {
    unsigned loc = k[0];
#pragma unroll
    for (int i = 1; i < NPER; ++i) loc = loc > k[i] ? loc : k[i];
    const unsigned best = wave_umax(loc);
#pragma unroll
    for (int i = 0; i < NPER; ++i) if (k[i] == best) k[i] = 0u;
    if (lane == r) mine = IDXMASK - (int)(best & (unsigned)IDXMASK);
  }
  return mine;
}

__device__ void phase_peer(const Params& p, char* smem, int bid, int nb) {
  const int tid = TID(), lane = tid & 63, wid = tid >> 6;
  float* qs = (float*)smem;
  float* sc = (float*)(smem + 8192);
  int* eidx = (int*)(smem + 24576);
  float* gts = (float*)(smem + 40960);
  for (int it = bid; it < T_ / 32; it += nb) {
    const int t0 = it * 32;
#pragma unroll
    for (int i = 0; i < 2; ++i) {
      const int idx = (i * NT + tid) * 4;
      *(int4*)(eidx + idx) = *(const int4*)(p.eidxG() + (size_t)t0 * 128 + idx);
      *(float4*)(gts + idx) = *(const float4*)(p.gateG() + (size_t)t0 * 128 + idx);
    }
    __syncthreads();
    for (int ti = 0; ti < 4; ++ti) {
      const int tok = wid * 4 + ti, t = t0 + tok;
      typedef float f32x32 __attribute__((ext_vector_type(32)));
      typedef unsigned u32x6 __attribute__((ext_vector_type(6)));
      float hreg[32];
      f32x32 o;
#pragma unroll
      for (int q = 0; q < 8; ++q) {
        const u32x2 hv = *(const u32x2*)(p.h1b() + (size_t)t * D_ + (q * 64 + lane) * 4);
        hreg[q * 4] = bflo(hv[0]); hreg[q * 4 + 1] = bfhi(hv[0]); hreg[q * 4 + 2] = bflo(hv[1]); hreg[q * 4 + 3] = bfhi(hv[1]);
      }
#pragma unroll
      for (int i = 0; i < 32; ++i) o[i] = 0.f;
      const float* Us = p.Us(); const float* Vs = p.Vs();
      const unsigned char* Uq = p.Uq() + lane * 24;
      const int* ep = eidx + tok * 128; const float* gp = gts + tok * 128;
      u32x4 uA4[2], vA4[2], uB4[2], vB4[2]; u32x2 uA2[2], vA2[2], uB2[2], vB2[2];
      float gA[2], suA[2], svA[2], gB[2], suB[2], svB[2];
#define PEER_LOAD(U4, U2, V4, V2, G, SU, SV, J0)                                                        \
      _Pragma("unroll") for (int jj = 0; jj < 2; ++jj) {                                                \
        const int e = __builtin_amdgcn_readfirstlane(ep[(J0) + jj]);                                    \
        G[jj] = gp[(J0) + jj]; SU[jj] = Us[e]; SV[jj] = Vs[e];                                          \
        const unsigned char* up = Uq + (size_t)e * 3072; const unsigned char* vp = up + 1536;           \
        U2[jj] = *(const u32x2*)(up); U4[jj] = *(const u32x4*)(up + 8);                                 \
        V2[jj] = *(const u32x2*)(vp); V4[jj] = *(const u32x4*)(vp + 8);                                 \
      }
#define PEER_COMPUTE(U4, U2, V4, V2, G, SU, SV)                                                         \
      _Pragma("unroll") for (int jj = 0; jj < 2; ++jj) {                                                \
        const u32x6 uw = {U2[jj][0], U2[jj][1], U4[jj][0], U4[jj][1], U4[jj][2], U4[jj][3]};            \
        const f32x32 ud = __builtin_amdgcn_cvt_scalef32_pk32_f32_fp6(uw, 1.0f);                         \
        float d0 = 0.f, d1 = 0.f, d2 = 0.f, d3 = 0.f;                                                   \
        _Pragma("unroll") for (int i = 0; i < 32; i += 4) {                                             \
          d0 += ud[i] * hreg[i]; d1 += ud[i + 1] * hreg[i + 1]; d2 += ud[i + 2] * hreg[i + 2]; d3 += ud[i + 3] * hreg[i + 3]; \
        }                                                                                               \
        const float av = wave_sum((d0 + d1) + (d2 + d3)) * SU[jj];                                      \
        const float act = gelu_exact(av) * G[jj] * SV[jj];                                              \
        const u32x6 vw = {V2[jj][0], V2[jj][1], V4[jj][0], V4[jj][1], V4[jj][2], V4[jj][3]};            \
        const f32x32 vd = __builtin_amdgcn_cvt_scalef32_pk32_f32_fp6(vw, 1.0f);                         \
        o += vd * act;                                                                                  \
      }
      PEER_LOAD(uA4, uA2, vA4, vA2, gA, suA, svA, 0)
#pragma unroll 1
      for (int j0 = 0; j0 < 128; j0 += 4) {
        PEER_LOAD(uB4, uB2, vB4, vB2, gB, suB, svB, j0 + 2)
        PEER_COMPUTE(uA4, uA2, vA4, vA2, gA, suA, svA)
        if (j0 + 4 < 128) { PEER_LOAD(uA4, uA2, vA4, vA2, gA, suA, svA, j0 + 4) }
        PEER_COMPUTE(uB4, uB2, vB4, vB2, gB, suB, svB)
      }
#undef PEER_LOAD
#undef PEER_COMPUTE
      float* orow = p.out + (size_t)t * D_ + lane * 4;
      float sum = 0.f;
#pragma unroll
      for (int q = 0; q < 8; ++q) {
        const float4 r0 = *(const float4*)(orow + q * 256);
        o[q * 4 + 0] += r0.x; o[q * 4 + 1] += r0.y; o[q * 4 + 2] += r0.z; o[q * 4 + 3] += r0.w;
      }
#pragma unroll
      for (int i = 0; i < 32; ++i) sum += o[i];
      const float mu = wave_sum(sum) * (1.f / D_);
      float sq = 0.f;
#pragma unroll
      for (int i = 0; i < 32; ++i) { o[i] -= mu; sq += o[i] * o[i]; }
      const float rstd = rsqrtf(wave_sum(sq) * (1.f / D_) + EPS);
#pragma unroll
      for (int q = 0; q < 8; ++q) {
        const int col = (q * 64 + lane) * 4;
        const float4 g0 = *(const float4*)(p.ln2_g + col), b0 = *(const float4*)(p.ln2_b + col);
        float4 w0;
        w0.x = o[q * 4 + 0] * rstd * g0.x + b0.x; w0.y = o[q * 4 + 1] * rstd * g0.y + b0.y;
        w0.z = o[q * 4 + 2] * rstd * g0.z + b0.z; w0.w = o[q * 4 + 3] * rstd * g0.w + b0.w;
        *(float4*)(orow + q * 256) = w0;
      }
    }
    __syncthreads();
  }
}

template <int PH>
__device__ __forceinline__ void run_phase(const Params& p, char* smem, int bid, int nb) {
  if constexpr (PH == 0) phase_prep(p, smem, bid, nb);
  if constexpr (PH == 1) phase_inproj(p, smem, bid, nb);
  if constexpr (PH == 2) phase_up(p, smem, bid, nb);
#ifdef ATTN_NAIVE
  if constexpr (PH == 3) phase_attn_naive(p, smem, bid, nb);
#else
  if constexpr (PH == 3) phase_attn(p, smem, bid, nb);
#endif
  if constexpr (PH == 4) phase_outproj(p, smem, bid, nb);
  if constexpr (PH == 5) phase_ln1(p, bid, nb);
  if constexpr (PH == 6) phase_mid(p, smem, bid, nb);
  if constexpr (PH == 7) phase_peer(p, smem, bid, nb);
}

template <int PH>
__global__ void __launch_bounds__(NT, 2) phase_kernel(Params p) {
  __shared__ __attribute__((aligned(16))) char smem[SMEM_BYTES];
  run_phase<PH>(p, smem, blockIdx.x, gridDim.x);
}

#define BW_CENSUS(j) (256 + (j) * 32)
#define BW_XSUB(j) (256 + 512 + (j) * 32)
#define BW_XGEN(j) (256 + 1024 + (j) * 32)
#define BW_TOP (256 + 1536)
#define BW_TOPGEN (256 + 1568)
__device__ __forceinline__ unsigned bw_ld(unsigned* p) { return __hip_atomic_load(p, __ATOMIC_RELAXED, __HIP_MEMORY_SCOPE_AGENT); }
__device__ __forceinline__ unsigned bw_add(unsigned* p, unsigned v) { return __hip_atomic_fetch_add(p, v, __ATOMIC_RELAXED, __HIP_MEMORY_SCOPE_AGENT); }
__device__ __forceinline__ unsigned xcc_id() { return (unsigned)__builtin_amdgcn_s_getreg((3 << 11) | 20) & 0xFu; }

__device__ __forceinline__ void grid_barrier(unsigned* bar, unsigned* st  ) {
  asm volatile("s_waitcnt vmcnt(0)" ::: "memory");
  __syncthreads();
  if (threadIdx.x == 0) {
    __builtin_amdgcn_s_waitcnt(0);
    const unsigned x = xcc_id();
    unsigned nloc = st[0], nx = st[1];
    if (nloc == 0u) {
      const unsigned G = gridDim.x;
      for (;;) {
        unsigned sum = 0u, cnt = 0u, mine = 0u;
#pragma unroll
        for (unsigned j = 0; j < 16; ++j) { const unsigned c = bw_ld(&bar[BW_CENSUS(j)]); sum += c; cnt += (c > 0u) ? 1u : 0u; mine = (j == x) ? c : mine; }
        nloc = mine; nx = cnt;
        if (sum == G) break;
        __builtin_amdgcn_s_sleep(1);
      }
      st[0] = nloc; st[1] = nx;
    }
    const unsigned old = bw_add(&bar[BW_XSUB(x)], 1u);
    const unsigned gen = old / nloc;
    if (old + 1u == (gen + 1u) * nloc) {
      __builtin_amdgcn_fence(__ATOMIC_RELEASE, "agent");
      asm volatile("s_waitcnt vmcnt(0)" ::: "memory");
      const unsigned og = bw_add(&bar[BW_TOP], 1u);
      const unsigned tg = og / nx;
      if (og + 1u == (tg + 1u) * nx) bw_add(&bar[BW_TOPGEN], 1u);
      else while (bw_ld(&bar[BW_TOPGEN]) == tg) __builtin_amdgcn_s_sleep(1);
      __builtin_amdgcn_fence(__ATOMIC_ACQUIRE, "agent");
      bw_add(&bar[BW_XGEN(x)], 1u);
      asm volatile("s_waitcnt vmcnt(0)" ::: "memory");
    } else {
      while (bw_ld(&bar[BW_XGEN(x)]) == gen) __builtin_amdgcn_s_sleep(1);
      __builtin_amdgcn_fence(__ATOMIC_ACQUIRE, "agent");
      asm volatile("s_waitcnt vmcnt(0)" ::: "memory");
    }
  }
  __syncthreads();
}

#if SINGLE_LAUNCH
typedef const __attribute__((address_space(4))) unsigned long long* kargp_t;
static_assert(sizeof(Params) % 8 == 0, "Params must be a pack of 8-byte fields");
#define RUN_PHASE(N) run_phase<N>(p_, smem, bid, nb);
__global__ void __launch_bounds__(NT, 2) fwd_kernel(Params p_) {
  __shared__ __attribute__((aligned(16))) char smem[SMEM_BYTES + 64];
  const int bid = blockIdx.x, nb = gridDim.x;
  unsigned* bar = (unsigned*)(p_.ws + O_CTR);
  unsigned* st = (unsigned*)(smem + SMEM_BYTES);
  if (threadIdx.x == 0) { st[0] = 0u; st[1] = 0u; (void)bw_add(&bar[BW_CENSUS(xcc_id())], 1u); }
  if (p_.out == nullptr) cg::this_grid().sync();
  RUN_PHASE(0) grid_barrier(bar, st);
  RUN_PHASE(1) grid_barrier(bar, st);
  RUN_PHASE(2) grid_barrier(bar, st);
  RUN_PHASE(3) grid_barrier(bar, st);
  RUN_PHASE(4) grid_barrier(bar, st);
  RUN_PHASE(5) grid_barrier(bar, st);
  RUN_PHASE(6) grid_barrier(bar, st);
  RUN_PHASE(7)
}
#endif

extern "C" void kernel_launch(void* const* d_in, const int* in_sizes, int n_in, void* d_out, int out_size,
                              void* d_ws, size_t ws_size, hipStream_t stream) {
  (void)in_sizes; (void)n_in; (void)out_size; (void)ws_size;
  Params p{};
  p.x = (const float*)d_in[0]; p.p = (const float*)d_in[1]; p.positions = (const int*)d_in[2];
  p.w_in = (const float*)d_in[3]; p.b_forget = (const float*)d_in[4]; p.g_q = (const float*)d_in[5];
  p.w_uq = (const float*)d_in[6]; p.g_kv = (const float*)d_in[7]; p.w_ukv = (const float*)d_in[8];
  p.w_out = (const float*)d_in[9]; p.ln1_g = (const float*)d_in[10]; p.ln1_b = (const float*)d_in[11];
  p.peer_wq = (const float*)d_in[12]; p.keys1 = (const float*)d_in[13]; p.keys2 = (const float*)d_in[14];
  p.peer_u = (const float*)d_in[15]; p.peer_v = (const float*)d_in[16]; p.wgate = (const float*)d_in[17];
  p.wproj = (const float*)d_in[18]; p.ln2_g = (const float*)d_in[19]; p.ln2_b = (const float*)d_in[20];
  p.out = (float*)d_out;
  p.ws = (char*)d_ws;

  static int grid_blocks = 0;
  if (!grid_blocks) {
    int dev = 0, cus = 0, per_cu = 0;
    (void)hipGetDevice(&dev);
    (void)hipDeviceGetAttribute(&cus, hipDeviceAttributeMultiprocessorCount, dev);
#if SINGLE_LAUNCH
    (void)hipOccupancyMaxActiveBlocksPerMultiprocessor(&per_cu, fwd_kernel, NT, 0);
#else
    per_cu = 2;
#endif
    if (per_cu > 1) per_cu = 1;
    if (per_cu < 1) per_cu = 1;
    grid_blocks = cus * per_cu;
  }
#if SINGLE_LAUNCH
  (void)hipMemsetAsync(d_ws, 0, 16384, stream);
  void* args[] = {&p};
  hipError_t e = hipLaunchCooperativeKernel((void*)fwd_kernel, dim3(grid_blocks), dim3(NT), args, 0, stream);
  if (e != hipSuccess) fprintf(stderr, "cooperative launch failed: %s (grid %d)\n", hipGetErrorString(e), grid_blocks);
#else
  phase_kernel<0><<<grid_blocks, NT, 0, stream>>>(p);
  phase_kernel<1><<<grid_blocks, NT, 0, stream>>>(p);
  phase_kernel<2><<<grid_blocks, NT, 0, stream>>>(p);
  phase_kernel<3><<<grid_blocks, NT, 0, stream>>>(p);
  phase_kernel<4><<<grid_blocks, NT, 0, stream>>>(p);
  phase_kernel<5><<<grid_blocks, NT, 0, stream>>>(p);
  phase_kernel<6><<<grid_blocks, NT, 0, stream>>>(p);
  phase_kernel<7><<<grid_blocks, NT, 0, stream>>>(p);
#endif
}
```

```cpp
#include <hip/hip_runtime.h>
#include <hip/hip_bf16.h>
#include <hip/hip_cooperative_groups.h>
#include <stdint.h>
#include <cstdio>
namespace cg = cooperative_groups;

typedef unsigned short u16;
typedef short bf16x8 __attribute__((ext_vector_type(8)));
typedef float f32x4 __attribute__((ext_vector_type(4)));
typedef unsigned u32x4 __attribute__((ext_vector_type(4)));
typedef unsigned u32x2 __attribute__((ext_vector_type(2)));

#ifndef SINGLE_LAUNCH
#define SINGLE_LAUNCH 1
#endif

constexpr int T_ = 8192, D_ = 2048, S_ = 4096, NB_ = 2;
constexpr int INW = 4168;
constexpr int NPH = 8;
constexpr float ALPHA = 1.189207115002721f;
constexpr float EPS = 1e-6f;
constexpr int NT = 512;
constexpr int SMEM_BYTES = 133120;

constexpr size_t al256(size_t x) { return (x + 255) & ~(size_t)255; }
constexpr size_t O_CTR = 0;
constexpr size_t O_WINT = O_CTR + 16384;
constexpr size_t O_WUQT = O_WINT + al256((size_t)4352 * 2048 * 2);
constexpr size_t O_WUKVT = O_WUQT + al256((size_t)1536 * 512 * 2);
constexpr size_t O_WOUTT = O_WUKVT + al256((size_t)2048 * 512 * 2);
constexpr size_t O_WPQT = O_WOUTT + al256((size_t)2048 * 2048 * 2);
constexpr size_t O_WGT = O_WPQT + al256((size_t)1024 * 2048 * 2);
constexpr size_t O_WPT = O_WGT + al256((size_t)2048 * 2048 * 2);
constexpr size_t O_PB = O_WPT + al256((size_t)2048 * 256 * 2);
constexpr size_t O_UB = O_PB + al256((size_t)8192 * 256 * 2);
constexpr size_t O_VB = O_UB + 2048;
constexpr size_t O_OMIX = O_UB + al256((size_t)16384 * 4096);
constexpr size_t O_CS = O_OMIX + al256((size_t)8192 * 2048 * 2);
constexpr size_t O_PROJB = O_CS + al256((size_t)8192 * 32 * 8);
constexpr size_t O_KEYH = O_PROJB + al256((size_t)8192 * 2048 * 2);
constexpr size_t O_KEYL = O_KEYH + al256((size_t)2 * 8 * 128 * 64 * 2);
constexpr size_t O_US = O_KEYL + al256((size_t)2 * 8 * 128 * 64 * 2);
constexpr size_t O_VS = O_US + al256((size_t)16384 * 4);
constexpr size_t O_REGB = O_VS + al256((size_t)16384 * 4);
constexpr size_t O_XB = O_REGB;
constexpr size_t O_CQB = O_XB + al256((size_t)8192 * 2048 * 2);
constexpr size_t O_CKVB = O_CQB + al256((size_t)8192 * 512 * 2);
constexpr size_t O_QM = O_CKVB + al256((size_t)8192 * 512 * 2);
constexpr size_t O_KM = O_QM + al256((size_t)8192 * 8 * 192 * 2);
constexpr size_t O_VMT = O_KM + al256((size_t)8192 * 8 * 192 * 2);
constexpr size_t O_QF = O_VMT + al256((size_t)8192 * 8 * 128 * 2);
constexpr size_t O_KF = O_QF + al256((size_t)8192 * 8 * 128 * 2);
constexpr size_t O_VFT = O_KF + al256((size_t)8192 * 8 * 128 * 2);
constexpr size_t O_LOGF = O_VFT + al256((size_t)8192 * 8 * 128 * 2);
constexpr size_t O_FK = O_LOGF + al256((size_t)16 * 4096 * 4);
constexpr size_t O_KRS = O_FK + al256((size_t)16 * 4096 * 4);
constexpr size_t O_RSS = O_KRS + al256((size_t)8192 * 64 * 4);
constexpr size_t O_ENDB = O_RSS + al256((size_t)2 * 8192 * 4);
constexpr size_t O_Y1 = O_REGB;
constexpr size_t O_H1B = O_Y1 + al256((size_t)8192 * 2048 * 4);
constexpr size_t O_PQ = O_H1B + al256((size_t)8192 * 2048 * 2);
constexpr size_t O_GATE = O_PQ + al256((size_t)8192 * 128 * 4);
constexpr size_t O_ENDB2 = O_GATE + al256((size_t)8192 * 128 * 4);
static_assert(O_ENDB2 <= O_ENDB, "region B reuse overflow");
static_assert(O_ENDB <= (size_t)500 * 1024 * 1024, "workspace too large");

struct Params {
  const float *x, *p; const int* positions;
  const float *w_in, *b_forget, *g_q, *w_uq, *g_kv, *w_ukv, *w_out, *ln1_g, *ln1_b;
  const float *peer_wq, *keys1, *keys2, *peer_u, *peer_v, *wgate, *wproj, *ln2_g, *ln2_b;
  float* out;
  char* ws;
#define WSP(type, name, off) __device__ __forceinline__ type* name() const { return (type*)(ws + (off)); }
  WSP(unsigned, ctr, O_CTR) WSP(u16, WinT, O_WINT) WSP(u16, WuqT, O_WUQT) WSP(u16, WukvT, O_WUKVT) WSP(u16, WoutT, O_WOUTT)
  WSP(u16, WpqT, O_WPQT) WSP(u16, WgT, O_WGT) WSP(u16, WpT, O_WPT) WSP(u16, pb, O_PB) WSP(unsigned char, Uq, O_UB) WSP(unsigned char, Vq, O_VB) WSP(float, Us, O_US) WSP(float, Vs, O_VS)
  WSP(u16, omix, O_OMIX) WSP(float2, cs, O_CS) WSP(u16, projb, O_PROJB) WSP(u16, keyH, O_KEYH) WSP(u16, keyL, O_KEYL)
  WSP(u16, xb, O_XB) WSP(u16, cqb, O_CQB) WSP(u16, ckvb, O_CKVB) WSP(u16, Qm, O_QM) WSP(u16, Km, O_KM) WSP(u16, VmT, O_VMT)
  WSP(u16, Qf, O_QF) WSP(u16, Kf, O_KF) WSP(u16, VfT, O_VFT) WSP(float, logf, O_LOGF) WSP(float, Fk, O_FK) WSP(float, krsum, O_KRS) WSP(float, rss, O_RSS)
  WSP(float, y1, O_Y1) WSP(u16, h1b, O_H1B) WSP(int, eidxG, O_PQ) WSP(float, gateG, O_GATE)
#undef WSP
};

__device__ __forceinline__ int TID() { int t = threadIdx.x; asm volatile("" : "+v"(t)); return t; }
__device__ __forceinline__ unsigned pk2(float lo, float hi) {
  unsigned r; asm volatile("v_cvt_pk_bf16_f32 %0, %1, %2" : "=v"(r) : "v"(lo), "v"(hi)); return r;
}
__device__ __forceinline__ u16 f2bf(float f) { return (u16)(pk2(f, 0.f) & 0xffffu); }
__device__ __forceinline__ float bf2f(u16 v) { return __uint_as_float(((unsigned)v) << 16); }
__device__ __forceinline__ float bflo(unsigned v) { return __uint_as_float(v << 16); }
__device__ __forceinline__ float bfhi(unsigned v) { return __uint_as_float(v & 0xffff0000u); }

template <int CTRL> __device__ __forceinline__ int dppi(int v) { return __builtin_amdgcn_update_dpp(0, v, CTRL, 0xF, 0xF, false); }
template <int CTRL> __device__ __forceinline__ float dppf(float v) { return __int_as_float(dppi<CTRL>(__float_as_int(v))); }
__device__ __forceinline__ float rdlane(float v, int l) { return __int_as_float(__builtin_amdgcn_readlane(__float_as_int(v), l)); }

__device__ __forceinline__ float row_sum(float v) {
  v += dppf<0xB1>(v); v += dppf<0x4E>(v); v += dppf<0x141>(v); v += dppf<0x140>(v); return v;
}
__device__ __forceinline__ float row_max(float v) {
  v = fmaxf(v, dppf<0xB1>(v)); v = fmaxf(v, dppf<0x4E>(v)); v = fmaxf(v, dppf<0x141>(v)); v = fmaxf(v, dppf<0x140>(v)); return v;
}
__device__ __forceinline__ float wave_sum(float v) {
  v = row_sum(v);
  return (rdlane(v, 0) + rdlane(v, 16)) + (rdlane(v, 32) + rdlane(v, 48));
}
__device__ __forceinline__ float wave_max(float v) {
  v = row_max(v);
  return fmaxf(fmaxf(rdlane(v, 0), rdlane(v, 16)), fmaxf(rdlane(v, 32), rdlane(v, 48)));
}
__device__ __forceinline__ unsigned wave_umax(unsigned v) {
  unsigned t;
  t = (unsigned)dppi<0xB1>((int)v); v = v > t ? v : t;
  t = (unsigned)dppi<0x4E>((int)v); v = v > t ? v : t;
  t = (unsigned)dppi<0x141>((int)v); v = v > t ? v : t;
  t = (unsigned)dppi<0x140>((int)v); v = v > t ? v : t;
  unsigned a = (unsigned)__builtin_amdgcn_readlane((int)v, 0), b = (unsigned)__builtin_amdgcn_readlane((int)v, 16);
  unsigned c = (unsigned)__builtin_amdgcn_readlane((int)v, 32), d = (unsigned)__builtin_amdgcn_readlane((int)v, 48);
  a = a > b ? a : b; c = c > d ? c : d; return a > c ? a : c;
}
__device__ __forceinline__ unsigned ordkey(float f) {
  unsigned u = __float_as_uint(f);
  return (u & 0x80000000u) ? ~u : (u | 0x80000000u);
}

__device__ __forceinline__ unsigned fp6_code(float v) {
  const float a = fabsf(v);
  int code = a < 2.f ? (int)rintf(a * 8.f) : (a < 4.f ? 16 + (int)rintf((a - 2.f) * 4.f) : 24 + (int)rintf((a - 4.f) * 2.f));
  code = code > 31 ? 31 : code;
  return (unsigned)code | (v < 0.f ? 32u : 0u);
}
__device__ __forceinline__ void quant_chunk(const Params& p, int chunk) {
  const int tid = TID(), lane = tid & 63, wid = tid >> 6;
#pragma unroll 1
  for (int i8 = 0; i8 < 8; ++i8) {
    const int r = chunk * 64 + wid * 8 + i8;
    const int tab = r >> 14, row = r & 16383;
    const float* src = (tab ? p.peer_v : p.peer_u) + (size_t)row * D_ + lane * 4;
    float4 v[8];
    float am = 0.f;
#pragma unroll
    for (int i = 0; i < 8; ++i) {
      { const f32x4 tv = __builtin_nontemporal_load((const f32x4*)(src + i * 256)); v[i] = make_float4(tv[0], tv[1], tv[2], tv[3]); }
      am = fmaxf(am, fmaxf(fmaxf(fabsf(v[i].x), fabsf(v[i].y)), fmaxf(fabsf(v[i].z), fabsf(v[i].w))));
    }
    am = wave_max(am);
    const float qs = am > 0.f ? 7.5f / am : 1.f;
    unsigned w[6];
#pragma unroll
    for (int g = 0; g < 2; ++g) {
      unsigned long long lo = 0ull; unsigned hi = 0u;
#pragma unroll
      for (int i = 0; i < 4; ++i) {
        const float4 f = v[g * 4 + i];
        const unsigned q4 = fp6_code(f.x * qs) | (fp6_code(f.y * qs) << 6) | (fp6_code(f.z * qs) << 12) | (fp6_code(f.w * qs) << 18);
        if (i == 0) lo |= (unsigned long long)q4;
        if (i == 1) lo |= (unsigned long long)q4 << 24;
        if (i == 2) { lo |= (unsigned long long)q4 << 48; hi |= q4 >> 16; }
        if (i == 3) hi |= q4 << 8;
      }
      w[g * 3 + 0] = (unsigned)lo; w[g * 3 + 1] = (unsigned)(lo >> 32); w[g * 3 + 2] = hi;
    }
    unsigned* dst = (unsigned*)(p.Uq() + (size_t)row * 3072 + tab * 1536 + lane * 24);
    *(u32x2*)dst = u32x2{w[0], w[1]}; *(u32x2*)(dst + 2) = u32x2{w[2], w[3]}; *(u32x2*)(dst + 4) = u32x2{w[4], w[5]};
    if (lane == 0) (tab ? p.Vs() : p.Us())[row] = am > 0.f ? am / 7.5f : 1.f;
  }
}

__device__ void transpose_cvt(const float* __restrict__ W, int ldw, int K, int src_col0, int ncols,
                              u16* __restrict__ WT, int dst_row0, const float* __restrict__ kscale,
                              float* tile, int bid, int nb) {
  const int tiles_k = K / 64, tiles_n = ncols / 64, tid = TID();
#pragma unroll 1
  for (int t = bid; t < tiles_k * tiles_n; t += nb) {
    const int tk = t % tiles_k, tn = t / tiles_k, k0 = tk * 64, n0 = tn * 64;
#pragma unroll
    for (int i = 0; i < 2; ++i) {
      const int r = (tid >> 4) + 32 * i, c = (tid & 15) * 4;
      const f32x4 tv = __builtin_nontemporal_load((const f32x4*)(W + (size_t)(k0 + r) * ldw + src_col0 + n0 + c));
      const float4 v = make_float4(tv[0], tv[1], tv[2], tv[3]);
      const float sc = kscale ? kscale[k0 + r] : 1.f;
      tile[r * 65 + c + 0] = v.x * sc; tile[r * 65 + c + 1] = v.y * sc;
      tile[r * 65 + c + 2] = v.z * sc; tile[r * 65 + c + 3] = v.w * sc;
    }
    __syncthreads();
    {
      const int n = tid >> 3, kk = (tid & 7) * 8;
      unsigned w[4];
#pragma unroll
      for (int e = 0; e < 4; ++e) w[e] = pk2(tile[(kk + 2 * e) * 65 + n], tile[(kk + 2 * e + 1) * 65 + n]);
      *(u32x4*)(WT + (size_t)(dst_row0 + n0 + n) * K + k0 + kk) = u32x4{w[0], w[1], w[2], w[3]};
    }
    __syncthreads();
  }
}

__device__ void cvt_bf16(const float* __restrict__ src, u16* __restrict__ dst, size_t n8, size_t gtid, size_t gthreads) {
  for (size_t i = gtid; i < n8; i += gthreads) {
    const float4 a = ((const float4*)src)[2 * i], b = ((const float4*)src)[2 * i + 1];
    ((u32x4*)dst)[i] = u32x4{pk2(a.x, a.y), pk2(a.z, a.w), pk2(b.x, b.y), pk2(b.z, b.w)};
  }
}

__device__ void phase_prep(const Params& p, char* smem, int bid, int nb) {
  const int tid = TID(), lane = tid & 63, wid = tid >> 6;
  float* tile = (float*)smem;
  if (bid == 0 && tid == 0) p.ctr()[0] = 0;
  transpose_cvt(p.w_in, INW, D_, 0, 1024, p.WinT(), 0, nullptr, tile, bid, nb);
  transpose_cvt(p.w_in, INW, D_, 1088, 3072, p.WinT(), 1024, nullptr, tile, bid, nb);
  transpose_cvt(p.w_in, INW, D_, 1024, 64, p.WinT(), 4096, nullptr, tile, bid, nb);
  transpose_cvt(p.w_uq, 1536, 512, 0, 1536, p.WuqT(), 0, p.g_q, tile, bid, nb);
  transpose_cvt(p.w_ukv, 2048, 512, 0, 2048, p.WukvT(), 0, p.g_kv, tile, bid, nb);
  transpose_cvt(p.w_out, 2048, 2048, 0, 2048, p.WoutT(), 0, nullptr, tile, bid, nb);
  transpose_cvt(p.peer_wq, 1024, 2048, 0, 1024, p.WpqT(), 0, nullptr, tile, bid, nb);
  transpose_cvt(p.wgate, 2048, 2048, 0, 2048, p.WgT(), 0, nullptr, tile, bid, nb);
  transpose_cvt(p.wproj, 2048, 256, 0, 2048, p.WpT(), 0, nullptr, tile, bid, nb);
  const size_t gtid = (size_t)bid * NT + tid, gth = (size_t)nb * NT;
  for (size_t i = gtid; i < (size_t)192 * 2048 / 8; i += gth) ((u32x4*)(p.WinT() + (size_t)4160 * 2048))[i] = u32x4{0, 0, 0, 0};
  cvt_bf16(p.p, p.pb(), (size_t)T_ * 256 / 8, gtid, gth);
  for (size_t i = gtid; i < (size_t)T_ * 64 / 4; i += gth) ((float4*)p.krsum())[i] = make_float4(0.f, 0.f, 0.f, 0.f);
  for (size_t i = gtid; i < (size_t)2 * T_ / 4; i += gth) ((float4*)p.rss())[i] = make_float4(0.f, 0.f, 0.f, 0.f);
  for (size_t i = gtid; i < (size_t)2 * 65536; i += gth) {
    const float v = i < 65536 ? p.keys1[i] : p.keys2[i - 65536];
    const u16 h = f2bf(v);
    p.keyH()[i] = h; p.keyL()[i] = f2bf(v - bf2f(h));
  }
  for (size_t i = gtid; i < (size_t)T_ * 32; i += gth) {
    const int t = (int)(i >> 5), fi = (int)(i & 31);
    const float invf = 1.0f / powf(10000.0f, (float)(2 * fi) / 64.0f);
    const float ang = (float)p.positions[t] * invf;
    const double rev = (double)ang * 0.15915494309189535;
    const float fr = (float)(rev - rint(rev));
    p.cs()[i] = make_float2(__builtin_amdgcn_cosf(fr), __builtin_amdgcn_sinf(fr));
  }
  __syncthreads();
  float* wff = (float*)smem;
  for (int i = tid; i < 2048 * 2; i += NT) {
    const int k = i >> 1, hf = i & 1;
    *(float4*)(wff + (k ^ ((k >> 3) & 7)) * 8 + hf * 4) = *(const float4*)(p.w_in + (size_t)k * INW + 4160 + hf * 4);
  }
  __syncthreads();
  for (int t = bid * 8 + wid; t < T_; t += nb * 8) {
    float a[8];
#pragma unroll
    for (int e = 0; e < 8; ++e) a[e] = 0.f;
#pragma unroll 1
    for (int i = 0; i < 4; ++i) {
      const int k = (i * 64 + lane) * 8;
      const f32x4 xa = __builtin_nontemporal_load((const f32x4*)(p.x + (size_t)t * D_ + k)), xb4 = __builtin_nontemporal_load((const f32x4*)(p.x + (size_t)t * D_ + k + 4));
      const float4 x0 = make_float4(xa[0], xa[1], xa[2], xa[3]), x1 = make_float4(xb4[0], xb4[1], xb4[2], xb4[3]);
      *(u32x4*)(p.xb() + (size_t)t * D_ + k) = u32x4{pk2(x0.x, x0.y), pk2(x0.z, x0.w), pk2(x1.x, x1.y), pk2(x1.z, x1.w)};
      const float xs[8] = {x0.x, x0.y, x0.z, x0.w, x1.x, x1.y, x1.z, x1.w};
#pragma unroll
      for (int j = 0; j < 8; ++j) {
        const int kr = (k + j) ^ (lane & 7);
        const float4 w0 = *(const float4*)(wff + kr * 8), w1 = *(const float4*)(wff + kr * 8 + 4);
        a[0] += xs[j] * w0.x; a[1] += xs[j] * w0.y; a[2] += xs[j] * w0.z; a[3] += xs[j] * w0.w;
        a[4] += xs[j] * w1.x; a[5] += xs[j] * w1.y; a[6] += xs[j] * w1.z; a[7] += xs[j] * w1.w;
      }
    }
    float mine = 0.f;
#pragma unroll
    for (int e = 0; e < 8; ++e) { const float s = wave_sum(a[e]); if (lane == e) mine = s; }
    if (lane < 8) {
      const float z = mine + p.b_forget[lane];
      const float ls = fminf(z, 0.f) - log1pf(expf(-fabsf(z)));
      const int b = t >> 12, s = t & 4095;
      p.logf()[((size_t)(b * 8 + lane)) * S_ + s] = ls;
    }
  }
}

template <int WM, int WN>
__device__ __forceinline__ void gemm_core(const u16* __restrict__ A, int lda, const u16* __restrict__ Bt, int ldb,
                                          int K, int brow, int bcol, char* smem, f32x4 (&acc)[4 / WM][4][4]) {
  constexpr int MS = 4 / WM, BN = 64 * WN, NBL = BN / 64;
  static_assert(WM * WN == 8, "8 waves");
  const int tid = TID(), wid = tid >> 6, lane = tid & 63, wr = wid / WN, wc = wid % WN, fr = lane & 15, fq = lane >> 4;
#pragma unroll
  for (int h = 0; h < MS; ++h)
#pragma unroll
    for (int m = 0; m < 4; ++m)
#pragma unroll
      for (int n = 0; n < 4; ++n) acc[h][m][n] = f32x4{0.f, 0.f, 0.f, 0.f};
  const int nk = K / 64;
  const int srow = tid >> 3, sch = (tid & 7) ^ ((tid >> 4) & 7);
  const u16* ga = A + (size_t)(brow + srow) * lda + sch * 8;
  const u16* gb = Bt + (size_t)(bcol + srow) * ldb + sch * 8;
  char* sdst = smem + tid * 16;
  auto issue = [&](int kt, int st) {
    char* sa = sdst + st * 65536;
#pragma unroll
    for (int i = 0; i < 4; ++i)
      __builtin_amdgcn_global_load_lds((const unsigned*)(ga + (size_t)i * 64 * lda + kt * 64), (unsigned*)(sa + i * 8192), 16, 0, 0);
#pragma unroll
    for (int i = 0; i < NBL; ++i)
      __builtin_amdgcn_global_load_lds((const unsigned*)(gb + (size_t)i * 64 * ldb + kt * 64), (unsigned*)(sa + 32768 + i * 8192), 16, 0, 0);
  };
  const int fx = (fr >> 1) & 7;
  const int arow = (wr * (256 / WM) + fr) * 128, brw = 32768 + (wc * 64 + fr) * 128;
  const int c0 = (fq ^ fx) * 16, c1 = ((4 + fq) ^ fx) * 16;
  asm volatile("s_waitcnt vmcnt(0)" ::: "memory");
  __syncthreads();
  issue(0, 0);
#pragma unroll 1
  for (int kt = 0; kt < nk; ++kt) {
    asm volatile("s_waitcnt vmcnt(0)" ::: "memory");
    __builtin_amdgcn_s_barrier();
    asm volatile("" ::: "memory");
    if (kt + 1 < nk) issue(kt + 1, (kt + 1) & 1);
    const char* sb = smem + (kt & 1) * 65536;
#pragma unroll
    for (int ks = 0; ks < 2; ++ks) {
      const int co = ks ? c1 : c0;
      bf16x8 Bl[4];
#pragma unroll
      for (int n = 0; n < 4; ++n) Bl[n] = *reinterpret_cast<const bf16x8*>(sb + brw + co + n * 2048);
#pragma unroll
      for (int h = 0; h < MS; ++h) {
        bf16x8 At[4];
#pragma unroll
        for (int m = 0; m < 4; ++m) At[m] = *reinterpret_cast<const bf16x8*>(sb + arow + co + (h * 4 + m) * 2048);
#pragma unroll
        for (int m = 0; m < 4; ++m)
#pragma unroll
          for (int n = 0; n < 4; ++n) acc[h][m][n] = __builtin_amdgcn_mfma_f32_16x16x32_bf16(At[m], Bl[n], acc[h][m][n], 0, 0, 0);
      }
    }
  }
}

template <int WM, int WN, class Epi>
__device__ __forceinline__ void gemm_tile(const u16* __restrict__ A, int lda, const u16* __restrict__ Bt, int ldb,
                                          int K, int brow, int bcol, char* smem, Epi epi) {
  constexpr int MS = 4 / WM;
  const int tid = TID(), wid = tid >> 6, lane = tid & 63, wr = wid / WN, wc = wid % WN, fr = lane & 15, fq = lane >> 4;
  f32x4 acc[MS][4][4];
  gemm_core<WM, WN>(A, lda, Bt, ldb, K, brow, bcol, smem, acc);
#pragma unroll
  for (int h = 0; h < MS; ++h) epi(acc[h], brow + wr * (256 / WM) + h * 64, bcol + wc * 64, fr, fq);
}

namespace pg8 {
#define PG8_LAS __attribute__((address_space(3)))
typedef unsigned short bf16_t;
constexpr int BM = 256, BK = 64, HALF = 128, HTB = HALF * BK * 2  , STAGE_BYTES = 8 * HTB, NXCD = 8, WGM = 8;

__host__ __device__ __forceinline__ int lds_byte(int r, int c) { const int st = (r >> 4) * 2 + (c >> 5), rr = r & 15, cc = c & 31, ob = rr * 64 + cc * 2; return st * 1024 + (ob ^ (((ob >> 9) & 1) << 5)); }
__host__ __device__ __forceinline__ void stage_rc(int b, int& R, int& C) { const int st = b / 1024, sb = b % 1024, swz = sb ^ (((sb >> 9) & 1) << 5); R = (st >> 1) * 16 + swz / 64; C = (st & 1) * 32 + (swz % 64) / 2; }
__host__ __device__ __forceinline__ int perm32(int rho) { const int n = rho >> 4, i = rho & 15; return 8 * (i >> 2) + 4 * n + (i & 3); }
struct Unit { int pm, pn; };
struct Gemm { const bf16_t* A; const bf16_t* Bt; int M, N, K; };
struct StaticOrder {
    int nM, nN, nwg, G, c;
    __device__ void init(int M, int N, int G_, int c_) { nM = M / BM; nN = N / BM; nwg = nM * nN; G = G_; c = c_; }
    __device__ bool next(int i, Unit& u) const {
        const long L = (long)i * G + c; if (L >= nwg) return false;
        int wgid = (int)L; { const int q = nwg / NXCD, r = nwg % NXCD, xcd = wgid % NXCD, off = wgid / NXCD; wgid = (xcd < r ? xcd * (q + 1) : r * (q + 1) + (xcd - r) * q) + off; }
        const int nig = WGM * nN, gid = wgid / nig, fm = gid * WGM, gsz = (nM - fm) < WGM ? (nM - fm) : WGM;
        u.pm = fm + ((wgid % nig) % gsz); u.pn = (wgid % nig) / gsz; return true;
    }
    __device__ __forceinline__ void a_ready(const Unit&) const {}
    __device__ __forceinline__ void done(const Unit&) const {}
};
template <class Epi, class Sched, bool STAMP = false>
__device__ __forceinline__ void gemm_phase(PG8_LAS unsigned char* lds, const Gemm g, const Sched& S, const Epi& E, unsigned long long* stamps) {
    const int tid = TID(), wid = __builtin_amdgcn_readfirstlane(tid >> 6), lane = tid & 63, wr = wid >> 2, wc = wid & 3, fr = lane & 15, fq = lane >> 4;
    const int K = g.K, nt = K / BK;
    int ts_lo = 0, ts_hi = 0, nts = 0; const unsigned long long rt_entry = STAMP ? (unsigned long long)wall_clock64() : 0ull;
#define PG8_STAMP() do { if (STAMP && wid == 0 && nts < 64) { const unsigned long long _c = (unsigned long long)clock64(); \
        ts_lo = (lane == nts) ? (int)(unsigned)_c : ts_lo; ts_hi = (lane == nts) ? (int)(unsigned)(_c >> 32) : ts_hi; ++nts; } } while (0)
    PG8_STAMP();
    unsigned voffA[2], voffB[2];
#pragma unroll
    for (int i = 0; i < 2; ++i) { int R, C; stage_rc(tid * 16 + i * 8192, R, C); const int Rb = Epi::PERM ? ((R & ~31) + perm32(R & 31)) : R;
        voffA[i] = (unsigned)(R * K + C) * 2u; voffB[i] = (unsigned)(Rb * K + C) * 2u; }
    const size_t kstep = (size_t)(BK * 2);
    const size_t hstep = (size_t)HALF * K * 2;
    const size_t tstep = 2 * hstep;
    const unsigned ldsw = (unsigned)wid * 1024u;
    const int aoff = lds_byte(wr * 64 + fr, fq * 8), boff = lds_byte(wc * 32 + fr, fq * 8);
#define PG8_SA(b, h) (((b) * 2 + (h)) * HTB)
#define PG8_SB(b, h) ((4 + (b) * 2 + (h)) * HTB)
#define PG8_STAGE(bufoff, gbase, voff) do { _Pragma("unroll") for (int _i = 0; _i < 2; ++_i) \
        __builtin_amdgcn_global_load_lds((const unsigned*)((const char*)(gbase) + (voff)[_i]), (PG8_LAS unsigned*)(lds + (bufoff) + ldsw + _i * 8192), 16, 0, 0); } while (0)
#define PG8_LDA(dst, b, h) do { _Pragma("unroll") for (int m = 0; m < 4; ++m) _Pragma("unroll") for (int k = 0; k < 2; ++k) dst[m][k] = *(const PG8_LAS bf16x8*)(lds + PG8_SA(b, h) + aoff + m * 2048 + k * 1024); } while (0)
#define PG8_LDB(dst, b, h) do { _Pragma("unroll") for (int n = 0; n < 2; ++n) _Pragma("unroll") for (int k = 0; k < 2; ++k) dst[n][k] = *(const PG8_LAS bf16x8*)(lds + PG8_SB(b, h) + boff + n * 2048 + k * 1024); } while (0)
#define PG8_MMA(ai, bj, At, Bt) do { __builtin_amdgcn_s_setprio(1); _Pragma("unroll") for (int m = 0; m < 4; ++m) _Pragma("unroll") for (int n = 0; n < 2; ++n) _Pragma("unroll") for (int k = 0; k < 2; ++k) \
        acc[ai][bj][m][n] = __builtin_amdgcn_mfma_f32_16x16x32_bf16(Bt[n][k], At[m][k], acc[ai][bj][m][n], 0, 0, 0); __builtin_amdgcn_s_setprio(0); } while (0)
#define PG8_WAIT_V(n) asm volatile("s_waitcnt vmcnt(" #n ")" ::: "memory")
#define PG8_WAIT_L(n) asm volatile("s_waitcnt lgkmcnt(" #n ")" ::: "memory")
#define PG8_BAR __builtin_amdgcn_s_barrier()
#define PG8_SCHED __builtin_amdgcn_sched_barrier(0)
    Unit cur, nxt; int ui = 0;
    if (!S.next(0, cur)) return;
    f32x4 acc[2][2][4][2];
#pragma unroll
    for (int a = 0; a < 2; ++a)
#pragma unroll
        for (int b = 0; b < 2; ++b)
#pragma unroll
            for (int m = 0; m < 4; ++m)
#pragma unroll
                for (int n = 0; n < 2; ++n) acc[a][b][m][n] = (f32x4){0.f, 0.f, 0.f, 0.f};
    bf16x8 At[4][2], B0[2][2], B1[2][2];
    const char* cA = (const char*)g.A + (size_t)cur.pm * tstep; const char* cB = (const char*)g.Bt + (size_t)cur.pn * tstep;
    S.a_ready(cur);
    PG8_STAGE(PG8_SB(0, 0), cB, voffB); PG8_STAGE(PG8_SA(0, 0), cA, voffA); PG8_STAGE(PG8_SB(0, 1), cB + hstep, voffB); PG8_STAGE(PG8_SA(0, 1), cA + hstep, voffA);
    if (wr == 1) PG8_BAR;
    PG8_WAIT_V(4); PG8_BAR;
    PG8_STAGE(PG8_SB(1, 0), cB + kstep, voffB); PG8_STAGE(PG8_SA(1, 0), cA + kstep, voffA); PG8_STAGE(PG8_SB(1, 1), cB + hstep + kstep, voffB);
    PG8_WAIT_V(6); PG8_BAR;
    PG8_STAMP();
    for (;;) {
        const bool has_next = S.next(ui + 1, nxt);
        const char* nA = has_next ? (const char*)g.A + (size_t)nxt.pm * tstep : cA; const char* nB = has_next ? (const char*)g.Bt + (size_t)nxt.pn * tstep : cB;
        for (int t = 0; t < nt; t += 2) {
            const bool last = (t == nt - 2);
            const char* a1 = cA + (size_t)(t + 1) * kstep;
            const char* a2 = last ? nA : cA + (size_t)(t + 2) * kstep; const char* b2 = last ? nB : cB + (size_t)(t + 2) * kstep;
            const char* a3 = a2 + kstep; const char* b3 = b2 + kstep;
            if (last && has_next) S.a_ready(nxt);
            PG8_LDB(B0, 0, 0); PG8_SCHED; PG8_LDA(At, 0, 0); PG8_STAGE(PG8_SA(1, 1), a1 + hstep, voffA);
            PG8_WAIT_L(8); PG8_BAR; PG8_WAIT_L(0); PG8_MMA(0, 0, At, B0); PG8_BAR; PG8_SCHED;
            PG8_LDB(B1, 0, 1); PG8_STAGE(PG8_SB(0, 0), b2, voffB);
            PG8_BAR; PG8_WAIT_L(0); PG8_MMA(0, 1, At, B1); PG8_BAR;
            PG8_LDA(At, 0, 1); PG8_STAGE(PG8_SA(0, 0), a2, voffA);
            PG8_BAR; PG8_WAIT_L(0); PG8_MMA(1, 0, At, B0); PG8_BAR; PG8_SCHED;
            PG8_STAGE(PG8_SB(0, 1), b2 + hstep, voffB);
            PG8_WAIT_V(6); PG8_BAR; PG8_MMA(1, 1, At, B1); PG8_BAR;
            PG8_LDB(B0, 1, 0); PG8_SCHED; PG8_LDA(At, 1, 0); PG8_STAGE(PG8_SA(0, 1), a2 + hstep, voffA);
            PG8_WAIT_L(8); PG8_BAR; PG8_WAIT_L(0); PG8_MMA(0, 0, At, B0); PG8_BAR; PG8_SCHED;
            PG8_LDB(B1, 1, 1); PG8_STAGE(PG8_SB(1, 0), b3, voffB);
            PG8_BAR; PG8_WAIT_L(0); PG8_MMA(0, 1, At, B1); PG8_BAR;
            PG8_LDA(At, 1, 1); PG8_STAGE(PG8_SA(1, 0), a3, voffA);
            PG8_BAR; PG8_WAIT_L(0); PG8_MMA(1, 0, At, B0); PG8_BAR; PG8_SCHED;
            PG8_STAGE(PG8_SB(1, 1), b3 + hstep, voffB);
            PG8_WAIT_V(6); PG8_BAR; PG8_MMA(1, 1, At, B1); PG8_BAR;
        }
        PG8_STAMP();
        if constexpr (!Epi::AFTER_DRAIN) { E(acc, cur, wr, wc, fr, fq); S.done(cur); }
        PG8_STAMP();
        if (!has_next) break;
#pragma unroll
        for (int a = 0; a < 2; ++a)
#pragma unroll
            for (int b = 0; b < 2; ++b)
#pragma unroll
                for (int m = 0; m < 4; ++m)
#pragma unroll
                    for (int n = 0; n < 2; ++n) acc[a][b][m][n] = (f32x4){0.f, 0.f, 0.f, 0.f};
        cur = nxt; cA = nA; cB = nB; ++ui;
    }
    PG8_WAIT_V(0);
    if (wr == 0) PG8_BAR;
    PG8_BAR;
    if constexpr (Epi::AFTER_DRAIN) { E.fused(acc, cur, wr, wc, fr, fq, lds, wid, lane); S.done(cur); }
    PG8_STAMP();
    if (STAMP && wid == 0) { stamps[lane] = lane < nts ? (((unsigned long long)(unsigned)ts_hi << 32) | (unsigned)ts_lo) : 0ull;
        if (lane == 62) stamps[62] = rt_entry; if (lane == 63) stamps[63] = (unsigned long long)wall_clock64(); }
#undef PG8_STAMP
#undef PG8_SA
#undef PG8_SB
#undef PG8_STAGE
#undef PG8_LDA
#undef PG8_LDB
#undef PG8_MMA
#undef PG8_WAIT_V
#undef PG8_WAIT_L
#undef PG8_BAR
#undef PG8_SCHED
}
}


__device__ __forceinline__ u32x4 pack8(const f32x4& a, const f32x4& b) { return u32x4{pk2(a[0], a[1]), pk2(a[2], a[3]), pk2(b[0], b[1]), pk2(b[2], b[3])}; }
__device__ __forceinline__ float sumsq4(const f32x4& a) { return (a[0] * a[0] + a[1] * a[1]) + (a[2] * a[2] + a[3] * a[3]); }
__device__ __forceinline__ void store_tr8(u16* vt, const f32x4& a, const f32x4& b) {
  vt[0] = f2bf(a[0]); vt[(size_t)S_] = f2bf(a[1]); vt[(size_t)2 * S_] = f2bf(a[2]); vt[(size_t)3 * S_] = f2bf(a[3]);
  vt[(size_t)4 * S_] = f2bf(b[0]); vt[(size_t)5 * S_] = f2bf(b[1]); vt[(size_t)6 * S_] = f2bf(b[2]); vt[(size_t)7 * S_] = f2bf(b[3]);
}
struct EpiInproj {
  static constexpr bool PERM = true, AFTER_DRAIN = false;
  u16 *cqb, *ckvb, *Qf, *Kf, *VfT; float* rss;
  __device__ __forceinline__ void operator()(const f32x4 (&acc)[2][2][4][2], const pg8::Unit& u, int wr, int wc, int fr, int fq) const {
    const int ct = u.pn * 256;
#pragma unroll
    for (int ai = 0; ai < 2; ++ai)
#pragma unroll
      for (int m = 0; m < 4; ++m) {
        const int row = u.pm * 256 + ai * 128 + wr * 64 + m * 16 + fr, b = row >> 12, s = row & 4095;
        float ss = 0.f;
#pragma unroll
        for (int bj = 0; bj < 2; ++bj) {
          const int c0 = ct + bj * 128 + wc * 32 + 8 * fq;
          const f32x4 v0 = acc[ai][bj][m][0], v1 = acc[ai][bj][m][1];
          if (ct < 1024) {
            u16* dst = ct < 512 ? cqb : ckvb;
            *(u32x4*)(dst + (size_t)row * 512 + (c0 & 511)) = pack8(v0, v1);
            ss += sumsq4(v0) + sumsq4(v1);
          } else if (ct < 3072) {
            int c = c0 - 1024; u16* dst = c < 1024 ? Qf : Kf; c &= 1023;
            *(u32x4*)(dst + ((size_t)(b * 8 + (c >> 7)) * S_ + s) * 128 + (c & 127)) = pack8(v0, v1);
          } else {
            const int c = c0 - 3072;
            store_tr8(VfT + ((size_t)(b * 8 + (c >> 7)) * 128 + (c & 127)) * S_ + s, v0, v1);
          }
        }
        if (ct < 1024) atomicAdd(rss + (ct < 512 ? 0 : T_) + row, ss);
        __builtin_amdgcn_sched_barrier(0);
      }
  }
};
struct EpiQup {
  static constexpr bool PERM = true, AFTER_DRAIN = false;
  u16* Qm; const float* rss;
  __device__ __forceinline__ void operator()(const f32x4 (&acc)[2][2][4][2], const pg8::Unit& u, int wr, int wc, int fr, int fq) const {
#pragma unroll
    for (int ai = 0; ai < 2; ++ai)
#pragma unroll
      for (int m = 0; m < 4; ++m) {
        const int row = u.pm * 256 + ai * 128 + wr * 64 + m * 16 + fr, b = row >> 12, s = row & 4095;
        const float rs = rsqrtf(rss[row] * (1.f / 512.f) + EPS);
#pragma unroll
        for (int bj = 0; bj < 2; ++bj) {
          const int c0 = u.pn * 256 + bj * 128 + wc * 32 + 8 * fq, hh = c0 / 192, off = c0 % 192;
          *(u32x4*)(Qm + ((size_t)(b * 8 + hh) * S_ + s) * 192 + off) = pack8(acc[ai][bj][m][0] * rs, acc[ai][bj][m][1] * rs);
        }
        __builtin_amdgcn_sched_barrier(0);
      }
  }
};
struct EpiKVup {
  static constexpr bool PERM = true, AFTER_DRAIN = false;
  u16 *Km, *VmT; const float* rss;
  __device__ __forceinline__ void operator()(const f32x4 (&acc)[2][2][4][2], const pg8::Unit& u, int wr, int wc, int fr, int fq) const {
    const int hh = u.pn;
#pragma unroll
    for (int ai = 0; ai < 2; ++ai)
#pragma unroll
      for (int m = 0; m < 4; ++m) {
        const int row = u.pm * 256 + ai * 128 + wr * 64 + m * 16 + fr, b = row >> 12, s = row & 4095;
        const float rs = rsqrtf(rss[T_ + row] * (1.f / 512.f) + EPS);
        const int off = wc * 32 + 8 * fq;
        *(u32x4*)(Km + ((size_t)(b * 8 + hh) * S_ + s) * 192 + off) = pack8(acc[ai][0][m][0] * rs, acc[ai][0][m][1] * rs);
        store_tr8(VmT + ((size_t)(b * 8 + hh) * 128 + off) * S_ + s, acc[ai][1][m][0] * rs, acc[ai][1][m][1] * rs);
        __builtin_amdgcn_sched_barrier(0);
      }
  }
};
struct EpiProj {
  static constexpr bool PERM = true, AFTER_DRAIN = false;
  u16* projb;
  __device__ __forceinline__ void operator()(const f32x4 (&acc)[2][2][4][2], const pg8::Unit& u, int wr, int wc, int fr, int fq) const {
#pragma unroll
    for (int ai = 0; ai < 2; ++ai)
#pragma unroll
      for (int m = 0; m < 4; ++m) {
        const int row = u.pm * 256 + ai * 128 + wr * 64 + m * 16 + fr;
#pragma unroll
        for (int bj = 0; bj < 2; ++bj)
          *(u32x4*)(projb + (size_t)row * D_ + u.pn * 256 + bj * 128 + wc * 32 + 8 * fq) = pack8(acc[ai][bj][m][0], acc[ai][bj][m][1]);
      }
  }
};
struct EpiOut {
  static constexpr bool PERM = false, AFTER_DRAIN = false;
  const float* x; float* y1;
  __device__ __forceinline__ void operator()(const f32x4 (&acc)[2][2][4][2], const pg8::Unit& u, int wr, int wc, int fr, int fq) const {
#pragma unroll
    for (int ai = 0; ai < 2; ++ai)
#pragma unroll
      for (int m = 0; m < 4; ++m) {
        const size_t rb = (size_t)(u.pm * 256 + ai * 128 + wr * 64 + m * 16 + fr) * D_ + u.pn * 256 + wc * 32 + 4 * fq;
#pragma unroll
        for (int bj = 0; bj < 2; ++bj)
#pragma unroll
          for (int n = 0; n < 2; ++n) {
            const size_t o = rb + bj * 128 + n * 16;
            const f32x4 xv = *(const f32x4*)(x + o);
            *(f32x4*)(y1 + o) = xv * ALPHA + acc[ai][bj][m][n];
          }
      }
  }
};
struct EpiGate {
  static constexpr bool PERM = false, AFTER_DRAIN = false;
  const float* h1; const u16* projb; float* out;
  __device__ __forceinline__ void operator()(const f32x4 (&acc)[2][2][4][2], const pg8::Unit& u, int wr, int wc, int fr, int fq) const {
#pragma unroll
    for (int ai = 0; ai < 2; ++ai)
#pragma unroll
      for (int m = 0; m < 4; ++m) {
        const size_t rb = (size_t)(u.pm * 256 + ai * 128 + wr * 64 + m * 16 + fr) * D_ + u.pn * 256 + wc * 32 + 4 * fq;
#pragma unroll
        for (int bj = 0; bj < 2; ++bj)
#pragma unroll
          for (int n = 0; n < 2; ++n) {
            const size_t o = rb + bj * 128 + n * 16;
            const f32x4 hv = *(const f32x4*)(h1 + o);
            const u32x2 pj = *(const u32x2*)(projb + o);
            const f32x4 a = acc[ai][bj][m][n];
            f32x4 r;
            r[0] = ALPHA * hv[0] + bflo(pj[0]) / (1.f + __expf(-a[0])); r[1] = ALPHA * hv[1] + bfhi(pj[0]) / (1.f + __expf(-a[1]));
            r[2] = ALPHA * hv[2] + bflo(pj[1]) / (1.f + __expf(-a[2])); r[3] = ALPHA * hv[3] + bfhi(pj[1]) / (1.f + __expf(-a[3]));
            *(f32x4*)(out + o) = r;
          }
      }
  }
};

__device__ __forceinline__ int vblock(int bid, int nb) { return (nb & 7) ? bid : (bid & 7) * (nb >> 3) + (bid >> 3); }
__device__ __forceinline__ void tile_rc(int t, int Nt, int& tm, int& tn) {
  const int g = t / (8 * Nt), q = t % (8 * Nt);
  tn = q >> 3; tm = g * 8 + (q & 7);
}

__device__ void phase_inproj(const Params& p, char* smem, int bid, int nb) {
  {
    EpiInproj E{p.cqb(), p.ckvb(), p.Qf(), p.Kf(), p.VfT(), p.rss()};
    pg8::Gemm g{p.xb(), p.WinT(), T_, 4096, D_};
    pg8::StaticOrder S; S.init(T_, 4096, nb, bid);
    pg8::gemm_phase((PG8_LAS unsigned char*)smem, g, S, E, nullptr);
  }
  for (int t = vblock(bid, nb); t < 256; t += nb) {
    const int tm = t >> 3, ks = t & 7;
    f32x4 acc[2][4][4];
    gemm_core<2, 4>(p.xb() + ks * 256, D_, p.WinT() + ks * 256, D_, 256, tm * 256, 4096, smem, acc);
    const int tid = TID(), wid = tid >> 6, lane = tid & 63, wr = wid >> 2, wc = wid & 3, fr = lane & 15, fq = lane >> 4;
    if (wc == 0) {
#pragma unroll
      for (int h = 0; h < 2; ++h) {
        float* kd = p.krsum() + (size_t)(tm * 256 + wr * 128 + h * 64 + fq * 4) * 64 + fr;
#pragma unroll
        for (int m = 0; m < 4; ++m)
#pragma unroll
          for (int n = 0; n < 4; ++n)
#pragma unroll
            for (int j = 0; j < 4; ++j) atomicAdd(kd + (m * 16 + j) * 64 + n * 16, acc[h][m][n][j]);
      }
    }
  }
}

__device__ void phase_up(const Params& p, char* smem, int bid, int nb) {
  PG8_LAS unsigned char* lds = (PG8_LAS unsigned char*)smem;
  {
    EpiQup E{p.Qm(), p.rss()};
    pg8::Gemm g{p.cqb(), p.WuqT(), T_, 1536, 512};
    pg8::StaticOrder S; S.init(T_, 1536, nb, (bid + nb - 64) % nb);
    pg8::gemm_phase(lds, g, S, E, nullptr);
  }
  {
    EpiKVup E{p.Km(), p.VmT(), p.rss()};
    pg8::Gemm g{p.ckvb(), p.WukvT(), T_, 2048, 512};
    pg8::StaticOrder S; S.init(T_, 2048, nb, bid);
    pg8::gemm_phase(lds, g, S, E, nullptr);
  }
  {
    EpiProj E{p.projb()};
    pg8::Gemm g{p.pb(), p.WpT(), T_, 2048, 256};
    pg8::StaticOrder S; S.init(T_, 2048, nb, bid);
    pg8::gemm_phase(lds, g, S, E, nullptr);
  }
  for (int t = bid; t < 48; t += nb) {
    if (t >= 16) {
      const int r0 = (t - 16) * 256, tid = TID();
#pragma unroll 1
      for (int it = 0; it < 16; ++it) {
        const int pr = it * NT + tid, row = r0 + (pr >> 5), i = pr & 31, b = row >> 12, s = row & 4095;
        const float x1 = p.krsum()[(size_t)row * 64 + i], x2 = p.krsum()[(size_t)row * 64 + 32 + i];
        const float2 cs = p.cs()[(size_t)row * 32 + i];
        const u16 o1 = f2bf(x1 * cs.x - x2 * cs.y), o2 = f2bf(x1 * cs.y + x2 * cs.x);
#pragma unroll
        for (int hh = 0; hh < 8; ++hh) {
          u16* kd = p.Km() + ((size_t)(b * 8 + hh) * S_ + s) * 192 + 128;
          kd[i] = o1; kd[32 + i] = o2;
        }
      }
    } else {
      const int seq = t;
      if ((TID() >> 6) == 0) {
        const int lane = TID() & 63;
        const float* src = p.logf() + (size_t)seq * S_ + lane * 64;
        float* dst = p.Fk() + (size_t)seq * S_ + lane * 64;
        float sum = 0.f;
#pragma unroll
        for (int i = 0; i < 16; ++i) { const float4 v = *(const float4*)(src + i * 4); sum += v.x; sum += v.y; sum += v.z; sum += v.w; }
        float inc = sum;
#pragma unroll
        for (int d = 1; d < 64; d <<= 1) { const float o = __shfl_up(inc, d, 64); if (lane >= d) inc += o; }
        float run = inc - sum;
#pragma unroll
        for (int i = 0; i < 16; ++i) {
          const float4 v = *(const float4*)(src + i * 4); float4 o;
          run += v.x; o.x = run; run += v.y; o.y = run; run += v.z; o.z = run; run += v.w; o.w = run;
          *(float4*)(dst + i * 4) = o;
        }
      }
    }
  }
}

#ifdef ATTN_NAIVE
__device__ void phase_attn_naive(const Params& p, char* smem, int bid, int nb) {
  const int tid = TID(), lane = tid & 63, wid = tid >> 6;
  const int per = NB_ * 8 * S_, nrows = 2 * per;
  for (int r = bid * 4 + wid; r < nrows; r += nb * 4) {
    const int type = r / per, rr = r % per, bh = rr / S_, s = rr % S_;
    const int DQ = type ? 128 : 192;
    const u16* Q = type ? p.Qf() + ((size_t)bh * S_ + s) * 128 : p.Qm() + ((size_t)bh * S_ + s) * 192;
    const u16* Kb = type ? p.Kf() + (size_t)bh * S_ * 128 : p.Km() + (size_t)bh * S_ * 192;
    const u16* VT = (type ? p.VfT() : p.VmT()) + (size_t)bh * 128 * S_;
    const float* F = p.Fk() + (size_t)bh * S_;
    const float scale = type ? 0.08838834764831845f : 0.07216878364870322f;
    float m = -1e30f, l = 0.f;
    float acc[128];
#pragma unroll
    for (int d = 0; d < 128; ++d) acc[d] = 0.f;
    const float fqv = type ? F[s] : 0.f;
    for (int k0 = 0; k0 <= s; k0 += 64) {
      const int key = k0 + lane; const bool valid = key <= s; const int keyc = valid ? key : s;
      const u16* kr = Kb + (size_t)keyc * DQ;
      float sc = 0.f;
      for (int d = 0; d < DQ; d += 8) {
        const u32x4 kv = *(const u32x4*)(kr + d), qv = *(const u32x4*)(Q + d);
#pragma unroll
        for (int w = 0; w < 4; ++w) sc += bflo(kv[w]) * bflo(qv[w]) + bfhi(kv[w]) * bfhi(qv[w]);
      }
      sc *= scale;
      if (type) sc += fqv - F[keyc];
      if (!valid) sc = -1e30f;
      const float mx = wave_max(sc), mn = fmaxf(m, mx), alpha = __expf(m - mn);
      const float pr = valid ? __expf(sc - mn) : 0.f;
      m = mn; l = l * alpha + pr;
#pragma unroll
      for (int d = 0; d < 128; ++d) acc[d] = acc[d] * alpha + pr * bf2f(VT[(size_t)d * S_ + keyc]);
    }
    const float inv = 1.f / wave_sum(l);
    float o0 = 0.f, o1 = 0.f;
#pragma unroll
    for (int d = 0; d < 128; ++d) {
      const float o = wave_sum(acc[d]) * inv;
      if (lane == (d & 63)) { if (d < 64) o0 = o; else o1 = o; }
    }
    const int b = bh >> 3, hh = bh & 7;
    u16* od = p.omix() + ((size_t)(b * S_ + s)) * 2048 + type * 1024 + hh * 128;
    od[lane] = f2bf(o0); od[64 + lane] = f2bf(o1);
  }
}

#endif
typedef float f32x16 __attribute__((ext_vector_type(16)));
template <int TYPE>
__device__ __forceinline__ void attn_item(const Params& p, char* smem, int bh, int qb) {
  constexpr int DQK = TYPE ? 128 : 192, NKS = DQK / 16, KSTR = DQK * 2 + 16, VSTR = 128;
  constexpr int KCH = DQK / 8, NKL = 64 * KCH / NT;
  constexpr float C2 = (TYPE ? 0.08838834764831845f : 0.07216878364870322f) * 1.4426950408889634f;
  char* sK = smem; char* sV = smem + 51200; float* sF = (float*)(smem + 51200 + 32768);
  const int tid = TID(), lane = tid & 63, wid = tid >> 6, c = lane & 31, hi = lane >> 5;
  const u16* Qb = (TYPE ? p.Qf() : p.Qm()) + (size_t)bh * S_ * DQK;
  const u16* Kb = (TYPE ? p.Kf() : p.Km()) + (size_t)bh * S_ * DQK;
  const u16* Vb = (TYPE ? p.VfT() : p.VmT()) + (size_t)bh * 128 * S_;
  const float* Fb = p.Fk() + (size_t)bh * S_;
  const int qrow = qb * 256 + wid * 32;
  bf16x8 qf[NKS];
#pragma unroll
  for (int ks = 0; ks < NKS; ++ks) qf[ks] = *(const bf16x8*)(Qb + (size_t)(qrow + c) * DQK + ks * 16 + hi * 8);
  if (TYPE == 0) {
    const float2* csr = p.cs() + (size_t)((bh >> 3) * S_ + qrow + c) * 32;
#pragma unroll
    for (int kk = 0; kk < 2; ++kk) {
      u32x4 x1 = *reinterpret_cast<u32x4*>(&qf[(NKS - 4) + kk]), x2 = *reinterpret_cast<u32x4*>(&qf[(NKS - 2) + kk]);
#pragma unroll
      for (int w = 0; w < 4; ++w) {
        const float4 cs = *(const float4*)(csr + 16 * kk + 8 * hi + 2 * w);
        const float a0 = bflo(x1[w]), a1 = bfhi(x1[w]), b0 = bflo(x2[w]), b1 = bfhi(x2[w]);
        x1[w] = pk2(a0 * cs.x - b0 * cs.y, a1 * cs.z - b1 * cs.w);
        x2[w] = pk2(a0 * cs.y + b0 * cs.x, a1 * cs.w + b1 * cs.z);
      }
      qf[(NKS - 4) + kk] = *reinterpret_cast<bf16x8*>(&x1); qf[(NKS - 2) + kk] = *reinterpret_cast<bf16x8*>(&x2);
    }
  }
  f32x16 o[4];
#pragma unroll
  for (int db = 0; db < 4; ++db)
#pragma unroll
    for (int r = 0; r < 16; ++r) o[db][r] = 0.f;
  float m = -1e30f, l = 0.f;
  const int ntiles = 4 * qb + 4;
  u32x4 kreg[NKL];
  float4 freg = make_float4(0.f, 0.f, 0.f, 0.f);
  const unsigned koff = (unsigned)tid * 16u;
  auto load_k = [&](int kt) {
    const char* kb = (const char*)(Kb + (size_t)kt * 64 * DQK);
#pragma unroll
    for (int i = 0; i < NKL; ++i) kreg[i] = *(const u32x4*)(kb + i * 8192 + koff);
    if (TYPE) { if (tid < 16) freg = *(const float4*)(Fb + kt * 64 + tid * 4); }
  };
  const unsigned voff = (unsigned)((((tid >> 3) * S_) + (((tid & 7) ^ ((tid >> 4) & 7)) * 8)) * 2);
  auto load_v = [&](int kt) {
    const char* vb = (const char*)(Vb + kt * 64);
    char* dst = sV + (kt & 1) * 16384 + tid * 16;
#pragma unroll
    for (int i = 0; i < 2; ++i)
      __builtin_amdgcn_global_load_lds((const unsigned*)(vb + (size_t)i * 64 * S_ * 2 + voff), (unsigned*)(dst + i * 8192), 16, 0, 0);
  };
  auto store_tile = [&](int kt) {
    char* sKw = sK + (kt & 1) * 25600;
#pragma unroll
    for (int i = 0; i < NKL; ++i) { const int ch = tid + NT * i, key = ch / KCH, dc = ch % KCH; *(u32x4*)(sKw + key * KSTR + dc * 16) = kreg[i]; }
    if (TYPE) { if (tid < 16) { const float L2E = 1.4426950408889634f; *(float4*)(sF + (kt & 1) * 64 + tid * 4) = make_float4(freg.x * L2E, freg.y * L2E, freg.z * L2E, freg.w * L2E); } }
  };
  const int krow = (c & 19) | ((c & 4) << 1) | ((c & 8) >> 1);
  const char* ka0 = sK + krow * KSTR + hi * 16;
  const char* ka1 = ka0 + 32 * KSTR;
  const int vx = (c >> 1) & 7;
  int vo[2][2];
#pragma unroll
  for (int kb = 0; kb < 2; ++kb)
#pragma unroll
    for (int s2 = 0; s2 < 2; ++s2) vo[kb][s2] = c * VSTR + (((4 * kb + 2 * s2 + hi) ^ vx) * 16);
  load_k(0); load_v(0);
  store_tile(0);
#pragma unroll 1
  for (int kt = 0; kt < ntiles; ++kt) {
    asm volatile("s_waitcnt vmcnt(0) lgkmcnt(0)" ::: "memory");
    __syncthreads();
    if (kt + 1 < ntiles) { load_k(kt + 1); load_v(kt + 1); }
    const int k0 = kt * 64;
    const char* sVc = sV + (kt & 1) * 16384;
    const int kbo = (kt & 1) * 25600;
    const float* sFc = sF + (kt & 1) * 64;
    if (k0 <= qrow + 31) {
      f32x16 p0, p1;
#pragma unroll
      for (int r = 0; r < 16; ++r) { p0[r] = 0.f; p1[r] = 0.f; }
#pragma unroll
      for (int ks = 0; ks < NKS; ++ks) {
        const bf16x8 a0 = *(const bf16x8*)(ka0 + kbo + ks * 32), a1 = *(const bf16x8*)(ka1 + kbo + ks * 32);
        p0 = __builtin_amdgcn_mfma_f32_32x32x16_bf16(a0, qf[ks], p0, 0, 0, 0);
        p1 = __builtin_amdgcn_mfma_f32_32x32x16_bf16(a1, qf[ks], p1, 0, 0, 0);
      }
      if (TYPE) {
#pragma unroll
        for (int s = 0; s < 2; ++s) {
          const float4 f0 = *(const float4*)(sFc + 16 * s + 8 * hi), f1 = *(const float4*)(sFc + 16 * s + 8 * hi + 4);
          const float4 g0 = *(const float4*)(sFc + 32 + 16 * s + 8 * hi), g1 = *(const float4*)(sFc + 32 + 16 * s + 8 * hi + 4);
          p0[8 * s + 0] = p0[8 * s + 0] * C2 - f0.x; p0[8 * s + 1] = p0[8 * s + 1] * C2 - f0.y; p0[8 * s + 2] = p0[8 * s + 2] * C2 - f0.z; p0[8 * s + 3] = p0[8 * s + 3] * C2 - f0.w;
          p0[8 * s + 4] = p0[8 * s + 4] * C2 - f1.x; p0[8 * s + 5] = p0[8 * s + 5] * C2 - f1.y; p0[8 * s + 6] = p0[8 * s + 6] * C2 - f1.z; p0[8 * s + 7] = p0[8 * s + 7] * C2 - f1.w;
          p1[8 * s + 0] = p1[8 * s + 0] * C2 - g0.x; p1[8 * s + 1] = p1[8 * s + 1] * C2 - g0.y; p1[8 * s + 2] = p1[8 * s + 2] * C2 - g0.z; p1[8 * s + 3] = p1[8 * s + 3] * C2 - g0.w;
          p1[8 * s + 4] = p1[8 * s + 4] * C2 - g1.x; p1[8 * s + 5] = p1[8 * s + 5] * C2 - g1.y; p1[8 * s + 6] = p1[8 * s + 6] * C2 - g1.z; p1[8 * s + 7] = p1[8 * s + 7] * C2 - g1.w;
        }
      }
      if (k0 + 63 > qrow) {
        const int lim = qrow + c - k0 - 8 * hi;
        const float NEG = -__builtin_inff();
#pragma unroll
        for (int r = 0; r < 16; ++r) {
          const int kb = 16 * (r >> 3) + (r & 7);
          if (kb > lim) p0[r] = NEG;
          if (kb + 32 > lim) p1[r] = NEG;
        }
      }
      float mx = p0[0];
#pragma unroll
      for (int r = 1; r < 16; ++r) mx = fmaxf(mx, p0[r]);
#pragma unroll
      for (int r = 0; r < 16; ++r) mx = fmaxf(mx, p1[r]);
      {
        auto rr = __builtin_amdgcn_permlane32_swap(__float_as_uint(mx), __float_as_uint(mx), false, false);
        mx = fmaxf(__uint_as_float(rr[0]), __uint_as_float(rr[1]));
      }
      if (!TYPE) mx *= C2;
      constexpr float THR = TYPE ? 96.f : 16.f;
      float mn = m, alpha = 1.f;
      if (!__all(mx - m <= THR)) {
        mn = fmaxf(m, mx);
        alpha = __builtin_amdgcn_exp2f(m - mn);
        m = mn;
#pragma unroll
        for (int db = 0; db < 4; ++db)
#pragma unroll
          for (int r = 0; r < 16; ++r) o[db][r] *= alpha;
      }
      float ps = 0.f;
      if (TYPE) {
#pragma unroll
        for (int r = 0; r < 16; ++r) { p0[r] = __builtin_amdgcn_exp2f(p0[r] - mn); p1[r] = __builtin_amdgcn_exp2f(p1[r] - mn); ps += p0[r] + p1[r]; }
      } else {
#pragma unroll
        for (int r = 0; r < 16; ++r) { p0[r] = __builtin_amdgcn_exp2f(fmaf(p0[r], C2, -mn)); p1[r] = __builtin_amdgcn_exp2f(fmaf(p1[r], C2, -mn)); ps += p0[r] + p1[r]; }
      }
      l = l * alpha + ps;
      bf16x8 pa[2][2];
#pragma unroll
      for (int s = 0; s < 2; ++s) {
        u32x4 w0 = {pk2(p0[8 * s + 0], p0[8 * s + 1]), pk2(p0[8 * s + 2], p0[8 * s + 3]), pk2(p0[8 * s + 4], p0[8 * s + 5]), pk2(p0[8 * s + 6], p0[8 * s + 7])};
        u32x4 w1 = {pk2(p1[8 * s + 0], p1[8 * s + 1]), pk2(p1[8 * s + 2], p1[8 * s + 3]), pk2(p1[8 * s + 4], p1[8 * s + 5]), pk2(p1[8 * s + 6], p1[8 * s + 7])};
        pa[0][s] = *reinterpret_cast<bf16x8*>(&w0); pa[1][s] = *reinterpret_cast<bf16x8*>(&w1);
      }
#pragma unroll
      for (int db = 0; db < 4; ++db)
#pragma unroll
        for (int kb = 0; kb < 2; ++kb)
#pragma unroll
          for (int s = 0; s < 2; ++s) {
            const bf16x8 av = *(const bf16x8*)(sVc + db * 32 * VSTR + vo[kb][s]);
            o[db] = __builtin_amdgcn_mfma_f32_32x32x16_bf16(av, pa[kb][s], o[db], 0, 0, 0);
          }
    }
    if (kt + 1 < ntiles) store_tile(kt + 1);
  }
  {
    auto rr = __builtin_amdgcn_permlane32_swap(__float_as_uint(l), __float_as_uint(l), false, false);
    const float inv = 1.f / (__uint_as_float(rr[0]) + __uint_as_float(rr[1]));
    const int b = bh >> 3, hh = bh & 7;
    u16* od = p.omix() + ((size_t)(b * S_ + qrow + c)) * 2048 + TYPE * 1024 + hh * 128 + 4 * hi;
#pragma unroll
    for (int db = 0; db < 4; ++db)
#pragma unroll
      for (int g = 0; g < 4; ++g)
        *(u32x2*)(od + 32 * db + 8 * g) = u32x2{pk2(o[db][4 * g] * inv, o[db][4 * g + 1] * inv), pk2(o[db][4 * g + 2] * inv, o[db][4 * g + 3] * inv)};
  }
}

__device__ void phase_attn(const Params& p, char* smem, int bid, int nb) {
  int* sItem = (int*)(smem + 90000);
  const int x = bid & 7;
  unsigned* q = p.ctr() + 32 + x;
  for (;;) {
    __syncthreads();
    if (TID() == 0) *sItem = (int)atomicAdd(q, 1u);
    __syncthreads();
    const int item = *sItem;
    if (item >= 64) break;
    const int qb = 15 - (item >> 2), r = item & 3, type = r >> 1, bh = x + 8 * (r & 1);
    if (type == 0) attn_item<0>(p, smem, bh, qb); else attn_item<1>(p, smem, bh, qb);
  }
  unsigned* qc = p.ctr() + 48;
  for (;;) {
    __syncthreads();
    if (TID() == 0) *sItem = (int)atomicAdd(qc, 1u);
    __syncthreads();
    const int chunk = *sItem;
    if (chunk >= 512) break;
    quant_chunk(p, chunk);
  }
}

__device__ void phase_outproj(const Params& p, char* smem, int bid, int nb) {
  EpiOut E{p.x, p.y1()};
  pg8::Gemm g{p.omix(), p.WoutT(), T_, D_, D_};
  pg8::StaticOrder S; S.init(T_, D_, nb, bid);
  pg8::gemm_phase((PG8_LAS unsigned char*)smem, g, S, E, nullptr);
}

__device__ void phase_ln1(const Params& p, int bid, int nb) {
  const int lane = TID() & 63, wid = TID() >> 6;
  for (int t = bid * 8 + wid; t < T_; t += nb * 8) {
    float* row = p.y1() + (size_t)t * D_;
    float4 v[8];
    float sum = 0.f;
#pragma unroll
    for (int i = 0; i < 8; ++i) { v[i] = *(const float4*)(row + (i * 64 + lane) * 4); sum += (v[i].x + v[i].y) + (v[i].z + v[i].w); }
    const float mu = wave_sum(sum) * (1.f / D_);
    float sq = 0.f;
#pragma unroll
    for (int i = 0; i < 8; ++i) {
      v[i].x -= mu; v[i].y -= mu; v[i].z -= mu; v[i].w -= mu;
      sq += (v[i].x * v[i].x + v[i].y * v[i].y) + (v[i].z * v[i].z + v[i].w * v[i].w);
    }
    const float rstd = rsqrtf(wave_sum(sq) * (1.f / D_) + EPS);
#pragma unroll
    for (int i = 0; i < 8; ++i) {
      const int c = (i * 64 + lane) * 4;
      const float4 g = *(const float4*)(p.ln1_g + c), bb = *(const float4*)(p.ln1_b + c);
      float4 o; o.x = v[i].x * rstd * g.x + bb.x; o.y = v[i].y * rstd * g.y + bb.y; o.z = v[i].z * rstd * g.z + bb.z; o.w = v[i].w * rstd * g.w + bb.w;
      *(float4*)(row + c) = o;
      *(u32x2*)(p.h1b() + (size_t)t * D_ + c) = u32x2{pk2(o.x, o.y), pk2(o.z, o.w)};
    }
  }
}

__device__ __forceinline__ void ins16(unsigned (&t)[16], unsigned x) {
#pragma unroll
  for (int i = 0; i < 16; ++i) { const unsigned hi = t[i] > x ? t[i] : x; x = t[i] > x ? x : t[i]; t[i] = hi; }
}
__device__ __forceinline__ void ins16p(unsigned (&ck)[16], int (&ce)[16], unsigned x, int xe) {
#pragma unroll
  for (int i = 0; i < 16; ++i) {
    const bool sw = x > ck[i];
    const unsigned nk = sw ? x : ck[i], nx = sw ? ck[i] : x;
    const int ne = sw ? xe : ce[i], nxe = sw ? ce[i] : xe;
    ck[i] = nk; x = nx; ce[i] = ne; xe = nxe;
  }
}
__device__ __forceinline__ float unordkey(unsigned k) { return __uint_as_float((k & 0x80000000u) ? (k & 0x7fffffffu) : ~k); }

__device__ __forceinline__ void sort16_asc(unsigned (&s)[16]) {
#pragma unroll
  for (int k = 2; k <= 16; k <<= 1)
#pragma unroll
    for (int j = k >> 1; j > 0; j >>= 1)
#pragma unroll
      for (int i = 0; i < 16; ++i) {
        const int l = i ^ j;
        if (l > i) {
          const unsigned lo = s[i] < s[l] ? s[i] : s[l], hi = s[i] < s[l] ? s[l] : s[i];
          if ((i & k) == 0) { s[i] = lo; s[l] = hi; } else { s[i] = hi; s[l] = lo; }
        }
      }
}
__device__ __forceinline__ void merge16(unsigned (&t)[16], const unsigned (&s)[16]) {
#pragma unroll
  for (int i = 0; i < 16; ++i) t[i] = t[i] > s[i] ? t[i] : s[i];
#pragma unroll
  for (int j = 8; j > 0; j >>= 1)
#pragma unroll
    for (int i = 0; i < 16; ++i) {
      const int l = i ^ j;
      if (l > i) { const unsigned hi = t[i] > t[l] ? t[i] : t[l], lo = t[i] > t[l] ? t[l] : t[i]; t[i] = hi; t[l] = lo; }
    }
}

__device__ __forceinline__ void score_block(const u16* kH, const u16* kL, const bf16x8 (&qh)[4], const bf16x8 (&ql)[4], int hi, unsigned (&t)[16]) {
#pragma unroll
  for (int i = 0; i < 16; ++i) t[i] = 0u;
#pragma unroll 1
  for (int kb = 0; kb < 4; ++kb) {
    f32x16 sc;
#pragma unroll
    for (int r = 0; r < 16; ++r) sc[r] = 0.f;
#pragma unroll
    for (int ks = 0; ks < 4; ++ks) {
      const bf16x8 ah = *(const bf16x8*)(kH + kb * 32 * 64 + ks * 16), al = *(const bf16x8*)(kL + kb * 32 * 64 + ks * 16);
      sc = __builtin_amdgcn_mfma_f32_32x32x16_bf16(ah, qh[ks], sc, 0, 0, 0);
      sc = __builtin_amdgcn_mfma_f32_32x32x16_bf16(ah, ql[ks], sc, 0, 0, 0);
      sc = __builtin_amdgcn_mfma_f32_32x32x16_bf16(al, qh[ks], sc, 0, 0, 0);
    }
    const unsigned base = (unsigned)(127 - 32 * kb) - 4u * (unsigned)hi;
    unsigned s[16];
#pragma unroll
    for (int r = 0; r < 16; ++r) s[r] = (ordkey(sc[r]) & ~127u) | (base - (unsigned)((r & 3) + 8 * (r >> 2)));
    sort16_asc(s);
    merge16(t, s);
  }
  unsigned other[16];
#pragma unroll
  for (int i = 0; i < 16; ++i) {
    auto rr = __builtin_amdgcn_permlane32_swap(t[15 - i], t[15 - i], false, false);
    other[i] = hi ? rr[0] : rr[1];
  }
  merge16(t, other);
}

__device__ __forceinline__ void route_tile(const Params& p, char* smem, f32x4 (&acc)[4][4], int tm, int h) {
  const int tid = TID(), wid = tid >> 6, lane = tid & 63, wr = wid >> 1, wc = wid & 1, fr = lane & 15, fq = lane >> 4;
  __syncthreads();
  float* Qw = (float*)smem + wid * (64 * 65);
#pragma unroll
  for (int m = 0; m < 4; ++m)
#pragma unroll
    for (int n = 0; n < 4; ++n)
#pragma unroll
      for (int j = 0; j < 4; ++j) Qw[(m * 16 + fq * 4 + j) * 65 + n * 16 + fr] = acc[m][n][j];
  asm volatile("s_waitcnt lgkmcnt(0)" ::: "memory");
  const int c = lane & 31, hi = lane >> 5;
  bf16x8 qh[2][4], ql[2][4];
#pragma unroll
  for (int tb = 0; tb < 2; ++tb)
#pragma unroll
    for (int ks = 0; ks < 4; ++ks) {
      float v[8]; unsigned wh[4], wl[4];
#pragma unroll
      for (int j = 0; j < 8; ++j) v[j] = Qw[(tb * 32 + c) * 65 + 16 * ks + 8 * hi + j];
#pragma unroll
      for (int w = 0; w < 4; ++w) {
        wh[w] = pk2(v[2 * w], v[2 * w + 1]);
        wl[w] = pk2(v[2 * w] - bflo(wh[w]), v[2 * w + 1] - bfhi(wh[w]));
      }
      u32x4 uh = {wh[0], wh[1], wh[2], wh[3]}, ul = {wl[0], wl[1], wl[2], wl[3]};
      qh[tb][ks] = *reinterpret_cast<bf16x8*>(&uh); ql[tb][ks] = *reinterpret_cast<bf16x8*>(&ul);
    }
  const u16* kH = p.keyH() + ((size_t)(wc * 8 + h) * 128 + c) * 64 + 8 * hi;
  const u16* kL = p.keyL() + ((size_t)(wc * 8 + h) * 128 + c) * 64 + 8 * hi;
  unsigned t0[16], t1[16];
  score_block(kH, kL, qh[0], ql[0], hi, t0);
  score_block(kH, kL, qh[1], ql[1], hi, t1);
  unsigned t[16];
#pragma unroll
  for (int i = 0; i < 16; ++i) t[i] = hi ? t1[i] : t0[i];
  __syncthreads();
  unsigned* L = (unsigned*)smem;
#pragma unroll
  for (int r = 0; r < 16; ++r) L[(wc * 16 + r) * 256 + wr * 64 + lane] = t[r];
  __syncthreads();
  if (wid < 4) {
    const int tok = wid * 64 + lane;
    unsigned ck[16]; int ce[16];
#pragma unroll
    for (int i = 0; i < 16; ++i) { ck[i] = 0u; ce[i] = 0; }
#pragma unroll 1
    for (int a = 0; a < 16; ++a) {
      const unsigned ka = L[a * 256 + tok];
      const int i1a = (127 - (int)(ka & 127u)) * 128; const float v1a = unordkey(ka & ~127u);
      const int nbm1 = (int)((0x1112347FULL >> (4 * a)) & 15ULL);
#pragma unroll 1
      for (int b = 0; b <= nbm1; ++b) {
        const unsigned kb = L[(16 + b) * 256 + tok];
        const int i2b = 127 - (int)(kb & 127u); const float v2b = unordkey(kb & ~127u);
        ins16p(ck, ce, ordkey(v1a + v2b), i1a + i2b);
      }
    }
    float ex[16], sum = 0.f;
    const float mx = unordkey(ck[0]);
#pragma unroll
    for (int r = 0; r < 16; ++r) { ex[r] = __expf(unordkey(ck[r]) - mx); sum += ex[r]; }
    const float inv = 1.f / sum;
    const size_t o = ((size_t)(tm * 256 + tok) * 8 + h) * 16;
    int* ed = p.eidxG() + o; float* gd = p.gateG() + o;
#pragma unroll
    for (int r = 0; r < 16; r += 4) {
      *(int4*)(ed + r) = make_int4(ce[r], ce[r + 1], ce[r + 2], ce[r + 3]);
      *(float4*)(gd + r) = make_float4(ex[r] * inv, ex[r + 1] * inv, ex[r + 2] * inv, ex[r + 3] * inv);
    }
  }
}

__device__ void phase_mid(const Params& p, char* smem, int bid, int nb) {
  {
    EpiGate E{p.y1(), p.projb(), p.out};
    pg8::Gemm g{p.h1b(), p.WgT(), T_, D_, D_};
    pg8::StaticOrder S; S.init(T_, D_, nb, bid);
    pg8::gemm_phase((PG8_LAS unsigned char*)smem, g, S, E, nullptr);
  }
  for (int t = vblock(bid, nb); t < 32 * 8; t += nb) {
    int tm, tn; tile_rc(t, 8, tm, tn);
    f32x4 acc[1][4][4];
    gemm_core<4, 2>(p.h1b(), D_, p.WpqT(), D_, D_, tm * 256, tn * 128, smem, acc);
    route_tile(p, smem, acc[0], tm, tn);
  }
}

__device__ __forceinline__ float gelu_exact(float a) {
  const float x = fabsf(a) * 0.7071067811865476f;
  const float t = __builtin_amdgcn_rcpf(1.f + 0.3275911f * x);
  const float poly = t * (0.254829592f + t * (-0.284496736f + t * (1.421413741f + t * (-1.453152027f + t * 1.061405429f))));
  const float er = 1.f - poly * __expf(-x * x);
  return 0.5f * a * (1.f + (a < 0.f ? -er : er));
}

template <int NPER, int IDXMASK>
__device__ __forceinline__ int top16(unsigned (&k)[NPER], int lane) {
  int mine = 0;
#pragma unroll 1
  for (int r = 0; r < 16; ++r) {
    unsigned loc = k[0];
#pragma unroll
    for (int i = 1; i < NPER; ++i) loc = loc > k[i] ? loc : k[i];
    const unsigned best = wave_umax(loc);
#pragma unroll
    for (int i = 0; i < NPER; ++i) if (k[i] == best) k[i] = 0u;
    if (lane == r) mine = IDXMASK - (int)(best & (unsigned)IDXMASK);
  }
  return mine;
}

__device__ void phase_peer(const Params& p, char* smem, int bid, int nb) {
  const int tid = TID(), lane = tid & 63, wid = tid >> 6;
  float* qs = (float*)smem;
  float* sc = (float*)(smem + 8192);
  int* eidx = (int*)(smem + 24576);
  float* gts = (float*)(smem + 40960);
  for (int it = bid; it < T_ / 32; it += nb) {
    const int t0 = it * 32;
#pragma unroll
    for (int i = 0; i < 2; ++i) {
      const int idx = (i * NT + tid) * 4;
      *(int4*)(eidx + idx) = *(const int4*)(p.eidxG() + (size_t)t0 * 128 + idx);
      *(float4*)(gts + idx) = *(const float4*)(p.gateG() + (size_t)t0 * 128 + idx);
    }
    __syncthreads();
    for (int ti = 0; ti < 4; ++ti) {
      const int tok = wid * 4 + ti, t = t0 + tok;
      typedef float f32x32 __attribute__((ext_vector_type(32)));
      typedef unsigned u32x6 __attribute__((ext_vector_type(6)));
      float hreg[32];
      f32x32 o;
#pragma unroll
      for (int q = 0; q < 8; ++q) {
        const u32x2 hv = *(const u32x2*)(p.h1b() + (size_t)t * D_ + (q * 64 + lane) * 4);
        hreg[q * 4] = bflo(hv[0]); hreg[q * 4 + 1] = bfhi(hv[0]); hreg[q * 4 + 2] = bflo(hv[1]); hreg[q * 4 + 3] = bfhi(hv[1]);
      }
#pragma unroll
      for (int i = 0; i < 32; ++i) o[i] = 0.f;
      const float* Us = p.Us(); const float* Vs = p.Vs();
      const unsigned char* Uq = p.Uq() + lane * 24;
      const int* ep = eidx + tok * 128; const float* gp = gts + tok * 128;
      u32x4 uA4[2], vA4[2], uB4[2], vB4[2]; u32x2 uA2[2], vA2[2], uB2[2], vB2[2];
      float gA[2], suA[2], svA[2], gB[2], suB[2], svB[2];
#define PEER_LOAD(U4, U2, V4, V2, G, SU, SV, J0)                                                        \
      _Pragma("unroll") for (int jj = 0; jj < 2; ++jj) {                                                \
        const int e = __builtin_amdgcn_readfirstlane(ep[(J0) + jj]);                                    \
        G[jj] = gp[(J0) + jj]; SU[jj] = Us[e]; SV[jj] = Vs[e];                                          \
        const unsigned char* up = Uq + (size_t)e * 3072; const unsigned char* vp = up + 1536;           \
        U2[jj] = *(const u32x2*)(up); U4[jj] = *(const u32x4*)(up + 8);                                 \
        V2[jj] = *(const u32x2*)(vp); V4[jj] = *(const u32x4*)(vp + 8);                                 \
      }
#define PEER_COMPUTE(U4, U2, V4, V2, G, SU, SV)                                                         \
      _Pragma("unroll") for (int jj = 0; jj < 2; ++jj) {                                                \
        const u32x6 uw = {U2[jj][0], U2[jj][1], U4[jj][0], U4[jj][1], U4[jj][2], U4[jj][3]};            \
        const f32x32 ud = __builtin_amdgcn_cvt_scalef32_pk32_f32_fp6(uw, 1.0f);                         \
        float d0 = 0.f, d1 = 0.f, d2 = 0.f, d3 = 0.f;                                                   \
        _Pragma("unroll") for (int i = 0; i < 32; i += 4) {                                             \
          d0 += ud[i] * hreg[i]; d1 += ud[i + 1] * hreg[i + 1]; d2 += ud[i + 2] * hreg[i + 2]; d3 += ud[i + 3] * hreg[i + 3]; \
        }                                                                                               \
        const float av = wave_sum((d0 + d1) + (d2 + d3)) * SU[jj];                                      \
        const float act = gelu_exact(av) * G[jj] * SV[jj];                                              \
        const u32x6 vw = {V2[jj][0], V2[jj][1], V4[jj][0], V4[jj][1], V4[jj][2], V4[jj][3]};            \
        const f32x32 vd = __builtin_amdgcn_cvt_scalef32_pk32_f32_fp6(vw, 1.0f);                         \
        o += vd * act;                                                                                  \
      }
      PEER_LOAD(uA4, uA2, vA4, vA2, gA, suA, svA, 0)
#pragma unroll 1
      for (int j0 = 0; j0 < 128; j0 += 4) {
        PEER_LOAD(uB4, uB2, vB4, vB2, gB, suB, svB, j0 + 2)
        PEER_COMPUTE(uA4, uA2, vA4, vA2, gA, suA, svA)
        if (j0 + 4 < 128) { PEER_LOAD(uA4, uA2, vA4, vA2, gA, suA, svA, j0 + 4) }
        PEER_COMPUTE(uB4, uB2, vB4, vB2, gB, suB, svB)
      }
#undef PEER_LOAD
#undef PEER_COMPUTE
      float* orow = p.out + (size_t)t * D_ + lane * 4;
      float sum = 0.f;
#pragma unroll
      for (int q = 0; q < 8; ++q) {
        const float4 r0 = *(const float4*)(orow + q * 256);
        o[q * 4 + 0] += r0.x; o[q * 4 + 1] += r0.y; o[q * 4 + 2] += r0.z; o[q * 4 + 3] += r0.w;
      }
#pragma unroll
      for (int i = 0; i < 32; ++i) sum += o[i];
      const float mu = wave_sum(sum) * (1.f / D_);
      float sq = 0.f;
#pragma unroll
      for (int i = 0; i < 32; ++i) { o[i] -= mu; sq += o[i] * o[i]; }
      const float rstd = rsqrtf(wave_sum(sq) * (1.f / D_) + EPS);
#pragma unroll
      for (int q = 0; q < 8; ++q) {
        const int col = (q * 64 + lane) * 4;
        const float4 g0 = *(const float4*)(p.ln2_g + col), b0 = *(const float4*)(p.ln2_b + col);
        float4 w0;
        w0.x = o[q * 4 + 0] * rstd * g0.x + b0.x; w0.y = o[q * 4 + 1] * rstd * g0.y + b0.y;
        w0.z = o[q * 4 + 2] * rstd * g0.z + b0.z; w0.w = o[q * 4 + 3] * rstd * g0.w + b0.w;
        *(float4*)(orow + q * 256) = w0;
      }
    }
    __syncthreads();
  }
}

template <int PH>
__device__ __forceinline__ void run_phase(const Params& p, char* smem, int bid, int nb) {
  if constexpr (PH == 0) phase_prep(p, smem, bid, nb);
  if constexpr (PH == 1) phase_inproj(p, smem, bid, nb);
  if constexpr (PH == 2) phase_up(p, smem, bid, nb);
#ifdef ATTN_NAIVE
  if constexpr (PH == 3) phase_attn_naive(p, smem, bid, nb);
#else
  if constexpr (PH == 3) phase_attn(p, smem, bid, nb);
#endif
  if constexpr (PH == 4) phase_outproj(p, smem, bid, nb);
  if constexpr (PH == 5) phase_ln1(p, bid, nb);
  if constexpr (PH == 6) phase_mid(p, smem, bid, nb);
  if constexpr (PH == 7) phase_peer(p, smem, bid, nb);
}

template <int PH>
__global__ void __launch_bounds__(NT, 2) phase_kernel(Params p) {
  __shared__ __attribute__((aligned(16))) char smem[SMEM_BYTES];
  run_phase<PH>(p, smem, blockIdx.x, gridDim.x);
}

#define BW_CENSUS(j) (256 + (j) * 32)
#define BW_XSUB(j) (256 + 512 + (j) * 32)
#define BW_XGEN(j) (256 + 1024 + (j) * 32)
#define BW_TOP (256 + 1536)
#define BW_TOPGEN (256 + 1568)
__device__ __forceinline__ unsigned bw_ld(unsigned* p) { return __hip_atomic_load(p, __ATOMIC_RELAXED, __HIP_MEMORY_SCOPE_AGENT); }
__device__ __forceinline__ unsigned bw_add(unsigned* p, unsigned v) { return __hip_atomic_fetch_add(p, v, __ATOMIC_RELAXED, __HIP_MEMORY_SCOPE_AGENT); }
__device__ __forceinline__ unsigned xcc_id() { return (unsigned)__builtin_amdgcn_s_getreg((3 << 11) | 20) & 0xFu; }

__device__ __forceinline__ void grid_barrier(unsigned* bar, unsigned* st  ) {
  asm volatile("s_waitcnt vmcnt(0)" ::: "memory");
  __syncthreads();
  if (threadIdx.x == 0) {
    __builtin_amdgcn_s_waitcnt(0);
    const unsigned x = xcc_id();
    unsigned nloc = st[0], nx = st[1];
    if (nloc == 0u) {
      const unsigned G = gridDim.x;
      for (;;) {
        unsigned sum = 0u, cnt = 0u, mine = 0u;
#pragma unroll
        for (unsigned j = 0; j < 16; ++j) { const unsigned c = bw_ld(&bar[BW_CENSUS(j)]); sum += c; cnt += (c > 0u) ? 1u : 0u; mine = (j == x) ? c : mine; }
        nloc = mine; nx = cnt;
        if (sum == G) break;
        __builtin_amdgcn_s_sleep(1);
      }
      st[0] = nloc; st[1] = nx;
    }
    const unsigned old = bw_add(&bar[BW_XSUB(x)], 1u);
    const unsigned gen = old / nloc;
    if (old + 1u == (gen + 1u) * nloc) {
      __builtin_amdgcn_fence(__ATOMIC_RELEASE, "agent");
      asm volatile("s_waitcnt vmcnt(0)" ::: "memory");
      const unsigned og = bw_add(&bar[BW_TOP], 1u);
      const unsigned tg = og / nx;
      if (og + 1u == (tg + 1u) * nx) bw_add(&bar[BW_TOPGEN], 1u);
      else while (bw_ld(&bar[BW_TOPGEN]) == tg) __builtin_amdgcn_s_sleep(1);
      __builtin_amdgcn_fence(__ATOMIC_ACQUIRE, "agent");
      bw_add(&bar[BW_XGEN(x)], 1u);
      asm volatile("s_waitcnt vmcnt(0)" ::: "memory");
    } else {
      while (bw_ld(&bar[BW_XGEN(x)]) == gen) __builtin_amdgcn_s_sleep(1);
      __builtin_amdgcn_fence(__ATOMIC_ACQUIRE, "agent");
      asm volatile("s_waitcnt vmcnt(0)" ::: "memory");
    }
  }
  __syncthreads();
}

#if SINGLE_LAUNCH
typedef const __attribute__((address_space(4))) unsigned long long* kargp_t;
static_assert(sizeof(Params) % 8 == 0, "Params must be a pack of 8-byte fields");
#define RUN_PHASE(N) run_phase<N>(p_, smem, bid, nb);
__global__ void __launch_bounds__(NT, 2) fwd_kernel(Params p_) {
  __shared__ __attribute__((aligned(16))) char smem[SMEM_BYTES + 64];
  const int bid = blockIdx.x, nb = gridDim.x;
  unsigned* bar = (unsigned*)(p_.ws + O_CTR);
  unsigned* st = (unsigned*)(smem + SMEM_BYTES);
  if (threadIdx.x == 0) { st[0] = 0u; st[1] = 0u; (void)bw_add(&bar[BW_CENSUS(xcc_id())], 1u); }
  if (p_.out == nullptr) cg::this_grid().sync();
  RUN_PHASE(0) grid_barrier(bar, st);
  RUN_PHASE(1) grid_barrier(bar, st);
  RUN_PHASE(2) grid_barrier(bar, st);
  RUN_PHASE(3) grid_barrier(bar, st);
  RUN_PHASE(4) grid_barrier(bar, st);
  RUN_PHASE(5) grid_barrier(bar, st);
  RUN_PHASE(6) grid_barrier(bar, st);
  RUN_PHASE(7)
}
#endif

extern "C" void kernel_launch(void* const* d_in, const int* in_sizes, int n_in, void* d_out, int out_size,
                              void* d_ws, size_t ws_size, hipStream_t stream) {
  (void)in_sizes; (void)n_in; (void)out_size; (void)ws_size;
  Params p{};
  p.x = (const float*)d_in[0]; p.p = (const float*)d_in[1]; p.positions = (const int*)d_in[2];
  p.w_in = (const float*)d_in[3]; p.b_forget = (const float*)d_in[4]; p.g_q = (const float*)d_in[5];
  p.w_uq = (const float*)d_in[6]; p.g_kv = (const float*)d_in[7]; p.w_ukv = (const float*)d_in[8];
  p.w_out = (const float*)d_in[9]; p.ln1_g = (const float*)d_in[10]; p.ln1_b = (const float*)d_in[11];
  p.peer_wq = (const float*)d_in[12]; p.keys1 = (const float*)d_in[13]; p.keys2 = (const float*)d_in[14];
  p.peer_u = (const float*)d_in[15]; p.peer_v = (const float*)d_in[16]; p.wgate = (const float*)d_in[17];
  p.wproj = (const float*)d_in[18]; p.ln2_g = (const float*)d_in[19]; p.ln2_b = (const float*)d_in[20];
  p.out = (float*)d_out;
  p.ws = (char*)d_ws;

  static int grid_blocks = 0;
  if (!grid_blocks) {
    int dev = 0, cus = 0, per_cu = 0;
    (void)hipGetDevice(&dev);
    (void)hipDeviceGetAttribute(&cus, hipDeviceAttributeMultiprocessorCount, dev);
#if SINGLE_LAUNCH
    (void)hipOccupancyMaxActiveBlocksPerMultiprocessor(&per_cu, fwd_kernel, NT, 0);
#else
    per_cu = 2;
#endif
    if (per_cu > 1) per_cu = 1;
    if (per_cu < 1) per_cu = 1;
    grid_blocks = cus * per_cu;
  }
#if SINGLE_LAUNCH
  (void)hipMemsetAsync(d_ws, 0, 16384, stream);
  void* args[] = {&p};
  hipError_t e = hipLaunchCooperativeKernel((void*)fwd_kernel, dim3(grid_blocks), dim3(NT), args, 0, stream);
  if (e != hipSuccess) fprintf(stderr, "cooperative launch failed: %s (grid %d)\n", hipGetErrorString(e), grid_blocks);
#else
  phase_kernel<0><<<grid_blocks, NT, 0, stream>>>(p);
  phase_kernel<1><<<grid_blocks, NT, 0, stream>>>(p);
  phase_kernel<2><<<grid_blocks, NT, 0, stream>>>(p);
  phase_kernel<3><<<grid_blocks, NT, 0, stream>>>(p);
  phase_kernel<4><<<grid_blocks, NT, 0, stream>>>(p);
  phase_kernel<5><<<grid_blocks, NT, 0, stream>>>(p);
  phase_kernel<6><<<grid_blocks, NT, 0, stream>>>(p);
  phase_kernel<7><<<grid_blocks, NT, 0, stream>>>(p);
#endif
}
```

```cpp
#include <hip/hip_runtime.h>
#include <hip/hip_bf16.h>
#include <hip/hip_cooperative_groups.h>
#include <stdint.h>
#include <cstdio>
namespace cg = cooperative_groups;

typedef unsigned short u16;
typedef short bf16x8 __attribute__((ext_vector_type(8)));
typedef float f32x4 __attribute__((ext_vector_type(4)));
typedef unsigned u32x4 __attribute__((ext_vector_type(4)));
typedef unsigned u32x2 __attribute__((ext_vector_type(2)));

#ifndef SINGLE_LAUNCH
#define SINGLE_LAUNCH 1
#endif

constexpr int T_ = 8192, D_ = 2048, S_ = 4096, NB_ = 2;
constexpr int INW = 4168;
constexpr int NPH = 8;
constexpr float ALPHA = 1.189207115002721f;
constexpr float EPS = 1e-6f;
constexpr int NT = 512;
constexpr int SMEM_BYTES = 133120;

constexpr size_t al256(size_t x) { return (x + 255) & ~(size_t)255; }
constexpr size_t O_CTR = 0;
constexpr size_t O_WINT = O_CTR + 16384;
constexpr size_t O_WUQT = O_WINT + al256((size_t)4352 * 2048 * 2);
constexpr size_t O_WUKVT = O_WUQT + al256((size_t)1536 * 512 * 2);
constexpr size_t O_WOUTT = O_WUKVT + al256((size_t)2048 * 512 * 2);
constexpr size_t O_WPQT = O_WOUTT + al256((size_t)2048 * 2048 * 2);
constexpr size_t O_WGT = O_WPQT + al256((size_t)1024 * 2048 * 2);
constexpr size_t O_WPT = O_WGT + al256((size_t)2048 * 2048 * 2);
constexpr size_t O_PB = O_WPT + al256((size_t)2048 * 256 * 2);
constexpr size_t O_UB = O_PB + al256((size_t)8192 * 256 * 2);
constexpr size_t O_VB = O_UB + 2048;
constexpr size_t O_OMIX = O_UB + al256((size_t)16384 * 4096);
constexpr size_t O_CS = O_OMIX + al256((size_t)8192 * 2048 * 2);
constexpr size_t O_PROJB = O_CS + al256((size_t)8192 * 32 * 8);
constexpr size_t O_KEYH = O_PROJB + al256((size_t)8192 * 2048 * 2);
constexpr size_t O_KEYL = O_KEYH + al256((size_t)2 * 8 * 128 * 64 * 2);
constexpr size_t O_US = O_KEYL + al256((size_t)2 * 8 * 128 * 64 * 2);
constexpr size_t O_VS = O_US + al256((size_t)16384 * 4);
constexpr size_t O_REGB = O_VS + al256((size_t)16384 * 4);
constexpr size_t O_XB = O_REGB;
constexpr size_t O_CQB = O_XB + al256((size_t)8192 * 2048 * 2);
constexpr size_t O_CKVB = O_CQB + al256((size_t)8192 * 512 * 2);
constexpr size_t O_QM = O_CKVB + al256((size_t)8192 * 512 * 2);
constexpr size_t O_KM = O_QM + al256((size_t)8192 * 8 * 192 * 2);
constexpr size_t O_VMT = O_KM + al256((size_t)8192 * 8 * 192 * 2);
constexpr size_t O_QF = O_VMT + al256((size_t)8192 * 8 * 128 * 2);
constexpr size_t O_KF = O_QF + al256((size_t)8192 * 8 * 128 * 2);
constexpr size_t O_VFT = O_KF + al256((size_t)8192 * 8 * 128 * 2);
constexpr size_t O_LOGF = O_VFT + al256((size_t)8192 * 8 * 128 * 2);
constexpr size_t O_FK = O_LOGF + al256((size_t)16 * 4096 * 4);
constexpr size_t O_KRS = O_FK + al256((size_t)16 * 4096 * 4);
constexpr size_t O_RSS = O_KRS + al256((size_t)8192 * 64 * 4);
constexpr size_t O_ENDB = O_RSS + al256((size_t)2 * 8192 * 4);
constexpr size_t O_Y1 = O_REGB;
constexpr size_t O_H1B = O_Y1 + al256((size_t)8192 * 2048 * 4);
constexpr size_t O_PQ = O_H1B + al256((size_t)8192 * 2048 * 2);
constexpr size_t O_GATE = O_PQ + al256((size_t)8192 * 128 * 4);
constexpr size_t O_ENDB2 = O_GATE + al256((size_t)8192 * 128 * 4);
static_assert(O_ENDB2 <= O_ENDB, "region B reuse overflow");
static_assert(O_ENDB <= (size_t)500 * 1024 * 1024, "workspace too large");

struct Params {
  const float *x, *p; const int* positions;
  const float *w_in, *b_forget, *g_q, *w_uq, *g_kv, *w_ukv, *w_out, *ln1_g, *ln1_b;
  const float *peer_wq, *keys1, *keys2, *peer_u, *peer_v, *wgate, *wproj, *ln2_g, *ln2_b;
  float* out;
  char* ws;
#define WSP(type, name, off) __device__ __forceinline__ type* name() const { return (type*)(ws + (off)); }
  WSP(unsigned, ctr, O_CTR) WSP(u16, WinT, O_WINT) WSP(u16, WuqT, O_WUQT) WSP(u16, WukvT, O_WUKVT) WSP(u16, WoutT, O_WOUTT)
  WSP(u16, WpqT, O_WPQT) WSP(u16, WgT, O_WGT) WSP(u16, WpT, O_WPT) WSP(u16, pb, O_PB) WSP(unsigned char, Uq, O_UB) WSP(unsigned char, Vq, O_VB) WSP(float, Us, O_US) WSP(float, Vs, O_VS)
  WSP(u16, omix, O_OMIX) WSP(float2, cs, O_CS) WSP(u16, projb, O_PROJB) WSP(u16, keyH, O_KEYH) WSP(u16, keyL, O_KEYL)
  WSP(u16, xb, O_XB) WSP(u16, cqb, O_CQB) WSP(u16, ckvb, O_CKVB) WSP(u16, Qm, O_QM) WSP(u16, Km, O_KM) WSP(u16, VmT, O_VMT)
  WSP(u16, Qf, O_QF) WSP(u16, Kf, O_KF) WSP(u16, VfT, O_VFT) WSP(float, logf, O_LOGF) WSP(float, Fk, O_FK) WSP(float, krsum, O_KRS) WSP(float, rss, O_RSS)
  WSP(float, y1, O_Y1) WSP(u16, h1b, O_H1B) WSP(int, eidxG, O_PQ) WSP(float, gateG, O_GATE)
#undef WSP
};

__device__ __forceinline__ int TID() { int t = threadIdx.x; asm volatile("" : "+v"(t)); return t; }
__device__ __forceinline__ unsigned pk2(float lo, float hi) {
  unsigned r; asm volatile("v_cvt_pk_bf16_f32 %0, %1, %2" : "=v"(r) : "v"(lo), "v"(hi)); return r;
}
__device__ __forceinline__ u16 f2bf(float f) { return (u16)(pk2(f, 0.f) & 0xffffu); }
__device__ __forceinline__ float bf2f(u16 v) { return __uint_as_float(((unsigned)v) << 16); }
__device__ __forceinline__ float bflo(unsigned v) { return __uint_as_float(v << 16); }
__device__ __forceinline__ float bfhi(unsigned v) { return __uint_as_float(v & 0xffff0000u); }

template <int CTRL> __device__ __forceinline__ int dppi(int v) { return __builtin_amdgcn_update_dpp(0, v, CTRL, 0xF, 0xF, false); }
template <int CTRL> __device__ __forceinline__ float dppf(float v) { return __int_as_float(dppi<CTRL>(__float_as_int(v))); }
__device__ __forceinline__ float rdlane(float v, int l) { return __int_as_float(__builtin_amdgcn_readlane(__float_as_int(v), l)); }

__device__ __forceinline__ float row_sum(float v) {
  v += dppf<0xB1>(v); v += dppf<0x4E>(v); v += dppf<0x141>(v); v += dppf<0x140>(v); return v;
}
__device__ __forceinline__ float row_max(float v) {
  v = fmaxf(v, dppf<0xB1>(v)); v = fmaxf(v, dppf<0x4E>(v)); v = fmaxf(v, dppf<0x141>(v)); v = fmaxf(v, dppf<0x140>(v)); return v;
}
__device__ __forceinline__ float wave_sum(float v) {
  v = row_sum(v);
  return (rdlane(v, 0) + rdlane(v, 16)) + (rdlane(v, 32) + rdlane(v, 48));
}
__device__ __forceinline__ float wave_max(float v) {
  v = row_max(v);
  return fmaxf(fmaxf(rdlane(v, 0), rdlane(v, 16)), fmaxf(rdlane(v, 32), rdlane(v, 48)));
}
__device__ __forceinline__ unsigned wave_umax(unsigned v) {
  unsigned t;
  t = (unsigned)dppi<0xB1>((int)v); v = v > t ? v : t;
  t = (unsigned)dppi<0x4E>((int)v); v = v > t ? v : t;
  t = (unsigned)dppi<0x141>((int)v); v = v > t ? v : t;
  t = (unsigned)dppi<0x140>((int)v); v = v > t ? v : t;
  unsigned a = (unsigned)__builtin_amdgcn_readlane((int)v, 0), b = (unsigned)__builtin_amdgcn_readlane((int)v, 16);
  unsigned c = (unsigned)__builtin_amdgcn_readlane((int)v, 32), d = (unsigned)__builtin_amdgcn_readlane((int)v, 48);
  a = a > b ? a : b; c = c > d ? c : d; return a > c ? a : c;
}
__device__ __forceinline__ unsigned ordkey(float f) {
  unsigned u = __float_as_uint(f);
  return (u & 0x80000000u) ? ~u : (u | 0x80000000u);
}

__device__ __forceinline__ unsigned fp6_code(float v) {
  const float a = fabsf(v);
  int code = a < 2.f ? (int)rintf(a * 8.f) : (a < 4.f ? 16 + (int)rintf((a - 2.f) * 4.f) : 24 + (int)rintf((a - 4.f) * 2.f));
  code = code > 31 ? 31 : code;
  return (unsigned)code | (v < 0.f ? 32u : 0u);
}
__device__ __forceinline__ void quant_chunk(const Params& p, int chunk) {
  const int tid = TID(), lane = tid & 63, wid = tid >> 6;
#pragma unroll 1
  for (int i8 = 0; i8 < 8; ++i8) {
    const int r = chunk * 64 + wid * 8 + i8;
    const int tab = r >> 14, row = r & 16383;
    const float* src = (tab ? p.peer_v : p.peer_u) + (size_t)row * D_ + lane * 4;
    float4 v[8];
    float am = 0.f;
#pragma unroll
    for (int i = 0; i < 8; ++i) {
      { const f32x4 tv = __builtin_nontemporal_load((const f32x4*)(src + i * 256)); v[i] = make_float4(tv[0], tv[1], tv[2], tv[3]); }
      am = fmaxf(am, fmaxf(fmaxf(fabsf(v[i].x), fabsf(v[i].y)), fmaxf(fabsf(v[i].z), fabsf(v[i].w))));
    }
    am = wave_max(am);
    const float qs = am > 0.f ? 7.5f / am : 1.f;
    unsigned w[6];
#pragma unroll
    for (int g = 0; g < 2; ++g) {
      unsigned long long lo = 0ull; unsigned hi = 0u;
#pragma unroll
      for (int i = 0; i < 4; ++i) {
        const float4 f = v[g * 4 + i];
        const unsigned q4 = fp6_code(f.x * qs) | (fp6_code(f.y * qs) << 6) | (fp6_code(f.z * qs) << 12) | (fp6_code(f.w * qs) << 18);
        if (i == 0) lo |= (unsigned long long)q4;
        if (i == 1) lo |= (unsigned long long)q4 << 24;
        if (i == 2) { lo |= (unsigned long long)q4 << 48; hi |= q4 >> 16; }
        if (i == 3) hi |= q4 << 8;
      }
      w[g * 3 + 0] = (unsigned)lo; w[g * 3 + 1] = (unsigned)(lo >> 32); w[g * 3 + 2] = hi;
    }
    unsigned* dst = (unsigned*)(p.Uq() + (size_t)row * 3072 + tab * 1536 + lane * 24);
    *(u32x2*)dst = u32x2{w[0], w[1]}; *(u32x2*)(dst + 2) = u32x2{w[2], w[3]}; *(u32x2*)(dst + 4) = u32x2{w[4], w[5]};
    if (lane == 0) (tab ? p.Vs() : p.Us())[row] = am > 0.f ? am / 7.5f : 1.f;
  }
}

__device__ void transpose_cvt(const float* __restrict__ W, int ldw, int K, int src_col0, int ncols,
                              u16* __restrict__ WT, int dst_row0, const float* __restrict__ kscale,
                              float* tile, int bid, int nb) {
  const int tiles_k = K / 64, tiles_n = ncols / 64, tid = TID();
#pragma unroll 1
  for (int t = bid; t < tiles_k * tiles_n; t += nb) {
    const int tk = t % tiles_k, tn = t / tiles_k, k0 = tk * 64, n0 = tn * 64;
#pragma unroll
    for (int i = 0; i < 2; ++i) {
      const int r = (tid >> 4) + 32 * i, c = (tid & 15) * 4;
      const f32x4 tv = __builtin_nontemporal_load((const f32x4*)(W + (size_t)(k0 + r) * ldw + src_col0 + n0 + c));
      const float4 v = make_float4(tv[0], tv[1], tv[2], tv[3]);
      const float sc = kscale ? kscale[k0 + r] : 1.f;
      tile[r * 65 + c + 0] = v.x * sc; tile[r * 65 + c + 1] = v.y * sc;
      tile[r * 65 + c + 2] = v.z * sc; tile[r * 65 + c + 3] = v.w * sc;
    }
    __syncthreads();
    {
      const int n = tid >> 3, kk = (tid & 7) * 8;
      unsigned w[4];
#pragma unroll
      for (int e = 0; e < 4; ++e) w[e] = pk2(tile[(kk + 2 * e) * 65 + n], tile[(kk + 2 * e + 1) * 65 + n]);
      *(u32x4*)(WT + (size_t)(dst_row0 + n0 + n) * K + k0 + kk) = u32x4{w[0], w[1], w[2], w[3]};
    }
    __syncthreads();
  }
}

__device__ void cvt_bf16(const float* __restrict__ src, u16* __restrict__ dst, size_t n8, size_t gtid, size_t gthreads) {
  for (size_t i = gtid; i < n8; i += gthreads) {
    const float4 a = ((const float4*)src)[2 * i], b = ((const float4*)src)[2 * i + 1];
    ((u32x4*)dst)[i] = u32x4{pk2(a.x, a.y), pk2(a.z, a.w), pk2(b.x, b.y), pk2(b.z, b.w)};
  }
}

__device__ void phase_prep(const Params& p, char* smem, int bid, int nb) {
  const int tid = TID(), lane = tid & 63, wid = tid >> 6;
  float* tile = (float*)smem;
  if (bid == 0 && tid == 0) p.ctr()[0] = 0;
  transpose_cvt(p.w_in, INW, D_, 0, 1024, p.WinT(), 0, nullptr, tile, bid, nb);
  transpose_cvt(p.w_in, INW, D_, 1088, 3072, p.WinT(), 1024, nullptr, tile, bid, nb);
  transpose_cvt(p.w_in, INW, D_, 1024, 64, p.WinT(), 4096, nullptr, tile, bid, nb);
  transpose_cvt(p.w_uq, 1536, 512, 0, 1536, p.WuqT(), 0, p.g_q, tile, bid, nb);
  transpose_cvt(p.w_ukv, 2048, 512, 0, 2048, p.WukvT(), 0, p.g_kv, tile, bid, nb);
  transpose_cvt(p.w_out, 2048, 2048, 0, 2048, p.WoutT(), 0, nullptr, tile, bid, nb);
  transpose_cvt(p.peer_wq, 1024, 2048, 0, 1024, p.WpqT(), 0, nullptr, tile, bid, nb);
  transpose_cvt(p.wgate, 2048, 2048, 0, 2048, p.WgT(), 0, nullptr, tile, bid, nb);
  transpose_cvt(p.wproj, 2048, 256, 0, 2048, p.WpT(), 0, nullptr, tile, bid, nb);
  const size_t gtid = (size_t)bid * NT + tid, gth = (size_t)nb * NT;
  for (size_t i = gtid; i < (size_t)192 * 2048 / 8; i += gth) ((u32x4*)(p.WinT() + (size_t)4160 * 2048))[i] = u32x4{0, 0, 0, 0};
  cvt_bf16(p.p, p.pb(), (size_t)T_ * 256 / 8, gtid, gth);
  for (size_t i = gtid; i < (size_t)T_ * 64 / 4; i += gth) ((float4*)p.krsum())[i] = make_float4(0.f, 0.f, 0.f, 0.f);
  for (size_t i = gtid; i < (size_t)2 * T_ / 4; i += gth) ((float4*)p.rss())[i] = make_float4(0.f, 0.f, 0.f, 0.f);
  for (size_t i = gtid; i < (size_t)2 * 65536; i += gth) {
    const float v = i < 65536 ? p.keys1[i] : p.keys2[i - 65536];
    const u16 h = f2bf(v);
    p.keyH()[i] = h; p.keyL()[i] = f2bf(v - bf2f(h));
  }
  for (size_t i = gtid; i < (size_t)T_ * 32; i += gth) {
    const int t = (int)(i >> 5), fi = (int)(i & 31);
    const float invf = 1.0f / powf(10000.0f, (float)(2 * fi) / 64.0f);
    const float ang = (float)p.positions[t] * invf;
    const double rev = (double)ang * 0.15915494309189535;
    const float fr = (float)(rev - rint(rev));
    p.cs()[i] = make_float2(__builtin_amdgcn_cosf(fr), __builtin_amdgcn_sinf(fr));
  }
  __syncthreads();
  float* wff = (float*)smem;
  for (int i = tid; i < 2048 * 2; i += NT) {
    const int k = i >> 1, hf = i & 1;
    *(float4*)(wff + (k ^ ((k >> 3) & 7)) * 8 + hf * 4) = *(const float4*)(p.w_in + (size_t)k * INW + 4160 + hf * 4);
  }
  __syncthreads();
  for (int t = bid * 8 + wid; t < T_; t += nb * 8) {
    float a[8];
#pragma unroll
    for (int e = 0; e < 8; ++e) a[e] = 0.f;
#pragma unroll 1
    for (int i = 0; i < 4; ++i) {
      const int k = (i * 64 + lane) * 8;
      const f32x4 xa = __builtin_nontemporal_load((const f32x4*)(p.x + (size_t)t * D_ + k)), xb4 = __builtin_nontemporal_load((const f32x4*)(p.x + (size_t)t * D_ + k + 4));
      const float4 x0 = make_float4(xa[0], xa[1], xa[2], xa[3]), x1 = make_float4(xb4[0], xb4[1], xb4[2], xb4[3]);
      *(u32x4*)(p.xb() + (size_t)t * D_ + k) = u32x4{pk2(x0.x, x0.y), pk2(x0.z, x0.w), pk2(x1.x, x1.y), pk2(x1.z, x1.w)};
      const float xs[8] = {x0.x, x0.y, x0.z, x0.w, x1.x, x1.y, x1.z, x1.w};
#pragma unroll
      for (int j = 0; j < 8; ++j) {
        const int kr = (k + j) ^ (lane & 7);
        const float4 w0 = *(const float4*)(wff + kr * 8), w1 = *(const float4*)(wff + kr * 8 + 4);
        a[0] += xs[j] * w0.x; a[1] += xs[j] * w0.y; a[2] += xs[j] * w0.z; a[3] += xs[j] * w0.w;
        a[4] += xs[j] * w1.x; a[5] += xs[j] * w1.y; a[6] += xs[j] * w1.z; a[7] += xs[j] * w1.w;
      }
    }
    float mine = 0.f;
#pragma unroll
    for (int e = 0; e < 8; ++e) { const float s = wave_sum(a[e]); if (lane == e) mine = s; }
    if (lane < 8) {
      const float z = mine + p.b_forget[lane];
      const float ls = fminf(z, 0.f) - log1pf(expf(-fabsf(z)));
      const int b = t >> 12, s = t & 4095;
      p.logf()[((size_t)(b * 8 + lane)) * S_ + s] = ls;
    }
  }
}

template <int WM, int WN>
__device__ __forceinline__ void gemm_core(const u16* __restrict__ A, int lda, const u16* __restrict__ Bt, int ldb,
                                          int K, int brow, int bcol, char* smem, f32x4 (&acc)[4 / WM][4][4]) {
  constexpr int MS = 4 / WM, BN = 64 * WN, NBL = BN / 64;
  static_assert(WM * WN == 8, "8 waves");
  const int tid = TID(), wid = tid >> 6, lane = tid & 63, wr = wid / WN, wc = wid % WN, fr = lane & 15, fq = lane >> 4;
#pragma unroll
  for (int h = 0; h < MS; ++h)
#pragma unroll
    for (int m = 0; m < 4; ++m)
#pragma unroll
      for (int n = 0; n < 4; ++n) acc[h][m][n] = f32x4{0.f, 0.f, 0.f, 0.f};
  const int nk = K / 64;
  const int srow = tid >> 3, sch = (tid & 7) ^ ((tid >> 4) & 7);
  const u16* ga = A + (size_t)(brow + srow) * lda + sch * 8;
  const u16* gb = Bt + (size_t)(bcol + srow) * ldb + sch * 8;
  char* sdst = smem + tid * 16;
  auto issue = [&](int kt, int st) {
    char* sa = sdst + st * 65536;
#pragma unroll
    for (int i = 0; i < 4; ++i)
      __builtin_amdgcn_global_load_lds((const unsigned*)(ga + (size_t)i * 64 * lda + kt * 64), (unsigned*)(sa + i * 8192), 16, 0, 0);
#pragma unroll
    for (int i = 0; i < NBL; ++i)
      __builtin_amdgcn_global_load_lds((const unsigned*)(gb + (size_t)i * 64 * ldb + kt * 64), (unsigned*)(sa + 32768 + i * 8192), 16, 0, 0);
  };
  const int fx = (fr >> 1) & 7;
  const int arow = (wr * (256 / WM) + fr) * 128, brw = 32768 + (wc * 64 + fr) * 128;
  const int c0 = (fq ^ fx) * 16, c1 = ((4 + fq) ^ fx) * 16;
  asm volatile("s_waitcnt vmcnt(0)" ::: "memory");
  __syncthreads();
  issue(0, 0);
#pragma unroll 1
  for (int kt = 0; kt < nk; ++kt) {
    asm volatile("s_waitcnt vmcnt(0)" ::: "memory");
    __builtin_amdgcn_s_barrier();
    asm volatile("" ::: "memory");
    if (kt + 1 < nk) issue(kt + 1, (kt + 1) & 1);
    const char* sb = smem + (kt & 1) * 65536;
#pragma unroll
    for (int ks = 0; ks < 2; ++ks) {
      const int co = ks ? c1 : c0;
      bf16x8 Bl[4];
#pragma unroll
      for (int n = 0; n < 4; ++n) Bl[n] = *reinterpret_cast<const bf16x8*>(sb + brw + co + n * 2048);
#pragma unroll
      for (int h = 0; h < MS; ++h) {
        bf16x8 At[4];
#pragma unroll
        for (int m = 0; m < 4; ++m) At[m] = *reinterpret_cast<const bf16x8*>(sb + arow + co + (h * 4 + m) * 2048);
#pragma unroll
        for (int m = 0; m < 4; ++m)
#pragma unroll
          for (int n = 0; n < 4; ++n) acc[h][m][n] = __builtin_amdgcn_mfma_f32_16x16x32_bf16(At[m], Bl[n], acc[h][m][n], 0, 0, 0);
      }
    }
  }
}

template <int WM, int WN, class Epi>
__device__ __forceinline__ void gemm_tile(const u16* __restrict__ A, int lda, const u16* __restrict__ Bt, int ldb,
                                          int K, int brow, int bcol, char* smem, Epi epi) {
  constexpr int MS = 4 / WM;
  const int tid = TID(), wid = tid >> 6, lane = tid & 63, wr = wid / WN, wc = wid % WN, fr = lane & 15, fq = lane >> 4;
  f32x4 acc[MS][4][4];
  gemm_core<WM, WN>(A, lda, Bt, ldb, K, brow, bcol, smem, acc);
#pragma unroll
  for (int h = 0; h < MS; ++h) epi(acc[h], brow + wr * (256 / WM) + h * 64, bcol + wc * 64, fr, fq);
}

namespace pg8 {
#define PG8_LAS __attribute__((address_space(3)))
typedef unsigned short bf16_t;
constexpr int BM = 256, BK = 64, HALF = 128, HTB = HALF * BK * 2  , STAGE_BYTES = 8 * HTB, NXCD = 8, WGM = 8;

__host__ __device__ __forceinline__ int lds_byte(int r, int c) { const int st = (r >> 4) * 2 + (c >> 5), rr = r & 15, cc = c & 31, ob = rr * 64 + cc * 2; return st * 1024 + (ob ^ (((ob >> 9) & 1) << 5)); }
__host__ __device__ __forceinline__ void stage_rc(int b, int& R, int& C) { const int st = b / 1024, sb = b % 1024, swz = sb ^ (((sb >> 9) & 1) << 5); R = (st >> 1) * 16 + swz / 64; C = (st & 1) * 32 + (swz % 64) / 2; }
__host__ __device__ __forceinline__ int perm32(int rho) { const int n = rho >> 4, i = rho & 15; return 8 * (i >> 2) + 4 * n + (i & 3); }
struct Unit { int pm, pn; };
struct Gemm { const bf16_t* A; const bf16_t* Bt; int M, N, K; };
struct StaticOrder {
    int nM, nN, nwg, G, c;
    __device__ void init(int M, int N, int G_, int c_) { nM = M / BM; nN = N / BM; nwg = nM * nN; G = G_; c = c_; }
    __device__ bool next(int i, Unit& u) const {
        const long L = (long)i * G + c; if (L >= nwg) return false;
        int wgid = (int)L; { const int q = nwg / NXCD, r = nwg % NXCD, xcd = wgid % NXCD, off = wgid / NXCD; wgid = (xcd < r ? xcd * (q + 1) : r * (q + 1) + (xcd - r) * q) + off; }
        const int nig = WGM * nN, gid = wgid / nig, fm = gid * WGM, gsz = (nM - fm) < WGM ? (nM - fm) : WGM;
        u.pm = fm + ((wgid % nig) % gsz); u.pn = (wgid % nig) / gsz; return true;
    }
    __device__ __forceinline__ void a_ready(const Unit&) const {}
    __device__ __forceinline__ void done(const Unit&) const {}
};
template <class Epi, class Sched, bool STAMP = false>
__device__ __forceinline__ void gemm_phase(PG8_LAS unsigned char* lds, const Gemm g, const Sched& S, const Epi& E, unsigned long long* stamps) {
    const int tid = TID(), wid = __builtin_amdgcn_readfirstlane(tid >> 6), lane = tid & 63, wr = wid >> 2, wc = wid & 3, fr = lane & 15, fq = lane >> 4;
    const int K = g.K, nt = K / BK;
    int ts_lo = 0, ts_hi = 0, nts = 0; const unsigned long long rt_entry = STAMP ? (unsigned long long)wall_clock64() : 0ull;
#define PG8_STAMP() do { if (STAMP && wid == 0 && nts < 64) { const unsigned long long _c = (unsigned long long)clock64(); \
        ts_lo = (lane == nts) ? (int)(unsigned)_c : ts_lo; ts_hi = (lane == nts) ? (int)(unsigned)(_c >> 32) : ts_hi; ++nts; } } while (0)
    PG8_STAMP();
    unsigned voffA[2], voffB[2];
#pragma unroll
    for (int i = 0; i < 2; ++i) { int R, C; stage_rc(tid * 16 + i * 8192, R, C); const int Rb = Epi::PERM ? ((R & ~31) + perm32(R & 31)) : R;
        voffA[i] = (unsigned)(R * K + C) * 2u; voffB[i] = (unsigned)(Rb * K + C) * 2u; }
    const size_t kstep = (size_t)(BK * 2);
    const size_t hstep = (size_t)HALF * K * 2;
    const size_t tstep = 2 * hstep;
    const unsigned ldsw = (unsigned)wid * 1024u;
    const int aoff = lds_byte(wr * 64 + fr, fq * 8), boff = lds_byte(wc * 32 + fr, fq * 8);
#define PG8_SA(b, h) (((b) * 2 + (h)) * HTB)
#define PG8_SB(b, h) ((4 + (b) * 2 + (h)) * HTB)
#define PG8_STAGE(bufoff, gbase, voff) do { _Pragma("unroll") for (int _i = 0; _i < 2; ++_i) \
        __builtin_amdgcn_global_load_lds((const unsigned*)((const char*)(gbase) + (voff)[_i]), (PG8_LAS unsigned*)(lds + (bufoff) + ldsw + _i * 8192), 16, 0, 0); } while (0)
#define PG8_LDA(dst, b, h) do { _Pragma("unroll") for (int m = 0; m < 4; ++m) _Pragma("unroll") for (int k = 0; k < 2; ++k) dst[m][k] = *(const PG8_LAS bf16x8*)(lds + PG8_SA(b, h) + aoff + m * 2048 + k * 1024); } while (0)
#define PG8_LDB(dst, b, h) do { _Pragma("unroll") for (int n = 0; n < 2; ++n) _Pragma("unroll") for (int k = 0; k < 2; ++k) dst[n][k] = *(const PG8_LAS bf16x8*)(lds + PG8_SB(b, h) + boff + n * 2048 + k * 1024); } while (0)
#define PG8_MMA(ai, bj, At, Bt) do { __builtin_amdgcn_s_setprio(1); _Pragma("unroll") for (int m = 0; m < 4; ++m) _Pragma("unroll") for (int n = 0; n < 2; ++n) _Pragma("unroll") for (int k = 0; k < 2; ++k) \
        acc[ai][bj][m][n] = __builtin_amdgcn_mfma_f32_16x16x32_bf16(Bt[n][k], At[m][k], acc[ai][bj][m][n], 0, 0, 0); __builtin_amdgcn_s_setprio(0); } while (0)
#define PG8_WAIT_V(n) asm volatile("s_waitcnt vmcnt(" #n ")" ::: "memory")
#define PG8_WAIT_L(n) asm volatile("s_waitcnt lgkmcnt(" #n ")" ::: "memory")
#define PG8_BAR __builtin_amdgcn_s_barrier()
#define PG8_SCHED __builtin_amdgcn_sched_barrier(0)
    Unit cur, nxt; int ui = 0;
    if (!S.next(0, cur)) return;
    f32x4 acc[2][2][4][2];
#pragma unroll
    for (int a = 0; a < 2; ++a)
#pragma unroll
        for (int b = 0; b < 2; ++b)
#pragma unroll
            for (int m = 0; m < 4; ++m)
#pragma unroll
                for (int n = 0; n < 2; ++n) acc[a][b][m][n] = (f32x4){0.f, 0.f, 0.f, 0.f};
    bf16x8 At[4][2], B0[2][2], B1[2][2];
    const char* cA = (const char*)g.A + (size_t)cur.pm * tstep; const char* cB = (const char*)g.Bt + (size_t)cur.pn * tstep;
    S.a_ready(cur);
    PG8_STAGE(PG8_SB(0, 0), cB, voffB); PG8_STAGE(PG8_SA(0, 0), cA, voffA); PG8_STAGE(PG8_SB(0, 1), cB + hstep, voffB); PG8_STAGE(PG8_SA(0, 1), cA + hstep, voffA);
    if (wr == 1) PG8_BAR;
    PG8_WAIT_V(4); PG8_BAR;
    PG8_STAGE(PG8_SB(1, 0), cB + kstep, voffB); PG8_STAGE(PG8_SA(1, 0), cA + kstep, voffA); PG8_STAGE(PG8_SB(1, 1), cB + hstep + kstep, voffB);
    PG8_WAIT_V(6); PG8_BAR;
    PG8_STAMP();
    for (;;) {
        const bool has_next = S.next(ui + 1, nxt);
        const char* nA = has_next ? (const char*)g.A + (size_t)nxt.pm * tstep : cA; const char* nB = has_next ? (const char*)g.Bt + (size_t)nxt.pn * tstep : cB;
        for (int t = 0; t < nt; t += 2) {
            const bool last = (t == nt - 2);
            const char* a1 = cA + (size_t)(t + 1) * kstep;
            const char* a2 = last ? nA : cA + (size_t)(t + 2) * kstep; const char* b2 = last ? nB : cB + (size_t)(t + 2) * kstep;
            const char* a3 = a2 + kstep; const char* b3 = b2 + kstep;
            if (last && has_next) S.a_ready(nxt);
            PG8_LDB(B0, 0, 0); PG8_SCHED; PG8_LDA(At, 0, 0); PG8_STAGE(PG8_SA(1, 1), a1 + hstep, voffA);
            PG8_WAIT_L(8); PG8_BAR; PG8_WAIT_L(0); PG8_MMA(0, 0, At, B0); PG8_BAR; PG8_SCHED;
            PG8_LDB(B1, 0, 1); PG8_STAGE(PG8_SB(0, 0), b2, voffB);
            PG8_BAR; PG8_WAIT_L(0); PG8_MMA(0, 1, At, B1); PG8_BAR;
            PG8_LDA(At, 0, 1); PG8_STAGE(PG8_SA(0, 0), a2, voffA);
            PG8_BAR; PG8_WAIT_L(0); PG8_MMA(1, 0, At, B0); PG8_BAR; PG8_SCHED;
            PG8_STAGE(PG8_SB(0, 1), b2 + hstep, voffB);
            PG8_WAIT_V(6); PG8_BAR; PG8_MMA(1, 1, At, B1); PG8_BAR;
            PG8_LDB(B0, 1, 0); PG8_SCHED; PG8_LDA(At, 1, 0); PG8_STAGE(PG8_SA(0, 1), a2 + hstep, voffA);
            PG8_WAIT_L(8); PG8_BAR; PG8_WAIT_L(0); PG8_MMA(0, 0, At, B0); PG8_BAR; PG8_SCHED;
            PG8_LDB(B1, 1, 1); PG8_STAGE(PG8_SB(1, 0), b3, voffB);
            PG8_BAR; PG8_WAIT_L(0); PG8_MMA(0, 1, At, B1); PG8_BAR;
            PG8_LDA(At, 1, 1); PG8_STAGE(PG8_SA(1, 0), a3, voffA);
            PG8_BAR; PG8_WAIT_L(0); PG8_MMA(1, 0, At, B0); PG8_BAR; PG8_SCHED;
            PG8_STAGE(PG8_SB(1, 1), b3 + hstep, voffB);
            PG8_WAIT_V(6); PG8_BAR; PG8_MMA(1, 1, At, B1); PG8_BAR;
        }
        PG8_STAMP();
        if constexpr (!Epi::AFTER_DRAIN) { E(acc, cur, wr, wc, fr, fq); S.done(cur); }
        PG8_STAMP();
        if (!has_next) break;
#pragma unroll
        for (int a = 0; a < 2; ++a)
#pragma unroll
            for (int b = 0; b < 2; ++b)
#pragma unroll
                for (int m = 0; m < 4; ++m)
#pragma unroll
                    for (int n = 0; n < 2; ++n) acc[a][b][m][n] = (f32x4){0.f, 0.f, 0.f, 0.f};
        cur = nxt; cA = nA; cB = nB; ++ui;
    }
    PG8_WAIT_V(0);
    if (wr == 0) PG8_BAR;
    PG8_BAR;
    if constexpr (Epi::AFTER_DRAIN) { E.fused(acc, cur, wr, wc, fr, fq, lds, wid, lane); S.done(cur); }
    PG8_STAMP();
    if (STAMP && wid == 0) { stamps[lane] = lane < nts ? (((unsigned long long)(unsigned)ts_hi << 32) | (unsigned)ts_lo) : 0ull;
        if (lane == 62) stamps[62] = rt_entry; if (lane == 63) stamps[63] = (unsigned long long)wall_clock64(); }
#undef PG8_STAMP
#undef PG8_SA
#undef PG8_SB
#undef PG8_STAGE
#undef PG8_LDA
#undef PG8_LDB
#undef PG8_MMA
#undef PG8_WAIT_V
#undef PG8_WAIT_L
#undef PG8_BAR
#undef PG8_SCHED
}
}


__device__ __forceinline__ u32x4 pack8(const f32x4& a, const f32x4& b) { return u32x4{pk2(a[0], a[1]), pk2(a[2], a[3]), pk2(b[0], b[1]), pk2(b[2], b[3])}; }
__device__ __forceinline__ float sumsq4(const f32x4& a) { return (a[0] * a[0] + a[1] * a[1]) + (a[2] * a[2] + a[3] * a[3]); }
__device__ __forceinline__ void store_tr8(u16* vt, const f32x4& a, const f32x4& b) {
  vt[0] = f2bf(a[0]); vt[(size_t)S_] = f2bf(a[1]); vt[(size_t)2 * S_] = f2bf(a[2]); vt[(size_t)3 * S_] = f2bf(a[3]);
  vt[(size_t)4 * S_] = f2bf(b[0]); vt[(size_t)5 * S_] = f2bf(b[1]); vt[(size_t)6 * S_] = f2bf(b[2]); vt[(size_t)7 * S_] = f2bf(b[3]);
}
struct EpiInproj {
  static constexpr bool PERM = true, AFTER_DRAIN = false;
  u16 *cqb, *ckvb, *Qf, *Kf, *VfT; float* rss;
  __device__ __forceinline__ void operator()(const f32x4 (&acc)[2][2][4][2], const pg8::Unit& u, int wr, int wc, int fr, int fq) const {
    const int ct = u.pn * 256;
#pragma unroll
    for (int ai = 0; ai < 2; ++ai)
#pragma unroll
      for (int m = 0; m < 4; ++m) {
        const int row = u.pm * 256 + ai * 128 + wr * 64 + m * 16 + fr, b = row >> 12, s = row & 4095;
        float ss = 0.f;
#pragma unroll
        for (int bj = 0; bj < 2; ++bj) {
          const int c0 = ct + bj * 128 + wc * 32 + 8 * fq;
          const f32x4 v0 = acc[ai][bj][m][0], v1 = acc[ai][bj][m][1];
          if (ct < 1024) {
            u16* dst = ct < 512 ? cqb : ckvb;
            *(u32x4*)(dst + (size_t)row * 512 + (c0 & 511)) = pack8(v0, v1);
            ss += sumsq4(v0) + sumsq4(v1);
          } else if (ct < 3072) {
            int c = c0 - 1024; u16* dst = c < 1024 ? Qf : Kf; c &= 1023;
            *(u32x4*)(dst + ((size_t)(b * 8 + (c >> 7)) * S_ + s) * 128 + (c & 127)) = pack8(v0, v1);
          } else {
            const int c = c0 - 3072;
            store_tr8(VfT + ((size_t)(b * 8 + (c >> 7)) * 128 + (c & 127)) * S_ + s, v0, v1);
          }
        }
        if (ct < 1024) atomicAdd(rss + (ct < 512 ? 0 : T_) + row, ss);
        __builtin_amdgcn_sched_barrier(0);
      }
  }
};
struct EpiQup {
  static constexpr bool PERM = true, AFTER_DRAIN = false;
  u16* Qm; const float* rss;
  __device__ __forceinline__ void operator()(const f32x4 (&acc)[2][2][4][2], const pg8::Unit& u, int wr, int wc, int fr, int fq) const {
#pragma unroll
    for (int ai = 0; ai < 2; ++ai)
#pragma unroll
      for (int m = 0; m < 4; ++m) {
        const int row = u.pm * 256 + ai * 128 + wr * 64 + m * 16 + fr, b = row >> 12, s = row & 4095;
        const float rs = rsqrtf(rss[row] * (1.f / 512.f) + EPS);
#pragma unroll
        for (int bj = 0; bj < 2; ++bj) {
          const int c0 = u.pn * 256 + bj * 128 + wc * 32 + 8 * fq, hh = c0 / 192, off = c0 % 192;
          *(u32x4*)(Qm + ((size_t)(b * 8 + hh) * S_ + s) * 192 + off) = pack8(acc[ai][bj][m][0] * rs, acc[ai][bj][m][1] * rs);
        }
        __builtin_amdgcn_sched_barrier(0);
      }
  }
};
struct EpiKVup {
  static constexpr bool PERM = true, AFTER_DRAIN = false;
  u16 *Km, *VmT; const float* rss;
  __device__ __forceinline__ void operator()(const f32x4 (&acc)[2][2][4][2], const pg8::Unit& u, int wr, int wc, int fr, int fq) const {
    const int hh = u.pn;
#pragma unroll
    for (int ai = 0; ai < 2; ++ai)
#pragma unroll
      for (int m = 0; m < 4; ++m) {
        const int row = u.pm * 256 + ai * 128 + wr * 64 + m * 16 + fr, b = row >> 12, s = row & 4095;
        const float rs = rsqrtf(rss[T_ + row] * (1.f / 512.f) + EPS);
        const int off = wc * 32 + 8 * fq;
        *(u32x4*)(Km + ((size_t)(b * 8 + hh) * S_ + s) * 192 + off) = pack8(acc[ai][0][m][0] * rs, acc[ai][0][m][1] * rs);
        store_tr8(VmT + ((size_t)(b * 8 + hh) * 128 + off) * S_ + s, acc[ai][1][m][0] * rs, acc[ai][1][m][1] * rs);
        __builtin_amdgcn_sched_barrier(0);
      }
  }
};
struct EpiProj {
  static constexpr bool PERM = true, AFTER_DRAIN = false;
  u16* projb;
  __device__ __forceinline__ void operator()(const f32x4 (&acc)[2][2][4][2], const pg8::Unit& u, int wr, int wc, int fr, int fq) const {
#pragma unroll
    for (int ai = 0; ai < 2; ++ai)
#pragma unroll
      for (int m = 0; m < 4; ++m) {
        const int row = u.pm * 256 + ai * 128 + wr * 64 + m * 16 + fr;
#pragma unroll
        for (int bj = 0; bj < 2; ++bj)
          *(u32x4*)(projb + (size_t)row * D_ + u.pn * 256 + bj * 128 + wc * 32 + 8 * fq) = pack8(acc[ai][bj][m][0], acc[ai][bj][m][1]);
      }
  }
};
struct EpiOut {
  static constexpr bool PERM = false, AFTER_DRAIN = false;
  const float* x; float* y1;
  __device__ __forceinline__ void operator()(const f32x4 (&acc)[2][2][4][2], const pg8::Unit& u, int wr, int wc, int fr, int fq) const {
#pragma unroll
    for (int ai = 0; ai < 2; ++ai)
#pragma unroll
      for (int m = 0; m < 4; ++m) {
        const size_t rb = (size_t)(u.pm * 256 + ai * 128 + wr * 64 + m * 16 + fr) * D_ + u.pn * 256 + wc * 32 + 4 * fq;
#pragma unroll
        for (int bj = 0; bj < 2; ++bj)
#pragma unroll
          for (int n = 0; n < 2; ++n) {
            const size_t o = rb + bj * 128 + n * 16;
            const f32x4 xv = *(const f32x4*)(x + o);
            *(f32x4*)(y1 + o) = xv * ALPHA + acc[ai][bj][m][n];
          }
      }
  }
};
struct EpiGate {
  static constexpr bool PERM = false, AFTER_DRAIN = false;
  const u16* h1b; const u16* projb; float* out;
  __device__ __forceinline__ void operator()(const f32x4 (&acc)[2][2][4][2], const pg8::Unit& u, int wr, int wc, int fr, int fq) const {
#pragma unroll
    for (int ai = 0; ai < 2; ++ai)
#pragma unroll
      for (int m = 0; m < 4; ++m) {
        const size_t rb = (size_t)(u.pm * 256 + ai * 128 + wr * 64 + m * 16 + fr) * D_ + u.pn * 256 + wc * 32 + 4 * fq;
#pragma unroll
        for (int bj = 0; bj < 2; ++bj)
#pragma unroll
          for (int n = 0; n < 2; ++n) {
            const size_t o = rb + bj * 128 + n * 16;
            const u32x2 hb = *(const u32x2*)(h1b + o);
            const f32x4 hv = {bflo(hb[0]), bfhi(hb[0]), bflo(hb[1]), bfhi(hb[1])};
            const u32x2 pj = *(const u32x2*)(projb + o);
            const f32x4 a = acc[ai][bj][m][n];
            f32x4 r;
            r[0] = ALPHA * hv[0] + bflo(pj[0]) / (1.f + __expf(-a[0])); r[1] = ALPHA * hv[1] + bfhi(pj[0]) / (1.f + __expf(-a[1]));
            r[2] = ALPHA * hv[2] + bflo(pj[1]) / (1.f + __expf(-a[2])); r[3] = ALPHA * hv[3] + bfhi(pj[1]) / (1.f + __expf(-a[3]));
            *(f32x4*)(out + o) = r;
          }
      }
  }
};

__device__ __forceinline__ int vblock(int bid, int nb) { return (nb & 7) ? bid : (bid & 7) * (nb >> 3) + (bid >> 3); }
__device__ __forceinline__ void tile_rc(int t, int Nt, int& tm, int& tn) {
  const int g = t / (8 * Nt), q = t % (8 * Nt);
  tn = q >> 3; tm = g * 8 + (q & 7);
}

__device__ void phase_inproj(const Params& p, char* smem, int bid, int nb) {
  {
    EpiInproj E{p.cqb(), p.ckvb(), p.Qf(), p.Kf(), p.VfT(), p.rss()};
    pg8::Gemm g{p.xb(), p.WinT(), T_, 4096, D_};
    pg8::StaticOrder S; S.init(T_, 4096, nb, bid);
    pg8::gemm_phase((PG8_LAS unsigned char*)smem, g, S, E, nullptr);
  }
  for (int t = vblock(bid, nb); t < 256; t += nb) {
    const int tm = t >> 3, ks = t & 7;
    f32x4 acc[2][4][4];
    gemm_core<2, 4>(p.xb() + ks * 256, D_, p.WinT() + ks * 256, D_, 256, tm * 256, 4096, smem, acc);
    const int tid = TID(), wid = tid >> 6, lane = tid & 63, wr = wid >> 2, wc = wid & 3, fr = lane & 15, fq = lane >> 4;
    if (wc == 0) {
#pragma unroll
      for (int h = 0; h < 2; ++h) {
        float* kd = p.krsum() + (size_t)(tm * 256 + wr * 128 + h * 64 + fq * 4) * 64 + fr;
#pragma unroll
        for (int m = 0; m < 4; ++m)
#pragma unroll
          for (int n = 0; n < 4; ++n)
#pragma unroll
            for (int j = 0; j < 4; ++j) atomicAdd(kd + (m * 16 + j) * 64 + n * 16, acc[h][m][n][j]);
      }
    }
  }
}

__device__ void phase_up(const Params& p, char* smem, int bid, int nb) {
  PG8_LAS unsigned char* lds = (PG8_LAS unsigned char*)smem;
  {
    EpiQup E{p.Qm(), p.rss()};
    pg8::Gemm g{p.cqb(), p.WuqT(), T_, 1536, 512};
    pg8::StaticOrder S; S.init(T_, 1536, nb, (bid + nb - 64) % nb);
    pg8::gemm_phase(lds, g, S, E, nullptr);
  }
  {
    EpiKVup E{p.Km(), p.VmT(), p.rss()};
    pg8::Gemm g{p.ckvb(), p.WukvT(), T_, 2048, 512};
    pg8::StaticOrder S; S.init(T_, 2048, nb, bid);
    pg8::gemm_phase(lds, g, S, E, nullptr);
  }
  {
    EpiProj E{p.projb()};
    pg8::Gemm g{p.pb(), p.WpT(), T_, 2048, 256};
    pg8::StaticOrder S; S.init(T_, 2048, nb, bid);
    pg8::gemm_phase(lds, g, S, E, nullptr);
  }
  for (int t = bid; t < 48; t += nb) {
    if (t >= 16) {
      const int r0 = (t - 16) * 256, tid = TID();
#pragma unroll 1
      for (int it = 0; it < 16; ++it) {
        const int pr = it * NT + tid, row = r0 + (pr >> 5), i = pr & 31, b = row >> 12, s = row & 4095;
        const float x1 = p.krsum()[(size_t)row * 64 + i], x2 = p.krsum()[(size_t)row * 64 + 32 + i];
        const float2 cs = p.cs()[(size_t)row * 32 + i];
        const u16 o1 = f2bf(x1 * cs.x - x2 * cs.y), o2 = f2bf(x1 * cs.y + x2 * cs.x);
#pragma unroll
        for (int hh = 0; hh < 8; ++hh) {
          u16* kd = p.Km() + ((size_t)(b * 8 + hh) * S_ + s) * 192 + 128;
          kd[i] = o1; kd[32 + i] = o2;
        }
      }
    } else {
      const int seq = t;
      if ((TID() >> 6) == 0) {
        const int lane = TID() & 63;
        const float* src = p.logf() + (size_t)seq * S_ + lane * 64;
        float* dst = p.Fk() + (size_t)seq * S_ + lane * 64;
        float sum = 0.f;
#pragma unroll
        for (int i = 0; i < 16; ++i) { const float4 v = *(const float4*)(src + i * 4); sum += v.x; sum += v.y; sum += v.z; sum += v.w; }
        float inc = sum;
#pragma unroll
        for (int d = 1; d < 64; d <<= 1) { const float o = __shfl_up(inc, d, 64); if (lane >= d) inc += o; }
        float run = inc - sum;
#pragma unroll
        for (int i = 0; i < 16; ++i) {
          const float4 v = *(const float4*)(src + i * 4); float4 o;
          run += v.x; o.x = run; run += v.y; o.y = run; run += v.z; o.z = run; run += v.w; o.w = run;
          *(float4*)(dst + i * 4) = o;
        }
      }
    }
  }
}

#ifdef ATTN_NAIVE
__device__ void phase_attn_naive(const Params& p, char* smem, int bid, int nb) {
  const int tid = TID(), lane = tid & 63, wid = tid >> 6;
  const int per = NB_ * 8 * S_, nrows = 2 * per;
  for (int r = bid * 4 + wid; r < nrows; r += nb * 4) {
    const int type = r / per, rr = r % per, bh = rr / S_, s = rr % S_;
    const int DQ = type ? 128 : 192;
    const u16* Q = type ? p.Qf() + ((size_t)bh * S_ + s) * 128 : p.Qm() + ((size_t)bh * S_ + s) * 192;
    const u16* Kb = type ? p.Kf() + (size_t)bh * S_ * 128 : p.Km() + (size_t)bh * S_ * 192;
    const u16* VT = (type ? p.VfT() : p.VmT()) + (size_t)bh * 128 * S_;
    const float* F = p.Fk() + (size_t)bh * S_;
    const float scale = type ? 0.08838834764831845f : 0.07216878364870322f;
    float m = -1e30f, l = 0.f;
    float acc[128];
#pragma unroll
    for (int d = 0; d < 128; ++d) acc[d] = 0.f;
    const float fqv = type ? F[s] : 0.f;
    for (int k0 = 0; k0 <= s; k0 += 64) {
      const int key = k0 + lane; const bool valid = key <= s; const int keyc = valid ? key : s;
      const u16* kr = Kb + (size_t)keyc * DQ;
      float sc = 0.f;
      for (int d = 0; d < DQ; d += 8) {
        const u32x4 kv = *(const u32x4*)(kr + d), qv = *(const u32x4*)(Q + d);
#pragma unroll
        for (int w = 0; w < 4; ++w) sc += bflo(kv[w]) * bflo(qv[w]) + bfhi(kv[w]) * bfhi(qv[w]);
      }
      sc *= scale;
      if (type) sc += fqv - F[keyc];
      if (!valid) sc = -1e30f;
      const float mx = wave_max(sc), mn = fmaxf(m, mx), alpha = __expf(m - mn);
      const float pr = valid ? __expf(sc - mn) : 0.f;
      m = mn; l = l * alpha + pr;
#pragma unroll
      for (int d = 0; d < 128; ++d) acc[d] = acc[d] * alpha + pr * bf2f(VT[(size_t)d * S_ + keyc]);
    }
    const float inv = 1.f / wave_sum(l);
    float o0 = 0.f, o1 = 0.f;
#pragma unroll
    for (int d = 0; d < 128; ++d) {
      const float o = wave_sum(acc[d]) * inv;
      if (lane == (d & 63)) { if (d < 64) o0 = o; else o1 = o; }
    }
    const int b = bh >> 3, hh = bh & 7;
    u16* od = p.omix() + ((size_t)(b * S_ + s)) * 2048 + type * 1024 + hh * 128;
    od[lane] = f2bf(o0); od[64 + lane] = f2bf(o1);
  }
}

#endif
typedef float f32x16 __attribute__((ext_vector_type(16)));
template <int TYPE>
__device__ __forceinline__ void attn_item(const Params& p, char* smem, int bh, int qb) {
  constexpr int DQK = TYPE ? 128 : 192, NKS = DQK / 16, KSTR = DQK * 2 + 16, VSTR = 128;
  constexpr int KCH = DQK / 8, NKL = 64 * KCH / NT;
  constexpr float C2 = (TYPE ? 0.08838834764831845f : 0.07216878364870322f) * 1.4426950408889634f;
  char* sK = smem; char* sV = smem + 51200; float* sF = (float*)(smem + 51200 + 32768);
  const int tid = TID(), lane = tid & 63, wid = tid >> 6, c = lane & 31, hi = lane >> 5;
  const u16* Qb = (TYPE ? p.Qf() : p.Qm()) + (size_t)bh * S_ * DQK;
  const u16* Kb = (TYPE ? p.Kf() : p.Km()) + (size_t)bh * S_ * DQK;
  const u16* Vb = (TYPE ? p.VfT() : p.VmT()) + (size_t)bh * 128 * S_;
  const float* Fb = p.Fk() + (size_t)bh * S_;
  const int qrow = qb * 256 + wid * 32;
  bf16x8 qf[NKS];
#pragma unroll
  for (int ks = 0; ks < NKS; ++ks) qf[ks] = *(const bf16x8*)(Qb + (size_t)(qrow + c) * DQK + ks * 16 + hi * 8);
  if (TYPE == 0) {
    const float2* csr = p.cs() + (size_t)((bh >> 3) * S_ + qrow + c) * 32;
#pragma unroll
    for (int kk = 0; kk < 2; ++kk) {
      u32x4 x1 = *reinterpret_cast<u32x4*>(&qf[(NKS - 4) + kk]), x2 = *reinterpret_cast<u32x4*>(&qf[(NKS - 2) + kk]);
#pragma unroll
      for (int w = 0; w < 4; ++w) {
        const float4 cs = *(const float4*)(csr + 16 * kk + 8 * hi + 2 * w);
        const float a0 = bflo(x1[w]), a1 = bfhi(x1[w]), b0 = bflo(x2[w]), b1 = bfhi(x2[w]);
        x1[w] = pk2(a0 * cs.x - b0 * cs.y, a1 * cs.z - b1 * cs.w);
        x2[w] = pk2(a0 * cs.y + b0 * cs.x, a1 * cs.w + b1 * cs.z);
      }
      qf[(NKS - 4) + kk] = *reinterpret_cast<bf16x8*>(&x1); qf[(NKS - 2) + kk] = *reinterpret_cast<bf16x8*>(&x2);
    }
  }
  f32x16 o[4];
#pragma unroll
  for (int db = 0; db < 4; ++db)
#pragma unroll
    for (int r = 0; r < 16; ++r) o[db][r] = 0.f;
  float m = -1e30f, l = 0.f;
  const int ntiles = 4 * qb + 4;
  u32x4 kreg[NKL];
  float4 freg = make_float4(0.f, 0.f, 0.f, 0.f);
  const unsigned koff = (unsigned)tid * 16u;
  auto load_k = [&](int kt) {
    const char* kb = (const char*)(Kb + (size_t)kt * 64 * DQK);
#pragma unroll
    for (int i = 0; i < NKL; ++i) kreg[i] = *(const u32x4*)(kb + i * 8192 + koff);
    if (TYPE) { if (tid < 16) freg = *(const float4*)(Fb + kt * 64 + tid * 4); }
  };
  const unsigned voff = (unsigned)((((tid >> 3) * S_) + (((tid & 7) ^ ((tid >> 4) & 7)) * 8)) * 2);
  auto load_v = [&](int kt) {
    const char* vb = (const char*)(Vb + kt * 64);
    char* dst = sV + (kt & 1) * 16384 + tid * 16;
#pragma unroll
    for (int i = 0; i < 2; ++i)
      __builtin_amdgcn_global_load_lds((const unsigned*)(vb + (size_t)i * 64 * S_ * 2 + voff), (unsigned*)(dst + i * 8192), 16, 0, 0);
  };
  auto store_tile = [&](int kt) {
    char* sKw = sK + (kt & 1) * 25600;
#pragma unroll
    for (int i = 0; i < NKL; ++i) { const int ch = tid + NT * i, key = ch / KCH, dc = ch % KCH; *(u32x4*)(sKw + key * KSTR + dc * 16) = kreg[i]; }
    if (TYPE) { if (tid < 16) { const float L2E = 1.4426950408889634f; *(float4*)(sF + (kt & 1) * 64 + tid * 4) = make_float4(freg.x * L2E, freg.y * L2E, freg.z * L2E, freg.w * L2E); } }
  };
  const int krow = (c & 19) | ((c & 4) << 1) | ((c & 8) >> 1);
  const char* ka0 = sK + krow * KSTR + hi * 16;
  const char* ka1 = ka0 + 32 * KSTR;
  const int vx = (c >> 1) & 7;
  int vo[2][2];
#pragma unroll
  for (int kb = 0; kb < 2; ++kb)
#pragma unroll
    for (int s2 = 0; s2 < 2; ++s2) vo[kb][s2] = c * VSTR + (((4 * kb + 2 * s2 + hi) ^ vx) * 16);
  load_k(0); load_v(0);
  store_tile(0);
#pragma unroll 1
  for (int kt = 0; kt < ntiles; ++kt) {
    asm volatile("s_waitcnt vmcnt(0) lgkmcnt(0)" ::: "memory");
    __syncthreads();
    if (kt + 1 < ntiles) { load_k(kt + 1); load_v(kt + 1); }
    const int k0 = kt * 64;
    const char* sVc = sV + (kt & 1) * 16384;
    const int kbo = (kt & 1) * 25600;
    const float* sFc = sF + (kt & 1) * 64;
    if (k0 <= qrow + 31) {
      f32x16 p0, p1;
#pragma unroll
      for (int r = 0; r < 16; ++r) { p0[r] = 0.f; p1[r] = 0.f; }
#pragma unroll
      for (int ks = 0; ks < NKS; ++ks) {
        const bf16x8 a0 = *(const bf16x8*)(ka0 + kbo + ks * 32), a1 = *(const bf16x8*)(ka1 + kbo + ks * 32);
        p0 = __builtin_amdgcn_mfma_f32_32x32x16_bf16(a0, qf[ks], p0, 0, 0, 0);
        p1 = __builtin_amdgcn_mfma_f32_32x32x16_bf16(a1, qf[ks], p1, 0, 0, 0);
      }
      if (TYPE) {
#pragma unroll
        for (int s = 0; s < 2; ++s) {
          const float4 f0 = *(const float4*)(sFc + 16 * s + 8 * hi), f1 = *(const float4*)(sFc + 16 * s + 8 * hi + 4);
          const float4 g0 = *(const float4*)(sFc + 32 + 16 * s + 8 * hi), g1 = *(const float4*)(sFc + 32 + 16 * s + 8 * hi + 4);
          p0[8 * s + 0] = p0[8 * s + 0] * C2 - f0.x; p0[8 * s + 1] = p0[8 * s + 1] * C2 - f0.y; p0[8 * s + 2] = p0[8 * s + 2] * C2 - f0.z; p0[8 * s + 3] = p0[8 * s + 3] * C2 - f0.w;
          p0[8 * s + 4] = p0[8 * s + 4] * C2 - f1.x; p0[8 * s + 5] = p0[8 * s + 5] * C2 - f1.y; p0[8 * s + 6] = p0[8 * s + 6] * C2 - f1.z; p0[8 * s + 7] = p0[8 * s + 7] * C2 - f1.w;
          p1[8 * s + 0] = p1[8 * s + 0] * C2 - g0.x; p1[8 * s + 1] = p1[8 * s + 1] * C2 - g0.y; p1[8 * s + 2] = p1[8 * s + 2] * C2 - g0.z; p1[8 * s + 3] = p1[8 * s + 3] * C2 - g0.w;
          p1[8 * s + 4] = p1[8 * s + 4] * C2 - g1.x; p1[8 * s + 5] = p1[8 * s + 5] * C2 - g1.y; p1[8 * s + 6] = p1[8 * s + 6] * C2 - g1.z; p1[8 * s + 7] = p1[8 * s + 7] * C2 - g1.w;
        }
      }
      if (k0 + 63 > qrow) {
        const int lim = qrow + c - k0 - 8 * hi;
        const float NEG = -__builtin_inff();
#pragma unroll
        for (int r = 0; r < 16; ++r) {
          const int kb = 16 * (r >> 3) + (r & 7);
          if (kb > lim) p0[r] = NEG;
          if (kb + 32 > lim) p1[r] = NEG;
        }
      }
      float mx = p0[0];
#pragma unroll
      for (int r = 1; r < 16; ++r) mx = fmaxf(mx, p0[r]);
#pragma unroll
      for (int r = 0; r < 16; ++r) mx = fmaxf(mx, p1[r]);
      {
        auto rr = __builtin_amdgcn_permlane32_swap(__float_as_uint(mx), __float_as_uint(mx), false, false);
        mx = fmaxf(__uint_as_float(rr[0]), __uint_as_float(rr[1]));
      }
      if (!TYPE) mx *= C2;
      constexpr float THR = TYPE ? 96.f : 16.f;
      float mn = m, alpha = 1.f;
      if (!__all(mx - m <= THR)) {
        mn = fmaxf(m, mx);
        alpha = __builtin_amdgcn_exp2f(m - mn);
        m = mn;
#pragma unroll
        for (int db = 0; db < 4; ++db)
#pragma unroll
          for (int r = 0; r < 16; ++r) o[db][r] *= alpha;
      }
      float ps = 0.f;
      if (TYPE) {
#pragma unroll
        for (int r = 0; r < 16; ++r) { p0[r] = __builtin_amdgcn_exp2f(p0[r] - mn); p1[r] = __builtin_amdgcn_exp2f(p1[r] - mn); ps += p0[r] + p1[r]; }
      } else {
#pragma unroll
        for (int r = 0; r < 16; ++r) { p0[r] = __builtin_amdgcn_exp2f(fmaf(p0[r], C2, -mn)); p1[r] = __builtin_amdgcn_exp2f(fmaf(p1[r], C2, -mn)); ps += p0[r] + p1[r]; }
      }
      l = l * alpha + ps;
      bf16x8 pa[2][2];
#pragma unroll
      for (int s = 0; s < 2; ++s) {
        u32x4 w0 = {pk2(p0[8 * s + 0], p0[8 * s + 1]), pk2(p0[8 * s + 2], p0[8 * s + 3]), pk2(p0[8 * s + 4], p0[8 * s + 5]), pk2(p0[8 * s + 6], p0[8 * s + 7])};
        u32x4 w1 = {pk2(p1[8 * s + 0], p1[8 * s + 1]), pk2(p1[8 * s + 2], p1[8 * s + 3]), pk2(p1[8 * s + 4], p1[8 * s + 5]), pk2(p1[8 * s + 6], p1[8 * s + 7])};
        pa[0][s] = *reinterpret_cast<bf16x8*>(&w0); pa[1][s] = *reinterpret_cast<bf16x8*>(&w1);
      }
#pragma unroll
      for (int db = 0; db < 4; ++db)
#pragma unroll
        for (int kb = 0; kb < 2; ++kb)
#pragma unroll
          for (int s = 0; s < 2; ++s) {
            const bf16x8 av = *(const bf16x8*)(sVc + db * 32 * VSTR + vo[kb][s]);
            o[db] = __builtin_amdgcn_mfma_f32_32x32x16_bf16(av, pa[kb][s], o[db], 0, 0, 0);
          }
    }
    if (kt + 1 < ntiles) store_tile(kt + 1);
  }
  {
    auto rr = __builtin_amdgcn_permlane32_swap(__float_as_uint(l), __float_as_uint(l), false, false);
    const float inv = 1.f / (__uint_as_float(rr[0]) + __uint_as_float(rr[1]));
    const int b = bh >> 3, hh = bh & 7;
    u16* od = p.omix() + ((size_t)(b * S_ + qrow + c)) * 2048 + TYPE * 1024 + hh * 128 + 4 * hi;
#pragma unroll
    for (int db = 0; db < 4; ++db)
#pragma unroll
      for (int g = 0; g < 4; ++g)
        *(u32x2*)(od + 32 * db + 8 * g) = u32x2{pk2(o[db][4 * g] * inv, o[db][4 * g + 1] * inv), pk2(o[db][4 * g + 2] * inv, o[db][4 * g + 3] * inv)};
  }
}

__device__ void phase_attn(const Params& p, char* smem, int bid, int nb) {
  int* sItem = (int*)(smem + 90000);
  const int x = bid & 7;
  unsigned* q = p.ctr() + 32 + x;
  for (;;) {
    __syncthreads();
    if (TID() == 0) *sItem = (int)atomicAdd(q, 1u);
    __syncthreads();
    const int item = *sItem;
    if (item >= 64) break;
    const int qb = 15 - (item >> 2), r = item & 3, type = r >> 1, bh = x + 8 * (r & 1);
    if (type == 0) attn_item<0>(p, smem, bh, qb); else attn_item<1>(p, smem, bh, qb);
  }
  unsigned* qc = p.ctr() + 48;
  for (;;) {
    __syncthreads();
    if (TID() == 0) *sItem = (int)atomicAdd(qc, 1u);
    __syncthreads();
    const int chunk = *sItem;
    if (chunk >= 512) break;
    quant_chunk(p, chunk);
  }
}

__device__ void phase_outproj(const Params& p, char* smem, int bid, int nb) {
  EpiOut E{p.x, p.y1()};
  pg8::Gemm g{p.omix(), p.WoutT(), T_, D_, D_};
  pg8::StaticOrder S; S.init(T_, D_, nb, bid);
  pg8::gemm_phase((PG8_LAS unsigned char*)smem, g, S, E, nullptr);
}

__device__ void phase_ln1(const Params& p, int bid, int nb) {
  const int lane = TID() & 63, wid = TID() >> 6;
  for (int t = bid * 8 + wid; t < T_; t += nb * 8) {
    float* row = p.y1() + (size_t)t * D_;
    float4 v[8];
    float sum = 0.f;
#pragma unroll
    for (int i = 0; i < 8; ++i) { v[i] = *(const float4*)(row + (i * 64 + lane) * 4); sum += (v[i].x + v[i].y) + (v[i].z + v[i].w); }
    const float mu = wave_sum(sum) * (1.f / D_);
    float sq = 0.f;
#pragma unroll
    for (int i = 0; i < 8; ++i) {
      v[i].x -= mu; v[i].y -= mu; v[i].z -= mu; v[i].w -= mu;
      sq += (v[i].x * v[i].x + v[i].y * v[i].y) + (v[i].z * v[i].z + v[i].w * v[i].w);
    }
    const float rstd = rsqrtf(wave_sum(sq) * (1.f / D_) + EPS);
#pragma unroll
    for (int i = 0; i < 8; ++i) {
      const int c = (i * 64 + lane) * 4;
      const float4 g = *(const float4*)(p.ln1_g + c), bb = *(const float4*)(p.ln1_b + c);
      float4 o; o.x = v[i].x * rstd * g.x + bb.x; o.y = v[i].y * rstd * g.y + bb.y; o.z = v[i].z * rstd * g.z + bb.z; o.w = v[i].w * rstd * g.w + bb.w;
      *(u32x2*)(p.h1b() + (size_t)t * D_ + c) = u32x2{pk2(o.x, o.y), pk2(o.z, o.w)};
    }
  }
}

__device__ __forceinline__ void ins16(unsigned (&t)[16], unsigned x) {
#pragma unroll
  for (int i = 0; i < 16; ++i) { const unsigned hi = t[i] > x ? t[i] : x; x = t[i] > x ? x : t[i]; t[i] = hi; }
}
__device__ __forceinline__ void ins16p(unsigned (&ck)[16], int (&ce)[16], unsigned x, int xe) {
#pragma unroll
  for (int i = 0; i < 16; ++i) {
    const bool sw = x > ck[i];
    const unsigned nk = sw ? x : ck[i], nx = sw ? ck[i] : x;
    const int ne = sw ? xe : ce[i], nxe = sw ? ce[i] : xe;
    ck[i] = nk; x = nx; ce[i] = ne; xe = nxe;
  }
}
__device__ __forceinline__ float unordkey(unsigned k) { return __uint_as_float((k & 0x80000000u) ? (k & 0x7fffffffu) : ~k); }

__device__ __forceinline__ void sort16_asc(unsigned (&s)[16]) {
#pragma unroll
  for (int k = 2; k <= 16; k <<= 1)
#pragma unroll
    for (int j = k >> 1; j > 0; j >>= 1)
#pragma unroll
      for (int i = 0; i < 16; ++i) {
        const int l = i ^ j;
        if (l > i) {
          const unsigned lo = s[i] < s[l] ? s[i] : s[l], hi = s[i] < s[l] ? s[l] : s[i];
          if ((i & k) == 0) { s[i] = lo; s[l] = hi; } else { s[i] = hi; s[l] = lo; }
        }
      }
}
__device__ __forceinline__ void merge16(unsigned (&t)[16], const unsigned (&s)[16]) {
#pragma unroll
  for (int i = 0; i < 16; ++i) t[i] = t[i] > s[i] ? t[i] : s[i];
#pragma unroll
  for (int j = 8; j > 0; j >>= 1)
#pragma unroll
    for (int i = 0; i < 16; ++i) {
      const int l = i ^ j;
      if (l > i) { const unsigned hi = t[i] > t[l] ? t[i] : t[l], lo = t[i] > t[l] ? t[l] : t[i]; t[i] = hi; t[l] = lo; }
    }
}

__device__ __forceinline__ void score_block(const u16* kH, const u16* kL, const bf16x8 (&qh)[4], const bf16x8 (&ql)[4], int hi, unsigned (&t)[16]) {
#pragma unroll
  for (int i = 0; i < 16; ++i) t[i] = 0u;
#pragma unroll 1
  for (int kb = 0; kb < 4; ++kb) {
    f32x16 sc;
#pragma unroll
    for (int r = 0; r < 16; ++r) sc[r] = 0.f;
#pragma unroll
    for (int ks = 0; ks < 4; ++ks) {
      const bf16x8 ah = *(const bf16x8*)(kH + kb * 32 * 64 + ks * 16), al = *(const bf16x8*)(kL + kb * 32 * 64 + ks * 16);
      sc = __builtin_amdgcn_mfma_f32_32x32x16_bf16(ah, qh[ks], sc, 0, 0, 0);
      sc = __builtin_amdgcn_mfma_f32_32x32x16_bf16(ah, ql[ks], sc, 0, 0, 0);
      sc = __builtin_amdgcn_mfma_f32_32x32x16_bf16(al, qh[ks], sc, 0, 0, 0);
    }
    const unsigned base = (unsigned)(127 - 32 * kb) - 4u * (unsigned)hi;
    unsigned s[16];
#pragma unroll
    for (int r = 0; r < 16; ++r) s[r] = (ordkey(sc[r]) & ~127u) | (base - (unsigned)((r & 3) + 8 * (r >> 2)));
    sort16_asc(s);
    merge16(t, s);
  }
  unsigned other[16];
#pragma unroll
  for (int i = 0; i < 16; ++i) {
    auto rr = __builtin_amdgcn_permlane32_swap(t[15 - i], t[15 - i], false, false);
    other[i] = hi ? rr[0] : rr[1];
  }
  merge16(t, other);
}

__device__ __forceinline__ void route_tile(const Params& p, char* smem, f32x4 (&acc)[4][4], int tm, int h) {
  const int tid = TID(), wid = tid >> 6, lane = tid & 63, wr = wid >> 1, wc = wid & 1, fr = lane & 15, fq = lane >> 4;
  __syncthreads();
  float* Qw = (float*)smem + wid * (64 * 65);
#pragma unroll
  for (int m = 0; m < 4; ++m)
#pragma unroll
    for (int n = 0; n < 4; ++n)
#pragma unroll
      for (int j = 0; j < 4; ++j) Qw[(m * 16 + fq * 4 + j) * 65 + n * 16 + fr] = acc[m][n][j];
  asm volatile("s_waitcnt lgkmcnt(0)" ::: "memory");
  const int c = lane & 31, hi = lane >> 5;
  bf16x8 qh[2][4], ql[2][4];
#pragma unroll
  for (int tb = 0; tb < 2; ++tb)
#pragma unroll
    for (int ks = 0; ks < 4; ++ks) {
      float v[8]; unsigned wh[4], wl[4];
#pragma unroll
      for (int j = 0; j < 8; ++j) v[j] = Qw[(tb * 32 + c) * 65 + 16 * ks + 8 * hi + j];
#pragma unroll
      for (int w = 0; w < 4; ++w) {
        wh[w] = pk2(v[2 * w], v[2 * w + 1]);
        wl[w] = pk2(v[2 * w] - bflo(wh[w]), v[2 * w + 1] - bfhi(wh[w]));
      }
      u32x4 uh = {wh[0], wh[1], wh[2], wh[3]}, ul = {wl[0], wl[1], wl[2], wl[3]};
      qh[tb][ks] = *reinterpret_cast<bf16x8*>(&uh); ql[tb][ks] = *reinterpret_cast<bf16x8*>(&ul);
    }
  const u16* kH = p.keyH() + ((size_t)(wc * 8 + h) * 128 + c) * 64 + 8 * hi;
  const u16* kL = p.keyL() + ((size_t)(wc * 8 + h) * 128 + c) * 64 + 8 * hi;
  unsigned t0[16], t1[16];
  score_block(kH, kL, qh[0], ql[0], hi, t0);
  score_block(kH, kL, qh[1], ql[1], hi, t1);
  unsigned t[16];
#pragma unroll
  for (int i = 0; i < 16; ++i) t[i] = hi ? t1[i] : t0[i];
  __syncthreads();
  unsigned* L = (unsigned*)smem;
#pragma unroll
  for (int r = 0; r < 16; ++r) L[(wc * 16 + r) * 256 + wr * 64 + lane] = t[r];
  __syncthreads();
  if (wid < 4) {
    const int tok = wid * 64 + lane;
    unsigned ck[16]; int ce[16];
#pragma unroll
    for (int i = 0; i < 16; ++i) { ck[i] = 0u; ce[i] = 0; }
#pragma unroll 1
    for (int a = 0; a < 16; ++a) {
      const unsigned ka = L[a * 256 + tok];
      const int i1a = (127 - (int)(ka & 127u)) * 128; const float v1a = unordkey(ka & ~127u);
      const int nbm1 = (int)((0x1112347FULL >> (4 * a)) & 15ULL);
#pragma unroll 1
      for (int b = 0; b <= nbm1; ++b) {
        const unsigned kb = L[(16 + b) * 256 + tok];
        const int i2b = 127 - (int)(kb & 127u); const float v2b = unordkey(kb & ~127u);
        ins16p(ck, ce, ordkey(v1a + v2b), i1a + i2b);
      }
    }
    float ex[16], sum = 0.f;
    const float mx = unordkey(ck[0]);
#pragma unroll
    for (int r = 0; r < 16; ++r) { ex[r] = __expf(unordkey(ck[r]) - mx); sum += ex[r]; }
    const float inv = 1.f / sum;
    const size_t o = ((size_t)(tm * 256 + tok) * 8 + h) * 16;
    int* ed = p.eidxG() + o; float* gd = p.gateG() + o;
#pragma unroll
    for (int r = 0; r < 16; r += 4) {
      *(int4*)(ed + r) = make_int4(ce[r], ce[r + 1], ce[r + 2], ce[r + 3]);
      *(float4*)(gd + r) = make_float4(ex[r] * inv, ex[r + 1] * inv, ex[r + 2] * inv, ex[r + 3] * inv);
    }
  }
}

__device__ void phase_mid(const Params& p, char* smem, int bid, int nb) {
  {
    EpiGate E{p.h1b(), p.projb(), p.out};
    pg8::Gemm g{p.h1b(), p.WgT(), T_, D_, D_};
    pg8::StaticOrder S; S.init(T_, D_, nb, bid);
    pg8::gemm_phase((PG8_LAS unsigned char*)smem, g, S, E, nullptr);
  }
  for (int t = vblock(bid, nb); t < 32 * 8; t += nb) {
    int tm, tn; tile_rc(t, 8, tm, tn);
    f32x4 acc[1][4][4];
    gemm_core<4, 2>(p.h1b(), D_, p.WpqT(), D_, D_, tm * 256, tn * 128, smem, acc);
    route_tile(p, smem, acc[0], tm, tn);
  }
}

__device__ __forceinline__ float gelu_exact(float a) {
  const float x = fabsf(a) * 0.7071067811865476f;
  const float t = __builtin_amdgcn_rcpf(1.f + 0.3275911f * x);
  const float poly = t * (0.254829592f + t * (-0.284496736f + t * (1.421413741f + t * (-1.453152027f + t * 1.061405429f))));
  const float er = 1.f - poly * __expf(-x * x);
  return 0.5f * a * (1.f + (a < 0.f ? -er : er));
}

template <int NPER, int IDXMASK>
__device__ __forceinline__ int top16(unsigned (&k)[NPER], int lane) {
  int mine = 0;
#pragma unroll 1
  for (int r = 0; r < 16; ++r) {
    unsigned loc = k[0];
#pragma unroll
    for (int i = 1; i < NPER; ++i) loc = loc > k[i] ? loc : k[i];
    const unsigned best = wave_umax(loc);
#pragma unroll
    for (int i = 0; i < NPER; ++i) if (k[i] == best) k[i] = 0u;
    if (lane == r) mine = IDXMASK - (int)(best & (unsigned)IDXMASK);
  }
  return mine;
}

__device__ void phase_peer(const Params& p, char* smem, int bid, int nb) {
  const int tid = TID(), lane = tid & 63, wid = tid >> 6;
  float* qs = (float*)smem;
  float* sc = (float*)(smem + 8192);
  int* eidx = (int*)(smem + 24576);
  float* gts = (float*)(smem + 40960);
  for (int it = bid; it < T_ / 32; it += nb) {
    const int t0 = it * 32;
#pragma unroll
    for (int i = 0; i < 2; ++i) {
      const int idx = (i * NT + tid) * 4;
      *(int4*)(eidx + idx) = *(const int4*)(p.eidxG() + (size_t)t0 * 128 + idx);
      *(float4*)(gts + idx) = *(const float4*)(p.gateG() + (size_t)t0 * 128 + idx);
    }
    __syncthreads();
    for (int ti = 0; ti < 4; ++ti) {
      const int tok = wid * 4 + ti, t = t0 + tok;
      typedef float f32x32 __attribute__((ext_vector_type(32)));
      typedef unsigned u32x6 __attribute__((ext_vector_type(6)));
      float hreg[32];
      f32x32 o;
#pragma unroll
      for (int q = 0; q < 8; ++q) {
        const u32x2 hv = *(const u32x2*)(p.h1b() + (size_t)t * D_ + (q * 64 + lane) * 4);
        hreg[q * 4] = bflo(hv[0]); hreg[q * 4 + 1] = bfhi(hv[0]); hreg[q * 4 + 2] = bflo(hv[1]); hreg[q * 4 + 3] = bfhi(hv[1]);
      }
#pragma unroll
      for (int i = 0; i < 32; ++i) o[i] = 0.f;
      const float* Us = p.Us(); const float* Vs = p.Vs();
      const unsigned char* Uq = p.Uq() + lane * 24;
      const int* ep = eidx + tok * 128; const float* gp = gts + tok * 128;
      u32x4 uA4[2], vA4[2], uB4[2], vB4[2]; u32x2 uA2[2], vA2[2], uB2[2], vB2[2];
      float gA[2], suA[2], svA[2], gB[2], suB[2], svB[2];
#define PEER_LOAD(U4, U2, V4, V2, G, SU, SV, J0)                                                        \
      _Pragma("unroll") for (int jj = 0; jj < 2; ++jj) {                                                \
        const int e = __builtin_amdgcn_readfirstlane(ep[(J0) + jj]);                                    \
        G[jj] = gp[(J0) + jj]; SU[jj] = Us[e]; SV[jj] = Vs[e];                                          \
        const unsigned char* up = Uq + (size_t)e * 3072; const unsigned char* vp = up + 1536;           \
        U2[jj] = *(const u32x2*)(up); U4[jj] = *(const u32x4*)(up + 8);                                 \
        V2[jj] = *(const u32x2*)(vp); V4[jj] = *(const u32x4*)(vp + 8);                                 \
      }
#define PEER_COMPUTE(U4, U2, V4, V2, G, SU, SV)                                                         \
      _Pragma("unroll") for (int jj = 0; jj < 2; ++jj) {                                                \
        const u32x6 uw = {U2[jj][0], U2[jj][1], U4[jj][0], U4[jj][1], U4[jj][2], U4[jj][3]};            \
        const f32x32 ud = __builtin_amdgcn_cvt_scalef32_pk32_f32_fp6(uw, 1.0f);                         \
        float d0 = 0.f, d1 = 0.f, d2 = 0.f, d3 = 0.f;                                                   \
        _Pragma("unroll") for (int i = 0; i < 32; i += 4) {                                             \
          d0 += ud[i] * hreg[i]; d1 += ud[i + 1] * hreg[i + 1]; d2 += ud[i + 2] * hreg[i + 2]; d3 += ud[i + 3] * hreg[i + 3]; \
        }                                                                                               \
        const float av = wave_sum((d0 + d1) + (d2 + d3)) * SU[jj];                                      \
        const float act = gelu_exact(av) * G[jj] * SV[jj];                                              \
        const u32x6 vw = {V2[jj][0], V2[jj][1], V4[jj][0], V4[jj][1], V4[jj][2], V4[jj][3]};            \
        const f32x32 vd = __builtin_amdgcn_cvt_scalef32_pk32_f32_fp6(vw, 1.0f);                         \
        o += vd * act;                                                                                  \
      }
      PEER_LOAD(uA4, uA2, vA4, vA2, gA, suA, svA, 0)
#pragma unroll 1
      for (int j0 = 0; j0 < 128; j0 += 4) {
        PEER_LOAD(uB4, uB2, vB4, vB2, gB, suB, svB, j0 + 2)
        PEER_COMPUTE(uA4, uA2, vA4, vA2, gA, suA, svA)
        if (j0 + 4 < 128) { PEER_LOAD(uA4, uA2, vA4, vA2, gA, suA, svA, j0 + 4) }
        PEER_COMPUTE(uB4, uB2, vB4, vB2, gB, suB, svB)
      }
#undef PEER_LOAD
#undef PEER_COMPUTE
      float* orow = p.out + (size_t)t * D_ + lane * 4;
      float sum = 0.f;
#pragma unroll
      for (int q = 0; q < 8; ++q) {
        const float4 r0 = *(const float4*)(orow + q * 256);
        o[q * 4 + 0] += r0.x; o[q * 4 + 1] += r0.y; o[q * 4 + 2] += r0.z; o[q * 4 + 3] += r0.w;
      }
#pragma unroll
      for (int i = 0; i < 32; ++i) sum += o[i];
      const float mu = wave_sum(sum) * (1.f / D_);
      float sq = 0.f;
#pragma unroll
      for (int i = 0; i < 32; ++i) { o[i] -= mu; sq += o[i] * o[i]; }
      const float rstd = rsqrtf(wave_sum(sq) * (1.f / D_) + EPS);
#pragma unroll
      for (int q = 0; q < 8; ++q) {
        const int col = (q * 64 + lane) * 4;
        const float4 g0 = *(const float4*)(p.ln2_g + col), b0 = *(const float4*)(p.ln2_b + col);
        float4 w0;
        w0.x = o[q * 4 + 0] * rstd * g0.x + b0.x; w0.y = o[q * 4 + 1] * rstd * g0.y + b0.y;
        w0.z = o[q * 4 + 2] * rstd * g0.z + b0.z; w0.w = o[q * 4 + 3] * rstd * g0.w + b0.w;
        *(float4*)(orow + q * 256) = w0;
      }
    }
    __syncthreads();
  }
}

template <int PH>
__device__ __forceinline__ void run_phase(const Params& p, char* smem, int bid, int nb) {
  if constexpr (PH == 0) phase_prep(p, smem, bid, nb);
  if constexpr (PH == 1) phase_inproj(p, smem, bid, nb);
  if constexpr (PH == 2) phase_up(p, smem, bid, nb);
#ifdef ATTN_NAIVE
  if constexpr (PH == 3) phase_attn_naive(p, smem, bid, nb);
#else
  if constexpr (PH == 3) phase_attn(p, smem, bid, nb);
#endif
  if constexpr (PH == 4) phase_outproj(p, smem, bid, nb);
  if constexpr (PH == 5) phase_ln1(p, bid, nb);
  if constexpr (PH == 6) phase_mid(p, smem, bid, nb);
  if constexpr (PH == 7) phase_peer(p, smem, bid, nb);
}

template <int PH>
__global__ void __launch_bounds__(NT, 2) phase_kernel(Params p) {
  __shared__ __attribute__((aligned(16))) char smem[SMEM_BYTES];
  run_phase<PH>(p, smem, blockIdx.x, gridDim.x);
}

#define BW_CENSUS(j) (256 + (j) * 32)
#define BW_XSUB(j) (256 + 512 + (j) * 32)
#define BW_XGEN(j) (256 + 1024 + (j) * 32)
#define BW_TOP (256 + 1536)
#define BW_TOPGEN (256 + 1568)
__device__ __forceinline__ unsigned bw_ld(unsigned* p) { return __hip_atomic_load(p, __ATOMIC_RELAXED, __HIP_MEMORY_SCOPE_AGENT); }
__device__ __forceinline__ unsigned bw_add(unsigned* p, unsigned v) { return __hip_atomic_fetch_add(p, v, __ATOMIC_RELAXED, __HIP_MEMORY_SCOPE_AGENT); }
__device__ __forceinline__ unsigned xcc_id() { return (unsigned)__builtin_amdgcn_s_getreg((3 << 11) | 20) & 0xFu; }

__device__ __forceinline__ void grid_barrier(unsigned* bar, unsigned* st  ) {
  asm volatile("s_waitcnt vmcnt(0)" ::: "memory");
  __syncthreads();
  if (threadIdx.x == 0) {
    __builtin_amdgcn_s_waitcnt(0);
    const unsigned x = xcc_id();
    unsigned nloc = st[0], nx = st[1];
    if (nloc == 0u) {
      const unsigned G = gridDim.x;
      for (;;) {
        unsigned sum = 0u, cnt = 0u, mine = 0u;
#pragma unroll
        for (unsigned j = 0; j < 16; ++j) { const unsigned c = bw_ld(&bar[BW_CENSUS(j)]); sum += c; cnt += (c > 0u) ? 1u : 0u; mine = (j == x) ? c : mine; }
        nloc = mine; nx = cnt;
        if (sum == G) break;
        __builtin_amdgcn_s_sleep(1);
      }
      st[0] = nloc; st[1] = nx;
    }
    const unsigned old = bw_add(&bar[BW_XSUB(x)], 1u);
    const unsigned gen = old / nloc;
    if (old + 1u == (gen + 1u) * nloc) {
      __builtin_amdgcn_fence(__ATOMIC_RELEASE, "agent");
      asm volatile("s_waitcnt vmcnt(0)" ::: "memory");
      const unsigned og = bw_add(&bar[BW_TOP], 1u);
      const unsigned tg = og / nx;
      if (og + 1u == (tg + 1u) * nx) bw_add(&bar[BW_TOPGEN], 1u);
      else while (bw_ld(&bar[BW_TOPGEN]) == tg) __builtin_amdgcn_s_sleep(1);
      __builtin_amdgcn_fence(__ATOMIC_ACQUIRE, "agent");
      bw_add(&bar[BW_XGEN(x)], 1u);
      asm volatile("s_waitcnt vmcnt(0)" ::: "memory");
    } else {
      while (bw_ld(&bar[BW_XGEN(x)]) == gen) __builtin_amdgcn_s_sleep(1);
      __builtin_amdgcn_fence(__ATOMIC_ACQUIRE, "agent");
      asm volatile("s_waitcnt vmcnt(0)" ::: "memory");
    }
  }
  __syncthreads();
}

#if SINGLE_LAUNCH
typedef const __attribute__((address_space(4))) unsigned long long* kargp_t;
static_assert(sizeof(Params) % 8 == 0, "Params must be a pack of 8-byte fields");
#define RUN_PHASE(N) run_phase<N>(p_, smem, bid, nb);
__global__ void __launch_bounds__(NT, 2) fwd_kernel(Params p_) {
  __shared__ __attribute__((aligned(16))) char smem[SMEM_BYTES + 64];
  const int bid = blockIdx.x, nb = gridDim.x;
  unsigned* bar = (unsigned*)(p_.ws + O_CTR);
  unsigned* st = (unsigned*)(smem + SMEM_BYTES);
  if (threadIdx.x == 0) { st[0] = 0u; st[1] = 0u; (void)bw_add(&bar[BW_CENSUS(xcc_id())], 1u); }
  if (p_.out == nullptr) cg::this_grid().sync();
  RUN_PHASE(0) grid_barrier(bar, st);
  RUN_PHASE(1) grid_barrier(bar, st);
  RUN_PHASE(2) grid_barrier(bar, st);
  RUN_PHASE(3) grid_barrier(bar, st);
  RUN_PHASE(4) grid_barrier(bar, st);
  RUN_PHASE(5) grid_barrier(bar, st);
  RUN_PHASE(6) grid_barrier(bar, st);
  RUN_PHASE(7)
}
#endif

extern "C" void kernel_launch(void* const* d_in, const int* in_sizes, int n_in, void* d_out, int out_size,
                              void* d_ws, size_t ws_size, hipStream_t stream) {
  (void)in_sizes; (void)n_in; (void)out_size; (void)ws_size;
  Params p{};
  p.x = (const float*)d_in[0]; p.p = (const float*)d_in[1]; p.positions = (const int*)d_in[2];
  p.w_in = (const float*)d_in[3]; p.b_forget = (const float*)d_in[4]; p.g_q = (const float*)d_in[5];
  p.w_uq = (const float*)d_in[6]; p.g_kv = (const float*)d_in[7]; p.w_ukv = (const float*)d_in[8];
  p.w_out = (const float*)d_in[9]; p.ln1_g = (const float*)d_in[10]; p.ln1_b = (const float*)d_in[11];
  p.peer_wq = (const float*)d_in[12]; p.keys1 = (const float*)d_in[13]; p.keys2 = (const float*)d_in[14];
  p.peer_u = (const float*)d_in[15]; p.peer_v = (const float*)d_in[16]; p.wgate = (const float*)d_in[17];
  p.wproj = (const float*)d_in[18]; p.ln2_g = (const float*)d_in[19]; p.ln2_b = (const float*)d_in[20];
  p.out = (float*)d_out;
  p.ws = (char*)d_ws;

  static int grid_blocks = 0;
  if (!grid_blocks) {
    int dev = 0, cus = 0, per_cu = 0;
    (void)hipGetDevice(&dev);
    (void)hipDeviceGetAttribute(&cus, hipDeviceAttributeMultiprocessorCount, dev);
#if SINGLE_LAUNCH
    (void)hipOccupancyMaxActiveBlocksPerMultiprocessor(&per_cu, fwd_kernel, NT, 0);
#else
    per_cu = 2;
#endif
    if (per_cu > 1) per_cu = 1;
    if (per_cu < 1) per_cu = 1;
    grid_blocks = cus * per_cu;
  }
#if SINGLE_LAUNCH
  (void)hipMemsetAsync(d_ws, 0, 16384, stream);
  void* args[] = {&p};
  hipError_t e = hipLaunchCooperativeKernel((void*)fwd_kernel, dim3(grid_blocks), dim3(NT), args, 0, stream);
  if (e != hipSuccess) fprintf(stderr, "cooperative launch failed: %s (grid %d)\n", hipGetErrorString(e), grid_blocks);
#else
  phase_kernel<0><<<grid_blocks, NT, 0, stream>>>(p);
  phase_kernel<1><<<grid_blocks, NT, 0, stream>>>(p);
  phase_kernel<2><<<grid_blocks, NT, 0, stream>>>(p);
  phase_kernel<3><<<grid_blocks, NT, 0, stream>>>(p);
  phase_kernel<4><<<grid_blocks, NT, 0, stream>>>(p);
  phase_kernel<5><<<grid_blocks, NT, 0, stream>>>(p);
  phase_kernel<6><<<grid_blocks, NT, 0, stream>>>(p);
  phase_kernel<7><<<grid_blocks, NT, 0, stream>>>(p);
#endif
}
```

```cpp
#include <hip/hip_runtime.h>
#include <hip/hip_bf16.h>
#include <hip/hip_cooperative_groups.h>
#include <stdint.h>
#include <cstdio>
namespace cg = cooperative_groups;

typedef unsigned short u16;
typedef short bf16x8 __attribute__((ext_vector_type(8)));
typedef float f32x4 __attribute__((ext_vector_type(4)));
typedef unsigned u32x4 __attribute__((ext_vector_type(4)));
typedef unsigned u32x2 __attribute__((ext_vector_type(2)));

#ifndef SINGLE_LAUNCH
#define SINGLE_LAUNCH 1
#endif

constexpr int T_ = 8192, D_ = 2048, S_ = 4096, NB_ = 2;
constexpr int INW = 4168;
constexpr int NPH = 8;
constexpr float ALPHA = 1.189207115002721f;
constexpr float EPS = 1e-6f;
constexpr int NT = 512;
constexpr int SMEM_BYTES = 133120;

constexpr size_t al256(size_t x) { return (x + 255) & ~(size_t)255; }
constexpr size_t O_CTR = 0;
constexpr size_t O_WINT = O_CTR + 16384;
constexpr size_t O_WUQT = O_WINT + al256((size_t)4352 * 2048 * 2);
constexpr size_t O_WUKVT = O_WUQT + al256((size_t)1536 * 512 * 2);
constexpr size_t O_WOUTT = O_WUKVT + al256((size_t)2048 * 512 * 2);
constexpr size_t O_WPQT = O_WOUTT + al256((size_t)2048 * 2048 * 2);
constexpr size_t O_WGT = O_WPQT + al256((size_t)1024 * 2048 * 2);
constexpr size_t O_WPT = O_WGT + al256((size_t)2048 * 2048 * 2);
constexpr size_t O_PB = O_WPT + al256((size_t)2048 * 256 * 2);
constexpr size_t O_UB = O_PB + al256((size_t)8192 * 256 * 2);
constexpr size_t O_VB = O_UB + 2048;
constexpr size_t O_OMIX = O_UB + al256((size_t)16384 * 4096);
constexpr size_t O_CS = O_OMIX + al256((size_t)8192 * 2048 * 2);
constexpr size_t O_PROJB = O_CS + al256((size_t)8192 * 32 * 8);
constexpr size_t O_KEYH = O_PROJB + al256((size_t)8192 * 2048 * 2);
constexpr size_t O_KEYL = O_KEYH + al256((size_t)2 * 8 * 128 * 64 * 2);
constexpr size_t O_US = O_KEYL + al256((size_t)2 * 8 * 128 * 64 * 2);
constexpr size_t O_VS = O_US + al256((size_t)16384 * 4);
constexpr size_t O_REGB = O_VS + al256((size_t)16384 * 4);
constexpr size_t O_XB = O_REGB;
constexpr size_t O_CQB = O_XB + al256((size_t)8192 * 2048 * 2);
constexpr size_t O_CKVB = O_CQB + al256((size_t)8192 * 512 * 2);
constexpr size_t O_QM = O_CKVB + al256((size_t)8192 * 512 * 2);
constexpr size_t O_KM = O_QM + al256((size_t)8192 * 8 * 192 * 2);
constexpr size_t O_VMT = O_KM + al256((size_t)8192 * 8 * 192 * 2);
constexpr size_t O_QF = O_VMT + al256((size_t)8192 * 8 * 128 * 2);
constexpr size_t O_KF = O_QF + al256((size_t)8192 * 8 * 128 * 2);
constexpr size_t O_VFT = O_KF + al256((size_t)8192 * 8 * 128 * 2);
constexpr size_t O_LOGF = O_VFT + al256((size_t)8192 * 8 * 128 * 2);
constexpr size_t O_FK = O_LOGF + al256((size_t)16 * 4096 * 4);
constexpr size_t O_KRS = O_FK + al256((size_t)16 * 4096 * 4);
constexpr size_t O_RSS = O_KRS + al256((size_t)8192 * 64 * 4);
constexpr size_t O_ENDB = O_RSS + al256((size_t)2 * 8192 * 4);
constexpr size_t O_Y1 = O_REGB;
constexpr size_t O_H1B = O_Y1 + al256((size_t)8192 * 2048 * 4);
constexpr size_t O_PQ = O_H1B + al256((size_t)8192 * 2048 * 2);
constexpr size_t O_GATE = O_PQ + al256((size_t)8192 * 128 * 4);
constexpr size_t O_R2B = O_GATE + al256((size_t)8192 * 128 * 4);
constexpr size_t O_ENDB2 = O_R2B + al256((size_t)8192 * 2048 * 2);
static_assert(O_ENDB2 <= O_ENDB, "region B reuse overflow");
static_assert(O_ENDB <= (size_t)500 * 1024 * 1024, "workspace too large");

struct Params {
  const float *x, *p; const int* positions;
  const float *w_in, *b_forget, *g_q, *w_uq, *g_kv, *w_ukv, *w_out, *ln1_g, *ln1_b;
  const float *peer_wq, *keys1, *keys2, *peer_u, *peer_v, *wgate, *wproj, *ln2_g, *ln2_b;
  float* out;
  char* ws;
#define WSP(type, name, off) __device__ __forceinline__ type* name() const { return (type*)(ws + (off)); }
  WSP(unsigned, ctr, O_CTR) WSP(u16, WinT, O_WINT) WSP(u16, WuqT, O_WUQT) WSP(u16, WukvT, O_WUKVT) WSP(u16, WoutT, O_WOUTT)
  WSP(u16, WpqT, O_WPQT) WSP(u16, WgT, O_WGT) WSP(u16, WpT, O_WPT) WSP(u16, pb, O_PB) WSP(unsigned char, Uq, O_UB) WSP(unsigned char, Vq, O_VB) WSP(float, Us, O_US) WSP(float, Vs, O_VS)
  WSP(u16, omix, O_OMIX) WSP(float2, cs, O_CS) WSP(u16, projb, O_PROJB) WSP(u16, keyH, O_KEYH) WSP(u16, keyL, O_KEYL)
  WSP(u16, xb, O_XB) WSP(u16, cqb, O_CQB) WSP(u16, ckvb, O_CKVB) WSP(u16, Qm, O_QM) WSP(u16, Km, O_KM) WSP(u16, VmT, O_VMT)
  WSP(u16, Qf, O_QF) WSP(u16, Kf, O_KF) WSP(u16, VfT, O_VFT) WSP(float, logf, O_LOGF) WSP(float, Fk, O_FK) WSP(float, krsum, O_KRS) WSP(float, rss, O_RSS)
  WSP(float, y1, O_Y1) WSP(u16, h1b, O_H1B) WSP(int, eidxG, O_PQ) WSP(float, gateG, O_GATE) WSP(u16, r2b, O_R2B)
#undef WSP
};

__device__ __forceinline__ int TID() { int t = threadIdx.x; asm volatile("" : "+v"(t)); return t; }
__device__ __forceinline__ unsigned pk2(float lo, float hi) {
  unsigned r; asm volatile("v_cvt_pk_bf16_f32 %0, %1, %2" : "=v"(r) : "v"(lo), "v"(hi)); return r;
}
__device__ __forceinline__ u16 f2bf(float f) { return (u16)(pk2(f, 0.f) & 0xffffu); }
__device__ __forceinline__ float bf2f(u16 v) { return __uint_as_float(((unsigned)v) << 16); }
__device__ __forceinline__ float bflo(unsigned v) { return __uint_as_float(v << 16); }
__device__ __forceinline__ float bfhi(unsigned v) { return __uint_as_float(v & 0xffff0000u); }

template <int CTRL> __device__ __forceinline__ int dppi(int v) { return __builtin_amdgcn_update_dpp(0, v, CTRL, 0xF, 0xF, false); }
template <int CTRL> __device__ __forceinline__ float dppf(float v) { return __int_as_float(dppi<CTRL>(__float_as_int(v))); }
__device__ __forceinline__ float rdlane(float v, int l) { return __int_as_float(__builtin_amdgcn_readlane(__float_as_int(v), l)); }

__device__ __forceinline__ float row_sum(float v) {
  v += dppf<0xB1>(v); v += dppf<0x4E>(v); v += dppf<0x141>(v); v += dppf<0x140>(v); return v;
}
__device__ __forceinline__ float row_max(float v) {
  v = fmaxf(v, dppf<0xB1>(v)); v = fmaxf(v, dppf<0x4E>(v)); v = fmaxf(v, dppf<0x141>(v)); v = fmaxf(v, dppf<0x140>(v)); return v;
}
__device__ __forceinline__ float wave_sum(float v) {
  v = row_sum(v);
  return (rdlane(v, 0) + rdlane(v, 16)) + (rdlane(v, 32) + rdlane(v, 48));
}
__device__ __forceinline__ float wave_max(float v) {
  v = row_max(v);
  return fmaxf(fmaxf(rdlane(v, 0), rdlane(v, 16)), fmaxf(rdlane(v, 32), rdlane(v, 48)));
}
__device__ __forceinline__ unsigned wave_umax(unsigned v) {
  unsigned t;
  t = (unsigned)dppi<0xB1>((int)v); v = v > t ? v : t;
  t = (unsigned)dppi<0x4E>((int)v); v = v > t ? v : t;
  t = (unsigned)dppi<0x141>((int)v); v = v > t ? v : t;
  t = (unsigned)dppi<0x140>((int)v); v = v > t ? v : t;
  unsigned a = (unsigned)__builtin_amdgcn_readlane((int)v, 0), b = (unsigned)__builtin_amdgcn_readlane((int)v, 16);
  unsigned c = (unsigned)__builtin_amdgcn_readlane((int)v, 32), d = (unsigned)__builtin_amdgcn_readlane((int)v, 48);
  a = a > b ? a : b; c = c > d ? c : d; return a > c ? a : c;
}
__device__ __forceinline__ unsigned ordkey(float f) {
  unsigned u = __float_as_uint(f);
  return (u & 0x80000000u) ? ~u : (u | 0x80000000u);
}

__device__ __forceinline__ unsigned fp6_code(float v) {
  const float a = fabsf(v);
  int code = a < 2.f ? (int)rintf(a * 8.f) : (a < 4.f ? 16 + (int)rintf((a - 2.f) * 4.f) : 24 + (int)rintf((a - 4.f) * 2.f));
  code = code > 31 ? 31 : code;
  return (unsigned)code | (v < 0.f ? 32u : 0u);
}
__device__ __forceinline__ void quant_chunk(const Params& p, int chunk) {
  const int tid = TID(), lane = tid & 63, wid = tid >> 6;
#pragma unroll 1
  for (int i8 = 0; i8 < 8; ++i8) {
    const int r = chunk * 64 + wid * 8 + i8;
    const int tab = r >> 14, row = r & 16383;
    const float* src = (tab ? p.peer_v : p.peer_u) + (size_t)row * D_ + lane * 4;
    float4 v[8];
    float am = 0.f;
#pragma unroll
    for (int i = 0; i < 8; ++i) {
      { const f32x4 tv = __builtin_nontemporal_load((const f32x4*)(src + i * 256)); v[i] = make_float4(tv[0], tv[1], tv[2], tv[3]); }
      am = fmaxf(am, fmaxf(fmaxf(fabsf(v[i].x), fabsf(v[i].y)), fmaxf(fabsf(v[i].z), fabsf(v[i].w))));
    }
    am = wave_max(am);
    const float qs = am > 0.f ? 7.5f / am : 1.f;
    unsigned w[6];
#pragma unroll
    for (int g = 0; g < 2; ++g) {
      unsigned long long lo = 0ull; unsigned hi = 0u;
#pragma unroll
      for (int i = 0; i < 4; ++i) {
        const float4 f = v[g * 4 + i];
        const unsigned q4 = fp6_code(f.x * qs) | (fp6_code(f.y * qs) << 6) | (fp6_code(f.z * qs) << 12) | (fp6_code(f.w * qs) << 18);
        if (i == 0) lo |= (unsigned long long)q4;
        if (i == 1) lo |= (unsigned long long)q4 << 24;
        if (i == 2) { lo |= (unsigned long long)q4 << 48; hi |= q4 >> 16; }
        if (i == 3) hi |= q4 << 8;
      }
      w[g * 3 + 0] = (unsigned)lo; w[g * 3 + 1] = (unsigned)(lo >> 32); w[g * 3 + 2] = hi;
    }
    unsigned* dst = (unsigned*)(p.Uq() + (size_t)row * 3072 + tab * 1536 + lane * 24);
    *(u32x2*)dst = u32x2{w[0], w[1]}; *(u32x2*)(dst + 2) = u32x2{w[2], w[3]}; *(u32x2*)(dst + 4) = u32x2{w[4], w[5]};
    if (lane == 0) (tab ? p.Vs() : p.Us())[row] = am > 0.f ? am / 7.5f : 1.f;
  }
}

__device__ void transpose_cvt(const float* __restrict__ W, int ldw, int K, int src_col0, int ncols,
                              u16* __restrict__ WT, int dst_row0, const float* __restrict__ kscale,
                              float* tile, int bid, int nb) {
  const int tiles_k = K / 64, tiles_n = ncols / 64, tid = TID();
#pragma unroll 1
  for (int t = bid; t < tiles_k * tiles_n; t += nb) {
    const int tk = t % tiles_k, tn = t / tiles_k, k0 = tk * 64, n0 = tn * 64;
#pragma unroll
    for (int i = 0; i < 2; ++i) {
      const int r = (tid >> 4) + 32 * i, c = (tid & 15) * 4;
      const f32x4 tv = __builtin_nontemporal_load((const f32x4*)(W + (size_t)(k0 + r) * ldw + src_col0 + n0 + c));
      const float4 v = make_float4(tv[0], tv[1], tv[2], tv[3]);
      const float sc = kscale ? kscale[k0 + r] : 1.f;
      tile[r * 65 + c + 0] = v.x * sc; tile[r * 65 + c + 1] = v.y * sc;
      tile[r * 65 + c + 2] = v.z * sc; tile[r * 65 + c + 3] = v.w * sc;
    }
    __syncthreads();
    {
      const int n = tid >> 3, kk = (tid & 7) * 8;
      unsigned w[4];
#pragma unroll
      for (int e = 0; e < 4; ++e) w[e] = pk2(tile[(kk + 2 * e) * 65 + n], tile[(kk + 2 * e + 1) * 65 + n]);
      *(u32x4*)(WT + (size_t)(dst_row0 + n0 + n) * K + k0 + kk) = u32x4{w[0], w[1], w[2], w[3]};
    }
    __syncthreads();
  }
}

__device__ void cvt_bf16(const float* __restrict__ src, u16* __restrict__ dst, size_t n8, size_t gtid, size_t gthreads) {
  for (size_t i = gtid; i < n8; i += gthreads) {
    const float4 a = ((const float4*)src)[2 * i], b = ((const float4*)src)[2 * i + 1];
    ((u32x4*)dst)[i] = u32x4{pk2(a.x, a.y), pk2(a.z, a.w), pk2(b.x, b.y), pk2(b.z, b.w)};
  }
}

__device__ void phase_prep(const Params& p, char* smem, int bid, int nb) {
  const int tid = TID(), lane = tid & 63, wid = tid >> 6;
  float* tile = (float*)smem;
  if (bid == 0 && tid == 0) p.ctr()[0] = 0;
  transpose_cvt(p.w_in, INW, D_, 0, 1024, p.WinT(), 0, nullptr, tile, bid, nb);
  transpose_cvt(p.w_in, INW, D_, 1088, 3072, p.WinT(), 1024, nullptr, tile, bid, nb);
  transpose_cvt(p.w_in, INW, D_, 1024, 64, p.WinT(), 4096, nullptr, tile, bid, nb);
  transpose_cvt(p.w_uq, 1536, 512, 0, 1536, p.WuqT(), 0, p.g_q, tile, bid, nb);
  transpose_cvt(p.w_ukv, 2048, 512, 0, 2048, p.WukvT(), 0, p.g_kv, tile, bid, nb);
  transpose_cvt(p.w_out, 2048, 2048, 0, 2048, p.WoutT(), 0, nullptr, tile, bid, nb);
  transpose_cvt(p.peer_wq, 1024, 2048, 0, 1024, p.WpqT(), 0, nullptr, tile, bid, nb);
  transpose_cvt(p.wgate, 2048, 2048, 0, 2048, p.WgT(), 0, nullptr, tile, bid, nb);
  transpose_cvt(p.wproj, 2048, 256, 0, 2048, p.WpT(), 0, nullptr, tile, bid, nb);
  const size_t gtid = (size_t)bid * NT + tid, gth = (size_t)nb * NT;
  for (size_t i = gtid; i < (size_t)192 * 2048 / 8; i += gth) ((u32x4*)(p.WinT() + (size_t)4160 * 2048))[i] = u32x4{0, 0, 0, 0};
  cvt_bf16(p.p, p.pb(), (size_t)T_ * 256 / 8, gtid, gth);
  for (size_t i = gtid; i < (size_t)T_ * 64 / 4; i += gth) ((float4*)p.krsum())[i] = make_float4(0.f, 0.f, 0.f, 0.f);
  for (size_t i = gtid; i < (size_t)2 * T_ / 4; i += gth) ((float4*)p.rss())[i] = make_float4(0.f, 0.f, 0.f, 0.f);
  for (size_t i = gtid; i < (size_t)2 * 65536; i += gth) {
    const float v = i < 65536 ? p.keys1[i] : p.keys2[i - 65536];
    const u16 h = f2bf(v);
    p.keyH()[i] = h; p.keyL()[i] = f2bf(v - bf2f(h));
  }
  for (size_t i = gtid; i < (size_t)T_ * 32; i += gth) {
    const int t = (int)(i >> 5), fi = (int)(i & 31);
    const float invf = 1.0f / powf(10000.0f, (float)(2 * fi) / 64.0f);
    const float ang = (float)p.positions[t] * invf;
    const double rev = (double)ang * 0.15915494309189535;
    const float fr = (float)(rev - rint(rev));
    p.cs()[i] = make_float2(__builtin_amdgcn_cosf(fr), __builtin_amdgcn_sinf(fr));
  }
  __syncthreads();
  float* wff = (float*)smem;
  for (int i = tid; i < 2048 * 2; i += NT) {
    const int k = i >> 1, hf = i & 1;
    *(float4*)(wff + (k ^ ((k >> 3) & 7)) * 8 + hf * 4) = *(const float4*)(p.w_in + (size_t)k * INW + 4160 + hf * 4);
  }
  __syncthreads();
  for (int t = bid * 8 + wid; t < T_; t += nb * 8) {
    float a[8];
#pragma unroll
    for (int e = 0; e < 8; ++e) a[e] = 0.f;
#pragma unroll 1
    for (int i = 0; i < 4; ++i) {
      const int k = (i * 64 + lane) * 8;
      const f32x4 xa = __builtin_nontemporal_load((const f32x4*)(p.x + (size_t)t * D_ + k)), xb4 = __builtin_nontemporal_load((const f32x4*)(p.x + (size_t)t * D_ + k + 4));
      const float4 x0 = make_float4(xa[0], xa[1], xa[2], xa[3]), x1 = make_float4(xb4[0], xb4[1], xb4[2], xb4[3]);
      *(u32x4*)(p.xb() + (size_t)t * D_ + k) = u32x4{pk2(x0.x, x0.y), pk2(x0.z, x0.w), pk2(x1.x, x1.y), pk2(x1.z, x1.w)};
      const float xs[8] = {x0.x, x0.y, x0.z, x0.w, x1.x, x1.y, x1.z, x1.w};
#pragma unroll
      for (int j = 0; j < 8; ++j) {
        const int kr = (k + j) ^ (lane & 7);
        const float4 w0 = *(const float4*)(wff + kr * 8), w1 = *(const float4*)(wff + kr * 8 + 4);
        a[0] += xs[j] * w0.x; a[1] += xs[j] * w0.y; a[2] += xs[j] * w0.z; a[3] += xs[j] * w0.w;
        a[4] += xs[j] * w1.x; a[5] += xs[j] * w1.y; a[6] += xs[j] * w1.z; a[7] += xs[j] * w1.w;
      }
    }
    float mine = 0.f;
#pragma unroll
    for (int e = 0; e < 8; ++e) { const float s = wave_sum(a[e]); if (lane == e) mine = s; }
    if (lane < 8) {
      const float z = mine + p.b_forget[lane];
      const float ls = fminf(z, 0.f) - log1pf(expf(-fabsf(z)));
      const int b = t >> 12, s = t & 4095;
      p.logf()[((size_t)(b * 8 + lane)) * S_ + s] = ls;
    }
  }
}

template <int WM, int WN>
__device__ __forceinline__ void gemm_core(const u16* __restrict__ A, int lda, const u16* __restrict__ Bt, int ldb,
                                          int K, int brow, int bcol, char* smem, f32x4 (&acc)[4 / WM][4][4]) {
  constexpr int MS = 4 / WM, BN = 64 * WN, NBL = BN / 64;
  static_assert(WM * WN == 8, "8 waves");
  const int tid = TID(), wid = tid >> 6, lane = tid & 63, wr = wid / WN, wc = wid % WN, fr = lane & 15, fq = lane >> 4;
#pragma unroll
  for (int h = 0; h < MS; ++h)
#pragma unroll
    for (int m = 0; m < 4; ++m)
#pragma unroll
      for (int n = 0; n < 4; ++n) acc[h][m][n] = f32x4{0.f, 0.f, 0.f, 0.f};
  const int nk = K / 64;
  const int srow = tid >> 3, sch = (tid & 7) ^ ((tid >> 4) & 7);
  const u16* ga = A + (size_t)(brow + srow) * lda + sch * 8;
  const u16* gb = Bt + (size_t)(bcol + srow) * ldb + sch * 8;
  char* sdst = smem + tid * 16;
  auto issue = [&](int kt, int st) {
    char* sa = sdst + st * 65536;
#pragma unroll
    for (int i = 0; i < 4; ++i)
      __builtin_amdgcn_global_load_lds((const unsigned*)(ga + (size_t)i * 64 * lda + kt * 64), (unsigned*)(sa + i * 8192), 16, 0, 0);
#pragma unroll
    for (int i = 0; i < NBL; ++i)
      __builtin_amdgcn_global_load_lds((const unsigned*)(gb + (size_t)i * 64 * ldb + kt * 64), (unsigned*)(sa + 32768 + i * 8192), 16, 0, 0);
  };
  const int fx = (fr >> 1) & 7;
  const int arow = (wr * (256 / WM) + fr) * 128, brw = 32768 + (wc * 64 + fr) * 128;
  const int c0 = (fq ^ fx) * 16, c1 = ((4 + fq) ^ fx) * 16;
  asm volatile("s_waitcnt vmcnt(0)" ::: "memory");
  __syncthreads();
  issue(0, 0);
#pragma unroll 1
  for (int kt = 0; kt < nk; ++kt) {
    asm volatile("s_waitcnt vmcnt(0)" ::: "memory");
    __builtin_amdgcn_s_barrier();
    asm volatile("" ::: "memory");
    if (kt + 1 < nk) issue(kt + 1, (kt + 1) & 1);
    const char* sb = smem + (kt & 1) * 65536;
#pragma unroll
    for (int ks = 0; ks < 2; ++ks) {
      const int co = ks ? c1 : c0;
      bf16x8 Bl[4];
#pragma unroll
      for (int n = 0; n < 4; ++n) Bl[n] = *reinterpret_cast<const bf16x8*>(sb + brw + co + n * 2048);
#pragma unroll
      for (int h = 0; h < MS; ++h) {
        bf16x8 At[4];
#pragma unroll
        for (int m = 0; m < 4; ++m) At[m] = *reinterpret_cast<const bf16x8*>(sb + arow + co + (h * 4 + m) * 2048);
#pragma unroll
        for (int m = 0; m < 4; ++m)
#pragma unroll
          for (int n = 0; n < 4; ++n) acc[h][m][n] = __builtin_amdgcn_mfma_f32_16x16x32_bf16(At[m], Bl[n], acc[h][m][n], 0, 0, 0);
      }
    }
  }
}

template <int WM, int WN, class Epi>
__device__ __forceinline__ void gemm_tile(const u16* __restrict__ A, int lda, const u16* __restrict__ Bt, int ldb,
                                          int K, int brow, int bcol, char* smem, Epi epi) {
  constexpr int MS = 4 / WM;
  const int tid = TID(), wid = tid >> 6, lane = tid & 63, wr = wid / WN, wc = wid % WN, fr = lane & 15, fq = lane >> 4;
  f32x4 acc[MS][4][4];
  gemm_core<WM, WN>(A, lda, Bt, ldb, K, brow, bcol, smem, acc);
#pragma unroll
  for (int h = 0; h < MS; ++h) epi(acc[h], brow + wr * (256 / WM) + h * 64, bcol + wc * 64, fr, fq);
}

namespace pg8 {
#define PG8_LAS __attribute__((address_space(3)))
typedef unsigned short bf16_t;
constexpr int BM = 256, BK = 64, HALF = 128, HTB = HALF * BK * 2  , STAGE_BYTES = 8 * HTB, NXCD = 8, WGM = 8;

__host__ __device__ __forceinline__ int lds_byte(int r, int c) { const int st = (r >> 4) * 2 + (c >> 5), rr = r & 15, cc = c & 31, ob = rr * 64 + cc * 2; return st * 1024 + (ob ^ (((ob >> 9) & 1) << 5)); }
__host__ __device__ __forceinline__ void stage_rc(int b, int& R, int& C) { const int st = b / 1024, sb = b % 1024, swz = sb ^ (((sb >> 9) & 1) << 5); R = (st >> 1) * 16 + swz / 64; C = (st & 1) * 32 + (swz % 64) / 2; }
__host__ __device__ __forceinline__ int perm32(int rho) { const int n = rho >> 4, i = rho & 15; return 8 * (i >> 2) + 4 * n + (i & 3); }
struct Unit { int pm, pn; };
struct Gemm { const bf16_t* A; const bf16_t* Bt; int M, N, K; };
struct StaticOrder {
    int nM, nN, nwg, G, c;
    __device__ void init(int M, int N, int G_, int c_) { nM = M / BM; nN = N / BM; nwg = nM * nN; G = G_; c = c_; }
    __device__ bool next(int i, Unit& u) const {
        const long L = (long)i * G + c; if (L >= nwg) return false;
        int wgid = (int)L; { const int q = nwg / NXCD, r = nwg % NXCD, xcd = wgid % NXCD, off = wgid / NXCD; wgid = (xcd < r ? xcd * (q + 1) : r * (q + 1) + (xcd - r) * q) + off; }
        const int nig = WGM * nN, gid = wgid / nig, fm = gid * WGM, gsz = (nM - fm) < WGM ? (nM - fm) : WGM;
        u.pm = fm + ((wgid % nig) % gsz); u.pn = (wgid % nig) / gsz; return true;
    }
    __device__ __forceinline__ void a_ready(const Unit&) const {}
    __device__ __forceinline__ void done(const Unit&) const {}
};
template <class Epi, class Sched, bool STAMP = false>
__device__ __forceinline__ void gemm_phase(PG8_LAS unsigned char* lds, const Gemm g, const Sched& S, const Epi& E, unsigned long long* stamps) {
    const int tid = TID(), wid = __builtin_amdgcn_readfirstlane(tid >> 6), lane = tid & 63, wr = wid >> 2, wc = wid & 3, fr = lane & 15, fq = lane >> 4;
    const int K = g.K, nt = K / BK;
    int ts_lo = 0, ts_hi = 0, nts = 0; const unsigned long long rt_entry = STAMP ? (unsigned long long)wall_clock64() : 0ull;
#define PG8_STAMP() do { if (STAMP && wid == 0 && nts < 64) { const unsigned long long _c = (unsigned long long)clock64(); \
        ts_lo = (lane == nts) ? (int)(unsigned)_c : ts_lo; ts_hi = (lane == nts) ? (int)(unsigned)(_c >> 32) : ts_hi; ++nts; } } while (0)
    PG8_STAMP();
    unsigned voffA[2], voffB[2];
#pragma unroll
    for (int i = 0; i < 2; ++i) { int R, C; stage_rc(tid * 16 + i * 8192, R, C); const int Rb = Epi::PERM ? ((R & ~31) + perm32(R & 31)) : R;
        voffA[i] = (unsigned)(R * K + C) * 2u; voffB[i] = (unsigned)(Rb * K + C) * 2u; }
    const size_t kstep = (size_t)(BK * 2);
    const size_t hstep = (size_t)HALF * K * 2;
    const size_t tstep = 2 * hstep;
    const unsigned ldsw = (unsigned)wid * 1024u;
    const int aoff = lds_byte(wr * 64 + fr, fq * 8), boff = lds_byte(wc * 32 + fr, fq * 8);
#define PG8_SA(b, h) (((b) * 2 + (h)) * HTB)
#define PG8_SB(b, h) ((4 + (b) * 2 + (h)) * HTB)
#define PG8_STAGE(bufoff, gbase, voff) do { _Pragma("unroll") for (int _i = 0; _i < 2; ++_i) \
        __builtin_amdgcn_global_load_lds((const unsigned*)((const char*)(gbase) + (voff)[_i]), (PG8_LAS unsigned*)(lds + (bufoff) + ldsw + _i * 8192), 16, 0, 0); } while (0)
#define PG8_LDA(dst, b, h) do { _Pragma("unroll") for (int m = 0; m < 4; ++m) _Pragma("unroll") for (int k = 0; k < 2; ++k) dst[m][k] = *(const PG8_LAS bf16x8*)(lds + PG8_SA(b, h) + aoff + m * 2048 + k * 1024); } while (0)
#define PG8_LDB(dst, b, h) do { _Pragma("unroll") for (int n = 0; n < 2; ++n) _Pragma("unroll") for (int k = 0; k < 2; ++k) dst[n][k] = *(const PG8_LAS bf16x8*)(lds + PG8_SB(b, h) + boff + n * 2048 + k * 1024); } while (0)
#define PG8_MMA(ai, bj, At, Bt) do { __builtin_amdgcn_s_setprio(1); _Pragma("unroll") for (int m = 0; m < 4; ++m) _Pragma("unroll") for (int n = 0; n < 2; ++n) _Pragma("unroll") for (int k = 0; k < 2; ++k) \
        acc[ai][bj][m][n] = __builtin_amdgcn_mfma_f32_16x16x32_bf16(Bt[n][k], At[m][k], acc[ai][bj][m][n], 0, 0, 0); __builtin_amdgcn_s_setprio(0); } while (0)
#define PG8_WAIT_V(n) asm volatile("s_waitcnt vmcnt(" #n ")" ::: "memory")
#define PG8_WAIT_L(n) asm volatile("s_waitcnt lgkmcnt(" #n ")" ::: "memory")
#define PG8_BAR __builtin_amdgcn_s_barrier()
#define PG8_SCHED __builtin_amdgcn_sched_barrier(0)
    Unit cur, nxt; int ui = 0;
    if (!S.next(0, cur)) return;
    f32x4 acc[2][2][4][2];
#pragma unroll
    for (int a = 0; a < 2; ++a)
#pragma unroll
        for (int b = 0; b < 2; ++b)
#pragma unroll
            for (int m = 0; m < 4; ++m)
#pragma unroll
                for (int n = 0; n < 2; ++n) acc[a][b][m][n] = (f32x4){0.f, 0.f, 0.f, 0.f};
    bf16x8 At[4][2], B0[2][2], B1[2][2];
    const char* cA = (const char*)g.A + (size_t)cur.pm * tstep; const char* cB = (const char*)g.Bt + (size_t)cur.pn * tstep;
    S.a_ready(cur);
    PG8_STAGE(PG8_SB(0, 0), cB, voffB); PG8_STAGE(PG8_SA(0, 0), cA, voffA); PG8_STAGE(PG8_SB(0, 1), cB + hstep, voffB); PG8_STAGE(PG8_SA(0, 1), cA + hstep, voffA);
    if (wr == 1) PG8_BAR;
    PG8_WAIT_V(4); PG8_BAR;
    PG8_STAGE(PG8_SB(1, 0), cB + kstep, voffB); PG8_STAGE(PG8_SA(1, 0), cA + kstep, voffA); PG8_STAGE(PG8_SB(1, 1), cB + hstep + kstep, voffB);
    PG8_WAIT_V(6); PG8_BAR;
    PG8_STAMP();
    for (;;) {
        const bool has_next = S.next(ui + 1, nxt);
        const char* nA = has_next ? (const char*)g.A + (size_t)nxt.pm * tstep : cA; const char* nB = has_next ? (const char*)g.Bt + (size_t)nxt.pn * tstep : cB;
        for (int t = 0; t < nt; t += 2) {
            const bool last = (t == nt - 2);
            const char* a1 = cA + (size_t)(t + 1) * kstep;
            const char* a2 = last ? nA : cA + (size_t)(t + 2) * kstep; const char* b2 = last ? nB : cB + (size_t)(t + 2) * kstep;
            const char* a3 = a2 + kstep; const char* b3 = b2 + kstep;
            if (last && has_next) S.a_ready(nxt);
            PG8_LDB(B0, 0, 0); PG8_SCHED; PG8_LDA(At, 0, 0); PG8_STAGE(PG8_SA(1, 1), a1 + hstep, voffA);
            PG8_WAIT_L(8); PG8_BAR; PG8_WAIT_L(0); PG8_MMA(0, 0, At, B0); PG8_BAR; PG8_SCHED;
            PG8_LDB(B1, 0, 1); PG8_STAGE(PG8_SB(0, 0), b2, voffB);
            PG8_BAR; PG8_WAIT_L(0); PG8_MMA(0, 1, At, B1); PG8_BAR;
            PG8_LDA(At, 0, 1); PG8_STAGE(PG8_SA(0, 0), a2, voffA);
            PG8_BAR; PG8_WAIT_L(0); PG8_MMA(1, 0, At, B0); PG8_BAR; PG8_SCHED;
            PG8_STAGE(PG8_SB(0, 1), b2 + hstep, voffB);
            PG8_WAIT_V(6); PG8_BAR; PG8_MMA(1, 1, At, B1); PG8_BAR;
            PG8_LDB(B0, 1, 0); PG8_SCHED; PG8_LDA(At, 1, 0); PG8_STAGE(PG8_SA(0, 1), a2 + hstep, voffA);
            PG8_WAIT_L(8); PG8_BAR; PG8_WAIT_L(0); PG8_MMA(0, 0, At, B0); PG8_BAR; PG8_SCHED;
            PG8_LDB(B1, 1, 1); PG8_STAGE(PG8_SB(1, 0), b3, voffB);
            PG8_BAR; PG8_WAIT_L(0); PG8_MMA(0, 1, At, B1); PG8_BAR;
            PG8_LDA(At, 1, 1); PG8_STAGE(PG8_SA(1, 0), a3, voffA);
            PG8_BAR; PG8_WAIT_L(0); PG8_MMA(1, 0, At, B0); PG8_BAR; PG8_SCHED;
            PG8_STAGE(PG8_SB(1, 1), b3 + hstep, voffB);
            PG8_WAIT_V(6); PG8_BAR; PG8_MMA(1, 1, At, B1); PG8_BAR;
        }
        PG8_STAMP();
        if constexpr (!Epi::AFTER_DRAIN) { E(acc, cur, wr, wc, fr, fq); S.done(cur); }
        PG8_STAMP();
        if (!has_next) break;
#pragma unroll
        for (int a = 0; a < 2; ++a)
#pragma unroll
            for (int b = 0; b < 2; ++b)
#pragma unroll
                for (int m = 0; m < 4; ++m)
#pragma unroll
                    for (int n = 0; n < 2; ++n) acc[a][b][m][n] = (f32x4){0.f, 0.f, 0.f, 0.f};
        cur = nxt; cA = nA; cB = nB; ++ui;
    }
    PG8_WAIT_V(0);
    if (wr == 0) PG8_BAR;
    PG8_BAR;
    if constexpr (Epi::AFTER_DRAIN) { E.fused(acc, cur, wr, wc, fr, fq, lds, wid, lane); S.done(cur); }
    PG8_STAMP();
    if (STAMP && wid == 0) { stamps[lane] = lane < nts ? (((unsigned long long)(unsigned)ts_hi << 32) | (unsigned)ts_lo) : 0ull;
        if (lane == 62) stamps[62] = rt_entry; if (lane == 63) stamps[63] = (unsigned long long)wall_clock64(); }
#undef PG8_STAMP
#undef PG8_SA
#undef PG8_SB
#undef PG8_STAGE
#undef PG8_LDA
#undef PG8_LDB
#undef PG8_MMA
#undef PG8_WAIT_V
#undef PG8_WAIT_L
#undef PG8_BAR
#undef PG8_SCHED
}
}


__device__ __forceinline__ u32x4 pack8(const f32x4& a, const f32x4& b) { return u32x4{pk2(a[0], a[1]), pk2(a[2], a[3]), pk2(b[0], b[1]), pk2(b[2], b[3])}; }
__device__ __forceinline__ float sumsq4(const f32x4& a) { return (a[0] * a[0] + a[1] * a[1]) + (a[2] * a[2] + a[3] * a[3]); }
__device__ __forceinline__ void store_tr8(u16* vt, const f32x4& a, const f32x4& b) {
  vt[0] = f2bf(a[0]); vt[(size_t)S_] = f2bf(a[1]); vt[(size_t)2 * S_] = f2bf(a[2]); vt[(size_t)3 * S_] = f2bf(a[3]);
  vt[(size_t)4 * S_] = f2bf(b[0]); vt[(size_t)5 * S_] = f2bf(b[1]); vt[(size_t)6 * S_] = f2bf(b[2]); vt[(size_t)7 * S_] = f2bf(b[3]);
}
struct EpiInproj {
  static constexpr bool PERM = true, AFTER_DRAIN = false;
  u16 *cqb, *ckvb, *Qf, *Kf, *VfT; float* rss;
  __device__ __forceinline__ void operator()(const f32x4 (&acc)[2][2][4][2], const pg8::Unit& u, int wr, int wc, int fr, int fq) const {
    const int ct = u.pn * 256;
#pragma unroll
    for (int ai = 0; ai < 2; ++ai)
#pragma unroll
      for (int m = 0; m < 4; ++m) {
        const int row = u.pm * 256 + ai * 128 + wr * 64 + m * 16 + fr, b = row >> 12, s = row & 4095;
        float ss = 0.f;
#pragma unroll
        for (int bj = 0; bj < 2; ++bj) {
          const int c0 = ct + bj * 128 + wc * 32 + 8 * fq;
          const f32x4 v0 = acc[ai][bj][m][0], v1 = acc[ai][bj][m][1];
          if (ct < 1024) {
            u16* dst = ct < 512 ? cqb : ckvb;
            *(u32x4*)(dst + (size_t)row * 512 + (c0 & 511)) = pack8(v0, v1);
            ss += sumsq4(v0) + sumsq4(v1);
          } else if (ct < 3072) {
            int c = c0 - 1024; u16* dst = c < 1024 ? Qf : Kf; c &= 1023;
            *(u32x4*)(dst + ((size_t)(b * 8 + (c >> 7)) * S_ + s) * 128 + (c & 127)) = pack8(v0, v1);
          } else {
            const int c = c0 - 3072;
            store_tr8(VfT + ((size_t)(b * 8 + (c >> 7)) * 128 + (c & 127)) * S_ + s, v0, v1);
          }
        }
        if (ct < 1024) atomicAdd(rss + (ct < 512 ? 0 : T_) + row, ss);
        __builtin_amdgcn_sched_barrier(0);
      }
  }
};
struct EpiQup {
  static constexpr bool PERM = true, AFTER_DRAIN = false;
  u16* Qm; const float* rss;
  __device__ __forceinline__ void operator()(const f32x4 (&acc)[2][2][4][2], const pg8::Unit& u, int wr, int wc, int fr, int fq) const {
#pragma unroll
    for (int ai = 0; ai < 2; ++ai)
#pragma unroll
      for (int m = 0; m < 4; ++m) {
        const int row = u.pm * 256 + ai * 128 + wr * 64 + m * 16 + fr, b = row >> 12, s = row & 4095;
        const float rs = rsqrtf(rss[row] * (1.f / 512.f) + EPS);
#pragma unroll
        for (int bj = 0; bj < 2; ++bj) {
          const int c0 = u.pn * 256 + bj * 128 + wc * 32 + 8 * fq, hh = c0 / 192, off = c0 % 192;
          *(u32x4*)(Qm + ((size_t)(b * 8 + hh) * S_ + s) * 192 + off) = pack8(acc[ai][bj][m][0] * rs, acc[ai][bj][m][1] * rs);
        }
        __builtin_amdgcn_sched_barrier(0);
      }
  }
};
struct EpiKVup {
  static constexpr bool PERM = true, AFTER_DRAIN = false;
  u16 *Km, *VmT; const float* rss;
  __device__ __forceinline__ void operator()(const f32x4 (&acc)[2][2][4][2], const pg8::Unit& u, int wr, int wc, int fr, int fq) const {
    const int hh = u.pn;
#pragma unroll
    for (int ai = 0; ai < 2; ++ai)
#pragma unroll
      for (int m = 0; m < 4; ++m) {
        const int row = u.pm * 256 + ai * 128 + wr * 64 + m * 16 + fr, b = row >> 12, s = row & 4095;
        const float rs = rsqrtf(rss[T_ + row] * (1.f / 512.f) + EPS);
        const int off = wc * 32 + 8 * fq;
        *(u32x4*)(Km + ((size_t)(b * 8 + hh) * S_ + s) * 192 + off) = pack8(acc[ai][0][m][0] * rs, acc[ai][0][m][1] * rs);
        store_tr8(VmT + ((size_t)(b * 8 + hh) * 128 + off) * S_ + s, acc[ai][1][m][0] * rs, acc[ai][1][m][1] * rs);
        __builtin_amdgcn_sched_barrier(0);
      }
  }
};
struct EpiProj {
  static constexpr bool PERM = true, AFTER_DRAIN = false;
  u16* projb;
  __device__ __forceinline__ void operator()(const f32x4 (&acc)[2][2][4][2], const pg8::Unit& u, int wr, int wc, int fr, int fq) const {
#pragma unroll
    for (int ai = 0; ai < 2; ++ai)
#pragma unroll
      for (int m = 0; m < 4; ++m) {
        const int row = u.pm * 256 + ai * 128 + wr * 64 + m * 16 + fr;
#pragma unroll
        for (int bj = 0; bj < 2; ++bj)
          *(u32x4*)(projb + (size_t)row * D_ + u.pn * 256 + bj * 128 + wc * 32 + 8 * fq) = pack8(acc[ai][bj][m][0], acc[ai][bj][m][1]);
      }
  }
};
struct EpiOut {
  static constexpr bool PERM = false, AFTER_DRAIN = false;
  const float* x; u16* y1;
  __device__ __forceinline__ void operator()(const f32x4 (&acc)[2][2][4][2], const pg8::Unit& u, int wr, int wc, int fr, int fq) const {
#pragma unroll
    for (int ai = 0; ai < 2; ++ai)
#pragma unroll
      for (int m = 0; m < 4; ++m) {
        const size_t rb = (size_t)(u.pm * 256 + ai * 128 + wr * 64 + m * 16 + fr) * D_ + u.pn * 256 + wc * 32 + 4 * fq;
#pragma unroll
        for (int bj = 0; bj < 2; ++bj)
#pragma unroll
          for (int n = 0; n < 2; ++n) {
            const size_t o = rb + bj * 128 + n * 16;
            const f32x4 xv = *(const f32x4*)(x + o);
            const f32x4 y = xv * ALPHA + acc[ai][bj][m][n];
            *(u32x2*)(y1 + o) = u32x2{pk2(y[0], y[1]), pk2(y[2], y[3])};
          }
      }
  }
};
struct EpiGate {
  static constexpr bool PERM = false, AFTER_DRAIN = false;
  const u16* h1b; const u16* projb; u16* r2b;
  __device__ __forceinline__ void operator()(const f32x4 (&acc)[2][2][4][2], const pg8::Unit& u, int wr, int wc, int fr, int fq) const {
#pragma unroll
    for (int ai = 0; ai < 2; ++ai)
#pragma unroll
      for (int m = 0; m < 4; ++m) {
        const size_t rb = (size_t)(u.pm * 256 + ai * 128 + wr * 64 + m * 16 + fr) * D_ + u.pn * 256 + wc * 32 + 4 * fq;
#pragma unroll
        for (int bj = 0; bj < 2; ++bj)
#pragma unroll
          for (int n = 0; n < 2; ++n) {
            const size_t o = rb + bj * 128 + n * 16;
            const u32x2 hb = *(const u32x2*)(h1b + o);
            const f32x4 hv = {bflo(hb[0]), bfhi(hb[0]), bflo(hb[1]), bfhi(hb[1])};
            const u32x2 pj = *(const u32x2*)(projb + o);
            const f32x4 a = acc[ai][bj][m][n];
            f32x4 r;
            r[0] = ALPHA * hv[0] + bflo(pj[0]) / (1.f + __expf(-a[0])); r[1] = ALPHA * hv[1] + bfhi(pj[0]) / (1.f + __expf(-a[1]));
            r[2] = ALPHA * hv[2] + bflo(pj[1]) / (1.f + __expf(-a[2])); r[3] = ALPHA * hv[3] + bfhi(pj[1]) / (1.f + __expf(-a[3]));
            *(u32x2*)(r2b + o) = u32x2{pk2(r[0], r[1]), pk2(r[2], r[3])};
          }
      }
  }
};

__device__ __forceinline__ int vblock(int bid, int nb) { return (nb & 7) ? bid : (bid & 7) * (nb >> 3) + (bid >> 3); }
__device__ __forceinline__ void tile_rc(int t, int Nt, int& tm, int& tn) {
  const int g = t / (8 * Nt), q = t % (8 * Nt);
  tn = q >> 3; tm = g * 8 + (q & 7);
}

__device__ void phase_inproj(const Params& p, char* smem, int bid, int nb) {
  {
    EpiInproj E{p.cqb(), p.ckvb(), p.Qf(), p.Kf(), p.VfT(), p.rss()};
    pg8::Gemm g{p.xb(), p.WinT(), T_, 4096, D_};
    pg8::StaticOrder S; S.init(T_, 4096, nb, bid);
    pg8::gemm_phase((PG8_LAS unsigned char*)smem, g, S, E, nullptr);
  }
  for (int t = vblock(bid, nb); t < 256; t += nb) {
    const int tm = t >> 3, ks = t & 7;
    f32x4 acc[2][4][4];
    gemm_core<2, 4>(p.xb() + ks * 256, D_, p.WinT() + ks * 256, D_, 256, tm * 256, 4096, smem, acc);
    const int tid = TID(), wid = tid >> 6, lane = tid & 63, wr = wid >> 2, wc = wid & 3, fr = lane & 15, fq = lane >> 4;
    if (wc == 0) {
#pragma unroll
      for (int h = 0; h < 2; ++h) {
        float* kd = p.krsum() + (size_t)(tm * 256 + wr * 128 + h * 64 + fq * 4) * 64 + fr;
#pragma unroll
        for (int m = 0; m < 4; ++m)
#pragma unroll
          for (int n = 0; n < 4; ++n)
#pragma unroll
            for (int j = 0; j < 4; ++j) atomicAdd(kd + (m * 16 + j) * 64 + n * 16, acc[h][m][n][j]);
      }
    }
  }
}

__device__ void phase_up(const Params& p, char* smem, int bid, int nb) {
  PG8_LAS unsigned char* lds = (PG8_LAS unsigned char*)smem;
  {
    EpiQup E{p.Qm(), p.rss()};
    pg8::Gemm g{p.cqb(), p.WuqT(), T_, 1536, 512};
    pg8::StaticOrder S; S.init(T_, 1536, nb, (bid + nb - 64) % nb);
    pg8::gemm_phase(lds, g, S, E, nullptr);
  }
  {
    EpiKVup E{p.Km(), p.VmT(), p.rss()};
    pg8::Gemm g{p.ckvb(), p.WukvT(), T_, 2048, 512};
    pg8::StaticOrder S; S.init(T_, 2048, nb, bid);
    pg8::gemm_phase(lds, g, S, E, nullptr);
  }
  {
    EpiProj E{p.projb()};
    pg8::Gemm g{p.pb(), p.WpT(), T_, 2048, 256};
    pg8::StaticOrder S; S.init(T_, 2048, nb, bid);
    pg8::gemm_phase(lds, g, S, E, nullptr);
  }
  for (int t = bid; t < 48; t += nb) {
    if (t >= 16) {
      const int r0 = (t - 16) * 256, tid = TID();
#pragma unroll 1
      for (int it = 0; it < 16; ++it) {
        const int pr = it * NT + tid, row = r0 + (pr >> 5), i = pr & 31, b = row >> 12, s = row & 4095;
        const float x1 = p.krsum()[(size_t)row * 64 + i], x2 = p.krsum()[(size_t)row * 64 + 32 + i];
        const float2 cs = p.cs()[(size_t)row * 32 + i];
        const u16 o1 = f2bf(x1 * cs.x - x2 * cs.y), o2 = f2bf(x1 * cs.y + x2 * cs.x);
#pragma unroll
        for (int hh = 0; hh < 8; ++hh) {
          u16* kd = p.Km() + ((size_t)(b * 8 + hh) * S_ + s) * 192 + 128;
          kd[i] = o1; kd[32 + i] = o2;
        }
      }
    } else {
      const int seq = t;
      if ((TID() >> 6) == 0) {
        const int lane = TID() & 63;
        const float* src = p.logf() + (size_t)seq * S_ + lane * 64;
        float* dst = p.Fk() + (size_t)seq * S_ + lane * 64;
        float sum = 0.f;
#pragma unroll
        for (int i = 0; i < 16; ++i) { const float4 v = *(const float4*)(src + i * 4); sum += v.x; sum += v.y; sum += v.z; sum += v.w; }
        float inc = sum;
#pragma unroll
        for (int d = 1; d < 64; d <<= 1) { const float o = __shfl_up(inc, d, 64); if (lane >= d) inc += o; }
        float run = inc - sum;
#pragma unroll
        for (int i = 0; i < 16; ++i) {
          const float4 v = *(const float4*)(src + i * 4); float4 o;
          run += v.x; o.x = run; run += v.y; o.y = run; run += v.z; o.z = run; run += v.w; o.w = run;
          *(float4*)(dst + i * 4) = o;
        }
      }
    }
  }
}

#ifdef ATTN_NAIVE
__device__ void phase_attn_naive(const Params& p, char* smem, int bid, int nb) {
  const int tid = TID(), lane = tid & 63, wid = tid >> 6;
  const int per = NB_ * 8 * S_, nrows = 2 * per;
  for (int r = bid * 4 + wid; r < nrows; r += nb * 4) {
    const int type = r / per, rr = r % per, bh = rr / S_, s = rr % S_;
    const int DQ = type ? 128 : 192;
    const u16* Q = type ? p.Qf() + ((size_t)bh * S_ + s) * 128 : p.Qm() + ((size_t)bh * S_ + s) * 192;
    const u16* Kb = type ? p.Kf() + (size_t)bh * S_ * 128 : p.Km() + (size_t)bh * S_ * 192;
    const u16* VT = (type ? p.VfT() : p.VmT()) + (size_t)bh * 128 * S_;
    const float* F = p.Fk() + (size_t)bh * S_;
    const float scale = type ? 0.08838834764831845f : 0.07216878364870322f;
    float m = -1e30f, l = 0.f;
    float acc[128];
#pragma unroll
    for (int d = 0; d < 128; ++d) acc[d] = 0.f;
    const float fqv = type ? F[s] : 0.f;
    for (int k0 = 0; k0 <= s; k0 += 64) {
      const int key = k0 + lane; const bool valid = key <= s; const int keyc = valid ? key : s;
      const u16* kr = Kb + (size_t)keyc * DQ;
      float sc = 0.f;
      for (int d = 0; d < DQ; d += 8) {
        const u32x4 kv = *(const u32x4*)(kr + d), qv = *(const u32x4*)(Q + d);
#pragma unroll
        for (int w = 0; w < 4; ++w) sc += bflo(kv[w]) * bflo(qv[w]) + bfhi(kv[w]) * bfhi(qv[w]);
      }
      sc *= scale;
      if (type) sc += fqv - F[keyc];
      if (!valid) sc = -1e30f;
      const float mx = wave_max(sc), mn = fmaxf(m, mx), alpha = __expf(m - mn);
      const float pr = valid ? __expf(sc - mn) : 0.f;
      m = mn; l = l * alpha + pr;
#pragma unroll
      for (int d = 0; d < 128; ++d) acc[d] = acc[d] * alpha + pr * bf2f(VT[(size_t)d * S_ + keyc]);
    }
    const float inv = 1.f / wave_sum(l);
    float o0 = 0.f, o1 = 0.f;
#pragma unroll
    for (int d = 0; d < 128; ++d) {
      const float o = wave_sum(acc[d]) * inv;
      if (lane == (d & 63)) { if (d < 64) o0 = o; else o1 = o; }
    }
    const int b = bh >> 3, hh = bh & 7;
    u16* od = p.omix() + ((size_t)(b * S_ + s)) * 2048 + type * 1024 + hh * 128;
    od[lane] = f2bf(o0); od[64 + lane] = f2bf(o1);
  }
}

#endif
typedef float f32x16 __attribute__((ext_vector_type(16)));
template <int TYPE>
__device__ __forceinline__ void attn_item(const Params& p, char* smem, int bh, int qb) {
  constexpr int DQK = TYPE ? 128 : 192, NKS = DQK / 16, KSTR = DQK * 2 + 16, VSTR = 128;
  constexpr int KCH = DQK / 8, NKL = 64 * KCH / NT;
  constexpr float C2 = (TYPE ? 0.08838834764831845f : 0.07216878364870322f) * 1.4426950408889634f;
  char* sK = smem; char* sV = smem + 51200; float* sF = (float*)(smem + 51200 + 32768);
  const int tid = TID(), lane = tid & 63, wid = tid >> 6, c = lane & 31, hi = lane >> 5;
  const u16* Qb = (TYPE ? p.Qf() : p.Qm()) + (size_t)bh * S_ * DQK;
  const u16* Kb = (TYPE ? p.Kf() : p.Km()) + (size_t)bh * S_ * DQK;
  const u16* Vb = (TYPE ? p.VfT() : p.VmT()) + (size_t)bh * 128 * S_;
  const float* Fb = p.Fk() + (size_t)bh * S_;
  const int qrow = qb * 256 + wid * 32;
  bf16x8 qf[NKS];
#pragma unroll
  for (int ks = 0; ks < NKS; ++ks) qf[ks] = *(const bf16x8*)(Qb + (size_t)(qrow + c) * DQK + ks * 16 + hi * 8);
  if (TYPE == 0) {
    const float2* csr = p.cs() + (size_t)((bh >> 3) * S_ + qrow + c) * 32;
#pragma unroll
    for (int kk = 0; kk < 2; ++kk) {
      u32x4 x1 = *reinterpret_cast<u32x4*>(&qf[(NKS - 4) + kk]), x2 = *reinterpret_cast<u32x4*>(&qf[(NKS - 2) + kk]);
#pragma unroll
      for (int w = 0; w < 4; ++w) {
        const float4 cs = *(const float4*)(csr + 16 * kk + 8 * hi + 2 * w);
        const float a0 = bflo(x1[w]), a1 = bfhi(x1[w]), b0 = bflo(x2[w]), b1 = bfhi(x2[w]);
        x1[w] = pk2(a0 * cs.x - b0 * cs.y, a1 * cs.z - b1 * cs.w);
        x2[w] = pk2(a0 * cs.y + b0 * cs.x, a1 * cs.w + b1 * cs.z);
      }
      qf[(NKS - 4) + kk] = *reinterpret_cast<bf16x8*>(&x1); qf[(NKS - 2) + kk] = *reinterpret_cast<bf16x8*>(&x2);
    }
  }
  f32x16 o[4];
#pragma unroll
  for (int db = 0; db < 4; ++db)
#pragma unroll
    for (int r = 0; r < 16; ++r) o[db][r] = 0.f;
  float m = -1e30f, l = 0.f;
  const int ntiles = 4 * qb + 4;
  u32x4 kreg[NKL];
  float4 freg = make_float4(0.f, 0.f, 0.f, 0.f);
  const unsigned koff = (unsigned)tid * 16u;
  auto load_k = [&](int kt) {
    const char* kb = (const char*)(Kb + (size_t)kt * 64 * DQK);
#pragma unroll
    for (int i = 0; i < NKL; ++i) kreg[i] = *(const u32x4*)(kb + i * 8192 + koff);
    if (TYPE) { if (tid < 16) freg = *(const float4*)(Fb + kt * 64 + tid * 4); }
  };
  const unsigned voff = (unsigned)((((tid >> 3) * S_) + (((tid & 7) ^ ((tid >> 4) & 7)) * 8)) * 2);
  auto load_v = [&](int kt) {
    const char* vb = (const char*)(Vb + kt * 64);
    char* dst = sV + (kt & 1) * 16384 + tid * 16;
#pragma unroll
    for (int i = 0; i < 2; ++i)
      __builtin_amdgcn_global_load_lds((const unsigned*)(vb + (size_t)i * 64 * S_ * 2 + voff), (unsigned*)(dst + i * 8192), 16, 0, 0);
  };
  auto store_tile = [&](int kt) {
    char* sKw = sK + (kt & 1) * 25600;
#pragma unroll
    for (int i = 0; i < NKL; ++i) { const int ch = tid + NT * i, key = ch / KCH, dc = ch % KCH; *(u32x4*)(sKw + key * KSTR + dc * 16) = kreg[i]; }
    if (TYPE) { if (tid < 16) { const float L2E = 1.4426950408889634f; *(float4*)(sF + (kt & 1) * 64 + tid * 4) = make_float4(freg.x * L2E, freg.y * L2E, freg.z * L2E, freg.w * L2E); } }
  };
  const int krow = (c & 19) | ((c & 4) << 1) | ((c & 8) >> 1);
  const char* ka0 = sK + krow * KSTR + hi * 16;
  const char* ka1 = ka0 + 32 * KSTR;
  const int vx = (c >> 1) & 7;
  int vo[2][2];
#pragma unroll
  for (int kb = 0; kb < 2; ++kb)
#pragma unroll
    for (int s2 = 0; s2 < 2; ++s2) vo[kb][s2] = c * VSTR + (((4 * kb + 2 * s2 + hi) ^ vx) * 16);
  load_k(0); load_v(0);
  store_tile(0);
#pragma unroll 1
  for (int kt = 0; kt < ntiles; ++kt) {
    asm volatile("s_waitcnt vmcnt(0) lgkmcnt(0)" ::: "memory");
    __syncthreads();
    if (kt + 1 < ntiles) { load_k(kt + 1); load_v(kt + 1); }
    const int k0 = kt * 64;
    const char* sVc = sV + (kt & 1) * 16384;
    const int kbo = (kt & 1) * 25600;
    const float* sFc = sF + (kt & 1) * 64;
    if (k0 <= qrow + 31) {
      f32x16 p0, p1;
#pragma unroll
      for (int r = 0; r < 16; ++r) { p0[r] = 0.f; p1[r] = 0.f; }
#pragma unroll
      for (int ks = 0; ks < NKS; ++ks) {
        const bf16x8 a0 = *(const bf16x8*)(ka0 + kbo + ks * 32), a1 = *(const bf16x8*)(ka1 + kbo + ks * 32);
        p0 = __builtin_amdgcn_mfma_f32_32x32x16_bf16(a0, qf[ks], p0, 0, 0, 0);
        p1 = __builtin_amdgcn_mfma_f32_32x32x16_bf16(a1, qf[ks], p1, 0, 0, 0);
      }
      if (TYPE) {
#pragma unroll
        for (int s = 0; s < 2; ++s) {
          const float4 f0 = *(const float4*)(sFc + 16 * s + 8 * hi), f1 = *(const float4*)(sFc + 16 * s + 8 * hi + 4);
          const float4 g0 = *(const float4*)(sFc + 32 + 16 * s + 8 * hi), g1 = *(const float4*)(sFc + 32 + 16 * s + 8 * hi + 4);
          p0[8 * s + 0] = p0[8 * s + 0] * C2 - f0.x; p0[8 * s + 1] = p0[8 * s + 1] * C2 - f0.y; p0[8 * s + 2] = p0[8 * s + 2] * C2 - f0.z; p0[8 * s + 3] = p0[8 * s + 3] * C2 - f0.w;
          p0[8 * s + 4] = p0[8 * s + 4] * C2 - f1.x; p0[8 * s + 5] = p0[8 * s + 5] * C2 - f1.y; p0[8 * s + 6] = p0[8 * s + 6] * C2 - f1.z; p0[8 * s + 7] = p0[8 * s + 7] * C2 - f1.w;
          p1[8 * s + 0] = p1[8 * s + 0] * C2 - g0.x; p1[8 * s + 1] = p1[8 * s + 1] * C2 - g0.y; p1[8 * s + 2] = p1[8 * s + 2] * C2 - g0.z; p1[8 * s + 3] = p1[8 * s + 3] * C2 - g0.w;
          p1[8 * s + 4] = p1[8 * s + 4] * C2 - g1.x; p1[8 * s + 5] = p1[8 * s + 5] * C2 - g1.y; p1[8 * s + 6] = p1[8 * s + 6] * C2 - g1.z; p1[8 * s + 7] = p1[8 * s + 7] * C2 - g1.w;
        }
      }
      if (k0 + 63 > qrow) {
        const int lim = qrow + c - k0 - 8 * hi;
        const float NEG = -__builtin_inff();
#pragma unroll
        for (int r = 0; r < 16; ++r) {
          const int kb = 16 * (r >> 3) + (r & 7);
          if (kb > lim) p0[r] = NEG;
          if (kb + 32 > lim) p1[r] = NEG;
        }
      }
      float mx = p0[0];
#pragma unroll
      for (int r = 1; r < 16; ++r) mx = fmaxf(mx, p0[r]);
#pragma unroll
      for (int r = 0; r < 16; ++r) mx = fmaxf(mx, p1[r]);
      {
        auto rr = __builtin_amdgcn_permlane32_swap(__float_as_uint(mx), __float_as_uint(mx), false, false);
        mx = fmaxf(__uint_as_float(rr[0]), __uint_as_float(rr[1]));
      }
      if (!TYPE) mx *= C2;
      constexpr float THR = TYPE ? 96.f : 16.f;
      float mn = m, alpha = 1.f;
      if (!__all(mx - m <= THR)) {
        mn = fmaxf(m, mx);
        alpha = __builtin_amdgcn_exp2f(m - mn);
        m = mn;
#pragma unroll
        for (int db = 0; db < 4; ++db)
#pragma unroll
          for (int r = 0; r < 16; ++r) o[db][r] *= alpha;
      }
      float ps = 0.f;
      if (TYPE) {
#pragma unroll
        for (int r = 0; r < 16; ++r) { p0[r] = __builtin_amdgcn_exp2f(p0[r] - mn); p1[r] = __builtin_amdgcn_exp2f(p1[r] - mn); ps += p0[r] + p1[r]; }
      } else {
#pragma unroll
        for (int r = 0; r < 16; ++r) { p0[r] = __builtin_amdgcn_exp2f(fmaf(p0[r], C2, -mn)); p1[r] = __builtin_amdgcn_exp2f(fmaf(p1[r], C2, -mn)); ps += p0[r] + p1[r]; }
      }
      l = l * alpha + ps;
      bf16x8 pa[2][2];
#pragma unroll
      for (int s = 0; s < 2; ++s) {
        u32x4 w0 = {pk2(p0[8 * s + 0], p0[8 * s + 1]), pk2(p0[8 * s + 2], p0[8 * s + 3]), pk2(p0[8 * s + 4], p0[8 * s + 5]), pk2(p0[8 * s + 6], p0[8 * s + 7])};
        u32x4 w1 = {pk2(p1[8 * s + 0], p1[8 * s + 1]), pk2(p1[8 * s + 2], p1[8 * s + 3]), pk2(p1[8 * s + 4], p1[8 * s + 5]), pk2(p1[8 * s + 6], p1[8 * s + 7])};
        pa[0][s] = *reinterpret_cast<bf16x8*>(&w0); pa[1][s] = *reinterpret_cast<bf16x8*>(&w1);
      }
#pragma unroll
      for (int db = 0; db < 4; ++db)
#pragma unroll
        for (int kb = 0; kb < 2; ++kb)
#pragma unroll
          for (int s = 0; s < 2; ++s) {
            const bf16x8 av = *(const bf16x8*)(sVc + db * 32 * VSTR + vo[kb][s]);
            o[db] = __builtin_amdgcn_mfma_f32_32x32x16_bf16(av, pa[kb][s], o[db], 0, 0, 0);
          }
    }
    if (kt + 1 < ntiles) store_tile(kt + 1);
  }
  {
    auto rr = __builtin_amdgcn_permlane32_swap(__float_as_uint(l), __float_as_uint(l), false, false);
    const float inv = 1.f / (__uint_as_float(rr[0]) + __uint_as_float(rr[1]));
    const int b = bh >> 3, hh = bh & 7;
    u16* od = p.omix() + ((size_t)(b * S_ + qrow + c)) * 2048 + TYPE * 1024 + hh * 128 + 4 * hi;
#pragma unroll
    for (int db = 0; db < 4; ++db)
#pragma unroll
      for (int g = 0; g < 4; ++g)
        *(u32x2*)(od + 32 * db + 8 * g) = u32x2{pk2(o[db][4 * g] * inv, o[db][4 * g + 1] * inv), pk2(o[db][4 * g + 2] * inv, o[db][4 * g + 3] * inv)};
  }
}

__device__ void phase_attn(const Params& p, char* smem, int bid, int nb) {
  int* sItem = (int*)(smem + 90000);
  const int x = bid & 7;
  unsigned* q = p.ctr() + 32 + x;
  for (;;) {
    __syncthreads();
    if (TID() == 0) *sItem = (int)atomicAdd(q, 1u);
    __syncthreads();
    const int item = *sItem;
    if (item >= 64) break;
    const int qb = 15 - (item >> 2), r = item & 3, type = r >> 1, bh = x + 8 * (r & 1);
    if (type == 0) attn_item<0>(p, smem, bh, qb); else attn_item<1>(p, smem, bh, qb);
  }
  unsigned* qc = p.ctr() + 48;
  for (;;) {
    __syncthreads();
    if (TID() == 0) *sItem = (int)atomicAdd(qc, 1u);
    __syncthreads();
    const int chunk = *sItem;
    if (chunk >= 512) break;
    quant_chunk(p, chunk);
  }
}

__device__ void phase_outproj(const Params& p, char* smem, int bid, int nb) {
  EpiOut E{p.x, (u16*)p.y1()};
  pg8::Gemm g{p.omix(), p.WoutT(), T_, D_, D_};
  pg8::StaticOrder S; S.init(T_, D_, nb, bid);
  pg8::gemm_phase((PG8_LAS unsigned char*)smem, g, S, E, nullptr);
}

__device__ void phase_ln1(const Params& p, int bid, int nb) {
  const int lane = TID() & 63, wid = TID() >> 6;
  for (int t = bid * 8 + wid; t < T_; t += nb * 8) {
    const u16* row = (const u16*)p.y1() + (size_t)t * D_;
    float4 v[8];
    float sum = 0.f;
#pragma unroll
    for (int i = 0; i < 8; ++i) { const u32x2 yb = *(const u32x2*)(row + (i * 64 + lane) * 4); v[i] = make_float4(bflo(yb[0]), bfhi(yb[0]), bflo(yb[1]), bfhi(yb[1])); sum += (v[i].x + v[i].y) + (v[i].z + v[i].w); }
    const float mu = wave_sum(sum) * (1.f / D_);
    float sq = 0.f;
#pragma unroll
    for (int i = 0; i < 8; ++i) {
      v[i].x -= mu; v[i].y -= mu; v[i].z -= mu; v[i].w -= mu;
      sq += (v[i].x * v[i].x + v[i].y * v[i].y) + (v[i].z * v[i].z + v[i].w * v[i].w);
    }
    const float rstd = rsqrtf(wave_sum(sq) * (1.f / D_) + EPS);
#pragma unroll
    for (int i = 0; i < 8; ++i) {
      const int c = (i * 64 + lane) * 4;
      const float4 g = *(const float4*)(p.ln1_g + c), bb = *(const float4*)(p.ln1_b + c);
      float4 o; o.x = v[i].x * rstd * g.x + bb.x; o.y = v[i].y * rstd * g.y + bb.y; o.z = v[i].z * rstd * g.z + bb.z; o.w = v[i].w * rstd * g.w + bb.w;
      *(u32x2*)(p.h1b() + (size_t)t * D_ + c) = u32x2{pk2(o.x, o.y), pk2(o.z, o.w)};
    }
  }
}

__device__ __forceinline__ void ins16(unsigned (&t)[16], unsigned x) {
#pragma unroll
  for (int i = 0; i < 16; ++i) { const unsigned hi = t[i] > x ? t[i] : x; x = t[i] > x ? x : t[i]; t[i] = hi; }
}
__device__ __forceinline__ void ins16p(unsigned (&ck)[16], int (&ce)[16], unsigned x, int xe) {
#pragma unroll
  for (int i = 0; i < 16; ++i) {
    const bool sw = x > ck[i];
    const unsigned nk = sw ? x : ck[i], nx = sw ? ck[i] : x;
    const int ne = sw ? xe : ce[i], nxe = sw ? ce[i] : xe;
    ck[i] = nk; x = nx; ce[i] = ne; xe = nxe;
  }
}
__device__ __forceinline__ float unordkey(unsigned k) { return __uint_as_float((k & 0x80000000u) ? (k & 0x7fffffffu) : ~k); }

__device__ __forceinline__ void sort16_asc(unsigned (&s)[16]) {
#pragma unroll
  for (int k = 2; k <= 16; k <<= 1)
#pragma unroll
    for (int j = k >> 1; j > 0; j >>= 1)
#pragma unroll
      for (int i = 0; i < 16; ++i) {
        const int l = i ^ j;
        if (l > i) {
          const unsigned lo = s[i] < s[l] ? s[i] : s[l], hi = s[i] < s[l] ? s[l] : s[i];
          if ((i & k) == 0) { s[i] = lo; s[l] = hi; } else { s[i] = hi; s[l] = lo; }
        }
      }
}
__device__ __forceinline__ void merge16(unsigned (&t)[16], const unsigned (&s)[16]) {
#pragma unroll
  for (int i = 0; i < 16; ++i) t[i] = t[i] > s[i] ? t[i] : s[i];
#pragma unroll
  for (int j = 8; j > 0; j >>= 1)
#pragma unroll
    for (int i = 0; i < 16; ++i) {
      const int l = i ^ j;
      if (l > i) { const unsigned hi = t[i] > t[l] ? t[i] : t[l], lo = t[i] > t[l] ? t[l] : t[i]; t[i] = hi; t[l] = lo; }
    }
}

__device__ __forceinline__ void score_block(const u16* kH, const u16* kL, const bf16x8 (&qh)[4], const bf16x8 (&ql)[4], int hi, unsigned (&t)[16]) {
#pragma unroll
  for (int i = 0; i < 16; ++i) t[i] = 0u;
#pragma unroll 1
  for (int kb = 0; kb < 4; ++kb) {
    f32x16 sc;
#pragma unroll
    for (int r = 0; r < 16; ++r) sc[r] = 0.f;
#pragma unroll
    for (int ks = 0; ks < 4; ++ks) {
      const bf16x8 ah = *(const bf16x8*)(kH + kb * 32 * 64 + ks * 16), al = *(const bf16x8*)(kL + kb * 32 * 64 + ks * 16);
      sc = __builtin_amdgcn_mfma_f32_32x32x16_bf16(ah, qh[ks], sc, 0, 0, 0);
      sc = __builtin_amdgcn_mfma_f32_32x32x16_bf16(ah, ql[ks], sc, 0, 0, 0);
      sc = __builtin_amdgcn_mfma_f32_32x32x16_bf16(al, qh[ks], sc, 0, 0, 0);
    }
    const unsigned base = (unsigned)(127 - 32 * kb) - 4u * (unsigned)hi;
    unsigned s[16];
#pragma unroll
    for (int r = 0; r < 16; ++r) s[r] = (ordkey(sc[r]) & ~127u) | (base - (unsigned)((r & 3) + 8 * (r >> 2)));
    sort16_asc(s);
    merge16(t, s);
  }
  unsigned other[16];
#pragma unroll
  for (int i = 0; i < 16; ++i) {
    auto rr = __builtin_amdgcn_permlane32_swap(t[15 - i], t[15 - i], false, false);
    other[i] = hi ? rr[0] : rr[1];
  }
  merge16(t, other);
}

__device__ __forceinline__ void route_tile(const Params& p, char* smem, f32x4 (&acc)[4][4], int tm, int h) {
  const int tid = TID(), wid = tid >> 6, lane = tid & 63, wr = wid >> 1, wc = wid & 1, fr = lane & 15, fq = lane >> 4;
  __syncthreads();
  float* Qw = (float*)smem + wid * (64 * 65);
#pragma unroll
  for (int m = 0; m < 4; ++m)
#pragma unroll
    for (int n = 0; n < 4; ++n)
#pragma unroll
      for (int j = 0; j < 4; ++j) Qw[(m * 16 + fq * 4 + j) * 65 + n * 16 + fr] = acc[m][n][j];
  asm volatile("s_waitcnt lgkmcnt(0)" ::: "memory");
  const int c = lane & 31, hi = lane >> 5;
  bf16x8 qh[2][4], ql[2][4];
#pragma unroll
  for (int tb = 0; tb < 2; ++tb)
#pragma unroll
    for (int ks = 0; ks < 4; ++ks) {
      float v[8]; unsigned wh[4], wl[4];
#pragma unroll
      for (int j = 0; j < 8; ++j) v[j] = Qw[(tb * 32 + c) * 65 + 16 * ks + 8 * hi + j];
#pragma unroll
      for (int w = 0; w < 4; ++w) {
        wh[w] = pk2(v[2 * w], v[2 * w + 1]);
        wl[w] = pk2(v[2 * w] - bflo(wh[w]), v[2 * w + 1] - bfhi(wh[w]));
      }
      u32x4 uh = {wh[0], wh[1], wh[2], wh[3]}, ul = {wl[0], wl[1], wl[2], wl[3]};
      qh[tb][ks] = *reinterpret_cast<bf16x8*>(&uh); ql[tb][ks] = *reinterpret_cast<bf16x8*>(&ul);
    }
  const u16* kH = p.keyH() + ((size_t)(wc * 8 + h) * 128 + c) * 64 + 8 * hi;
  const u16* kL = p.keyL() + ((size_t)(wc * 8 + h) * 128 + c) * 64 + 8 * hi;
  unsigned t0[16], t1[16];
  score_block(kH, kL, qh[0], ql[0], hi, t0);
  score_block(kH, kL, qh[1], ql[1], hi, t1);
  unsigned t[16];
#pragma unroll
  for (int i = 0; i < 16; ++i) t[i] = hi ? t1[i] : t0[i];
  __syncthreads();
  unsigned* L = (unsigned*)smem;
#pragma unroll
  for (int r = 0; r < 16; ++r) L[(wc * 16 + r) * 256 + wr * 64 + lane] = t[r];
  __syncthreads();
  if (wid < 4) {
    const int tok = wid * 64 + lane;
    unsigned ck[16]; int ce[16];
#pragma unroll
    for (int i = 0; i < 16; ++i) { ck[i] = 0u; ce[i] = 0; }
#pragma unroll 1
    for (int a = 0; a < 16; ++a) {
      const unsigned ka = L[a * 256 + tok];
      const int i1a = (127 - (int)(ka & 127u)) * 128; const float v1a = unordkey(ka & ~127u);
      const int nbm1 = (int)((0x1112347FULL >> (4 * a)) & 15ULL);
#pragma unroll 1
      for (int b = 0; b <= nbm1; ++b) {
        const unsigned kb = L[(16 + b) * 256 + tok];
        const int i2b = 127 - (int)(kb & 127u); const float v2b = unordkey(kb & ~127u);
        ins16p(ck, ce, ordkey(v1a + v2b), i1a + i2b);
      }
    }
    float ex[16], sum = 0.f;
    const float mx = unordkey(ck[0]);
#pragma unroll
    for (int r = 0; r < 16; ++r) { ex[r] = __expf(unordkey(ck[r]) - mx); sum += ex[r]; }
    const float inv = 1.f / sum;
    const size_t o = ((size_t)(tm * 256 + tok) * 8 + h) * 16;
    int* ed = p.eidxG() + o; float* gd = p.gateG() + o;
#pragma unroll
    for (int r = 0; r < 16; r += 4) {
      *(int4*)(ed + r) = make_int4(ce[r], ce[r + 1], ce[r + 2], ce[r + 3]);
      *(float4*)(gd + r) = make_float4(ex[r] * inv, ex[r + 1] * inv, ex[r + 2] * inv, ex[r + 3] * inv);
    }
  }
}

__device__ void phase_mid(const Params& p, char* smem, int bid, int nb) {
  {
    EpiGate E{p.h1b(), p.projb(), p.r2b()};
    pg8::Gemm g{p.h1b(), p.WgT(), T_, D_, D_};
    pg8::StaticOrder S; S.init(T_, D_, nb, bid);
    pg8::gemm_phase((PG8_LAS unsigned char*)smem, g, S, E, nullptr);
  }
  for (int t = vblock(bid, nb); t < 32 * 8; t += nb) {
    int tm, tn; tile_rc(t, 8, tm, tn);
    f32x4 acc[1][4][4];
    gemm_core<4, 2>(p.h1b(), D_, p.WpqT(), D_, D_, tm * 256, tn * 128, smem, acc);
    route_tile(p, smem, acc[0], tm, tn);
  }
}

__device__ __forceinline__ float gelu_exact(float a) {
  const float x = fabsf(a) * 0.7071067811865476f;
  const float t = __builtin_amdgcn_rcpf(1.f + 0.3275911f * x);
  const float poly = t * (0.254829592f + t * (-0.284496736f + t * (1.421413741f + t * (-1.453152027f + t * 1.061405429f))));
  const float er = 1.f - poly * __expf(-x * x);
  return 0.5f * a * (1.f + (a < 0.f ? -er : er));
}

template <int NPER, int IDXMASK>
__device__ __forceinline__ int top16(unsigned (&k)[NPER], int lane) {
  int mine = 0;
#pragma unroll 1
  for (int r = 0; r < 16; ++r) {
    unsigned loc = k[0];
#pragma unroll
    for (int i = 1; i < NPER; ++i) loc = loc > k[i] ? loc : k[i];
    const unsigned best = wave_umax(loc);
#pragma unroll
    for (int i = 0; i < NPER; ++i) if (k[i] == best) k[i] = 0u;
    if (lane == r) mine = IDXMASK - (int)(best & (unsigned)IDXMASK);
  }
  return mine;
}

__device__ void phase_peer(const Params& p, char* smem, int bid, int nb) {
  const int tid = TID(), lane = tid & 63, wid = tid >> 6;
  float* qs = (float*)smem;
  float* sc = (float*)(smem + 8192);
  int* eidx = (int*)(smem + 24576);
  float* gts = (float*)(smem + 40960);
  for (int it = bid; it < T_ / 32; it += nb) {
    const int t0 = it * 32;
#pragma unroll
    for (int i = 0; i < 2; ++i) {
      const int idx = (i * NT + tid) * 4;
      *(int4*)(eidx + idx) = *(const int4*)(p.eidxG() + (size_t)t0 * 128 + idx);
      *(float4*)(gts + idx) = *(const float4*)(p.gateG() + (size_t)t0 * 128 + idx);
    }
    __syncthreads();
    for (int ti = 0; ti < 4; ++ti) {
      const int tok = wid * 4 + ti, t = t0 + tok;
      typedef float f32x32 __attribute__((ext_vector_type(32)));
      typedef unsigned u32x6 __attribute__((ext_vector_type(6)));
      float hreg[32];
      f32x32 o;
#pragma unroll
      for (int q = 0; q < 8; ++q) {
        const u32x2 hv = *(const u32x2*)(p.h1b() + (size_t)t * D_ + (q * 64 + lane) * 4);
        hreg[q * 4] = bflo(hv[0]); hreg[q * 4 + 1] = bfhi(hv[0]); hreg[q * 4 + 2] = bflo(hv[1]); hreg[q * 4 + 3] = bfhi(hv[1]);
      }
#pragma unroll
      for (int i = 0; i < 32; ++i) o[i] = 0.f;
      const float* Us = p.Us(); const float* Vs = p.Vs();
      const unsigned char* Uq = p.Uq() + lane * 24;
      const int* ep = eidx + tok * 128; const float* gp = gts + tok * 128;
      u32x4 uA4[2], vA4[2], uB4[2], vB4[2]; u32x2 uA2[2], vA2[2], uB2[2], vB2[2];
      float gA[2], suA[2], svA[2], gB[2], suB[2], svB[2];
#define PEER_LOAD(U4, U2, V4, V2, G, SU, SV, J0)                                                        \
      _Pragma("unroll") for (int jj = 0; jj < 2; ++jj) {                                                \
        const int e = __builtin_amdgcn_readfirstlane(ep[(J0) + jj]);                                    \
        G[jj] = gp[(J0) + jj]; SU[jj] = Us[e]; SV[jj] = Vs[e];                                          \
        const unsigned char* up = Uq + (size_t)e * 3072; const unsigned char* vp = up + 1536;           \
        U2[jj] = *(const u32x2*)(up); U4[jj] = *(const u32x4*)(up + 8);                                 \
        V2[jj] = *(const u32x2*)(vp); V4[jj] = *(const u32x4*)(vp + 8);                                 \
      }
#define PEER_COMPUTE(U4, U2, V4, V2, G, SU, SV)                                                         \
      _Pragma("unroll") for (int jj = 0; jj < 2; ++jj) {                                                \
        const u32x6 uw = {U2[jj][0], U2[jj][1], U4[jj][0], U4[jj][1], U4[jj][2], U4[jj][3]};            \
        const f32x32 ud = __builtin_amdgcn_cvt_scalef32_pk32_f32_fp6(uw, 1.0f);                         \
        float d0 = 0.f, d1 = 0.f, d2 = 0.f, d3 = 0.f;                                                   \
        _Pragma("unroll") for (int i = 0; i < 32; i += 4) {                                             \
          d0 += ud[i] * hreg[i]; d1 += ud[i + 1] * hreg[i + 1]; d2 += ud[i + 2] * hreg[i + 2]; d3 += ud[i + 3] * hreg[i + 3]; \
        }                                                                                               \
        const float av = wave_sum((d0 + d1) + (d2 + d3)) * SU[jj];                                      \
        const float act = gelu_exact(av) * G[jj] * SV[jj];                                              \
        const u32x6 vw = {V2[jj][0], V2[jj][1], V4[jj][0], V4[jj][1], V4[jj][2], V4[jj][3]};            \
        const f32x32 vd = __builtin_amdgcn_cvt_scalef32_pk32_f32_fp6(vw, 1.0f);                         \
        o += vd * act;                                                                                  \
      }
      PEER_LOAD(uA4, uA2, vA4, vA2, gA, suA, svA, 0)
#pragma unroll 1
      for (int j0 = 0; j0 < 128; j0 += 4) {
        PEER_LOAD(uB4, uB2, vB4, vB2, gB, suB, svB, j0 + 2)
        PEER_COMPUTE(uA4, uA2, vA4, vA2, gA, suA, svA)
        if (j0 + 4 < 128) { PEER_LOAD(uA4, uA2, vA4, vA2, gA, suA, svA, j0 + 4) }
        PEER_COMPUTE(uB4, uB2, vB4, vB2, gB, suB, svB)
      }
#undef PEER_LOAD
#undef PEER_COMPUTE
      float* orow = p.out + (size_t)t * D_ + lane * 4;
      float sum = 0.f;
#pragma unroll
      for (int q = 0; q < 8; ++q) {
        const u32x2 rb2 = *(const u32x2*)(p.r2b() + (size_t)t * D_ + (q * 64 + lane) * 4);
        const float4 r0 = make_float4(bflo(rb2[0]), bfhi(rb2[0]), bflo(rb2[1]), bfhi(rb2[1]));
        o[q * 4 + 0] += r0.x; o[q * 4 + 1] += r0.y; o[q * 4 + 2] += r0.z; o[q * 4 + 3] += r0.w;
      }
#pragma unroll
      for (int i = 0; i < 32; ++i) sum += o[i];
      const float mu = wave_sum(sum) * (1.f / D_);
      float sq = 0.f;
#pragma unroll
      for (int i = 0; i < 32; ++i) { o[i] -= mu; sq += o[i] * o[i]; }
      const float rstd = rsqrtf(wave_sum(sq) * (1.f / D_) + EPS);
#pragma unroll
      for (int q = 0; q < 8; ++q) {
        const int col = (q * 64 + lane) * 4;
        const float4 g0 = *(const float4*)(p.ln2_g + col), b0 = *(const float4*)(p.ln2_b + col);
        float4 w0;
        w0.x = o[q * 4 + 0] * rstd * g0.x + b0.x; w0.y = o[q * 4 + 1] * rstd * g0.y + b0.y;
        w0.z = o[q * 4 + 2] * rstd * g0.z + b0.z; w0.w = o[q * 4 + 3] * rstd * g0.w + b0.w;
        *(float4*)(orow + q * 256) = w0;
      }
    }
    __syncthreads();
  }
}

template <int PH>
__device__ __forceinline__ void run_phase(const Params& p, char* smem, int bid, int nb) {
  if constexpr (PH == 0) phase_prep(p, smem, bid, nb);
  if constexpr (PH == 1) phase_inproj(p, smem, bid, nb);
  if constexpr (PH == 2) phase_up(p, smem, bid, nb);
#ifdef ATTN_NAIVE
  if constexpr (PH == 3) phase_attn_naive(p, smem, bid, nb);
#else
  if constexpr (PH == 3) phase_attn(p, smem, bid, nb);
#endif
  if constexpr (PH == 4) phase_outproj(p, smem, bid, nb);
  if constexpr (PH == 5) phase_ln1(p, bid, nb);
  if constexpr (PH == 6) phase_mid(p, smem, bid, nb);
  if constexpr (PH == 7) phase_peer(p, smem, bid, nb);
}

template <int PH>
__global__ void __launch_bounds__(NT, 2) phase_kernel(Params p) {
  __shared__ __attribute__((aligned(16))) char smem[SMEM_BYTES];
  run_phase<PH>(p, smem, blockIdx.x, gridDim.x);
}

#define BW_CENSUS(j) (256 + (j) * 32)
#define BW_XSUB(j) (256 + 512 + (j) * 32)
#define BW_XGEN(j) (256 + 1024 + (j) * 32)
#define BW_TOP (256 + 1536)
#define BW_TOPGEN (256 + 1568)
__device__ __forceinline__ unsigned bw_ld(unsigned* p) { return __hip_atomic_load(p, __ATOMIC_RELAXED, __HIP_MEMORY_SCOPE_AGENT); }
__device__ __forceinline__ unsigned bw_add(unsigned* p, unsigned v) { return __hip_atomic_fetch_add(p, v, __ATOMIC_RELAXED, __HIP_MEMORY_SCOPE_AGENT); }
__device__ __forceinline__ unsigned xcc_id() { return (unsigned)__builtin_amdgcn_s_getreg((3 << 11) | 20) & 0xFu; }

__device__ __forceinline__ void grid_barrier(unsigned* bar, unsigned* st  ) {
  asm volatile("s_waitcnt vmcnt(0)" ::: "memory");
  __syncthreads();
  if (threadIdx.x == 0) {
    __builtin_amdgcn_s_waitcnt(0);
    const unsigned x = xcc_id();
    unsigned nloc = st[0], nx = st[1];
    if (nloc == 0u) {
      const unsigned G = gridDim.x;
      for (;;) {
        unsigned sum = 0u, cnt = 0u, mine = 0u;
#pragma unroll
        for (unsigned j = 0; j < 16; ++j) { const unsigned c = bw_ld(&bar[BW_CENSUS(j)]); sum += c; cnt += (c > 0u) ? 1u : 0u; mine = (j == x) ? c : mine; }
        nloc = mine; nx = cnt;
        if (sum == G) break;
        __builtin_amdgcn_s_sleep(1);
      }
      st[0] = nloc; st[1] = nx;
    }
    const unsigned old = bw_add(&bar[BW_XSUB(x)], 1u);
    const unsigned gen = old / nloc;
    if (old + 1u == (gen + 1u) * nloc) {
      __builtin_amdgcn_fence(__ATOMIC_RELEASE, "agent");
      asm volatile("s_waitcnt vmcnt(0)" ::: "memory");
      const unsigned og = bw_add(&bar[BW_TOP], 1u);
      const unsigned tg = og / nx;
      if (og + 1u == (tg + 1u) * nx) bw_add(&bar[BW_TOPGEN], 1u);
      else while (bw_ld(&bar[BW_TOPGEN]) == tg) __builtin_amdgcn_s_sleep(1);
      __builtin_amdgcn_fence(__ATOMIC_ACQUIRE, "agent");
      bw_add(&bar[BW_XGEN(x)], 1u);
      asm volatile("s_waitcnt vmcnt(0)" ::: "memory");
    } else {
      while (bw_ld(&bar[BW_XGEN(x)]) == gen) __builtin_amdgcn_s_sleep(1);
      __builtin_amdgcn_fence(__ATOMIC_ACQUIRE, "agent");
      asm volatile("s_waitcnt vmcnt(0)" ::: "memory");
    }
  }
  __syncthreads();
}

#if SINGLE_LAUNCH
typedef const __attribute__((address_space(4))) unsigned long long* kargp_t;
static_assert(sizeof(Params) % 8 == 0, "Params must be a pack of 8-byte fields");
#define RUN_PHASE(N) run_phase<N>(p_, smem, bid, nb);
__global__ void __launch_bounds__(NT, 2) fwd_kernel(Params p_) {
  __shared__ __attribute__((aligned(16))) char smem[SMEM_BYTES + 64];
  const int bid = blockIdx.x, nb = gridDim.x;
  unsigned* bar = (unsigned*)(p_.ws + O_CTR);
  unsigned* st = (unsigned*)(smem + SMEM_BYTES);
  if (threadIdx.x == 0) { st[0] = 0u; st[1] = 0u; (void)bw_add(&bar[BW_CENSUS(xcc_id())], 1u); }
  if (p_.out == nullptr) cg::this_grid().sync();
  RUN_PHASE(0) grid_barrier(bar, st);
  RUN_PHASE(1) grid_barrier(bar, st);
  RUN_PHASE(2) grid_barrier(bar, st);
  RUN_PHASE(3) grid_barrier(bar, st);
  RUN_PHASE(4) grid_barrier(bar, st);
  RUN_PHASE(5) grid_barrier(bar, st);
  RUN_PHASE(6) grid_barrier(bar, st);
  RUN_PHASE(7)
}
#endif

extern "C" void kernel_launch(void* const* d_in, const int* in_sizes, int n_in, void* d_out, int out_size,
                              void* d_ws, size_t ws_size, hipStream_t stream) {
  (void)in_sizes; (void)n_in; (void)out_size; (void)ws_size;
  Params p{};
  p.x = (const float*)d_in[0]; p.p = (const float*)d_in[1]; p.positions = (const int*)d_in[2];
  p.w_in = (const float*)d_in[3]; p.b_forget = (const float*)d_in[4]; p.g_q = (const float*)d_in[5];
  p.w_uq = (const float*)d_in[6]; p.g_kv = (const float*)d_in[7]; p.w_ukv = (const float*)d_in[8];
  p.w_out = (const float*)d_in[9]; p.ln1_g = (const float*)d_in[10]; p.ln1_b = (const float*)d_in[11];
  p.peer_wq = (const float*)d_in[12]; p.keys1 = (const float*)d_in[13]; p.keys2 = (const float*)d_in[14];
  p.peer_u = (const float*)d_in[15]; p.peer_v = (const float*)d_in[16]; p.wgate = (const float*)d_in[17];
  p.wproj = (const float*)d_in[18]; p.ln2_g = (const float*)d_in[19]; p.ln2_b = (const float*)d_in[20];
  p.out = (float*)d_out;
  p.ws = (char*)d_ws;

  static int grid_blocks = 0;
  if (!grid_blocks) {
    int dev = 0, cus = 0, per_cu = 0;
    (void)hipGetDevice(&dev);
    (void)hipDeviceGetAttribute(&cus, hipDeviceAttributeMultiprocessorCount, dev);
#if SINGLE_LAUNCH
    (void)hipOccupancyMaxActiveBlocksPerMultiprocessor(&per_cu, fwd_kernel, NT, 0);
#else
    per_cu = 2;
#endif
    if (per_cu > 1) per_cu = 1;
    if (per_cu < 1) per_cu = 1;
    grid_blocks = cus * per_cu;
  }
#if SINGLE_LAUNCH
  (void)hipMemsetAsync(d_ws, 0, 16384, stream);
  void* args[] = {&p};
  hipError_t e = hipLaunchCooperativeKernel((void*)fwd_kernel, dim3(grid_blocks), dim3(NT), args, 0, stream);
  if (e != hipSuccess) fprintf(stderr, "cooperative launch failed: %s (grid %d)\n", hipGetErrorString(e), grid_blocks);
#else
  phase_kernel<0><<<grid_blocks, NT, 0, stream>>>(p);
  phase_kernel<1><<<grid_blocks, NT, 0, stream>>>(p);
  phase_kernel<2><<<grid_blocks, NT, 0, stream>>>(p);
  phase_kernel<3><<<grid_blocks, NT, 0, stream>>>(p);
  phase_kernel<4><<<grid_blocks, NT, 0, stream>>>(p);
  phase_kernel<5><<<grid_blocks, NT, 0, stream>>>(p);
  phase_kernel<6><<<grid_blocks, NT, 0, stream>>>(p);
  phase_kernel<7><<<grid_blocks, NT, 0, stream>>>(p);
#endif
}
```

```cpp
#include <hip/hip_runtime.h>
#include <hip/hip_bf16.h>
#include <hip/hip_cooperative_groups.h>
#include <stdint.h>
#include <cstdio>
namespace cg = cooperative_groups;

typedef unsigned short u16;
typedef short bf16x8 __attribute__((ext_vector_type(8)));
typedef float f32x4 __attribute__((ext_vector_type(4)));
typedef unsigned u32x4 __attribute__((ext_vector_type(4)));
typedef unsigned u32x2 __attribute__((ext_vector_type(2)));

#ifndef SINGLE_LAUNCH
#define SINGLE_LAUNCH 1
#endif

constexpr int T_ = 8192, D_ = 2048, S_ = 4096, NB_ = 2;
constexpr int INW = 4168;
constexpr int NPH = 8;
constexpr float ALPHA = 1.189207115002721f;
constexpr float EPS = 1e-6f;
constexpr int NT = 512;
constexpr int SMEM_BYTES = 133120;

constexpr size_t al256(size_t x) { return (x + 255) & ~(size_t)255; }
constexpr size_t O_CTR = 0;
constexpr size_t O_WINT = O_CTR + 16384;
constexpr size_t O_WUQT = O_WINT + al256((size_t)4352 * 2048 * 2);
constexpr size_t O_WUKVT = O_WUQT + al256((size_t)1536 * 512 * 2);
constexpr size_t O_WOUTT = O_WUKVT + al256((size_t)2048 * 512 * 2);
constexpr size_t O_WPQT = O_WOUTT + al256((size_t)2048 * 2048 * 2);
constexpr size_t O_WGT = O_WPQT + al256((size_t)1024 * 2048 * 2);
constexpr size_t O_WPT = O_WGT + al256((size_t)2048 * 2048 * 2);
constexpr size_t O_PB = O_WPT + al256((size_t)2048 * 256 * 2);
constexpr size_t O_UB = O_PB + al256((size_t)8192 * 256 * 2);
constexpr size_t O_VB = O_UB + 2048;
constexpr size_t O_OMIX = O_UB + al256((size_t)16384 * 4096);
constexpr size_t O_CS = O_OMIX + al256((size_t)8192 * 2048 * 2);
constexpr size_t O_PROJB = O_CS + al256((size_t)8192 * 32 * 8);
constexpr size_t O_KEYH = O_PROJB + al256((size_t)8192 * 2048 * 2);
constexpr size_t O_KEYL = O_KEYH + al256((size_t)2 * 8 * 128 * 64 * 2);
constexpr size_t O_US = O_KEYL + al256((size_t)2 * 8 * 128 * 64 * 2);
constexpr size_t O_VS = O_US + al256((size_t)16384 * 4);
constexpr size_t O_REGB = O_VS + al256((size_t)16384 * 4);
constexpr size_t O_XB = O_REGB;
constexpr size_t O_CQB = O_XB + al256((size_t)8192 * 2048 * 2);
constexpr size_t O_CKVB = O_CQB + al256((size_t)8192 * 512 * 2);
constexpr size_t O_QM = O_CKVB + al256((size_t)8192 * 512 * 2);
constexpr size_t O_KM = O_QM + al256((size_t)8192 * 8 * 192 * 2);
constexpr size_t O_VMT = O_KM + al256((size_t)8192 * 8 * 192 * 2);
constexpr size_t O_QF = O_VMT + al256((size_t)8192 * 8 * 128 * 2);
constexpr size_t O_KF = O_QF + al256((size_t)8192 * 8 * 128 * 2);
constexpr size_t O_VFT = O_KF + al256((size_t)8192 * 8 * 128 * 2);
constexpr size_t O_LOGF = O_VFT + al256((size_t)8192 * 8 * 128 * 2);
constexpr size_t O_FK = O_LOGF + al256((size_t)16 * 4096 * 4);
constexpr size_t O_KRS = O_FK + al256((size_t)16 * 4096 * 4);
constexpr size_t O_RSS = O_KRS + al256((size_t)8192 * 64 * 4);
constexpr size_t O_ENDB = O_RSS + al256((size_t)2 * 8192 * 4);
constexpr size_t O_Y1 = O_REGB;
constexpr size_t O_H1B = O_Y1 + al256((size_t)8192 * 2048 * 4);
constexpr size_t O_PQ = O_H1B + al256((size_t)8192 * 2048 * 2);
constexpr size_t O_GATE = O_PQ + al256((size_t)8192 * 128 * 4);
constexpr size_t O_R2B = O_GATE + al256((size_t)8192 * 128 * 4);
constexpr size_t O_ENDB2 = O_R2B + al256((size_t)8192 * 2048 * 2);
static_assert(O_ENDB2 <= O_ENDB, "region B reuse overflow");
static_assert(O_ENDB <= (size_t)500 * 1024 * 1024, "workspace too large");

struct Params {
  const float *x, *p; const int* positions;
  const float *w_in, *b_forget, *g_q, *w_uq, *g_kv, *w_ukv, *w_out, *ln1_g, *ln1_b;
  const float *peer_wq, *keys1, *keys2, *peer_u, *peer_v, *wgate, *wproj, *ln2_g, *ln2_b;
  float* out;
  char* ws;
#define WSP(type, name, off) __device__ __forceinline__ type* name() const { return (type*)(ws + (off)); }
  WSP(unsigned, ctr, O_CTR) WSP(u16, WinT, O_WINT) WSP(u16, WuqT, O_WUQT) WSP(u16, WukvT, O_WUKVT) WSP(u16, WoutT, O_WOUTT)
  WSP(u16, WpqT, O_WPQT) WSP(u16, WgT, O_WGT) WSP(u16, WpT, O_WPT) WSP(u16, pb, O_PB) WSP(unsigned char, Uq, O_UB) WSP(unsigned char, Vq, O_VB) WSP(float, Us, O_US) WSP(float, Vs, O_VS)
  WSP(u16, omix, O_OMIX) WSP(float2, cs, O_CS) WSP(u16, projb, O_PROJB) WSP(u16, keyH, O_KEYH) WSP(u16, keyL, O_KEYL)
  WSP(u16, xb, O_XB) WSP(u16, cqb, O_CQB) WSP(u16, ckvb, O_CKVB) WSP(u16, Qm, O_QM) WSP(u16, Km, O_KM) WSP(u16, VmT, O_VMT)
  WSP(u16, Qf, O_QF) WSP(u16, Kf, O_KF) WSP(u16, VfT, O_VFT) WSP(float, logf, O_LOGF) WSP(float, Fk, O_FK) WSP(float, krsum, O_KRS) WSP(float, rss, O_RSS)
  WSP(float, y1, O_Y1) WSP(u16, h1b, O_H1B) WSP(int, eidxG, O_PQ) WSP(float, gateG, O_GATE) WSP(u16, r2b, O_R2B)
#undef WSP
};

__device__ __forceinline__ int TID() { int t = threadIdx.x; asm volatile("" : "+v"(t)); return t; }
__device__ __forceinline__ unsigned pk2(float lo, float hi) {
  unsigned r; asm volatile("v_cvt_pk_bf16_f32 %0, %1, %2" : "=v"(r) : "v"(lo), "v"(hi)); return r;
}
__device__ __forceinline__ u16 f2bf(float f) { return (u16)(pk2(f, 0.f) & 0xffffu); }
__device__ __forceinline__ float bf2f(u16 v) { return __uint_as_float(((unsigned)v) << 16); }
__device__ __forceinline__ float bflo(unsigned v) { return __uint_as_float(v << 16); }
__device__ __forceinline__ float bfhi(unsigned v) { return __uint_as_float(v & 0xffff0000u); }

template <int CTRL> __device__ __forceinline__ int dppi(int v) { return __builtin_amdgcn_update_dpp(0, v, CTRL, 0xF, 0xF, false); }
template <int CTRL> __device__ __forceinline__ float dppf(float v) { return __int_as_float(dppi<CTRL>(__float_as_int(v))); }
__device__ __forceinline__ float rdlane(float v, int l) { return __int_as_float(__builtin_amdgcn_readlane(__float_as_int(v), l)); }

__device__ __forceinline__ float row_sum(float v) {
  v += dppf<0xB1>(v); v += dppf<0x4E>(v); v += dppf<0x141>(v); v += dppf<0x140>(v); return v;
}
__device__ __forceinline__ float row_max(float v) {
  v = fmaxf(v, dppf<0xB1>(v)); v = fmaxf(v, dppf<0x4E>(v)); v = fmaxf(v, dppf<0x141>(v)); v = fmaxf(v, dppf<0x140>(v)); return v;
}
__device__ __forceinline__ float wave_sum(float v) {
  v = row_sum(v);
  return (rdlane(v, 0) + rdlane(v, 16)) + (rdlane(v, 32) + rdlane(v, 48));
}
__device__ __forceinline__ float wave_max(float v) {
  v = row_max(v);
  return fmaxf(fmaxf(rdlane(v, 0), rdlane(v, 16)), fmaxf(rdlane(v, 32), rdlane(v, 48)));
}
__device__ __forceinline__ unsigned wave_umax(unsigned v) {
  unsigned t;
  t = (unsigned)dppi<0xB1>((int)v); v = v > t ? v : t;
  t = (unsigned)dppi<0x4E>((int)v); v = v > t ? v : t;
  t = (unsigned)dppi<0x141>((int)v); v = v > t ? v : t;
  t = (unsigned)dppi<0x140>((int)v); v = v > t ? v : t;
  unsigned a = (unsigned)__builtin_amdgcn_readlane((int)v, 0), b = (unsigned)__builtin_amdgcn_readlane((int)v, 16);
  unsigned c = (unsigned)__builtin_amdgcn_readlane((int)v, 32), d = (unsigned)__builtin_amdgcn_readlane((int)v, 48);
  a = a > b ? a : b; c = c > d ? c : d; return a > c ? a : c;
}
__device__ __forceinline__ unsigned ordkey(float f) {
  unsigned u = __float_as_uint(f);
  return (u & 0x80000000u) ? ~u : (u | 0x80000000u);
}

__device__ __forceinline__ unsigned fp6_code(float v) {
  const float a = fabsf(v);
  int code = a < 2.f ? (int)rintf(a * 8.f) : (a < 4.f ? 16 + (int)rintf((a - 2.f) * 4.f) : 24 + (int)rintf((a - 4.f) * 2.f));
  code = code > 31 ? 31 : code;
  return (unsigned)code | (v < 0.f ? 32u : 0u);
}
__device__ __forceinline__ void quant_chunk(const Params& p, int chunk) {
  const int tid = TID(), lane = tid & 63, wid = tid >> 6;
#pragma unroll 1
  for (int i8 = 0; i8 < 8; ++i8) {
    const int r = chunk * 64 + wid * 8 + i8;
    const int tab = r >> 14, row = r & 16383;
    const float* src = (tab ? p.peer_v : p.peer_u) + (size_t)row * D_ + lane * 4;
    float4 v[8];
    float am = 0.f;
#pragma unroll
    for (int i = 0; i < 8; ++i) {
      { const f32x4 tv = __builtin_nontemporal_load((const f32x4*)(src + i * 256)); v[i] = make_float4(tv[0], tv[1], tv[2], tv[3]); }
      am = fmaxf(am, fmaxf(fmaxf(fabsf(v[i].x), fabsf(v[i].y)), fmaxf(fabsf(v[i].z), fabsf(v[i].w))));
    }
    am = wave_max(am);
    const float qs = am > 0.f ? 7.5f / am : 1.f;
    unsigned w[6];
#pragma unroll
    for (int g = 0; g < 2; ++g) {
      unsigned long long lo = 0ull; unsigned hi = 0u;
#pragma unroll
      for (int i = 0; i < 4; ++i) {
        const float4 f = v[g * 4 + i];
        const unsigned q4 = fp6_code(f.x * qs) | (fp6_code(f.y * qs) << 6) | (fp6_code(f.z * qs) << 12) | (fp6_code(f.w * qs) << 18);
        if (i == 0) lo |= (unsigned long long)q4;
        if (i == 1) lo |= (unsigned long long)q4 << 24;
        if (i == 2) { lo |= (unsigned long long)q4 << 48; hi |= q4 >> 16; }
        if (i == 3) hi |= q4 << 8;
      }
      w[g * 3 + 0] = (unsigned)lo; w[g * 3 + 1] = (unsigned)(lo >> 32); w[g * 3 + 2] = hi;
    }
    unsigned* dst = (unsigned*)(p.Uq() + (size_t)row * 3072 + tab * 1536 + lane * 24);
    *(u32x2*)dst = u32x2{w[0], w[1]}; *(u32x2*)(dst + 2) = u32x2{w[2], w[3]}; *(u32x2*)(dst + 4) = u32x2{w[4], w[5]};
    if (lane == 0) (tab ? p.Vs() : p.Us())[row] = am > 0.f ? am / 7.5f : 1.f;
  }
}

__device__ void transpose_cvt(const float* __restrict__ W, int ldw, int K, int src_col0, int ncols,
                              u16* __restrict__ WT, int dst_row0, const float* __restrict__ kscale,
                              float* tile, int bid, int nb) {
  const int tiles_k = K / 64, tiles_n = ncols / 64, tid = TID();
#pragma unroll 1
  for (int t = bid; t < tiles_k * tiles_n; t += nb) {
    const int tk = t % tiles_k, tn = t / tiles_k, k0 = tk * 64, n0 = tn * 64;
#pragma unroll
    for (int i = 0; i < 2; ++i) {
      const int r = (tid >> 4) + 32 * i, c = (tid & 15) * 4;
      const f32x4 tv = __builtin_nontemporal_load((const f32x4*)(W + (size_t)(k0 + r) * ldw + src_col0 + n0 + c));
      const float4 v = make_float4(tv[0], tv[1], tv[2], tv[3]);
      const float sc = kscale ? kscale[k0 + r] : 1.f;
      tile[r * 65 + c + 0] = v.x * sc; tile[r * 65 + c + 1] = v.y * sc;
      tile[r * 65 + c + 2] = v.z * sc; tile[r * 65 + c + 3] = v.w * sc;
    }
    __syncthreads();
    {
      const int n = tid >> 3, kk = (tid & 7) * 8;
      unsigned w[4];
#pragma unroll
      for (int e = 0; e < 4; ++e) w[e] = pk2(tile[(kk + 2 * e) * 65 + n], tile[(kk + 2 * e + 1) * 65 + n]);
      *(u32x4*)(WT + (size_t)(dst_row0 + n0 + n) * K + k0 + kk) = u32x4{w[0], w[1], w[2], w[3]};
    }
    __syncthreads();
  }
}

__device__ void cvt_bf16(const float* __restrict__ src, u16* __restrict__ dst, size_t n8, size_t gtid, size_t gthreads) {
  for (size_t i = gtid; i < n8; i += gthreads) {
    const float4 a = ((const float4*)src)[2 * i], b = ((const float4*)src)[2 * i + 1];
    ((u32x4*)dst)[i] = u32x4{pk2(a.x, a.y), pk2(a.z, a.w), pk2(b.x, b.y), pk2(b.z, b.w)};
  }
}

__device__ void phase_prep(const Params& p, char* smem, int bid, int nb) {
  const int tid = TID(), lane = tid & 63, wid = tid >> 6;
  float* tile = (float*)smem;
  if (bid == 0 && tid == 0) p.ctr()[0] = 0;
  transpose_cvt(p.w_in, INW, D_, 0, 1024, p.WinT(), 0, nullptr, tile, bid, nb);
  transpose_cvt(p.w_in, INW, D_, 1088, 3072, p.WinT(), 1024, nullptr, tile, bid, nb);
  transpose_cvt(p.w_in, INW, D_, 1024, 64, p.WinT(), 4096, nullptr, tile, bid, nb);
  transpose_cvt(p.w_uq, 1536, 512, 0, 1536, p.WuqT(), 0, p.g_q, tile, bid, nb);
  transpose_cvt(p.w_ukv, 2048, 512, 0, 2048, p.WukvT(), 0, p.g_kv, tile, bid, nb);
  transpose_cvt(p.w_out, 2048, 2048, 0, 2048, p.WoutT(), 0, nullptr, tile, bid, nb);
  transpose_cvt(p.peer_wq, 1024, 2048, 0, 1024, p.WpqT(), 0, nullptr, tile, bid, nb);
  transpose_cvt(p.wgate, 2048, 2048, 0, 2048, p.WgT(), 0, nullptr, tile, bid, nb);
  transpose_cvt(p.wproj, 2048, 256, 0, 2048, p.WpT(), 0, nullptr, tile, bid, nb);
  const size_t gtid = (size_t)bid * NT + tid, gth = (size_t)nb * NT;
  for (size_t i = gtid; i < (size_t)192 * 2048 / 8; i += gth) ((u32x4*)(p.WinT() + (size_t)4160 * 2048))[i] = u32x4{0, 0, 0, 0};
  cvt_bf16(p.p, p.pb(), (size_t)T_ * 256 / 8, gtid, gth);
  for (size_t i = gtid; i < (size_t)T_ * 64 / 4; i += gth) ((float4*)p.krsum())[i] = make_float4(0.f, 0.f, 0.f, 0.f);
  for (size_t i = gtid; i < (size_t)2 * T_ / 4; i += gth) ((float4*)p.rss())[i] = make_float4(0.f, 0.f, 0.f, 0.f);
  for (size_t i = gtid; i < (size_t)2 * 65536; i += gth) {
    const float v = i < 65536 ? p.keys1[i] : p.keys2[i - 65536];
    const u16 h = f2bf(v);
    p.keyH()[i] = h; p.keyL()[i] = f2bf(v - bf2f(h));
  }
  for (size_t i = gtid; i < (size_t)T_ * 32; i += gth) {
    const int t = (int)(i >> 5), fi = (int)(i & 31);
    const float invf = 1.0f / powf(10000.0f, (float)(2 * fi) / 64.0f);
    const float ang = (float)p.positions[t] * invf;
    const double rev = (double)ang * 0.15915494309189535;
    const float fr = (float)(rev - rint(rev));
    p.cs()[i] = make_float2(__builtin_amdgcn_cosf(fr), __builtin_amdgcn_sinf(fr));
  }
  __syncthreads();
  float* wff = (float*)smem;
  for (int i = tid; i < 2048 * 2; i += NT) {
    const int k = i >> 1, hf = i & 1;
    *(float4*)(wff + (k ^ ((k >> 3) & 7)) * 8 + hf * 4) = *(const float4*)(p.w_in + (size_t)k * INW + 4160 + hf * 4);
  }
  __syncthreads();
  for (int t = bid * 8 + wid; t < T_; t += nb * 8) {
    float a[8];
#pragma unroll
    for (int e = 0; e < 8; ++e) a[e] = 0.f;
#pragma unroll
    for (int i = 0; i < 4; ++i) {
      const int k = (i * 64 + lane) * 8;
      const f32x4 xa = __builtin_nontemporal_load((const f32x4*)(p.x + (size_t)t * D_ + k)), xb4 = __builtin_nontemporal_load((const f32x4*)(p.x + (size_t)t * D_ + k + 4));
      const float4 x0 = make_float4(xa[0], xa[1], xa[2], xa[3]), x1 = make_float4(xb4[0], xb4[1], xb4[2], xb4[3]);
      *(u32x4*)(p.xb() + (size_t)t * D_ + k) = u32x4{pk2(x0.x, x0.y), pk2(x0.z, x0.w), pk2(x1.x, x1.y), pk2(x1.z, x1.w)};
      const float xs[8] = {x0.x, x0.y, x0.z, x0.w, x1.x, x1.y, x1.z, x1.w};
#pragma unroll
      for (int j = 0; j < 8; ++j) {
        const int kr = (k + j) ^ (lane & 7);
        const float4 w0 = *(const float4*)(wff + kr * 8), w1 = *(const float4*)(wff + kr * 8 + 4);
        a[0] += xs[j] * w0.x; a[1] += xs[j] * w0.y; a[2] += xs[j] * w0.z; a[3] += xs[j] * w0.w;
        a[4] += xs[j] * w1.x; a[5] += xs[j] * w1.y; a[6] += xs[j] * w1.z; a[7] += xs[j] * w1.w;
      }
    }
    float mine = 0.f;
#pragma unroll
    for (int e = 0; e < 8; ++e) { const float s = wave_sum(a[e]); if (lane == e) mine = s; }
    if (lane < 8) {
      const float z = mine + p.b_forget[lane];
      const float ls = fminf(z, 0.f) - log1pf(expf(-fabsf(z)));
      const int b = t >> 12, s = t & 4095;
      p.logf()[((size_t)(b * 8 + lane)) * S_ + s] = ls;
    }
  }
}

template <int WM, int WN>
__device__ __forceinline__ void gemm_core(const u16* __restrict__ A, int lda, const u16* __restrict__ Bt, int ldb,
                                          int K, int brow, int bcol, char* smem, f32x4 (&acc)[4 / WM][4][4]) {
  constexpr int MS = 4 / WM, BN = 64 * WN, NBL = BN / 64;
  static_assert(WM * WN == 8, "8 waves");
  const int tid = TID(), wid = tid >> 6, lane = tid & 63, wr = wid / WN, wc = wid % WN, fr = lane & 15, fq = lane >> 4;
#pragma unroll
  for (int h = 0; h < MS; ++h)
#pragma unroll
    for (int m = 0; m < 4; ++m)
#pragma unroll
      for (int n = 0; n < 4; ++n) acc[h][m][n] = f32x4{0.f, 0.f, 0.f, 0.f};
  const int nk = K / 64;
  const int srow = tid >> 3, sch = (tid & 7) ^ ((tid >> 4) & 7);
  const u16* ga = A + (size_t)(brow + srow) * lda + sch * 8;
  const u16* gb = Bt + (size_t)(bcol + srow) * ldb + sch * 8;
  char* sdst = smem + tid * 16;
  auto issue = [&](int kt, int st) {
    char* sa = sdst + st * 65536;
#pragma unroll
    for (int i = 0; i < 4; ++i)
      __builtin_amdgcn_global_load_lds((const unsigned*)(ga + (size_t)i * 64 * lda + kt * 64), (unsigned*)(sa + i * 8192), 16, 0, 0);
#pragma unroll
    for (int i = 0; i < NBL; ++i)
      __builtin_amdgcn_global_load_lds((const unsigned*)(gb + (size_t)i * 64 * ldb + kt * 64), (unsigned*)(sa + 32768 + i * 8192), 16, 0, 0);
  };
  const int fx = (fr >> 1) & 7;
  const int arow = (wr * (256 / WM) + fr) * 128, brw = 32768 + (wc * 64 + fr) * 128;
  const int c0 = (fq ^ fx) * 16, c1 = ((4 + fq) ^ fx) * 16;
  asm volatile("s_waitcnt vmcnt(0)" ::: "memory");
  __syncthreads();
  issue(0, 0);
#pragma unroll 1
  for (int kt = 0; kt < nk; ++kt) {
    asm volatile("s_waitcnt vmcnt(0)" ::: "memory");
    __builtin_amdgcn_s_barrier();
    asm volatile("" ::: "memory");
    if (kt + 1 < nk) issue(kt + 1, (kt + 1) & 1);
    const char* sb = smem + (kt & 1) * 65536;
#pragma unroll
    for (int ks = 0; ks < 2; ++ks) {
      const int co = ks ? c1 : c0;
      bf16x8 Bl[4];
#pragma unroll
      for (int n = 0; n < 4; ++n) Bl[n] = *reinterpret_cast<const bf16x8*>(sb + brw + co + n * 2048);
#pragma unroll
      for (int h = 0; h < MS; ++h) {
        bf16x8 At[4];
#pragma unroll
        for (int m = 0; m < 4; ++m) At[m] = *reinterpret_cast<const bf16x8*>(sb + arow + co + (h * 4 + m) * 2048);
#pragma unroll
        for (int m = 0; m < 4; ++m)
#pragma unroll
          for (int n = 0; n < 4; ++n) acc[h][m][n] = __builtin_amdgcn_mfma_f32_16x16x32_bf16(At[m], Bl[n], acc[h][m][n], 0, 0, 0);
      }
    }
  }
}

template <int WM, int WN, class Epi>
__device__ __forceinline__ void gemm_tile(const u16* __restrict__ A, int lda, const u16* __restrict__ Bt, int ldb,
                                          int K, int brow, int bcol, char* smem, Epi epi) {
  constexpr int MS = 4 / WM;
  const int tid = TID(), wid = tid >> 6, lane = tid & 63, wr = wid / WN, wc = wid % WN, fr = lane & 15, fq = lane >> 4;
  f32x4 acc[MS][4][4];
  gemm_core<WM, WN>(A, lda, Bt, ldb, K, brow, bcol, smem, acc);
#pragma unroll
  for (int h = 0; h < MS; ++h) epi(acc[h], brow + wr * (256 / WM) + h * 64, bcol + wc * 64, fr, fq);
}

namespace pg8 {
#define PG8_LAS __attribute__((address_space(3)))
typedef unsigned short bf16_t;
constexpr int BM = 256, BK = 64, HALF = 128, HTB = HALF * BK * 2  , STAGE_BYTES = 8 * HTB, NXCD = 8, WGM = 8;

__host__ __device__ __forceinline__ int lds_byte(int r, int c) { const int st = (r >> 4) * 2 + (c >> 5), rr = r & 15, cc = c & 31, ob = rr * 64 + cc * 2; return st * 1024 + (ob ^ (((ob >> 9) & 1) << 5)); }
__host__ __device__ __forceinline__ void stage_rc(int b, int& R, int& C) { const int st = b / 1024, sb = b % 1024, swz = sb ^ (((sb >> 9) & 1) << 5); R = (st >> 1) * 16 + swz / 64; C = (st & 1) * 32 + (swz % 64) / 2; }
__host__ __device__ __forceinline__ int perm32(int rho) { const int n = rho >> 4, i = rho & 15; return 8 * (i >> 2) + 4 * n + (i & 3); }
struct Unit { int pm, pn; };
struct Gemm { const bf16_t* A; const bf16_t* Bt; int M, N, K; };
struct StaticOrder {
    int nM, nN, nwg, G, c;
    __device__ void init(int M, int N, int G_, int c_) { nM = M / BM; nN = N / BM; nwg = nM * nN; G = G_; c = c_; }
    __device__ bool next(int i, Unit& u) const {
        const long L = (long)i * G + c; if (L >= nwg) return false;
        int wgid = (int)L; { const int q = nwg / NXCD, r = nwg % NXCD, xcd = wgid % NXCD, off = wgid / NXCD; wgid = (xcd < r ? xcd * (q + 1) : r * (q + 1) + (xcd - r) * q) + off; }
        const int nig = WGM * nN, gid = wgid / nig, fm = gid * WGM, gsz = (nM - fm) < WGM ? (nM - fm) : WGM;
        u.pm = fm + ((wgid % nig) % gsz); u.pn = (wgid % nig) / gsz; return true;
    }
    __device__ __forceinline__ void a_ready(const Unit&) const {}
    __device__ __forceinline__ void done(const Unit&) const {}
};
template <class Epi, class Sched, bool STAMP = false>
__device__ __forceinline__ void gemm_phase(PG8_LAS unsigned char* lds, const Gemm g, const Sched& S, const Epi& E, unsigned long long* stamps) {
    const int tid = TID(), wid = __builtin_amdgcn_readfirstlane(tid >> 6), lane = tid & 63, wr = wid >> 2, wc = wid & 3, fr = lane & 15, fq = lane >> 4;
    const int K = g.K, nt = K / BK;
    int ts_lo = 0, ts_hi = 0, nts = 0; const unsigned long long rt_entry = STAMP ? (unsigned long long)wall_clock64() : 0ull;
#define PG8_STAMP() do { if (STAMP && wid == 0 && nts < 64) { const unsigned long long _c = (unsigned long long)clock64(); \
        ts_lo = (lane == nts) ? (int)(unsigned)_c : ts_lo; ts_hi = (lane == nts) ? (int)(unsigned)(_c >> 32) : ts_hi; ++nts; } } while (0)
    PG8_STAMP();
    unsigned voffA[2], voffB[2];
#pragma unroll
    for (int i = 0; i < 2; ++i) { int R, C; stage_rc(tid * 16 + i * 8192, R, C); const int Rb = Epi::PERM ? ((R & ~31) + perm32(R & 31)) : R;
        voffA[i] = (unsigned)(R * K + C) * 2u; voffB[i] = (unsigned)(Rb * K + C) * 2u; }
    const size_t kstep = (size_t)(BK * 2);
    const size_t hstep = (size_t)HALF * K * 2;
    const size_t tstep = 2 * hstep;
    const unsigned ldsw = (unsigned)wid * 1024u;
    const int aoff = lds_byte(wr * 64 + fr, fq * 8), boff = lds_byte(wc * 32 + fr, fq * 8);
#define PG8_SA(b, h) (((b) * 2 + (h)) * HTB)
#define PG8_SB(b, h) ((4 + (b) * 2 + (h)) * HTB)
#define PG8_STAGE(bufoff, gbase, voff) do { _Pragma("unroll") for (int _i = 0; _i < 2; ++_i) \
        __builtin_amdgcn_global_load_lds((const unsigned*)((const char*)(gbase) + (voff)[_i]), (PG8_LAS unsigned*)(lds + (bufoff) + ldsw + _i * 8192), 16, 0, 0); } while (0)
#define PG8_LDA(dst, b, h) do { _Pragma("unroll") for (int m = 0; m < 4; ++m) _Pragma("unroll") for (int k = 0; k < 2; ++k) dst[m][k] = *(const PG8_LAS bf16x8*)(lds + PG8_SA(b, h) + aoff + m * 2048 + k * 1024); } while (0)
#define PG8_LDB(dst, b, h) do { _Pragma("unroll") for (int n = 0; n < 2; ++n) _Pragma("unroll") for (int k = 0; k < 2; ++k) dst[n][k] = *(const PG8_LAS bf16x8*)(lds + PG8_SB(b, h) + boff + n * 2048 + k * 1024); } while (0)
#define PG8_MMA(ai, bj, At, Bt) do { __builtin_amdgcn_s_setprio(1); _Pragma("unroll") for (int m = 0; m < 4; ++m) _Pragma("unroll") for (int n = 0; n < 2; ++n) _Pragma("unroll") for (int k = 0; k < 2; ++k) \
        acc[ai][bj][m][n] = __builtin_amdgcn_mfma_f32_16x16x32_bf16(Bt[n][k], At[m][k], acc[ai][bj][m][n], 0, 0, 0); __builtin_amdgcn_s_setprio(0); } while (0)
#define PG8_WAIT_V(n) asm volatile("s_waitcnt vmcnt(" #n ")" ::: "memory")
#define PG8_WAIT_L(n) asm volatile("s_waitcnt lgkmcnt(" #n ")" ::: "memory")
#define PG8_BAR __builtin_amdgcn_s_barrier()
#define PG8_SCHED __builtin_amdgcn_sched_barrier(0)
    Unit cur, nxt; int ui = 0;
    if (!S.next(0, cur)) return;
    f32x4 acc[2][2][4][2];
#pragma unroll
    for (int a = 0; a < 2; ++a)
#pragma unroll
        for (int b = 0; b < 2; ++b)
#pragma unroll
            for (int m = 0; m < 4; ++m)
#pragma unroll
                for (int n = 0; n < 2; ++n) acc[a][b][m][n] = (f32x4){0.f, 0.f, 0.f, 0.f};
    bf16x8 At[4][2], B0[2][2], B1[2][2];
    const char* cA = (const char*)g.A + (size_t)cur.pm * tstep; const char* cB = (const char*)g.Bt + (size_t)cur.pn * tstep;
    S.a_ready(cur);
    PG8_STAGE(PG8_SB(0, 0), cB, voffB); PG8_STAGE(PG8_SA(0, 0), cA, voffA); PG8_STAGE(PG8_SB(0, 1), cB + hstep, voffB); PG8_STAGE(PG8_SA(0, 1), cA + hstep, voffA);
    if (wr == 1) PG8_BAR;
    PG8_WAIT_V(4); PG8_BAR;
    PG8_STAGE(PG8_SB(1, 0), cB + kstep, voffB); PG8_STAGE(PG8_SA(1, 0), cA + kstep, voffA); PG8_STAGE(PG8_SB(1, 1), cB + hstep + kstep, voffB);
    PG8_WAIT_V(6); PG8_BAR;
    PG8_STAMP();
    for (;;) {
        const bool has_next = S.next(ui + 1, nxt);
        const char* nA = has_next ? (const char*)g.A + (size_t)nxt.pm * tstep : cA; const char* nB = has_next ? (const char*)g.Bt + (size_t)nxt.pn * tstep : cB;
        for (int t = 0; t < nt; t += 2) {
            const bool last = (t == nt - 2);
            const char* a1 = cA + (size_t)(t + 1) * kstep;
            const char* a2 = last ? nA : cA + (size_t)(t + 2) * kstep; const char* b2 = last ? nB : cB + (size_t)(t + 2) * kstep;
            const char* a3 = a2 + kstep; const char* b3 = b2 + kstep;
            if (last && has_next) S.a_ready(nxt);
            PG8_LDB(B0, 0, 0); PG8_SCHED; PG8_LDA(At, 0, 0); PG8_STAGE(PG8_SA(1, 1), a1 + hstep, voffA);
            PG8_WAIT_L(8); PG8_BAR; PG8_WAIT_L(0); PG8_MMA(0, 0, At, B0); PG8_BAR; PG8_SCHED;
            PG8_LDB(B1, 0, 1); PG8_STAGE(PG8_SB(0, 0), b2, voffB);
            PG8_BAR; PG8_WAIT_L(0); PG8_MMA(0, 1, At, B1); PG8_BAR;
            PG8_LDA(At, 0, 1); PG8_STAGE(PG8_SA(0, 0), a2, voffA);
            PG8_BAR; PG8_WAIT_L(0); PG8_MMA(1, 0, At, B0); PG8_BAR; PG8_SCHED;
            PG8_STAGE(PG8_SB(0, 1), b2 + hstep, voffB);
            PG8_WAIT_V(6); PG8_BAR; PG8_MMA(1, 1, At, B1); PG8_BAR;
            PG8_LDB(B0, 1, 0); PG8_SCHED; PG8_LDA(At, 1, 0); PG8_STAGE(PG8_SA(0, 1), a2 + hstep, voffA);
            PG8_WAIT_L(8); PG8_BAR; PG8_WAIT_L(0); PG8_MMA(0, 0, At, B0); PG8_BAR; PG8_SCHED;
            PG8_LDB(B1, 1, 1); PG8_STAGE(PG8_SB(1, 0), b3, voffB);
            PG8_BAR; PG8_WAIT_L(0); PG8_MMA(0, 1, At, B1); PG8_BAR;
            PG8_LDA(At, 1, 1); PG8_STAGE(PG8_SA(1, 0), a3, voffA);
            PG8_BAR; PG8_WAIT_L(0); PG8_MMA(1, 0, At, B0); PG8_BAR; PG8_SCHED;
            PG8_STAGE(PG8_SB(1, 1), b3 + hstep, voffB);
            PG8_WAIT_V(6); PG8_BAR; PG8_MMA(1, 1, At, B1); PG8_BAR;
        }
        PG8_STAMP();
        if constexpr (!Epi::AFTER_DRAIN) { E(acc, cur, wr, wc, fr, fq); S.done(cur); }
        PG8_STAMP();
        if (!has_next) break;
#pragma unroll
        for (int a = 0; a < 2; ++a)
#pragma unroll
            for (int b = 0; b < 2; ++b)
#pragma unroll
                for (int m = 0; m < 4; ++m)
#pragma unroll
                    for (int n = 0; n < 2; ++n) acc[a][b][m][n] = (f32x4){0.f, 0.f, 0.f, 0.f};
        cur = nxt; cA = nA; cB = nB; ++ui;
    }
    PG8_WAIT_V(0);
    if (wr == 0) PG8_BAR;
    PG8_BAR;
    if constexpr (Epi::AFTER_DRAIN) { E.fused(acc, cur, wr, wc, fr, fq, lds, wid, lane); S.done(cur); }
    PG8_STAMP();
    if (STAMP && wid == 0) { stamps[lane] = lane < nts ? (((unsigned long long)(unsigned)ts_hi << 32) | (unsigned)ts_lo) : 0ull;
        if (lane == 62) stamps[62] = rt_entry; if (lane == 63) stamps[63] = (unsigned long long)wall_clock64(); }
#undef PG8_STAMP
#undef PG8_SA
#undef PG8_SB
#undef PG8_STAGE
#undef PG8_LDA
#undef PG8_LDB
#undef PG8_MMA
#undef PG8_WAIT_V
#undef PG8_WAIT_L
#undef PG8_BAR
#undef PG8_SCHED
}
}


__device__ __forceinline__ u32x4 pack8(const f32x4& a, const f32x4& b) { return u32x4{pk2(a[0], a[1]), pk2(a[2], a[3]), pk2(b[0], b[1]), pk2(b[2], b[3])}; }
__device__ __forceinline__ float sumsq4(const f32x4& a) { return (a[0] * a[0] + a[1] * a[1]) + (a[2] * a[2] + a[3] * a[3]); }
__device__ __forceinline__ void store_tr8(u16* vt, const f32x4& a, const f32x4& b) {
  vt[0] = f2bf(a[0]); vt[(size_t)S_] = f2bf(a[1]); vt[(size_t)2 * S_] = f2bf(a[2]); vt[(size_t)3 * S_] = f2bf(a[3]);
  vt[(size_t)4 * S_] = f2bf(b[0]); vt[(size_t)5 * S_] = f2bf(b[1]); vt[(size_t)6 * S_] = f2bf(b[2]); vt[(size_t)7 * S_] = f2bf(b[3]);
}
struct EpiInproj {
  static constexpr bool PERM = true, AFTER_DRAIN = false;
  u16 *cqb, *ckvb, *Qf, *Kf, *VfT; float* rss;
  __device__ __forceinline__ void operator()(const f32x4 (&acc)[2][2][4][2], const pg8::Unit& u, int wr, int wc, int fr, int fq) const {
    const int ct = u.pn * 256;
#pragma unroll
    for (int ai = 0; ai < 2; ++ai)
#pragma unroll
      for (int m = 0; m < 4; ++m) {
        const int row = u.pm * 256 + ai * 128 + wr * 64 + m * 16 + fr, b = row >> 12, s = row & 4095;
        float ss = 0.f;
#pragma unroll
        for (int bj = 0; bj < 2; ++bj) {
          const int c0 = ct + bj * 128 + wc * 32 + 8 * fq;
          const f32x4 v0 = acc[ai][bj][m][0], v1 = acc[ai][bj][m][1];
          if (ct < 1024) {
            u16* dst = ct < 512 ? cqb : ckvb;
            *(u32x4*)(dst + (size_t)row * 512 + (c0 & 511)) = pack8(v0, v1);
            ss += sumsq4(v0) + sumsq4(v1);
          } else if (ct < 3072) {
            int c = c0 - 1024; u16* dst = c < 1024 ? Qf : Kf; c &= 1023;
            *(u32x4*)(dst + ((size_t)(b * 8 + (c >> 7)) * S_ + s) * 128 + (c & 127)) = pack8(v0, v1);
          } else {
            const int c = c0 - 3072;
            store_tr8(VfT + ((size_t)(b * 8 + (c >> 7)) * 128 + (c & 127)) * S_ + s, v0, v1);
          }
        }
        if (ct < 1024) atomicAdd(rss + (ct < 512 ? 0 : T_) + row, ss);
        __builtin_amdgcn_sched_barrier(0);
      }
  }
};
struct EpiQup {
  static constexpr bool PERM = true, AFTER_DRAIN = false;
  u16* Qm; const float* rss;
  __device__ __forceinline__ void operator()(const f32x4 (&acc)[2][2][4][2], const pg8::Unit& u, int wr, int wc, int fr, int fq) const {
#pragma unroll
    for (int ai = 0; ai < 2; ++ai)
#pragma unroll
      for (int m = 0; m < 4; ++m) {
        const int row = u.pm * 256 + ai * 128 + wr * 64 + m * 16 + fr, b = row >> 12, s = row & 4095;
        const float rs = rsqrtf(rss[row] * (1.f / 512.f) + EPS);
#pragma unroll
        for (int bj = 0; bj < 2; ++bj) {
          const int c0 = u.pn * 256 + bj * 128 + wc * 32 + 8 * fq, hh = c0 / 192, off = c0 % 192;
          *(u32x4*)(Qm + ((size_t)(b * 8 + hh) * S_ + s) * 192 + off) = pack8(acc[ai][bj][m][0] * rs, acc[ai][bj][m][1] * rs);
        }
        __builtin_amdgcn_sched_barrier(0);
      }
  }
};
struct EpiKVup {
  static constexpr bool PERM = true, AFTER_DRAIN = false;
  u16 *Km, *VmT; const float* rss;
  __device__ __forceinline__ void operator()(const f32x4 (&acc)[2][2][4][2], const pg8::Unit& u, int wr, int wc, int fr, int fq) const {
    const int hh = u.pn;
#pragma unroll
    for (int ai = 0; ai < 2; ++ai)
#pragma unroll
      for (int m = 0; m < 4; ++m) {
        const int row = u.pm * 256 + ai * 128 + wr * 64 + m * 16 + fr, b = row >> 12, s = row & 4095;
        const float rs = rsqrtf(rss[T_ + row] * (1.f / 512.f) + EPS);
        const int off = wc * 32 + 8 * fq;
        *(u32x4*)(Km + ((size_t)(b * 8 + hh) * S_ + s) * 192 + off) = pack8(acc[ai][0][m][0] * rs, acc[ai][0][m][1] * rs);
        store_tr8(VmT + ((size_t)(b * 8 + hh) * 128 + off) * S_ + s, acc[ai][1][m][0] * rs, acc[ai][1][m][1] * rs);
        __builtin_amdgcn_sched_barrier(0);
      }
  }
};
struct EpiProj {
  static constexpr bool PERM = true, AFTER_DRAIN = false;
  u16* projb;
  __device__ __forceinline__ void operator()(const f32x4 (&acc)[2][2][4][2], const pg8::Unit& u, int wr, int wc, int fr, int fq) const {
#pragma unroll
    for (int ai = 0; ai < 2; ++ai)
#pragma unroll
      for (int m = 0; m < 4; ++m) {
        const int row = u.pm * 256 + ai * 128 + wr * 64 + m * 16 + fr;
#pragma unroll
        for (int bj = 0; bj < 2; ++bj)
          *(u32x4*)(projb + (size_t)row * D_ + u.pn * 256 + bj * 128 + wc * 32 + 8 * fq) = pack8(acc[ai][bj][m][0], acc[ai][bj][m][1]);
      }
  }
};
struct EpiOut {
  static constexpr bool PERM = false, AFTER_DRAIN = false;
  const float* x; u16* y1;
  __device__ __forceinline__ void operator()(const f32x4 (&acc)[2][2][4][2], const pg8::Unit& u, int wr, int wc, int fr, int fq) const {
#pragma unroll
    for (int ai = 0; ai < 2; ++ai)
#pragma unroll
      for (int m = 0; m < 4; ++m) {
        const size_t rb = (size_t)(u.pm * 256 + ai * 128 + wr * 64 + m * 16 + fr) * D_ + u.pn * 256 + wc * 32 + 4 * fq;
#pragma unroll
        for (int bj = 0; bj < 2; ++bj)
#pragma unroll
          for (int n = 0; n < 2; ++n) {
            const size_t o = rb + bj * 128 + n * 16;
            const f32x4 xv = *(const f32x4*)(x + o);
            const f32x4 y = xv * ALPHA + acc[ai][bj][m][n];
            *(u32x2*)(y1 + o) = u32x2{pk2(y[0], y[1]), pk2(y[2], y[3])};
          }
      }
  }
};
struct EpiGate {
  static constexpr bool PERM = false, AFTER_DRAIN = false;
  const u16* h1b; const u16* projb; u16* r2b;
  __device__ __forceinline__ void operator()(const f32x4 (&acc)[2][2][4][2], const pg8::Unit& u, int wr, int wc, int fr, int fq) const {
#pragma unroll
    for (int ai = 0; ai < 2; ++ai)
#pragma unroll
      for (int m = 0; m < 4; ++m) {
        const size_t rb = (size_t)(u.pm * 256 + ai * 128 + wr * 64 + m * 16 + fr) * D_ + u.pn * 256 + wc * 32 + 4 * fq;
#pragma unroll
        for (int bj = 0; bj < 2; ++bj)
#pragma unroll
          for (int n = 0; n < 2; ++n) {
            const size_t o = rb + bj * 128 + n * 16;
            const u32x2 hb = *(const u32x2*)(h1b + o);
            const f32x4 hv = {bflo(hb[0]), bfhi(hb[0]), bflo(hb[1]), bfhi(hb[1])};
            const u32x2 pj = *(const u32x2*)(projb + o);
            const f32x4 a = acc[ai][bj][m][n];
            f32x4 r;
            r[0] = ALPHA * hv[0] + bflo(pj[0]) / (1.f + __expf(-a[0])); r[1] = ALPHA * hv[1] + bfhi(pj[0]) / (1.f + __expf(-a[1]));
            r[2] = ALPHA * hv[2] + bflo(pj[1]) / (1.f + __expf(-a[2])); r[3] = ALPHA * hv[3] + bfhi(pj[1]) / (1.f + __expf(-a[3]));
            *(u32x2*)(r2b + o) = u32x2{pk2(r[0], r[1]), pk2(r[2], r[3])};
          }
      }
  }
};

__device__ __forceinline__ int vblock(int bid, int nb) { return (nb & 7) ? bid : (bid & 7) * (nb >> 3) + (bid >> 3); }
__device__ __forceinline__ void tile_rc(int t, int Nt, int& tm, int& tn) {
  const int g = t / (8 * Nt), q = t % (8 * Nt);
  tn = q >> 3; tm = g * 8 + (q & 7);
}

__device__ void phase_inproj(const Params& p, char* smem, int bid, int nb) {
  {
    EpiInproj E{p.cqb(), p.ckvb(), p.Qf(), p.Kf(), p.VfT(), p.rss()};
    pg8::Gemm g{p.xb(), p.WinT(), T_, 4096, D_};
    pg8::StaticOrder S; S.init(T_, 4096, nb, bid);
    pg8::gemm_phase((PG8_LAS unsigned char*)smem, g, S, E, nullptr);
  }
  for (int t = vblock(bid, nb); t < 256; t += nb) {
    const int tm = t >> 3, ks = t & 7;
    f32x4 acc[2][4][4];
    gemm_core<2, 4>(p.xb() + ks * 256, D_, p.WinT() + ks * 256, D_, 256, tm * 256, 4096, smem, acc);
    const int tid = TID(), wid = tid >> 6, lane = tid & 63, wr = wid >> 2, wc = wid & 3, fr = lane & 15, fq = lane >> 4;
    if (wc == 0) {
#pragma unroll
      for (int h = 0; h < 2; ++h) {
        float* kd = p.krsum() + (size_t)(tm * 256 + wr * 128 + h * 64 + fq * 4) * 64 + fr;
#pragma unroll
        for (int m = 0; m < 4; ++m)
#pragma unroll
          for (int n = 0; n < 4; ++n)
#pragma unroll
            for (int j = 0; j < 4; ++j) atomicAdd(kd + (m * 16 + j) * 64 + n * 16, acc[h][m][n][j]);
      }
    }
  }
}

__device__ void phase_up(const Params& p, char* smem, int bid, int nb) {
  PG8_LAS unsigned char* lds = (PG8_LAS unsigned char*)smem;
  {
    EpiQup E{p.Qm(), p.rss()};
    pg8::Gemm g{p.cqb(), p.WuqT(), T_, 1536, 512};
    pg8::StaticOrder S; S.init(T_, 1536, nb, (bid + nb - 64) % nb);
    pg8::gemm_phase(lds, g, S, E, nullptr);
  }
  {
    EpiKVup E{p.Km(), p.VmT(), p.rss()};
    pg8::Gemm g{p.ckvb(), p.WukvT(), T_, 2048, 512};
    pg8::StaticOrder S; S.init(T_, 2048, nb, bid);
    pg8::gemm_phase(lds, g, S, E, nullptr);
  }
  {
    EpiProj E{p.projb()};
    pg8::Gemm g{p.pb(), p.WpT(), T_, 2048, 256};
    pg8::StaticOrder S; S.init(T_, 2048, nb, bid);
    pg8::gemm_phase(lds, g, S, E, nullptr);
  }
  for (int t = bid; t < 48; t += nb) {
    if (t >= 16) {
      const int r0 = (t - 16) * 256, tid = TID();
#pragma unroll 1
      for (int it = 0; it < 16; ++it) {
        const int pr = it * NT + tid, row = r0 + (pr >> 5), i = pr & 31, b = row >> 12, s = row & 4095;
        const float x1 = p.krsum()[(size_t)row * 64 + i], x2 = p.krsum()[(size_t)row * 64 + 32 + i];
        const float2 cs = p.cs()[(size_t)row * 32 + i];
        const u16 o1 = f2bf(x1 * cs.x - x2 * cs.y), o2 = f2bf(x1 * cs.y + x2 * cs.x);
#pragma unroll
        for (int hh = 0; hh < 8; ++hh) {
          u16* kd = p.Km() + ((size_t)(b * 8 + hh) * S_ + s) * 192 + 128;
          kd[i] = o1; kd[32 + i] = o2;
        }
      }
    } else {
      const int seq = t;
      if ((TID() >> 6) == 0) {
        const int lane = TID() & 63;
        const float* src = p.logf() + (size_t)seq * S_ + lane * 64;
        float* dst = p.Fk() + (size_t)seq * S_ + lane * 64;
        float sum = 0.f;
#pragma unroll
        for (int i = 0; i < 16; ++i) { const float4 v = *(const float4*)(src + i * 4); sum += v.x; sum += v.y; sum += v.z; sum += v.w; }
        float inc = sum;
#pragma unroll
        for (int d = 1; d < 64; d <<= 1) { const float o = __shfl_up(inc, d, 64); if (lane >= d) inc += o; }
        float run = inc - sum;
#pragma unroll
        for (int i = 0; i < 16; ++i) {
          const float4 v = *(const float4*)(src + i * 4); float4 o;
          run += v.x; o.x = run; run += v.y; o.y = run; run += v.z; o.z = run; run += v.w; o.w = run;
          *(float4*)(dst + i * 4) = o;
        }
      }
    }
  }
}

#ifdef ATTN_NAIVE
__device__ void phase_attn_naive(const Params& p, char* smem, int bid, int nb) {
  const int tid = TID(), lane = tid & 63, wid = tid >> 6;
  const int per = NB_ * 8 * S_, nrows = 2 * per;
  for (int r = bid * 4 + wid; r < nrows; r += nb * 4) {
    const int type = r / per, rr = r % per, bh = rr / S_, s = rr % S_;
    const int DQ = type ? 128 : 192;
    const u16* Q = type ? p.Qf() + ((size_t)bh * S_ + s) * 128 : p.Qm() + ((size_t)bh * S_ + s) * 192;
    const u16* Kb = type ? p.Kf() + (size_t)bh * S_ * 128 : p.Km() + (size_t)bh * S_ * 192;
    const u16* VT = (type ? p.VfT() : p.VmT()) + (size_t)bh * 128 * S_;
    const float* F = p.Fk() + (size_t)bh * S_;
    const float scale = type ? 0.08838834764831845f : 0.07216878364870322f;
    float m = -1e30f, l = 0.f;
    float acc[128];
#pragma unroll
    for (int d = 0; d < 128; ++d) acc[d] = 0.f;
    const float fqv = type ? F[s] : 0.f;
    for (int k0 = 0; k0 <= s; k0 += 64) {
      const int key = k0 + lane; const bool valid = key <= s; const int keyc = valid ? key : s;
      const u16* kr = Kb + (size_t)keyc * DQ;
      float sc = 0.f;
      for (int d = 0; d < DQ; d += 8) {
        const u32x4 kv = *(const u32x4*)(kr + d), qv = *(const u32x4*)(Q + d);
#pragma unroll
        for (int w = 0; w < 4; ++w) sc += bflo(kv[w]) * bflo(qv[w]) + bfhi(kv[w]) * bfhi(qv[w]);
      }
      sc *= scale;
      if (type) sc += fqv - F[keyc];
      if (!valid) sc = -1e30f;
      const float mx = wave_max(sc), mn = fmaxf(m, mx), alpha = __expf(m - mn);
      const float pr = valid ? __expf(sc - mn) : 0.f;
      m = mn; l = l * alpha + pr;
#pragma unroll
      for (int d = 0; d < 128; ++d) acc[d] = acc[d] * alpha + pr * bf2f(VT[(size_t)d * S_ + keyc]);
    }
    const float inv = 1.f / wave_sum(l);
    float o0 = 0.f, o1 = 0.f;
#pragma unroll
    for (int d = 0; d < 128; ++d) {
      const float o = wave_sum(acc[d]) * inv;
      if (lane == (d & 63)) { if (d < 64) o0 = o; else o1 = o; }
    }
    const int b = bh >> 3, hh = bh & 7;
    u16* od = p.omix() + ((size_t)(b * S_ + s)) * 2048 + type * 1024 + hh * 128;
    od[lane] = f2bf(o0); od[64 + lane] = f2bf(o1);
  }
}

#endif
typedef float f32x16 __attribute__((ext_vector_type(16)));
template <int TYPE>
__device__ __forceinline__ void attn_item(const Params& p, char* smem, int bh, int qb) {
  constexpr int DQK = TYPE ? 128 : 192, NKS = DQK / 16, KSTR = DQK * 2 + 16, VSTR = 128;
  constexpr int KCH = DQK / 8, NKL = 64 * KCH / NT;
  constexpr float C2 = (TYPE ? 0.08838834764831845f : 0.07216878364870322f) * 1.4426950408889634f;
  char* sK = smem; char* sV = smem + 51200; float* sF = (float*)(smem + 51200 + 32768);
  const int tid = TID(), lane = tid & 63, wid = tid >> 6, c = lane & 31, hi = lane >> 5;
  const u16* Qb = (TYPE ? p.Qf() : p.Qm()) + (size_t)bh * S_ * DQK;
  const u16* Kb = (TYPE ? p.Kf() : p.Km()) + (size_t)bh * S_ * DQK;
  const u16* Vb = (TYPE ? p.VfT() : p.VmT()) + (size_t)bh * 128 * S_;
  const float* Fb = p.Fk() + (size_t)bh * S_;
  const int qrow = qb * 256 + wid * 32;
  bf16x8 qf[NKS];
#pragma unroll
  for (int ks = 0; ks < NKS; ++ks) qf[ks] = *(const bf16x8*)(Qb + (size_t)(qrow + c) * DQK + ks * 16 + hi * 8);
  if (TYPE == 0) {
    const float2* csr = p.cs() + (size_t)((bh >> 3) * S_ + qrow + c) * 32;
#pragma unroll
    for (int kk = 0; kk < 2; ++kk) {
      u32x4 x1 = *reinterpret_cast<u32x4*>(&qf[(NKS - 4) + kk]), x2 = *reinterpret_cast<u32x4*>(&qf[(NKS - 2) + kk]);
#pragma unroll
      for (int w = 0; w < 4; ++w) {
        const float4 cs = *(const float4*)(csr + 16 * kk + 8 * hi + 2 * w);
        const float a0 = bflo(x1[w]), a1 = bfhi(x1[w]), b0 = bflo(x2[w]), b1 = bfhi(x2[w]);
        x1[w] = pk2(a0 * cs.x - b0 * cs.y, a1 * cs.z - b1 * cs.w);
        x2[w] = pk2(a0 * cs.y + b0 * cs.x, a1 * cs.w + b1 * cs.z);
      }
      qf[(NKS - 4) + kk] = *reinterpret_cast<bf16x8*>(&x1); qf[(NKS - 2) + kk] = *reinterpret_cast<bf16x8*>(&x2);
    }
  }
  f32x16 o[4];
#pragma unroll
  for (int db = 0; db < 4; ++db)
#pragma unroll
    for (int r = 0; r < 16; ++r) o[db][r] = 0.f;
  float m = -1e30f, l = 0.f;
  const int ntiles = 4 * qb + 4;
  u32x4 kreg[NKL];
  float4 freg = make_float4(0.f, 0.f, 0.f, 0.f);
  const unsigned koff = (unsigned)tid * 16u;
  auto load_k = [&](int kt) {
    const char* kb = (const char*)(Kb + (size_t)kt * 64 * DQK);
#pragma unroll
    for (int i = 0; i < NKL; ++i) kreg[i] = *(const u32x4*)(kb + i * 8192 + koff);
    if (TYPE) { if (tid < 16) freg = *(const float4*)(Fb + kt * 64 + tid * 4); }
  };
  const unsigned voff = (unsigned)((((tid >> 3) * S_) + (((tid & 7) ^ ((tid >> 4) & 7)) * 8)) * 2);
  auto load_v = [&](int kt) {
    const char* vb = (const char*)(Vb + kt * 64);
    char* dst = sV + (kt & 1) * 16384 + tid * 16;
#pragma unroll
    for (int i = 0; i < 2; ++i)
      __builtin_amdgcn_global_load_lds((const unsigned*)(vb + (size_t)i * 64 * S_ * 2 + voff), (unsigned*)(dst + i * 8192), 16, 0, 0);
  };
  auto store_tile = [&](int kt) {
    char* sKw = sK + (kt & 1) * 25600;
#pragma unroll
    for (int i = 0; i < NKL; ++i) { const int ch = tid + NT * i, key = ch / KCH, dc = ch % KCH; *(u32x4*)(sKw + key * KSTR + dc * 16) = kreg[i]; }
    if (TYPE) { if (tid < 16) { const float L2E = 1.4426950408889634f; *(float4*)(sF + (kt & 1) * 64 + tid * 4) = make_float4(freg.x * L2E, freg.y * L2E, freg.z * L2E, freg.w * L2E); } }
  };
  const int krow = (c & 19) | ((c & 4) << 1) | ((c & 8) >> 1);
  const char* ka0 = sK + krow * KSTR + hi * 16;
  const char* ka1 = ka0 + 32 * KSTR;
  const int vx = (c >> 1) & 7;
  int vo[2][2];
#pragma unroll
  for (int kb = 0; kb < 2; ++kb)
#pragma unroll
    for (int s2 = 0; s2 < 2; ++s2) vo[kb][s2] = c * VSTR + (((4 * kb + 2 * s2 + hi) ^ vx) * 16);
  load_k(0); load_v(0);
  store_tile(0);
#pragma unroll 1
  for (int kt = 0; kt < ntiles; ++kt) {
    asm volatile("s_waitcnt vmcnt(0) lgkmcnt(0)" ::: "memory");
    __syncthreads();
    if (kt + 1 < ntiles) { load_k(kt + 1); load_v(kt + 1); }
    const int k0 = kt * 64;
    const char* sVc = sV + (kt & 1) * 16384;
    const int kbo = (kt & 1) * 25600;
    const float* sFc = sF + (kt & 1) * 64;
    if (k0 <= qrow + 31) {
      f32x16 p0, p1;
#pragma unroll
      for (int r = 0; r < 16; ++r) { p0[r] = 0.f; p1[r] = 0.f; }
#pragma unroll
      for (int ks = 0; ks < NKS; ++ks) {
        const bf16x8 a0 = *(const bf16x8*)(ka0 + kbo + ks * 32), a1 = *(const bf16x8*)(ka1 + kbo + ks * 32);
        p0 = __builtin_amdgcn_mfma_f32_32x32x16_bf16(a0, qf[ks], p0, 0, 0, 0);
        p1 = __builtin_amdgcn_mfma_f32_32x32x16_bf16(a1, qf[ks], p1, 0, 0, 0);
      }
      if (TYPE) {
#pragma unroll
        for (int s = 0; s < 2; ++s) {
          const float4 f0 = *(const float4*)(sFc + 16 * s + 8 * hi), f1 = *(const float4*)(sFc + 16 * s + 8 * hi + 4);
          const float4 g0 = *(const float4*)(sFc + 32 + 16 * s + 8 * hi), g1 = *(const float4*)(sFc + 32 + 16 * s + 8 * hi + 4);
          p0[8 * s + 0] = p0[8 * s + 0] * C2 - f0.x; p0[8 * s + 1] = p0[8 * s + 1] * C2 - f0.y; p0[8 * s + 2] = p0[8 * s + 2] * C2 - f0.z; p0[8 * s + 3] = p0[8 * s + 3] * C2 - f0.w;
          p0[8 * s + 4] = p0[8 * s + 4] * C2 - f1.x; p0[8 * s + 5] = p0[8 * s + 5] * C2 - f1.y; p0[8 * s + 6] = p0[8 * s + 6] * C2 - f1.z; p0[8 * s + 7] = p0[8 * s + 7] * C2 - f1.w;
          p1[8 * s + 0] = p1[8 * s + 0] * C2 - g0.x; p1[8 * s + 1] = p1[8 * s + 1] * C2 - g0.y; p1[8 * s + 2] = p1[8 * s + 2] * C2 - g0.z; p1[8 * s + 3] = p1[8 * s + 3] * C2 - g0.w;
          p1[8 * s + 4] = p1[8 * s + 4] * C2 - g1.x; p1[8 * s + 5] = p1[8 * s + 5] * C2 - g1.y; p1[8 * s + 6] = p1[8 * s + 6] * C2 - g1.z; p1[8 * s + 7] = p1[8 * s + 7] * C2 - g1.w;
        }
      }
      if (k0 + 63 > qrow) {
        const int lim = qrow + c - k0 - 8 * hi;
        const float NEG = -__builtin_inff();
#pragma unroll
        for (int r = 0; r < 16; ++r) {
          const int kb = 16 * (r >> 3) + (r & 7);
          if (kb > lim) p0[r] = NEG;
          if (kb + 32 > lim) p1[r] = NEG;
        }
      }
      float mx = p0[0];
#pragma unroll
      for (int r = 1; r < 16; ++r) mx = fmaxf(mx, p0[r]);
#pragma unroll
      for (int r = 0; r < 16; ++r) mx = fmaxf(mx, p1[r]);
      {
        auto rr = __builtin_amdgcn_permlane32_swap(__float_as_uint(mx), __float_as_uint(mx), false, false);
        mx = fmaxf(__uint_as_float(rr[0]), __uint_as_float(rr[1]));
      }
      if (!TYPE) mx *= C2;
      constexpr float THR = TYPE ? 96.f : 16.f;
      float mn = m, alpha = 1.f;
      if (!__all(mx - m <= THR)) {
        mn = fmaxf(m, mx);
        alpha = __builtin_amdgcn_exp2f(m - mn);
        m = mn;
#pragma unroll
        for (int db = 0; db < 4; ++db)
#pragma unroll
          for (int r = 0; r < 16; ++r) o[db][r] *= alpha;
      }
      float ps = 0.f;
      if (TYPE) {
#pragma unroll
        for (int r = 0; r < 16; ++r) { p0[r] = __builtin_amdgcn_exp2f(p0[r] - mn); p1[r] = __builtin_amdgcn_exp2f(p1[r] - mn); ps += p0[r] + p1[r]; }
      } else {
#pragma unroll
        for (int r = 0; r < 16; ++r) { p0[r] = __builtin_amdgcn_exp2f(fmaf(p0[r], C2, -mn)); p1[r] = __builtin_amdgcn_exp2f(fmaf(p1[r], C2, -mn)); ps += p0[r] + p1[r]; }
      }
      l = l * alpha + ps;
      bf16x8 pa[2][2];
#pragma unroll
      for (int s = 0; s < 2; ++s) {
        u32x4 w0 = {pk2(p0[8 * s + 0], p0[8 * s + 1]), pk2(p0[8 * s + 2], p0[8 * s + 3]), pk2(p0[8 * s + 4], p0[8 * s + 5]), pk2(p0[8 * s + 6], p0[8 * s + 7])};
        u32x4 w1 = {pk2(p1[8 * s + 0], p1[8 * s + 1]), pk2(p1[8 * s + 2], p1[8 * s + 3]), pk2(p1[8 * s + 4], p1[8 * s + 5]), pk2(p1[8 * s + 6], p1[8 * s + 7])};
        pa[0][s] = *reinterpret_cast<bf16x8*>(&w0); pa[1][s] = *reinterpret_cast<bf16x8*>(&w1);
      }
#pragma unroll
      for (int db = 0; db < 4; ++db)
#pragma unroll
        for (int kb = 0; kb < 2; ++kb)
#pragma unroll
          for (int s = 0; s < 2; ++s) {
            const bf16x8 av = *(const bf16x8*)(sVc + db * 32 * VSTR + vo[kb][s]);
            o[db] = __builtin_amdgcn_mfma_f32_32x32x16_bf16(av, pa[kb][s], o[db], 0, 0, 0);
          }
    }
    if (kt + 1 < ntiles) store_tile(kt + 1);
  }
  {
    auto rr = __builtin_amdgcn_permlane32_swap(__float_as_uint(l), __float_as_uint(l), false, false);
    const float inv = 1.f / (__uint_as_float(rr[0]) + __uint_as_float(rr[1]));
    const int b = bh >> 3, hh = bh & 7;
    u16* od = p.omix() + ((size_t)(b * S_ + qrow + c)) * 2048 + TYPE * 1024 + hh * 128 + 4 * hi;
#pragma unroll
    for (int db = 0; db < 4; ++db)
#pragma unroll
      for (int g = 0; g < 4; ++g)
        *(u32x2*)(od + 32 * db + 8 * g) = u32x2{pk2(o[db][4 * g] * inv, o[db][4 * g + 1] * inv), pk2(o[db][4 * g + 2] * inv, o[db][4 * g + 3] * inv)};
  }
}

__device__ void phase_attn(const Params& p, char* smem, int bid, int nb) {
  int* sItem = (int*)(smem + 90000);
  const int x = bid & 7;
  unsigned* q = p.ctr() + 32 + x;
  for (;;) {
    __syncthreads();
    if (TID() == 0) *sItem = (int)atomicAdd(q, 1u);
    __syncthreads();
    const int item = *sItem;
    if (item >= 64) break;
    const int qb = 15 - (item >> 2), r = item & 3, type = r >> 1, bh = x + 8 * (r & 1);
    if (type == 0) attn_item<0>(p, smem, bh, qb); else attn_item<1>(p, smem, bh, qb);
  }
  unsigned* qc = p.ctr() + 48;
  for (;;) {
    __syncthreads();
    if (TID() == 0) *sItem = (int)atomicAdd(qc, 1u);
    __syncthreads();
    const int chunk = *sItem;
    if (chunk >= 512) break;
    quant_chunk(p, chunk);
  }
}

__device__ void phase_outproj(const Params& p, char* smem, int bid, int nb) {
  EpiOut E{p.x, (u16*)p.y1()};
  pg8::Gemm g{p.omix(), p.WoutT(), T_, D_, D_};
  pg8::StaticOrder S; S.init(T_, D_, nb, bid);
  pg8::gemm_phase((PG8_LAS unsigned char*)smem, g, S, E, nullptr);
}

__device__ void phase_ln1(const Params& p, int bid, int nb) {
  const int lane = TID() & 63, wid = TID() >> 6;
  for (int t = bid * 8 + wid; t < T_ / 2; t += nb * 8) {
    float4 v[2][8];
    float sum[2] = {0.f, 0.f};
#pragma unroll
    for (int r = 0; r < 2; ++r) {
      const u16* row = (const u16*)p.y1() + (size_t)(t + r * (T_ / 2)) * D_;
#pragma unroll
      for (int i = 0; i < 8; ++i) {
        const u32x2 yb = *(const u32x2*)(row + (i * 64 + lane) * 4);
        v[r][i] = make_float4(bflo(yb[0]), bfhi(yb[0]), bflo(yb[1]), bfhi(yb[1]));
      }
    }
#pragma unroll
    for (int r = 0; r < 2; ++r)
#pragma unroll
      for (int i = 0; i < 8; ++i) sum[r] += (v[r][i].x + v[r][i].y) + (v[r][i].z + v[r][i].w);
    float rstd[2];
#pragma unroll
    for (int r = 0; r < 2; ++r) {
      const float mu = wave_sum(sum[r]) * (1.f / D_);
      float sq = 0.f;
#pragma unroll
      for (int i = 0; i < 8; ++i) {
        v[r][i].x -= mu; v[r][i].y -= mu; v[r][i].z -= mu; v[r][i].w -= mu;
        sq += (v[r][i].x * v[r][i].x + v[r][i].y * v[r][i].y) + (v[r][i].z * v[r][i].z + v[r][i].w * v[r][i].w);
      }
      rstd[r] = rsqrtf(wave_sum(sq) * (1.f / D_) + EPS);
    }
#pragma unroll
    for (int i = 0; i < 8; ++i) {
      const int c = (i * 64 + lane) * 4;
      const float4 g = *(const float4*)(p.ln1_g + c), bb = *(const float4*)(p.ln1_b + c);
#pragma unroll
      for (int r = 0; r < 2; ++r) {
        float4 o; o.x = v[r][i].x * rstd[r] * g.x + bb.x; o.y = v[r][i].y * rstd[r] * g.y + bb.y; o.z = v[r][i].z * rstd[r] * g.z + bb.z; o.w = v[r][i].w * rstd[r] * g.w + bb.w;
        *(u32x2*)(p.h1b() + (size_t)(t + r * (T_ / 2)) * D_ + c) = u32x2{pk2(o.x, o.y), pk2(o.z, o.w)};
      }
    }
  }
}

__device__ __forceinline__ void ins16(unsigned (&t)[16], unsigned x) {
#pragma unroll
  for (int i = 0; i < 16; ++i) { const unsigned hi = t[i] > x ? t[i] : x; x = t[i] > x ? x : t[i]; t[i] = hi; }
}
__device__ __forceinline__ void ins16p(unsigned (&ck)[16], int (&ce)[16], unsigned x, int xe) {
#pragma unroll
  for (int i = 0; i < 16; ++i) {
    const bool sw = x > ck[i];
    const unsigned nk = sw ? x : ck[i], nx = sw ? ck[i] : x;
    const int ne = sw ? xe : ce[i], nxe = sw ? ce[i] : xe;
    ck[i] = nk; x = nx; ce[i] = ne; xe = nxe;
  }
}
__device__ __forceinline__ float unordkey(unsigned k) { return __uint_as_float((k & 0x80000000u) ? (k & 0x7fffffffu) : ~k); }

__device__ __forceinline__ void sort16_asc(unsigned (&s)[16]) {
#pragma unroll
  for (int k = 2; k <= 16; k <<= 1)
#pragma unroll
    for (int j = k >> 1; j > 0; j >>= 1)
#pragma unroll
      for (int i = 0; i < 16; ++i) {
        const int l = i ^ j;
        if (l > i) {
          const unsigned lo = s[i] < s[l] ? s[i] : s[l], hi = s[i] < s[l] ? s[l] : s[i];
          if ((i & k) == 0) { s[i] = lo; s[l] = hi; } else { s[i] = hi; s[l] = lo; }
        }
      }
}
__device__ __forceinline__ void merge16(unsigned (&t)[16], const unsigned (&s)[16]) {
#pragma unroll
  for (int i = 0; i < 16; ++i) t[i] = t[i] > s[i] ? t[i] : s[i];
#pragma unroll
  for (int j = 8; j > 0; j >>= 1)
#pragma unroll
    for (int i = 0; i < 16; ++i) {
      const int l = i ^ j;
      if (l > i) { const unsigned hi = t[i] > t[l] ? t[i] : t[l], lo = t[i] > t[l] ? t[l] : t[i]; t[i] = hi; t[l] = lo; }
    }
}

__device__ __forceinline__ void score_block(const u16* kH, const u16* kL, const bf16x8 (&qh)[4], const bf16x8 (&ql)[4], int hi, unsigned (&t)[16]) {
#pragma unroll
  for (int i = 0; i < 16; ++i) t[i] = 0u;
#pragma unroll 1
  for (int kb = 0; kb < 4; ++kb) {
    f32x16 sc;
#pragma unroll
    for (int r = 0; r < 16; ++r) sc[r] = 0.f;
#pragma unroll
    for (int ks = 0; ks < 4; ++ks) {
      const bf16x8 ah = *(const bf16x8*)(kH + kb * 32 * 64 + ks * 16), al = *(const bf16x8*)(kL + kb * 32 * 64 + ks * 16);
      sc = __builtin_amdgcn_mfma_f32_32x32x16_bf16(ah, qh[ks], sc, 0, 0, 0);
      sc = __builtin_amdgcn_mfma_f32_32x32x16_bf16(ah, ql[ks], sc, 0, 0, 0);
      sc = __builtin_amdgcn_mfma_f32_32x32x16_bf16(al, qh[ks], sc, 0, 0, 0);
    }
    const unsigned base = (unsigned)(127 - 32 * kb) - 4u * (unsigned)hi;
    unsigned s[16];
#pragma unroll
    for (int r = 0; r < 16; ++r) s[r] = (ordkey(sc[r]) & ~127u) | (base - (unsigned)((r & 3) + 8 * (r >> 2)));
    sort16_asc(s);
    merge16(t, s);
  }
  unsigned other[16];
#pragma unroll
  for (int i = 0; i < 16; ++i) {
    auto rr = __builtin_amdgcn_permlane32_swap(t[15 - i], t[15 - i], false, false);
    other[i] = hi ? rr[0] : rr[1];
  }
  merge16(t, other);
}

__device__ __forceinline__ void route_tile(const Params& p, char* smem, f32x4 (&acc)[4][4], int tm, int h) {
  const int tid = TID(), wid = tid >> 6, lane = tid & 63, wr = wid >> 1, wc = wid & 1, fr = lane & 15, fq = lane >> 4;
  __syncthreads();
  float* Qw = (float*)smem + wid * (64 * 65);
#pragma unroll
  for (int m = 0; m < 4; ++m)
#pragma unroll
    for (int n = 0; n < 4; ++n)
#pragma unroll
      for (int j = 0; j < 4; ++j) Qw[(m * 16 + fq * 4 + j) * 65 + n * 16 + fr] = acc[m][n][j];
  asm volatile("s_waitcnt lgkmcnt(0)" ::: "memory");
  const int c = lane & 31, hi = lane >> 5;
  bf16x8 qh[2][4], ql[2][4];
#pragma unroll
  for (int tb = 0; tb < 2; ++tb)
#pragma unroll
    for (int ks = 0; ks < 4; ++ks) {
      float v[8]; unsigned wh[4], wl[4];
#pragma unroll
      for (int j = 0; j < 8; ++j) v[j] = Qw[(tb * 32 + c) * 65 + 16 * ks + 8 * hi + j];
#pragma unroll
      for (int w = 0; w < 4; ++w) {
        wh[w] = pk2(v[2 * w], v[2 * w + 1]);
        wl[w] = pk2(v[2 * w] - bflo(wh[w]), v[2 * w + 1] - bfhi(wh[w]));
      }
      u32x4 uh = {wh[0], wh[1], wh[2], wh[3]}, ul = {wl[0], wl[1], wl[2], wl[3]};
      qh[tb][ks] = *reinterpret_cast<bf16x8*>(&uh); ql[tb][ks] = *reinterpret_cast<bf16x8*>(&ul);
    }
  const u16* kH = p.keyH() + ((size_t)(wc * 8 + h) * 128 + c) * 64 + 8 * hi;
  const u16* kL = p.keyL() + ((size_t)(wc * 8 + h) * 128 + c) * 64 + 8 * hi;
  unsigned t0[16], t1[16];
  score_block(kH, kL, qh[0], ql[0], hi, t0);
  score_block(kH, kL, qh[1], ql[1], hi, t1);
  unsigned t[16];
#pragma unroll
  for (int i = 0; i < 16; ++i) t[i] = hi ? t1[i] : t0[i];
  __syncthreads();
  unsigned* L = (unsigned*)smem;
#pragma unroll
  for (int r = 0; r < 16; ++r) L[(wc * 16 + r) * 256 + wr * 64 + lane] = t[r];
  __syncthreads();
  if (wid < 4) {
    const int tok = wid * 64 + lane;
    unsigned ck[16]; int ce[16];
#pragma unroll
    for (int i = 0; i < 16; ++i) { ck[i] = 0u; ce[i] = 0; }
#pragma unroll 1
    for (int a = 0; a < 16; ++a) {
      const unsigned ka = L[a * 256 + tok];
      const int i1a = (127 - (int)(ka & 127u)) * 128; const float v1a = unordkey(ka & ~127u);
      const int nbm1 = (int)((0x1112347FULL >> (4 * a)) & 15ULL);
#pragma unroll 1
      for (int b = 0; b <= nbm1; ++b) {
        const unsigned kb = L[(16 + b) * 256 + tok];
        const int i2b = 127 - (int)(kb & 127u); const float v2b = unordkey(kb & ~127u);
        ins16p(ck, ce, ordkey(v1a + v2b), i1a + i2b);
      }
    }
    float ex[16], sum = 0.f;
    const float mx = unordkey(ck[0]);
#pragma unroll
    for (int r = 0; r < 16; ++r) { ex[r] = __expf(unordkey(ck[r]) - mx); sum += ex[r]; }
    const float inv = 1.f / sum;
    const size_t o = ((size_t)(tm * 256 + tok) * 8 + h) * 16;
    int* ed = p.eidxG() + o; float* gd = p.gateG() + o;
#pragma unroll
    for (int r = 0; r < 16; r += 4) {
      *(int4*)(ed + r) = make_int4(ce[r], ce[r + 1], ce[r + 2], ce[r + 3]);
      *(float4*)(gd + r) = make_float4(ex[r] * inv, ex[r + 1] * inv, ex[r + 2] * inv, ex[r + 3] * inv);
    }
  }
}

__device__ void phase_mid(const Params& p, char* smem, int bid, int nb) {
  {
    EpiGate E{p.h1b(), p.projb(), p.r2b()};
    pg8::Gemm g{p.h1b(), p.WgT(), T_, D_, D_};
    pg8::StaticOrder S; S.init(T_, D_, nb, bid);
    pg8::gemm_phase((PG8_LAS unsigned char*)smem, g, S, E, nullptr);
  }
  for (int t = vblock(bid, nb); t < 32 * 8; t += nb) {
    int tm, tn; tile_rc(t, 8, tm, tn);
    f32x4 acc[1][4][4];
    gemm_core<4, 2>(p.h1b(), D_, p.WpqT(), D_, D_, tm * 256, tn * 128, smem, acc);
    route_tile(p, smem, acc[0], tm, tn);
  }
}

__device__ __forceinline__ float gelu_exact(float a) {
  const float x = fabsf(a) * 0.7071067811865476f;
  const float t = __builtin_amdgcn_rcpf(1.f + 0.3275911f * x);
  const float poly = t * (0.254829592f + t * (-0.284496736f + t * (1.421413741f + t * (-1.453152027f + t * 1.061405429f))));
  const float er = 1.f - poly * __expf(-x * x);
  return 0.5f * a * (1.f + (a < 0.f ? -er : er));
}

template <int NPER, int IDXMASK>
__device__ __forceinline__ int top16(unsigned (&k)[NPER], int lane) {
  int mine = 0;
#pragma unroll 1
  for (int r = 0; r < 16; ++r) {
    unsigned loc = k[0];
#pragma unroll
    for (int i = 1; i < NPER; ++i) loc = loc > k[i] ? loc : k[i];
    const unsigned best = wave_umax(loc);
#pragma unroll
    for (int i = 0; i < NPER; ++i) if (k[i] == best) k[i] = 0u;
    if (lane == r) mine = IDXMASK - (int)(best & (unsigned)IDXMASK);
  }
  return mine;
}

__device__ void phase_peer(const Params& p, char* smem, int bid, int nb) {
  const int tid = TID(), lane = tid & 63, wid = tid >> 6;
  float* qs = (float*)smem;
  float* sc = (float*)(smem + 8192);
  int* eidx = (int*)(smem + 24576);
  float* gts = (float*)(smem + 40960);
  for (int it = bid; it < T_ / 32; it += nb) {
    const int t0 = it * 32;
#pragma unroll
    for (int i = 0; i < 2; ++i) {
      const int idx = (i * NT + tid) * 4;
      *(int4*)(eidx + idx) = *(const int4*)(p.eidxG() + (size_t)t0 * 128 + idx);
      *(float4*)(gts + idx) = *(const float4*)(p.gateG() + (size_t)t0 * 128 + idx);
    }
    __syncthreads();
    for (int ti = 0; ti < 4; ++ti) {
      const int tok = wid * 4 + ti, t = t0 + tok;
      typedef float f32x32 __attribute__((ext_vector_type(32)));
      typedef unsigned u32x6 __attribute__((ext_vector_type(6)));
      float hreg[32];
      f32x32 o;
#pragma unroll
      for (int q = 0; q < 8; ++q) {
        const u32x2 hv = *(const u32x2*)(p.h1b() + (size_t)t * D_ + (q * 64 + lane) * 4);
        hreg[q * 4] = bflo(hv[0]); hreg[q * 4 + 1] = bfhi(hv[0]); hreg[q * 4 + 2] = bflo(hv[1]); hreg[q * 4 + 3] = bfhi(hv[1]);
      }
#pragma unroll
      for (int i = 0; i < 32; ++i) o[i] = 0.f;
      u32x2 r2p[8];
#pragma unroll
      for (int q = 0; q < 8; ++q) r2p[q] = *(const u32x2*)(p.r2b() + (size_t)t * D_ + (q * 64 + lane) * 4);
      const float* Us = p.Us(); const float* Vs = p.Vs();
      const unsigned char* Uq = p.Uq() + lane * 24;
      const int* ep = eidx + tok * 128; const float* gp = gts + tok * 128;
      u32x4 uA4[2], vA4[2], uB4[2], vB4[2]; u32x2 uA2[2], vA2[2], uB2[2], vB2[2];
      float gA[2], suA[2], svA[2], gB[2], suB[2], svB[2];
#define PEER_LOAD(U4, U2, V4, V2, G, SU, SV, J0)                                                        \
      _Pragma("unroll") for (int jj = 0; jj < 2; ++jj) {                                                \
        const int e = __builtin_amdgcn_readfirstlane(ep[(J0) + jj]);                                    \
        G[jj] = gp[(J0) + jj]; SU[jj] = Us[e]; SV[jj] = Vs[e];                                          \
        const unsigned char* up = Uq + (size_t)e * 3072; const unsigned char* vp = up + 1536;           \
        U2[jj] = *(const u32x2*)(up); U4[jj] = *(const u32x4*)(up + 8);                                 \
        V2[jj] = *(const u32x2*)(vp); V4[jj] = *(const u32x4*)(vp + 8);                                 \
      }
#define PEER_COMPUTE(U4, U2, V4, V2, G, SU, SV)                                                         \
      _Pragma("unroll") for (int jj = 0; jj < 2; ++jj) {                                                \
        const u32x6 uw = {U2[jj][0], U2[jj][1], U4[jj][0], U4[jj][1], U4[jj][2], U4[jj][3]};            \
        const f32x32 ud = __builtin_amdgcn_cvt_scalef32_pk32_f32_fp6(uw, 1.0f);                         \
        float d0 = 0.f, d1 = 0.f, d2 = 0.f, d3 = 0.f;                                                   \
        _Pragma("unroll") for (int i = 0; i < 32; i += 4) {                                             \
          d0 += ud[i] * hreg[i]; d1 += ud[i + 1] * hreg[i + 1]; d2 += ud[i + 2] * hreg[i + 2]; d3 += ud[i + 3] * hreg[i + 3]; \
        }                                                                                               \
        const float av = wave_sum((d0 + d1) + (d2 + d3)) * SU[jj];                                      \
        const float act = gelu_exact(av) * G[jj] * SV[jj];                                              \
        const u32x6 vw = {V2[jj][0], V2[jj][1], V4[jj][0], V4[jj][1], V4[jj][2], V4[jj][3]};            \
        const f32x32 vd = __builtin_amdgcn_cvt_scalef32_pk32_f32_fp6(vw, 1.0f);                         \
        o += vd * act;                                                                                  \
      }
      PEER_LOAD(uA4, uA2, vA4, vA2, gA, suA, svA, 0)
#pragma unroll 1
      for (int j0 = 0; j0 < 128; j0 += 4) {
        PEER_LOAD(uB4, uB2, vB4, vB2, gB, suB, svB, j0 + 2)
        PEER_COMPUTE(uA4, uA2, vA4, vA2, gA, suA, svA)
        if (j0 + 4 < 128) { PEER_LOAD(uA4, uA2, vA4, vA2, gA, suA, svA, j0 + 4) }
        PEER_COMPUTE(uB4, uB2, vB4, vB2, gB, suB, svB)
      }
#undef PEER_LOAD
#undef PEER_COMPUTE
      float* orow = p.out + (size_t)t * D_ + lane * 4;
      float sum = 0.f;
#pragma unroll
      for (int q = 0; q < 8; ++q) {
        const u32x2 rb2 = r2p[q];
        const float4 r0 = make_float4(bflo(rb2[0]), bfhi(rb2[0]), bflo(rb2[1]), bfhi(rb2[1]));
        o[q * 4 + 0] += r0.x; o[q * 4 + 1] += r0.y; o[q * 4 + 2] += r0.z; o[q * 4 + 3] += r0.w;
      }
#pragma unroll
      for (int i = 0; i < 32; ++i) sum += o[i];
      const float mu = wave_sum(sum) * (1.f / D_);
      float sq = 0.f;
#pragma unroll
      for (int i = 0; i < 32; ++i) { o[i] -= mu; sq += o[i] * o[i]; }
      const float rstd = rsqrtf(wave_sum(sq) * (1.f / D_) + EPS);
#pragma unroll
      for (int q = 0; q < 8; ++q) {
        const int col = (q * 64 + lane) * 4;
        const float4 g0 = *(const float4*)(p.ln2_g + col), b0 = *(const float4*)(p.ln2_b + col);
        float4 w0;
        w0.x = o[q * 4 + 0] * rstd * g0.x + b0.x; w0.y = o[q * 4 + 1] * rstd * g0.y + b0.y;
        w0.z = o[q * 4 + 2] * rstd * g0.z + b0.z; w0.w = o[q * 4 + 3] * rstd * g0.w + b0.w;
        *(float4*)(orow + q * 256) = w0;
      }
    }
    __syncthreads();
  }
}

template <int PH>
__device__ __forceinline__ void run_phase(const Params& p, char* smem, int bid, int nb) {
  if constexpr (PH == 0) phase_prep(p, smem, bid, nb);
  if constexpr (PH == 1) phase_inproj(p, smem, bid, nb);
  if constexpr (PH == 2) phase_up(p, smem, bid, nb);
#ifdef ATTN_NAIVE
  if constexpr (PH == 3) phase_attn_naive(p, smem, bid, nb);
#else
  if constexpr (PH == 3) phase_attn(p, smem, bid, nb);
#endif
  if constexpr (PH == 4) phase_outproj(p, smem, bid, nb);
  if constexpr (PH == 5) phase_ln1(p, bid, nb);
  if constexpr (PH == 6) phase_mid(p, smem, bid, nb);
  if constexpr (PH == 7) phase_peer(p, smem, bid, nb);
}

template <int PH>
__global__ void __launch_bounds__(NT, 2) phase_kernel(Params p) {
  __shared__ __attribute__((aligned(16))) char smem[SMEM_BYTES];
  run_phase<PH>(p, smem, blockIdx.x, gridDim.x);
}

#define BW_CENSUS(j) (256 + (j) * 32)
#define BW_XSUB(j) (256 + 512 + (j) * 32)
#define BW_XGEN(j) (256 + 1024 + (j) * 32)
#define BW_TOP (256 + 1536)
#define BW_TOPGEN (256 + 1568)
__device__ __forceinline__ unsigned bw_ld(unsigned* p) { return __hip_atomic_load(p, __ATOMIC_RELAXED, __HIP_MEMORY_SCOPE_AGENT); }
__device__ __forceinline__ unsigned bw_add(unsigned* p, unsigned v) { return __hip_atomic_fetch_add(p, v, __ATOMIC_RELAXED, __HIP_MEMORY_SCOPE_AGENT); }
__device__ __forceinline__ unsigned xcc_id() { return (unsigned)__builtin_amdgcn_s_getreg((3 << 11) | 20) & 0xFu; }

__device__ __forceinline__ void grid_barrier(unsigned* bar, unsigned* st  ) {
  asm volatile("s_waitcnt vmcnt(0)" ::: "memory");
  __syncthreads();
  if (threadIdx.x == 0) {
    __builtin_amdgcn_s_waitcnt(0);
    const unsigned x = xcc_id();
    unsigned nloc = st[0], nx = st[1];
    if (nloc == 0u) {
      const unsigned G = gridDim.x;
      for (;;) {
        unsigned sum = 0u, cnt = 0u, mine = 0u;
#pragma unroll
        for (unsigned j = 0; j < 16; ++j) { const unsigned c = bw_ld(&bar[BW_CENSUS(j)]); sum += c; cnt += (c > 0u) ? 1u : 0u; mine = (j == x) ? c : mine; }
        nloc = mine; nx = cnt;
        if (sum == G) break;
        __builtin_amdgcn_s_sleep(1);
      }
      st[0] = nloc; st[1] = nx;
    }
    const unsigned old = bw_add(&bar[BW_XSUB(x)], 1u);
    const unsigned gen = old / nloc;
    if (old + 1u == (gen + 1u) * nloc) {
      __builtin_amdgcn_fence(__ATOMIC_RELEASE, "agent");
      asm volatile("s_waitcnt vmcnt(0)" ::: "memory");
      const unsigned og = bw_add(&bar[BW_TOP], 1u);
      const unsigned tg = og / nx;
      if (og + 1u == (tg + 1u) * nx) bw_add(&bar[BW_TOPGEN], 1u);
      else while (bw_ld(&bar[BW_TOPGEN]) == tg) __builtin_amdgcn_s_sleep(1);
      __builtin_amdgcn_fence(__ATOMIC_ACQUIRE, "agent");
      bw_add(&bar[BW_XGEN(x)], 1u);
      asm volatile("s_waitcnt vmcnt(0)" ::: "memory");
    } else {
      while (bw_ld(&bar[BW_XGEN(x)]) == gen) __builtin_amdgcn_s_sleep(1);
      __builtin_amdgcn_fence(__ATOMIC_ACQUIRE, "agent");
      asm volatile("s_waitcnt vmcnt(0)" ::: "memory");
    }
  }
  __syncthreads();
}

#if SINGLE_LAUNCH
typedef const __attribute__((address_space(4))) unsigned long long* kargp_t;
static_assert(sizeof(Params) % 8 == 0, "Params must be a pack of 8-byte fields");
#define RUN_PHASE(N) run_phase<N>(p_, smem, bid, nb);
__global__ void __launch_bounds__(NT, 2) fwd_kernel(Params p_) {
  __shared__ __attribute__((aligned(16))) char smem[SMEM_BYTES + 64];
  const int bid = blockIdx.x, nb = gridDim.x;
  unsigned* bar = (unsigned*)(p_.ws + O_CTR);
  unsigned* st = (unsigned*)(smem + SMEM_BYTES);
  if (threadIdx.x == 0) { st[0] = 0u; st[1] = 0u; (void)bw_add(&bar[BW_CENSUS(xcc_id())], 1u); }
  if (p_.out == nullptr) cg::this_grid().sync();
  RUN_PHASE(0) grid_barrier(bar, st);
  RUN_PHASE(1) grid_barrier(bar, st);
  RUN_PHASE(2) grid_barrier(bar, st);
  RUN_PHASE(3) grid_barrier(bar, st);
  RUN_PHASE(4) grid_barrier(bar, st);
  RUN_PHASE(5) grid_barrier(bar, st);
  RUN_PHASE(6) grid_barrier(bar, st);
  RUN_PHASE(7)
}
#endif

extern "C" void kernel_launch(void* const* d_in, const int* in_sizes, int n_in, void* d_out, int out_size,
                              void* d_ws, size_t ws_size, hipStream_t stream) {
  (void)in_sizes; (void)n_in; (void)out_size; (void)ws_size;
  Params p{};
  p.x = (const float*)d_in[0]; p.p = (const float*)d_in[1]; p.positions = (const int*)d_in[2];
  p.w_in = (const float*)d_in[3]; p.b_forget = (const float*)d_in[4]; p.g_q = (const float*)d_in[5];
  p.w_uq = (const float*)d_in[6]; p.g_kv = (const float*)d_in[7]; p.w_ukv = (const float*)d_in[8];
  p.w_out = (const float*)d_in[9]; p.ln1_g = (const float*)d_in[10]; p.ln1_b = (const float*)d_in[11];
  p.peer_wq = (const float*)d_in[12]; p.keys1 = (const float*)d_in[13]; p.keys2 = (const float*)d_in[14];
  p.peer_u = (const float*)d_in[15]; p.peer_v = (const float*)d_in[16]; p.wgate = (const float*)d_in[17];
  p.wproj = (const float*)d_in[18]; p.ln2_g = (const float*)d_in[19]; p.ln2_b = (const float*)d_in[20];
  p.out = (float*)d_out;
  p.ws = (char*)d_ws;

  static int grid_blocks = 0;
  if (!grid_blocks) {
    int dev = 0, cus = 0, per_cu = 0;
    (void)hipGetDevice(&dev);
    (void)hipDeviceGetAttribute(&cus, hipDeviceAttributeMultiprocessorCount, dev);
#if SINGLE_LAUNCH
    (void)hipOccupancyMaxActiveBlocksPerMultiprocessor(&per_cu, fwd_kernel, NT, 0);
#else
    per_cu = 2;
#endif
    if (per_cu > 1) per_cu = 1;
    if (per_cu < 1) per_cu = 1;
    grid_blocks = cus * per_cu;
  }
#if SINGLE_LAUNCH
  (void)hipMemsetAsync(d_ws, 0, 16384, stream);
  void* args[] = {&p};
  hipError_t e = hipLaunchCooperativeKernel((void*)fwd_kernel, dim3(grid_blocks), dim3(NT), args, 0, stream);
  if (e != hipSuccess) fprintf(stderr, "cooperative launch failed: %s (grid %d)\n", hipGetErrorString(e), grid_blocks);
#else
  phase_kernel<0><<<grid_blocks, NT, 0, stream>>>(p);
  phase_kernel<1><<<grid_blocks, NT, 0, stream>>>(p);
  phase_kernel<2><<<grid_blocks, NT, 0, stream>>>(p);
  phase_kernel<3><<<grid_blocks, NT, 0, stream>>>(p);
  phase_kernel<4><<<grid_blocks, NT, 0, stream>>>(p);
  phase_kernel<5><<<grid_blocks, NT, 0, stream>>>(p);
  phase_kernel<6><<<grid_blocks, NT, 0, stream>>>(p);
  phase_kernel<7><<<grid_blocks, NT, 0, stream>>>(p);
#endif
}
```

```cpp
#include <hip/hip_runtime.h>
#include <hip/hip_bf16.h>
#include <hip/hip_cooperative_groups.h>
#include <stdint.h>
#include <cstdio>
namespace cg = cooperative_groups;

typedef unsigned short u16;
typedef short bf16x8 __attribute__((ext_vector_type(8)));
typedef float f32x4 __attribute__((ext_vector_type(4)));
typedef unsigned u32x4 __attribute__((ext_vector_type(4)));
typedef unsigned u32x2 __attribute__((ext_vector_type(2)));

#ifndef SINGLE_LAUNCH
#define SINGLE_LAUNCH 1
#endif

constexpr int T_ = 8192, D_ = 2048, S_ = 4096, NB_ = 2;
constexpr int INW = 4168;
constexpr int NPH = 8;
constexpr float ALPHA = 1.189207115002721f;
constexpr float EPS = 1e-6f;
constexpr int NT = 512;
constexpr int SMEM_BYTES = 133120;

constexpr size_t al256(size_t x) { return (x + 255) & ~(size_t)255; }
constexpr size_t O_CTR = 0;
constexpr size_t O_WINT = O_CTR + 16384;
constexpr size_t O_WUQT = O_WINT + al256((size_t)4352 * 2048 * 2);
constexpr size_t O_WUKVT = O_WUQT + al256((size_t)1536 * 512 * 2);
constexpr size_t O_WOUTT = O_WUKVT + al256((size_t)2048 * 512 * 2);
constexpr size_t O_WPQT = O_WOUTT + al256((size_t)2048 * 2048 * 2);
constexpr size_t O_WGT = O_WPQT + al256((size_t)1024 * 2048 * 2);
constexpr size_t O_WPT = O_WGT + al256((size_t)2048 * 2048 * 2);
constexpr size_t O_PB = O_WPT + al256((size_t)2048 * 256 * 2);
constexpr size_t O_UB = O_PB + al256((size_t)8192 * 256 * 2);
constexpr size_t O_VB = O_UB + 2048;
constexpr size_t O_OMIX = O_UB + al256((size_t)16384 * 4096);
constexpr size_t O_CS = O_OMIX + al256((size_t)8192 * 2048 * 2);
constexpr size_t O_PROJB = O_CS + al256((size_t)8192 * 32 * 8);
constexpr size_t O_KEYH = O_PROJB + al256((size_t)8192 * 2048 * 2);
constexpr size_t O_KEYL = O_KEYH + al256((size_t)2 * 8 * 128 * 64 * 2);
constexpr size_t O_US = O_KEYL + al256((size_t)2 * 8 * 128 * 64 * 2);
constexpr size_t O_VS = O_US + al256((size_t)16384 * 4);
constexpr size_t O_REGB = O_VS + al256((size_t)16384 * 4);
constexpr size_t O_XB = O_REGB;
constexpr size_t O_CQB = O_XB + al256((size_t)8192 * 2048 * 2);
constexpr size_t O_CKVB = O_CQB + al256((size_t)8192 * 512 * 2);
constexpr size_t O_QM = O_CKVB + al256((size_t)8192 * 512 * 2);
constexpr size_t O_KM = O_QM + al256((size_t)8192 * 8 * 192 * 2);
constexpr size_t O_VMT = O_KM + al256((size_t)8192 * 8 * 192 * 2);
constexpr size_t O_QF = O_VMT + al256((size_t)8192 * 8 * 128 * 2);
constexpr size_t O_KF = O_QF + al256((size_t)8192 * 8 * 128 * 2);
constexpr size_t O_VFT = O_KF + al256((size_t)8192 * 8 * 128 * 2);
constexpr size_t O_LOGF = O_VFT + al256((size_t)8192 * 8 * 128 * 2);
constexpr size_t O_FK = O_LOGF + al256((size_t)16 * 4096 * 4);
constexpr size_t O_KRS = O_FK + al256((size_t)16 * 4096 * 4);
constexpr size_t O_RSS = O_KRS + al256((size_t)8192 * 64 * 4);
constexpr size_t O_KN2 = O_RSS + al256((size_t)2 * 8192 * 4);
constexpr size_t O_KNP = O_KN2 + al256((size_t)16 * 4096 * 4);
constexpr size_t O_ENDB = O_KNP + al256((size_t)16 * 64 * 4);
constexpr size_t O_Y1 = O_REGB;
constexpr size_t O_H1B = O_Y1 + al256((size_t)8192 * 2048 * 4);
constexpr size_t O_PQ = O_H1B + al256((size_t)8192 * 2048 * 2);
constexpr size_t O_GATE = O_PQ + al256((size_t)8192 * 128 * 4);
constexpr size_t O_R2B = O_GATE + al256((size_t)8192 * 128 * 4);
constexpr size_t O_ENDB2 = O_R2B + al256((size_t)8192 * 2048 * 2);
static_assert(O_ENDB2 <= O_ENDB, "region B reuse overflow");
static_assert(O_ENDB <= (size_t)500 * 1024 * 1024, "workspace too large");

struct Params {
  const float *x, *p; const int* positions;
  const float *w_in, *b_forget, *g_q, *w_uq, *g_kv, *w_ukv, *w_out, *ln1_g, *ln1_b;
  const float *peer_wq, *keys1, *keys2, *peer_u, *peer_v, *wgate, *wproj, *ln2_g, *ln2_b;
  float* out;
  char* ws;
#define WSP(type, name, off) __device__ __forceinline__ type* name() const { return (type*)(ws + (off)); }
  WSP(unsigned, ctr, O_CTR) WSP(u16, WinT, O_WINT) WSP(u16, WuqT, O_WUQT) WSP(u16, WukvT, O_WUKVT) WSP(u16, WoutT, O_WOUTT)
  WSP(u16, WpqT, O_WPQT) WSP(u16, WgT, O_WGT) WSP(u16, WpT, O_WPT) WSP(u16, pb, O_PB) WSP(unsigned char, Uq, O_UB) WSP(unsigned char, Vq, O_VB) WSP(float, Us, O_US) WSP(float, Vs, O_VS)
  WSP(u16, omix, O_OMIX) WSP(float2, cs, O_CS) WSP(u16, projb, O_PROJB) WSP(u16, keyH, O_KEYH) WSP(u16, keyL, O_KEYL)
  WSP(u16, xb, O_XB) WSP(u16, cqb, O_CQB) WSP(u16, ckvb, O_CKVB) WSP(u16, Qm, O_QM) WSP(u16, Km, O_KM) WSP(u16, VmT, O_VMT)
  WSP(u16, Qf, O_QF) WSP(u16, Kf, O_KF) WSP(u16, VfT, O_VFT) WSP(float, logf, O_LOGF) WSP(float, Fk, O_FK) WSP(float, krsum, O_KRS) WSP(float, rss, O_RSS) WSP(float, kn2, O_KN2) WSP(float, knp, O_KNP)
  WSP(float, y1, O_Y1) WSP(u16, h1b, O_H1B) WSP(int, eidxG, O_PQ) WSP(float, gateG, O_GATE) WSP(u16, r2b, O_R2B)
#undef WSP
};

__device__ __forceinline__ int TID() { int t = threadIdx.x; asm volatile("" : "+v"(t)); return t; }
__device__ __forceinline__ unsigned pk2(float lo, float hi) {
  unsigned r; asm volatile("v_cvt_pk_bf16_f32 %0, %1, %2" : "=v"(r) : "v"(lo), "v"(hi)); return r;
}
__device__ __forceinline__ u16 f2bf(float f) { return (u16)(pk2(f, 0.f) & 0xffffu); }
__device__ __forceinline__ float bf2f(u16 v) { return __uint_as_float(((unsigned)v) << 16); }
__device__ __forceinline__ float bflo(unsigned v) { return __uint_as_float(v << 16); }
__device__ __forceinline__ float bfhi(unsigned v) { return __uint_as_float(v & 0xffff0000u); }

template <int CTRL> __device__ __forceinline__ int dppi(int v) { return __builtin_amdgcn_update_dpp(0, v, CTRL, 0xF, 0xF, false); }
template <int CTRL> __device__ __forceinline__ float dppf(float v) { return __int_as_float(dppi<CTRL>(__float_as_int(v))); }
__device__ __forceinline__ float rdlane(float v, int l) { return __int_as_float(__builtin_amdgcn_readlane(__float_as_int(v), l)); }

__device__ __forceinline__ float row_sum(float v) {
  v += dppf<0xB1>(v); v += dppf<0x4E>(v); v += dppf<0x141>(v); v += dppf<0x140>(v); return v;
}
__device__ __forceinline__ float row_max(float v) {
  v = fmaxf(v, dppf<0xB1>(v)); v = fmaxf(v, dppf<0x4E>(v)); v = fmaxf(v, dppf<0x141>(v)); v = fmaxf(v, dppf<0x140>(v)); return v;
}
__device__ __forceinline__ float wave_sum(float v) {
  v = row_sum(v);
  return (rdlane(v, 0) + rdlane(v, 16)) + (rdlane(v, 32) + rdlane(v, 48));
}
__device__ __forceinline__ float wave_max(float v) {
  v = row_max(v);
  return fmaxf(fmaxf(rdlane(v, 0), rdlane(v, 16)), fmaxf(rdlane(v, 32), rdlane(v, 48)));
}
__device__ __forceinline__ unsigned wave_umax(unsigned v) {
  unsigned t;
  t = (unsigned)dppi<0xB1>((int)v); v = v > t ? v : t;
  t = (unsigned)dppi<0x4E>((int)v); v = v > t ? v : t;
  t = (unsigned)dppi<0x141>((int)v); v = v > t ? v : t;
  t = (unsigned)dppi<0x140>((int)v); v = v > t ? v : t;
  unsigned a = (unsigned)__builtin_amdgcn_readlane((int)v, 0), b = (unsigned)__builtin_amdgcn_readlane((int)v, 16);
  unsigned c = (unsigned)__builtin_amdgcn_readlane((int)v, 32), d = (unsigned)__builtin_amdgcn_readlane((int)v, 48);
  a = a > b ? a : b; c = c > d ? c : d; return a > c ? a : c;
}
__device__ __forceinline__ unsigned ordkey(float f) {
  unsigned u = __float_as_uint(f);
  return (u & 0x80000000u) ? ~u : (u | 0x80000000u);
}

__device__ __forceinline__ unsigned fp6_code(float v) {
  const float a = fabsf(v);
  int code = a < 2.f ? (int)rintf(a * 8.f) : (a < 4.f ? 16 + (int)rintf((a - 2.f) * 4.f) : 24 + (int)rintf((a - 4.f) * 2.f));
  code = code > 31 ? 31 : code;
  return (unsigned)code | (v < 0.f ? 32u : 0u);
}
__device__ __forceinline__ void quant_chunk(const Params& p, int chunk) {
  const int tid = TID(), lane = tid & 63, wid = tid >> 6;
#pragma unroll 1
  for (int i8 = 0; i8 < 8; ++i8) {
    const int r = chunk * 64 + wid * 8 + i8;
    const int tab = r >> 14, row = r & 16383;
    const float* src = (tab ? p.peer_v : p.peer_u) + (size_t)row * D_ + lane * 4;
    float4 v[8];
    float am = 0.f;
#pragma unroll
    for (int i = 0; i < 8; ++i) {
      { const f32x4 tv = __builtin_nontemporal_load((const f32x4*)(src + i * 256)); v[i] = make_float4(tv[0], tv[1], tv[2], tv[3]); }
      am = fmaxf(am, fmaxf(fmaxf(fabsf(v[i].x), fabsf(v[i].y)), fmaxf(fabsf(v[i].z), fabsf(v[i].w))));
    }
    am = wave_max(am);
    const float qs = am > 0.f ? 7.5f / am : 1.f;
    unsigned w[6];
#pragma unroll
    for (int g = 0; g < 2; ++g) {
      unsigned long long lo = 0ull; unsigned hi = 0u;
#pragma unroll
      for (int i = 0; i < 4; ++i) {
        const float4 f = v[g * 4 + i];
        const unsigned q4 = fp6_code(f.x * qs) | (fp6_code(f.y * qs) << 6) | (fp6_code(f.z * qs) << 12) | (fp6_code(f.w * qs) << 18);
        if (i == 0) lo |= (unsigned long long)q4;
        if (i == 1) lo |= (unsigned long long)q4 << 24;
        if (i == 2) { lo |= (unsigned long long)q4 << 48; hi |= q4 >> 16; }
        if (i == 3) hi |= q4 << 8;
      }
      w[g * 3 + 0] = (unsigned)lo; w[g * 3 + 1] = (unsigned)(lo >> 32); w[g * 3 + 2] = hi;
    }
    unsigned* dst = (unsigned*)(p.Uq() + (size_t)row * 3072 + tab * 1536 + lane * 24);
    *(u32x2*)dst = u32x2{w[0], w[1]}; *(u32x2*)(dst + 2) = u32x2{w[2], w[3]}; *(u32x2*)(dst + 4) = u32x2{w[4], w[5]};
    if (lane == 0) (tab ? p.Vs() : p.Us())[row] = am > 0.f ? am / 7.5f : 1.f;
  }
}

__device__ void transpose_cvt(const float* __restrict__ W, int ldw, int K, int src_col0, int ncols,
                              u16* __restrict__ WT, int dst_row0, const float* __restrict__ kscale,
                              float* tile, int bid, int nb) {
  const int tiles_k = K / 64, tiles_n = ncols / 64, tid = TID();
#pragma unroll 1
  for (int t = bid; t < tiles_k * tiles_n; t += nb) {
    const int tk = t % tiles_k, tn = t / tiles_k, k0 = tk * 64, n0 = tn * 64;
#pragma unroll
    for (int i = 0; i < 2; ++i) {
      const int r = (tid >> 4) + 32 * i, c = (tid & 15) * 4;
      const f32x4 tv = __builtin_nontemporal_load((const f32x4*)(W + (size_t)(k0 + r) * ldw + src_col0 + n0 + c));
      const float4 v = make_float4(tv[0], tv[1], tv[2], tv[3]);
      const float sc = kscale ? kscale[k0 + r] : 1.f;
      tile[r * 65 + c + 0] = v.x * sc; tile[r * 65 + c + 1] = v.y * sc;
      tile[r * 65 + c + 2] = v.z * sc; tile[r * 65 + c + 3] = v.w * sc;
    }
    __syncthreads();
    {
      const int n = tid >> 3, kk = (tid & 7) * 8;
      unsigned w[4];
#pragma unroll
      for (int e = 0; e < 4; ++e) w[e] = pk2(tile[(kk + 2 * e) * 65 + n], tile[(kk + 2 * e + 1) * 65 + n]);
      *(u32x4*)(WT + (size_t)(dst_row0 + n0 + n) * K + k0 + kk) = u32x4{w[0], w[1], w[2], w[3]};
    }
    __syncthreads();
  }
}

__device__ void cvt_bf16(const float* __restrict__ src, u16* __restrict__ dst, size_t n8, size_t gtid, size_t gthreads) {
  for (size_t i = gtid; i < n8; i += gthreads) {
    const float4 a = ((const float4*)src)[2 * i], b = ((const float4*)src)[2 * i + 1];
    ((u32x4*)dst)[i] = u32x4{pk2(a.x, a.y), pk2(a.z, a.w), pk2(b.x, b.y), pk2(b.z, b.w)};
  }
}

__device__ void phase_prep(const Params& p, char* smem, int bid, int nb) {
  const int tid = TID(), lane = tid & 63, wid = tid >> 6;
  float* tile = (float*)smem;
  if (bid == 0 && tid == 0) p.ctr()[0] = 0;
  transpose_cvt(p.w_in, INW, D_, 0, 1024, p.WinT(), 0, nullptr, tile, bid, nb);
  transpose_cvt(p.w_in, INW, D_, 1088, 3072, p.WinT(), 1024, nullptr, tile, bid, nb);
  transpose_cvt(p.w_in, INW, D_, 1024, 64, p.WinT(), 4096, nullptr, tile, bid, nb);
  transpose_cvt(p.w_uq, 1536, 512, 0, 1536, p.WuqT(), 0, p.g_q, tile, bid, nb);
  transpose_cvt(p.w_ukv, 2048, 512, 0, 2048, p.WukvT(), 0, p.g_kv, tile, bid, nb);
  transpose_cvt(p.w_out, 2048, 2048, 0, 2048, p.WoutT(), 0, nullptr, tile, bid, nb);
  transpose_cvt(p.peer_wq, 1024, 2048, 0, 1024, p.WpqT(), 0, nullptr, tile, bid, nb);
  transpose_cvt(p.wgate, 2048, 2048, 0, 2048, p.WgT(), 0, nullptr, tile, bid, nb);
  transpose_cvt(p.wproj, 2048, 256, 0, 2048, p.WpT(), 0, nullptr, tile, bid, nb);
  const size_t gtid = (size_t)bid * NT + tid, gth = (size_t)nb * NT;
  for (size_t i = gtid; i < (size_t)192 * 2048 / 8; i += gth) ((u32x4*)(p.WinT() + (size_t)4160 * 2048))[i] = u32x4{0, 0, 0, 0};
  cvt_bf16(p.p, p.pb(), (size_t)T_ * 256 / 8, gtid, gth);
  for (size_t i = gtid; i < (size_t)T_ * 64 / 4; i += gth) ((float4*)p.krsum())[i] = make_float4(0.f, 0.f, 0.f, 0.f);
  for (size_t i = gtid; i < (size_t)2 * T_ / 4; i += gth) ((float4*)p.rss())[i] = make_float4(0.f, 0.f, 0.f, 0.f);
  for (size_t i = gtid; i < (size_t)16 * S_ / 4; i += gth) ((float4*)p.kn2())[i] = make_float4(0.f, 0.f, 0.f, 0.f);
  for (size_t i = gtid; i < (size_t)2 * 65536; i += gth) {
    const float v = i < 65536 ? p.keys1[i] : p.keys2[i - 65536];
    const u16 h = f2bf(v);
    p.keyH()[i] = h; p.keyL()[i] = f2bf(v - bf2f(h));
  }
  for (size_t i = gtid; i < (size_t)T_ * 32; i += gth) {
    const int t = (int)(i >> 5), fi = (int)(i & 31);
    const float invf = 1.0f / powf(10000.0f, (float)(2 * fi) / 64.0f);
    const float ang = (float)p.positions[t] * invf;
    const double rev = (double)ang * 0.15915494309189535;
    const float fr = (float)(rev - rint(rev));
    p.cs()[i] = make_float2(__builtin_amdgcn_cosf(fr), __builtin_amdgcn_sinf(fr));
  }
  __syncthreads();
  float* wff = (float*)smem;
  for (int i = tid; i < 2048 * 2; i += NT) {
    const int k = i >> 1, hf = i & 1;
    *(float4*)(wff + (k ^ ((k >> 3) & 7)) * 8 + hf * 4) = *(const float4*)(p.w_in + (size_t)k * INW + 4160 + hf * 4);
  }
  __syncthreads();
  for (int t = bid * 8 + wid; t < T_; t += nb * 8) {
    float a[8];
#pragma unroll
    for (int e = 0; e < 8; ++e) a[e] = 0.f;
#pragma unroll 1
    for (int i = 0; i < 4; ++i) {
      const int k = (i * 64 + lane) * 8;
      const f32x4 xa = __builtin_nontemporal_load((const f32x4*)(p.x + (size_t)t * D_ + k)), xb4 = __builtin_nontemporal_load((const f32x4*)(p.x + (size_t)t * D_ + k + 4));
      const float4 x0 = make_float4(xa[0], xa[1], xa[2], xa[3]), x1 = make_float4(xb4[0], xb4[1], xb4[2], xb4[3]);
      *(u32x4*)(p.xb() + (size_t)t * D_ + k) = u32x4{pk2(x0.x, x0.y), pk2(x0.z, x0.w), pk2(x1.x, x1.y), pk2(x1.z, x1.w)};
      const float xs[8] = {x0.x, x0.y, x0.z, x0.w, x1.x, x1.y, x1.z, x1.w};
#pragma unroll
      for (int j = 0; j < 8; ++j) {
        const int kr = (k + j) ^ (lane & 7);
        const float4 w0 = *(const float4*)(wff + kr * 8), w1 = *(const float4*)(wff + kr * 8 + 4);
        a[0] += xs[j] * w0.x; a[1] += xs[j] * w0.y; a[2] += xs[j] * w0.z; a[3] += xs[j] * w0.w;
        a[4] += xs[j] * w1.x; a[5] += xs[j] * w1.y; a[6] += xs[j] * w1.z; a[7] += xs[j] * w1.w;
      }
    }
    float mine = 0.f;
#pragma unroll
    for (int e = 0; e < 8; ++e) { const float s = wave_sum(a[e]); if (lane == e) mine = s; }
    if (lane < 8) {
      const float z = mine + p.b_forget[lane];
      const float ls = fminf(z, 0.f) - log1pf(expf(-fabsf(z)));
      const int b = t >> 12, s = t & 4095;
      p.logf()[((size_t)(b * 8 + lane)) * S_ + s] = ls;
    }
  }
}

template <int WM, int WN>
__device__ __forceinline__ void gemm_core(const u16* __restrict__ A, int lda, const u16* __restrict__ Bt, int ldb,
                                          int K, int brow, int bcol, char* smem, f32x4 (&acc)[4 / WM][4][4]) {
  constexpr int MS = 4 / WM, BN = 64 * WN, NBL = BN / 64;
  static_assert(WM * WN == 8, "8 waves");
  const int tid = TID(), wid = tid >> 6, lane = tid & 63, wr = wid / WN, wc = wid % WN, fr = lane & 15, fq = lane >> 4;
#pragma unroll
  for (int h = 0; h < MS; ++h)
#pragma unroll
    for (int m = 0; m < 4; ++m)
#pragma unroll
      for (int n = 0; n < 4; ++n) acc[h][m][n] = f32x4{0.f, 0.f, 0.f, 0.f};
  const int nk = K / 64;
  const int srow = tid >> 3, sch = (tid & 7) ^ ((tid >> 4) & 7);
  const u16* ga = A + (size_t)(brow + srow) * lda + sch * 8;
  const u16* gb = Bt + (size_t)(bcol + srow) * ldb + sch * 8;
  char* sdst = smem + tid * 16;
  auto issue = [&](int kt, int st) {
    char* sa = sdst + st * 65536;
#pragma unroll
    for (int i = 0; i < 4; ++i)
      __builtin_amdgcn_global_load_lds((const unsigned*)(ga + (size_t)i * 64 * lda + kt * 64), (unsigned*)(sa + i * 8192), 16, 0, 0);
#pragma unroll
    for (int i = 0; i < NBL; ++i)
      __builtin_amdgcn_global_load_lds((const unsigned*)(gb + (size_t)i * 64 * ldb + kt * 64), (unsigned*)(sa + 32768 + i * 8192), 16, 0, 0);
  };
  const int fx = (fr >> 1) & 7;
  const int arow = (wr * (256 / WM) + fr) * 128, brw = 32768 + (wc * 64 + fr) * 128;
  const int c0 = (fq ^ fx) * 16, c1 = ((4 + fq) ^ fx) * 16;
  asm volatile("s_waitcnt vmcnt(0)" ::: "memory");
  __syncthreads();
  issue(0, 0);
#pragma unroll 1
  for (int kt = 0; kt < nk; ++kt) {
    asm volatile("s_waitcnt vmcnt(0)" ::: "memory");
    __builtin_amdgcn_s_barrier();
    asm volatile("" ::: "memory");
    if (kt + 1 < nk) issue(kt + 1, (kt + 1) & 1);
    const char* sb = smem + (kt & 1) * 65536;
#pragma unroll
    for (int ks = 0; ks < 2; ++ks) {
      const int co = ks ? c1 : c0;
      bf16x8 Bl[4];
#pragma unroll
      for (int n = 0; n < 4; ++n) Bl[n] = *reinterpret_cast<const bf16x8*>(sb + brw + co + n * 2048);
#pragma unroll
      for (int h = 0; h < MS; ++h) {
        bf16x8 At[4];
#pragma unroll
        for (int m = 0; m < 4; ++m) At[m] = *reinterpret_cast<const bf16x8*>(sb + arow + co + (h * 4 + m) * 2048);
#pragma unroll
        for (int m = 0; m < 4; ++m)
#pragma unroll
          for (int n = 0; n < 4; ++n) acc[h][m][n] = __builtin_amdgcn_mfma_f32_16x16x32_bf16(At[m], Bl[n], acc[h][m][n], 0, 0, 0);
      }
    }
  }
}

template <int WM, int WN, class Epi>
__device__ __forceinline__ void gemm_tile(const u16* __restrict__ A, int lda, const u16* __restrict__ Bt, int ldb,
                                          int K, int brow, int bcol, char* smem, Epi epi) {
  constexpr int MS = 4 / WM;
  const int tid = TID(), wid = tid >> 6, lane = tid & 63, wr = wid / WN, wc = wid % WN, fr = lane & 15, fq = lane >> 4;
  f32x4 acc[MS][4][4];
  gemm_core<WM, WN>(A, lda, Bt, ldb, K, brow, bcol, smem, acc);
#pragma unroll
  for (int h = 0; h < MS; ++h) epi(acc[h], brow + wr * (256 / WM) + h * 64, bcol + wc * 64, fr, fq);
}

namespace pg8 {
#define PG8_LAS __attribute__((address_space(3)))
typedef unsigned short bf16_t;
constexpr int BM = 256, BK = 64, HALF = 128, HTB = HALF * BK * 2  , STAGE_BYTES = 8 * HTB, NXCD = 8, WGM = 8;

__host__ __device__ __forceinline__ int lds_byte(int r, int c) { const int st = (r >> 4) * 2 + (c >> 5), rr = r & 15, cc = c & 31, ob = rr * 64 + cc * 2; return st * 1024 + (ob ^ (((ob >> 9) & 1) << 5)); }
__host__ __device__ __forceinline__ void stage_rc(int b, int& R, int& C) { const int st = b / 1024, sb = b % 1024, swz = sb ^ (((sb >> 9) & 1) << 5); R = (st >> 1) * 16 + swz / 64; C = (st & 1) * 32 + (swz % 64) / 2; }
__host__ __device__ __forceinline__ int perm32(int rho) { const int n = rho >> 4, i = rho & 15; return 8 * (i >> 2) + 4 * n + (i & 3); }
struct Unit { int pm, pn; };
struct Gemm { const bf16_t* A; const bf16_t* Bt; int M, N, K; };
struct StaticOrder {
    int nM, nN, nwg, G, c;
    __device__ void init(int M, int N, int G_, int c_) { nM = M / BM; nN = N / BM; nwg = nM * nN; G = G_; c = c_; }
    __device__ bool next(int i, Unit& u) const {
        const long L = (long)i * G + c; if (L >= nwg) return false;
        int wgid = (int)L; { const int q = nwg / NXCD, r = nwg % NXCD, xcd = wgid % NXCD, off = wgid / NXCD; wgid = (xcd < r ? xcd * (q + 1) : r * (q + 1) + (xcd - r) * q) + off; }
        const int nig = WGM * nN, gid = wgid / nig, fm = gid * WGM, gsz = (nM - fm) < WGM ? (nM - fm) : WGM;
        u.pm = fm + ((wgid % nig) % gsz); u.pn = (wgid % nig) / gsz; return true;
    }
    __device__ __forceinline__ void a_ready(const Unit&) const {}
    __device__ __forceinline__ void done(const Unit&) const {}
};
template <class Epi, class Sched, bool STAMP = false>
__device__ __forceinline__ void gemm_phase(PG8_LAS unsigned char* lds, const Gemm g, const Sched& S, const Epi& E, unsigned long long* stamps) {
    const int tid = TID(), wid = __builtin_amdgcn_readfirstlane(tid >> 6), lane = tid & 63, wr = wid >> 2, wc = wid & 3, fr = lane & 15, fq = lane >> 4;
    const int K = g.K, nt = K / BK;
    int ts_lo = 0, ts_hi = 0, nts = 0; const unsigned long long rt_entry = STAMP ? (unsigned long long)wall_clock64() : 0ull;
#define PG8_STAMP() do { if (STAMP && wid == 0 && nts < 64) { const unsigned long long _c = (unsigned long long)clock64(); \
        ts_lo = (lane == nts) ? (int)(unsigned)_c : ts_lo; ts_hi = (lane == nts) ? (int)(unsigned)(_c >> 32) : ts_hi; ++nts; } } while (0)
    PG8_STAMP();
    unsigned voffA[2], voffB[2];
#pragma unroll
    for (int i = 0; i < 2; ++i) { int R, C; stage_rc(tid * 16 + i * 8192, R, C); const int Rb = Epi::PERM ? ((R & ~31) + perm32(R & 31)) : R;
        voffA[i] = (unsigned)(R * K + C) * 2u; voffB[i] = (unsigned)(Rb * K + C) * 2u; }
    const size_t kstep = (size_t)(BK * 2);
    const size_t hstep = (size_t)HALF * K * 2;
    const size_t tstep = 2 * hstep;
    const unsigned ldsw = (unsigned)wid * 1024u;
    const int aoff = lds_byte(wr * 64 + fr, fq * 8), boff = lds_byte(wc * 32 + fr, fq * 8);
#define PG8_SA(b, h) (((b) * 2 + (h)) * HTB)
#define PG8_SB(b, h) ((4 + (b) * 2 + (h)) * HTB)
#define PG8_STAGE(bufoff, gbase, voff) do { _Pragma("unroll") for (int _i = 0; _i < 2; ++_i) \
        __builtin_amdgcn_global_load_lds((const unsigned*)((const char*)(gbase) + (voff)[_i]), (PG8_LAS unsigned*)(lds + (bufoff) + ldsw + _i * 8192), 16, 0, 0); } while (0)
#define PG8_LDA(dst, b, h) do { _Pragma("unroll") for (int m = 0; m < 4; ++m) _Pragma("unroll") for (int k = 0; k < 2; ++k) dst[m][k] = *(const PG8_LAS bf16x8*)(lds + PG8_SA(b, h) + aoff + m * 2048 + k * 1024); } while (0)
#define PG8_LDB(dst, b, h) do { _Pragma("unroll") for (int n = 0; n < 2; ++n) _Pragma("unroll") for (int k = 0; k < 2; ++k) dst[n][k] = *(const PG8_LAS bf16x8*)(lds + PG8_SB(b, h) + boff + n * 2048 + k * 1024); } while (0)
#define PG8_MMA(ai, bj, At, Bt) do { __builtin_amdgcn_s_setprio(1); _Pragma("unroll") for (int m = 0; m < 4; ++m) _Pragma("unroll") for (int n = 0; n < 2; ++n) _Pragma("unroll") for (int k = 0; k < 2; ++k) \
        acc[ai][bj][m][n] = __builtin_amdgcn_mfma_f32_16x16x32_bf16(Bt[n][k], At[m][k], acc[ai][bj][m][n], 0, 0, 0); __builtin_amdgcn_s_setprio(0); } while (0)
#define PG8_WAIT_V(n) asm volatile("s_waitcnt vmcnt(" #n ")" ::: "memory")
#define PG8_WAIT_L(n) asm volatile("s_waitcnt lgkmcnt(" #n ")" ::: "memory")
#define PG8_BAR __builtin_amdgcn_s_barrier()
#define PG8_SCHED __builtin_amdgcn_sched_barrier(0)
    Unit cur, nxt; int ui = 0;
    if (!S.next(0, cur)) return;
    f32x4 acc[2][2][4][2];
#pragma unroll
    for (int a = 0; a < 2; ++a)
#pragma unroll
        for (int b = 0; b < 2; ++b)
#pragma unroll
            for (int m = 0; m < 4; ++m)
#pragma unroll
                for (int n = 0; n < 2; ++n) acc[a][b][m][n] = (f32x4){0.f, 0.f, 0.f, 0.f};
    bf16x8 At[4][2], B0[2][2], B1[2][2];
    const char* cA = (const char*)g.A + (size_t)cur.pm * tstep; const char* cB = (const char*)g.Bt + (size_t)cur.pn * tstep;
    S.a_ready(cur);
    PG8_STAGE(PG8_SB(0, 0), cB, voffB); PG8_STAGE(PG8_SA(0, 0), cA, voffA); PG8_STAGE(PG8_SB(0, 1), cB + hstep, voffB); PG8_STAGE(PG8_SA(0, 1), cA + hstep, voffA);
    if (wr == 1) PG8_BAR;
    PG8_WAIT_V(4); PG8_BAR;
    PG8_STAGE(PG8_SB(1, 0), cB + kstep, voffB); PG8_STAGE(PG8_SA(1, 0), cA + kstep, voffA); PG8_STAGE(PG8_SB(1, 1), cB + hstep + kstep, voffB);
    PG8_WAIT_V(6); PG8_BAR;
    PG8_STAMP();
    for (;;) {
        const bool has_next = S.next(ui + 1, nxt);
        const char* nA = has_next ? (const char*)g.A + (size_t)nxt.pm * tstep : cA; const char* nB = has_next ? (const char*)g.Bt + (size_t)nxt.pn * tstep : cB;
        for (int t = 0; t < nt; t += 2) {
            const bool last = (t == nt - 2);
            const char* a1 = cA + (size_t)(t + 1) * kstep;
            const char* a2 = last ? nA : cA + (size_t)(t + 2) * kstep; const char* b2 = last ? nB : cB + (size_t)(t + 2) * kstep;
            const char* a3 = a2 + kstep; const char* b3 = b2 + kstep;
            if (last && has_next) S.a_ready(nxt);
            PG8_LDB(B0, 0, 0); PG8_SCHED; PG8_LDA(At, 0, 0); PG8_STAGE(PG8_SA(1, 1), a1 + hstep, voffA);
            PG8_WAIT_L(8); PG8_BAR; PG8_WAIT_L(0); PG8_MMA(0, 0, At, B0); PG8_BAR; PG8_SCHED;
            PG8_LDB(B1, 0, 1); PG8_STAGE(PG8_SB(0, 0), b2, voffB);
            PG8_BAR; PG8_WAIT_L(0); PG8_MMA(0, 1, At, B1); PG8_BAR;
            PG8_LDA(At, 0, 1); PG8_STAGE(PG8_SA(0, 0), a2, voffA);
            PG8_BAR; PG8_WAIT_L(0); PG8_MMA(1, 0, At, B0); PG8_BAR; PG8_SCHED;
            PG8_STAGE(PG8_SB(0, 1), b2 + hstep, voffB);
            PG8_WAIT_V(6); PG8_BAR; PG8_MMA(1, 1, At, B1); PG8_BAR;
            PG8_LDB(B0, 1, 0); PG8_SCHED; PG8_LDA(At, 1, 0); PG8_STAGE(PG8_SA(0, 1), a2 + hstep, voffA);
            PG8_WAIT_L(8); PG8_BAR; PG8_WAIT_L(0); PG8_MMA(0, 0, At, B0); PG8_BAR; PG8_SCHED;
            PG8_LDB(B1, 1, 1); PG8_STAGE(PG8_SB(1, 0), b3, voffB);
            PG8_BAR; PG8_WAIT_L(0); PG8_MMA(0, 1, At, B1); PG8_BAR;
            PG8_LDA(At, 1, 1); PG8_STAGE(PG8_SA(1, 0), a3, voffA);
            PG8_BAR; PG8_WAIT_L(0); PG8_MMA(1, 0, At, B0); PG8_BAR; PG8_SCHED;
            PG8_STAGE(PG8_SB(1, 1), b3 + hstep, voffB);
            PG8_WAIT_V(6); PG8_BAR; PG8_MMA(1, 1, At, B1); PG8_BAR;
        }
        PG8_STAMP();
        if constexpr (!Epi::AFTER_DRAIN) { E(acc, cur, wr, wc, fr, fq); S.done(cur); }
        PG8_STAMP();
        if (!has_next) break;
#pragma unroll
        for (int a = 0; a < 2; ++a)
#pragma unroll
            for (int b = 0; b < 2; ++b)
#pragma unroll
                for (int m = 0; m < 4; ++m)
#pragma unroll
                    for (int n = 0; n < 2; ++n) acc[a][b][m][n] = (f32x4){0.f, 0.f, 0.f, 0.f};
        cur = nxt; cA = nA; cB = nB; ++ui;
    }
    PG8_WAIT_V(0);
    if (wr == 0) PG8_BAR;
    PG8_BAR;
    if constexpr (Epi::AFTER_DRAIN) { E.fused(acc, cur, wr, wc, fr, fq, lds, wid, lane); S.done(cur); }
    PG8_STAMP();
    if (STAMP && wid == 0) { stamps[lane] = lane < nts ? (((unsigned long long)(unsigned)ts_hi << 32) | (unsigned)ts_lo) : 0ull;
        if (lane == 62) stamps[62] = rt_entry; if (lane == 63) stamps[63] = (unsigned long long)wall_clock64(); }
#undef PG8_STAMP
#undef PG8_SA
#undef PG8_SB
#undef PG8_STAGE
#undef PG8_LDA
#undef PG8_LDB
#undef PG8_MMA
#undef PG8_WAIT_V
#undef PG8_WAIT_L
#undef PG8_BAR
#undef PG8_SCHED
}
}


__device__ __forceinline__ u32x4 pack8(const f32x4& a, const f32x4& b) { return u32x4{pk2(a[0], a[1]), pk2(a[2], a[3]), pk2(b[0], b[1]), pk2(b[2], b[3])}; }
__device__ __forceinline__ float sumsq4(const f32x4& a) { return (a[0] * a[0] + a[1] * a[1]) + (a[2] * a[2] + a[3] * a[3]); }
__device__ __forceinline__ void store_tr8(u16* vt, const f32x4& a, const f32x4& b) {
  vt[0] = f2bf(a[0]); vt[(size_t)S_] = f2bf(a[1]); vt[(size_t)2 * S_] = f2bf(a[2]); vt[(size_t)3 * S_] = f2bf(a[3]);
  vt[(size_t)4 * S_] = f2bf(b[0]); vt[(size_t)5 * S_] = f2bf(b[1]); vt[(size_t)6 * S_] = f2bf(b[2]); vt[(size_t)7 * S_] = f2bf(b[3]);
}
struct EpiInproj {
  static constexpr bool PERM = true, AFTER_DRAIN = false;
  u16 *cqb, *ckvb, *Qf, *Kf, *VfT; float* rss; float* kn2;
  __device__ __forceinline__ void operator()(const f32x4 (&acc)[2][2][4][2], const pg8::Unit& u, int wr, int wc, int fr, int fq) const {
    const int ct = u.pn * 256;
#pragma unroll
    for (int ai = 0; ai < 2; ++ai)
#pragma unroll
      for (int m = 0; m < 4; ++m) {
        const int row = u.pm * 256 + ai * 128 + wr * 64 + m * 16 + fr, b = row >> 12, s = row & 4095;
        float ss = 0.f;
#pragma unroll
        for (int bj = 0; bj < 2; ++bj) {
          const int c0 = ct + bj * 128 + wc * 32 + 8 * fq;
          const f32x4 v0 = acc[ai][bj][m][0], v1 = acc[ai][bj][m][1];
          if (ct < 1024) {
            u16* dst = ct < 512 ? cqb : ckvb;
            *(u32x4*)(dst + (size_t)row * 512 + (c0 & 511)) = pack8(v0, v1);
            ss += sumsq4(v0) + sumsq4(v1);
          } else if (ct < 3072) {
            int c = c0 - 1024; u16* dst = c < 1024 ? Qf : Kf; c &= 1023;
            *(u32x4*)(dst + ((size_t)(b * 8 + (c >> 7)) * S_ + s) * 128 + (c & 127)) = pack8(v0, v1);
            if (ct >= 2048) atomicAdd(kn2 + (size_t)(b * 8 + (c >> 7)) * S_ + s, sumsq4(v0) + sumsq4(v1));
          } else {
            const int c = c0 - 3072;
            store_tr8(VfT + ((size_t)(b * 8 + (c >> 7)) * 128 + (c & 127)) * S_ + s, v0, v1);
          }
        }
        if (ct < 1024) atomicAdd(rss + (ct < 512 ? 0 : T_) + row, ss);
        __builtin_amdgcn_sched_barrier(0);
      }
  }
};
struct EpiQup {
  static constexpr bool PERM = true, AFTER_DRAIN = false;
  u16* Qm; const float* rss;
  __device__ __forceinline__ void operator()(const f32x4 (&acc)[2][2][4][2], const pg8::Unit& u, int wr, int wc, int fr, int fq) const {
#pragma unroll
    for (int ai = 0; ai < 2; ++ai)
#pragma unroll
      for (int m = 0; m < 4; ++m) {
        const int row = u.pm * 256 + ai * 128 + wr * 64 + m * 16 + fr, b = row >> 12, s = row & 4095;
        const float rs = rsqrtf(rss[row] * (1.f / 512.f) + EPS);
#pragma unroll
        for (int bj = 0; bj < 2; ++bj) {
          const int c0 = u.pn * 256 + bj * 128 + wc * 32 + 8 * fq, hh = c0 / 192, off = c0 % 192;
          *(u32x4*)(Qm + ((size_t)(b * 8 + hh) * S_ + s) * 192 + off) = pack8(acc[ai][bj][m][0] * rs, acc[ai][bj][m][1] * rs);
        }
        __builtin_amdgcn_sched_barrier(0);
      }
  }
};
struct EpiKVup {
  static constexpr bool PERM = true, AFTER_DRAIN = false;
  u16 *Km, *VmT; const float* rss;
  __device__ __forceinline__ void operator()(const f32x4 (&acc)[2][2][4][2], const pg8::Unit& u, int wr, int wc, int fr, int fq) const {
    const int hh = u.pn;
#pragma unroll
    for (int ai = 0; ai < 2; ++ai)
#pragma unroll
      for (int m = 0; m < 4; ++m) {
        const int row = u.pm * 256 + ai * 128 + wr * 64 + m * 16 + fr, b = row >> 12, s = row & 4095;
        const float rs = rsqrtf(rss[T_ + row] * (1.f / 512.f) + EPS);
        const int off = wc * 32 + 8 * fq;
        *(u32x4*)(Km + ((size_t)(b * 8 + hh) * S_ + s) * 192 + off) = pack8(acc[ai][0][m][0] * rs, acc[ai][0][m][1] * rs);
        store_tr8(VmT + ((size_t)(b * 8 + hh) * 128 + off) * S_ + s, acc[ai][1][m][0] * rs, acc[ai][1][m][1] * rs);
        __builtin_amdgcn_sched_barrier(0);
      }
  }
};
struct EpiProj {
  static constexpr bool PERM = true, AFTER_DRAIN = false;
  u16* projb;
  __device__ __forceinline__ void operator()(const f32x4 (&acc)[2][2][4][2], const pg8::Unit& u, int wr, int wc, int fr, int fq) const {
#pragma unroll
    for (int ai = 0; ai < 2; ++ai)
#pragma unroll
      for (int m = 0; m < 4; ++m) {
        const int row = u.pm * 256 + ai * 128 + wr * 64 + m * 16 + fr;
#pragma unroll
        for (int bj = 0; bj < 2; ++bj)
          *(u32x4*)(projb + (size_t)row * D_ + u.pn * 256 + bj * 128 + wc * 32 + 8 * fq) = pack8(acc[ai][bj][m][0], acc[ai][bj][m][1]);
      }
  }
};
struct EpiOut {
  static constexpr bool PERM = false, AFTER_DRAIN = false;
  const float* x; u16* y1;
  __device__ __forceinline__ void operator()(const f32x4 (&acc)[2][2][4][2], const pg8::Unit& u, int wr, int wc, int fr, int fq) const {
#pragma unroll
    for (int ai = 0; ai < 2; ++ai)
#pragma unroll
      for (int m = 0; m < 4; ++m) {
        const size_t rb = (size_t)(u.pm * 256 + ai * 128 + wr * 64 + m * 16 + fr) * D_ + u.pn * 256 + wc * 32 + 4 * fq;
#pragma unroll
        for (int bj = 0; bj < 2; ++bj)
#pragma unroll
          for (int n = 0; n < 2; ++n) {
            const size_t o = rb + bj * 128 + n * 16;
            const f32x4 xv = *(const f32x4*)(x + o);
            const f32x4 y = xv * ALPHA + acc[ai][bj][m][n];
            *(u32x2*)(y1 + o) = u32x2{pk2(y[0], y[1]), pk2(y[2], y[3])};
          }
      }
  }
};
struct EpiGate {
  static constexpr bool PERM = false, AFTER_DRAIN = false;
  const u16* h1b; const u16* projb; u16* r2b;
  __device__ __forceinline__ void operator()(const f32x4 (&acc)[2][2][4][2], const pg8::Unit& u, int wr, int wc, int fr, int fq) const {
#pragma unroll
    for (int ai = 0; ai < 2; ++ai)
#pragma unroll
      for (int m = 0; m < 4; ++m) {
        const size_t rb = (size_t)(u.pm * 256 + ai * 128 + wr * 64 + m * 16 + fr) * D_ + u.pn * 256 + wc * 32 + 4 * fq;
#pragma unroll
        for (int bj = 0; bj < 2; ++bj)
#pragma unroll
          for (int n = 0; n < 2; ++n) {
            const size_t o = rb + bj * 128 + n * 16;
            const u32x2 hb = *(const u32x2*)(h1b + o);
            const f32x4 hv = {bflo(hb[0]), bfhi(hb[0]), bflo(hb[1]), bfhi(hb[1])};
            const u32x2 pj = *(const u32x2*)(projb + o);
            const f32x4 a = acc[ai][bj][m][n];
            f32x4 r;
            r[0] = ALPHA * hv[0] + bflo(pj[0]) / (1.f + __expf(-a[0])); r[1] = ALPHA * hv[1] + bfhi(pj[0]) / (1.f + __expf(-a[1]));
            r[2] = ALPHA * hv[2] + bflo(pj[1]) / (1.f + __expf(-a[2])); r[3] = ALPHA * hv[3] + bfhi(pj[1]) / (1.f + __expf(-a[3]));
            *(u32x2*)(r2b + o) = u32x2{pk2(r[0], r[1]), pk2(r[2], r[3])};
          }
      }
  }
};

__device__ __forceinline__ int vblock(int bid, int nb) { return (nb & 7) ? bid : (bid & 7) * (nb >> 3) + (bid >> 3); }
__device__ __forceinline__ void tile_rc(int t, int Nt, int& tm, int& tn) {
  const int g = t / (8 * Nt), q = t % (8 * Nt);
  tn = q >> 3; tm = g * 8 + (q & 7);
}

__device__ void phase_inproj(const Params& p, char* smem, int bid, int nb) {
  {
    EpiInproj E{p.cqb(), p.ckvb(), p.Qf(), p.Kf(), p.VfT(), p.rss(), p.kn2()};
    pg8::Gemm g{p.xb(), p.WinT(), T_, 4096, D_};
    pg8::StaticOrder S; S.init(T_, 4096, nb, bid);
    pg8::gemm_phase((PG8_LAS unsigned char*)smem, g, S, E, nullptr);
  }
  for (int t = vblock(bid, nb); t < 256; t += nb) {
    const int tm = t >> 3, ks = t & 7;
    f32x4 acc[2][4][4];
    gemm_core<2, 4>(p.xb() + ks * 256, D_, p.WinT() + ks * 256, D_, 256, tm * 256, 4096, smem, acc);
    const int tid = TID(), wid = tid >> 6, lane = tid & 63, wr = wid >> 2, wc = wid & 3, fr = lane & 15, fq = lane >> 4;
    if (wc == 0) {
#pragma unroll
      for (int h = 0; h < 2; ++h) {
        float* kd = p.krsum() + (size_t)(tm * 256 + wr * 128 + h * 64 + fq * 4) * 64 + fr;
#pragma unroll
        for (int m = 0; m < 4; ++m)
#pragma unroll
          for (int n = 0; n < 4; ++n)
#pragma unroll
            for (int j = 0; j < 4; ++j) atomicAdd(kd + (m * 16 + j) * 64 + n * 16, acc[h][m][n][j]);
      }
    }
  }
}

__device__ void phase_up(const Params& p, char* smem, int bid, int nb) {
  PG8_LAS unsigned char* lds = (PG8_LAS unsigned char*)smem;
  {
    EpiQup E{p.Qm(), p.rss()};
    pg8::Gemm g{p.cqb(), p.WuqT(), T_, 1536, 512};
    pg8::StaticOrder S; S.init(T_, 1536, nb, (bid + nb - 64) % nb);
    pg8::gemm_phase(lds, g, S, E, nullptr);
  }
  {
    EpiKVup E{p.Km(), p.VmT(), p.rss()};
    pg8::Gemm g{p.ckvb(), p.WukvT(), T_, 2048, 512};
    pg8::StaticOrder S; S.init(T_, 2048, nb, bid);
    pg8::gemm_phase(lds, g, S, E, nullptr);
  }
  {
    EpiProj E{p.projb()};
    pg8::Gemm g{p.pb(), p.WpT(), T_, 2048, 256};
    pg8::StaticOrder S; S.init(T_, 2048, nb, bid);
    pg8::gemm_phase(lds, g, S, E, nullptr);
  }
  for (int t = bid; t < 48; t += nb) {
    if (t >= 16) {
      const int r0 = (t - 16) * 256, tid = TID();
#pragma unroll 1
      for (int it = 0; it < 16; ++it) {
        const int pr = it * NT + tid, row = r0 + (pr >> 5), i = pr & 31, b = row >> 12, s = row & 4095;
        const float x1 = p.krsum()[(size_t)row * 64 + i], x2 = p.krsum()[(size_t)row * 64 + 32 + i];
        const float2 cs = p.cs()[(size_t)row * 32 + i];
        const u16 o1 = f2bf(x1 * cs.x - x2 * cs.y), o2 = f2bf(x1 * cs.y + x2 * cs.x);
#pragma unroll
        for (int hh = 0; hh < 8; ++hh) {
          u16* kd = p.Km() + ((size_t)(b * 8 + hh) * S_ + s) * 192 + 128;
          kd[i] = o1; kd[32 + i] = o2;
        }
      }
    } else {
      const int seq = t;
      if ((TID() >> 6) == 0) {
        const int lane = TID() & 63;
        const float* src = p.logf() + (size_t)seq * S_ + lane * 64;
        float* dst = p.Fk() + (size_t)seq * S_ + lane * 64;
        float sum = 0.f;
#pragma unroll
        for (int i = 0; i < 16; ++i) { const float4 v = *(const float4*)(src + i * 4); sum += v.x; sum += v.y; sum += v.z; sum += v.w; }
        float inc = sum;
#pragma unroll
        for (int d = 1; d < 64; d <<= 1) { const float o = __shfl_up(inc, d, 64); if (lane >= d) inc += o; }
        float run = inc - sum;
#pragma unroll
        for (int i = 0; i < 16; ++i) {
          const float4 v = *(const float4*)(src + i * 4); float4 o;
          run += v.x; o.x = run; run += v.y; o.y = run; run += v.z; o.z = run; run += v.w; o.w = run;
          *(float4*)(dst + i * 4) = o;
        }
        const float* kn = p.kn2() + (size_t)seq * S_ + lane * 64;
        float mxn = 0.f;
#pragma unroll
        for (int i = 0; i < 16; ++i) { const float4 v = *(const float4*)(kn + i * 4); mxn = fmaxf(mxn, fmaxf(fmaxf(v.x, v.y), fmaxf(v.z, v.w))); }
#pragma unroll
        for (int d = 1; d < 64; d <<= 1) { const float o2 = __shfl_up(mxn, d, 64); if (lane >= d) mxn = fmaxf(mxn, o2); }
        p.knp()[seq * 64 + lane] = sqrtf(mxn);
      }
    }
  }
}

#ifdef ATTN_NAIVE
__device__ void phase_attn_naive(const Params& p, char* smem, int bid, int nb) {
  const int tid = TID(), lane = tid & 63, wid = tid >> 6;
  const int per = NB_ * 8 * S_, nrows = 2 * per;
  for (int r = bid * 4 + wid; r < nrows; r += nb * 4) {
    const int type = r / per, rr = r % per, bh = rr / S_, s = rr % S_;
    const int DQ = type ? 128 : 192;
    const u16* Q = type ? p.Qf() + ((size_t)bh * S_ + s) * 128 : p.Qm() + ((size_t)bh * S_ + s) * 192;
    const u16* Kb = type ? p.Kf() + (size_t)bh * S_ * 128 : p.Km() + (size_t)bh * S_ * 192;
    const u16* VT = (type ? p.VfT() : p.VmT()) + (size_t)bh * 128 * S_;
    const float* F = p.Fk() + (size_t)bh * S_;
    const float scale = type ? 0.08838834764831845f : 0.07216878364870322f;
    float m = -1e30f, l = 0.f;
    float acc[128];
#pragma unroll
    for (int d = 0; d < 128; ++d) acc[d] = 0.f;
    const float fqv = type ? F[s] : 0.f;
    for (int k0 = 0; k0 <= s; k0 += 64) {
      const int key = k0 + lane; const bool valid = key <= s; const int keyc = valid ? key : s;
      const u16* kr = Kb + (size_t)keyc * DQ;
      float sc = 0.f;
      for (int d = 0; d < DQ; d += 8) {
        const u32x4 kv = *(const u32x4*)(kr + d), qv = *(const u32x4*)(Q + d);
#pragma unroll
        for (int w = 0; w < 4; ++w) sc += bflo(kv[w]) * bflo(qv[w]) + bfhi(kv[w]) * bfhi(qv[w]);
      }
      sc *= scale;
      if (type) sc += fqv - F[keyc];
      if (!valid) sc = -1e30f;
      const float mx = wave_max(sc), mn = fmaxf(m, mx), alpha = __expf(m - mn);
      const float pr = valid ? __expf(sc - mn) : 0.f;
      m = mn; l = l * alpha + pr;
#pragma unroll
      for (int d = 0; d < 128; ++d) acc[d] = acc[d] * alpha + pr * bf2f(VT[(size_t)d * S_ + keyc]);
    }
    const float inv = 1.f / wave_sum(l);
    float o0 = 0.f, o1 = 0.f;
#pragma unroll
    for (int d = 0; d < 128; ++d) {
      const float o = wave_sum(acc[d]) * inv;
      if (lane == (d & 63)) { if (d < 64) o0 = o; else o1 = o; }
    }
    const int b = bh >> 3, hh = bh & 7;
    u16* od = p.omix() + ((size_t)(b * S_ + s)) * 2048 + type * 1024 + hh * 128;
    od[lane] = f2bf(o0); od[64 + lane] = f2bf(o1);
  }
}

#endif
typedef float f32x16 __attribute__((ext_vector_type(16)));
template <int TYPE>
__device__ __forceinline__ void attn_item(const Params& p, char* smem, int bh, int qb) {
  constexpr int DQK = TYPE ? 128 : 192, NKS = DQK / 16, KSTR = DQK * 2 + 16, VSTR = 128;
  constexpr int KCH = DQK / 8, NKL = 64 * KCH / NT;
  constexpr float C2 = (TYPE ? 0.08838834764831845f : 0.07216878364870322f) * 1.4426950408889634f;
  char* sK = smem; char* sV = smem + 51200; float* sF = (float*)(smem + 51200 + 32768);
  const int tid = TID(), lane = tid & 63, wid = tid >> 6, c = lane & 31, hi = lane >> 5;
  const u16* Qb = (TYPE ? p.Qf() : p.Qm()) + (size_t)bh * S_ * DQK;
  const u16* Kb = (TYPE ? p.Kf() : p.Km()) + (size_t)bh * S_ * DQK;
  const u16* Vb = (TYPE ? p.VfT() : p.VmT()) + (size_t)bh * 128 * S_;
  const float* Fb = p.Fk() + (size_t)bh * S_;
  const int qrow = qb * 256 + wid * 32;
  bf16x8 qf[NKS];
#pragma unroll
  for (int ks = 0; ks < NKS; ++ks) qf[ks] = *(const bf16x8*)(Qb + (size_t)(qrow + c) * DQK + ks * 16 + hi * 8);
  if (TYPE == 0) {
    const float2* csr = p.cs() + (size_t)((bh >> 3) * S_ + qrow + c) * 32;
#pragma unroll
    for (int kk = 0; kk < 2; ++kk) {
      u32x4 x1 = *reinterpret_cast<u32x4*>(&qf[(NKS - 4) + kk]), x2 = *reinterpret_cast<u32x4*>(&qf[(NKS - 2) + kk]);
#pragma unroll
      for (int w = 0; w < 4; ++w) {
        const float4 cs = *(const float4*)(csr + 16 * kk + 8 * hi + 2 * w);
        const float a0 = bflo(x1[w]), a1 = bfhi(x1[w]), b0 = bflo(x2[w]), b1 = bfhi(x2[w]);
        x1[w] = pk2(a0 * cs.x - b0 * cs.y, a1 * cs.z - b1 * cs.w);
        x2[w] = pk2(a0 * cs.y + b0 * cs.x, a1 * cs.w + b1 * cs.z);
      }
      qf[(NKS - 4) + kk] = *reinterpret_cast<bf16x8*>(&x1); qf[(NKS - 2) + kk] = *reinterpret_cast<bf16x8*>(&x2);
    }
  }
  f32x16 o[4];
#pragma unroll
  for (int db = 0; db < 4; ++db)
#pragma unroll
    for (int r = 0; r < 16; ++r) o[db][r] = 0.f;
  float m = -1e30f, l = 0.f;
  const int ntiles = 4 * qb + 4;
  u32x4 kreg[NKL];
  float4 freg = make_float4(0.f, 0.f, 0.f, 0.f);
  const unsigned koff = (unsigned)tid * 16u;
  auto load_k = [&](int kt) {
    const char* kb = (const char*)(Kb + (size_t)kt * 64 * DQK);
#pragma unroll
    for (int i = 0; i < NKL; ++i) kreg[i] = *(const u32x4*)(kb + i * 8192 + koff);
    if (TYPE) { if (tid < 16) freg = *(const float4*)(Fb + kt * 64 + tid * 4); }
  };
  const unsigned voff = (unsigned)((((tid >> 3) * S_) + (((tid & 7) ^ ((tid >> 4) & 7)) * 8)) * 2);
  auto load_v = [&](int kt, int buf) {
    const char* vb = (const char*)(Vb + kt * 64);
    char* dst = sV + buf * 16384 + tid * 16;
#pragma unroll
    for (int i = 0; i < 2; ++i)
      __builtin_amdgcn_global_load_lds((const unsigned*)(vb + (size_t)i * 64 * S_ * 2 + voff), (unsigned*)(dst + i * 8192), 16, 0, 0);
  };
  auto store_tile = [&](int buf) {
    char* sKw = sK + buf * 25600;
#pragma unroll
    for (int i = 0; i < NKL; ++i) { const int ch = tid + NT * i, key = ch / KCH, dc = ch % KCH; *(u32x4*)(sKw + key * KSTR + dc * 16) = kreg[i]; }
    if (TYPE) { if (tid < 16) { const float L2E = 1.4426950408889634f; *(float4*)(sF + buf * 64 + tid * 4) = make_float4(freg.x * L2E, freg.y * L2E, freg.z * L2E, freg.w * L2E); } }
  };
  const int krow = (c & 19) | ((c & 4) << 1) | ((c & 8) >> 1);
  const char* ka0 = sK + krow * KSTR + hi * 16;
  const char* ka1 = ka0 + 32 * KSTR;
  const int vx = (c >> 1) & 7;
  int vo[2][2];
#pragma unroll
  for (int kb = 0; kb < 2; ++kb)
#pragma unroll
    for (int s2 = 0; s2 < 2; ++s2) vo[kb][s2] = c * VSTR + (((4 * kb + 2 * s2 + hi) ^ vx) * 16);
  float qn = 0.f;
  if (TYPE) {
#pragma unroll
    for (int ks = 0; ks < NKS; ++ks) {
      const u32x4 w = *reinterpret_cast<const u32x4*>(&qf[ks]);
#pragma unroll
      for (int e = 0; e < 4; ++e) { const float a = bflo(w[e]), b2 = bfhi(w[e]); qn += a * a + b2 * b2; }
    }
    auto rr = __builtin_amdgcn_permlane32_swap(__float_as_uint(qn), __float_as_uint(qn), false, false);
    qn = sqrtf(__uint_as_float(rr[0]) + __uint_as_float(rr[1])) * (C2 * 1.02f);
  }
  int* sFlag = (int*)(smem + 90112);
  const float* KNp = p.knp() + bh * 64;
  bool myneed = true;
  const int kt0 = TYPE ? ntiles - 1 : 0;
  load_k(kt0); load_v(kt0, 0);
  store_tile(0);
#pragma unroll 1
  for (int j = 0; j < ntiles; ++j) {
    const int kt = TYPE ? ntiles - 1 - j : j, ktn = TYPE ? kt - 1 : kt + 1;
    asm volatile("s_waitcnt vmcnt(0) lgkmcnt(0)" ::: "memory");
    __syncthreads();
    if (TYPE && j > 0) {
      const int* fl = sFlag + (j & 1) * 8;
      if (!(fl[0] | fl[1] | fl[2] | fl[3] | fl[4] | fl[5] | fl[6] | fl[7])) break;
    }
    float kn_next = 0.f, mb_next = 0.f;
    if (j + 1 < ntiles) {
      load_k(ktn); load_v(ktn, (j + 1) & 1);
      if (TYPE) { kn_next = KNp[ktn]; mb_next = -Fb[64 * ktn + 63] * 1.4426950408889634f; }
    }
    const int k0 = kt * 64;
    const char* sVc = sV + (j & 1) * 16384;
    const int kbo = (j & 1) * 25600;
    const float* sFc = sF + (j & 1) * 64;
    if (k0 <= qrow + 31 && myneed) {
      f32x16 p0, p1;
#pragma unroll
      for (int r = 0; r < 16; ++r) { p0[r] = 0.f; p1[r] = 0.f; }
#pragma unroll
      for (int ks = 0; ks < NKS; ++ks) {
        const bf16x8 a0 = *(const bf16x8*)(ka0 + kbo + ks * 32), a1 = *(const bf16x8*)(ka1 + kbo + ks * 32);
        p0 = __builtin_amdgcn_mfma_f32_32x32x16_bf16(a0, qf[ks], p0, 0, 0, 0);
        p1 = __builtin_amdgcn_mfma_f32_32x32x16_bf16(a1, qf[ks], p1, 0, 0, 0);
      }
      if (TYPE) {
#pragma unroll
        for (int s = 0; s < 2; ++s) {
          const float4 f0 = *(const float4*)(sFc + 16 * s + 8 * hi), f1 = *(const float4*)(sFc + 16 * s + 8 * hi + 4);
          const float4 g0 = *(const float4*)(sFc + 32 + 16 * s + 8 * hi), g1 = *(const float4*)(sFc + 32 + 16 * s + 8 * hi + 4);
          p0[8 * s + 0] = p0[8 * s + 0] * C2 - f0.x; p0[8 * s + 1] = p0[8 * s + 1] * C2 - f0.y; p0[8 * s + 2] = p0[8 * s + 2] * C2 - f0.z; p0[8 * s + 3] = p0[8 * s + 3] * C2 - f0.w;
          p0[8 * s + 4] = p0[8 * s + 4] * C2 - f1.x; p0[8 * s + 5] = p0[8 * s + 5] * C2 - f1.y; p0[8 * s + 6] = p0[8 * s + 6] * C2 - f1.z; p0[8 * s + 7] = p0[8 * s + 7] * C2 - f1.w;
          p1[8 * s + 0] = p1[8 * s + 0] * C2 - g0.x; p1[8 * s + 1] = p1[8 * s + 1] * C2 - g0.y; p1[8 * s + 2] = p1[8 * s + 2] * C2 - g0.z; p1[8 * s + 3] = p1[8 * s + 3] * C2 - g0.w;
          p1[8 * s + 4] = p1[8 * s + 4] * C2 - g1.x; p1[8 * s + 5] = p1[8 * s + 5] * C2 - g1.y; p1[8 * s + 6] = p1[8 * s + 6] * C2 - g1.z; p1[8 * s + 7] = p1[8 * s + 7] * C2 - g1.w;
        }
      }
      if (k0 + 63 > qrow) {
        const int lim = qrow + c - k0 - 8 * hi;
        const float NEG = -__builtin_inff();
#pragma unroll
        for (int r = 0; r < 16; ++r) {
          const int kb = 16 * (r >> 3) + (r & 7);
          if (kb > lim) p0[r] = NEG;
          if (kb + 32 > lim) p1[r] = NEG;
        }
      }
      float mx = p0[0];
#pragma unroll
      for (int r = 1; r < 16; ++r) mx = fmaxf(mx, p0[r]);
#pragma unroll
      for (int r = 0; r < 16; ++r) mx = fmaxf(mx, p1[r]);
      {
        auto rr = __builtin_amdgcn_permlane32_swap(__float_as_uint(mx), __float_as_uint(mx), false, false);
        mx = fmaxf(__uint_as_float(rr[0]), __uint_as_float(rr[1]));
      }
      if (!TYPE) mx *= C2;
      constexpr float THR = TYPE ? 96.f : 16.f;
      float mn = m, alpha = 1.f;
      if (!__all(mx - m <= THR)) {
        mn = fmaxf(m, mx);
        alpha = __builtin_amdgcn_exp2f(m - mn);
        m = mn;
#pragma unroll
        for (int db = 0; db < 4; ++db)
#pragma unroll
          for (int r = 0; r < 16; ++r) o[db][r] *= alpha;
      }
      float ps = 0.f;
      if (TYPE) {
#pragma unroll
        for (int r = 0; r < 16; ++r) { p0[r] = __builtin_amdgcn_exp2f(p0[r] - mn); p1[r] = __builtin_amdgcn_exp2f(p1[r] - mn); ps += p0[r] + p1[r]; }
      } else {
#pragma unroll
        for (int r = 0; r < 16; ++r) { p0[r] = __builtin_amdgcn_exp2f(fmaf(p0[r], C2, -mn)); p1[r] = __builtin_amdgcn_exp2f(fmaf(p1[r], C2, -mn)); ps += p0[r] + p1[r]; }
      }
      l = l * alpha + ps;
      bf16x8 pa[2][2];
#pragma unroll
      for (int s = 0; s < 2; ++s) {
        u32x4 w0 = {pk2(p0[8 * s + 0], p0[8 * s + 1]), pk2(p0[8 * s + 2], p0[8 * s + 3]), pk2(p0[8 * s + 4], p0[8 * s + 5]), pk2(p0[8 * s + 6], p0[8 * s + 7])};
        u32x4 w1 = {pk2(p1[8 * s + 0], p1[8 * s + 1]), pk2(p1[8 * s + 2], p1[8 * s + 3]), pk2(p1[8 * s + 4], p1[8 * s + 5]), pk2(p1[8 * s + 6], p1[8 * s + 7])};
        pa[0][s] = *reinterpret_cast<bf16x8*>(&w0); pa[1][s] = *reinterpret_cast<bf16x8*>(&w1);
      }
#pragma unroll
      for (int db = 0; db < 4; ++db)
#pragma unroll
        for (int kb = 0; kb < 2; ++kb)
#pragma unroll
          for (int s = 0; s < 2; ++s) {
            const bf16x8 av = *(const bf16x8*)(sVc + db * 32 * VSTR + vo[kb][s]);
            o[db] = __builtin_amdgcn_mfma_f32_32x32x16_bf16(av, pa[kb][s], o[db], 0, 0, 0);
          }
    }
    if (j + 1 < ntiles) store_tile((j + 1) & 1);
    if (TYPE) {
      const bool need = (j + 1 < ntiles) && (qn * kn_next + mb_next - m >= -160.f);
      myneed = __any(need);
      if (lane == 0) sFlag[((j + 1) & 1) * 8 + wid] = myneed ? 1 : 0;
    }
  }
  {
    auto rr = __builtin_amdgcn_permlane32_swap(__float_as_uint(l), __float_as_uint(l), false, false);
    const float inv = 1.f / (__uint_as_float(rr[0]) + __uint_as_float(rr[1]));
    const int b = bh >> 3, hh = bh & 7;
    u16* od = p.omix() + ((size_t)(b * S_ + qrow + c)) * 2048 + TYPE * 1024 + hh * 128 + 4 * hi;
#pragma unroll
    for (int db = 0; db < 4; ++db)
#pragma unroll
      for (int g = 0; g < 4; ++g)
        *(u32x2*)(od + 32 * db + 8 * g) = u32x2{pk2(o[db][4 * g] * inv, o[db][4 * g + 1] * inv), pk2(o[db][4 * g + 2] * inv, o[db][4 * g + 3] * inv)};
  }
}

__device__ void phase_attn(const Params& p, char* smem, int bid, int nb) {
  int* sItem = (int*)(smem + 90000);
  const int x = bid & 7;
  unsigned* q = p.ctr() + 32 + x;
  for (;;) {
    __syncthreads();
    if (TID() == 0) *sItem = (int)atomicAdd(q, 1u);
    __syncthreads();
    const int item = *sItem;
    if (item >= 64) break;
    const int qb = 15 - (item >> 2), r = item & 3, type = r >> 1, bh = x + 8 * (r & 1);
    if (type == 0) attn_item<0>(p, smem, bh, qb); else attn_item<1>(p, smem, bh, qb);
  }
  unsigned* qc = p.ctr() + 48;
  for (;;) {
    __syncthreads();
    if (TID() == 0) *sItem = (int)atomicAdd(qc, 1u);
    __syncthreads();
    const int chunk = *sItem;
    if (chunk >= 512) break;
    quant_chunk(p, chunk);
  }
}

__device__ void phase_outproj(const Params& p, char* smem, int bid, int nb) {
  EpiOut E{p.x, (u16*)p.y1()};
  pg8::Gemm g{p.omix(), p.WoutT(), T_, D_, D_};
  pg8::StaticOrder S; S.init(T_, D_, nb, bid);
  pg8::gemm_phase((PG8_LAS unsigned char*)smem, g, S, E, nullptr);
}

__device__ void phase_ln1(const Params& p, int bid, int nb) {
  const int lane = TID() & 63, wid = TID() >> 6;
  for (int t = bid * 8 + wid; t < T_; t += nb * 8) {
    const u16* row = (const u16*)p.y1() + (size_t)t * D_;
    float4 v[8];
    float sum = 0.f;
#pragma unroll
    for (int i = 0; i < 8; ++i) { const u32x2 yb = *(const u32x2*)(row + (i * 64 + lane) * 4); v[i] = make_float4(bflo(yb[0]), bfhi(yb[0]), bflo(yb[1]), bfhi(yb[1])); sum += (v[i].x + v[i].y) + (v[i].z + v[i].w); }
    const float mu = wave_sum(sum) * (1.f / D_);
    float sq = 0.f;
#pragma unroll
    for (int i = 0; i < 8; ++i) {
      v[i].x -= mu; v[i].y -= mu; v[i].z -= mu; v[i].w -= mu;
      sq += (v[i].x * v[i].x + v[i].y * v[i].y) + (v[i].z * v[i].z + v[i].w * v[i].w);
    }
    const float rstd = rsqrtf(wave_sum(sq) * (1.f / D_) + EPS);
#pragma unroll
    for (int i = 0; i < 8; ++i) {
      const int c = (i * 64 + lane) * 4;
      const float4 g = *(const float4*)(p.ln1_g + c), bb = *(const float4*)(p.ln1_b + c);
      float4 o; o.x = v[i].x * rstd * g.x + bb.x; o.y = v[i].y * rstd * g.y + bb.y; o.z = v[i].z * rstd * g.z + bb.z; o.w = v[i].w * rstd * g.w + bb.w;
      *(u32x2*)(p.h1b() + (size_t)t * D_ + c) = u32x2{pk2(o.x, o.y), pk2(o.z, o.w)};
    }
  }
}

__device__ __forceinline__ void ins16(unsigned (&t)[16], unsigned x) {
#pragma unroll
  for (int i = 0; i < 16; ++i) { const unsigned hi = t[i] > x ? t[i] : x; x = t[i] > x ? x : t[i]; t[i] = hi; }
}
__device__ __forceinline__ void ins16p(unsigned (&ck)[16], int (&ce)[16], unsigned x, int xe) {
#pragma unroll
  for (int i = 0; i < 16; ++i) {
    const bool sw = x > ck[i];
    const unsigned nk = sw ? x : ck[i], nx = sw ? ck[i] : x;
    const int ne = sw ? xe : ce[i], nxe = sw ? ce[i] : xe;
    ck[i] = nk; x = nx; ce[i] = ne; xe = nxe;
  }
}
__device__ __forceinline__ float unordkey(unsigned k) { return __uint_as_float((k & 0x80000000u) ? (k & 0x7fffffffu) : ~k); }

__device__ __forceinline__ void sort16_asc(unsigned (&s)[16]) {
#pragma unroll
  for (int k = 2; k <= 16; k <<= 1)
#pragma unroll
    for (int j = k >> 1; j > 0; j >>= 1)
#pragma unroll
      for (int i = 0; i < 16; ++i) {
        const int l = i ^ j;
        if (l > i) {
          const unsigned lo = s[i] < s[l] ? s[i] : s[l], hi = s[i] < s[l] ? s[l] : s[i];
          if ((i & k) == 0) { s[i] = lo; s[l] = hi; } else { s[i] = hi; s[l] = lo; }
        }
      }
}
__device__ __forceinline__ void merge16(unsigned (&t)[16], const unsigned (&s)[16]) {
#pragma unroll
  for (int i = 0; i < 16; ++i) t[i] = t[i] > s[i] ? t[i] : s[i];
#pragma unroll
  for (int j = 8; j > 0; j >>= 1)
#pragma unroll
    for (int i = 0; i < 16; ++i) {
      const int l = i ^ j;
      if (l > i) { const unsigned hi = t[i] > t[l] ? t[i] : t[l], lo = t[i] > t[l] ? t[l] : t[i]; t[i] = hi; t[l] = lo; }
    }
}

__device__ __forceinline__ void score_block(const u16* kH, const u16* kL, const bf16x8 (&qh)[4], const bf16x8 (&ql)[4], int hi, unsigned (&t)[16]) {
#pragma unroll
  for (int i = 0; i < 16; ++i) t[i] = 0u;
#pragma unroll 1
  for (int kb = 0; kb < 4; ++kb) {
    f32x16 sc;
#pragma unroll
    for (int r = 0; r < 16; ++r) sc[r] = 0.f;
#pragma unroll
    for (int ks = 0; ks < 4; ++ks) {
      const bf16x8 ah = *(const bf16x8*)(kH + kb * 32 * 64 + ks * 16), al = *(const bf16x8*)(kL + kb * 32 * 64 + ks * 16);
      sc = __builtin_amdgcn_mfma_f32_32x32x16_bf16(ah, qh[ks], sc, 0, 0, 0);
      sc = __builtin_amdgcn_mfma_f32_32x32x16_bf16(ah, ql[ks], sc, 0, 0, 0);
      sc = __builtin_amdgcn_mfma_f32_32x32x16_bf16(al, qh[ks], sc, 0, 0, 0);
    }
    const unsigned base = (unsigned)(127 - 32 * kb) - 4u * (unsigned)hi;
    unsigned s[16];
#pragma unroll
    for (int r = 0; r < 16; ++r) s[r] = (ordkey(sc[r]) & ~127u) | (base - (unsigned)((r & 3) + 8 * (r >> 2)));
    sort16_asc(s);
    merge16(t, s);
  }
  unsigned other[16];
#pragma unroll
  for (int i = 0; i < 16; ++i) {
    auto rr = __builtin_amdgcn_permlane32_swap(t[15 - i], t[15 - i], false, false);
    other[i] = hi ? rr[0] : rr[1];
  }
  merge16(t, other);
}

__device__ __forceinline__ void route_tile(const Params& p, char* smem, f32x4 (&acc)[4][4], int tm, int h) {
  const int tid = TID(), wid = tid >> 6, lane = tid & 63, wr = wid >> 1, wc = wid & 1, fr = lane & 15, fq = lane >> 4;
  __syncthreads();
  float* Qw = (float*)smem + wid * (64 * 65);
#pragma unroll
  for (int m = 0; m < 4; ++m)
#pragma unroll
    for (int n = 0; n < 4; ++n)
#pragma unroll
      for (int j = 0; j < 4; ++j) Qw[(m * 16 + fq * 4 + j) * 65 + n * 16 + fr] = acc[m][n][j];
  asm volatile("s_waitcnt lgkmcnt(0)" ::: "memory");
  const int c = lane & 31, hi = lane >> 5;
  bf16x8 qh[2][4], ql[2][4];
#pragma unroll
  for (int tb = 0; tb < 2; ++tb)
#pragma unroll
    for (int ks = 0; ks < 4; ++ks) {
      float v[8]; unsigned wh[4], wl[4];
#pragma unroll
      for (int j = 0; j < 8; ++j) v[j] = Qw[(tb * 32 + c) * 65 + 16 * ks + 8 * hi + j];
#pragma unroll
      for (int w = 0; w < 4; ++w) {
        wh[w] = pk2(v[2 * w], v[2 * w + 1]);
        wl[w] = pk2(v[2 * w] - bflo(wh[w]), v[2 * w + 1] - bfhi(wh[w]));
      }
      u32x4 uh = {wh[0], wh[1], wh[2], wh[3]}, ul = {wl[0], wl[1], wl[2], wl[3]};
      qh[tb][ks] = *reinterpret_cast<bf16x8*>(&uh); ql[tb][ks] = *reinterpret_cast<bf16x8*>(&ul);
    }
  const u16* kH = p.keyH() + ((size_t)(wc * 8 + h) * 128 + c) * 64 + 8 * hi;
  const u16* kL = p.keyL() + ((size_t)(wc * 8 + h) * 128 + c) * 64 + 8 * hi;
  unsigned t0[16], t1[16];
  score_block(kH, kL, qh[0], ql[0], hi, t0);
  score_block(kH, kL, qh[1], ql[1], hi, t1);
  unsigned t[16];
#pragma unroll
  for (int i = 0; i < 16; ++i) t[i] = hi ? t1[i] : t0[i];
  __syncthreads();
  unsigned* L = (unsigned*)smem;
#pragma unroll
  for (int r = 0; r < 16; ++r) L[(wc * 16 + r) * 256 + wr * 64 + lane] = t[r];
  __syncthreads();
  if (wid < 4) {
    const int tok = wid * 64 + lane;
    unsigned ck[16]; int ce[16];
#pragma unroll
    for (int i = 0; i < 16; ++i) { ck[i] = 0u; ce[i] = 0; }
#pragma unroll 1
    for (int a = 0; a < 16; ++a) {
      const unsigned ka = L[a * 256 + tok];
      const int i1a = (127 - (int)(ka & 127u)) * 128; const float v1a = unordkey(ka & ~127u);
      const int nbm1 = (int)((0x1112347FULL >> (4 * a)) & 15ULL);
#pragma unroll 1
      for (int b = 0; b <= nbm1; ++b) {
        const unsigned kb = L[(16 + b) * 256 + tok];
        const int i2b = 127 - (int)(kb & 127u); const float v2b = unordkey(kb & ~127u);
        ins16p(ck, ce, ordkey(v1a + v2b), i1a + i2b);
      }
    }
    float ex[16], sum = 0.f;
    const float mx = unordkey(ck[0]);
#pragma unroll
    for (int r = 0; r < 16; ++r) { ex[r] = __expf(unordkey(ck[r]) - mx); sum += ex[r]; }
    const float inv = 1.f / sum;
    const size_t o = ((size_t)(tm * 256 + tok) * 8 + h) * 16;
    int* ed = p.eidxG() + o; float* gd = p.gateG() + o;
#pragma unroll
    for (int r = 0; r < 16; r += 4) {
      *(int4*)(ed + r) = make_int4(ce[r], ce[r + 1], ce[r + 2], ce[r + 3]);
      *(float4*)(gd + r) = make_float4(ex[r] * inv, ex[r + 1] * inv, ex[r + 2] * inv, ex[r + 3] * inv);
    }
  }
}

__device__ void phase_mid(const Params& p, char* smem, int bid, int nb) {
  {
    EpiGate E{p.h1b(), p.projb(), p.r2b()};
    pg8::Gemm g{p.h1b(), p.WgT(), T_, D_, D_};
    pg8::StaticOrder S; S.init(T_, D_, nb, bid);
    pg8::gemm_phase((PG8_LAS unsigned char*)smem, g, S, E, nullptr);
  }
  for (int t = vblock(bid, nb); t < 32 * 8; t += nb) {
    int tm, tn; tile_rc(t, 8, tm, tn);
    f32x4 acc[1][4][4];
    gemm_core<4, 2>(p.h1b(), D_, p.WpqT(), D_, D_, tm * 256, tn * 128, smem, acc);
    route_tile(p, smem, acc[0], tm, tn);
  }
}

__device__ __forceinline__ float gelu_exact(float a) {
  const float x = fabsf(a) * 0.7071067811865476f;
  const float t = __builtin_amdgcn_rcpf(1.f + 0.3275911f * x);
  const float poly = t * (0.254829592f + t * (-0.284496736f + t * (1.421413741f + t * (-1.453152027f + t * 1.061405429f))));
  const float er = 1.f - poly * __expf(-x * x);
  return 0.5f * a * (1.f + (a < 0.f ? -er : er));
}

template <int NPER, int IDXMASK>
__device__ __forceinline__ int top16(unsigned (&k)[NPER], int lane) {
  int mine = 0;
#pragma unroll 1
  for (int r = 0; r < 16; ++r) {
    unsigned loc = k[0];
#pragma unroll
    for (int i = 1; i < NPER; ++i) loc = loc > k[i] ? loc : k[i];
    const unsigned best = wave_umax(loc);
#pragma unroll
    for (int i = 0; i < NPER; ++i) if (k[i] == best) k[i] = 0u;
    if (lane == r) mine = IDXMASK - (int)(best & (unsigned)IDXMASK);
  }
  return mine;
}

__device__ void phase_peer(const Params& p, char* smem, int bid, int nb) {
  const int tid = TID(), lane = tid & 63, wid = tid >> 6;
  float* qs = (float*)smem;
  float* sc = (float*)(smem + 8192);
  int* eidx = (int*)(smem + 24576);
  float* gts = (float*)(smem + 40960);
  for (int it = bid; it < T_ / 32; it += nb) {
    const int t0 = it * 32;
#pragma unroll
    for (int i = 0; i < 2; ++i) {
      const int idx = (i * NT + tid) * 4;
      *(int4*)(eidx + idx) = *(const int4*)(p.eidxG() + (size_t)t0 * 128 + idx);
      *(float4*)(gts + idx) = *(const float4*)(p.gateG() + (size_t)t0 * 128 + idx);
    }
    __syncthreads();
    for (int ti = 0; ti < 4; ++ti) {
      const int tok = wid * 4 + ti, t = t0 + tok;
      typedef float f32x32 __attribute__((ext_vector_type(32)));
      typedef unsigned u32x6 __attribute__((ext_vector_type(6)));
      float hreg[32];
      f32x32 o;
#pragma unroll
      for (int q = 0; q < 8; ++q) {
        const u32x2 hv = *(const u32x2*)(p.h1b() + (size_t)t * D_ + (q * 64 + lane) * 4);
        hreg[q * 4] = bflo(hv[0]); hreg[q * 4 + 1] = bfhi(hv[0]); hreg[q * 4 + 2] = bflo(hv[1]); hreg[q * 4 + 3] = bfhi(hv[1]);
      }
#pragma unroll
      for (int i = 0; i < 32; ++i) o[i] = 0.f;
      const float* Us = p.Us(); const float* Vs = p.Vs();
      const unsigned char* Uq = p.Uq() + lane * 24;
      const int* ep = eidx + tok * 128; const float* gp = gts + tok * 128;
      u32x4 uA4[2], vA4[2], uB4[2], vB4[2]; u32x2 uA2[2], vA2[2], uB2[2], vB2[2];
      float gA[2], suA[2], svA[2], gB[2], suB[2], svB[2];
#define PEER_LOAD(U4, U2, V4, V2, G, SU, SV, J0)                                                        \
      _Pragma("unroll") for (int jj = 0; jj < 2; ++jj) {                                                \
        const int e = __builtin_amdgcn_readfirstlane(ep[(J0) + jj]);                                    \
        G[jj] = gp[(J0) + jj]; SU[jj] = Us[e]; SV[jj] = Vs[e];                                          \
        const unsigned char* up = Uq + (size_t)e * 3072; const unsigned char* vp = up + 1536;           \
        U2[jj] = *(const u32x2*)(up); U4[jj] = *(const u32x4*)(up + 8);                                 \
        V2[jj] = *(const u32x2*)(vp); V4[jj] = *(const u32x4*)(vp + 8);                                 \
      }
#define PEER_COMPUTE(U4, U2, V4, V2, G, SU, SV)                                                         \
      _Pragma("unroll") for (int jj = 0; jj < 2; ++jj) {                                                \
        const u32x6 uw = {U2[jj][0], U2[jj][1], U4[jj][0], U4[jj][1], U4[jj][2], U4[jj][3]};            \
        const f32x32 ud = __builtin_amdgcn_cvt_scalef32_pk32_f32_fp6(uw, 1.0f);                         \
        float d0 = 0.f, d1 = 0.f, d2 = 0.f, d3 = 0.f;                                                   \
        _Pragma("unroll") for (int i = 0; i < 32; i += 4) {                                             \
          d0 += ud[i] * hreg[i]; d1 += ud[i + 1] * hreg[i + 1]; d2 += ud[i + 2] * hreg[i + 2]; d3 += ud[i + 3] * hreg[i + 3]; \
        }                                                                                               \
        const float av = wave_sum((d0 + d1) + (d2 + d3)) * SU[jj];                                      \
        const float act = gelu_exact(av) * G[jj] * SV[jj];                                              \
        const u32x6 vw = {V2[jj][0], V2[jj][1], V4[jj][0], V4[jj][1], V4[jj][2], V4[jj][3]};            \
        const f32x32 vd = __builtin_amdgcn_cvt_scalef32_pk32_f32_fp6(vw, 1.0f);                         \
        o += vd * act;                                                                                  \
      }
      PEER_LOAD(uA4, uA2, vA4, vA2, gA, suA, svA, 0)
#pragma unroll 1
      for (int j0 = 0; j0 < 128; j0 += 4) {
        PEER_LOAD(uB4, uB2, vB4, vB2, gB, suB, svB, j0 + 2)
        PEER_COMPUTE(uA4, uA2, vA4, vA2, gA, suA, svA)
        if (j0 + 4 < 128) { PEER_LOAD(uA4, uA2, vA4, vA2, gA, suA, svA, j0 + 4) }
        PEER_COMPUTE(uB4, uB2, vB4, vB2, gB, suB, svB)
      }
#undef PEER_LOAD
#undef PEER_COMPUTE
      float* orow = p.out + (size_t)t * D_ + lane * 4;
      float sum = 0.f;
#pragma unroll
      for (int q = 0; q < 8; ++q) {
        const u32x2 rb2 = *(const u32x2*)(p.r2b() + (size_t)t * D_ + (q * 64 + lane) * 4);
        const float4 r0 = make_float4(bflo(rb2[0]), bfhi(rb2[0]), bflo(rb2[1]), bfhi(rb2[1]));
        o[q * 4 + 0] += r0.x; o[q * 4 + 1] += r0.y; o[q * 4 + 2] += r0.z; o[q * 4 + 3] += r0.w;
      }
#pragma unroll
      for (int i = 0; i < 32; ++i) sum += o[i];
      const float mu = wave_sum(sum) * (1.f / D_);
      float sq = 0.f;
#pragma unroll
      for (int i = 0; i < 32; ++i) { o[i] -= mu; sq += o[i] * o[i]; }
      const float rstd = rsqrtf(wave_sum(sq) * (1.f / D_) + EPS);
#pragma unroll
      for (int q = 0; q < 8; ++q) {
        const int col = (q * 64 + lane) * 4;
        const float4 g0 = *(const float4*)(p.ln2_g + col), b0 = *(const float4*)(p.ln2_b + col);
        float4 w0;
        w0.x = o[q * 4 + 0] * rstd * g0.x + b0.x; w0.y = o[q * 4 + 1] * rstd * g0.y + b0.y;
        w0.z = o[q * 4 + 2] * rstd * g0.z + b0.z; w0.w = o[q * 4 + 3] * rstd * g0.w + b0.w;
        *(float4*)(orow + q * 256) = w0;
      }
    }
    __syncthreads();
  }
}

template <int PH>
__device__ __forceinline__ void run_phase(const Params& p, char* smem, int bid, int nb) {
  if constexpr (PH == 0) phase_prep(p, smem, bid, nb);
  if constexpr (PH == 1) phase_inproj(p, smem, bid, nb);
  if constexpr (PH == 2) phase_up(p, smem, bid, nb);
#ifdef ATTN_NAIVE
  if constexpr (PH == 3) phase_attn_naive(p, smem, bid, nb);
#else
  if constexpr (PH == 3) phase_attn(p, smem, bid, nb);
#endif
  if constexpr (PH == 4) phase_outproj(p, smem, bid, nb);
  if constexpr (PH == 5) phase_ln1(p, bid, nb);
  if constexpr (PH == 6) phase_mid(p, smem, bid, nb);
  if constexpr (PH == 7) phase_peer(p, smem, bid, nb);
}

template <int PH>
__global__ void __launch_bounds__(NT, 2) phase_kernel(Params p) {
  __shared__ __attribute__((aligned(16))) char smem[SMEM_BYTES];
  run_phase<PH>(p, smem, blockIdx.x, gridDim.x);
}

#define BW_CENSUS(j) (256 + (j) * 32)
#define BW_XSUB(j) (256 + 512 + (j) * 32)
#define BW_XGEN(j) (256 + 1024 + (j) * 32)
#define BW_TOP (256 + 1536)
#define BW_TOPGEN (256 + 1568)
__device__ __forceinline__ unsigned bw_ld(unsigned* p) { return __hip_atomic_load(p, __ATOMIC_RELAXED, __HIP_MEMORY_SCOPE_AGENT); }
__device__ __forceinline__ unsigned bw_add(unsigned* p, unsigned v) { return __hip_atomic_fetch_add(p, v, __ATOMIC_RELAXED, __HIP_MEMORY_SCOPE_AGENT); }
__device__ __forceinline__ unsigned xcc_id() { return (unsigned)__builtin_amdgcn_s_getreg((3 << 11) | 20) & 0xFu; }

__device__ __forceinline__ void grid_barrier(unsigned* bar, unsigned* st  ) {
  asm volatile("s_waitcnt vmcnt(0)" ::: "memory");
  __syncthreads();
  if (threadIdx.x == 0) {
    __builtin_amdgcn_s_waitcnt(0);
    const unsigned x = xcc_id();
    unsigned nloc = st[0], nx = st[1];
    if (nloc == 0u) {
      const unsigned G = gridDim.x;
      for (;;) {
        unsigned sum = 0u, cnt = 0u, mine = 0u;
#pragma unroll
        for (unsigned j = 0; j < 16; ++j) { const unsigned c = bw_ld(&bar[BW_CENSUS(j)]); sum += c; cnt += (c > 0u) ? 1u : 0u; mine = (j == x) ? c : mine; }
        nloc = mine; nx = cnt;
        if (sum == G) break;
        __builtin_amdgcn_s_sleep(1);
      }
      st[0] = nloc; st[1] = nx;
    }
    const unsigned old = bw_add(&bar[BW_XSUB(x)], 1u);
    const unsigned gen = old / nloc;
    if (old + 1u == (gen + 1u) * nloc) {
      __builtin_amdgcn_fence(__ATOMIC_RELEASE, "agent");
      asm volatile("s_waitcnt vmcnt(0)" ::: "memory");
      const unsigned og = bw_add(&bar[BW_TOP], 1u);
      const unsigned tg = og / nx;
      if (og + 1u == (tg + 1u) * nx) bw_add(&bar[BW_TOPGEN], 1u);
      else while (bw_ld(&bar[BW_TOPGEN]) == tg) __builtin_amdgcn_s_sleep(1);
      __builtin_amdgcn_fence(__ATOMIC_ACQUIRE, "agent");
      bw_add(&bar[BW_XGEN(x)], 1u);
      asm volatile("s_waitcnt vmcnt(0)" ::: "memory");
    } else {
      while (bw_ld(&bar[BW_XGEN(x)]) == gen) __builtin_amdgcn_s_sleep(1);
      __builtin_amdgcn_fence(__ATOMIC_ACQUIRE, "agent");
      asm volatile("s_waitcnt vmcnt(0)" ::: "memory");
    }
  }
  __syncthreads();
}

#if SINGLE_LAUNCH
typedef const __attribute__((address_space(4))) unsigned long long* kargp_t;
static_assert(sizeof(Params) % 8 == 0, "Params must be a pack of 8-byte fields");
#define RUN_PHASE(N) run_phase<N>(p_, smem, bid, nb);
__global__ void __launch_bounds__(NT, 2) fwd_kernel(Params p_) {
  __shared__ __attribute__((aligned(16))) char smem[SMEM_BYTES + 64];
  const int bid = blockIdx.x, nb = gridDim.x;
  unsigned* bar = (unsigned*)(p_.ws + O_CTR);
  unsigned* st = (unsigned*)(smem + SMEM_BYTES);
  if (threadIdx.x == 0) { st[0] = 0u; st[1] = 0u; (void)bw_add(&bar[BW_CENSUS(xcc_id())], 1u); }
  if (p_.out == nullptr) cg::this_grid().sync();
  RUN_PHASE(0) grid_barrier(bar, st);
  RUN_PHASE(1) grid_barrier(bar, st);
  RUN_PHASE(2) grid_barrier(bar, st);
  RUN_PHASE(3) grid_barrier(bar, st);
  RUN_PHASE(4) grid_barrier(bar, st);
  RUN_PHASE(5) grid_barrier(bar, st);
  RUN_PHASE(6) grid_barrier(bar, st);
  RUN_PHASE(7)
}
#endif

extern "C" void kernel_launch(void* const* d_in, const int* in_sizes, int n_in, void* d_out, int out_size,
                              void* d_ws, size_t ws_size, hipStream_t stream) {
  (void)in_sizes; (void)n_in; (void)out_size; (void)ws_size;
  Params p{};
  p.x = (const float*)d_in[0]; p.p = (const float*)d_in[1]; p.positions = (const int*)d_in[2];
  p.w_in = (const float*)d_in[3]; p.b_forget = (const float*)d_in[4]; p.g_q = (const float*)d_in[5];
  p.w_uq = (const float*)d_in[6]; p.g_kv = (const float*)d_in[7]; p.w_ukv = (const float*)d_in[8];
  p.w_out = (const float*)d_in[9]; p.ln1_g = (const float*)d_in[10]; p.ln1_b = (const float*)d_in[11];
  p.peer_wq = (const float*)d_in[12]; p.keys1 = (const float*)d_in[13]; p.keys2 = (const float*)d_in[14];
  p.peer_u = (const float*)d_in[15]; p.peer_v = (const float*)d_in[16]; p.wgate = (const float*)d_in[17];
  p.wproj = (const float*)d_in[18]; p.ln2_g = (const float*)d_in[19]; p.ln2_b = (const float*)d_in[20];
  p.out = (float*)d_out;
  p.ws = (char*)d_ws;

  static int grid_blocks = 0;
  if (!grid_blocks) {
    int dev = 0, cus = 0, per_cu = 0;
    (void)hipGetDevice(&dev);
    (void)hipDeviceGetAttribute(&cus, hipDeviceAttributeMultiprocessorCount, dev);
#if SINGLE_LAUNCH
    (void)hipOccupancyMaxActiveBlocksPerMultiprocessor(&per_cu, fwd_kernel, NT, 0);
#else
    per_cu = 2;
#endif
    if (per_cu > 1) per_cu = 1;
    if (per_cu < 1) per_cu = 1;
    grid_blocks = cus * per_cu;
  }
#if SINGLE_LAUNCH
  (void)hipMemsetAsync(d_ws, 0, 16384, stream);
  void* args[] = {&p};
  hipError_t e = hipLaunchCooperativeKernel((void*)fwd_kernel, dim3(grid_blocks), dim3(NT), args, 0, stream);
  if (e != hipSuccess) fprintf(stderr, "cooperative launch failed: %s (grid %d)\n", hipGetErrorString(e), grid_blocks);
#else
  phase_kernel<0><<<grid_blocks, NT, 0, stream>>>(p);
  phase_kernel<1><<<grid_blocks, NT, 0, stream>>>(p);
  phase_kernel<2><<<grid_blocks, NT, 0, stream>>>(p);
  phase_kernel<3><<<grid_blocks, NT, 0, stream>>>(p);
  phase_kernel<4><<<grid_blocks, NT, 0, stream>>>(p);
  phase_kernel<5><<<grid_blocks, NT, 0, stream>>>(p);
  phase_kernel<6><<<grid_blocks, NT, 0, stream>>>(p);
  phase_kernel<7><<<grid_blocks, NT, 0, stream>>>(p);
#endif
}
```
